# Optimizing an MI355X kernel written in HIP

```python
import jax, jax.numpy as jnp
from jax import lax
import numpy as np

D_MODEL = 2048
BATCH = 8
SEQ = 2048
DEPTH = 1

D_MIX = D_MODEL
D_LRU = D_MIX // 2
D_SGU = D_MIX - D_LRU
LRU_HEADS = 8
LRU_BLOCK = D_LRU // LRU_HEADS
CONV_WIDTH = 4
LRU_C = 8.0
SGU_GROUPS = 8
SGU_GROUP_DIM = D_SGU // SGU_GROUPS
CHUNK = 128
PEER_HEADS = 8
N_KEYS = 128
N_EXPERTS = N_KEYS * N_KEYS
PEER_TOPK = 16
D_KEY = 256
PEER_BLOCK = 128
EPS = 1e-6

kernel_name = "hybrid_rglru_sgu_peer_adaln_block"


def rms_norm(x, g):
    xf = x.astype(jnp.float32)
    y = xf * lax.rsqrt(jnp.mean(xf * xf, axis=-1, keepdims=True) + EPS)
    return (y * g.astype(jnp.float32)).astype(x.dtype)


def modulate(h, shift, scale):
    return h * (1 + scale[:, None, :]) + shift[:, None, :]


def causal_depthwise_conv(x, w, b):
    out = lax.conv_general_dilated(
        x, w[:, None, :].astype(x.dtype), window_strides=(1,),
        padding=[(CONV_WIDTH - 1, 0)],
        dimension_numbers=("NWC", "WIO", "NWC"),
        feature_group_count=x.shape[-1])
    return out + b


def rg_lru(x, w_a, b_a, w_i, b_i, lam):
    B, S, _ = x.shape
    xh = x.reshape(B, S, LRU_HEADS, LRU_BLOCK)
    r = jax.nn.sigmoid(jnp.einsum('bshi,hij->bshj', xh, w_a) + b_a).reshape(B, S, D_LRU)
    i = jax.nn.sigmoid(jnp.einsum('bshi,hij->bshj', xh, w_i) + b_i).reshape(B, S, D_LRU)
    log_a = -LRU_C * r.astype(jnp.float32) * jax.nn.softplus(-lam.astype(jnp.float32))
    a = jnp.exp(log_a)
    b = jnp.sqrt(-jnp.expm1(2.0 * log_a)) * (i * x).astype(jnp.float32)

    def combine(left, right):
        a1, b1 = left
        a2, b2 = right
        return a1 * a2, a2 * b1 + b2

    _, h = lax.associative_scan(combine, (a, b), axis=1)
    return h.astype(x.dtype)


def spatial_gating(u, v, g_v, w_s, b_s):
    B, S, _ = v.shape
    nc = S // CHUNK
    v = rms_norm(v, g_v)
    vv = v.reshape(B, nc, CHUNK, SGU_GROUPS, SGU_GROUP_DIM)
    mask = jnp.tril(jnp.ones((CHUNK, CHUNK), dtype=bool))
    w = jnp.where(mask[None], w_s, 0)
    s = jnp.einsum('gij,bnjgd->bnigd', w, vv) + b_s.T[None, None, :, :, None]
    return u * s.reshape(B, S, D_SGU)


def hybrid_mixer(h, w_in, conv_w, conv_b, w_gate_a, b_gate_a, w_gate_i, b_gate_i,
                 lru_lambda, g_v, w_spatial, b_spatial, w_out):
    proj = h @ w_in
    x_lru, y_gate, u, v = jnp.split(proj, [D_LRU, 2 * D_LRU, 2 * D_LRU + D_SGU], axis=-1)
    xc = causal_depthwise_conv(x_lru, conv_w, conv_b)
    y_rec = rg_lru(xc, w_gate_a, b_gate_a, w_gate_i, b_gate_i, lru_lambda) * jax.nn.gelu(y_gate)
    y_sgu = spatial_gating(jax.nn.gelu(u), jax.nn.gelu(v), g_v, w_spatial, b_spatial)
    return jnp.concatenate([y_rec, y_sgu], axis=-1) @ w_out


def peer(h, w_query, sub_keys, expert_u, expert_v):
    B, S, D = h.shape
    q = (h @ w_query).reshape(B, S, PEER_HEADS, 2, D_KEY // 2)
    s = jnp.einsum('bshpk,hpnk->bshpn', q, sub_keys).astype(jnp.float32)
    v1, i1 = lax.top_k(s[..., 0, :], PEER_TOPK)
    v2, i2 = lax.top_k(s[..., 1, :], PEER_TOPK)
    n_cand = PEER_TOPK * PEER_TOPK
    cand = (v1[..., :, None] + v2[..., None, :]).reshape(B, S, PEER_HEADS, n_cand)
    cand_idx = (i1[..., :, None] * N_KEYS + i2[..., None, :]).reshape(B, S, PEER_HEADS, n_cand)
    top_v, pos = lax.top_k(cand, PEER_TOPK)
    idx = jnp.take_along_axis(cand_idx, pos, axis=-1)
    g = jax.nn.softmax(top_v, axis=-1)
    n_sel = PEER_HEADS * PEER_TOPK
    nb = (B * S) // PEER_BLOCK
    xb = h.reshape(nb, PEER_BLOCK, D)
    ib = idx.reshape(nb, PEER_BLOCK, n_sel)
    gb = g.astype(h.dtype).reshape(nb, PEER_BLOCK, n_sel)

    def block(args):
        xt, it, gt = args
        u = jnp.take(expert_u, it, axis=0)
        act = jax.nn.gelu(jnp.einsum('td,ted->te', xt, u)) * gt
        vv = jnp.take(expert_v, it, axis=0)
        return jnp.einsum('te,ted->td', act, vv)

    out = lax.map(block, (xb, ib, gb))
    return out.reshape(B, S, D)


def setup_inputs(seed: int = 0) -> dict:
    key = jax.random.key(seed)
    k = jax.random.split(key, 24)
    f32 = jnp.float32

    def nrm(kk, shape, scale):
        return jax.random.normal(kk, shape, f32) * scale

    L = DEPTH
    a0 = jax.random.uniform(k[10], (L, D_LRU), f32, minval=0.9, maxval=0.999)
    return {
        "x": nrm(k[0], (BATCH, SEQ, D_MODEL), 1.0),
        "c": nrm(k[1], (BATCH, D_MODEL), 1.0),
        "w_ada": nrm(k[2], (L, D_MODEL, 6 * D_MODEL), 0.5 * D_MODEL ** -0.5),
        "b_ada": nrm(k[3], (L, 6 * D_MODEL), 0.01),
        "g_norm_mix": 1.0 + nrm(k[4], (L, D_MODEL), 0.02),
        "w_in": nrm(k[5], (L, D_MODEL, 2 * D_LRU + 2 * D_SGU), D_MODEL ** -0.5),
        "conv_w": nrm(k[6], (L, CONV_WIDTH, D_LRU), CONV_WIDTH ** -0.5),
        "conv_b": nrm(k[7], (L, D_LRU), 0.01),
        "w_gate_a": nrm(k[8], (L, LRU_HEADS, LRU_BLOCK, LRU_BLOCK), LRU_BLOCK ** -0.5),
        "b_gate_a": nrm(k[9], (L, LRU_HEADS, LRU_BLOCK), 0.01),
        "w_gate_i": nrm(k[11], (L, LRU_HEADS, LRU_BLOCK, LRU_BLOCK), LRU_BLOCK ** -0.5),
        "b_gate_i": nrm(k[12], (L, LRU_HEADS, LRU_BLOCK), 0.01),
        "lru_lambda": jnp.log(a0) - jnp.log1p(-a0),
        "g_v": 1.0 + nrm(k[13], (L, D_SGU), 0.02),
        "w_spatial": nrm(k[14], (L, SGU_GROUPS, CHUNK, CHUNK), 0.5 * CHUNK ** -0.5),
        "b_spatial": 1.0 + nrm(k[15], (L, SGU_GROUPS, CHUNK), 0.01),
        "w_out": nrm(k[16], (L, D_MIX, D_MODEL), D_MIX ** -0.5),
        "g_norm_ffn": 1.0 + nrm(k[17], (L, D_MODEL), 0.02),
        "w_query": nrm(k[18], (L, D_MODEL, PEER_HEADS * D_KEY), D_MODEL ** -0.5),
        "sub_keys": nrm(k[19], (L, PEER_HEADS, 2, N_KEYS, D_KEY // 2), (D_KEY // 2) ** -0.5),
        "expert_u": nrm(k[20], (L, N_EXPERTS, D_MODEL), D_MODEL ** -0.5),
        "expert_v": nrm(k[21], (L, N_EXPERTS, D_MODEL), 1.0),
        "g_final": 1.0 + nrm(k[22], (D_MODEL,), 0.02),
    }


def reference(x, c, w_ada, b_ada, g_norm_mix, w_in, conv_w, conv_b, w_gate_a, b_gate_a,
              w_gate_i, b_gate_i, lru_lambda, g_v, w_spatial, b_spatial, w_out,
              g_norm_ffn, w_query, sub_keys, expert_u, expert_v, g_final):
    for l in range(DEPTH):
        mod = jax.nn.silu(c) @ w_ada[l] + b_ada[l]
        sh_m, sc_m, gt_m, sh_f, sc_f, gt_f = jnp.split(mod, 6, axis=-1)
        h = modulate(rms_norm(x, g_norm_mix[l]), sh_m, sc_m)
        mix = hybrid_mixer(h, w_in[l], conv_w[l], conv_b[l], w_gate_a[l], b_gate_a[l],
                           w_gate_i[l], b_gate_i[l], lru_lambda[l], g_v[l],
                           w_spatial[l], b_spatial[l], w_out[l])
        x = x + gt_m[:, None, :] * mix
        h = modulate(rms_norm(x, g_norm_ffn[l]), sh_f, sc_f)
        x = x + gt_f[:, None, :] * peer(h, w_query[l], sub_keys[l], expert_u[l], expert_v[l])
    return rms_norm(x, g_final)
```

```cpp
#include <hip/hip_runtime.h>
#include <cstdio>
#include <cstdint>

constexpr int D = 2048, NB = 8, SEQ = 2048, M = NB * SEQ;
constexpr int DLRU = 1024, DSGU = 1024, NPROJ = 4096;
constexpr int NMOD = 6 * D;
constexpr int NHEAD = 8, NKEYS = 128, TOPK = 16, NSEL = NHEAD * TOPK;
constexpr float EPS = 1e-6f;
constexpr int NT = 512;

constexpr size_t MiB = 1u << 20;
constexpr size_t WS_CTL = 0;
constexpr size_t WS_MODP = 1 * MiB;
constexpr size_t WS_RSTDV = 8 * MiB;
constexpr size_t WS_IDX = 41 * MiB;
constexpr size_t WS_GATE = 49 * MiB;
constexpr size_t WS_H = 64 * MiB;
constexpr size_t WS_PROJ = 128 * MiB;
constexpr size_t WS_Q = 128 * MiB;
constexpr size_t WS_YMIX = 256 * MiB;
constexpr size_t WS_XC = 320 * MiB;
constexpr size_t WS_A = 384 * MiB;
constexpr size_t WS_BB = 448 * MiB;
constexpr size_t WS_END = 512 * MiB;

typedef unsigned short bf16_t;
struct Params { const float* in[23]; float* out; unsigned char* ws; };
enum { I_X = 0, I_C, I_WADA, I_BADA, I_GMIX, I_WIN, I_CONVW, I_CONVB, I_WGA, I_BGA, I_WGI, I_BGI, I_LAM, I_GV, I_WSP, I_BSP, I_WOUT, I_GFFN, I_WQ, I_SKEY, I_EU, I_EV, I_GFIN };

__device__ __forceinline__ float bf2f(bf16_t v) { return __uint_as_float(((unsigned)v) << 16); }
__device__ __forceinline__ bf16_t f2bf(float f) { unsigned u = __float_as_uint(f); u += 0x7fffu + ((u >> 16) & 1u); return (bf16_t)(u >> 16); }
__device__ __forceinline__ float sigmoidf_(float x) { return 1.f / (1.f + __expf(-x)); }
__device__ __forceinline__ float gelu_t(float x) { const float u = 0.7978845608028654f * (x + 0.044715f * x * x * x); return x * sigmoidf_(2.f * u); }
__device__ __forceinline__ float wave_sum(float v) {
#pragma unroll
    for (int o = 1; o < 64; o <<= 1) v += __shfl_xor(v, o);
    return v;
}
__device__ __forceinline__ float mod_at(const Params& p, int b, int n) {
    const float* mp = (const float*)(p.ws + WS_MODP);
    float s = p.in[I_BADA][n];
#pragma unroll
    for (int kc = 0; kc < 4; ++kc) s += mp[(size_t)(kc * 8 + b) * NMOD + n];
    return s;
}

__device__ void phase_mod(const Params& p, float* lds, int bid, int nb) {
    const int tid = threadIdx.x, lane = tid & 63, wave = tid >> 6;
    const float* c = p.in[I_C]; const float* W = p.in[I_WADA];
    float* modp = (float*)(p.ws + WS_MODP);
    for (int i = tid; i < NB * D; i += NT) { const float v = c[i]; lds[i] = v * sigmoidf_(v); }
    __syncthreads();
    float* red = lds + NB * D;
    for (int item = bid; item < 192; item += nb) {
        const int nt = item % 48, kc = item / 48;
        const int n0 = nt * 256 + lane * 4, k0 = kc * 512 + wave * 64;
        float acc[8][4];
#pragma unroll
        for (int b = 0; b < 8; ++b)
#pragma unroll
            for (int j = 0; j < 4; ++j) acc[b][j] = 0.f;
        for (int kk = 0; kk < 64; ++kk) {
            const float4 w = *(const float4*)(W + (size_t)(k0 + kk) * NMOD + n0);
#pragma unroll
            for (int b = 0; b < 8; ++b) { const float s = lds[b * D + k0 + kk]; acc[b][0] += s * w.x; acc[b][1] += s * w.y; acc[b][2] += s * w.z; acc[b][3] += s * w.w; }
        }
#pragma unroll
        for (int b = 0; b < 8; ++b)
#pragma unroll
            for (int j = 0; j < 4; ++j) red[(wave * 32 + b * 4 + j) * 64 + lane] = acc[b][j];
        __syncthreads();
        for (int o = tid; o < 2048; o += NT) {
            const int b = o >> 8, nn = o & 255, ln = nn >> 2, j = nn & 3;
            float s = 0.f;
#pragma unroll
            for (int w = 0; w < 8; ++w) s += red[(w * 32 + b * 4 + j) * 64 + ln];
            modp[(size_t)(kc * 8 + b) * NMOD + nt * 256 + nn] = s;
        }
        __syncthreads();
    }
}

__device__ void phase_hrows(const Params& p, const float* src, const float* gn, int shift_off, int scale_off, bf16_t* dst, float* lds, int bid, int nb) {
    const int tid = threadIdx.x, lane = tid & 63, wave = tid >> 6;
    float* Aw = lds; float* Bw = lds + D;
    for (int item = bid; item < M / 64; item += nb) {
        const int b = item / (SEQ / 64);
        for (int col = tid; col < D; col += NT) { Aw[col] = gn[col] * (1.f + mod_at(p, b, scale_off + col)); Bw[col] = mod_at(p, b, shift_off + col); }
        __syncthreads();
        for (int r = wave; r < 64; r += 8) {
            const size_t row = (size_t)item * 64 + r;
            float4 v[8]; float ss = 0.f;
#pragma unroll
            for (int j = 0; j < 8; ++j) { v[j] = *(const float4*)(src + row * D + lane * 4 + 256 * j); ss += v[j].x * v[j].x + v[j].y * v[j].y + v[j].z * v[j].z + v[j].w * v[j].w; }
            const float rstd = rsqrtf(wave_sum(ss) * (1.f / D) + EPS);
#pragma unroll
            for (int j = 0; j < 8; ++j) {
                const int col = lane * 4 + 256 * j;
                const float o0 = v[j].x * rstd * Aw[col] + Bw[col], o1 = v[j].y * rstd * Aw[col + 1] + Bw[col + 1];
                const float o2 = v[j].z * rstd * Aw[col + 2] + Bw[col + 2], o3 = v[j].w * rstd * Aw[col + 3] + Bw[col + 3];
                uint2 w; w.x = (unsigned)f2bf(o0) | ((unsigned)f2bf(o1) << 16); w.y = (unsigned)f2bf(o2) | ((unsigned)f2bf(o3) << 16);
                *(uint2*)(dst + row * D + col) = w;
            }
        }
        __syncthreads();
    }
}

template <class Epi>
__device__ void naive_gemm(const bf16_t* A, const float* W, int Mm, int N, int K, const Epi& epi, float* lds, int bid, int nb) {
    const int tid = threadIdx.x, ty = tid >> 4, tx = tid & 15;
    float* As = lds;
    float* Bs = lds + 16 * 132;
    const int ntn = N / 64, ntiles = (Mm / 128) * ntn;
    for (int tile = bid; tile < ntiles; tile += nb) {
        const int tm = tile / ntn, tn = tile % ntn;
        float acc[4][4];
#pragma unroll
        for (int i = 0; i < 4; ++i)
#pragma unroll
            for (int j = 0; j < 4; ++j) acc[i][j] = 0.f;
        for (int k0 = 0; k0 < K; k0 += 16) {
            { const int r = tid >> 2, kq = (tid & 3) * 4;
              const uint2 a = *(const uint2*)(A + (size_t)(tm * 128 + r) * K + k0 + kq);
              As[(kq + 0) * 132 + r] = bf2f((bf16_t)(a.x & 0xffff)); As[(kq + 1) * 132 + r] = bf2f((bf16_t)(a.x >> 16));
              As[(kq + 2) * 132 + r] = bf2f((bf16_t)(a.y & 0xffff)); As[(kq + 3) * 132 + r] = bf2f((bf16_t)(a.y >> 16)); }
            { const int kk = tid >> 5, n2 = (tid & 31) * 2;
              const float2 b = *(const float2*)(W + (size_t)(k0 + kk) * N + tn * 64 + n2);
              Bs[kk * 68 + n2] = b.x; Bs[kk * 68 + n2 + 1] = b.y; }
            __syncthreads();
#pragma unroll
            for (int kk = 0; kk < 16; ++kk) {
                const float4 a = *(const float4*)(As + kk * 132 + ty * 4);
                const float4 b = *(const float4*)(Bs + kk * 68 + tx * 4);
                const float av[4] = {a.x, a.y, a.z, a.w}, bv[4] = {b.x, b.y, b.z, b.w};
#pragma unroll
                for (int i = 0; i < 4; ++i)
#pragma unroll
                    for (int j = 0; j < 4; ++j) acc[i][j] += av[i] * bv[j];
            }
            __syncthreads();
        }
#pragma unroll
        for (int i = 0; i < 4; ++i) epi(tm * 128 + ty * 4 + i, tn * 64 + tx * 4, acc[i]);
    }
}
struct EpiProj {
    bf16_t* proj;
    __device__ __forceinline__ void operator()(int m, int n0, const float (&v)[4]) const {
        const int which = n0 >> 10, cc = n0 & 1023;
        bf16_t* o = proj + (size_t)which * M * 1024 + (size_t)m * 1024 + cc;
#pragma unroll
        for (int j = 0; j < 4; ++j) o[j] = f2bf(which ? gelu_t(v[j]) : v[j]);
    }
};
struct EpiX1 {
    Params p;
    __device__ __forceinline__ void operator()(int m, int n0, const float (&v)[4]) const {
        const int b = m / SEQ;
#pragma unroll
        for (int j = 0; j < 4; ++j) p.out[(size_t)m * D + n0 + j] = p.in[I_X][(size_t)m * D + n0 + j] + mod_at(p, b, 2 * D + n0 + j) * v[j];
    }
};
struct EpiQ {
    bf16_t* q;
    __device__ __forceinline__ void operator()(int m, int n0, const float (&v)[4]) const {
#pragma unroll
        for (int j = 0; j < 4; ++j) q[(size_t)m * D + n0 + j] = f2bf(v[j]);
    }
};

__device__ void phase_conv_naive(const Params& p, int bid, int nb) {
    const bf16_t* xl = (const bf16_t*)(p.ws + WS_PROJ); float* xc = (float*)(p.ws + WS_XC);
    const float* cw = p.in[I_CONVW]; const float* cb = p.in[I_CONVB];
    for (size_t e = (size_t)bid * NT + threadIdx.x; e < (size_t)M * DLRU; e += (size_t)nb * NT) {
        const int c = (int)(e & 1023); const size_t row = e >> 10; const int t = (int)(row % SEQ);
        float s = cb[c];
#pragma unroll
        for (int k = 0; k < 4; ++k) { const int tt = t - 3 + k; if (tt >= 0) s += cw[k * DLRU + c] * bf2f(xl[(row - 3 + k) * 1024 + c]); }
        xc[e] = s;
    }
}
__device__ void phase_gates_naive(const Params& p, int bid, int nb) {
    const float* xc = (const float*)(p.ws + WS_XC); float* av = (float*)(p.ws + WS_A); float* bv = (float*)(p.ws + WS_BB);
    const float* wa = p.in[I_WGA]; const float* wi = p.in[I_WGI];
    for (size_t e = (size_t)bid * NT + threadIdx.x; e < (size_t)M * DLRU; e += (size_t)nb * NT) {
        const int c = (int)(e & 1023); const size_t row = e >> 10; const int hd = c >> 7, j = c & 127;
        float za = p.in[I_BGA][c], zi = p.in[I_BGI][c];
        const float* xr = xc + row * 1024 + hd * 128;
        for (int i = 0; i < 128; ++i) { const float xv = xr[i]; za += xv * wa[(size_t)(hd * 128 + i) * 128 + j]; zi += xv * wi[(size_t)(hd * 128 + i) * 128 + j]; }
        const float r = sigmoidf_(za), ig = sigmoidf_(zi);
        const float lam = p.in[I_LAM][c];
        const float sp = fmaxf(-lam, 0.f) + log1pf(__expf(-fabsf(lam)));
        const float la = -8.f * r * sp;
        const float a = __expf(la);
        av[e] = a; bv[e] = sqrtf(fmaxf(-expm1f(2.f * la), 0.f)) * (ig * xc[e]);
    }
}
__device__ void phase_scan_naive(const Params& p, int bid, int nb) {
    const float* av = (const float*)(p.ws + WS_A); const float* bv = (const float*)(p.ws + WS_BB);
    const bf16_t* yg = (const bf16_t*)(p.ws + WS_PROJ) + (size_t)M * 1024;
    bf16_t* ymix = (bf16_t*)(p.ws + WS_YMIX);
    for (int e = bid * NT + threadIdx.x; e < NB * DLRU; e += nb * NT) {
        const int b = e >> 10, c = e & 1023;
        float h = 0.f;
        for (int t = 0; t < SEQ; ++t) { const size_t row = (size_t)b * SEQ + t; h = av[row * 1024 + c] * h + bv[row * 1024 + c]; ymix[row * D + c] = f2bf(h * bf2f(yg[row * 1024 + c])); }
    }
}
__device__ void phase_rstdv_naive(const Params& p, int bid, int nb) {
    const bf16_t* vg = (const bf16_t*)(p.ws + WS_PROJ) + (size_t)3 * M * 1024; float* rs = (float*)(p.ws + WS_RSTDV);
    const int lane = threadIdx.x & 63, wave = threadIdx.x >> 6;
    for (int row = bid * 8 + wave; row < M; row += nb * 8) {
        float ss = 0.f;
        for (int d = lane; d < 1024; d += 64) { const float v = bf2f(vg[(size_t)row * 1024 + d]); ss += v * v; }
        ss = wave_sum(ss);
        if (lane == 0) rs[row] = rsqrtf(ss * (1.f / 1024.f) + EPS);
    }
}
__device__ void phase_sgu_naive(const Params& p, int bid, int nb) {
    const bf16_t* ug = (const bf16_t*)(p.ws + WS_PROJ) + (size_t)2 * M * 1024; const bf16_t* vg = (const bf16_t*)(p.ws + WS_PROJ) + (size_t)3 * M * 1024;
    const float* rs = (const float*)(p.ws + WS_RSTDV); bf16_t* ymix = (bf16_t*)(p.ws + WS_YMIX);
    const float* ws = p.in[I_WSP]; const float* bs = p.in[I_BSP]; const float* gv = p.in[I_GV];
    for (size_t e = (size_t)bid * NT + threadIdx.x; e < (size_t)M * DSGU; e += (size_t)nb * NT) {
        const int d = (int)(e & 1023); const size_t row = e >> 10; const int g = d >> 7, i = (int)(row & 127); const size_t base = row - i;
        float s = 0.f;
        for (int j = 0; j <= i; ++j) s += ws[(size_t)(g * 128 + i) * 128 + j] * (bf2f(vg[(base + j) * 1024 + d]) * rs[base + j]);
        s = s * gv[d] + bs[g * 128 + i];
        ymix[row * D + 1024 + d] = f2bf(bf2f(ug[row * 1024 + d]) * s);
    }
}

__device__ __forceinline__ void wave_argmax(float& v, int& i) {
#pragma unroll
    for (int off = 32; off >= 1; off >>= 1) { const float ov = __shfl_xor(v, off); const int oi = __shfl_xor(i, off); if (ov > v || (ov == v && oi < i)) { v = ov; i = oi; } }
}
__device__ void phase_topk_naive(const Params& p, int bid, int nb) {
    const bf16_t* Q = (const bf16_t*)(p.ws + WS_Q); const float* keys = p.in[I_SKEY];
    int* idx = (int*)(p.ws + WS_IDX); float* gate = (float*)(p.ws + WS_GATE);
    const int lane = threadIdx.x & 63, wave = threadIdx.x >> 6;
    const float NEG = -3.0e38f;
    for (int task = bid * 8 + wave; task < M * NHEAD; task += nb * 8) {
        const int token = task >> 3, hd = task & 7;
        float tv[2]; int ti[2];
#pragma unroll
        for (int pp = 0; pp < 2; ++pp) {
            const bf16_t* q = Q + (size_t)token * D + hd * 256 + pp * 128;
            const float* k0 = keys + ((size_t)(hd * 2 + pp) * 128 + lane) * 128; const float* k1 = k0 + 64 * 128;
            float s0 = 0.f, s1 = 0.f;
            for (int k = 0; k < 128; k += 4) {
                const uint2 qq = *(const uint2*)(q + k);
                const float q0 = bf2f((bf16_t)(qq.x & 0xffff)), q1 = bf2f((bf16_t)(qq.x >> 16)), q2 = bf2f((bf16_t)(qq.y & 0xffff)), q3 = bf2f((bf16_t)(qq.y >> 16));
                const float4 a = *(const float4*)(k0 + k), b = *(const float4*)(k1 + k);
                s0 += q0 * a.x + q1 * a.y + q2 * a.z + q3 * a.w; s1 += q0 * b.x + q1 * b.y + q2 * b.z + q3 * b.w;
            }
            float myv = NEG; int myi = 0;
            for (int r = 0; r < TOPK; ++r) {
                float v; int i; if (s0 >= s1) { v = s0; i = lane; } else { v = s1; i = lane + 64; }
                wave_argmax(v, i);
                if (i == lane) s0 = NEG; if (i == lane + 64) s1 = NEG;
                if (lane == r) { myv = v; myi = i; }
            }
            tv[pp] = myv; ti[pp] = myi;
        }
        float cv[4];
#pragma unroll
        for (int m = 0; m < 4; ++m) cv[m] = __shfl(tv[0], (lane >> 4) + 4 * m) + __shfl(tv[1], lane & 15);
        float selv = NEG; int selc = 0;
        for (int r = 0; r < TOPK; ++r) {
            float v = cv[0]; int i = lane;
#pragma unroll
            for (int m = 1; m < 4; ++m) if (cv[m] > v) { v = cv[m]; i = lane + 64 * m; }
            wave_argmax(v, i);
#pragma unroll
            for (int m = 0; m < 4; ++m) if (i == lane + 64 * m) cv[m] = NEG;
            if (lane == r) { selv = v; selc = i; }
        }
        const float mx = __shfl(selv, 0);
        const float e = lane < TOPK ? __expf(selv - mx) : 0.f;
        const float sum = wave_sum(e);
        const int i1 = __shfl(ti[0], selc >> 4), i2 = __shfl(ti[1], selc & 15);
        if (lane < TOPK) { idx[(size_t)token * NSEL + hd * TOPK + lane] = i1 * NKEYS + i2; gate[(size_t)token * NSEL + hd * TOPK + lane] = e / sum; }
    }
}

__device__ void phase_peer_naive(const Params& p, int bid, int nb) {
    const bf16_t* H = (const bf16_t*)(p.ws + WS_H); const int* idx = (const int*)(p.ws + WS_IDX); const float* gate = (const float*)(p.ws + WS_GATE);
    const float* EU = p.in[I_EU]; const float* EV = p.in[I_EV]; const float* gf = p.in[I_GFIN];
    const int lane = threadIdx.x & 63, wave = threadIdx.x >> 6;
    for (int token = bid * 8 + wave; token < M; token += nb * 8) {
        float hv[32], acc[32];
#pragma unroll
        for (int j = 0; j < 8; ++j) { const uint2 w = *(const uint2*)(H + (size_t)token * D + lane * 4 + 256 * j);
            hv[4 * j] = bf2f((bf16_t)(w.x & 0xffff)); hv[4 * j + 1] = bf2f((bf16_t)(w.x >> 16)); hv[4 * j + 2] = bf2f((bf16_t)(w.y & 0xffff)); hv[4 * j + 3] = bf2f((bf16_t)(w.y >> 16)); }
#pragma unroll
        for (int j = 0; j < 32; ++j) acc[j] = 0.f;
        for (int s = 0; s < NSEL; ++s) {
            const int e = idx[(size_t)token * NSEL + s]; const float g = gate[(size_t)token * NSEL + s];
            const float* u = EU + (size_t)e * D + lane * 4; const float* v = EV + (size_t)e * D + lane * 4;
            float dot = 0.f;
#pragma unroll
            for (int j = 0; j < 8; ++j) { const float4 w = *(const float4*)(u + 256 * j); dot += hv[4 * j] * w.x + hv[4 * j + 1] * w.y + hv[4 * j + 2] * w.z + hv[4 * j + 3] * w.w; }
            dot = wave_sum(dot);
            const float act = gelu_t(dot) * g;
#pragma unroll
            for (int j = 0; j < 8; ++j) { const float4 w = *(const float4*)(v + 256 * j); acc[4 * j] += act * w.x; acc[4 * j + 1] += act * w.y; acc[4 * j + 2] += act * w.z; acc[4 * j + 3] += act * w.w; }
        }
        const int b = token / SEQ;
        float ss = 0.f;
#pragma unroll
        for (int j = 0; j < 8; ++j) {
            const int col = lane * 4 + 256 * j;
            const float4 x1 = *(const float4*)(p.out + (size_t)token * D + col);
            acc[4 * j] = x1.x + mod_at(p, b, 5 * D + col) * acc[4 * j]; acc[4 * j + 1] = x1.y + mod_at(p, b, 5 * D + col + 1) * acc[4 * j + 1];
            acc[4 * j + 2] = x1.z + mod_at(p, b, 5 * D + col + 2) * acc[4 * j + 2]; acc[4 * j + 3] = x1.w + mod_at(p, b, 5 * D + col + 3) * acc[4 * j + 3];
            ss += acc[4 * j] * acc[4 * j] + acc[4 * j + 1] * acc[4 * j + 1] + acc[4 * j + 2] * acc[4 * j + 2] + acc[4 * j + 3] * acc[4 * j + 3];
        }
        const float rstd = rsqrtf(wave_sum(ss) * (1.f / D) + EPS);
#pragma unroll
        for (int j = 0; j < 8; ++j) {
            const int col = lane * 4 + 256 * j;
            const float4 g4 = *(const float4*)(gf + col);
            float4 o; o.x = acc[4 * j] * rstd * g4.x; o.y = acc[4 * j + 1] * rstd * g4.y; o.z = acc[4 * j + 2] * rstd * g4.z; o.w = acc[4 * j + 3] * rstd * g4.w;
            *(float4*)(p.out + (size_t)token * D + col) = o;
        }
    }
}

extern __shared__ __attribute__((aligned(16))) unsigned char dyn_lds[];
__global__ void __launch_bounds__(NT) k_phase(Params p, int ph) {
    float* lds = (float*)dyn_lds;
    const int bid = blockIdx.x, nb = gridDim.x;
    switch (ph) {
    case 0: phase_mod(p, lds, bid, nb); break;
    case 1: phase_hrows(p, p.in[I_X], p.in[I_GMIX], 0, D, (bf16_t*)(p.ws + WS_H), lds, bid, nb); break;
    case 2: { EpiProj e{(bf16_t*)(p.ws + WS_PROJ)}; naive_gemm(( const bf16_t*)(p.ws + WS_H), p.in[I_WIN], M, NPROJ, D, e, lds, bid, nb); } break;
    case 3: phase_conv_naive(p, bid, nb); break;
    case 4: phase_gates_naive(p, bid, nb); break;
    case 5: phase_scan_naive(p, bid, nb); break;
    case 6: phase_rstdv_naive(p, bid, nb); break;
    case 7: phase_sgu_naive(p, bid, nb); break;
    case 8: { EpiX1 e{p}; naive_gemm((const bf16_t*)(p.ws + WS_YMIX), p.in[I_WOUT], M, D, D, e, lds, bid, nb); } break;
    case 9: phase_hrows(p, p.out, p.in[I_GFFN], 3 * D, 4 * D, (bf16_t*)(p.ws + WS_H), lds, bid, nb); break;
    case 10: { EpiQ e{(bf16_t*)(p.ws + WS_Q)}; naive_gemm((const bf16_t*)(p.ws + WS_H), p.in[I_WQ], M, D, D, e, lds, bid, nb); } break;
    case 11: phase_topk_naive(p, bid, nb); break;
    case 12: phase_peer_naive(p, bid, nb); break;
    }
}

extern "C" void kernel_launch(void* const* d_in, const int* in_sizes, int n_in, void* d_out, int out_size, void* d_ws, size_t ws_size, hipStream_t stream) {
    static int ok = 0;
    if (ok == 0) {
        if (n_in != 23 || in_sizes[0] != M * D || out_size != M * D || ws_size < WS_END) { fprintf(stderr, "kernel_launch: unexpected shapes (n_in %d in0 %d out %d ws %zu)\n", n_in, n_in > 0 ? in_sizes[0] : -1, out_size, ws_size); ok = -1; return; }
        if (hipFuncSetAttribute((const void*)k_phase, hipFuncAttributeMaxDynamicSharedMemorySize, 147456) != hipSuccess) { fprintf(stderr, "hipFuncSetAttribute failed\n"); ok = -1; return; }
        ok = 1;
    }
    if (ok < 0) return;
    Params p{};
    for (int i = 0; i < 23; ++i) p.in[i] = (const float*)d_in[i];
    p.out = (float*)d_out; p.ws = (unsigned char*)d_ws;
    const int big = 147456, small = 16384;
    const int grids[13] = {256, 256, 256, 2048, 2048, 16, 2048, 2048, 256, 256, 256, 2048, 2048};
    const int ldsb[13] = {big, big, big, small, small, small, small, small, big, big, big, small, small};
    for (int ph = 0; ph < 13; ++ph) hipLaunchKernelGGL(k_phase, dim3(grids[ph]), dim3(NT), ldsb[ph], stream, p, ph);
}
```

```cpp
#include <hip/hip_runtime.h>
#include <hip/hip_cooperative_groups.h>
#include <cstdio>
#include <cstdint>

constexpr int D = 2048, NB = 8, SEQ = 2048, M = NB * SEQ;
constexpr int DLRU = 1024, DSGU = 1024, NPROJ = 4096;
constexpr int NMOD = 6 * D;
constexpr int NHEAD = 8, NKEYS = 128, TOPK = 16, NSEL = NHEAD * TOPK;
constexpr float EPS = 1e-6f;
constexpr int NT = 512;
namespace cg = cooperative_groups;

constexpr size_t MiB = 1u << 20;
constexpr size_t WS_CTL = 0;
constexpr size_t WS_MODP = 1 * MiB;
constexpr size_t WS_RSTDV = 8 * MiB;
constexpr size_t WS_IDX = 41 * MiB;
constexpr size_t WS_GATE = 49 * MiB;
constexpr size_t WS_H = 64 * MiB;
constexpr size_t WS_PROJ = 128 * MiB;
constexpr size_t WS_Q = 128 * MiB;
constexpr size_t WS_YMIX = 256 * MiB;
constexpr size_t WS_XC = 320 * MiB;
constexpr size_t WS_A = 384 * MiB;
constexpr size_t WS_BB = 448 * MiB;
constexpr size_t WS_END = 512 * MiB;

typedef unsigned short bf16_t;
struct Params { const float* in[23]; float* out; unsigned char* ws; };
enum { I_X = 0, I_C, I_WADA, I_BADA, I_GMIX, I_WIN, I_CONVW, I_CONVB, I_WGA, I_BGA, I_WGI, I_BGI, I_LAM, I_GV, I_WSP, I_BSP, I_WOUT, I_GFFN, I_WQ, I_SKEY, I_EU, I_EV, I_GFIN };

__device__ __forceinline__ float bf2f(bf16_t v) { return __uint_as_float(((unsigned)v) << 16); }
__device__ __forceinline__ bf16_t f2bf(float f) { unsigned u = __float_as_uint(f); u += 0x7fffu + ((u >> 16) & 1u); return (bf16_t)(u >> 16); }
__device__ __forceinline__ float sigmoidf_(float x) { return 1.f / (1.f + __expf(-x)); }
__device__ __forceinline__ float gelu_t(float x) { const float u = 0.7978845608028654f * (x + 0.044715f * x * x * x); return x * sigmoidf_(2.f * u); }
__device__ __forceinline__ float wave_sum(float v) {
#pragma unroll
    for (int o = 1; o < 64; o <<= 1) v += __shfl_xor(v, o);
    return v;
}
__device__ __forceinline__ float mod_at(const Params& p, int b, int n) {
    const float* mp = (const float*)(p.ws + WS_MODP);
    float s = p.in[I_BADA][n];
#pragma unroll
    for (int kc = 0; kc < 4; ++kc) s += mp[(size_t)(kc * 8 + b) * NMOD + n];
    return s;
}

__device__ void phase_mod(const Params& p, float* lds, int bid, int nb) {
    const int tid = threadIdx.x, lane = tid & 63, wave = tid >> 6;
    const float* c = p.in[I_C]; const float* W = p.in[I_WADA];
    float* modp = (float*)(p.ws + WS_MODP);
    for (int i = tid; i < NB * D; i += NT) { const float v = c[i]; lds[i] = v * sigmoidf_(v); }
    __syncthreads();
    float* red = lds + NB * D;
    for (int item = bid; item < 192; item += nb) {
        const int nt = item % 48, kc = item / 48;
        const int n0 = nt * 256 + lane * 4, k0 = kc * 512 + wave * 64;
        float acc[8][4];
#pragma unroll
        for (int b = 0; b < 8; ++b)
#pragma unroll
            for (int j = 0; j < 4; ++j) acc[b][j] = 0.f;
        for (int kk = 0; kk < 64; ++kk) {
            const float4 w = *(const float4*)(W + (size_t)(k0 + kk) * NMOD + n0);
#pragma unroll
            for (int b = 0; b < 8; ++b) { const float s = lds[b * D + k0 + kk]; acc[b][0] += s * w.x; acc[b][1] += s * w.y; acc[b][2] += s * w.z; acc[b][3] += s * w.w; }
        }
#pragma unroll
        for (int b = 0; b < 8; ++b)
#pragma unroll
            for (int j = 0; j < 4; ++j) red[(wave * 32 + b * 4 + j) * 64 + lane] = acc[b][j];
        __syncthreads();
        for (int o = tid; o < 2048; o += NT) {
            const int b = o >> 8, nn = o & 255, ln = nn >> 2, j = nn & 3;
            float s = 0.f;
#pragma unroll
            for (int w = 0; w < 8; ++w) s += red[(w * 32 + b * 4 + j) * 64 + ln];
            modp[(size_t)(kc * 8 + b) * NMOD + nt * 256 + nn] = s;
        }
        __syncthreads();
    }
}

__device__ void phase_hrows(const Params& p, const float* src, const float* gn, int shift_off, int scale_off, bf16_t* dst, float* lds, int bid, int nb) {
    const int tid = threadIdx.x, lane = tid & 63, wave = tid >> 6;
    float* Aw = lds; float* Bw = lds + D;
    for (int item = bid; item < M / 64; item += nb) {
        const int b = item / (SEQ / 64);
        for (int col = tid; col < D; col += NT) { Aw[col] = gn[col] * (1.f + mod_at(p, b, scale_off + col)); Bw[col] = mod_at(p, b, shift_off + col); }
        __syncthreads();
        for (int r = wave; r < 64; r += 8) {
            const size_t row = (size_t)item * 64 + r;
            float4 v[8]; float ss = 0.f;
#pragma unroll
            for (int j = 0; j < 8; ++j) { v[j] = *(const float4*)(src + row * D + lane * 4 + 256 * j); ss += v[j].x * v[j].x + v[j].y * v[j].y + v[j].z * v[j].z + v[j].w * v[j].w; }
            const float rstd = rsqrtf(wave_sum(ss) * (1.f / D) + EPS);
#pragma unroll
            for (int j = 0; j < 8; ++j) {
                const int col = lane * 4 + 256 * j;
                const float o0 = v[j].x * rstd * Aw[col] + Bw[col], o1 = v[j].y * rstd * Aw[col + 1] + Bw[col + 1];
                const float o2 = v[j].z * rstd * Aw[col + 2] + Bw[col + 2], o3 = v[j].w * rstd * Aw[col + 3] + Bw[col + 3];
                uint2 w; w.x = (unsigned)f2bf(o0) | ((unsigned)f2bf(o1) << 16); w.y = (unsigned)f2bf(o2) | ((unsigned)f2bf(o3) << 16);
                *(uint2*)(dst + row * D + col) = w;
            }
        }
        __syncthreads();
    }
}

template <class Epi>
__device__ void naive_gemm(const bf16_t* A, const float* W, int Mm, int N, int K, const Epi& epi, float* lds, int bid, int nb) {
    const int tid = threadIdx.x, ty = tid >> 4, tx = tid & 15;
    float* As = lds;
    float* Bs = lds + 16 * 132;
    const int ntn = N / 64, ntiles = (Mm / 128) * ntn;
    for (int tile = bid; tile < ntiles; tile += nb) {
        const int tm = tile / ntn, tn = tile % ntn;
        float acc[4][4];
#pragma unroll
        for (int i = 0; i < 4; ++i)
#pragma unroll
            for (int j = 0; j < 4; ++j) acc[i][j] = 0.f;
        for (int k0 = 0; k0 < K; k0 += 16) {
            { const int r = tid >> 2, kq = (tid & 3) * 4;
              const uint2 a = *(const uint2*)(A + (size_t)(tm * 128 + r) * K + k0 + kq);
              As[(kq + 0) * 132 + r] = bf2f((bf16_t)(a.x & 0xffff)); As[(kq + 1) * 132 + r] = bf2f((bf16_t)(a.x >> 16));
              As[(kq + 2) * 132 + r] = bf2f((bf16_t)(a.y & 0xffff)); As[(kq + 3) * 132 + r] = bf2f((bf16_t)(a.y >> 16)); }
            { const int kk = tid >> 5, n2 = (tid & 31) * 2;
              const float2 b = *(const float2*)(W + (size_t)(k0 + kk) * N + tn * 64 + n2);
              Bs[kk * 68 + n2] = b.x; Bs[kk * 68 + n2 + 1] = b.y; }
            __syncthreads();
#pragma unroll
            for (int kk = 0; kk < 16; ++kk) {
                const float4 a = *(const float4*)(As + kk * 132 + ty * 4);
                const float4 b = *(const float4*)(Bs + kk * 68 + tx * 4);
                const float av[4] = {a.x, a.y, a.z, a.w}, bv[4] = {b.x, b.y, b.z, b.w};
#pragma unroll
                for (int i = 0; i < 4; ++i)
#pragma unroll
                    for (int j = 0; j < 4; ++j) acc[i][j] += av[i] * bv[j];
            }
            __syncthreads();
        }
#pragma unroll
        for (int i = 0; i < 4; ++i) epi(tm * 128 + ty * 4 + i, tn * 64 + tx * 4, acc[i]);
    }
}
struct EpiProj {
    bf16_t* proj;
    __device__ __forceinline__ void operator()(int m, int n0, const float (&v)[4]) const {
        const int which = n0 >> 10, cc = n0 & 1023;
        bf16_t* o = proj + (size_t)which * M * 1024 + (size_t)m * 1024 + cc;
#pragma unroll
        for (int j = 0; j < 4; ++j) o[j] = f2bf(which ? gelu_t(v[j]) : v[j]);
    }
};
struct EpiX1 {
    Params p;
    __device__ __forceinline__ void operator()(int m, int n0, const float (&v)[4]) const {
        const int b = m / SEQ;
#pragma unroll
        for (int j = 0; j < 4; ++j) p.out[(size_t)m * D + n0 + j] = p.in[I_X][(size_t)m * D + n0 + j] + mod_at(p, b, 2 * D + n0 + j) * v[j];
    }
};
struct EpiQ {
    bf16_t* q;
    __device__ __forceinline__ void operator()(int m, int n0, const float (&v)[4]) const {
#pragma unroll
        for (int j = 0; j < 4; ++j) q[(size_t)m * D + n0 + j] = f2bf(v[j]);
    }
};

__device__ void phase_conv_naive(const Params& p, int bid, int nb) {
    const bf16_t* xl = (const bf16_t*)(p.ws + WS_PROJ); float* xc = (float*)(p.ws + WS_XC);
    const float* cw = p.in[I_CONVW]; const float* cb = p.in[I_CONVB];
    for (size_t e = (size_t)bid * NT + threadIdx.x; e < (size_t)M * DLRU; e += (size_t)nb * NT) {
        const int c = (int)(e & 1023); const size_t row = e >> 10; const int t = (int)(row % SEQ);
        float s = cb[c];
#pragma unroll
        for (int k = 0; k < 4; ++k) { const int tt = t - 3 + k; if (tt >= 0) s += cw[k * DLRU + c] * bf2f(xl[(row - 3 + k) * 1024 + c]); }
        xc[e] = s;
    }
}
__device__ void phase_gates_naive(const Params& p, int bid, int nb) {
    const float* xc = (const float*)(p.ws + WS_XC); float* av = (float*)(p.ws + WS_A); float* bv = (float*)(p.ws + WS_BB);
    const float* wa = p.in[I_WGA]; const float* wi = p.in[I_WGI];
    for (size_t e = (size_t)bid * NT + threadIdx.x; e < (size_t)M * DLRU; e += (size_t)nb * NT) {
        const int c = (int)(e & 1023); const size_t row = e >> 10; const int hd = c >> 7, j = c & 127;
        float za = p.in[I_BGA][c], zi = p.in[I_BGI][c];
        const float* xr = xc + row * 1024 + hd * 128;
        for (int i = 0; i < 128; ++i) { const float xv = xr[i]; za += xv * wa[(size_t)(hd * 128 + i) * 128 + j]; zi += xv * wi[(size_t)(hd * 128 + i) * 128 + j]; }
        const float r = sigmoidf_(za), ig = sigmoidf_(zi);
        const float lam = p.in[I_LAM][c];
        const float sp = fmaxf(-lam, 0.f) + log1pf(__expf(-fabsf(lam)));
        const float la = -8.f * r * sp;
        const float a = __expf(la);
        av[e] = a; bv[e] = sqrtf(fmaxf(-expm1f(2.f * la), 0.f)) * (ig * xc[e]);
    }
}
__device__ void phase_scan_naive(const Params& p, int bid, int nb) {
    const float* av = (const float*)(p.ws + WS_A); const float* bv = (const float*)(p.ws + WS_BB);
    const bf16_t* yg = (const bf16_t*)(p.ws + WS_PROJ) + (size_t)M * 1024;
    bf16_t* ymix = (bf16_t*)(p.ws + WS_YMIX);
    for (int e = bid * NT + threadIdx.x; e < NB * DLRU; e += nb * NT) {
        const int b = e >> 10, c = e & 1023;
        float h = 0.f;
        for (int t = 0; t < SEQ; ++t) { const size_t row = (size_t)b * SEQ + t; h = av[row * 1024 + c] * h + bv[row * 1024 + c]; ymix[row * D + c] = f2bf(h * bf2f(yg[row * 1024 + c])); }
    }
}
__device__ void phase_rstdv_naive(const Params& p, int bid, int nb) {
    const bf16_t* vg = (const bf16_t*)(p.ws + WS_PROJ) + (size_t)3 * M * 1024; float* rs = (float*)(p.ws + WS_RSTDV);
    const int lane = threadIdx.x & 63, wave = threadIdx.x >> 6;
    for (int row = bid * 8 + wave; row < M; row += nb * 8) {
        float ss = 0.f;
        for (int d = lane; d < 1024; d += 64) { const float v = bf2f(vg[(size_t)row * 1024 + d]); ss += v * v; }
        ss = wave_sum(ss);
        if (lane == 0) rs[row] = rsqrtf(ss * (1.f / 1024.f) + EPS);
    }
}
__device__ void phase_sgu_naive(const Params& p, int bid, int nb) {
    const bf16_t* ug = (const bf16_t*)(p.ws + WS_PROJ) + (size_t)2 * M * 1024; const bf16_t* vg = (const bf16_t*)(p.ws + WS_PROJ) + (size_t)3 * M * 1024;
    const float* rs = (const float*)(p.ws + WS_RSTDV); bf16_t* ymix = (bf16_t*)(p.ws + WS_YMIX);
    const float* ws = p.in[I_WSP]; const float* bs = p.in[I_BSP]; const float* gv = p.in[I_GV];
    for (size_t e = (size_t)bid * NT + threadIdx.x; e < (size_t)M * DSGU; e += (size_t)nb * NT) {
        const int d = (int)(e & 1023); const size_t row = e >> 10; const int g = d >> 7, i = (int)(row & 127); const size_t base = row - i;
        float s = 0.f;
        for (int j = 0; j <= i; ++j) s += ws[(size_t)(g * 128 + i) * 128 + j] * (bf2f(vg[(base + j) * 1024 + d]) * rs[base + j]);
        s = s * gv[d] + bs[g * 128 + i];
        ymix[row * D + 1024 + d] = f2bf(bf2f(ug[row * 1024 + d]) * s);
    }
}

__device__ __forceinline__ void wave_argmax(float& v, int& i) {
#pragma unroll
    for (int off = 32; off >= 1; off >>= 1) { const float ov = __shfl_xor(v, off); const int oi = __shfl_xor(i, off); if (ov > v || (ov == v && oi < i)) { v = ov; i = oi; } }
}
__device__ void phase_topk_naive(const Params& p, int bid, int nb) {
    const bf16_t* Q = (const bf16_t*)(p.ws + WS_Q); const float* keys = p.in[I_SKEY];
    int* idx = (int*)(p.ws + WS_IDX); float* gate = (float*)(p.ws + WS_GATE);
    const int lane = threadIdx.x & 63, wave = threadIdx.x >> 6;
    const float NEG = -3.0e38f;
    for (int task = bid * 8 + wave; task < M * NHEAD; task += nb * 8) {
        const int token = task >> 3, hd = task & 7;
        float tv[2]; int ti[2];
#pragma unroll
        for (int pp = 0; pp < 2; ++pp) {
            const bf16_t* q = Q + (size_t)token * D + hd * 256 + pp * 128;
            const float* k0 = keys + ((size_t)(hd * 2 + pp) * 128 + lane) * 128; const float* k1 = k0 + 64 * 128;
            float s0 = 0.f, s1 = 0.f;
            for (int k = 0; k < 128; k += 4) {
                const uint2 qq = *(const uint2*)(q + k);
                const float q0 = bf2f((bf16_t)(qq.x & 0xffff)), q1 = bf2f((bf16_t)(qq.x >> 16)), q2 = bf2f((bf16_t)(qq.y & 0xffff)), q3 = bf2f((bf16_t)(qq.y >> 16));
                const float4 a = *(const float4*)(k0 + k), b = *(const float4*)(k1 + k);
                s0 += q0 * a.x + q1 * a.y + q2 * a.z + q3 * a.w; s1 += q0 * b.x + q1 * b.y + q2 * b.z + q3 * b.w;
            }
            float myv = NEG; int myi = 0;
            for (int r = 0; r < TOPK; ++r) {
                float v; int i; if (s0 >= s1) { v = s0; i = lane; } else { v = s1; i = lane + 64; }
                wave_argmax(v, i);
                if (i == lane) s0 = NEG; if (i == lane + 64) s1 = NEG;
                if (lane == r) { myv = v; myi = i; }
            }
            tv[pp] = myv; ti[pp] = myi;
        }
        float cv[4];
#pragma unroll
        for (int m = 0; m < 4; ++m) cv[m] = __shfl(tv[0], (lane >> 4) + 4 * m) + __shfl(tv[1], lane & 15);
        float selv = NEG; int selc = 0;
        for (int r = 0; r < TOPK; ++r) {
            float v = cv[0]; int i = lane;
#pragma unroll
            for (int m = 1; m < 4; ++m) if (cv[m] > v) { v = cv[m]; i = lane + 64 * m; }
            wave_argmax(v, i);
#pragma unroll
            for (int m = 0; m < 4; ++m) if (i == lane + 64 * m) cv[m] = NEG;
            if (lane == r) { selv = v; selc = i; }
        }
        const float mx = __shfl(selv, 0);
        const float e = lane < TOPK ? __expf(selv - mx) : 0.f;
        const float sum = wave_sum(e);
        const int i1 = __shfl(ti[0], selc >> 4), i2 = __shfl(ti[1], selc & 15);
        if (lane < TOPK) { idx[(size_t)token * NSEL + hd * TOPK + lane] = i1 * NKEYS + i2; gate[(size_t)token * NSEL + hd * TOPK + lane] = e / sum; }
    }
}

__device__ void phase_peer_naive(const Params& p, int bid, int nb) {
    const bf16_t* H = (const bf16_t*)(p.ws + WS_H); const int* idx = (const int*)(p.ws + WS_IDX); const float* gate = (const float*)(p.ws + WS_GATE);
    const float* EU = p.in[I_EU]; const float* EV = p.in[I_EV]; const float* gf = p.in[I_GFIN];
    const int lane = threadIdx.x & 63, wave = threadIdx.x >> 6;
    for (int token = bid * 8 + wave; token < M; token += nb * 8) {
        float hv[32], acc[32];
#pragma unroll
        for (int j = 0; j < 8; ++j) { const uint2 w = *(const uint2*)(H + (size_t)token * D + lane * 4 + 256 * j);
            hv[4 * j] = bf2f((bf16_t)(w.x & 0xffff)); hv[4 * j + 1] = bf2f((bf16_t)(w.x >> 16)); hv[4 * j + 2] = bf2f((bf16_t)(w.y & 0xffff)); hv[4 * j + 3] = bf2f((bf16_t)(w.y >> 16)); }
#pragma unroll
        for (int j = 0; j < 32; ++j) acc[j] = 0.f;
        for (int s = 0; s < NSEL; ++s) {
            const int e = idx[(size_t)token * NSEL + s]; const float g = gate[(size_t)token * NSEL + s];
            const float* u = EU + (size_t)e * D + lane * 4; const float* v = EV + (size_t)e * D + lane * 4;
            float dot = 0.f;
#pragma unroll
            for (int j = 0; j < 8; ++j) { const float4 w = *(const float4*)(u + 256 * j); dot += hv[4 * j] * w.x + hv[4 * j + 1] * w.y + hv[4 * j + 2] * w.z + hv[4 * j + 3] * w.w; }
            dot = wave_sum(dot);
            const float act = gelu_t(dot) * g;
#pragma unroll
            for (int j = 0; j < 8; ++j) { const float4 w = *(const float4*)(v + 256 * j); acc[4 * j] += act * w.x; acc[4 * j + 1] += act * w.y; acc[4 * j + 2] += act * w.z; acc[4 * j + 3] += act * w.w; }
        }
        const int b = token / SEQ;
        float ss = 0.f;
#pragma unroll
        for (int j = 0; j < 8; ++j) {
            const int col = lane * 4 + 256 * j;
            const float4 x1 = *(const float4*)(p.out + (size_t)token * D + col);
            acc[4 * j] = x1.x + mod_at(p, b, 5 * D + col) * acc[4 * j]; acc[4 * j + 1] = x1.y + mod_at(p, b, 5 * D + col + 1) * acc[4 * j + 1];
            acc[4 * j + 2] = x1.z + mod_at(p, b, 5 * D + col + 2) * acc[4 * j + 2]; acc[4 * j + 3] = x1.w + mod_at(p, b, 5 * D + col + 3) * acc[4 * j + 3];
            ss += acc[4 * j] * acc[4 * j] + acc[4 * j + 1] * acc[4 * j + 1] + acc[4 * j + 2] * acc[4 * j + 2] + acc[4 * j + 3] * acc[4 * j + 3];
        }
        const float rstd = rsqrtf(wave_sum(ss) * (1.f / D) + EPS);
#pragma unroll
        for (int j = 0; j < 8; ++j) {
            const int col = lane * 4 + 256 * j;
            const float4 g4 = *(const float4*)(gf + col);
            float4 o; o.x = acc[4 * j] * rstd * g4.x; o.y = acc[4 * j + 1] * rstd * g4.y; o.z = acc[4 * j + 2] * rstd * g4.z; o.w = acc[4 * j + 3] * rstd * g4.w;
            *(float4*)(p.out + (size_t)token * D + col) = o;
        }
    }
}

extern __shared__ __attribute__((aligned(16))) unsigned char dyn_lds[];
constexpr int LDS_BYTES = 147456;
__global__ void __launch_bounds__(NT) fwd_megakernel(Params p) {
    cg::grid_group grid = cg::this_grid();
    float* lds = (float*)dyn_lds;
    const int bid = blockIdx.x, nb = gridDim.x;
    phase_mod(p, lds, bid, nb);
    grid.sync();
    phase_hrows(p, p.in[I_X], p.in[I_GMIX], 0, D, (bf16_t*)(p.ws + WS_H), lds, bid, nb);
    grid.sync();
    { EpiProj e{(bf16_t*)(p.ws + WS_PROJ)}; naive_gemm((const bf16_t*)(p.ws + WS_H), p.in[I_WIN], M, NPROJ, D, e, lds, bid, nb); }
    grid.sync();
    phase_conv_naive(p, bid, nb);
    phase_rstdv_naive(p, bid, nb);
    grid.sync();
    phase_gates_naive(p, bid, nb);
    phase_sgu_naive(p, bid, nb);
    grid.sync();
    phase_scan_naive(p, bid, nb);
    grid.sync();
    { EpiX1 e{p}; naive_gemm((const bf16_t*)(p.ws + WS_YMIX), p.in[I_WOUT], M, D, D, e, lds, bid, nb); }
    grid.sync();
    phase_hrows(p, p.out, p.in[I_GFFN], 3 * D, 4 * D, (bf16_t*)(p.ws + WS_H), lds, bid, nb);
    grid.sync();
    { EpiQ e{(bf16_t*)(p.ws + WS_Q)}; naive_gemm((const bf16_t*)(p.ws + WS_H), p.in[I_WQ], M, D, D, e, lds, bid, nb); }
    grid.sync();
    phase_topk_naive(p, bid, nb);
    grid.sync();
    phase_peer_naive(p, bid, nb);
}

extern "C" void kernel_launch(void* const* d_in, const int* in_sizes, int n_in, void* d_out, int out_size, void* d_ws, size_t ws_size, hipStream_t stream) {
    static int grid_blocks = 0;
    if (grid_blocks == 0) {
        if (n_in != 23 || in_sizes[0] != M * D || out_size != M * D || ws_size < WS_END) { fprintf(stderr, "kernel_launch: unexpected shapes (n_in %d in0 %d out %d ws %zu)\n", n_in, n_in > 0 ? in_sizes[0] : -1, out_size, ws_size); grid_blocks = -1; return; }
        if (hipFuncSetAttribute((const void*)fwd_megakernel, hipFuncAttributeMaxDynamicSharedMemorySize, LDS_BYTES) != hipSuccess) { fprintf(stderr, "hipFuncSetAttribute failed\n"); grid_blocks = -1; return; }
        int dev = 0, cus = 0, per_cu = 0;
        hipGetDevice(&dev);
        hipDeviceGetAttribute(&cus, hipDeviceAttributeMultiprocessorCount, dev);
        if (hipOccupancyMaxActiveBlocksPerMultiprocessor(&per_cu, (const void*)fwd_megakernel, NT, LDS_BYTES) != hipSuccess || per_cu < 1) { fprintf(stderr, "occupancy query failed (%d)\n", per_cu); grid_blocks = -1; return; }
        grid_blocks = cus;
    }
    if (grid_blocks < 0) return;
    Params p{};
    for (int i = 0; i < 23; ++i) p.in[i] = (const float*)d_in[i];
    p.out = (float*)d_out; p.ws = (unsigned char*)d_ws;
    void* args[] = {&p};
    hipError_t e = hipLaunchCooperativeKernel((const void*)fwd_megakernel, dim3(grid_blocks), dim3(NT), args, LDS_BYTES, stream);
    if (e != hipSuccess) fprintf(stderr, "cooperative launch failed: %s (grid %d)\n", hipGetErrorString(e), grid_blocks);
}
```

```cpp
#include <hip/hip_runtime.h>
#include <hip/hip_cooperative_groups.h>
#include <cstdio>
#include <cstdint>

constexpr int D = 2048, NB = 8, SEQ = 2048, M = NB * SEQ;
constexpr int DLRU = 1024, DSGU = 1024, NPROJ = 4096;
constexpr int NMOD = 6 * D;
constexpr int NHEAD = 8, NKEYS = 128, TOPK = 16, NSEL = NHEAD * TOPK;
constexpr float EPS = 1e-6f;
constexpr int NT = 512;
namespace cg = cooperative_groups;

constexpr size_t MiB = 1u << 20;
constexpr size_t WS_CTL = 0;
constexpr size_t WS_MODP = 1 * MiB;
constexpr size_t WS_WGA_T = 3 * MiB;
constexpr size_t WS_WGI_T = 3 * MiB + 262144;
constexpr size_t WS_WSPB = 3 * MiB + 524288;
constexpr size_t WS_SKEYB = 3 * MiB + 786432;
constexpr size_t WS_SSQV = 5 * MiB;
constexpr size_t WS_RSTDV = 8 * MiB;
constexpr size_t WS_WIN_T = 9 * MiB;
constexpr size_t WS_WOUT_T = 25 * MiB;
constexpr size_t WS_WQ_T = 33 * MiB;
constexpr size_t WS_IDX = 41 * MiB;
constexpr size_t WS_GATE = 49 * MiB;
constexpr size_t WS_H = 64 * MiB;
constexpr size_t WS_PROJ = 128 * MiB;
constexpr size_t WS_Q = 128 * MiB;
constexpr size_t WS_YMIX = 256 * MiB;
constexpr size_t WS_EU16 = 320 * MiB;
constexpr size_t WS_EV16 = 384 * MiB;
constexpr size_t WS_XC = 320 * MiB;
constexpr size_t WS_A = 384 * MiB;
constexpr size_t WS_BB = 448 * MiB;
constexpr size_t WS_END = 512 * MiB;

typedef unsigned short bf16_t;
struct Params { const float* in[23]; float* out; unsigned char* ws; };
typedef const __attribute__((address_space(4))) Params* KP;
enum { I_X = 0, I_C, I_WADA, I_BADA, I_GMIX, I_WIN, I_CONVW, I_CONVB, I_WGA, I_BGA, I_WGI, I_BGI, I_LAM, I_GV, I_WSP, I_BSP, I_WOUT, I_GFFN, I_WQ, I_SKEY, I_EU, I_EV, I_GFIN };

__device__ __forceinline__ float bf2f(bf16_t v) { return __uint_as_float(((unsigned)v) << 16); }
__device__ __forceinline__ bf16_t f2bf(float f) { unsigned u = __float_as_uint(f); u += 0x7fffu + ((u >> 16) & 1u); return (bf16_t)(u >> 16); }
__device__ __forceinline__ float sigmoidf_(float x) { return 1.f / (1.f + __expf(-x)); }
__device__ __forceinline__ float gelu_t(float x) { const float u = 0.7978845608028654f * (x + 0.044715f * x * x * x); return x * sigmoidf_(2.f * u); }
__device__ __forceinline__ float wave_sum(float v) {
#pragma unroll
    for (int o = 1; o < 64; o <<= 1) v += __shfl_xor(v, o);
    return v;
}
__device__ __forceinline__ float mod_at(KP p, int b, int n) {
    const float* mp = (const float*)(p->ws + WS_MODP);
    float s = p->in[I_BADA][n];
#pragma unroll
    for (int kc = 0; kc < 4; ++kc) s += mp[(size_t)(kc * 8 + b) * NMOD + n];
    return s;
}

__device__ __forceinline__ void phase_mod(KP p, float* lds, int bid, int nb) {
    const int tid = threadIdx.x, lane = tid & 63, wave = tid >> 6;
    const float* c = p->in[I_C]; const float* W = p->in[I_WADA];
    float* modp = (float*)(p->ws + WS_MODP);
    for (int i = tid; i < NB * D; i += NT) { const float v = c[i]; lds[i] = v * sigmoidf_(v); }
    __syncthreads();
    float* red = lds + NB * D;
    for (int item = bid; item < 192; item += nb) {
        const int nt = item % 48, kc = item / 48;
        const int n0 = nt * 256 + lane * 4, k0 = kc * 512 + wave * 64;
        float acc[8][4];
#pragma unroll
        for (int b = 0; b < 8; ++b)
#pragma unroll
            for (int j = 0; j < 4; ++j) acc[b][j] = 0.f;
        for (int kk = 0; kk < 64; ++kk) {
            const float4 w = *(const float4*)(W + (size_t)(k0 + kk) * NMOD + n0);
#pragma unroll
            for (int b = 0; b < 8; ++b) { const float s = lds[b * D + k0 + kk]; acc[b][0] += s * w.x; acc[b][1] += s * w.y; acc[b][2] += s * w.z; acc[b][3] += s * w.w; }
        }
#pragma unroll
        for (int b = 0; b < 8; ++b)
#pragma unroll
            for (int j = 0; j < 4; ++j) red[(wave * 32 + b * 4 + j) * 64 + lane] = acc[b][j];
        __syncthreads();
        for (int o = tid; o < 2048; o += NT) {
            const int b = o >> 8, nn = o & 255, ln = nn >> 2, j = nn & 3;
            float s = 0.f;
#pragma unroll
            for (int w = 0; w < 8; ++w) s += red[(w * 32 + b * 4 + j) * 64 + ln];
            modp[(size_t)(kc * 8 + b) * NMOD + nt * 256 + nn] = s;
        }
        __syncthreads();
    }
}

__device__ __forceinline__ void phase_hrows(KP p, const float* src, const float* gn, int shift_off, int scale_off, bf16_t* dst, float* lds, int bid, int nb) {
    const int tid = threadIdx.x, lane = tid & 63, wave = tid >> 6;
    float* Aw = lds; float* Bw = lds + D;
    for (int item = bid; item < M / 64; item += nb) {
        const int b = item / (SEQ / 64);
        for (int col = tid; col < D; col += NT) { Aw[col] = gn[col] * (1.f + mod_at(p, b, scale_off + col)); Bw[col] = mod_at(p, b, shift_off + col); }
        __syncthreads();
        for (int r = wave; r < 64; r += 8) {
            const size_t row = (size_t)item * 64 + r;
            float4 v[8]; float ss = 0.f;
#pragma unroll
            for (int j = 0; j < 8; ++j) { v[j] = *(const float4*)(src + row * D + lane * 4 + 256 * j); ss += v[j].x * v[j].x + v[j].y * v[j].y + v[j].z * v[j].z + v[j].w * v[j].w; }
            const float rstd = rsqrtf(wave_sum(ss) * (1.f / D) + EPS);
#pragma unroll
            for (int j = 0; j < 8; ++j) {
                const int col = lane * 4 + 256 * j;
                const float o0 = v[j].x * rstd * Aw[col] + Bw[col], o1 = v[j].y * rstd * Aw[col + 1] + Bw[col + 1];
                const float o2 = v[j].z * rstd * Aw[col + 2] + Bw[col + 2], o3 = v[j].w * rstd * Aw[col + 3] + Bw[col + 3];
                uint2 w; w.x = (unsigned)f2bf(o0) | ((unsigned)f2bf(o1) << 16); w.y = (unsigned)f2bf(o2) | ((unsigned)f2bf(o3) << 16);
                *(uint2*)(dst + row * D + col) = w;
            }
        }
        __syncthreads();
    }
}

namespace pg8 {
#define PG8_LAS __attribute__((address_space(3)))
typedef unsigned short bf16_t;
typedef short bf16x8 __attribute__((ext_vector_type(8)));
typedef float f32x4 __attribute__((ext_vector_type(4)));
typedef unsigned u32x4 __attribute__((ext_vector_type(4)));
constexpr int BM = 256, BK = 64, HALF = 128, HTB = HALF * BK * 2  , STAGE_BYTES = 8 * HTB, NXCD = 8, WGM = 8;

__host__ __device__ __forceinline__ int lds_byte(int r, int c) { const int st = (r >> 4) * 2 + (c >> 5), rr = r & 15, cc = c & 31, ob = rr * 64 + cc * 2; return st * 1024 + (ob ^ (((ob >> 9) & 1) << 5)); }
__host__ __device__ __forceinline__ void stage_rc(int b, int& R, int& C) { const int st = b / 1024, sb = b % 1024, swz = sb ^ (((sb >> 9) & 1) << 5); R = (st >> 1) * 16 + swz / 64; C = (st & 1) * 32 + (swz % 64) / 2; }
__host__ __device__ __forceinline__ int perm32(int rho) { const int n = rho >> 4, i = rho & 15; return 8 * (i >> 2) + 4 * n + (i & 3); }

struct Unit { int pm, pn; };
struct Gemm { const bf16_t* A; const bf16_t* Bt; int M, N, K; };

struct StaticOrder {
    int nM, nN, nwg, G, c;
    __host__ __device__ void init(int M, int N, int G_, int c_) { nM = M / BM; nN = N / BM; nwg = nM * nN; G = G_; c = c_; }
    __host__ __device__ bool next(int i, Unit& u) const {
        const long L = (long)i * G + c; if (L >= nwg) return false;
        int wgid = (int)L; { const int q = nwg / NXCD, r = nwg % NXCD, xcd = wgid % NXCD, off = wgid / NXCD; wgid = (xcd < r ? xcd * (q + 1) : r * (q + 1) + (xcd - r) * q) + off; }
        const int nig = WGM * nN, gid = wgid / nig, fm = gid * WGM, gsz = (nM - fm) < WGM ? (nM - fm) : WGM;
        u.pm = fm + ((wgid % nig) % gsz); u.pn = (wgid % nig) / gsz; return true;
    }
    __device__ __forceinline__ void a_ready(const Unit&) const {}
    __device__ __forceinline__ void done(const Unit&) const {}
};


__device__ __forceinline__ unsigned cvt_pk_bf16(float lo, float hi) { unsigned r; asm volatile("v_cvt_pk_bf16_f32 %0, %1, %2" : "=v"(r) : "v"(lo), "v"(hi)); return r; }
__device__ __forceinline__ float gelu_tanh(float x) { const float u = 1.5957691216057308f * (x + 0.044715f * x * x * x); return x * __builtin_amdgcn_rcpf(1.f + __expf(-u)); }
struct EpiProj {
    static constexpr bool PERM = true, AFTER_DRAIN = false;
    bf16_t* proj; float* ssqv; int Mrows;
    __device__ __forceinline__ void operator()(const f32x4 (&acc)[2][2][4][2], const Unit& u, int wr, int wc, int fr, int fq) const {
        const int which = (u.pn * BM) >> 10, colt = (u.pn * BM) & 1023;
        bf16_t* base = proj + (size_t)which * Mrows * 1024;
        const int row0 = u.pm * BM + wr * 64 + fr, col0 = colt + wc * 32 + 8 * fq;
#pragma unroll
        for (int ai = 0; ai < 2; ++ai)
#pragma unroll
            for (int m = 0; m < 4; ++m) { const int row = row0 + ai * HALF + m * 16; bf16_t* rowp = base + (size_t)row * 1024 + col0; float ss = 0.f;
#pragma unroll
                for (int bj = 0; bj < 2; ++bj) { f32x4 v0 = acc[ai][bj][m][0], v1 = acc[ai][bj][m][1];
                    if (which) {
#pragma unroll
                        for (int j = 0; j < 4; ++j) { v0[j] = gelu_tanh(v0[j]); v1[j] = gelu_tanh(v1[j]); } }
                    ss += (v0[0] * v0[0] + v0[1] * v0[1]) + (v0[2] * v0[2] + v0[3] * v0[3]) + (v1[0] * v1[0] + v1[1] * v1[1]) + (v1[2] * v1[2] + v1[3] * v1[3]);
                    u32x4 w; w.x = cvt_pk_bf16(v0[0], v0[1]); w.y = cvt_pk_bf16(v0[2], v0[3]); w.z = cvt_pk_bf16(v1[0], v1[1]); w.w = cvt_pk_bf16(v1[2], v1[3]);
                    *(u32x4*)(rowp + bj * HALF) = w; }
                if (which == 3) { ss += __shfl_xor(ss, 16); ss += __shfl_xor(ss, 32); if (fq == 0) ssqv[(size_t)row * 16 + (u.pn & 3) * 4 + wc] = ss; } }
    }
};
struct EpiX1 {
    static constexpr bool PERM = false, AFTER_DRAIN = false;
    const float* x; float* out; const float* modp; const float* bada; int goff, nmod, seq;
    __device__ __forceinline__ void operator()(const f32x4 (&acc)[2][2][4][2], const Unit& u, int wr, int wc, int fr, int fq) const {
        const int row0 = u.pm * BM + wr * 64 + fr, col0 = u.pn * BM + wc * 32 + 4 * fq, b = (u.pm * BM) / seq;
        f32x4 gv[2][2];
#pragma unroll
        for (int bj = 0; bj < 2; ++bj)
#pragma unroll
            for (int n = 0; n < 2; ++n) { const int c = goff + col0 + bj * HALF + n * 16; f32x4 g = *(const f32x4*)(bada + c);
#pragma unroll
                for (int kc = 0; kc < 4; ++kc) g += *(const f32x4*)(modp + (size_t)(kc * 8 + b) * nmod + c);
                gv[bj][n] = g; }
#pragma unroll
        for (int ai = 0; ai < 2; ++ai)
#pragma unroll
            for (int m = 0; m < 4; ++m) { const size_t off = (size_t)(row0 + ai * HALF + m * 16) * (size_t)(2048) + col0;
#pragma unroll
                for (int bj = 0; bj < 2; ++bj)
#pragma unroll
                    for (int n = 0; n < 2; ++n) { const f32x4 xv = *(const f32x4*)(x + off + bj * HALF + n * 16); *(f32x4*)(out + off + bj * HALF + n * 16) = xv + gv[bj][n] * acc[ai][bj][m][n]; } }
    }
};
struct EpiQ {
    static constexpr bool PERM = true, AFTER_DRAIN = false;
    bf16_t* O; int ldc;
    __device__ __forceinline__ void operator()(const f32x4 (&acc)[2][2][4][2], const Unit& u, int wr, int wc, int fr, int fq) const {
        const int row0 = u.pm * BM + wr * 64 + fr, col0 = u.pn * BM + wc * 32 + 8 * fq;
#pragma unroll
        for (int ai = 0; ai < 2; ++ai)
#pragma unroll
            for (int m = 0; m < 4; ++m) { bf16_t* rowp = O + (size_t)(row0 + ai * HALF + m * 16) * ldc + col0;
#pragma unroll
                for (int bj = 0; bj < 2; ++bj) { const f32x4 v0 = acc[ai][bj][m][0], v1 = acc[ai][bj][m][1];
                    u32x4 w; w.x = cvt_pk_bf16(v0[0], v0[1]); w.y = cvt_pk_bf16(v0[2], v0[3]); w.z = cvt_pk_bf16(v1[0], v1[1]); w.w = cvt_pk_bf16(v1[2], v1[3]);
                    *(u32x4*)(rowp + bj * HALF) = w; } }
    }
};

template <class Epi, class Sched, bool ALIGN_EPI = false, bool SP2 = false>
__device__ __forceinline__ void gemm_phase(PG8_LAS unsigned char* lds, const Gemm g, const Sched& S, const Epi& E) {
    const int tid = threadIdx.x, wid = __builtin_amdgcn_readfirstlane(tid >> 6), lane = tid & 63, wr = wid >> 2, wc = wid & 3, fr = lane & 15, fq = lane >> 4;
    const int K = g.K, nt = K / BK;
    unsigned voffA[2], voffB[2];
#pragma unroll
    for (int i = 0; i < 2; ++i) { int R, C; stage_rc(tid * 16 + i * 8192, R, C); const int Rb = Epi::PERM ? ((R & ~31) + perm32(R & 31)) : R;
        voffA[i] = (unsigned)(R * K + C) * 2u; voffB[i] = (unsigned)(Rb * K + C) * 2u; }
    const size_t kstep = (size_t)(BK * 2);
    const size_t hstep = (size_t)HALF * K * 2;
    const size_t tstep = 2 * hstep;
    const unsigned ldsw = (unsigned)wid * 1024u;
    const int aoff = lds_byte(wr * 64 + fr, fq * 8), boff = lds_byte(wc * 32 + fr, fq * 8);
#define PG8_SA(b, h) (((b) * 2 + (h)) * HTB)
#define PG8_SB(b, h) ((4 + (b) * 2 + (h)) * HTB)
#define PG8_STAGE(bufoff, gbase, voff) do { _Pragma("unroll") for (int _i = 0; _i < 2; ++_i) \
        __builtin_amdgcn_global_load_lds((const unsigned*)((const char*)(gbase) + (voff)[_i]), (PG8_LAS unsigned*)(lds + (bufoff) + ldsw + _i * 8192), 16, 0, 0); } while (0)
#define PG8_LDA(dst, b, h) do { _Pragma("unroll") for (int m = 0; m < 4; ++m) _Pragma("unroll") for (int k = 0; k < 2; ++k) dst[m][k] = *(const PG8_LAS bf16x8*)(lds + PG8_SA(b, h) + aoff + m * 2048 + k * 1024); } while (0)
#define PG8_LDB(dst, b, h) do { _Pragma("unroll") for (int n = 0; n < 2; ++n) _Pragma("unroll") for (int k = 0; k < 2; ++k) dst[n][k] = *(const PG8_LAS bf16x8*)(lds + PG8_SB(b, h) + boff + n * 2048 + k * 1024); } while (0)
#define PG8_MMA(ai, bj, At, Bt) do { __builtin_amdgcn_s_setprio(1); _Pragma("unroll") for (int m = 0; m < 4; ++m) _Pragma("unroll") for (int n = 0; n < 2; ++n) _Pragma("unroll") for (int k = 0; k < 2; ++k) \
        acc[ai][bj][m][n] = __builtin_amdgcn_mfma_f32_16x16x32_bf16(Bt[n][k], At[m][k], acc[ai][bj][m][n], 0, 0, 0); __builtin_amdgcn_s_setprio(0); } while (0)
#define PG8_WAIT_V(n) asm volatile("s_waitcnt vmcnt(" #n ")" ::: "memory")
#define PG8_WAIT_L(n) asm volatile("s_waitcnt lgkmcnt(" #n ")" ::: "memory")
#define PG8_BAR __builtin_amdgcn_s_barrier()
#define PG8_SCHED __builtin_amdgcn_sched_barrier(0)
    Unit cur, nxt; int ui = 0;
    if (!S.next(0, cur)) return;
    f32x4 acc[2][2][4][2];
#pragma unroll
    for (int a = 0; a < 2; ++a)
#pragma unroll
        for (int b = 0; b < 2; ++b)
#pragma unroll
            for (int m = 0; m < 4; ++m)
#pragma unroll
                for (int n = 0; n < 2; ++n) acc[a][b][m][n] = (f32x4){0.f, 0.f, 0.f, 0.f};
    bf16x8 At[4][2], B0[2][2], B1[2][2];
    const char* cA = (const char*)g.A + (size_t)cur.pm * tstep; const char* cB = (const char*)g.Bt + (size_t)cur.pn * tstep;
    S.a_ready(cur);
    if constexpr (SP2) {
        PG8_STAGE(PG8_SB(0, 0), cB, voffB); PG8_STAGE(PG8_SB(0, 1), cB + hstep, voffB); PG8_STAGE(PG8_SA(0, 0), cA, voffA); PG8_STAGE(PG8_SA(0, 1), cA + hstep, voffA);
        if (wr == 1) PG8_BAR;
        PG8_WAIT_V(2); PG8_BAR;
        PG8_STAGE(PG8_SB(1, 0), cB + kstep, voffB); PG8_STAGE(PG8_SA(1, 0), cA + kstep, voffA); PG8_STAGE(PG8_SB(1, 1), cB + hstep + kstep, voffB);
        PG8_WAIT_V(6); PG8_BAR;
    } else {
        PG8_STAGE(PG8_SB(0, 0), cB, voffB); PG8_STAGE(PG8_SA(0, 0), cA, voffA); PG8_STAGE(PG8_SB(0, 1), cB + hstep, voffB); PG8_STAGE(PG8_SA(0, 1), cA + hstep, voffA);
        if (wr == 1) PG8_BAR;
        PG8_WAIT_V(4); PG8_BAR;
        PG8_STAGE(PG8_SB(1, 0), cB + kstep, voffB); PG8_STAGE(PG8_SA(1, 0), cA + kstep, voffA); PG8_STAGE(PG8_SB(1, 1), cB + hstep + kstep, voffB);
        PG8_WAIT_V(6); PG8_BAR;
    }
    for (;;) {
        const bool has_next = S.next(ui + 1, nxt);
        const char* nA = has_next ? (const char*)g.A + (size_t)nxt.pm * tstep : cA; const char* nB = has_next ? (const char*)g.Bt + (size_t)nxt.pn * tstep : cB;
        for (int t = 0; t < nt; t += 2) {
            const bool last = (t == nt - 2);
            const char* a1 = cA + (size_t)(t + 1) * kstep;
            const char* a2 = last ? nA : cA + (size_t)(t + 2) * kstep; const char* b2 = last ? nB : cB + (size_t)(t + 2) * kstep;
            const char* a3 = a2 + kstep; const char* b3 = b2 + kstep;
            if (last && has_next) S.a_ready(nxt);
            if constexpr (SP2) {
            PG8_LDB(B0, 0, 0); PG8_LDB(B1, 0, 1); PG8_SCHED; PG8_LDA(At, 0, 0); PG8_STAGE(PG8_SA(1, 1), a1 + hstep, voffA);
            PG8_WAIT_V(8); PG8_WAIT_L(0); PG8_BAR; PG8_MMA(0, 0, At, B0); PG8_MMA(0, 1, At, B1); PG8_BAR; PG8_SCHED;
            PG8_LDA(At, 0, 1); PG8_STAGE(PG8_SB(0, 0), b2, voffB); PG8_STAGE(PG8_SB(0, 1), b2 + hstep, voffB); PG8_STAGE(PG8_SA(0, 0), a2, voffA);
            PG8_WAIT_V(8); PG8_WAIT_L(0); PG8_BAR; PG8_MMA(1, 0, At, B0); PG8_MMA(1, 1, At, B1); PG8_BAR; PG8_SCHED;
            PG8_LDB(B0, 1, 0); PG8_LDB(B1, 1, 1); PG8_SCHED; PG8_LDA(At, 1, 0); PG8_STAGE(PG8_SA(0, 1), a2 + hstep, voffA);
            PG8_WAIT_V(8); PG8_WAIT_L(0); PG8_BAR; PG8_MMA(0, 0, At, B0); PG8_MMA(0, 1, At, B1); PG8_BAR; PG8_SCHED;
            PG8_LDA(At, 1, 1); PG8_STAGE(PG8_SB(1, 0), b3, voffB); PG8_STAGE(PG8_SB(1, 1), b3 + hstep, voffB); PG8_STAGE(PG8_SA(1, 0), a3, voffA);
            PG8_WAIT_V(8); PG8_WAIT_L(0); PG8_BAR; PG8_MMA(1, 0, At, B0); PG8_MMA(1, 1, At, B1); PG8_BAR; PG8_SCHED;
            } else {
            PG8_LDB(B0, 0, 0); PG8_SCHED; PG8_LDA(At, 0, 0); PG8_STAGE(PG8_SA(1, 1), a1 + hstep, voffA);
            PG8_WAIT_L(8); PG8_BAR; PG8_WAIT_L(0); PG8_MMA(0, 0, At, B0); PG8_BAR; PG8_SCHED;
            PG8_LDB(B1, 0, 1); PG8_STAGE(PG8_SB(0, 0), b2, voffB);
            PG8_BAR; PG8_WAIT_L(0); PG8_MMA(0, 1, At, B1); PG8_BAR;
            PG8_LDA(At, 0, 1); PG8_STAGE(PG8_SA(0, 0), a2, voffA);
            PG8_BAR; PG8_WAIT_L(0); PG8_MMA(1, 0, At, B0); PG8_BAR; PG8_SCHED;
            PG8_STAGE(PG8_SB(0, 1), b2 + hstep, voffB);
            PG8_WAIT_V(6); PG8_BAR; PG8_MMA(1, 1, At, B1); PG8_BAR;
            PG8_LDB(B0, 1, 0); PG8_SCHED; PG8_LDA(At, 1, 0); PG8_STAGE(PG8_SA(0, 1), a2 + hstep, voffA);
            PG8_WAIT_L(8); PG8_BAR; PG8_WAIT_L(0); PG8_MMA(0, 0, At, B0); PG8_BAR; PG8_SCHED;
            PG8_LDB(B1, 1, 1); PG8_STAGE(PG8_SB(1, 0), b3, voffB);
            PG8_BAR; PG8_WAIT_L(0); PG8_MMA(0, 1, At, B1); PG8_BAR;
            PG8_LDA(At, 1, 1); PG8_STAGE(PG8_SA(1, 0), a3, voffA);
            PG8_BAR; PG8_WAIT_L(0); PG8_MMA(1, 0, At, B0); PG8_BAR; PG8_SCHED;
            PG8_STAGE(PG8_SB(1, 1), b3 + hstep, voffB);
            PG8_WAIT_V(6); PG8_BAR; PG8_MMA(1, 1, At, B1); PG8_BAR;
            }
        }
        if constexpr (ALIGN_EPI) { if (wr == 0) PG8_BAR; }
        if constexpr (!Epi::AFTER_DRAIN) { E(acc, cur, wr, wc, fr, fq); S.done(cur); }
        if (!has_next) break;
#pragma unroll
        for (int a = 0; a < 2; ++a)
#pragma unroll
            for (int b = 0; b < 2; ++b)
#pragma unroll
                for (int m = 0; m < 4; ++m)
#pragma unroll
                    for (int n = 0; n < 2; ++n) acc[a][b][m][n] = (f32x4){0.f, 0.f, 0.f, 0.f};
        cur = nxt; cA = nA; cB = nB; ++ui;
        if constexpr (ALIGN_EPI) { if (wr == 1) PG8_BAR; }
    }
    PG8_WAIT_V(0);
    if constexpr (!ALIGN_EPI) { if (wr == 0) PG8_BAR; }
    PG8_BAR;
    if constexpr (Epi::AFTER_DRAIN) { E.fused(acc, cur, wr, wc, fr, fq, lds, wid, lane); S.done(cur); }
#undef PG8_SA
#undef PG8_SB
#undef PG8_STAGE
#undef PG8_LDA
#undef PG8_LDB
#undef PG8_MMA
#undef PG8_WAIT_V
#undef PG8_WAIT_L
#undef PG8_BAR
#undef PG8_SCHED
}
}

#define LAS __attribute__((address_space(3)))
__device__ __forceinline__ unsigned pk2(float lo, float hi) { return (unsigned)f2bf(lo) | ((unsigned)f2bf(hi) << 16); }
__device__ __forceinline__ void transpose_item(const float* W, int K, int N, bf16_t* WT, float* scr, int item, int lane) {
    const int nblk = N / 32, kb = item / nblk, nbk = item % nblk, k0 = 64 * kb, n0 = 32 * nbk;
#pragma unroll 8
    for (int i = 0; i < 32; ++i) { const int kk = 2 * i + (lane >> 5); scr[kk * 33 + (lane & 31)] = W[(size_t)(k0 + kk) * N + n0 + (lane & 31)]; }
    asm volatile("s_waitcnt lgkmcnt(0)" ::: "memory");
    const int c = lane & 7;
#pragma unroll
    for (int j = 0; j < 4; ++j) { const int n = (lane >> 3) + 8 * j; const float* s = scr + (8 * c) * 33 + n;
        uint4 o; o.x = pk2(s[0 * 33], s[1 * 33]); o.y = pk2(s[2 * 33], s[3 * 33]); o.z = pk2(s[4 * 33], s[5 * 33]); o.w = pk2(s[6 * 33], s[7 * 33]);
        *(uint4*)(WT + (size_t)(n0 + n) * K + k0 + 8 * c) = o; }
    asm volatile("s_waitcnt lgkmcnt(0)" ::: "memory");
}
__device__ __forceinline__ void phase_convert_weights(KP p, float* lds, int bid, int nb) {
    const int tid = threadIdx.x, lane = tid & 63, wave = tid >> 6;
    float* scr = lds + wave * (64 * 33);
    const int gw = bid * 8 + wave, ngw = nb * 8;
    constexpr int I_IN = (D / 64) * (NPROJ / 32), I_SQ = (D / 64) * (D / 32), I_G = 8 * (128 / 64) * (128 / 32);
    constexpr int NITEMS = I_IN + 2 * I_SQ + 2 * I_G;
    for (int it = gw; it < NITEMS; it += ngw) {
        int r = it;
        if (r < I_IN) { transpose_item(p->in[I_WIN], D, NPROJ, (bf16_t*)(p->ws + WS_WIN_T), scr, r, lane); continue; } r -= I_IN;
        if (r < I_SQ) { transpose_item(p->in[I_WOUT], D, D, (bf16_t*)(p->ws + WS_WOUT_T), scr, r, lane); continue; } r -= I_SQ;
        if (r < I_SQ) { transpose_item(p->in[I_WQ], D, D, (bf16_t*)(p->ws + WS_WQ_T), scr, r, lane); continue; } r -= I_SQ;
        if (r < I_G) { const int hd = r / 8; transpose_item(p->in[I_WGA] + hd * 16384, 128, 128, (bf16_t*)(p->ws + WS_WGA_T) + hd * 16384, scr, r % 8, lane); continue; } r -= I_G;
        { const int hd = r / 8; transpose_item(p->in[I_WGI] + hd * 16384, 128, 128, (bf16_t*)(p->ws + WS_WGI_T) + hd * 16384, scr, r % 8, lane); }
    }
    bf16_t* wsp = (bf16_t*)(p->ws + WS_WSPB); bf16_t* skb = (bf16_t*)(p->ws + WS_SKEYB);
    for (int e = bid * NT + tid; e < 8 * 128 * 128; e += nb * NT) { const int i = (e >> 7) & 127, j = e & 127; wsp[e] = f2bf(j <= i ? p->in[I_WSP][e] : 0.f); }
    for (int e = bid * NT + tid; e < 8 * 2 * 128 * 128; e += nb * NT) skb[e] = f2bf(p->in[I_SKEY][e]);
}

__device__ __forceinline__ void phase_conv_naive(KP p, int bid, int nb) {
    const bf16_t* xl = (const bf16_t*)(p->ws + WS_PROJ); float* xc = (float*)(p->ws + WS_XC);
    const float* cw = p->in[I_CONVW]; const float* cb = p->in[I_CONVB];
    for (size_t e = (size_t)bid * NT + threadIdx.x; e < (size_t)M * DLRU; e += (size_t)nb * NT) {
        const int c = (int)(e & 1023); const size_t row = e >> 10; const int t = (int)(row % SEQ);
        float s = cb[c];
#pragma unroll
        for (int k = 0; k < 4; ++k) { const int tt = t - 3 + k; if (tt >= 0) s += cw[k * DLRU + c] * bf2f(xl[(row - 3 + k) * 1024 + c]); }
        xc[e] = s;
    }
}
__device__ __forceinline__ void phase_gates_naive(KP p, int bid, int nb) {
    const float* xc = (const float*)(p->ws + WS_XC); float* av = (float*)(p->ws + WS_A); float* bv = (float*)(p->ws + WS_BB);
    const float* wa = p->in[I_WGA]; const float* wi = p->in[I_WGI];
    for (size_t e = (size_t)bid * NT + threadIdx.x; e < (size_t)M * DLRU; e += (size_t)nb * NT) {
        const int c = (int)(e & 1023); const size_t row = e >> 10; const int hd = c >> 7, j = c & 127;
        float za = p->in[I_BGA][c], zi = p->in[I_BGI][c];
        const float* xr = xc + row * 1024 + hd * 128;
        for (int i = 0; i < 128; ++i) { const float xv = xr[i]; za += xv * wa[(size_t)(hd * 128 + i) * 128 + j]; zi += xv * wi[(size_t)(hd * 128 + i) * 128 + j]; }
        const float r = sigmoidf_(za), ig = sigmoidf_(zi);
        const float lam = p->in[I_LAM][c];
        const float sp = fmaxf(-lam, 0.f) + log1pf(__expf(-fabsf(lam)));
        const float la = -8.f * r * sp;
        const float a = __expf(la);
        av[e] = a; bv[e] = sqrtf(fmaxf(-expm1f(2.f * la), 0.f)) * (ig * xc[e]);
    }
}
__device__ __forceinline__ void phase_scan_naive(KP p, int bid, int nb) {
    const float* av = (const float*)(p->ws + WS_A); const float* bv = (const float*)(p->ws + WS_BB);
    const bf16_t* yg = (const bf16_t*)(p->ws + WS_PROJ) + (size_t)M * 1024;
    bf16_t* ymix = (bf16_t*)(p->ws + WS_YMIX);
    for (int e = bid * NT + threadIdx.x; e < NB * DLRU; e += nb * NT) {
        const int b = e >> 10, c = e & 1023;
        float h = 0.f;
        for (int t = 0; t < SEQ; ++t) { const size_t row = (size_t)b * SEQ + t; h = av[row * 1024 + c] * h + bv[row * 1024 + c]; ymix[row * D + c] = f2bf(h * bf2f(yg[row * 1024 + c])); }
    }
}
__device__ __forceinline__ void phase_rstdv_naive(KP p, int bid, int nb) {
    const bf16_t* vg = (const bf16_t*)(p->ws + WS_PROJ) + (size_t)3 * M * 1024; float* rs = (float*)(p->ws + WS_RSTDV);
    const int lane = threadIdx.x & 63, wave = threadIdx.x >> 6;
    for (int row = bid * 8 + wave; row < M; row += nb * 8) {
        float ss = 0.f;
        for (int d = lane; d < 1024; d += 64) { const float v = bf2f(vg[(size_t)row * 1024 + d]); ss += v * v; }
        ss = wave_sum(ss);
        if (lane == 0) rs[row] = rsqrtf(ss * (1.f / 1024.f) + EPS);
    }
}
__device__ __forceinline__ void phase_sgu_naive(KP p, int bid, int nb) {
    const bf16_t* ug = (const bf16_t*)(p->ws + WS_PROJ) + (size_t)2 * M * 1024; const bf16_t* vg = (const bf16_t*)(p->ws + WS_PROJ) + (size_t)3 * M * 1024;
    const float* rs = (const float*)(p->ws + WS_RSTDV); bf16_t* ymix = (bf16_t*)(p->ws + WS_YMIX);
    const float* ws = p->in[I_WSP]; const float* bs = p->in[I_BSP]; const float* gv = p->in[I_GV];
    for (size_t e = (size_t)bid * NT + threadIdx.x; e < (size_t)M * DSGU; e += (size_t)nb * NT) {
        const int d = (int)(e & 1023); const size_t row = e >> 10; const int g = d >> 7, i = (int)(row & 127); const size_t base = row - i;
        float s = 0.f;
        for (int j = 0; j <= i; ++j) s += ws[(size_t)(g * 128 + i) * 128 + j] * (bf2f(vg[(base + j) * 1024 + d]) * rs[base + j]);
        s = s * gv[d] + bs[g * 128 + i];
        ymix[row * D + 1024 + d] = f2bf(bf2f(ug[row * 1024 + d]) * s);
    }
}

__device__ __forceinline__ void wave_argmax(float& v, int& i) {
#pragma unroll
    for (int off = 32; off >= 1; off >>= 1) { const float ov = __shfl_xor(v, off); const int oi = __shfl_xor(i, off); if (ov > v || (ov == v && oi < i)) { v = ov; i = oi; } }
}
__device__ __forceinline__ void topk_half_naive(const bf16_t* q, const float* k0, int lane, float& outv, int& outi) {
    const float NEG = -3.0e38f;
    const float* k1 = k0 + 64 * 128;
    float s0 = 0.f, s1 = 0.f;
    for (int k = 0; k < 128; k += 4) {
        const uint2 qq = *(const uint2*)(q + k);
        const float q0 = bf2f((bf16_t)(qq.x & 0xffff)), q1 = bf2f((bf16_t)(qq.x >> 16)), q2 = bf2f((bf16_t)(qq.y & 0xffff)), q3 = bf2f((bf16_t)(qq.y >> 16));
        const float4 a = *(const float4*)(k0 + k), b = *(const float4*)(k1 + k);
        s0 += q0 * a.x + q1 * a.y + q2 * a.z + q3 * a.w; s1 += q0 * b.x + q1 * b.y + q2 * b.z + q3 * b.w;
    }
    float myv = NEG; int myi = 0;
    for (int r = 0; r < TOPK; ++r) {
        float v; int i; if (s0 >= s1) { v = s0; i = lane; } else { v = s1; i = lane + 64; }
        wave_argmax(v, i);
        if (i == lane) s0 = NEG; if (i == lane + 64) s1 = NEG;
        if (lane == r) { myv = v; myi = i; }
    }
    outv = myv; outi = myi;
}
__device__ __forceinline__ void phase_topk_naive(KP p, int bid, int nb) {
    const bf16_t* Q = (const bf16_t*)(p->ws + WS_Q); const float* keys = p->in[I_SKEY];
    int* idx = (int*)(p->ws + WS_IDX); float* gate = (float*)(p->ws + WS_GATE);
    const int lane = threadIdx.x & 63, wave = threadIdx.x >> 6;
    const float NEG = -3.0e38f;
    for (int task = bid * 8 + wave; task < M * NHEAD; task += nb * 8) {
        const int token = task >> 3, hd = task & 7;
        float tv0, tv1; int ti0, ti1;
        topk_half_naive(Q + (size_t)token * D + hd * 256, keys + ((size_t)(hd * 2) * 128 + lane) * 128, lane, tv0, ti0);
        topk_half_naive(Q + (size_t)token * D + hd * 256 + 128, keys + ((size_t)(hd * 2 + 1) * 128 + lane) * 128, lane, tv1, ti1);
        const float vb = __shfl(tv1, lane & 15);
        float c0 = __shfl(tv0, (lane >> 4)) + vb, c1 = __shfl(tv0, (lane >> 4) + 4) + vb, c2 = __shfl(tv0, (lane >> 4) + 8) + vb, c3 = __shfl(tv0, (lane >> 4) + 12) + vb;
        float selv = NEG; int selc = 0;
        for (int r = 0; r < TOPK; ++r) {
            float v = c0; int i = lane;
            if (c1 > v) { v = c1; i = lane + 64; }
            if (c2 > v) { v = c2; i = lane + 128; }
            if (c3 > v) { v = c3; i = lane + 192; }
            wave_argmax(v, i);
            if (i == lane) c0 = NEG; if (i == lane + 64) c1 = NEG; if (i == lane + 128) c2 = NEG; if (i == lane + 192) c3 = NEG;
            if (lane == r) { selv = v; selc = i; }
        }
        const float mx = __shfl(selv, 0);
        const float e = lane < TOPK ? __expf(selv - mx) : 0.f;
        const float sum = wave_sum(e);
        const int i1 = __shfl(ti0, selc >> 4), i2 = __shfl(ti1, selc & 15);
        if (lane < TOPK) { idx[(size_t)token * NSEL + hd * TOPK + lane] = i1 * NKEYS + i2; gate[(size_t)token * NSEL + hd * TOPK + lane] = e / sum; }
    }
}

typedef _Float16 h2_t __attribute__((ext_vector_type(2)));
__device__ __forceinline__ unsigned pkh2(float lo, float hi) { h2_t v; v.x = (_Float16)lo; v.y = (_Float16)hi; return __builtin_bit_cast(unsigned, v); }
__device__ __forceinline__ float dot2h(unsigned a, unsigned b, float c) { return __builtin_amdgcn_fdot2(__builtin_bit_cast(h2_t, a), __builtin_bit_cast(h2_t, b), c, false); }
__device__ __forceinline__ void phase_convert_experts(KP p, int bid, int nb) {
    const size_t n8 = (size_t)NKEYS * NKEYS * D / 8;
    for (int t = 0; t < 2; ++t) {
        const float* src = t ? p->in[I_EV] : p->in[I_EU]; uint4* dst = (uint4*)(p->ws + (t ? WS_EV16 : WS_EU16));
        for (size_t i = (size_t)bid * NT + threadIdx.x; i < n8; i += (size_t)nb * NT) {
            const float4 a = *(const float4*)(src + i * 8), b = *(const float4*)(src + i * 8 + 4);
            uint4 o; o.x = pkh2(a.x, a.y); o.y = pkh2(a.z, a.w); o.z = pkh2(b.x, b.y); o.w = pkh2(b.z, b.w);
            dst[i] = o;
        }
    }
}
__device__ __forceinline__ void phase_peer(KP p, float* lds, int bid, int nb) {
    const bf16_t* H = (const bf16_t*)(p->ws + WS_H); const int* idx = (const int*)(p->ws + WS_IDX); const float* gate = (const float*)(p->ws + WS_GATE);
    const unsigned char* EU = p->ws + WS_EU16; const unsigned char* EV = p->ws + WS_EV16; const float* gf = p->in[I_GFIN];
    const int tid = threadIdx.x, lane = tid & 63, wave = tid >> 6;
    for (int i = tid; i < NB * D; i += NT) lds[i] = mod_at(p, i >> 11, 5 * D + (i & (D - 1)));
    __syncthreads();
    for (int token = bid * 8 + wave; token < M; token += nb * 8) {
        unsigned hp[16];
#pragma unroll
        for (int j = 0; j < 4; ++j) { const uint4 w = *(const uint4*)(H + (size_t)token * D + lane * 8 + 512 * j);
            hp[4 * j + 0] = pkh2(__uint_as_float(w.x << 16), __uint_as_float(w.x & 0xffff0000u)); hp[4 * j + 1] = pkh2(__uint_as_float(w.y << 16), __uint_as_float(w.y & 0xffff0000u));
            hp[4 * j + 2] = pkh2(__uint_as_float(w.z << 16), __uint_as_float(w.z & 0xffff0000u)); hp[4 * j + 3] = pkh2(__uint_as_float(w.w << 16), __uint_as_float(w.w & 0xffff0000u)); }
        const int e0 = idx[(size_t)token * NSEL + lane], e1 = idx[(size_t)token * NSEL + 64 + lane];
        const float g0 = gate[(size_t)token * NSEL + lane], g1 = gate[(size_t)token * NSEL + 64 + lane];
        float act0 = 0.f, act1 = 0.f;
        for (int s = 0; s < NSEL; s += 4) {
            const int ee = s < 64 ? e0 : e1; const float gg = s < 64 ? g0 : g1; const int sl = s & 63;
            uint4 r[4][4];
#pragma unroll
            for (int k = 0; k < 4; ++k) { const int e = __builtin_amdgcn_readlane(ee, sl + k); const unsigned char* base = EU + (size_t)e * (D * 2) + lane * 16;
#pragma unroll
                for (int j = 0; j < 4; ++j) r[k][j] = *(const uint4*)(base + 1024 * j); }
#pragma unroll
            for (int k = 0; k < 4; ++k) { float d = 0.f;
#pragma unroll
                for (int j = 0; j < 4; ++j) { d = dot2h(hp[4 * j], r[k][j].x, d); d = dot2h(hp[4 * j + 1], r[k][j].y, d); d = dot2h(hp[4 * j + 2], r[k][j].z, d); d = dot2h(hp[4 * j + 3], r[k][j].w, d); }
                d = wave_sum(d);
                const float a = gelu_t(d) * __builtin_bit_cast(float, __builtin_amdgcn_readlane(__builtin_bit_cast(int, gg), sl + k));
                if (lane == sl + k) { if (s < 64) act0 = a; else act1 = a; } }
        }
        float acc[32];
#pragma unroll
        for (int j = 0; j < 32; ++j) acc[j] = 0.f;
        for (int s = 0; s < NSEL; s += 4) {
            const int ee = s < 64 ? e0 : e1; const float aa = s < 64 ? act0 : act1; const int sl = s & 63;
            uint4 r[4][4];
#pragma unroll
            for (int k = 0; k < 4; ++k) { const int e = __builtin_amdgcn_readlane(ee, sl + k); const unsigned char* base = EV + (size_t)e * (D * 2) + lane * 16;
#pragma unroll
                for (int j = 0; j < 4; ++j) r[k][j] = *(const uint4*)(base + 1024 * j); }
#pragma unroll
            for (int k = 0; k < 4; ++k) { const float a = __builtin_bit_cast(float, __builtin_amdgcn_readlane(__builtin_bit_cast(int, aa), sl + k));
#pragma unroll
                for (int j = 0; j < 4; ++j) { const unsigned w[4] = {r[k][j].x, r[k][j].y, r[k][j].z, r[k][j].w};
#pragma unroll
                    for (int c = 0; c < 4; ++c) { const h2_t v = __builtin_bit_cast(h2_t, w[c]); acc[8 * j + 2 * c] = fmaf((float)v.x, a, acc[8 * j + 2 * c]); acc[8 * j + 2 * c + 1] = fmaf((float)v.y, a, acc[8 * j + 2 * c + 1]); } } }
        }
        const float* gt = lds + (token / SEQ) * D;
        float ss = 0.f;
#pragma unroll
        for (int j = 0; j < 4; ++j)
#pragma unroll
            for (int hh = 0; hh < 2; ++hh) {
                const int col = lane * 8 + 512 * j + 4 * hh;
                const float4 x1 = *(const float4*)(p->out + (size_t)token * D + col); const float4 g4 = *(const float4*)(gt + col);
                float* a = acc + 8 * j + 4 * hh;
                a[0] = x1.x + g4.x * a[0]; a[1] = x1.y + g4.y * a[1]; a[2] = x1.z + g4.z * a[2]; a[3] = x1.w + g4.w * a[3];
                ss += a[0] * a[0] + a[1] * a[1] + a[2] * a[2] + a[3] * a[3];
            }
        const float rstd = rsqrtf(wave_sum(ss) * (1.f / D) + EPS);
#pragma unroll
        for (int j = 0; j < 4; ++j)
#pragma unroll
            for (int hh = 0; hh < 2; ++hh) {
                const int col = lane * 8 + 512 * j + 4 * hh;
                const float4 g4 = *(const float4*)(gf + col); const float* a = acc + 8 * j + 4 * hh;
                float4 o; o.x = a[0] * rstd * g4.x; o.y = a[1] * rstd * g4.y; o.z = a[2] * rstd * g4.z; o.w = a[3] * rstd * g4.w;
                *(float4*)(p->out + (size_t)token * D + col) = o;
            }
    }
}

extern __shared__ __attribute__((aligned(16))) unsigned char dyn_lds[];
constexpr int LDS_BYTES = 147456;
__global__ void __launch_bounds__(NT) fwd_megakernel(Params p_unused) {
    cg::grid_group grid = cg::this_grid();
    KP p = (KP)__builtin_amdgcn_kernarg_segment_ptr();
    float* lds = (float*)dyn_lds;
    const int bid = blockIdx.x, nb = gridDim.x;
    phase_mod(p, lds, bid, nb);
    __syncthreads();
    phase_convert_weights(p, lds, bid, nb);
    grid.sync();
    phase_hrows(p, p->in[I_X], p->in[I_GMIX], 0, D, (bf16_t*)(p->ws + WS_H), lds, bid, nb);
    grid.sync();
    { pg8::Gemm g{(const bf16_t*)(p->ws + WS_H), (const bf16_t*)(p->ws + WS_WIN_T), M, NPROJ, D}; pg8::StaticOrder S; S.init(M, NPROJ, nb, bid);
      pg8::EpiProj E{(bf16_t*)(p->ws + WS_PROJ), (float*)(p->ws + WS_SSQV), M};
      pg8::gemm_phase<pg8::EpiProj, pg8::StaticOrder, true, true>((LAS unsigned char*)dyn_lds, g, S, E); }
    grid.sync();
    phase_conv_naive(p, bid, nb);
    phase_rstdv_naive(p, bid, nb);
    grid.sync();
    phase_gates_naive(p, bid, nb);
    phase_sgu_naive(p, bid, nb);
    grid.sync();
    phase_scan_naive(p, bid, nb);
    grid.sync();
    phase_convert_experts(p, bid, nb);
    { pg8::Gemm g{(const bf16_t*)(p->ws + WS_YMIX), (const bf16_t*)(p->ws + WS_WOUT_T), M, D, D}; pg8::StaticOrder S; S.init(M, D, nb, bid);
      pg8::EpiX1 E{p->in[I_X], p->out, (const float*)(p->ws + WS_MODP), p->in[I_BADA], 2 * D, NMOD, SEQ};
      pg8::gemm_phase<pg8::EpiX1, pg8::StaticOrder, true, true>((LAS unsigned char*)dyn_lds, g, S, E); }
    grid.sync();
    phase_hrows(p, p->out, p->in[I_GFFN], 3 * D, 4 * D, (bf16_t*)(p->ws + WS_H), lds, bid, nb);
    grid.sync();
    { pg8::Gemm g{(const bf16_t*)(p->ws + WS_H), (const bf16_t*)(p->ws + WS_WQ_T), M, D, D}; pg8::StaticOrder S; S.init(M, D, nb, bid);
      pg8::EpiQ E{(bf16_t*)(p->ws + WS_Q), D};
      pg8::gemm_phase<pg8::EpiQ, pg8::StaticOrder, true, true>((LAS unsigned char*)dyn_lds, g, S, E); }
    grid.sync();
    phase_topk_naive(p, bid, nb);
    grid.sync();
    phase_peer(p, lds, bid, nb);
}

extern "C" void kernel_launch(void* const* d_in, const int* in_sizes, int n_in, void* d_out, int out_size, void* d_ws, size_t ws_size, hipStream_t stream) {
    static int grid_blocks = 0;
    if (grid_blocks == 0) {
        if (n_in != 23 || in_sizes[0] != M * D || out_size != M * D || ws_size < WS_END) { fprintf(stderr, "kernel_launch: unexpected shapes (n_in %d in0 %d out %d ws %zu)\n", n_in, n_in > 0 ? in_sizes[0] : -1, out_size, ws_size); grid_blocks = -1; return; }
        if (hipFuncSetAttribute((const void*)fwd_megakernel, hipFuncAttributeMaxDynamicSharedMemorySize, LDS_BYTES) != hipSuccess) { fprintf(stderr, "hipFuncSetAttribute failed\n"); grid_blocks = -1; return; }
        int dev = 0, cus = 0, per_cu = 0;
        hipGetDevice(&dev);
        hipDeviceGetAttribute(&cus, hipDeviceAttributeMultiprocessorCount, dev);
        if (hipOccupancyMaxActiveBlocksPerMultiprocessor(&per_cu, (const void*)fwd_megakernel, NT, LDS_BYTES) != hipSuccess || per_cu < 1) { fprintf(stderr, "occupancy query failed (%d)\n", per_cu); grid_blocks = -1; return; }
        grid_blocks = cus;
    }
    if (grid_blocks < 0) return;
    Params p{};
    for (int i = 0; i < 23; ++i) p.in[i] = (const float*)d_in[i];
    p.out = (float*)d_out; p.ws = (unsigned char*)d_ws;
    void* args[] = {&p};
    hipError_t e = hipLaunchCooperativeKernel((const void*)fwd_megakernel, dim3(grid_blocks), dim3(NT), args, LDS_BYTES, stream);
    if (e != hipSuccess) fprintf(stderr, "cooperative launch failed: %s (grid %d)\n", hipGetErrorString(e), grid_blocks);
}
```

```cpp
#include <hip/hip_runtime.h>
#include <hip/hip_cooperative_groups.h>
#include <cstdio>
#include <cstdint>

constexpr int D = 2048, NB = 8, SEQ = 2048, M = NB * SEQ;
constexpr int DLRU = 1024, DSGU = 1024, NPROJ = 4096;
constexpr int NMOD = 6 * D;
constexpr int NHEAD = 8, NKEYS = 128, TOPK = 16, NSEL = NHEAD * TOPK;
constexpr float EPS = 1e-6f;
constexpr int NT = 512;
namespace cg = cooperative_groups;

constexpr size_t MiB = 1u << 20;
constexpr size_t WS_CTL = 0;
constexpr size_t WS_MODP = 1 * MiB;
constexpr size_t WS_WGA_T = 3 * MiB;
constexpr size_t WS_WGI_T = 3 * MiB + 262144;
constexpr size_t WS_WSPB = 3 * MiB + 524288;
constexpr size_t WS_SKEYB = 3 * MiB + 786432;
constexpr size_t WS_SSQV = 5 * MiB;
constexpr size_t WS_RSTDV = 8 * MiB;
constexpr size_t WS_WIN_T = 9 * MiB;
constexpr size_t WS_WOUT_T = 25 * MiB;
constexpr size_t WS_WQ_T = 33 * MiB;
constexpr size_t WS_IDX = 41 * MiB;
constexpr size_t WS_GATE = 49 * MiB;
constexpr size_t WS_H = 64 * MiB;
constexpr size_t WS_PROJ = 128 * MiB;
constexpr size_t WS_Q = 128 * MiB;
constexpr size_t WS_YMIX = 256 * MiB;
constexpr size_t WS_EU16 = 320 * MiB;
constexpr size_t WS_EV16 = 384 * MiB;
constexpr size_t WS_XC = 320 * MiB;
constexpr size_t WS_A = 384 * MiB;
constexpr size_t WS_BB = 448 * MiB;
constexpr size_t WS_END = 512 * MiB;

typedef unsigned short bf16_t;
struct Params { const float* in[23]; float* out; unsigned char* ws; };
typedef const __attribute__((address_space(4))) Params* KP;
enum { I_X = 0, I_C, I_WADA, I_BADA, I_GMIX, I_WIN, I_CONVW, I_CONVB, I_WGA, I_BGA, I_WGI, I_BGI, I_LAM, I_GV, I_WSP, I_BSP, I_WOUT, I_GFFN, I_WQ, I_SKEY, I_EU, I_EV, I_GFIN };

__device__ __forceinline__ int opaque_tid() { int t = threadIdx.x; asm volatile("" : "+v"(t)); return t; }
__device__ __forceinline__ float bf2f(bf16_t v) { return __uint_as_float(((unsigned)v) << 16); }
__device__ __forceinline__ bf16_t f2bf(float f) { unsigned u = __float_as_uint(f); u += 0x7fffu + ((u >> 16) & 1u); return (bf16_t)(u >> 16); }
__device__ __forceinline__ float sigmoidf_(float x) { return 1.f / (1.f + __expf(-x)); }
__device__ __forceinline__ float gelu_t(float x) { const float u = 0.7978845608028654f * (x + 0.044715f * x * x * x); return x * sigmoidf_(2.f * u); }
__device__ __forceinline__ float wave_sum(float v) {
#pragma unroll
    for (int o = 1; o < 64; o <<= 1) v += __shfl_xor(v, o);
    return v;
}
__device__ __forceinline__ float mod_at(KP p, int b, int n) {
    const float* mp = (const float*)(p->ws + WS_MODP);
    float s = p->in[I_BADA][n];
#pragma unroll
    for (int kc = 0; kc < 4; ++kc) s += mp[(size_t)(kc * 8 + b) * NMOD + n];
    return s;
}

__device__ __forceinline__ void phase_mod(KP p, float* lds, int bid, int nb) {
    const int tid = opaque_tid(), lane = tid & 63, wave = tid >> 6;
    const float* c = p->in[I_C]; const float* W = p->in[I_WADA];
    float* modp = (float*)(p->ws + WS_MODP);
    for (int i = tid; i < NB * D; i += NT) { const float v = c[i]; lds[i] = v * sigmoidf_(v); }
    __syncthreads();
    float* red = lds + NB * D;
    for (int item = bid; item < 192; item += nb) {
        const int nt = item % 48, kc = item / 48;
        const int n0 = nt * 256 + lane * 4, k0 = kc * 512 + wave * 64;
        float acc[8][4];
#pragma unroll
        for (int b = 0; b < 8; ++b)
#pragma unroll
            for (int j = 0; j < 4; ++j) acc[b][j] = 0.f;
        for (int kk = 0; kk < 64; ++kk) {
            const float4 w = *(const float4*)(W + (size_t)(k0 + kk) * NMOD + n0);
#pragma unroll
            for (int b = 0; b < 8; ++b) { const float s = lds[b * D + k0 + kk]; acc[b][0] += s * w.x; acc[b][1] += s * w.y; acc[b][2] += s * w.z; acc[b][3] += s * w.w; }
        }
#pragma unroll
        for (int b = 0; b < 8; ++b)
#pragma unroll
            for (int j = 0; j < 4; ++j) red[(wave * 32 + b * 4 + j) * 64 + lane] = acc[b][j];
        __syncthreads();
        for (int o = tid; o < 2048; o += NT) {
            const int b = o >> 8, nn = o & 255, ln = nn >> 2, j = nn & 3;
            float s = 0.f;
#pragma unroll
            for (int w = 0; w < 8; ++w) s += red[(w * 32 + b * 4 + j) * 64 + ln];
            modp[(size_t)(kc * 8 + b) * NMOD + nt * 256 + nn] = s;
        }
        __syncthreads();
    }
}

__device__ __forceinline__ void phase_hrows(KP p, const float* src, const float* gn, int shift_off, int scale_off, bf16_t* dst, float* lds, int bid, int nb) {
    const int tid = opaque_tid(), lane = tid & 63, wave = tid >> 6;
    float* Aw = lds; float* Bw = lds + D;
    for (int item = bid; item < M / 64; item += nb) {
        const int b = item / (SEQ / 64);
        for (int col = tid; col < D; col += NT) { Aw[col] = gn[col] * (1.f + mod_at(p, b, scale_off + col)); Bw[col] = mod_at(p, b, shift_off + col); }
        __syncthreads();
        for (int r = wave; r < 64; r += 8) {
            const size_t row = (size_t)item * 64 + r;
            float4 v[8]; float ss = 0.f;
#pragma unroll
            for (int j = 0; j < 8; ++j) { v[j] = *(const float4*)(src + row * D + lane * 4 + 256 * j); ss += v[j].x * v[j].x + v[j].y * v[j].y + v[j].z * v[j].z + v[j].w * v[j].w; }
            const float rstd = rsqrtf(wave_sum(ss) * (1.f / D) + EPS);
#pragma unroll
            for (int j = 0; j < 8; ++j) {
                const int col = lane * 4 + 256 * j;
                const float o0 = v[j].x * rstd * Aw[col] + Bw[col], o1 = v[j].y * rstd * Aw[col + 1] + Bw[col + 1];
                const float o2 = v[j].z * rstd * Aw[col + 2] + Bw[col + 2], o3 = v[j].w * rstd * Aw[col + 3] + Bw[col + 3];
                uint2 w; w.x = (unsigned)f2bf(o0) | ((unsigned)f2bf(o1) << 16); w.y = (unsigned)f2bf(o2) | ((unsigned)f2bf(o3) << 16);
                *(uint2*)(dst + row * D + col) = w;
            }
        }
        __syncthreads();
    }
}

namespace pg8 {
#define PG8_LAS __attribute__((address_space(3)))
typedef unsigned short bf16_t;
typedef short bf16x8 __attribute__((ext_vector_type(8)));
typedef float f32x4 __attribute__((ext_vector_type(4)));
typedef unsigned u32x4 __attribute__((ext_vector_type(4)));
constexpr int BM = 256, BK = 64, HALF = 128, HTB = HALF * BK * 2  , STAGE_BYTES = 8 * HTB, NXCD = 8, WGM = 8;

__host__ __device__ __forceinline__ int lds_byte(int r, int c) { const int st = (r >> 4) * 2 + (c >> 5), rr = r & 15, cc = c & 31, ob = rr * 64 + cc * 2; return st * 1024 + (ob ^ (((ob >> 9) & 1) << 5)); }
__host__ __device__ __forceinline__ void stage_rc(int b, int& R, int& C) { const int st = b / 1024, sb = b % 1024, swz = sb ^ (((sb >> 9) & 1) << 5); R = (st >> 1) * 16 + swz / 64; C = (st & 1) * 32 + (swz % 64) / 2; }
__host__ __device__ __forceinline__ int perm32(int rho) { const int n = rho >> 4, i = rho & 15; return 8 * (i >> 2) + 4 * n + (i & 3); }

struct Unit { int pm, pn; };
struct Gemm { const bf16_t* A; const bf16_t* Bt; int M, N, K; };

struct StaticOrder {
    int nM, nN, nwg, G, c;
    __host__ __device__ void init(int M, int N, int G_, int c_) { nM = M / BM; nN = N / BM; nwg = nM * nN; G = G_; c = c_; }
    __host__ __device__ bool next(int i, Unit& u) const {
        const long L = (long)i * G + c; if (L >= nwg) return false;
        int wgid = (int)L; { const int q = nwg / NXCD, r = nwg % NXCD, xcd = wgid % NXCD, off = wgid / NXCD; wgid = (xcd < r ? xcd * (q + 1) : r * (q + 1) + (xcd - r) * q) + off; }
        const int nig = WGM * nN, gid = wgid / nig, fm = gid * WGM, gsz = (nM - fm) < WGM ? (nM - fm) : WGM;
        u.pm = fm + ((wgid % nig) % gsz); u.pn = (wgid % nig) / gsz; return true;
    }
    __device__ __forceinline__ void a_ready(const Unit&) const {}
    __device__ __forceinline__ void done(const Unit&) const {}
};


__device__ __forceinline__ unsigned cvt_pk_bf16(float lo, float hi) { unsigned r; asm volatile("v_cvt_pk_bf16_f32 %0, %1, %2" : "=v"(r) : "v"(lo), "v"(hi)); return r; }
__device__ __forceinline__ float gelu_tanh(float x) { const float u = 1.5957691216057308f * (x + 0.044715f * x * x * x); return x * __builtin_amdgcn_rcpf(1.f + __expf(-u)); }
struct EpiProj {
    static constexpr bool PERM = true, AFTER_DRAIN = false;
    bf16_t* proj; float* ssqv; int Mrows;
    __device__ __forceinline__ void operator()(const f32x4 (&acc)[2][2][4][2], const Unit& u, int wr, int wc, int fr, int fq) const {
        const int which = (u.pn * BM) >> 10, colt = (u.pn * BM) & 1023;
        bf16_t* base = proj + (size_t)which * Mrows * 1024;
        const int row0 = u.pm * BM + wr * 64 + fr, col0 = colt + wc * 32 + 8 * fq;
#pragma unroll
        for (int ai = 0; ai < 2; ++ai)
#pragma unroll
            for (int m = 0; m < 4; ++m) { const int row = row0 + ai * HALF + m * 16; bf16_t* rowp = base + (size_t)row * 1024 + col0; float ss = 0.f;
#pragma unroll
                for (int bj = 0; bj < 2; ++bj) { f32x4 v0 = acc[ai][bj][m][0], v1 = acc[ai][bj][m][1];
                    if (which) {
#pragma unroll
                        for (int j = 0; j < 4; ++j) { v0[j] = gelu_tanh(v0[j]); v1[j] = gelu_tanh(v1[j]); } }
                    ss += (v0[0] * v0[0] + v0[1] * v0[1]) + (v0[2] * v0[2] + v0[3] * v0[3]) + (v1[0] * v1[0] + v1[1] * v1[1]) + (v1[2] * v1[2] + v1[3] * v1[3]);
                    u32x4 w; w.x = cvt_pk_bf16(v0[0], v0[1]); w.y = cvt_pk_bf16(v0[2], v0[3]); w.z = cvt_pk_bf16(v1[0], v1[1]); w.w = cvt_pk_bf16(v1[2], v1[3]);
                    *(u32x4*)(rowp + bj * HALF) = w; }
                if (which == 3) { ss += __shfl_xor(ss, 16); ss += __shfl_xor(ss, 32); if (fq == 0) ssqv[(size_t)row * 16 + (u.pn & 3) * 4 + wc] = ss; } }
    }
};
struct EpiX1 {
    static constexpr bool PERM = false, AFTER_DRAIN = false;
    const float* x; float* out; const float* modp; const float* bada; int goff, nmod, seq;
    __device__ __forceinline__ void operator()(const f32x4 (&acc)[2][2][4][2], const Unit& u, int wr, int wc, int fr, int fq) const {
        const int row0 = u.pm * BM + wr * 64 + fr, col0 = u.pn * BM + wc * 32 + 4 * fq, b = (u.pm * BM) / seq;
        f32x4 gv[2][2];
#pragma unroll
        for (int bj = 0; bj < 2; ++bj)
#pragma unroll
            for (int n = 0; n < 2; ++n) { const int c = goff + col0 + bj * HALF + n * 16; f32x4 g = *(const f32x4*)(bada + c);
#pragma unroll
                for (int kc = 0; kc < 4; ++kc) g += *(const f32x4*)(modp + (size_t)(kc * 8 + b) * nmod + c);
                gv[bj][n] = g; }
#pragma unroll
        for (int ai = 0; ai < 2; ++ai)
#pragma unroll
            for (int m = 0; m < 4; ++m) { const size_t off = (size_t)(row0 + ai * HALF + m * 16) * (size_t)(2048) + col0;
#pragma unroll
                for (int bj = 0; bj < 2; ++bj)
#pragma unroll
                    for (int n = 0; n < 2; ++n) { const f32x4 xv = *(const f32x4*)(x + off + bj * HALF + n * 16); *(f32x4*)(out + off + bj * HALF + n * 16) = xv + gv[bj][n] * acc[ai][bj][m][n]; } }
    }
};
struct EpiQ {
    static constexpr bool PERM = true, AFTER_DRAIN = false;
    bf16_t* O; int ldc;
    __device__ __forceinline__ void operator()(const f32x4 (&acc)[2][2][4][2], const Unit& u, int wr, int wc, int fr, int fq) const {
        const int row0 = u.pm * BM + wr * 64 + fr, col0 = u.pn * BM + wc * 32 + 8 * fq;
#pragma unroll
        for (int ai = 0; ai < 2; ++ai)
#pragma unroll
            for (int m = 0; m < 4; ++m) { bf16_t* rowp = O + (size_t)(row0 + ai * HALF + m * 16) * ldc + col0;
#pragma unroll
                for (int bj = 0; bj < 2; ++bj) { const f32x4 v0 = acc[ai][bj][m][0], v1 = acc[ai][bj][m][1];
                    u32x4 w; w.x = cvt_pk_bf16(v0[0], v0[1]); w.y = cvt_pk_bf16(v0[2], v0[3]); w.z = cvt_pk_bf16(v1[0], v1[1]); w.w = cvt_pk_bf16(v1[2], v1[3]);
                    *(u32x4*)(rowp + bj * HALF) = w; } }
    }
};

template <class Epi, class Sched, bool ALIGN_EPI = false, bool SP2 = false>
__device__ __forceinline__ void gemm_phase(PG8_LAS unsigned char* lds, const Gemm g, const Sched& S, const Epi& E) {
    const int tid = opaque_tid(), wid = __builtin_amdgcn_readfirstlane(tid >> 6), lane = tid & 63, wr = wid >> 2, wc = wid & 3, fr = lane & 15, fq = lane >> 4;
    const int K = g.K, nt = K / BK;
    unsigned voffA[2], voffB[2];
#pragma unroll
    for (int i = 0; i < 2; ++i) { int R, C; stage_rc(tid * 16 + i * 8192, R, C); const int Rb = Epi::PERM ? ((R & ~31) + perm32(R & 31)) : R;
        voffA[i] = (unsigned)(R * K + C) * 2u; voffB[i] = (unsigned)(Rb * K + C) * 2u; }
    const size_t kstep = (size_t)(BK * 2);
    const size_t hstep = (size_t)HALF * K * 2;
    const size_t tstep = 2 * hstep;
    const unsigned ldsw = (unsigned)wid * 1024u;
    const int aoff = lds_byte(wr * 64 + fr, fq * 8), boff = lds_byte(wc * 32 + fr, fq * 8);
#define PG8_SA(b, h) (((b) * 2 + (h)) * HTB)
#define PG8_SB(b, h) ((4 + (b) * 2 + (h)) * HTB)
#define PG8_STAGE(bufoff, gbase, voff) do { _Pragma("unroll") for (int _i = 0; _i < 2; ++_i) \
        __builtin_amdgcn_global_load_lds((const unsigned*)((const char*)(gbase) + (voff)[_i]), (PG8_LAS unsigned*)(lds + (bufoff) + ldsw + _i * 8192), 16, 0, 0); } while (0)
#define PG8_LDA(dst, b, h) do { _Pragma("unroll") for (int m = 0; m < 4; ++m) _Pragma("unroll") for (int k = 0; k < 2; ++k) dst[m][k] = *(const PG8_LAS bf16x8*)(lds + PG8_SA(b, h) + aoff + m * 2048 + k * 1024); } while (0)
#define PG8_LDB(dst, b, h) do { _Pragma("unroll") for (int n = 0; n < 2; ++n) _Pragma("unroll") for (int k = 0; k < 2; ++k) dst[n][k] = *(const PG8_LAS bf16x8*)(lds + PG8_SB(b, h) + boff + n * 2048 + k * 1024); } while (0)
#define PG8_MMA(ai, bj, At, Bt) do { __builtin_amdgcn_s_setprio(1); _Pragma("unroll") for (int m = 0; m < 4; ++m) _Pragma("unroll") for (int n = 0; n < 2; ++n) _Pragma("unroll") for (int k = 0; k < 2; ++k) \
        acc[ai][bj][m][n] = __builtin_amdgcn_mfma_f32_16x16x32_bf16(Bt[n][k], At[m][k], acc[ai][bj][m][n], 0, 0, 0); __builtin_amdgcn_s_setprio(0); } while (0)
#define PG8_WAIT_V(n) asm volatile("s_waitcnt vmcnt(" #n ")" ::: "memory")
#define PG8_WAIT_L(n) asm volatile("s_waitcnt lgkmcnt(" #n ")" ::: "memory")
#define PG8_BAR __builtin_amdgcn_s_barrier()
#define PG8_SCHED __builtin_amdgcn_sched_barrier(0)
    Unit cur, nxt; int ui = 0;
    if (!S.next(0, cur)) return;
    f32x4 acc[2][2][4][2];
#pragma unroll
    for (int a = 0; a < 2; ++a)
#pragma unroll
        for (int b = 0; b < 2; ++b)
#pragma unroll
            for (int m = 0; m < 4; ++m)
#pragma unroll
                for (int n = 0; n < 2; ++n) acc[a][b][m][n] = (f32x4){0.f, 0.f, 0.f, 0.f};
    bf16x8 At[4][2], B0[2][2], B1[2][2];
    const char* cA = (const char*)g.A + (size_t)cur.pm * tstep; const char* cB = (const char*)g.Bt + (size_t)cur.pn * tstep;
    S.a_ready(cur);
    if constexpr (SP2) {
        PG8_STAGE(PG8_SB(0, 0), cB, voffB); PG8_STAGE(PG8_SB(0, 1), cB + hstep, voffB); PG8_STAGE(PG8_SA(0, 0), cA, voffA); PG8_STAGE(PG8_SA(0, 1), cA + hstep, voffA);
        if (wr == 1) PG8_BAR;
        PG8_WAIT_V(2); PG8_BAR;
        PG8_STAGE(PG8_SB(1, 0), cB + kstep, voffB); PG8_STAGE(PG8_SA(1, 0), cA + kstep, voffA); PG8_STAGE(PG8_SB(1, 1), cB + hstep + kstep, voffB);
        PG8_WAIT_V(6); PG8_BAR;
    } else {
        PG8_STAGE(PG8_SB(0, 0), cB, voffB); PG8_STAGE(PG8_SA(0, 0), cA, voffA); PG8_STAGE(PG8_SB(0, 1), cB + hstep, voffB); PG8_STAGE(PG8_SA(0, 1), cA + hstep, voffA);
        if (wr == 1) PG8_BAR;
        PG8_WAIT_V(4); PG8_BAR;
        PG8_STAGE(PG8_SB(1, 0), cB + kstep, voffB); PG8_STAGE(PG8_SA(1, 0), cA + kstep, voffA); PG8_STAGE(PG8_SB(1, 1), cB + hstep + kstep, voffB);
        PG8_WAIT_V(6); PG8_BAR;
    }
    for (;;) {
        const bool has_next = S.next(ui + 1, nxt);
        const char* nA = has_next ? (const char*)g.A + (size_t)nxt.pm * tstep : cA; const char* nB = has_next ? (const char*)g.Bt + (size_t)nxt.pn * tstep : cB;
        for (int t = 0; t < nt; t += 2) {
            const bool last = (t == nt - 2);
            const char* a1 = cA + (size_t)(t + 1) * kstep;
            const char* a2 = last ? nA : cA + (size_t)(t + 2) * kstep; const char* b2 = last ? nB : cB + (size_t)(t + 2) * kstep;
            const char* a3 = a2 + kstep; const char* b3 = b2 + kstep;
            if (last && has_next) S.a_ready(nxt);
            if constexpr (SP2) {
            PG8_LDB(B0, 0, 0); PG8_LDB(B1, 0, 1); PG8_SCHED; PG8_LDA(At, 0, 0); PG8_STAGE(PG8_SA(1, 1), a1 + hstep, voffA);
            PG8_WAIT_V(8); PG8_WAIT_L(0); PG8_BAR; PG8_MMA(0, 0, At, B0); PG8_MMA(0, 1, At, B1); PG8_BAR; PG8_SCHED;
            PG8_LDA(At, 0, 1); PG8_STAGE(PG8_SB(0, 0), b2, voffB); PG8_STAGE(PG8_SB(0, 1), b2 + hstep, voffB); PG8_STAGE(PG8_SA(0, 0), a2, voffA);
            PG8_WAIT_V(8); PG8_WAIT_L(0); PG8_BAR; PG8_MMA(1, 0, At, B0); PG8_MMA(1, 1, At, B1); PG8_BAR; PG8_SCHED;
            PG8_LDB(B0, 1, 0); PG8_LDB(B1, 1, 1); PG8_SCHED; PG8_LDA(At, 1, 0); PG8_STAGE(PG8_SA(0, 1), a2 + hstep, voffA);
            PG8_WAIT_V(8); PG8_WAIT_L(0); PG8_BAR; PG8_MMA(0, 0, At, B0); PG8_MMA(0, 1, At, B1); PG8_BAR; PG8_SCHED;
            PG8_LDA(At, 1, 1); PG8_STAGE(PG8_SB(1, 0), b3, voffB); PG8_STAGE(PG8_SB(1, 1), b3 + hstep, voffB); PG8_STAGE(PG8_SA(1, 0), a3, voffA);
            PG8_WAIT_V(8); PG8_WAIT_L(0); PG8_BAR; PG8_MMA(1, 0, At, B0); PG8_MMA(1, 1, At, B1); PG8_BAR; PG8_SCHED;
            } else {
            PG8_LDB(B0, 0, 0); PG8_SCHED; PG8_LDA(At, 0, 0); PG8_STAGE(PG8_SA(1, 1), a1 + hstep, voffA);
            PG8_WAIT_L(8); PG8_BAR; PG8_WAIT_L(0); PG8_MMA(0, 0, At, B0); PG8_BAR; PG8_SCHED;
            PG8_LDB(B1, 0, 1); PG8_STAGE(PG8_SB(0, 0), b2, voffB);
            PG8_BAR; PG8_WAIT_L(0); PG8_MMA(0, 1, At, B1); PG8_BAR;
            PG8_LDA(At, 0, 1); PG8_STAGE(PG8_SA(0, 0), a2, voffA);
            PG8_BAR; PG8_WAIT_L(0); PG8_MMA(1, 0, At, B0); PG8_BAR; PG8_SCHED;
            PG8_STAGE(PG8_SB(0, 1), b2 + hstep, voffB);
            PG8_WAIT_V(6); PG8_BAR; PG8_MMA(1, 1, At, B1); PG8_BAR;
            PG8_LDB(B0, 1, 0); PG8_SCHED; PG8_LDA(At, 1, 0); PG8_STAGE(PG8_SA(0, 1), a2 + hstep, voffA);
            PG8_WAIT_L(8); PG8_BAR; PG8_WAIT_L(0); PG8_MMA(0, 0, At, B0); PG8_BAR; PG8_SCHED;
            PG8_LDB(B1, 1, 1); PG8_STAGE(PG8_SB(1, 0), b3, voffB);
            PG8_BAR; PG8_WAIT_L(0); PG8_MMA(0, 1, At, B1); PG8_BAR;
            PG8_LDA(At, 1, 1); PG8_STAGE(PG8_SA(1, 0), a3, voffA);
            PG8_BAR; PG8_WAIT_L(0); PG8_MMA(1, 0, At, B0); PG8_BAR; PG8_SCHED;
            PG8_STAGE(PG8_SB(1, 1), b3 + hstep, voffB);
            PG8_WAIT_V(6); PG8_BAR; PG8_MMA(1, 1, At, B1); PG8_BAR;
            }
        }
        if constexpr (ALIGN_EPI) { if (wr == 0) PG8_BAR; }
        if constexpr (!Epi::AFTER_DRAIN) { E(acc, cur, wr, wc, fr, fq); S.done(cur); }
        if (!has_next) break;
#pragma unroll
        for (int a = 0; a < 2; ++a)
#pragma unroll
            for (int b = 0; b < 2; ++b)
#pragma unroll
                for (int m = 0; m < 4; ++m)
#pragma unroll
                    for (int n = 0; n < 2; ++n) acc[a][b][m][n] = (f32x4){0.f, 0.f, 0.f, 0.f};
        cur = nxt; cA = nA; cB = nB; ++ui;
        if constexpr (ALIGN_EPI) { if (wr == 1) PG8_BAR; }
    }
    PG8_WAIT_V(0);
    if constexpr (!ALIGN_EPI) { if (wr == 0) PG8_BAR; }
    PG8_BAR;
    if constexpr (Epi::AFTER_DRAIN) { E.fused(acc, cur, wr, wc, fr, fq, lds, wid, lane); S.done(cur); }
#undef PG8_SA
#undef PG8_SB
#undef PG8_STAGE
#undef PG8_LDA
#undef PG8_LDB
#undef PG8_MMA
#undef PG8_WAIT_V
#undef PG8_WAIT_L
#undef PG8_BAR
#undef PG8_SCHED
}
}

#define LAS __attribute__((address_space(3)))
__device__ __forceinline__ unsigned pk2(float lo, float hi) { return (unsigned)f2bf(lo) | ((unsigned)f2bf(hi) << 16); }
__device__ __forceinline__ void transpose_item(const float* W, int K, int N, bf16_t* WT, float* scr, int item, int lane) {
    const int nblk = N / 32, kb = item / nblk, nbk = item % nblk, k0 = 64 * kb, n0 = 32 * nbk;
#pragma unroll 8
    for (int i = 0; i < 32; ++i) { const int kk = 2 * i + (lane >> 5); scr[kk * 33 + (lane & 31)] = W[(size_t)(k0 + kk) * N + n0 + (lane & 31)]; }
    asm volatile("s_waitcnt lgkmcnt(0)" ::: "memory");
    const int c = lane & 7;
#pragma unroll
    for (int j = 0; j < 4; ++j) { const int n = (lane >> 3) + 8 * j; const float* s = scr + (8 * c) * 33 + n;
        uint4 o; o.x = pk2(s[0 * 33], s[1 * 33]); o.y = pk2(s[2 * 33], s[3 * 33]); o.z = pk2(s[4 * 33], s[5 * 33]); o.w = pk2(s[6 * 33], s[7 * 33]);
        *(uint4*)(WT + (size_t)(n0 + n) * K + k0 + 8 * c) = o; }
    asm volatile("s_waitcnt lgkmcnt(0)" ::: "memory");
}
__device__ __forceinline__ void phase_convert_weights(KP p, float* lds, int bid, int nb) {
    const int tid = opaque_tid(), lane = tid & 63, wave = tid >> 6;
    float* scr = lds + wave * (64 * 33);
    const int gw = bid * 8 + wave, ngw = nb * 8;
    constexpr int I_IN = (D / 64) * (NPROJ / 32), I_SQ = (D / 64) * (D / 32), I_G = 8 * (128 / 64) * (128 / 32);
    constexpr int NITEMS = I_IN + 2 * I_SQ + 2 * I_G;
    for (int it = gw; it < NITEMS; it += ngw) {
        int r = it;
        if (r < I_IN) { transpose_item(p->in[I_WIN], D, NPROJ, (bf16_t*)(p->ws + WS_WIN_T), scr, r, lane); continue; } r -= I_IN;
        if (r < I_SQ) { transpose_item(p->in[I_WOUT], D, D, (bf16_t*)(p->ws + WS_WOUT_T), scr, r, lane); continue; } r -= I_SQ;
        if (r < I_SQ) { transpose_item(p->in[I_WQ], D, D, (bf16_t*)(p->ws + WS_WQ_T), scr, r, lane); continue; } r -= I_SQ;
        if (r < I_G) { const int hd = r / 8; transpose_item(p->in[I_WGA] + hd * 16384, 128, 128, (bf16_t*)(p->ws + WS_WGA_T) + hd * 16384, scr, r % 8, lane); continue; } r -= I_G;
        { const int hd = r / 8; transpose_item(p->in[I_WGI] + hd * 16384, 128, 128, (bf16_t*)(p->ws + WS_WGI_T) + hd * 16384, scr, r % 8, lane); }
    }
    bf16_t* wsp = (bf16_t*)(p->ws + WS_WSPB); bf16_t* skb = (bf16_t*)(p->ws + WS_SKEYB);
    for (int e = bid * NT + tid; e < 8 * 128 * 128; e += nb * NT) { const int i = (e >> 7) & 127, j = e & 127; wsp[e] = f2bf(j <= i ? p->in[I_WSP][e] : 0.f); }
    for (int e = bid * NT + tid; e < 8 * 2 * 128 * 128; e += nb * NT) skb[e] = f2bf(p->in[I_SKEY][e]);
}

typedef short bf16x8_t __attribute__((ext_vector_type(8)));
typedef float f32x4_t __attribute__((ext_vector_type(4)));
typedef short s16x4_t __attribute__((ext_vector_type(4)));
constexpr int XA_STRIDE = 272;
constexpr int LRU_XA = 0, LRU_SA = 34816, LRU_SB = LRU_SA + 16384, LRU_SEGP = LRU_SB + 16384, LRU_SEGH = LRU_SEGP + 2048;
__device__ __forceinline__ void phase_lru(KP p, unsigned char* lds, int bid, int nb) {
    const int tid = opaque_tid(), lane = tid & 63, wave = tid >> 6, c16 = lane & 15, q = lane >> 4;
    const bf16_t* XL = (const bf16_t*)(p->ws + WS_PROJ); const bf16_t* YG = XL + (size_t)M * 1024; bf16_t* ymix = (bf16_t*)(p->ws + WS_YMIX);
    float* SA = (float*)(lds + LRU_SA); float* SB = (float*)(lds + LRU_SB); float* SEGP = (float*)(lds + LRU_SEGP); float* SEGH = (float*)(lds + LRU_SEGH);
    for (int unit = bid; unit < NB * 8 * 4; unit += nb) {
        const int b = unit >> 5, hd = (unit >> 2) & 7, cq = unit & 3;
        bf16x8_t wf[2][2][4];
#pragma unroll
        for (int gs = 0; gs < 2; ++gs)
#pragma unroll
            for (int nt = 0; nt < 2; ++nt)
#pragma unroll
                for (int ks = 0; ks < 4; ++ks)
                    wf[gs][nt][ks] = *(const bf16x8_t*)((const bf16_t*)(p->ws + (gs ? WS_WGI_T : WS_WGA_T)) + ((size_t)(hd * 128 + cq * 32 + nt * 16 + c16) * 128 + ks * 32 + 8 * q));
        float ba[2], bi[2], c2[2];
#pragma unroll
        for (int nt = 0; nt < 2; ++nt) { const int ch = hd * 128 + cq * 32 + nt * 16 + c16; ba[nt] = p->in[I_BGA][ch]; bi[nt] = p->in[I_BGI][ch];
            const float lam = p->in[I_LAM][ch]; const float sp = fmaxf(-lam, 0.f) + log1pf(__expf(-fabsf(lam))); c2[nt] = -8.f * sp * 1.4426950408889634f; }
        const int o = tid & 15, rg = tid >> 4;
        float cw[4][8], cb[8];
#pragma unroll
        for (int e = 0; e < 8; ++e) { cb[e] = p->in[I_CONVB][hd * 128 + o * 8 + e];
#pragma unroll
            for (int k = 0; k < 4; ++k) cw[k][e] = p->in[I_CONVW][k * DLRU + hd * 128 + o * 8 + e]; }
        const int sc = tid & 31, seg = tid >> 5;
        float carry = 0.f;
        for (int ch = 0; ch < SEQ / 128; ++ch) {
            const int t0 = ch * 128; const size_t row0 = (size_t)b * SEQ + t0;
            bf16_t yg[8];
#pragma unroll
            for (int k = 0; k < 8; ++k) yg[k] = YG[(row0 + seg * 8 + k) * 1024 + hd * 128 + cq * 32 + sc];
            uint4 xr[7];
#pragma unroll
            for (int i = 0; i < 7; ++i) { const int t = t0 + 4 * rg - 3 + i;
                xr[i] = t >= 0 ? *(const uint4*)(XL + ((size_t)b * SEQ + t) * 1024 + hd * 128 + o * 8) : make_uint4(0u, 0u, 0u, 0u); }
#pragma unroll
            for (int r = 0; r < 4; ++r) {
                float acc8[8];
#pragma unroll
                for (int e = 0; e < 8; ++e) acc8[e] = cb[e];
#pragma unroll
                for (int k = 0; k < 4; ++k) { const uint4 w = xr[r + k]; const unsigned ww[4] = {w.x, w.y, w.z, w.w};
#pragma unroll
                    for (int e2 = 0; e2 < 4; ++e2) { acc8[2 * e2] += cw[k][2 * e2] * __uint_as_float(ww[e2] << 16); acc8[2 * e2 + 1] += cw[k][2 * e2 + 1] * __uint_as_float(ww[e2] & 0xffff0000u); } }
                uint4 ov; ov.x = pk2(acc8[0], acc8[1]); ov.y = pk2(acc8[2], acc8[3]); ov.z = pk2(acc8[4], acc8[5]); ov.w = pk2(acc8[6], acc8[7]);
                *(uint4*)(lds + LRU_XA + (4 * rg + r) * XA_STRIDE + o * 16) = ov;
            }
            __syncthreads();
            f32x4_t acc[2][2];
#pragma unroll
            for (int gs = 0; gs < 2; ++gs)
#pragma unroll
                for (int nt = 0; nt < 2; ++nt) acc[gs][nt] = (f32x4_t){0.f, 0.f, 0.f, 0.f};
#pragma unroll
            for (int ks = 0; ks < 4; ++ks) {
                const bf16x8_t a = *(const bf16x8_t*)(lds + LRU_XA + (16 * wave + c16) * XA_STRIDE + (ks * 32 + 8 * q) * 2);
#pragma unroll
                for (int gs = 0; gs < 2; ++gs)
#pragma unroll
                    for (int nt = 0; nt < 2; ++nt) acc[gs][nt] = __builtin_amdgcn_mfma_f32_16x16x32_bf16(a, wf[gs][nt][ks], acc[gs][nt], 0, 0, 0);
            }
#pragma unroll
            for (int nt = 0; nt < 2; ++nt)
#pragma unroll
                for (int reg = 0; reg < 4; ++reg) {
                    const int t = 16 * wave + 4 * q + reg, jj = nt * 16 + c16;
                    const float za = acc[0][nt][reg] + ba[nt], zi = acc[1][nt][reg] + bi[nt];
                    const float r = __builtin_amdgcn_rcpf(1.f + __expf(-za)), ig = __builtin_amdgcn_rcpf(1.f + __expf(-zi));
                    const float a = __builtin_amdgcn_exp2f(c2[nt] * r);
                    const float xcv = bf2f(*(const bf16_t*)(lds + LRU_XA + t * XA_STRIDE + (cq * 32 + jj) * 2));
                    SA[t * 32 + jj] = a; SB[t * 32 + jj] = __builtin_amdgcn_sqrtf(fmaxf(1.f - a * a, 0.f)) * (ig * xcv);
                }
            __syncthreads();
            float av[8], bv[8];
#pragma unroll
            for (int k = 0; k < 8; ++k) { av[k] = SA[(seg * 8 + k) * 32 + sc]; bv[k] = SB[(seg * 8 + k) * 32 + sc]; }
            float P = 1.f, H = 0.f;
#pragma unroll
            for (int k = 0; k < 8; ++k) { H = av[k] * H + bv[k]; P *= av[k]; }
            SEGP[seg * 32 + sc] = P; SEGH[seg * 32 + sc] = H;
            __syncthreads();
            float run = carry, hin = carry;
#pragma unroll
            for (int s = 0; s < 16; ++s) { if (s == seg) hin = run; run = SEGP[s * 32 + sc] * run + SEGH[s * 32 + sc]; }
            carry = run;
            H = hin;
#pragma unroll
            for (int k = 0; k < 8; ++k) { H = av[k] * H + bv[k]; ymix[(row0 + seg * 8 + k) * D + hd * 128 + cq * 32 + sc] = f2bf(H * bf2f(yg[k])); }
        }
        __syncthreads();
    }
}

constexpr int SGU_RS = 0, SGU_TV = 512, SGU_SS = SGU_TV + 128 * XA_STRIDE, SS_STRIDE = 132;
__device__ __forceinline__ void phase_sgu(KP p, unsigned char* lds, int bid, int nb) {
    const int tid = opaque_tid(), lane = tid & 63, wave = tid >> 6, c16 = lane & 15, q = lane >> 4;
    const bf16_t* UG = (const bf16_t*)(p->ws + WS_PROJ) + (size_t)2 * M * 1024; const bf16_t* VG = UG + (size_t)M * 1024;
    const float* ssqv = (const float*)(p->ws + WS_SSQV); bf16_t* ymix = (bf16_t*)(p->ws + WS_YMIX);
    float* RS = (float*)(lds + SGU_RS); float* SS = (float*)(lds + SGU_SS);
    bf16x8_t wa[8][4]; float gvv[8]; int gcur = -1;
    const int oct = tid & 15;
    for (int it = bid; it < NB * 16 * 8; it += nb) {
        const int g = it & 7; const size_t base = (size_t)(it >> 3) * 128;
        if (g != gcur) { gcur = g;
#pragma unroll
            for (int mt = 0; mt < 8; ++mt)
#pragma unroll
                for (int ks = 0; ks < 4; ++ks) if (ks <= ((16 * mt + 15) >> 5))
                    wa[mt][ks] = *(const bf16x8_t*)((const bf16_t*)(p->ws + WS_WSPB) + ((size_t)(g * 128 + mt * 16 + c16) * 128 + ks * 32 + 8 * q));
#pragma unroll
            for (int e = 0; e < 8; ++e) gvv[e] = p->in[I_GV][g * 128 + oct * 8 + e]; }
        uint4 vch[4], uch[4];
#pragma unroll
        for (int k = 0; k < 4; ++k) { const int row = (tid >> 4) + 32 * k; vch[k] = *(const uint4*)(VG + (base + row) * 1024 + g * 128 + oct * 8); uch[k] = *(const uint4*)(UG + (base + row) * 1024 + g * 128 + oct * 8); }
        if (tid < 128) { float ss = 0.f;
#pragma unroll
            for (int k = 0; k < 16; ++k) ss += ssqv[(base + tid) * 16 + k];
            RS[tid] = rsqrtf(ss * (1.f / 1024.f) + EPS); }
        __syncthreads();
#pragma unroll
        for (int k = 0; k < 4; ++k) { const int row = (tid >> 4) + 32 * k; const float r = RS[row]; const unsigned ww[4] = {vch[k].x, vch[k].y, vch[k].z, vch[k].w}; unsigned oo[4];
#pragma unroll
            for (int e2 = 0; e2 < 4; ++e2) oo[e2] = pk2(__uint_as_float(ww[e2] << 16) * r * gvv[2 * e2], __uint_as_float(ww[e2] & 0xffff0000u) * r * gvv[2 * e2 + 1]);
            *(uint4*)(lds + SGU_TV + row * XA_STRIDE + oct * 16) = make_uint4(oo[0], oo[1], oo[2], oo[3]); }
        __syncthreads();
        bf16x8_t bfr[4];
        { const int q4 = c16 >> 2, p4 = c16 & 3;
#pragma unroll
          for (int ks = 0; ks < 4; ++ks) {
              const unsigned a1 = SGU_TV + (ks * 32 + 8 * q + q4) * XA_STRIDE + (wave * 16 + 4 * p4) * 2;
              const s16x4_t lo = __builtin_amdgcn_ds_read_tr16_b64_v4i16((LAS s16x4_t*)(lds + a1));
              const s16x4_t hi = __builtin_amdgcn_ds_read_tr16_b64_v4i16((LAS s16x4_t*)(lds + a1 + 4 * XA_STRIDE));
              bfr[ks] = __builtin_shufflevector(lo, hi, 0, 1, 2, 3, 4, 5, 6, 7); } }
        f32x4_t acc[8];
#pragma unroll
        for (int mt = 0; mt < 8; ++mt) { acc[mt] = (f32x4_t){0.f, 0.f, 0.f, 0.f};
#pragma unroll
            for (int ks = 0; ks < 4; ++ks) if (ks <= ((16 * mt + 15) >> 5)) acc[mt] = __builtin_amdgcn_mfma_f32_16x16x32_bf16(wa[mt][ks], bfr[ks], acc[mt], 0, 0, 0); }
#pragma unroll
        for (int mt = 0; mt < 8; ++mt)
#pragma unroll
            for (int reg = 0; reg < 4; ++reg) { const int i = mt * 16 + 4 * q + reg; SS[i * SS_STRIDE + wave * 16 + c16] = acc[mt][reg] + p->in[I_BSP][g * 128 + i]; }
        __syncthreads();
#pragma unroll
        for (int k = 0; k < 4; ++k) { const int row = (tid >> 4) + 32 * k; const float4 s0 = *(const float4*)(SS + row * SS_STRIDE + oct * 8), s1 = *(const float4*)(SS + row * SS_STRIDE + oct * 8 + 4);
            const unsigned ww[4] = {uch[k].x, uch[k].y, uch[k].z, uch[k].w}; const float sv[8] = {s0.x, s0.y, s0.z, s0.w, s1.x, s1.y, s1.z, s1.w}; unsigned oo[4];
#pragma unroll
            for (int e2 = 0; e2 < 4; ++e2) oo[e2] = pk2(__uint_as_float(ww[e2] << 16) * sv[2 * e2], __uint_as_float(ww[e2] & 0xffff0000u) * sv[2 * e2 + 1]);
            *(uint4*)(ymix + (base + row) * D + 1024 + g * 128 + oct * 8) = make_uint4(oo[0], oo[1], oo[2], oo[3]); }
        __syncthreads();
    }
}

__device__ __forceinline__ void wave_argmax(float& v, int& i) {
#pragma unroll
    for (int off = 32; off >= 1; off >>= 1) { const float ov = __shfl_xor(v, off); const int oi = __shfl_xor(i, off); if (ov > v || (ov == v && oi < i)) { v = ov; i = oi; } }
}
__device__ __forceinline__ void topk_half_naive(const bf16_t* q, const float* k0, int lane, float& outv, int& outi) {
    const float NEG = -3.0e38f;
    const float* k1 = k0 + 64 * 128;
    float s0 = 0.f, s1 = 0.f;
    for (int k = 0; k < 128; k += 4) {
        const uint2 qq = *(const uint2*)(q + k);
        const float q0 = bf2f((bf16_t)(qq.x & 0xffff)), q1 = bf2f((bf16_t)(qq.x >> 16)), q2 = bf2f((bf16_t)(qq.y & 0xffff)), q3 = bf2f((bf16_t)(qq.y >> 16));
        const float4 a = *(const float4*)(k0 + k), b = *(const float4*)(k1 + k);
        s0 += q0 * a.x + q1 * a.y + q2 * a.z + q3 * a.w; s1 += q0 * b.x + q1 * b.y + q2 * b.z + q3 * b.w;
    }
    float myv = NEG; int myi = 0;
    for (int r = 0; r < TOPK; ++r) {
        float v; int i; if (s0 >= s1) { v = s0; i = lane; } else { v = s1; i = lane + 64; }
        wave_argmax(v, i);
        if (i == lane) s0 = NEG; if (i == lane + 64) s1 = NEG;
        if (lane == r) { myv = v; myi = i; }
    }
    outv = myv; outi = myi;
}
__device__ __forceinline__ void phase_topk_naive(KP p, int bid, int nb) {
    const bf16_t* Q = (const bf16_t*)(p->ws + WS_Q); const float* keys = p->in[I_SKEY];
    int* idx = (int*)(p->ws + WS_IDX); float* gate = (float*)(p->ws + WS_GATE);
    const int tid = opaque_tid(), lane = tid & 63, wave = tid >> 6;
    const float NEG = -3.0e38f;
    for (int task = bid * 8 + wave; task < M * NHEAD; task += nb * 8) {
        const int token = task >> 3, hd = task & 7;
        float tv0, tv1; int ti0, ti1;
        topk_half_naive(Q + (size_t)token * D + hd * 256, keys + ((size_t)(hd * 2) * 128 + lane) * 128, lane, tv0, ti0);
        topk_half_naive(Q + (size_t)token * D + hd * 256 + 128, keys + ((size_t)(hd * 2 + 1) * 128 + lane) * 128, lane, tv1, ti1);
        const float vb = __shfl(tv1, lane & 15);
        float c0 = __shfl(tv0, (lane >> 4)) + vb, c1 = __shfl(tv0, (lane >> 4) + 4) + vb, c2 = __shfl(tv0, (lane >> 4) + 8) + vb, c3 = __shfl(tv0, (lane >> 4) + 12) + vb;
        float selv = NEG; int selc = 0;
        for (int r = 0; r < TOPK; ++r) {
            float v = c0; int i = lane;
            if (c1 > v) { v = c1; i = lane + 64; }
            if (c2 > v) { v = c2; i = lane + 128; }
            if (c3 > v) { v = c3; i = lane + 192; }
            wave_argmax(v, i);
            if (i == lane) c0 = NEG; if (i == lane + 64) c1 = NEG; if (i == lane + 128) c2 = NEG; if (i == lane + 192) c3 = NEG;
            if (lane == r) { selv = v; selc = i; }
        }
        const float mx = __shfl(selv, 0);
        const float e = lane < TOPK ? __expf(selv - mx) : 0.f;
        const float sum = wave_sum(e);
        const int i1 = __shfl(ti0, selc >> 4), i2 = __shfl(ti1, selc & 15);
        if (lane < TOPK) { idx[(size_t)token * NSEL + hd * TOPK + lane] = i1 * NKEYS + i2; gate[(size_t)token * NSEL + hd * TOPK + lane] = e / sum; }
    }
}

typedef _Float16 h2_t __attribute__((ext_vector_type(2)));
__device__ __forceinline__ unsigned pkh2(float lo, float hi) { h2_t v; v.x = (_Float16)lo; v.y = (_Float16)hi; return __builtin_bit_cast(unsigned, v); }
__device__ __forceinline__ float dot2h(unsigned a, unsigned b, float c) { return __builtin_amdgcn_fdot2(__builtin_bit_cast(h2_t, a), __builtin_bit_cast(h2_t, b), c, false); }
__device__ __forceinline__ void phase_convert_experts(KP p, int bid, int nb) {
    const size_t n8 = (size_t)NKEYS * NKEYS * D / 8; const int tid = opaque_tid();
    for (int t = 0; t < 2; ++t) {
        const float* src = t ? p->in[I_EV] : p->in[I_EU]; uint4* dst = (uint4*)(p->ws + (t ? WS_EV16 : WS_EU16));
        for (size_t i = (size_t)bid * NT + tid; i < n8; i += (size_t)nb * NT) {
            const float4 a = *(const float4*)(src + i * 8), b = *(const float4*)(src + i * 8 + 4);
            uint4 o; o.x = pkh2(a.x, a.y); o.y = pkh2(a.z, a.w); o.z = pkh2(b.x, b.y); o.w = pkh2(b.z, b.w);
            dst[i] = o;
        }
    }
}
__device__ __forceinline__ void phase_peer(KP p, float* lds, int bid, int nb) {
    const bf16_t* H = (const bf16_t*)(p->ws + WS_H); const int* idx = (const int*)(p->ws + WS_IDX); const float* gate = (const float*)(p->ws + WS_GATE);
    const unsigned char* EU = p->ws + WS_EU16; const unsigned char* EV = p->ws + WS_EV16; const float* gf = p->in[I_GFIN];
    const int tid = opaque_tid(), lane = tid & 63, wave = tid >> 6;
    for (int i = tid; i < NB * D; i += NT) lds[i] = mod_at(p, i >> 11, 5 * D + (i & (D - 1)));
    __syncthreads();
    for (int token = bid * 8 + wave; token < M; token += nb * 8) {
        unsigned hp[16];
#pragma unroll
        for (int j = 0; j < 4; ++j) { const uint4 w = *(const uint4*)(H + (size_t)token * D + lane * 8 + 512 * j);
            hp[4 * j + 0] = pkh2(__uint_as_float(w.x << 16), __uint_as_float(w.x & 0xffff0000u)); hp[4 * j + 1] = pkh2(__uint_as_float(w.y << 16), __uint_as_float(w.y & 0xffff0000u));
            hp[4 * j + 2] = pkh2(__uint_as_float(w.z << 16), __uint_as_float(w.z & 0xffff0000u)); hp[4 * j + 3] = pkh2(__uint_as_float(w.w << 16), __uint_as_float(w.w & 0xffff0000u)); }
        const int e0 = idx[(size_t)token * NSEL + lane], e1 = idx[(size_t)token * NSEL + 64 + lane];
        const float g0 = gate[(size_t)token * NSEL + lane], g1 = gate[(size_t)token * NSEL + 64 + lane];
        float act0 = 0.f, act1 = 0.f;
        for (int s = 0; s < NSEL; s += 4) {
            const int ee = s < 64 ? e0 : e1; const float gg = s < 64 ? g0 : g1; const int sl = s & 63;
            uint4 r[4][4];
#pragma unroll
            for (int k = 0; k < 4; ++k) { const int e = __builtin_amdgcn_readlane(ee, sl + k); const unsigned char* base = EU + (size_t)e * (D * 2) + lane * 16;
#pragma unroll
                for (int j = 0; j < 4; ++j) r[k][j] = *(const uint4*)(base + 1024 * j); }
#pragma unroll
            for (int k = 0; k < 4; ++k) { float d = 0.f;
#pragma unroll
                for (int j = 0; j < 4; ++j) { d = dot2h(hp[4 * j], r[k][j].x, d); d = dot2h(hp[4 * j + 1], r[k][j].y, d); d = dot2h(hp[4 * j + 2], r[k][j].z, d); d = dot2h(hp[4 * j + 3], r[k][j].w, d); }
                d = wave_sum(d);
                const float a = gelu_t(d) * __builtin_bit_cast(float, __builtin_amdgcn_readlane(__builtin_bit_cast(int, gg), sl + k));
                if (lane == sl + k) { if (s < 64) act0 = a; else act1 = a; } }
        }
        float acc[32];
#pragma unroll
        for (int j = 0; j < 32; ++j) acc[j] = 0.f;
        for (int s = 0; s < NSEL; s += 4) {
            const int ee = s < 64 ? e0 : e1; const float aa = s < 64 ? act0 : act1; const int sl = s & 63;
            uint4 r[4][4];
#pragma unroll
            for (int k = 0; k < 4; ++k) { const int e = __builtin_amdgcn_readlane(ee, sl + k); const unsigned char* base = EV + (size_t)e * (D * 2) + lane * 16;
#pragma unroll
                for (int j = 0; j < 4; ++j) r[k][j] = *(const uint4*)(base + 1024 * j); }
#pragma unroll
            for (int k = 0; k < 4; ++k) { const float a = __builtin_bit_cast(float, __builtin_amdgcn_readlane(__builtin_bit_cast(int, aa), sl + k));
#pragma unroll
                for (int j = 0; j < 4; ++j) { const unsigned w[4] = {r[k][j].x, r[k][j].y, r[k][j].z, r[k][j].w};
#pragma unroll
                    for (int c = 0; c < 4; ++c) { const h2_t v = __builtin_bit_cast(h2_t, w[c]); acc[8 * j + 2 * c] = fmaf((float)v.x, a, acc[8 * j + 2 * c]); acc[8 * j + 2 * c + 1] = fmaf((float)v.y, a, acc[8 * j + 2 * c + 1]); } } }
        }
        const float* gt = lds + (token / SEQ) * D;
        float ss = 0.f;
#pragma unroll
        for (int j = 0; j < 4; ++j)
#pragma unroll
            for (int hh = 0; hh < 2; ++hh) {
                const int col = lane * 8 + 512 * j + 4 * hh;
                const float4 x1 = *(const float4*)(p->out + (size_t)token * D + col); const float4 g4 = *(const float4*)(gt + col);
                float* a = acc + 8 * j + 4 * hh;
                a[0] = x1.x + g4.x * a[0]; a[1] = x1.y + g4.y * a[1]; a[2] = x1.z + g4.z * a[2]; a[3] = x1.w + g4.w * a[3];
                ss += a[0] * a[0] + a[1] * a[1] + a[2] * a[2] + a[3] * a[3];
            }
        const float rstd = rsqrtf(wave_sum(ss) * (1.f / D) + EPS);
#pragma unroll
        for (int j = 0; j < 4; ++j)
#pragma unroll
            for (int hh = 0; hh < 2; ++hh) {
                const int col = lane * 8 + 512 * j + 4 * hh;
                const float4 g4 = *(const float4*)(gf + col); const float* a = acc + 8 * j + 4 * hh;
                float4 o; o.x = a[0] * rstd * g4.x; o.y = a[1] * rstd * g4.y; o.z = a[2] * rstd * g4.z; o.w = a[3] * rstd * g4.w;
                *(float4*)(p->out + (size_t)token * D + col) = o;
            }
    }
}

extern __shared__ __attribute__((aligned(16))) unsigned char dyn_lds[];
constexpr int LDS_BYTES = 147456;
__global__ void __launch_bounds__(NT) fwd_megakernel(Params p_unused) {
    cg::grid_group grid = cg::this_grid();
    KP p = (KP)__builtin_amdgcn_kernarg_segment_ptr();
    float* lds = (float*)dyn_lds;
    const int bid = blockIdx.x, nb = gridDim.x;
    phase_mod(p, lds, bid, nb);
    __syncthreads();
    phase_convert_weights(p, lds, bid, nb);
    phase_convert_experts(p, bid, nb);
    grid.sync();
    phase_hrows(p, p->in[I_X], p->in[I_GMIX], 0, D, (bf16_t*)(p->ws + WS_H), lds, bid, nb);
    grid.sync();
    { pg8::Gemm g{(const bf16_t*)(p->ws + WS_H), (const bf16_t*)(p->ws + WS_WIN_T), M, NPROJ, D}; pg8::StaticOrder S; S.init(M, NPROJ, nb, bid);
      pg8::EpiProj E{(bf16_t*)(p->ws + WS_PROJ), (float*)(p->ws + WS_SSQV), M};
      pg8::gemm_phase<pg8::EpiProj, pg8::StaticOrder, true, true>((LAS unsigned char*)dyn_lds, g, S, E); }
    grid.sync();
    phase_lru(p, dyn_lds, bid, nb);
    phase_sgu(p, dyn_lds, bid, nb);
    grid.sync();
    { pg8::Gemm g{(const bf16_t*)(p->ws + WS_YMIX), (const bf16_t*)(p->ws + WS_WOUT_T), M, D, D}; pg8::StaticOrder S; S.init(M, D, nb, bid);
      pg8::EpiX1 E{p->in[I_X], p->out, (const float*)(p->ws + WS_MODP), p->in[I_BADA], 2 * D, NMOD, SEQ};
      pg8::gemm_phase<pg8::EpiX1, pg8::StaticOrder, true, true>((LAS unsigned char*)dyn_lds, g, S, E); }
    grid.sync();
    phase_hrows(p, p->out, p->in[I_GFFN], 3 * D, 4 * D, (bf16_t*)(p->ws + WS_H), lds, bid, nb);
    grid.sync();
    { pg8::Gemm g{(const bf16_t*)(p->ws + WS_H), (const bf16_t*)(p->ws + WS_WQ_T), M, D, D}; pg8::StaticOrder S; S.init(M, D, nb, bid);
      pg8::EpiQ E{(bf16_t*)(p->ws + WS_Q), D};
      pg8::gemm_phase<pg8::EpiQ, pg8::StaticOrder, true, true>((LAS unsigned char*)dyn_lds, g, S, E); }
    grid.sync();
    phase_topk_naive(p, bid, nb);
    grid.sync();
    phase_peer(p, lds, bid, nb);
}

extern "C" void kernel_launch(void* const* d_in, const int* in_sizes, int n_in, void* d_out, int out_size, void* d_ws, size_t ws_size, hipStream_t stream) {
    static int grid_blocks = 0;
    if (grid_blocks == 0) {
        if (n_in != 23 || in_sizes[0] != M * D || out_size != M * D || ws_size < WS_END) { fprintf(stderr, "kernel_launch: unexpected shapes (n_in %d in0 %d out %d ws %zu)\n", n_in, n_in > 0 ? in_sizes[0] : -1, out_size, ws_size); grid_blocks = -1; return; }
        if (hipFuncSetAttribute((const void*)fwd_megakernel, hipFuncAttributeMaxDynamicSharedMemorySize, LDS_BYTES) != hipSuccess) { fprintf(stderr, "hipFuncSetAttribute failed\n"); grid_blocks = -1; return; }
        int dev = 0, cus = 0, per_cu = 0;
        hipGetDevice(&dev);
        hipDeviceGetAttribute(&cus, hipDeviceAttributeMultiprocessorCount, dev);
        if (hipOccupancyMaxActiveBlocksPerMultiprocessor(&per_cu, (const void*)fwd_megakernel, NT, LDS_BYTES) != hipSuccess || per_cu < 1) { fprintf(stderr, "occupancy query failed (%d)\n", per_cu); grid_blocks = -1; return; }
        grid_blocks = cus;
    }
    if (grid_blocks < 0) return;
    Params p{};
    for (int i = 0; i < 23; ++i) p.in[i] = (const float*)d_in[i];
    p.out = (float*)d_out; p.ws = (unsigned char*)d_ws;
    void* args[] = {&p};
    hipError_t e = hipLaunchCooperativeKernel((const void*)fwd_megakernel, dim3(grid_blocks), dim3(NT), args, LDS_BYTES, stream);
    if (e != hipSuccess) fprintf(stderr, "cooperative launch failed: %s (grid %d)\n", hipGetErrorString(e), grid_blocks);
}
```

```cpp
#include <hip/hip_runtime.h>
#include <hip/hip_cooperative_groups.h>
#include <cstdio>
#include <cstdint>

constexpr int D = 2048, NB = 8, SEQ = 2048, M = NB * SEQ;
constexpr int DLRU = 1024, DSGU = 1024, NPROJ = 4096;
constexpr int NMOD = 6 * D;
constexpr int NHEAD = 8, NKEYS = 128, TOPK = 16, NSEL = NHEAD * TOPK;
constexpr float EPS = 1e-6f;
constexpr int NT = 512;
namespace cg = cooperative_groups;

constexpr size_t MiB = 1u << 20;
constexpr size_t WS_CTL = 0;
constexpr size_t WS_MODP = 1 * MiB;
constexpr size_t WS_WGA_T = 3 * MiB;
constexpr size_t WS_WGI_T = 3 * MiB + 262144;
constexpr size_t WS_WSPB = 3 * MiB + 524288;
constexpr size_t WS_SKEYB = 3 * MiB + 786432;
constexpr size_t WS_SSQV = 5 * MiB;
constexpr size_t WS_RSTDV = 8 * MiB;
constexpr size_t WS_WIN_T = 9 * MiB;
constexpr size_t WS_WOUT_T = 25 * MiB;
constexpr size_t WS_WQ_T = 33 * MiB;
constexpr size_t WS_IDX = 41 * MiB;
constexpr size_t WS_GATE = 49 * MiB;
constexpr size_t WS_H = 64 * MiB;
constexpr size_t WS_PROJ = 128 * MiB;
constexpr size_t WS_Q = 128 * MiB;
constexpr size_t WS_YMIX = 256 * MiB;
constexpr size_t WS_EU16 = 320 * MiB;
constexpr size_t WS_EV16 = 384 * MiB;
constexpr size_t WS_XC = 320 * MiB;
constexpr size_t WS_A = 384 * MiB;
constexpr size_t WS_BB = 448 * MiB;
constexpr size_t WS_END = 512 * MiB;

typedef unsigned short bf16_t;
struct Params { const float* in[23]; float* out; unsigned char* ws; };
typedef const __attribute__((address_space(4))) Params* KP;
enum { I_X = 0, I_C, I_WADA, I_BADA, I_GMIX, I_WIN, I_CONVW, I_CONVB, I_WGA, I_BGA, I_WGI, I_BGI, I_LAM, I_GV, I_WSP, I_BSP, I_WOUT, I_GFFN, I_WQ, I_SKEY, I_EU, I_EV, I_GFIN };

__device__ __forceinline__ int opaque_tid() { int t = threadIdx.x; asm volatile("" : "+v"(t)); return t; }
__device__ __forceinline__ float bf2f(bf16_t v) { return __uint_as_float(((unsigned)v) << 16); }
__device__ __forceinline__ bf16_t f2bf(float f) { unsigned u = __float_as_uint(f); u += 0x7fffu + ((u >> 16) & 1u); return (bf16_t)(u >> 16); }
__device__ __forceinline__ float sigmoidf_(float x) { return 1.f / (1.f + __expf(-x)); }
__device__ __forceinline__ float gelu_t(float x) { const float u = 0.7978845608028654f * (x + 0.044715f * x * x * x); return x * sigmoidf_(2.f * u); }
__device__ __forceinline__ float wave_sum(float v) {
#pragma unroll
    for (int o = 1; o < 64; o <<= 1) v += __shfl_xor(v, o);
    return v;
}
__device__ __forceinline__ float mod_at(KP p, int b, int n) {
    const float* mp = (const float*)(p->ws + WS_MODP);
    float s = p->in[I_BADA][n];
#pragma unroll
    for (int kc = 0; kc < 4; ++kc) s += mp[(size_t)(kc * 8 + b) * NMOD + n];
    return s;
}

__device__ __forceinline__ void phase_mod(KP p, float* lds, int bid, int nb) {
    const int tid = opaque_tid(), lane = tid & 63, wave = tid >> 6;
    const float* c = p->in[I_C]; const float* W = p->in[I_WADA];
    float* modp = (float*)(p->ws + WS_MODP);
    for (int i = tid; i < NB * D; i += NT) { const float v = c[i]; lds[i] = v * sigmoidf_(v); }
    __syncthreads();
    float* red = lds + NB * D;
    for (int item = bid; item < 192; item += nb) {
        const int nt = item % 48, kc = item / 48;
        const int n0 = nt * 256 + lane * 4, k0 = kc * 512 + wave * 64;
        float acc[8][4];
#pragma unroll
        for (int b = 0; b < 8; ++b)
#pragma unroll
            for (int j = 0; j < 4; ++j) acc[b][j] = 0.f;
        for (int kk = 0; kk < 64; ++kk) {
            const float4 w = *(const float4*)(W + (size_t)(k0 + kk) * NMOD + n0);
#pragma unroll
            for (int b = 0; b < 8; ++b) { const float s = lds[b * D + k0 + kk]; acc[b][0] += s * w.x; acc[b][1] += s * w.y; acc[b][2] += s * w.z; acc[b][3] += s * w.w; }
        }
#pragma unroll
        for (int b = 0; b < 8; ++b)
#pragma unroll
            for (int j = 0; j < 4; ++j) red[(wave * 32 + b * 4 + j) * 64 + lane] = acc[b][j];
        __syncthreads();
        for (int o = tid; o < 2048; o += NT) {
            const int b = o >> 8, nn = o & 255, ln = nn >> 2, j = nn & 3;
            float s = 0.f;
#pragma unroll
            for (int w = 0; w < 8; ++w) s += red[(w * 32 + b * 4 + j) * 64 + ln];
            modp[(size_t)(kc * 8 + b) * NMOD + nt * 256 + nn] = s;
        }
        __syncthreads();
    }
}

__device__ __forceinline__ void phase_hrows(KP p, const float* src, const float* gn, int shift_off, int scale_off, bf16_t* dst, float* lds, int bid, int nb) {
    const int tid = opaque_tid(), lane = tid & 63, wave = tid >> 6;
    float* Aw = lds; float* Bw = lds + D;
    for (int item = bid; item < M / 64; item += nb) {
        const int b = item / (SEQ / 64);
        for (int col = tid; col < D; col += NT) { Aw[col] = gn[col] * (1.f + mod_at(p, b, scale_off + col)); Bw[col] = mod_at(p, b, shift_off + col); }
        __syncthreads();
        for (int r = wave; r < 64; r += 8) {
            const size_t row = (size_t)item * 64 + r;
            float4 v[8]; float ss = 0.f;
#pragma unroll
            for (int j = 0; j < 8; ++j) { v[j] = *(const float4*)(src + row * D + lane * 4 + 256 * j); ss += v[j].x * v[j].x + v[j].y * v[j].y + v[j].z * v[j].z + v[j].w * v[j].w; }
            const float rstd = rsqrtf(wave_sum(ss) * (1.f / D) + EPS);
#pragma unroll
            for (int j = 0; j < 8; ++j) {
                const int col = lane * 4 + 256 * j;
                const float o0 = v[j].x * rstd * Aw[col] + Bw[col], o1 = v[j].y * rstd * Aw[col + 1] + Bw[col + 1];
                const float o2 = v[j].z * rstd * Aw[col + 2] + Bw[col + 2], o3 = v[j].w * rstd * Aw[col + 3] + Bw[col + 3];
                uint2 w; w.x = (unsigned)f2bf(o0) | ((unsigned)f2bf(o1) << 16); w.y = (unsigned)f2bf(o2) | ((unsigned)f2bf(o3) << 16);
                *(uint2*)(dst + row * D + col) = w;
            }
        }
        __syncthreads();
    }
}

namespace pg8 {
#define PG8_LAS __attribute__((address_space(3)))
typedef unsigned short bf16_t;
typedef short bf16x8 __attribute__((ext_vector_type(8)));
typedef float f32x4 __attribute__((ext_vector_type(4)));
typedef unsigned u32x4 __attribute__((ext_vector_type(4)));
constexpr int BM = 256, BK = 64, HALF = 128, HTB = HALF * BK * 2  , STAGE_BYTES = 8 * HTB, NXCD = 8, WGM = 8;

__host__ __device__ __forceinline__ int lds_byte(int r, int c) { const int st = (r >> 4) * 2 + (c >> 5), rr = r & 15, cc = c & 31, ob = rr * 64 + cc * 2; return st * 1024 + (ob ^ (((ob >> 9) & 1) << 5)); }
__host__ __device__ __forceinline__ void stage_rc(int b, int& R, int& C) { const int st = b / 1024, sb = b % 1024, swz = sb ^ (((sb >> 9) & 1) << 5); R = (st >> 1) * 16 + swz / 64; C = (st & 1) * 32 + (swz % 64) / 2; }
__host__ __device__ __forceinline__ int perm32(int rho) { const int n = rho >> 4, i = rho & 15; return 8 * (i >> 2) + 4 * n + (i & 3); }

struct Unit { int pm, pn; };
struct Gemm { const bf16_t* A; const bf16_t* Bt; int M, N, K; };

struct StaticOrder {
    int nM, nN, nwg, G, c;
    __host__ __device__ void init(int M, int N, int G_, int c_) { nM = M / BM; nN = N / BM; nwg = nM * nN; G = G_; c = c_; }
    __host__ __device__ bool next(int i, Unit& u) const {
        const long L = (long)i * G + c; if (L >= nwg) return false;
        int wgid = (int)L; { const int q = nwg / NXCD, r = nwg % NXCD, xcd = wgid % NXCD, off = wgid / NXCD; wgid = (xcd < r ? xcd * (q + 1) : r * (q + 1) + (xcd - r) * q) + off; }
        const int nig = WGM * nN, gid = wgid / nig, fm = gid * WGM, gsz = (nM - fm) < WGM ? (nM - fm) : WGM;
        u.pm = fm + ((wgid % nig) % gsz); u.pn = (wgid % nig) / gsz; return true;
    }
    __device__ __forceinline__ void a_ready(const Unit&) const {}
    __device__ __forceinline__ void done(const Unit&) const {}
};


__device__ __forceinline__ unsigned cvt_pk_bf16(float lo, float hi) { unsigned r; asm volatile("v_cvt_pk_bf16_f32 %0, %1, %2" : "=v"(r) : "v"(lo), "v"(hi)); return r; }
__device__ __forceinline__ float gelu_tanh(float x) { const float u = 1.5957691216057308f * (x + 0.044715f * x * x * x); return x * __builtin_amdgcn_rcpf(1.f + __expf(-u)); }
struct EpiProj {
    static constexpr bool PERM = true, AFTER_DRAIN = false;
    bf16_t* proj; float* ssqv; int Mrows;
    __device__ __forceinline__ void operator()(const f32x4 (&acc)[2][2][4][2], const Unit& u, int wr, int wc, int fr, int fq) const {
        const int which = (u.pn * BM) >> 10, colt = (u.pn * BM) & 1023;
        bf16_t* base = proj + (size_t)which * Mrows * 1024;
        const int row0 = u.pm * BM + wr * 64 + fr, col0 = colt + wc * 32 + 8 * fq;
#pragma unroll
        for (int ai = 0; ai < 2; ++ai)
#pragma unroll
            for (int m = 0; m < 4; ++m) { const int row = row0 + ai * HALF + m * 16; bf16_t* rowp = base + (size_t)row * 1024 + col0; float ss = 0.f;
#pragma unroll
                for (int bj = 0; bj < 2; ++bj) { f32x4 v0 = acc[ai][bj][m][0], v1 = acc[ai][bj][m][1];
                    if (which) {
#pragma unroll
                        for (int j = 0; j < 4; ++j) { v0[j] = gelu_tanh(v0[j]); v1[j] = gelu_tanh(v1[j]); } }
                    ss += (v0[0] * v0[0] + v0[1] * v0[1]) + (v0[2] * v0[2] + v0[3] * v0[3]) + (v1[0] * v1[0] + v1[1] * v1[1]) + (v1[2] * v1[2] + v1[3] * v1[3]);
                    u32x4 w; w.x = cvt_pk_bf16(v0[0], v0[1]); w.y = cvt_pk_bf16(v0[2], v0[3]); w.z = cvt_pk_bf16(v1[0], v1[1]); w.w = cvt_pk_bf16(v1[2], v1[3]);
                    *(u32x4*)(rowp + bj * HALF) = w; }
                if (which == 3) { ss += __shfl_xor(ss, 16); ss += __shfl_xor(ss, 32); if (fq == 0) ssqv[(size_t)row * 16 + (u.pn & 3) * 4 + wc] = ss; } }
    }
};
struct EpiX1 {
    static constexpr bool PERM = false, AFTER_DRAIN = false;
    const float* x; float* out; const float* modp; const float* bada; int goff, nmod, seq;
    __device__ __forceinline__ void operator()(const f32x4 (&acc)[2][2][4][2], const Unit& u, int wr, int wc, int fr, int fq) const {
        const int row0 = u.pm * BM + wr * 64 + fr, col0 = u.pn * BM + wc * 32 + 4 * fq, b = (u.pm * BM) / seq;
        f32x4 gv[2][2];
#pragma unroll
        for (int bj = 0; bj < 2; ++bj)
#pragma unroll
            for (int n = 0; n < 2; ++n) { const int c = goff + col0 + bj * HALF + n * 16; f32x4 g = *(const f32x4*)(bada + c);
#pragma unroll
                for (int kc = 0; kc < 4; ++kc) g += *(const f32x4*)(modp + (size_t)(kc * 8 + b) * nmod + c);
                gv[bj][n] = g; }
#pragma unroll
        for (int ai = 0; ai < 2; ++ai)
#pragma unroll
            for (int m = 0; m < 4; ++m) { const size_t off = (size_t)(row0 + ai * HALF + m * 16) * (size_t)(2048) + col0;
#pragma unroll
                for (int bj = 0; bj < 2; ++bj)
#pragma unroll
                    for (int n = 0; n < 2; ++n) { const f32x4 xv = *(const f32x4*)(x + off + bj * HALF + n * 16); *(f32x4*)(out + off + bj * HALF + n * 16) = xv + gv[bj][n] * acc[ai][bj][m][n]; } }
    }
};
struct EpiQ {
    static constexpr bool PERM = true, AFTER_DRAIN = false;
    bf16_t* O; int ldc;
    __device__ __forceinline__ void operator()(const f32x4 (&acc)[2][2][4][2], const Unit& u, int wr, int wc, int fr, int fq) const {
        const int row0 = u.pm * BM + wr * 64 + fr, col0 = u.pn * BM + wc * 32 + 8 * fq;
#pragma unroll
        for (int ai = 0; ai < 2; ++ai)
#pragma unroll
            for (int m = 0; m < 4; ++m) { bf16_t* rowp = O + (size_t)(row0 + ai * HALF + m * 16) * ldc + col0;
#pragma unroll
                for (int bj = 0; bj < 2; ++bj) { const f32x4 v0 = acc[ai][bj][m][0], v1 = acc[ai][bj][m][1];
                    u32x4 w; w.x = cvt_pk_bf16(v0[0], v0[1]); w.y = cvt_pk_bf16(v0[2], v0[3]); w.z = cvt_pk_bf16(v1[0], v1[1]); w.w = cvt_pk_bf16(v1[2], v1[3]);
                    *(u32x4*)(rowp + bj * HALF) = w; } }
    }
};

template <class Epi, class Sched, bool ALIGN_EPI = false, bool SP2 = false>
__device__ __forceinline__ void gemm_phase(PG8_LAS unsigned char* lds, const Gemm g, const Sched& S, const Epi& E) {
    const int tid = opaque_tid(), wid = __builtin_amdgcn_readfirstlane(tid >> 6), lane = tid & 63, wr = wid >> 2, wc = wid & 3, fr = lane & 15, fq = lane >> 4;
    const int K = g.K, nt = K / BK;
    unsigned voffA[2], voffB[2];
#pragma unroll
    for (int i = 0; i < 2; ++i) { int R, C; stage_rc(tid * 16 + i * 8192, R, C); const int Rb = Epi::PERM ? ((R & ~31) + perm32(R & 31)) : R;
        voffA[i] = (unsigned)(R * K + C) * 2u; voffB[i] = (unsigned)(Rb * K + C) * 2u; }
    const size_t kstep = (size_t)(BK * 2);
    const size_t hstep = (size_t)HALF * K * 2;
    const size_t tstep = 2 * hstep;
    const unsigned ldsw = (unsigned)wid * 1024u;
    const int aoff = lds_byte(wr * 64 + fr, fq * 8), boff = lds_byte(wc * 32 + fr, fq * 8);
#define PG8_SA(b, h) (((b) * 2 + (h)) * HTB)
#define PG8_SB(b, h) ((4 + (b) * 2 + (h)) * HTB)
#define PG8_STAGE(bufoff, gbase, voff) do { _Pragma("unroll") for (int _i = 0; _i < 2; ++_i) \
        __builtin_amdgcn_global_load_lds((const unsigned*)((const char*)(gbase) + (voff)[_i]), (PG8_LAS unsigned*)(lds + (bufoff) + ldsw + _i * 8192), 16, 0, 0); } while (0)
#define PG8_LDA(dst, b, h) do { _Pragma("unroll") for (int m = 0; m < 4; ++m) _Pragma("unroll") for (int k = 0; k < 2; ++k) dst[m][k] = *(const PG8_LAS bf16x8*)(lds + PG8_SA(b, h) + aoff + m * 2048 + k * 1024); } while (0)
#define PG8_LDB(dst, b, h) do { _Pragma("unroll") for (int n = 0; n < 2; ++n) _Pragma("unroll") for (int k = 0; k < 2; ++k) dst[n][k] = *(const PG8_LAS bf16x8*)(lds + PG8_SB(b, h) + boff + n * 2048 + k * 1024); } while (0)
#define PG8_MMA(ai, bj, At, Bt) do { __builtin_amdgcn_s_setprio(1); _Pragma("unroll") for (int m = 0; m < 4; ++m) _Pragma("unroll") for (int n = 0; n < 2; ++n) _Pragma("unroll") for (int k = 0; k < 2; ++k) \
        acc[ai][bj][m][n] = __builtin_amdgcn_mfma_f32_16x16x32_bf16(Bt[n][k], At[m][k], acc[ai][bj][m][n], 0, 0, 0); __builtin_amdgcn_s_setprio(0); } while (0)
#define PG8_WAIT_V(n) asm volatile("s_waitcnt vmcnt(" #n ")" ::: "memory")
#define PG8_WAIT_L(n) asm volatile("s_waitcnt lgkmcnt(" #n ")" ::: "memory")
#define PG8_BAR __builtin_amdgcn_s_barrier()
#define PG8_SCHED __builtin_amdgcn_sched_barrier(0)
    Unit cur, nxt; int ui = 0;
    if (!S.next(0, cur)) return;
    f32x4 acc[2][2][4][2];
#pragma unroll
    for (int a = 0; a < 2; ++a)
#pragma unroll
        for (int b = 0; b < 2; ++b)
#pragma unroll
            for (int m = 0; m < 4; ++m)
#pragma unroll
                for (int n = 0; n < 2; ++n) acc[a][b][m][n] = (f32x4){0.f, 0.f, 0.f, 0.f};
    bf16x8 At[4][2], B0[2][2], B1[2][2];
    const char* cA = (const char*)g.A + (size_t)cur.pm * tstep; const char* cB = (const char*)g.Bt + (size_t)cur.pn * tstep;
    S.a_ready(cur);
    if constexpr (SP2) {
        PG8_STAGE(PG8_SB(0, 0), cB, voffB); PG8_STAGE(PG8_SB(0, 1), cB + hstep, voffB); PG8_STAGE(PG8_SA(0, 0), cA, voffA); PG8_STAGE(PG8_SA(0, 1), cA + hstep, voffA);
        if (wr == 1) PG8_BAR;
        PG8_WAIT_V(2); PG8_BAR;
        PG8_STAGE(PG8_SB(1, 0), cB + kstep, voffB); PG8_STAGE(PG8_SA(1, 0), cA + kstep, voffA); PG8_STAGE(PG8_SB(1, 1), cB + hstep + kstep, voffB);
        PG8_WAIT_V(6); PG8_BAR;
    } else {
        PG8_STAGE(PG8_SB(0, 0), cB, voffB); PG8_STAGE(PG8_SA(0, 0), cA, voffA); PG8_STAGE(PG8_SB(0, 1), cB + hstep, voffB); PG8_STAGE(PG8_SA(0, 1), cA + hstep, voffA);
        if (wr == 1) PG8_BAR;
        PG8_WAIT_V(4); PG8_BAR;
        PG8_STAGE(PG8_SB(1, 0), cB + kstep, voffB); PG8_STAGE(PG8_SA(1, 0), cA + kstep, voffA); PG8_STAGE(PG8_SB(1, 1), cB + hstep + kstep, voffB);
        PG8_WAIT_V(6); PG8_BAR;
    }
    for (;;) {
        const bool has_next = S.next(ui + 1, nxt);
        const char* nA = has_next ? (const char*)g.A + (size_t)nxt.pm * tstep : cA; const char* nB = has_next ? (const char*)g.Bt + (size_t)nxt.pn * tstep : cB;
        for (int t = 0; t < nt; t += 2) {
            const bool last = (t == nt - 2);
            const char* a1 = cA + (size_t)(t + 1) * kstep;
            const char* a2 = last ? nA : cA + (size_t)(t + 2) * kstep; const char* b2 = last ? nB : cB + (size_t)(t + 2) * kstep;
            const char* a3 = a2 + kstep; const char* b3 = b2 + kstep;
            if (last && has_next) S.a_ready(nxt);
            if constexpr (SP2) {
            PG8_LDB(B0, 0, 0); PG8_LDB(B1, 0, 1); PG8_SCHED; PG8_LDA(At, 0, 0); PG8_STAGE(PG8_SA(1, 1), a1 + hstep, voffA);
            PG8_WAIT_V(8); PG8_WAIT_L(0); PG8_BAR; PG8_MMA(0, 0, At, B0); PG8_MMA(0, 1, At, B1); PG8_BAR; PG8_SCHED;
            PG8_LDA(At, 0, 1); PG8_STAGE(PG8_SB(0, 0), b2, voffB); PG8_STAGE(PG8_SB(0, 1), b2 + hstep, voffB); PG8_STAGE(PG8_SA(0, 0), a2, voffA);
            PG8_WAIT_V(8); PG8_WAIT_L(0); PG8_BAR; PG8_MMA(1, 0, At, B0); PG8_MMA(1, 1, At, B1); PG8_BAR; PG8_SCHED;
            PG8_LDB(B0, 1, 0); PG8_LDB(B1, 1, 1); PG8_SCHED; PG8_LDA(At, 1, 0); PG8_STAGE(PG8_SA(0, 1), a2 + hstep, voffA);
            PG8_WAIT_V(8); PG8_WAIT_L(0); PG8_BAR; PG8_MMA(0, 0, At, B0); PG8_MMA(0, 1, At, B1); PG8_BAR; PG8_SCHED;
            PG8_LDA(At, 1, 1); PG8_STAGE(PG8_SB(1, 0), b3, voffB); PG8_STAGE(PG8_SB(1, 1), b3 + hstep, voffB); PG8_STAGE(PG8_SA(1, 0), a3, voffA);
            PG8_WAIT_V(8); PG8_WAIT_L(0); PG8_BAR; PG8_MMA(1, 0, At, B0); PG8_MMA(1, 1, At, B1); PG8_BAR; PG8_SCHED;
            } else {
            PG8_LDB(B0, 0, 0); PG8_SCHED; PG8_LDA(At, 0, 0); PG8_STAGE(PG8_SA(1, 1), a1 + hstep, voffA);
            PG8_WAIT_L(8); PG8_BAR; PG8_WAIT_L(0); PG8_MMA(0, 0, At, B0); PG8_BAR; PG8_SCHED;
            PG8_LDB(B1, 0, 1); PG8_STAGE(PG8_SB(0, 0), b2, voffB);
            PG8_BAR; PG8_WAIT_L(0); PG8_MMA(0, 1, At, B1); PG8_BAR;
            PG8_LDA(At, 0, 1); PG8_STAGE(PG8_SA(0, 0), a2, voffA);
            PG8_BAR; PG8_WAIT_L(0); PG8_MMA(1, 0, At, B0); PG8_BAR; PG8_SCHED;
            PG8_STAGE(PG8_SB(0, 1), b2 + hstep, voffB);
            PG8_WAIT_V(6); PG8_BAR; PG8_MMA(1, 1, At, B1); PG8_BAR;
            PG8_LDB(B0, 1, 0); PG8_SCHED; PG8_LDA(At, 1, 0); PG8_STAGE(PG8_SA(0, 1), a2 + hstep, voffA);
            PG8_WAIT_L(8); PG8_BAR; PG8_WAIT_L(0); PG8_MMA(0, 0, At, B0); PG8_BAR; PG8_SCHED;
            PG8_LDB(B1, 1, 1); PG8_STAGE(PG8_SB(1, 0), b3, voffB);
            PG8_BAR; PG8_WAIT_L(0); PG8_MMA(0, 1, At, B1); PG8_BAR;
            PG8_LDA(At, 1, 1); PG8_STAGE(PG8_SA(1, 0), a3, voffA);
            PG8_BAR; PG8_WAIT_L(0); PG8_MMA(1, 0, At, B0); PG8_BAR; PG8_SCHED;
            PG8_STAGE(PG8_SB(1, 1), b3 + hstep, voffB);
            PG8_WAIT_V(6); PG8_BAR; PG8_MMA(1, 1, At, B1); PG8_BAR;
            }
        }
        if constexpr (ALIGN_EPI) { if (wr == 0) PG8_BAR; }
        if constexpr (!Epi::AFTER_DRAIN) { E(acc, cur, wr, wc, fr, fq); S.done(cur); }
        if (!has_next) break;
#pragma unroll
        for (int a = 0; a < 2; ++a)
#pragma unroll
            for (int b = 0; b < 2; ++b)
#pragma unroll
                for (int m = 0; m < 4; ++m)
#pragma unroll
                    for (int n = 0; n < 2; ++n) acc[a][b][m][n] = (f32x4){0.f, 0.f, 0.f, 0.f};
        cur = nxt; cA = nA; cB = nB; ++ui;
        if constexpr (ALIGN_EPI) { if (wr == 1) PG8_BAR; }
    }
    PG8_WAIT_V(0);
    if constexpr (!ALIGN_EPI) { if (wr == 0) PG8_BAR; }
    PG8_BAR;
    if constexpr (Epi::AFTER_DRAIN) { E.fused(acc, cur, wr, wc, fr, fq, lds, wid, lane); S.done(cur); }
#undef PG8_SA
#undef PG8_SB
#undef PG8_STAGE
#undef PG8_LDA
#undef PG8_LDB
#undef PG8_MMA
#undef PG8_WAIT_V
#undef PG8_WAIT_L
#undef PG8_BAR
#undef PG8_SCHED
}
}

#define LAS __attribute__((address_space(3)))
__device__ __forceinline__ unsigned pk2(float lo, float hi) { return (unsigned)f2bf(lo) | ((unsigned)f2bf(hi) << 16); }
__device__ __forceinline__ void transpose_item(const float* W, int K, int N, bf16_t* WT, float* scr, int item, int lane) {
    const int nblk = N / 32, kb = item / nblk, nbk = item % nblk, k0 = 64 * kb, n0 = 32 * nbk;
#pragma unroll 8
    for (int i = 0; i < 32; ++i) { const int kk = 2 * i + (lane >> 5); scr[kk * 33 + (lane & 31)] = W[(size_t)(k0 + kk) * N + n0 + (lane & 31)]; }
    asm volatile("s_waitcnt lgkmcnt(0)" ::: "memory");
    const int c = lane & 7;
#pragma unroll
    for (int j = 0; j < 4; ++j) { const int n = (lane >> 3) + 8 * j; const float* s = scr + (8 * c) * 33 + n;
        uint4 o; o.x = pk2(s[0 * 33], s[1 * 33]); o.y = pk2(s[2 * 33], s[3 * 33]); o.z = pk2(s[4 * 33], s[5 * 33]); o.w = pk2(s[6 * 33], s[7 * 33]);
        *(uint4*)(WT + (size_t)(n0 + n) * K + k0 + 8 * c) = o; }
    asm volatile("s_waitcnt lgkmcnt(0)" ::: "memory");
}
__device__ __forceinline__ void phase_convert_weights(KP p, float* lds, int bid, int nb) {
    const int tid = opaque_tid(), lane = tid & 63, wave = tid >> 6;
    float* scr = lds + wave * (64 * 33);
    const int gw = bid * 8 + wave, ngw = nb * 8;
    constexpr int I_IN = (D / 64) * (NPROJ / 32), I_SQ = (D / 64) * (D / 32), I_G = 8 * (128 / 64) * (128 / 32);
    constexpr int NITEMS = I_IN + 2 * I_SQ + 2 * I_G;
    for (int it = gw; it < NITEMS; it += ngw) {
        int r = it;
        if (r < I_IN) { transpose_item(p->in[I_WIN], D, NPROJ, (bf16_t*)(p->ws + WS_WIN_T), scr, r, lane); continue; } r -= I_IN;
        if (r < I_SQ) { transpose_item(p->in[I_WOUT], D, D, (bf16_t*)(p->ws + WS_WOUT_T), scr, r, lane); continue; } r -= I_SQ;
        if (r < I_SQ) { transpose_item(p->in[I_WQ], D, D, (bf16_t*)(p->ws + WS_WQ_T), scr, r, lane); continue; } r -= I_SQ;
        if (r < I_G) { const int hd = r / 8; transpose_item(p->in[I_WGA] + hd * 16384, 128, 128, (bf16_t*)(p->ws + WS_WGA_T) + hd * 16384, scr, r % 8, lane); continue; } r -= I_G;
        { const int hd = r / 8; transpose_item(p->in[I_WGI] + hd * 16384, 128, 128, (bf16_t*)(p->ws + WS_WGI_T) + hd * 16384, scr, r % 8, lane); }
    }
    bf16_t* wsp = (bf16_t*)(p->ws + WS_WSPB); bf16_t* skb = (bf16_t*)(p->ws + WS_SKEYB);
    for (int e = bid * NT + tid; e < 8 * 128 * 128; e += nb * NT) { const int i = (e >> 7) & 127, j = e & 127; wsp[e] = f2bf(j <= i ? p->in[I_WSP][e] : 0.f); }
    for (int e = bid * NT + tid; e < 8 * 2 * 128 * 128; e += nb * NT) skb[e] = f2bf(p->in[I_SKEY][e]);
}

typedef short bf16x8_t __attribute__((ext_vector_type(8)));
typedef float f32x4_t __attribute__((ext_vector_type(4)));
typedef short s16x4_t __attribute__((ext_vector_type(4)));
constexpr int XA_STRIDE = 272;
constexpr int LRU_XA = 0, LRU_SA = 34816, LRU_SB = LRU_SA + 16384, LRU_SEGP = LRU_SB + 16384, LRU_SEGH = LRU_SEGP + 2048;
__device__ __forceinline__ void phase_lru(KP p, unsigned char* lds, int bid, int nb) {
    const int tid = opaque_tid(), lane = tid & 63, wave = tid >> 6, c16 = lane & 15, q = lane >> 4;
    const bf16_t* XL = (const bf16_t*)(p->ws + WS_PROJ); const bf16_t* YG = XL + (size_t)M * 1024; bf16_t* ymix = (bf16_t*)(p->ws + WS_YMIX);
    float* SA = (float*)(lds + LRU_SA); float* SB = (float*)(lds + LRU_SB); float* SEGP = (float*)(lds + LRU_SEGP); float* SEGH = (float*)(lds + LRU_SEGH);
    for (int unit = bid; unit < NB * 8 * 4; unit += nb) {
        const int b = unit >> 5, hd = (unit >> 2) & 7, cq = unit & 3;
        bf16x8_t wf[2][2][4];
#pragma unroll
        for (int gs = 0; gs < 2; ++gs)
#pragma unroll
            for (int nt = 0; nt < 2; ++nt)
#pragma unroll
                for (int ks = 0; ks < 4; ++ks)
                    wf[gs][nt][ks] = *(const bf16x8_t*)((const bf16_t*)(p->ws + (gs ? WS_WGI_T : WS_WGA_T)) + ((size_t)(hd * 128 + cq * 32 + nt * 16 + c16) * 128 + ks * 32 + 8 * q));
        float ba[2], bi[2], c2[2];
#pragma unroll
        for (int nt = 0; nt < 2; ++nt) { const int ch = hd * 128 + cq * 32 + nt * 16 + c16; ba[nt] = p->in[I_BGA][ch]; bi[nt] = p->in[I_BGI][ch];
            const float lam = p->in[I_LAM][ch]; const float sp = fmaxf(-lam, 0.f) + log1pf(__expf(-fabsf(lam))); c2[nt] = -8.f * sp * 1.4426950408889634f; }
        const int o = tid & 15, rg = tid >> 4;
        float cw[4][8], cb[8];
#pragma unroll
        for (int e = 0; e < 8; ++e) { cb[e] = p->in[I_CONVB][hd * 128 + o * 8 + e];
#pragma unroll
            for (int k = 0; k < 4; ++k) cw[k][e] = p->in[I_CONVW][k * DLRU + hd * 128 + o * 8 + e]; }
        const int sc = tid & 31, seg = tid >> 5;
        float carry = 0.f;
        for (int ch = 0; ch < SEQ / 128; ++ch) {
            const int t0 = ch * 128; const size_t row0 = (size_t)b * SEQ + t0;
            bf16_t yg[8];
#pragma unroll
            for (int k = 0; k < 8; ++k) yg[k] = YG[(row0 + seg * 8 + k) * 1024 + hd * 128 + cq * 32 + sc];
            uint4 xr[7];
#pragma unroll
            for (int i = 0; i < 7; ++i) { const int t = t0 + 4 * rg - 3 + i;
                xr[i] = t >= 0 ? *(const uint4*)(XL + ((size_t)b * SEQ + t) * 1024 + hd * 128 + o * 8) : make_uint4(0u, 0u, 0u, 0u); }
#pragma unroll
            for (int r = 0; r < 4; ++r) {
                float acc8[8];
#pragma unroll
                for (int e = 0; e < 8; ++e) acc8[e] = cb[e];
#pragma unroll
                for (int k = 0; k < 4; ++k) { const uint4 w = xr[r + k]; const unsigned ww[4] = {w.x, w.y, w.z, w.w};
#pragma unroll
                    for (int e2 = 0; e2 < 4; ++e2) { acc8[2 * e2] += cw[k][2 * e2] * __uint_as_float(ww[e2] << 16); acc8[2 * e2 + 1] += cw[k][2 * e2 + 1] * __uint_as_float(ww[e2] & 0xffff0000u); } }
                uint4 ov; ov.x = pk2(acc8[0], acc8[1]); ov.y = pk2(acc8[2], acc8[3]); ov.z = pk2(acc8[4], acc8[5]); ov.w = pk2(acc8[6], acc8[7]);
                *(uint4*)(lds + LRU_XA + (4 * rg + r) * XA_STRIDE + o * 16) = ov;
            }
            __syncthreads();
            f32x4_t acc[2][2];
#pragma unroll
            for (int gs = 0; gs < 2; ++gs)
#pragma unroll
                for (int nt = 0; nt < 2; ++nt) acc[gs][nt] = (f32x4_t){0.f, 0.f, 0.f, 0.f};
#pragma unroll
            for (int ks = 0; ks < 4; ++ks) {
                const bf16x8_t a = *(const bf16x8_t*)(lds + LRU_XA + (16 * wave + c16) * XA_STRIDE + (ks * 32 + 8 * q) * 2);
#pragma unroll
                for (int gs = 0; gs < 2; ++gs)
#pragma unroll
                    for (int nt = 0; nt < 2; ++nt) acc[gs][nt] = __builtin_amdgcn_mfma_f32_16x16x32_bf16(a, wf[gs][nt][ks], acc[gs][nt], 0, 0, 0);
            }
#pragma unroll
            for (int nt = 0; nt < 2; ++nt)
#pragma unroll
                for (int reg = 0; reg < 4; ++reg) {
                    const int t = 16 * wave + 4 * q + reg, jj = nt * 16 + c16;
                    const float za = acc[0][nt][reg] + ba[nt], zi = acc[1][nt][reg] + bi[nt];
                    const float r = __builtin_amdgcn_rcpf(1.f + __expf(-za)), ig = __builtin_amdgcn_rcpf(1.f + __expf(-zi));
                    const float a = __builtin_amdgcn_exp2f(c2[nt] * r);
                    const float xcv = bf2f(*(const bf16_t*)(lds + LRU_XA + t * XA_STRIDE + (cq * 32 + jj) * 2));
                    SA[t * 32 + jj] = a; SB[t * 32 + jj] = __builtin_amdgcn_sqrtf(fmaxf(1.f - a * a, 0.f)) * (ig * xcv);
                }
            __syncthreads();
            float av[8], bv[8];
#pragma unroll
            for (int k = 0; k < 8; ++k) { av[k] = SA[(seg * 8 + k) * 32 + sc]; bv[k] = SB[(seg * 8 + k) * 32 + sc]; }
            float P = 1.f, H = 0.f;
#pragma unroll
            for (int k = 0; k < 8; ++k) { H = av[k] * H + bv[k]; P *= av[k]; }
            SEGP[seg * 32 + sc] = P; SEGH[seg * 32 + sc] = H;
            __syncthreads();
            float run = carry, hin = carry;
#pragma unroll
            for (int s = 0; s < 16; ++s) { if (s == seg) hin = run; run = SEGP[s * 32 + sc] * run + SEGH[s * 32 + sc]; }
            carry = run;
            H = hin;
#pragma unroll
            for (int k = 0; k < 8; ++k) { H = av[k] * H + bv[k]; ymix[(row0 + seg * 8 + k) * D + hd * 128 + cq * 32 + sc] = f2bf(H * bf2f(yg[k])); }
        }
        __syncthreads();
    }
}

constexpr int SGU_RS = 0, SGU_TV = 512, SGU_SS = SGU_TV + 128 * XA_STRIDE, SS_STRIDE = 132;
__device__ __forceinline__ void phase_sgu(KP p, unsigned char* lds, int bid, int nb) {
    const int tid = opaque_tid(), lane = tid & 63, wave = tid >> 6, c16 = lane & 15, q = lane >> 4;
    const bf16_t* UG = (const bf16_t*)(p->ws + WS_PROJ) + (size_t)2 * M * 1024; const bf16_t* VG = UG + (size_t)M * 1024;
    const float* ssqv = (const float*)(p->ws + WS_SSQV); bf16_t* ymix = (bf16_t*)(p->ws + WS_YMIX);
    float* RS = (float*)(lds + SGU_RS); float* SS = (float*)(lds + SGU_SS);
    bf16x8_t wa[8][4]; float gvv[8]; int gcur = -1;
    const int oct = tid & 15;
    for (int it = bid; it < NB * 16 * 8; it += nb) {
        const int g = it & 7; const size_t base = (size_t)(it >> 3) * 128;
        if (g != gcur) { gcur = g;
#pragma unroll
            for (int mt = 0; mt < 8; ++mt)
#pragma unroll
                for (int ks = 0; ks < 4; ++ks) if (ks <= ((16 * mt + 15) >> 5))
                    wa[mt][ks] = *(const bf16x8_t*)((const bf16_t*)(p->ws + WS_WSPB) + ((size_t)(g * 128 + mt * 16 + c16) * 128 + ks * 32 + 8 * q));
#pragma unroll
            for (int e = 0; e < 8; ++e) gvv[e] = p->in[I_GV][g * 128 + oct * 8 + e]; }
        uint4 vch[4], uch[4];
#pragma unroll
        for (int k = 0; k < 4; ++k) { const int row = (tid >> 4) + 32 * k; vch[k] = *(const uint4*)(VG + (base + row) * 1024 + g * 128 + oct * 8); uch[k] = *(const uint4*)(UG + (base + row) * 1024 + g * 128 + oct * 8); }
        if (tid < 128) { float ss = 0.f;
#pragma unroll
            for (int k = 0; k < 16; ++k) ss += ssqv[(base + tid) * 16 + k];
            RS[tid] = rsqrtf(ss * (1.f / 1024.f) + EPS); }
        __syncthreads();
#pragma unroll
        for (int k = 0; k < 4; ++k) { const int row = (tid >> 4) + 32 * k; const float r = RS[row]; const unsigned ww[4] = {vch[k].x, vch[k].y, vch[k].z, vch[k].w}; unsigned oo[4];
#pragma unroll
            for (int e2 = 0; e2 < 4; ++e2) oo[e2] = pk2(__uint_as_float(ww[e2] << 16) * r * gvv[2 * e2], __uint_as_float(ww[e2] & 0xffff0000u) * r * gvv[2 * e2 + 1]);
            *(uint4*)(lds + SGU_TV + row * XA_STRIDE + oct * 16) = make_uint4(oo[0], oo[1], oo[2], oo[3]); }
        __syncthreads();
        bf16x8_t bfr[4];
        { const int q4 = c16 >> 2, p4 = c16 & 3;
#pragma unroll
          for (int ks = 0; ks < 4; ++ks) {
              const unsigned a1 = SGU_TV + (ks * 32 + 8 * q + q4) * XA_STRIDE + (wave * 16 + 4 * p4) * 2;
              const s16x4_t lo = __builtin_amdgcn_ds_read_tr16_b64_v4i16((LAS s16x4_t*)(lds + a1));
              const s16x4_t hi = __builtin_amdgcn_ds_read_tr16_b64_v4i16((LAS s16x4_t*)(lds + a1 + 4 * XA_STRIDE));
              bfr[ks] = __builtin_shufflevector(lo, hi, 0, 1, 2, 3, 4, 5, 6, 7); } }
        f32x4_t acc[8];
#pragma unroll
        for (int mt = 0; mt < 8; ++mt) { acc[mt] = (f32x4_t){0.f, 0.f, 0.f, 0.f};
#pragma unroll
            for (int ks = 0; ks < 4; ++ks) if (ks <= ((16 * mt + 15) >> 5)) acc[mt] = __builtin_amdgcn_mfma_f32_16x16x32_bf16(wa[mt][ks], bfr[ks], acc[mt], 0, 0, 0); }
#pragma unroll
        for (int mt = 0; mt < 8; ++mt)
#pragma unroll
            for (int reg = 0; reg < 4; ++reg) { const int i = mt * 16 + 4 * q + reg; SS[i * SS_STRIDE + wave * 16 + c16] = acc[mt][reg] + p->in[I_BSP][g * 128 + i]; }
        __syncthreads();
#pragma unroll
        for (int k = 0; k < 4; ++k) { const int row = (tid >> 4) + 32 * k; const float4 s0 = *(const float4*)(SS + row * SS_STRIDE + oct * 8), s1 = *(const float4*)(SS + row * SS_STRIDE + oct * 8 + 4);
            const unsigned ww[4] = {uch[k].x, uch[k].y, uch[k].z, uch[k].w}; const float sv[8] = {s0.x, s0.y, s0.z, s0.w, s1.x, s1.y, s1.z, s1.w}; unsigned oo[4];
#pragma unroll
            for (int e2 = 0; e2 < 4; ++e2) oo[e2] = pk2(__uint_as_float(ww[e2] << 16) * sv[2 * e2], __uint_as_float(ww[e2] & 0xffff0000u) * sv[2 * e2 + 1]);
            *(uint4*)(ymix + (base + row) * D + 1024 + g * 128 + oct * 8) = make_uint4(oo[0], oo[1], oo[2], oo[3]); }
        __syncthreads();
    }
}

typedef float f32x16_t __attribute__((ext_vector_type(16)));
__device__ __forceinline__ float vmaxf(float a, float b) { float r; asm("v_max_f32 %0, %1, %2" : "=v"(r) : "v"(a), "v"(b)); return r; }
__device__ __forceinline__ float vminf(float a, float b) { float r; asm("v_min_f32 %0, %1, %2" : "=v"(r) : "v"(a), "v"(b)); return r; }
#define CE_DESC(a, b) do { const float _mx = vmaxf(a, b), _mn = vminf(a, b); a = _mx; b = _mn; } while (0)
__device__ __forceinline__ void sort16_desc(float (&v)[16]) {
#pragma unroll
    for (int k = 2; k <= 16; k <<= 1)
#pragma unroll
        for (int j = k >> 1; j > 0; j >>= 1)
#pragma unroll
            for (int i = 0; i < 16; ++i) { const int l = i ^ j; if (l > i) { if ((i & k) == 0) CE_DESC(v[i], v[l]); else CE_DESC(v[l], v[i]); } }
}
__device__ __forceinline__ void merge16_desc(float (&a)[16], const float (&b)[16]) {
#pragma unroll
    for (int i = 0; i < 16; ++i) a[i] = vmaxf(a[i], b[15 - i]);
#pragma unroll
    for (int j = 8; j > 0; j >>= 1)
#pragma unroll
        for (int i = 0; i < 16; ++i) { const int l = i ^ j; if (l > i) CE_DESC(a[i], a[l]); }
}
__device__ __forceinline__ void topk_half(const bf16_t* qp, const unsigned char* kl, unsigned hh4, float (&X)[16]) {
    f32x16_t acc[4];
#pragma unroll
    for (int kt = 0; kt < 4; ++kt)
#pragma unroll
        for (int i = 0; i < 16; ++i) acc[kt][i] = 0.f;
#pragma unroll
    for (int ks = 0; ks < 8; ++ks) {
        const bf16x8_t bq = *(const bf16x8_t*)(qp + ks * 16);
#pragma unroll
        for (int kt = 0; kt < 4; ++kt) { const bf16x8_t ak = *(const bf16x8_t*)(kl + kt * 32 * XA_STRIDE + ks * 32); acc[kt] = __builtin_amdgcn_mfma_f32_32x32x16_bf16(ak, bq, acc[kt], 0, 0, 0); }
    }
    float g[4][16];
#pragma unroll
    for (int kt = 0; kt < 4; ++kt)
#pragma unroll
        for (int reg = 0; reg < 16; ++reg) g[kt][reg] = __uint_as_float(((__float_as_uint(acc[kt][reg]) & 0xFFFFFF80u) | hh4) | (unsigned)(kt * 32 + (reg & 3) + 8 * (reg >> 2)));
    sort16_desc(g[0]); sort16_desc(g[1]); sort16_desc(g[2]); sort16_desc(g[3]);
    merge16_desc(g[0], g[1]); merge16_desc(g[2], g[3]); merge16_desc(g[0], g[2]);
#pragma unroll
    for (int i = 0; i < 16; ++i) X[i] = g[0][i];
}
__device__ __forceinline__ unsigned pack_b0(float a, float b, float c, float d) {
    const unsigned ab = __builtin_amdgcn_perm(__float_as_uint(b), __float_as_uint(a), 0x0c0c0400u), cd = __builtin_amdgcn_perm(__float_as_uint(d), __float_as_uint(c), 0x0c0c0400u);
    return __builtin_amdgcn_perm(cd, ab, 0x05040100u);
}
__device__ __forceinline__ unsigned byte_lookup(const unsigned (&pk)[4], unsigned e) {
    const unsigned lo = __builtin_amdgcn_perm(pk[1], pk[0], e & 7u), hi = __builtin_amdgcn_perm(pk[3], pk[2], e & 7u);
    return ((e & 8u) ? hi : lo) & 0x7Fu;
}
__device__ __forceinline__ void phase_topk(KP p, unsigned char* lds, int bid, int nb) {
    const int tid = opaque_tid(), lane = tid & 63, wave = tid >> 6, r32 = lane & 31, hh = lane >> 5;
    const bf16_t* Q = (const bf16_t*)(p->ws + WS_Q); const bf16_t* KB = (const bf16_t*)(p->ws + WS_SKEYB);
    int* idx = (int*)(p->ws + WS_IDX); float* gate = (float*)(p->ws + WS_GATE);
    const float NEG = -3.0e38f;
    int hcur = -1;
    for (int bi = bid; bi < NHEAD * (M / 256); bi += nb) {
        const int hd = bi & 7, tile = (bi >> 3) * 8 + wave; const size_t token = (size_t)tile * 32 + r32;
        if (hd != hcur) { hcur = hd; __syncthreads();
#pragma unroll
            for (int k = 0; k < 8; ++k) { const int c = tid + NT * k, row = c >> 4, o = c & 15;
                *(uint4*)(lds + row * XA_STRIDE + o * 16) = *(const uint4*)(KB + ((size_t)hd * 256 + row) * 128 + o * 8); }
            __syncthreads(); }
        float X0[16], X1[16];
        topk_half(Q + token * D + hd * 256 + 8 * hh, lds + r32 * XA_STRIDE + hh * 16, 4u * hh, X0);
        __builtin_amdgcn_sched_barrier(0);
        topk_half(Q + token * D + hd * 256 + 128 + 8 * hh, lds + (128 + r32) * XA_STRIDE + hh * 16, 4u * hh, X1);
        __builtin_amdgcn_sched_barrier(0);
#pragma unroll
        for (int i = 0; i < 16; ++i) { const auto r = __builtin_amdgcn_permlane32_swap(__float_as_uint(X0[i]), __float_as_uint(X1[i]), false, false); X0[i] = __uint_as_float(r[0]); X1[i] = __uint_as_float(r[1]); }
        merge16_desc(X0, X1);
        float U[16];
#pragma unroll
        for (int i = 0; i < 16; ++i) U[i] = __shfl_xor(X0[i], 32);
        const unsigned hbit = (unsigned)hh << 8;
        float c0[16], c1[16];
#pragma unroll
        for (int j = 0; j < 16; ++j) { float s = X0[0] + U[j]; if (j == 0) s = hh ? NEG : s; c0[j] = __uint_as_float(((__float_as_uint(s) & 0xFFFFFE00u) | hbit) | (unsigned)j); }
        {
            int n = 0;
#pragma unroll
            for (int i = 1; i < 4; ++i)
#pragma unroll
                for (int j = i; j < 16; ++j) if ((i + 1) * (j + 1) <= 16) { float s = X0[i] + U[j]; if (j == i) s = hh ? NEG : s; c1[n] = __uint_as_float(((__float_as_uint(s) & 0xFFFFFE00u) | hbit) | (unsigned)(i * 16 + j)); ++n; }
#pragma unroll
            for (int k = 11; k < 16; ++k) c1[k] = NEG;
        }
        sort16_desc(c0); sort16_desc(c1); merge16_desc(c0, c1);
        float F[16];
#pragma unroll
        for (int i = 0; i < 16; ++i) F[i] = vmaxf(c0[i], __shfl_xor(c0[15 - i], 32));
        float mx = F[0];
#pragma unroll
        for (int i = 1; i < 16; ++i) mx = vmaxf(mx, F[i]);
        float ev[16], sum = 0.f;
#pragma unroll
        for (int i = 0; i < 16; ++i) { ev[i] = __expf(F[i] - mx); sum += ev[i]; }
        const float inv = 1.f / sum;
        unsigned pt[4], pu[4], pa[4], pb[4];
#pragma unroll
        for (int w = 0; w < 4; ++w) { pt[w] = pack_b0(X0[4 * w], X0[4 * w + 1], X0[4 * w + 2], X0[4 * w + 3]); pu[w] = pack_b0(U[4 * w], U[4 * w + 1], U[4 * w + 2], U[4 * w + 3]); }
#pragma unroll
        for (int w = 0; w < 4; ++w) { pa[w] = hh ? pu[w] : pt[w]; pb[w] = hh ? pt[w] : pu[w]; }
        int oi[8]; float og[8];
#pragma unroll
        for (int k = 0; k < 8; ++k) {
            const unsigned pl = __float_as_uint(F[k]) & 0x1FFu, sw = pl >> 8, pi = (pl >> 4) & 15u, pj = pl & 15u;
            const unsigned ai = sw ? pj : pi, bj = sw ? pi : pj;
            oi[k] = (int)(byte_lookup(pa, ai) * NKEYS + byte_lookup(pb, bj)); og[k] = ev[k] * inv;
        }
        int* io = idx + token * NSEL + hd * TOPK + 8 * hh; float* go = gate + token * NSEL + hd * TOPK + 8 * hh;
        *(int4*)io = make_int4(oi[0], oi[1], oi[2], oi[3]); *(int4*)(io + 4) = make_int4(oi[4], oi[5], oi[6], oi[7]);
        *(float4*)go = make_float4(og[0], og[1], og[2], og[3]); *(float4*)(go + 4) = make_float4(og[4], og[5], og[6], og[7]);
    }
}

__device__ __forceinline__ void wave_argmax(float& v, int& i) {
#pragma unroll
    for (int off = 32; off >= 1; off >>= 1) { const float ov = __shfl_xor(v, off); const int oi = __shfl_xor(i, off); if (ov > v || (ov == v && oi < i)) { v = ov; i = oi; } }
}
__device__ __forceinline__ void topk_half_naive(const bf16_t* q, const float* k0, int lane, float& outv, int& outi) {
    const float NEG = -3.0e38f;
    const float* k1 = k0 + 64 * 128;
    float s0 = 0.f, s1 = 0.f;
    for (int k = 0; k < 128; k += 4) {
        const uint2 qq = *(const uint2*)(q + k);
        const float q0 = bf2f((bf16_t)(qq.x & 0xffff)), q1 = bf2f((bf16_t)(qq.x >> 16)), q2 = bf2f((bf16_t)(qq.y & 0xffff)), q3 = bf2f((bf16_t)(qq.y >> 16));
        const float4 a = *(const float4*)(k0 + k), b = *(const float4*)(k1 + k);
        s0 += q0 * a.x + q1 * a.y + q2 * a.z + q3 * a.w; s1 += q0 * b.x + q1 * b.y + q2 * b.z + q3 * b.w;
    }
    float myv = NEG; int myi = 0;
    for (int r = 0; r < TOPK; ++r) {
        float v; int i; if (s0 >= s1) { v = s0; i = lane; } else { v = s1; i = lane + 64; }
        wave_argmax(v, i);
        if (i == lane) s0 = NEG; if (i == lane + 64) s1 = NEG;
        if (lane == r) { myv = v; myi = i; }
    }
    outv = myv; outi = myi;
}
__device__ __forceinline__ void phase_topk_naive(KP p, int bid, int nb) {
    const bf16_t* Q = (const bf16_t*)(p->ws + WS_Q); const float* keys = p->in[I_SKEY];
    int* idx = (int*)(p->ws + WS_IDX); float* gate = (float*)(p->ws + WS_GATE);
    const int tid = opaque_tid(), lane = tid & 63, wave = tid >> 6;
    const float NEG = -3.0e38f;
    for (int task = bid * 8 + wave; task < M * NHEAD; task += nb * 8) {
        const int token = task >> 3, hd = task & 7;
        float tv0, tv1; int ti0, ti1;
        topk_half_naive(Q + (size_t)token * D + hd * 256, keys + ((size_t)(hd * 2) * 128 + lane) * 128, lane, tv0, ti0);
        topk_half_naive(Q + (size_t)token * D + hd * 256 + 128, keys + ((size_t)(hd * 2 + 1) * 128 + lane) * 128, lane, tv1, ti1);
        const float vb = __shfl(tv1, lane & 15);
        float c0 = __shfl(tv0, (lane >> 4)) + vb, c1 = __shfl(tv0, (lane >> 4) + 4) + vb, c2 = __shfl(tv0, (lane >> 4) + 8) + vb, c3 = __shfl(tv0, (lane >> 4) + 12) + vb;
        float selv = NEG; int selc = 0;
        for (int r = 0; r < TOPK; ++r) {
            float v = c0; int i = lane;
            if (c1 > v) { v = c1; i = lane + 64; }
            if (c2 > v) { v = c2; i = lane + 128; }
            if (c3 > v) { v = c3; i = lane + 192; }
            wave_argmax(v, i);
            if (i == lane) c0 = NEG; if (i == lane + 64) c1 = NEG; if (i == lane + 128) c2 = NEG; if (i == lane + 192) c3 = NEG;
            if (lane == r) { selv = v; selc = i; }
        }
        const float mx = __shfl(selv, 0);
        const float e = lane < TOPK ? __expf(selv - mx) : 0.f;
        const float sum = wave_sum(e);
        const int i1 = __shfl(ti0, selc >> 4), i2 = __shfl(ti1, selc & 15);
        if (lane < TOPK) { idx[(size_t)token * NSEL + hd * TOPK + lane] = i1 * NKEYS + i2; gate[(size_t)token * NSEL + hd * TOPK + lane] = e / sum; }
    }
}

typedef _Float16 h2_t __attribute__((ext_vector_type(2)));
__device__ __forceinline__ unsigned pkh2(float lo, float hi) { h2_t v; v.x = (_Float16)lo; v.y = (_Float16)hi; return __builtin_bit_cast(unsigned, v); }
__device__ __forceinline__ float dot2h(unsigned a, unsigned b, float c) { return __builtin_amdgcn_fdot2(__builtin_bit_cast(h2_t, a), __builtin_bit_cast(h2_t, b), c, false); }
__device__ __forceinline__ void phase_convert_experts(KP p, int bid, int nb) {
    const size_t n8 = (size_t)NKEYS * NKEYS * D / 8; const int tid = opaque_tid();
    for (int t = 0; t < 2; ++t) {
        const float* src = t ? p->in[I_EV] : p->in[I_EU]; uint4* dst = (uint4*)(p->ws + (t ? WS_EV16 : WS_EU16));
        for (size_t i = (size_t)bid * NT + tid; i < n8; i += (size_t)nb * NT) {
            const float4 a = *(const float4*)(src + i * 8), b = *(const float4*)(src + i * 8 + 4);
            uint4 o; o.x = pkh2(a.x, a.y); o.y = pkh2(a.z, a.w); o.z = pkh2(b.x, b.y); o.w = pkh2(b.z, b.w);
            dst[i] = o;
        }
    }
}
__device__ __forceinline__ void phase_peer(KP p, float* lds, int bid, int nb) {
    const bf16_t* H = (const bf16_t*)(p->ws + WS_H); const int* idx = (const int*)(p->ws + WS_IDX); const float* gate = (const float*)(p->ws + WS_GATE);
    const unsigned char* EU = p->ws + WS_EU16; const unsigned char* EV = p->ws + WS_EV16; const float* gf = p->in[I_GFIN];
    const int tid = opaque_tid(), lane = tid & 63, wave = tid >> 6;
    for (int i = tid; i < NB * D; i += NT) lds[i] = mod_at(p, i >> 11, 5 * D + (i & (D - 1)));
    __syncthreads();
    for (int token = bid * 8 + wave; token < M; token += nb * 8) {
        unsigned hp[16];
#pragma unroll
        for (int j = 0; j < 4; ++j) { const uint4 w = *(const uint4*)(H + (size_t)token * D + lane * 8 + 512 * j);
            hp[4 * j + 0] = pkh2(__uint_as_float(w.x << 16), __uint_as_float(w.x & 0xffff0000u)); hp[4 * j + 1] = pkh2(__uint_as_float(w.y << 16), __uint_as_float(w.y & 0xffff0000u));
            hp[4 * j + 2] = pkh2(__uint_as_float(w.z << 16), __uint_as_float(w.z & 0xffff0000u)); hp[4 * j + 3] = pkh2(__uint_as_float(w.w << 16), __uint_as_float(w.w & 0xffff0000u)); }
        const int e0 = idx[(size_t)token * NSEL + lane], e1 = idx[(size_t)token * NSEL + 64 + lane];
        const float g0 = gate[(size_t)token * NSEL + lane], g1 = gate[(size_t)token * NSEL + 64 + lane];
        float act0 = 0.f, act1 = 0.f;
        for (int s = 0; s < NSEL; s += 4) {
            const int ee = s < 64 ? e0 : e1; const float gg = s < 64 ? g0 : g1; const int sl = s & 63;
            uint4 r[4][4];
#pragma unroll
            for (int k = 0; k < 4; ++k) { const int e = __builtin_amdgcn_readlane(ee, sl + k); const unsigned char* base = EU + (size_t)e * (D * 2) + lane * 16;
#pragma unroll
                for (int j = 0; j < 4; ++j) r[k][j] = *(const uint4*)(base + 1024 * j); }
#pragma unroll
            for (int k = 0; k < 4; ++k) { float d = 0.f;
#pragma unroll
                for (int j = 0; j < 4; ++j) { d = dot2h(hp[4 * j], r[k][j].x, d); d = dot2h(hp[4 * j + 1], r[k][j].y, d); d = dot2h(hp[4 * j + 2], r[k][j].z, d); d = dot2h(hp[4 * j + 3], r[k][j].w, d); }
                d = wave_sum(d);
                const float a = gelu_t(d) * __builtin_bit_cast(float, __builtin_amdgcn_readlane(__builtin_bit_cast(int, gg), sl + k));
                if (lane == sl + k) { if (s < 64) act0 = a; else act1 = a; } }
        }
        float acc[32];
#pragma unroll
        for (int j = 0; j < 32; ++j) acc[j] = 0.f;
        for (int s = 0; s < NSEL; s += 4) {
            const int ee = s < 64 ? e0 : e1; const float aa = s < 64 ? act0 : act1; const int sl = s & 63;
            uint4 r[4][4];
#pragma unroll
            for (int k = 0; k < 4; ++k) { const int e = __builtin_amdgcn_readlane(ee, sl + k); const unsigned char* base = EV + (size_t)e * (D * 2) + lane * 16;
#pragma unroll
                for (int j = 0; j < 4; ++j) r[k][j] = *(const uint4*)(base + 1024 * j); }
#pragma unroll
            for (int k = 0; k < 4; ++k) { const float a = __builtin_bit_cast(float, __builtin_amdgcn_readlane(__builtin_bit_cast(int, aa), sl + k));
#pragma unroll
                for (int j = 0; j < 4; ++j) { const unsigned w[4] = {r[k][j].x, r[k][j].y, r[k][j].z, r[k][j].w};
#pragma unroll
                    for (int c = 0; c < 4; ++c) { const h2_t v = __builtin_bit_cast(h2_t, w[c]); acc[8 * j + 2 * c] = fmaf((float)v.x, a, acc[8 * j + 2 * c]); acc[8 * j + 2 * c + 1] = fmaf((float)v.y, a, acc[8 * j + 2 * c + 1]); } } }
        }
        const float* gt = lds + (token / SEQ) * D;
        float ss = 0.f;
#pragma unroll
        for (int j = 0; j < 4; ++j)
#pragma unroll
            for (int hh = 0; hh < 2; ++hh) {
                const int col = lane * 8 + 512 * j + 4 * hh;
                const float4 x1 = *(const float4*)(p->out + (size_t)token * D + col); const float4 g4 = *(const float4*)(gt + col);
                float* a = acc + 8 * j + 4 * hh;
                a[0] = x1.x + g4.x * a[0]; a[1] = x1.y + g4.y * a[1]; a[2] = x1.z + g4.z * a[2]; a[3] = x1.w + g4.w * a[3];
                ss += a[0] * a[0] + a[1] * a[1] + a[2] * a[2] + a[3] * a[3];
            }
        const float rstd = rsqrtf(wave_sum(ss) * (1.f / D) + EPS);
#pragma unroll
        for (int j = 0; j < 4; ++j)
#pragma unroll
            for (int hh = 0; hh < 2; ++hh) {
                const int col = lane * 8 + 512 * j + 4 * hh;
                const float4 g4 = *(const float4*)(gf + col); const float* a = acc + 8 * j + 4 * hh;
                float4 o; o.x = a[0] * rstd * g4.x; o.y = a[1] * rstd * g4.y; o.z = a[2] * rstd * g4.z; o.w = a[3] * rstd * g4.w;
                *(float4*)(p->out + (size_t)token * D + col) = o;
            }
    }
}

extern __shared__ __attribute__((aligned(16))) unsigned char dyn_lds[];
constexpr int LDS_BYTES = 147456;
__global__ void __launch_bounds__(NT) fwd_megakernel(Params p_unused) {
    cg::grid_group grid = cg::this_grid();
    KP p = (KP)__builtin_amdgcn_kernarg_segment_ptr();
    float* lds = (float*)dyn_lds;
    const int bid = blockIdx.x, nb = gridDim.x;
    phase_mod(p, lds, bid, nb);
    __syncthreads();
    phase_convert_weights(p, lds, bid, nb);
    phase_convert_experts(p, bid, nb);
    grid.sync();
    phase_hrows(p, p->in[I_X], p->in[I_GMIX], 0, D, (bf16_t*)(p->ws + WS_H), lds, bid, nb);
    grid.sync();
    { pg8::Gemm g{(const bf16_t*)(p->ws + WS_H), (const bf16_t*)(p->ws + WS_WIN_T), M, NPROJ, D}; pg8::StaticOrder S; S.init(M, NPROJ, nb, bid);
      pg8::EpiProj E{(bf16_t*)(p->ws + WS_PROJ), (float*)(p->ws + WS_SSQV), M};
      pg8::gemm_phase<pg8::EpiProj, pg8::StaticOrder, true, true>((LAS unsigned char*)dyn_lds, g, S, E); }
    grid.sync();
    phase_lru(p, dyn_lds, bid, nb);
    phase_sgu(p, dyn_lds, bid, nb);
    grid.sync();
    { pg8::Gemm g{(const bf16_t*)(p->ws + WS_YMIX), (const bf16_t*)(p->ws + WS_WOUT_T), M, D, D}; pg8::StaticOrder S; S.init(M, D, nb, bid);
      pg8::EpiX1 E{p->in[I_X], p->out, (const float*)(p->ws + WS_MODP), p->in[I_BADA], 2 * D, NMOD, SEQ};
      pg8::gemm_phase<pg8::EpiX1, pg8::StaticOrder, true, true>((LAS unsigned char*)dyn_lds, g, S, E); }
    grid.sync();
    phase_hrows(p, p->out, p->in[I_GFFN], 3 * D, 4 * D, (bf16_t*)(p->ws + WS_H), lds, bid, nb);
    grid.sync();
    { pg8::Gemm g{(const bf16_t*)(p->ws + WS_H), (const bf16_t*)(p->ws + WS_WQ_T), M, D, D}; pg8::StaticOrder S; S.init(M, D, nb, bid);
      pg8::EpiQ E{(bf16_t*)(p->ws + WS_Q), D};
      pg8::gemm_phase<pg8::EpiQ, pg8::StaticOrder, true, true>((LAS unsigned char*)dyn_lds, g, S, E); }
    grid.sync();
    phase_topk(p, dyn_lds, bid, nb);
    grid.sync();
    phase_peer(p, lds, bid, nb);
}

extern "C" void kernel_launch(void* const* d_in, const int* in_sizes, int n_in, void* d_out, int out_size, void* d_ws, size_t ws_size, hipStream_t stream) {
    static int grid_blocks = 0;
    if (grid_blocks == 0) {
        if (n_in != 23 || in_sizes[0] != M * D || out_size != M * D || ws_size < WS_END) { fprintf(stderr, "kernel_launch: unexpected shapes (n_in %d in0 %d out %d ws %zu)\n", n_in, n_in > 0 ? in_sizes[0] : -1, out_size, ws_size); grid_blocks = -1; return; }
        if (hipFuncSetAttribute((const void*)fwd_megakernel, hipFuncAttributeMaxDynamicSharedMemorySize, LDS_BYTES) != hipSuccess) { fprintf(stderr, "hipFuncSetAttribute failed\n"); grid_blocks = -1; return; }
        int dev = 0, cus = 0, per_cu = 0;
        hipGetDevice(&dev);
        hipDeviceGetAttribute(&cus, hipDeviceAttributeMultiprocessorCount, dev);
        if (hipOccupancyMaxActiveBlocksPerMultiprocessor(&per_cu, (const void*)fwd_megakernel, NT, LDS_BYTES) != hipSuccess || per_cu < 1) { fprintf(stderr, "occupancy query failed (%d)\n", per_cu); grid_blocks = -1; return; }
        grid_blocks = cus;
    }
    if (grid_blocks < 0) return;
    Params p{};
    for (int i = 0; i < 23; ++i) p.in[i] = (const float*)d_in[i];
    p.out = (float*)d_out; p.ws = (unsigned char*)d_ws;
    void* args[] = {&p};
    hipError_t e = hipLaunchCooperativeKernel((const void*)fwd_megakernel, dim3(grid_blocks), dim3(NT), args, LDS_BYTES, stream);
    if (e != hipSuccess) fprintf(stderr, "cooperative launch failed: %s (grid %d)\n", hipGetErrorString(e), grid_blocks);
}
```

```cpp
#include <hip/hip_runtime.h>
#include <hip/hip_cooperative_groups.h>
#include <cstdio>
#include <cstdint>

constexpr int D = 2048, NB = 8, SEQ = 2048, M = NB * SEQ;
constexpr int DLRU = 1024, DSGU = 1024, NPROJ = 4096;
constexpr int NMOD = 6 * D;
constexpr int NHEAD = 8, NKEYS = 128, TOPK = 16, NSEL = NHEAD * TOPK;
constexpr float EPS = 1e-6f;
constexpr int NT = 512;
namespace cg = cooperative_groups;

constexpr size_t MiB = 1u << 20;
constexpr size_t WS_CTL = 0;
constexpr size_t WS_MODP = 1 * MiB;
constexpr size_t WS_WGA_T = 3 * MiB;
constexpr size_t WS_WGI_T = 3 * MiB + 262144;
constexpr size_t WS_WSPB = 3 * MiB + 524288;
constexpr size_t WS_SKEYB = 3 * MiB + 786432;
constexpr size_t WS_SSQV = 5 * MiB;
constexpr size_t WS_RSTDV = 8 * MiB;
constexpr size_t WS_WIN_T = 9 * MiB;
constexpr size_t WS_WOUT_T = 25 * MiB;
constexpr size_t WS_WQ_T = 33 * MiB;
constexpr size_t WS_IDX = 41 * MiB;
constexpr size_t WS_GATE = 49 * MiB;
constexpr size_t WS_H = 64 * MiB;
constexpr size_t WS_PROJ = 128 * MiB;
constexpr size_t WS_Q = 128 * MiB;
constexpr size_t WS_YMIX = 256 * MiB;
constexpr size_t WS_EU8 = 320 * MiB;
constexpr size_t WS_EV8 = 352 * MiB;
constexpr size_t WS_ESCALE = 57 * MiB;
constexpr size_t WS_XC = 320 * MiB;
constexpr size_t WS_A = 384 * MiB;
constexpr size_t WS_BB = 448 * MiB;
constexpr size_t WS_END = 512 * MiB;

typedef unsigned short bf16_t;
struct Params { const float* in[23]; float* out; unsigned char* ws; };
typedef const __attribute__((address_space(4))) Params* KP;
enum { I_X = 0, I_C, I_WADA, I_BADA, I_GMIX, I_WIN, I_CONVW, I_CONVB, I_WGA, I_BGA, I_WGI, I_BGI, I_LAM, I_GV, I_WSP, I_BSP, I_WOUT, I_GFFN, I_WQ, I_SKEY, I_EU, I_EV, I_GFIN };

__device__ __forceinline__ int opaque_tid() { int t = threadIdx.x; asm volatile("" : "+v"(t)); return t; }
__device__ __forceinline__ float bf2f(bf16_t v) { return __uint_as_float(((unsigned)v) << 16); }
__device__ __forceinline__ bf16_t f2bf(float f) { unsigned u = __float_as_uint(f); u += 0x7fffu + ((u >> 16) & 1u); return (bf16_t)(u >> 16); }
__device__ __forceinline__ float sigmoidf_(float x) { return 1.f / (1.f + __expf(-x)); }
__device__ __forceinline__ float gelu_t(float x) { const float u = 0.7978845608028654f * (x + 0.044715f * x * x * x); return x * sigmoidf_(2.f * u); }
__device__ __forceinline__ float wave_sum(float v) {
#pragma unroll
    for (int o = 1; o < 64; o <<= 1) v += __shfl_xor(v, o);
    return v;
}
__device__ __forceinline__ float mod_at(KP p, int b, int n) {
    const float* mp = (const float*)(p->ws + WS_MODP);
    float s = p->in[I_BADA][n];
#pragma unroll
    for (int kc = 0; kc < 4; ++kc) s += mp[(size_t)(kc * 8 + b) * NMOD + n];
    return s;
}

__device__ __forceinline__ void phase_mod(KP p, float* lds, int bid, int nb) {
    const int tid = opaque_tid(), lane = tid & 63, wave = tid >> 6;
    const float* c = p->in[I_C]; const float* W = p->in[I_WADA];
    float* modp = (float*)(p->ws + WS_MODP);
    for (int i = tid; i < NB * D; i += NT) { const float v = c[i]; lds[i] = v * sigmoidf_(v); }
    __syncthreads();
    float* red = lds + NB * D;
    for (int item = bid; item < 192; item += nb) {
        const int nt = item % 48, kc = item / 48;
        const int n0 = nt * 256 + lane * 4, k0 = kc * 512 + wave * 64;
        float acc[8][4];
#pragma unroll
        for (int b = 0; b < 8; ++b)
#pragma unroll
            for (int j = 0; j < 4; ++j) acc[b][j] = 0.f;
        for (int kk = 0; kk < 64; ++kk) {
            const float4 w = *(const float4*)(W + (size_t)(k0 + kk) * NMOD + n0);
#pragma unroll
            for (int b = 0; b < 8; ++b) { const float s = lds[b * D + k0 + kk]; acc[b][0] += s * w.x; acc[b][1] += s * w.y; acc[b][2] += s * w.z; acc[b][3] += s * w.w; }
        }
#pragma unroll
        for (int b = 0; b < 8; ++b)
#pragma unroll
            for (int j = 0; j < 4; ++j) red[(wave * 32 + b * 4 + j) * 64 + lane] = acc[b][j];
        __syncthreads();
        for (int o = tid; o < 2048; o += NT) {
            const int b = o >> 8, nn = o & 255, ln = nn >> 2, j = nn & 3;
            float s = 0.f;
#pragma unroll
            for (int w = 0; w < 8; ++w) s += red[(w * 32 + b * 4 + j) * 64 + ln];
            modp[(size_t)(kc * 8 + b) * NMOD + nt * 256 + nn] = s;
        }
        __syncthreads();
    }
}

__device__ __forceinline__ void phase_hrows(KP p, const float* src, const float* gn, int shift_off, int scale_off, bf16_t* dst, float* lds, int bid, int nb) {
    const int tid = opaque_tid(), lane = tid & 63, wave = tid >> 6;
    float* Aw = lds; float* Bw = lds + D;
    for (int item = bid; item < M / 64; item += nb) {
        const int b = item / (SEQ / 64);
        for (int col = tid; col < D; col += NT) { Aw[col] = gn[col] * (1.f + mod_at(p, b, scale_off + col)); Bw[col] = mod_at(p, b, shift_off + col); }
        __syncthreads();
        for (int r = wave; r < 64; r += 8) {
            const size_t row = (size_t)item * 64 + r;
            float4 v[8]; float ss = 0.f;
#pragma unroll
            for (int j = 0; j < 8; ++j) { v[j] = *(const float4*)(src + row * D + lane * 4 + 256 * j); ss += v[j].x * v[j].x + v[j].y * v[j].y + v[j].z * v[j].z + v[j].w * v[j].w; }
            const float rstd = rsqrtf(wave_sum(ss) * (1.f / D) + EPS);
#pragma unroll
            for (int j = 0; j < 8; ++j) {
                const int col = lane * 4 + 256 * j;
                const float o0 = v[j].x * rstd * Aw[col] + Bw[col], o1 = v[j].y * rstd * Aw[col + 1] + Bw[col + 1];
                const float o2 = v[j].z * rstd * Aw[col + 2] + Bw[col + 2], o3 = v[j].w * rstd * Aw[col + 3] + Bw[col + 3];
                uint2 w; w.x = (unsigned)f2bf(o0) | ((unsigned)f2bf(o1) << 16); w.y = (unsigned)f2bf(o2) | ((unsigned)f2bf(o3) << 16);
                *(uint2*)(dst + row * D + col) = w;
            }
        }
        __syncthreads();
    }
}

namespace pg8 {
#define PG8_LAS __attribute__((address_space(3)))
typedef unsigned short bf16_t;
typedef short bf16x8 __attribute__((ext_vector_type(8)));
typedef float f32x4 __attribute__((ext_vector_type(4)));
typedef unsigned u32x4 __attribute__((ext_vector_type(4)));
constexpr int BM = 256, BK = 64, HALF = 128, HTB = HALF * BK * 2  , STAGE_BYTES = 8 * HTB, NXCD = 8, WGM = 8;

__host__ __device__ __forceinline__ int lds_byte(int r, int c) { const int st = (r >> 4) * 2 + (c >> 5), rr = r & 15, cc = c & 31, ob = rr * 64 + cc * 2; return st * 1024 + (ob ^ (((ob >> 9) & 1) << 5)); }
__host__ __device__ __forceinline__ void stage_rc(int b, int& R, int& C) { const int st = b / 1024, sb = b % 1024, swz = sb ^ (((sb >> 9) & 1) << 5); R = (st >> 1) * 16 + swz / 64; C = (st & 1) * 32 + (swz % 64) / 2; }
__host__ __device__ __forceinline__ int perm32(int rho) { const int n = rho >> 4, i = rho & 15; return 8 * (i >> 2) + 4 * n + (i & 3); }

struct Unit { int pm, pn; };
struct Gemm { const bf16_t* A; const bf16_t* Bt; int M, N, K; };

struct StaticOrder {
    int nM, nN, nwg, G, c;
    __host__ __device__ void init(int M, int N, int G_, int c_) { nM = M / BM; nN = N / BM; nwg = nM * nN; G = G_; c = c_; }
    __host__ __device__ bool next(int i, Unit& u) const {
        const long L = (long)i * G + c; if (L >= nwg) return false;
        int wgid = (int)L; { const int q = nwg / NXCD, r = nwg % NXCD, xcd = wgid % NXCD, off = wgid / NXCD; wgid = (xcd < r ? xcd * (q + 1) : r * (q + 1) + (xcd - r) * q) + off; }
        const int nig = WGM * nN, gid = wgid / nig, fm = gid * WGM, gsz = (nM - fm) < WGM ? (nM - fm) : WGM;
        u.pm = fm + ((wgid % nig) % gsz); u.pn = (wgid % nig) / gsz; return true;
    }
    __device__ __forceinline__ void a_ready(const Unit&) const {}
    __device__ __forceinline__ void done(const Unit&) const {}
};


__device__ __forceinline__ unsigned cvt_pk_bf16(float lo, float hi) { unsigned r; asm volatile("v_cvt_pk_bf16_f32 %0, %1, %2" : "=v"(r) : "v"(lo), "v"(hi)); return r; }
__device__ __forceinline__ float gelu_tanh(float x) { const float u = 1.5957691216057308f * (x + 0.044715f * x * x * x); return x * __builtin_amdgcn_rcpf(1.f + __expf(-u)); }
struct EpiProj {
    static constexpr bool PERM = true, AFTER_DRAIN = false;
    bf16_t* proj; float* ssqv; int Mrows;
    __device__ __forceinline__ void operator()(const f32x4 (&acc)[2][2][4][2], const Unit& u, int wr, int wc, int fr, int fq) const {
        const int which = (u.pn * BM) >> 10, colt = (u.pn * BM) & 1023;
        bf16_t* base = proj + (size_t)which * Mrows * 1024;
        const int row0 = u.pm * BM + wr * 64 + fr, col0 = colt + wc * 32 + 8 * fq;
#pragma unroll
        for (int ai = 0; ai < 2; ++ai)
#pragma unroll
            for (int m = 0; m < 4; ++m) { const int row = row0 + ai * HALF + m * 16; bf16_t* rowp = base + (size_t)row * 1024 + col0; float ss = 0.f;
#pragma unroll
                for (int bj = 0; bj < 2; ++bj) { f32x4 v0 = acc[ai][bj][m][0], v1 = acc[ai][bj][m][1];
                    if (which) {
#pragma unroll
                        for (int j = 0; j < 4; ++j) { v0[j] = gelu_tanh(v0[j]); v1[j] = gelu_tanh(v1[j]); } }
                    ss += (v0[0] * v0[0] + v0[1] * v0[1]) + (v0[2] * v0[2] + v0[3] * v0[3]) + (v1[0] * v1[0] + v1[1] * v1[1]) + (v1[2] * v1[2] + v1[3] * v1[3]);
                    u32x4 w; w.x = cvt_pk_bf16(v0[0], v0[1]); w.y = cvt_pk_bf16(v0[2], v0[3]); w.z = cvt_pk_bf16(v1[0], v1[1]); w.w = cvt_pk_bf16(v1[2], v1[3]);
                    *(u32x4*)(rowp + bj * HALF) = w; }
                if (which == 3) { ss += __shfl_xor(ss, 16); ss += __shfl_xor(ss, 32); if (fq == 0) ssqv[(size_t)row * 16 + (u.pn & 3) * 4 + wc] = ss; } }
    }
};
struct EpiX1 {
    static constexpr bool PERM = false, AFTER_DRAIN = false;
    const float* x; float* out; const float* modp; const float* bada; int goff, nmod, seq;
    __device__ __forceinline__ void operator()(const f32x4 (&acc)[2][2][4][2], const Unit& u, int wr, int wc, int fr, int fq) const {
        const int row0 = u.pm * BM + wr * 64 + fr, col0 = u.pn * BM + wc * 32 + 4 * fq, b = (u.pm * BM) / seq;
        f32x4 gv[2][2];
#pragma unroll
        for (int bj = 0; bj < 2; ++bj)
#pragma unroll
            for (int n = 0; n < 2; ++n) { const int c = goff + col0 + bj * HALF + n * 16; f32x4 g = *(const f32x4*)(bada + c);
#pragma unroll
                for (int kc = 0; kc < 4; ++kc) g += *(const f32x4*)(modp + (size_t)(kc * 8 + b) * nmod + c);
                gv[bj][n] = g; }
#pragma unroll
        for (int ai = 0; ai < 2; ++ai)
#pragma unroll
            for (int m = 0; m < 4; ++m) { const size_t off = (size_t)(row0 + ai * HALF + m * 16) * (size_t)(2048) + col0;
#pragma unroll
                for (int bj = 0; bj < 2; ++bj)
#pragma unroll
                    for (int n = 0; n < 2; ++n) { const f32x4 xv = *(const f32x4*)(x + off + bj * HALF + n * 16); *(f32x4*)(out + off + bj * HALF + n * 16) = xv + gv[bj][n] * acc[ai][bj][m][n]; } }
    }
};
struct EpiQ {
    static constexpr bool PERM = true, AFTER_DRAIN = false;
    bf16_t* O; int ldc;
    __device__ __forceinline__ void operator()(const f32x4 (&acc)[2][2][4][2], const Unit& u, int wr, int wc, int fr, int fq) const {
        const int row0 = u.pm * BM + wr * 64 + fr, col0 = u.pn * BM + wc * 32 + 8 * fq;
#pragma unroll
        for (int ai = 0; ai < 2; ++ai)
#pragma unroll
            for (int m = 0; m < 4; ++m) { bf16_t* rowp = O + (size_t)(row0 + ai * HALF + m * 16) * ldc + col0;
#pragma unroll
                for (int bj = 0; bj < 2; ++bj) { const f32x4 v0 = acc[ai][bj][m][0], v1 = acc[ai][bj][m][1];
                    u32x4 w; w.x = cvt_pk_bf16(v0[0], v0[1]); w.y = cvt_pk_bf16(v0[2], v0[3]); w.z = cvt_pk_bf16(v1[0], v1[1]); w.w = cvt_pk_bf16(v1[2], v1[3]);
                    *(u32x4*)(rowp + bj * HALF) = w; } }
    }
};

template <class Epi, class Sched, bool ALIGN_EPI = false, bool SP2 = false>
__device__ __forceinline__ void gemm_phase(PG8_LAS unsigned char* lds, const Gemm g, const Sched& S, const Epi& E) {
    const int tid = opaque_tid(), wid = __builtin_amdgcn_readfirstlane(tid >> 6), lane = tid & 63, wr = wid >> 2, wc = wid & 3, fr = lane & 15, fq = lane >> 4;
    const int K = g.K, nt = K / BK;
    unsigned voffA[2], voffB[2];
#pragma unroll
    for (int i = 0; i < 2; ++i) { int R, C; stage_rc(tid * 16 + i * 8192, R, C); const int Rb = Epi::PERM ? ((R & ~31) + perm32(R & 31)) : R;
        voffA[i] = (unsigned)(R * K + C) * 2u; voffB[i] = (unsigned)(Rb * K + C) * 2u; }
    const size_t kstep = (size_t)(BK * 2);
    const size_t hstep = (size_t)HALF * K * 2;
    const size_t tstep = 2 * hstep;
    const unsigned ldsw = (unsigned)wid * 1024u;
    const int aoff = lds_byte(wr * 64 + fr, fq * 8), boff = lds_byte(wc * 32 + fr, fq * 8);
#define PG8_SA(b, h) (((b) * 2 + (h)) * HTB)
#define PG8_SB(b, h) ((4 + (b) * 2 + (h)) * HTB)
#define PG8_STAGE(bufoff, gbase, voff) do { _Pragma("unroll") for (int _i = 0; _i < 2; ++_i) \
        __builtin_amdgcn_global_load_lds((const unsigned*)((const char*)(gbase) + (voff)[_i]), (PG8_LAS unsigned*)(lds + (bufoff) + ldsw + _i * 8192), 16, 0, 0); } while (0)
#define PG8_LDA(dst, b, h) do { _Pragma("unroll") for (int m = 0; m < 4; ++m) _Pragma("unroll") for (int k = 0; k < 2; ++k) dst[m][k] = *(const PG8_LAS bf16x8*)(lds + PG8_SA(b, h) + aoff + m * 2048 + k * 1024); } while (0)
#define PG8_LDB(dst, b, h) do { _Pragma("unroll") for (int n = 0; n < 2; ++n) _Pragma("unroll") for (int k = 0; k < 2; ++k) dst[n][k] = *(const PG8_LAS bf16x8*)(lds + PG8_SB(b, h) + boff + n * 2048 + k * 1024); } while (0)
#define PG8_MMA(ai, bj, At, Bt) do { __builtin_amdgcn_s_setprio(1); _Pragma("unroll") for (int m = 0; m < 4; ++m) _Pragma("unroll") for (int n = 0; n < 2; ++n) _Pragma("unroll") for (int k = 0; k < 2; ++k) \
        acc[ai][bj][m][n] = __builtin_amdgcn_mfma_f32_16x16x32_bf16(Bt[n][k], At[m][k], acc[ai][bj][m][n], 0, 0, 0); __builtin_amdgcn_s_setprio(0); } while (0)
#define PG8_WAIT_V(n) asm volatile("s_waitcnt vmcnt(" #n ")" ::: "memory")
#define PG8_WAIT_L(n) asm volatile("s_waitcnt lgkmcnt(" #n ")" ::: "memory")
#define PG8_BAR __builtin_amdgcn_s_barrier()
#define PG8_SCHED __builtin_amdgcn_sched_barrier(0)
    Unit cur, nxt; int ui = 0;
    if (!S.next(0, cur)) return;
    f32x4 acc[2][2][4][2];
#pragma unroll
    for (int a = 0; a < 2; ++a)
#pragma unroll
        for (int b = 0; b < 2; ++b)
#pragma unroll
            for (int m = 0; m < 4; ++m)
#pragma unroll
                for (int n = 0; n < 2; ++n) acc[a][b][m][n] = (f32x4){0.f, 0.f, 0.f, 0.f};
    bf16x8 At[4][2], B0[2][2], B1[2][2];
    const char* cA = (const char*)g.A + (size_t)cur.pm * tstep; const char* cB = (const char*)g.Bt + (size_t)cur.pn * tstep;
    S.a_ready(cur);
    if constexpr (SP2) {
        PG8_STAGE(PG8_SB(0, 0), cB, voffB); PG8_STAGE(PG8_SB(0, 1), cB + hstep, voffB); PG8_STAGE(PG8_SA(0, 0), cA, voffA); PG8_STAGE(PG8_SA(0, 1), cA + hstep, voffA);
        if (wr == 1) PG8_BAR;
        PG8_WAIT_V(2); PG8_BAR;
        PG8_STAGE(PG8_SB(1, 0), cB + kstep, voffB); PG8_STAGE(PG8_SA(1, 0), cA + kstep, voffA); PG8_STAGE(PG8_SB(1, 1), cB + hstep + kstep, voffB);
        PG8_WAIT_V(6); PG8_BAR;
    } else {
        PG8_STAGE(PG8_SB(0, 0), cB, voffB); PG8_STAGE(PG8_SA(0, 0), cA, voffA); PG8_STAGE(PG8_SB(0, 1), cB + hstep, voffB); PG8_STAGE(PG8_SA(0, 1), cA + hstep, voffA);
        if (wr == 1) PG8_BAR;
        PG8_WAIT_V(4); PG8_BAR;
        PG8_STAGE(PG8_SB(1, 0), cB + kstep, voffB); PG8_STAGE(PG8_SA(1, 0), cA + kstep, voffA); PG8_STAGE(PG8_SB(1, 1), cB + hstep + kstep, voffB);
        PG8_WAIT_V(6); PG8_BAR;
    }
    for (;;) {
        const bool has_next = S.next(ui + 1, nxt);
        const char* nA = has_next ? (const char*)g.A + (size_t)nxt.pm * tstep : cA; const char* nB = has_next ? (const char*)g.Bt + (size_t)nxt.pn * tstep : cB;
        for (int t = 0; t < nt; t += 2) {
            const bool last = (t == nt - 2);
            const char* a1 = cA + (size_t)(t + 1) * kstep;
            const char* a2 = last ? nA : cA + (size_t)(t + 2) * kstep; const char* b2 = last ? nB : cB + (size_t)(t + 2) * kstep;
            const char* a3 = a2 + kstep; const char* b3 = b2 + kstep;
            if (last && has_next) S.a_ready(nxt);
            if constexpr (SP2) {
            PG8_LDB(B0, 0, 0); PG8_LDB(B1, 0, 1); PG8_SCHED; PG8_LDA(At, 0, 0); PG8_STAGE(PG8_SA(1, 1), a1 + hstep, voffA);
            PG8_WAIT_V(8); PG8_WAIT_L(0); PG8_BAR; PG8_MMA(0, 0, At, B0); PG8_MMA(0, 1, At, B1); PG8_BAR; PG8_SCHED;
            PG8_LDA(At, 0, 1); PG8_STAGE(PG8_SB(0, 0), b2, voffB); PG8_STAGE(PG8_SB(0, 1), b2 + hstep, voffB); PG8_STAGE(PG8_SA(0, 0), a2, voffA);
            PG8_WAIT_V(8); PG8_WAIT_L(0); PG8_BAR; PG8_MMA(1, 0, At, B0); PG8_MMA(1, 1, At, B1); PG8_BAR; PG8_SCHED;
            PG8_LDB(B0, 1, 0); PG8_LDB(B1, 1, 1); PG8_SCHED; PG8_LDA(At, 1, 0); PG8_STAGE(PG8_SA(0, 1), a2 + hstep, voffA);
            PG8_WAIT_V(8); PG8_WAIT_L(0); PG8_BAR; PG8_MMA(0, 0, At, B0); PG8_MMA(0, 1, At, B1); PG8_BAR; PG8_SCHED;
            PG8_LDA(At, 1, 1); PG8_STAGE(PG8_SB(1, 0), b3, voffB); PG8_STAGE(PG8_SB(1, 1), b3 + hstep, voffB); PG8_STAGE(PG8_SA(1, 0), a3, voffA);
            PG8_WAIT_V(8); PG8_WAIT_L(0); PG8_BAR; PG8_MMA(1, 0, At, B0); PG8_MMA(1, 1, At, B1); PG8_BAR; PG8_SCHED;
            } else {
            PG8_LDB(B0, 0, 0); PG8_SCHED; PG8_LDA(At, 0, 0); PG8_STAGE(PG8_SA(1, 1), a1 + hstep, voffA);
            PG8_WAIT_L(8); PG8_BAR; PG8_WAIT_L(0); PG8_MMA(0, 0, At, B0); PG8_BAR; PG8_SCHED;
            PG8_LDB(B1, 0, 1); PG8_STAGE(PG8_SB(0, 0), b2, voffB);
            PG8_BAR; PG8_WAIT_L(0); PG8_MMA(0, 1, At, B1); PG8_BAR;
            PG8_LDA(At, 0, 1); PG8_STAGE(PG8_SA(0, 0), a2, voffA);
            PG8_BAR; PG8_WAIT_L(0); PG8_MMA(1, 0, At, B0); PG8_BAR; PG8_SCHED;
            PG8_STAGE(PG8_SB(0, 1), b2 + hstep, voffB);
            PG8_WAIT_V(6); PG8_BAR; PG8_MMA(1, 1, At, B1); PG8_BAR;
            PG8_LDB(B0, 1, 0); PG8_SCHED; PG8_LDA(At, 1, 0); PG8_STAGE(PG8_SA(0, 1), a2 + hstep, voffA);
            PG8_WAIT_L(8); PG8_BAR; PG8_WAIT_L(0); PG8_MMA(0, 0, At, B0); PG8_BAR; PG8_SCHED;
            PG8_LDB(B1, 1, 1); PG8_STAGE(PG8_SB(1, 0), b3, voffB);
            PG8_BAR; PG8_WAIT_L(0); PG8_MMA(0, 1, At, B1); PG8_BAR;
            PG8_LDA(At, 1, 1); PG8_STAGE(PG8_SA(1, 0), a3, voffA);
            PG8_BAR; PG8_WAIT_L(0); PG8_MMA(1, 0, At, B0); PG8_BAR; PG8_SCHED;
            PG8_STAGE(PG8_SB(1, 1), b3 + hstep, voffB);
            PG8_WAIT_V(6); PG8_BAR; PG8_MMA(1, 1, At, B1); PG8_BAR;
            }
        }
        if constexpr (ALIGN_EPI) { if (wr == 0) PG8_BAR; }
        if constexpr (!Epi::AFTER_DRAIN) { E(acc, cur, wr, wc, fr, fq); S.done(cur); }
        if (!has_next) break;
#pragma unroll
        for (int a = 0; a < 2; ++a)
#pragma unroll
            for (int b = 0; b < 2; ++b)
#pragma unroll
                for (int m = 0; m < 4; ++m)
#pragma unroll
                    for (int n = 0; n < 2; ++n) acc[a][b][m][n] = (f32x4){0.f, 0.f, 0.f, 0.f};
        cur = nxt; cA = nA; cB = nB; ++ui;
        if constexpr (ALIGN_EPI) { if (wr == 1) PG8_BAR; }
    }
    PG8_WAIT_V(0);
    if constexpr (!ALIGN_EPI) { if (wr == 0) PG8_BAR; }
    PG8_BAR;
    if constexpr (Epi::AFTER_DRAIN) { E.fused(acc, cur, wr, wc, fr, fq, lds, wid, lane); S.done(cur); }
#undef PG8_SA
#undef PG8_SB
#undef PG8_STAGE
#undef PG8_LDA
#undef PG8_LDB
#undef PG8_MMA
#undef PG8_WAIT_V
#undef PG8_WAIT_L
#undef PG8_BAR
#undef PG8_SCHED
}
}

#define LAS __attribute__((address_space(3)))
__device__ __forceinline__ unsigned pk2(float lo, float hi) { return (unsigned)f2bf(lo) | ((unsigned)f2bf(hi) << 16); }
__device__ __forceinline__ void transpose_item(const float* W, int K, int N, bf16_t* WT, float* scr, int item, int lane) {
    const int nblk = N / 32, kb = item / nblk, nbk = item % nblk, k0 = 64 * kb, n0 = 32 * nbk;
#pragma unroll 8
    for (int i = 0; i < 32; ++i) { const int kk = 2 * i + (lane >> 5); scr[kk * 33 + (lane & 31)] = W[(size_t)(k0 + kk) * N + n0 + (lane & 31)]; }
    asm volatile("s_waitcnt lgkmcnt(0)" ::: "memory");
    const int c = lane & 7;
#pragma unroll
    for (int j = 0; j < 4; ++j) { const int n = (lane >> 3) + 8 * j; const float* s = scr + (8 * c) * 33 + n;
        uint4 o; o.x = pk2(s[0 * 33], s[1 * 33]); o.y = pk2(s[2 * 33], s[3 * 33]); o.z = pk2(s[4 * 33], s[5 * 33]); o.w = pk2(s[6 * 33], s[7 * 33]);
        *(uint4*)(WT + (size_t)(n0 + n) * K + k0 + 8 * c) = o; }
    asm volatile("s_waitcnt lgkmcnt(0)" ::: "memory");
}
__device__ __forceinline__ void phase_convert_weights(KP p, float* lds, int bid, int nb) {
    const int tid = opaque_tid(), lane = tid & 63, wave = tid >> 6;
    float* scr = lds + wave * (64 * 33);
    const int gw = bid * 8 + wave, ngw = nb * 8;
    constexpr int I_IN = (D / 64) * (NPROJ / 32), I_SQ = (D / 64) * (D / 32), I_G = 8 * (128 / 64) * (128 / 32);
    constexpr int NITEMS = I_IN + 2 * I_SQ + 2 * I_G;
    for (int it = gw; it < NITEMS; it += ngw) {
        int r = it;
        if (r < I_IN) { transpose_item(p->in[I_WIN], D, NPROJ, (bf16_t*)(p->ws + WS_WIN_T), scr, r, lane); continue; } r -= I_IN;
        if (r < I_SQ) { transpose_item(p->in[I_WOUT], D, D, (bf16_t*)(p->ws + WS_WOUT_T), scr, r, lane); continue; } r -= I_SQ;
        if (r < I_SQ) { transpose_item(p->in[I_WQ], D, D, (bf16_t*)(p->ws + WS_WQ_T), scr, r, lane); continue; } r -= I_SQ;
        if (r < I_G) { const int hd = r / 8; transpose_item(p->in[I_WGA] + hd * 16384, 128, 128, (bf16_t*)(p->ws + WS_WGA_T) + hd * 16384, scr, r % 8, lane); continue; } r -= I_G;
        { const int hd = r / 8; transpose_item(p->in[I_WGI] + hd * 16384, 128, 128, (bf16_t*)(p->ws + WS_WGI_T) + hd * 16384, scr, r % 8, lane); }
    }
    bf16_t* wsp = (bf16_t*)(p->ws + WS_WSPB); bf16_t* skb = (bf16_t*)(p->ws + WS_SKEYB);
    for (int e = bid * NT + tid; e < 8 * 128 * 128; e += nb * NT) { const int i = (e >> 7) & 127, j = e & 127; wsp[e] = f2bf(j <= i ? p->in[I_WSP][e] : 0.f); }
    for (int e = bid * NT + tid; e < 8 * 2 * 128 * 128; e += nb * NT) skb[e] = f2bf(p->in[I_SKEY][e]);
}

typedef short bf16x8_t __attribute__((ext_vector_type(8)));
typedef float f32x4_t __attribute__((ext_vector_type(4)));
typedef short s16x4_t __attribute__((ext_vector_type(4)));
constexpr int XA_STRIDE = 272;
constexpr int LRU_XA = 0, LRU_SA = 34816, LRU_SB = LRU_SA + 16384, LRU_SEGP = LRU_SB + 16384, LRU_SEGH = LRU_SEGP + 2048;
__device__ __forceinline__ void phase_lru(KP p, unsigned char* lds, int bid, int nb) {
    const int tid = opaque_tid(), lane = tid & 63, wave = tid >> 6, c16 = lane & 15, q = lane >> 4;
    const bf16_t* XL = (const bf16_t*)(p->ws + WS_PROJ); const bf16_t* YG = XL + (size_t)M * 1024; bf16_t* ymix = (bf16_t*)(p->ws + WS_YMIX);
    float* SA = (float*)(lds + LRU_SA); float* SB = (float*)(lds + LRU_SB); float* SEGP = (float*)(lds + LRU_SEGP); float* SEGH = (float*)(lds + LRU_SEGH);
    for (int unit = bid; unit < NB * 8 * 4; unit += nb) {
        const int b = unit >> 5, hd = (unit >> 2) & 7, cq = unit & 3;
        bf16x8_t wf[2][2][4];
#pragma unroll
        for (int gs = 0; gs < 2; ++gs)
#pragma unroll
            for (int nt = 0; nt < 2; ++nt)
#pragma unroll
                for (int ks = 0; ks < 4; ++ks)
                    wf[gs][nt][ks] = *(const bf16x8_t*)((const bf16_t*)(p->ws + (gs ? WS_WGI_T : WS_WGA_T)) + ((size_t)(hd * 128 + cq * 32 + nt * 16 + c16) * 128 + ks * 32 + 8 * q));
        float ba[2], bi[2], c2[2];
#pragma unroll
        for (int nt = 0; nt < 2; ++nt) { const int ch = hd * 128 + cq * 32 + nt * 16 + c16; ba[nt] = p->in[I_BGA][ch]; bi[nt] = p->in[I_BGI][ch];
            const float lam = p->in[I_LAM][ch]; const float sp = fmaxf(-lam, 0.f) + log1pf(__expf(-fabsf(lam))); c2[nt] = -8.f * sp * 1.4426950408889634f; }
        const int o = tid & 15, rg = tid >> 4;
        float cw[4][8], cb[8];
#pragma unroll
        for (int e = 0; e < 8; ++e) { cb[e] = p->in[I_CONVB][hd * 128 + o * 8 + e];
#pragma unroll
            for (int k = 0; k < 4; ++k) cw[k][e] = p->in[I_CONVW][k * DLRU + hd * 128 + o * 8 + e]; }
        const int sc = tid & 31, seg = tid >> 5;
        float carry = 0.f;
        for (int ch = 0; ch < SEQ / 128; ++ch) {
            const int t0 = ch * 128; const size_t row0 = (size_t)b * SEQ + t0;
            bf16_t yg[8];
#pragma unroll
            for (int k = 0; k < 8; ++k) yg[k] = YG[(row0 + seg * 8 + k) * 1024 + hd * 128 + cq * 32 + sc];
            uint4 xr[7];
#pragma unroll
            for (int i = 0; i < 7; ++i) { const int t = t0 + 4 * rg - 3 + i;
                xr[i] = t >= 0 ? *(const uint4*)(XL + ((size_t)b * SEQ + t) * 1024 + hd * 128 + o * 8) : make_uint4(0u, 0u, 0u, 0u); }
#pragma unroll
            for (int r = 0; r < 4; ++r) {
                float acc8[8];
#pragma unroll
                for (int e = 0; e < 8; ++e) acc8[e] = cb[e];
#pragma unroll
                for (int k = 0; k < 4; ++k) { const uint4 w = xr[r + k]; const unsigned ww[4] = {w.x, w.y, w.z, w.w};
#pragma unroll
                    for (int e2 = 0; e2 < 4; ++e2) { acc8[2 * e2] += cw[k][2 * e2] * __uint_as_float(ww[e2] << 16); acc8[2 * e2 + 1] += cw[k][2 * e2 + 1] * __uint_as_float(ww[e2] & 0xffff0000u); } }
                uint4 ov; ov.x = pk2(acc8[0], acc8[1]); ov.y = pk2(acc8[2], acc8[3]); ov.z = pk2(acc8[4], acc8[5]); ov.w = pk2(acc8[6], acc8[7]);
                *(uint4*)(lds + LRU_XA + (4 * rg + r) * XA_STRIDE + o * 16) = ov;
            }
            __syncthreads();
            f32x4_t acc[2][2];
#pragma unroll
            for (int gs = 0; gs < 2; ++gs)
#pragma unroll
                for (int nt = 0; nt < 2; ++nt) acc[gs][nt] = (f32x4_t){0.f, 0.f, 0.f, 0.f};
#pragma unroll
            for (int ks = 0; ks < 4; ++ks) {
                const bf16x8_t a = *(const bf16x8_t*)(lds + LRU_XA + (16 * wave + c16) * XA_STRIDE + (ks * 32 + 8 * q) * 2);
#pragma unroll
                for (int gs = 0; gs < 2; ++gs)
#pragma unroll
                    for (int nt = 0; nt < 2; ++nt) acc[gs][nt] = __builtin_amdgcn_mfma_f32_16x16x32_bf16(a, wf[gs][nt][ks], acc[gs][nt], 0, 0, 0);
            }
#pragma unroll
            for (int nt = 0; nt < 2; ++nt)
#pragma unroll
                for (int reg = 0; reg < 4; ++reg) {
                    const int t = 16 * wave + 4 * q + reg, jj = nt * 16 + c16;
                    const float za = acc[0][nt][reg] + ba[nt], zi = acc[1][nt][reg] + bi[nt];
                    const float r = __builtin_amdgcn_rcpf(1.f + __expf(-za)), ig = __builtin_amdgcn_rcpf(1.f + __expf(-zi));
                    const float a = __builtin_amdgcn_exp2f(c2[nt] * r);
                    const float xcv = bf2f(*(const bf16_t*)(lds + LRU_XA + t * XA_STRIDE + (cq * 32 + jj) * 2));
                    SA[t * 32 + jj] = a; SB[t * 32 + jj] = __builtin_amdgcn_sqrtf(fmaxf(1.f - a * a, 0.f)) * (ig * xcv);
                }
            __syncthreads();
            float av[8], bv[8];
#pragma unroll
            for (int k = 0; k < 8; ++k) { av[k] = SA[(seg * 8 + k) * 32 + sc]; bv[k] = SB[(seg * 8 + k) * 32 + sc]; }
            float P = 1.f, H = 0.f;
#pragma unroll
            for (int k = 0; k < 8; ++k) { H = av[k] * H + bv[k]; P *= av[k]; }
            SEGP[seg * 32 + sc] = P; SEGH[seg * 32 + sc] = H;
            __syncthreads();
            float run = carry, hin = carry;
#pragma unroll
            for (int s = 0; s < 16; ++s) { if (s == seg) hin = run; run = SEGP[s * 32 + sc] * run + SEGH[s * 32 + sc]; }
            carry = run;
            H = hin;
#pragma unroll
            for (int k = 0; k < 8; ++k) { H = av[k] * H + bv[k]; ymix[(row0 + seg * 8 + k) * D + hd * 128 + cq * 32 + sc] = f2bf(H * bf2f(yg[k])); }
        }
        __syncthreads();
    }
}

constexpr int SGU_RS = 0, SGU_TV = 512, SGU_SS = SGU_TV + 128 * XA_STRIDE, SS_STRIDE = 132;
__device__ __forceinline__ void phase_sgu(KP p, unsigned char* lds, int bid, int nb) {
    const int tid = opaque_tid(), lane = tid & 63, wave = tid >> 6, c16 = lane & 15, q = lane >> 4;
    const bf16_t* UG = (const bf16_t*)(p->ws + WS_PROJ) + (size_t)2 * M * 1024; const bf16_t* VG = UG + (size_t)M * 1024;
    const float* ssqv = (const float*)(p->ws + WS_SSQV); bf16_t* ymix = (bf16_t*)(p->ws + WS_YMIX);
    float* RS = (float*)(lds + SGU_RS); float* SS = (float*)(lds + SGU_SS);
    bf16x8_t wa[8][4]; float gvv[8]; int gcur = -1;
    const int oct = tid & 15;
    for (int it = bid; it < NB * 16 * 8; it += nb) {
        const int g = it & 7; const size_t base = (size_t)(it >> 3) * 128;
        if (g != gcur) { gcur = g;
#pragma unroll
            for (int mt = 0; mt < 8; ++mt)
#pragma unroll
                for (int ks = 0; ks < 4; ++ks) if (ks <= ((16 * mt + 15) >> 5))
                    wa[mt][ks] = *(const bf16x8_t*)((const bf16_t*)(p->ws + WS_WSPB) + ((size_t)(g * 128 + mt * 16 + c16) * 128 + ks * 32 + 8 * q));
#pragma unroll
            for (int e = 0; e < 8; ++e) gvv[e] = p->in[I_GV][g * 128 + oct * 8 + e]; }
        uint4 vch[4], uch[4];
#pragma unroll
        for (int k = 0; k < 4; ++k) { const int row = (tid >> 4) + 32 * k; vch[k] = *(const uint4*)(VG + (base + row) * 1024 + g * 128 + oct * 8); uch[k] = *(const uint4*)(UG + (base + row) * 1024 + g * 128 + oct * 8); }
        if (tid < 128) { float ss = 0.f;
#pragma unroll
            for (int k = 0; k < 16; ++k) ss += ssqv[(base + tid) * 16 + k];
            RS[tid] = rsqrtf(ss * (1.f / 1024.f) + EPS); }
        __syncthreads();
#pragma unroll
        for (int k = 0; k < 4; ++k) { const int row = (tid >> 4) + 32 * k; const float r = RS[row]; const unsigned ww[4] = {vch[k].x, vch[k].y, vch[k].z, vch[k].w}; unsigned oo[4];
#pragma unroll
            for (int e2 = 0; e2 < 4; ++e2) oo[e2] = pk2(__uint_as_float(ww[e2] << 16) * r * gvv[2 * e2], __uint_as_float(ww[e2] & 0xffff0000u) * r * gvv[2 * e2 + 1]);
            *(uint4*)(lds + SGU_TV + row * XA_STRIDE + oct * 16) = make_uint4(oo[0], oo[1], oo[2], oo[3]); }
        __syncthreads();
        bf16x8_t bfr[4];
        { const int q4 = c16 >> 2, p4 = c16 & 3;
#pragma unroll
          for (int ks = 0; ks < 4; ++ks) {
              const unsigned a1 = SGU_TV + (ks * 32 + 8 * q + q4) * XA_STRIDE + (wave * 16 + 4 * p4) * 2;
              const s16x4_t lo = __builtin_amdgcn_ds_read_tr16_b64_v4i16((LAS s16x4_t*)(lds + a1));
              const s16x4_t hi = __builtin_amdgcn_ds_read_tr16_b64_v4i16((LAS s16x4_t*)(lds + a1 + 4 * XA_STRIDE));
              bfr[ks] = __builtin_shufflevector(lo, hi, 0, 1, 2, 3, 4, 5, 6, 7); } }
        f32x4_t acc[8];
#pragma unroll
        for (int mt = 0; mt < 8; ++mt) { acc[mt] = (f32x4_t){0.f, 0.f, 0.f, 0.f};
#pragma unroll
            for (int ks = 0; ks < 4; ++ks) if (ks <= ((16 * mt + 15) >> 5)) acc[mt] = __builtin_amdgcn_mfma_f32_16x16x32_bf16(wa[mt][ks], bfr[ks], acc[mt], 0, 0, 0); }
#pragma unroll
        for (int mt = 0; mt < 8; ++mt)
#pragma unroll
            for (int reg = 0; reg < 4; ++reg) { const int i = mt * 16 + 4 * q + reg; SS[i * SS_STRIDE + wave * 16 + c16] = acc[mt][reg] + p->in[I_BSP][g * 128 + i]; }
        __syncthreads();
#pragma unroll
        for (int k = 0; k < 4; ++k) { const int row = (tid >> 4) + 32 * k; const float4 s0 = *(const float4*)(SS + row * SS_STRIDE + oct * 8), s1 = *(const float4*)(SS + row * SS_STRIDE + oct * 8 + 4);
            const unsigned ww[4] = {uch[k].x, uch[k].y, uch[k].z, uch[k].w}; const float sv[8] = {s0.x, s0.y, s0.z, s0.w, s1.x, s1.y, s1.z, s1.w}; unsigned oo[4];
#pragma unroll
            for (int e2 = 0; e2 < 4; ++e2) oo[e2] = pk2(__uint_as_float(ww[e2] << 16) * sv[2 * e2], __uint_as_float(ww[e2] & 0xffff0000u) * sv[2 * e2 + 1]);
            *(uint4*)(ymix + (base + row) * D + 1024 + g * 128 + oct * 8) = make_uint4(oo[0], oo[1], oo[2], oo[3]); }
        __syncthreads();
    }
}

typedef float f32x16_t __attribute__((ext_vector_type(16)));
__device__ __forceinline__ float vmaxf(float a, float b) { float r; asm("v_max_f32 %0, %1, %2" : "=v"(r) : "v"(a), "v"(b)); return r; }
__device__ __forceinline__ float vminf(float a, float b) { float r; asm("v_min_f32 %0, %1, %2" : "=v"(r) : "v"(a), "v"(b)); return r; }
#define CE_DESC(a, b) do { const float _mx = vmaxf(a, b), _mn = vminf(a, b); a = _mx; b = _mn; } while (0)
__device__ __forceinline__ void sort16_desc(float (&v)[16]) {
#pragma unroll
    for (int k = 2; k <= 16; k <<= 1)
#pragma unroll
        for (int j = k >> 1; j > 0; j >>= 1)
#pragma unroll
            for (int i = 0; i < 16; ++i) { const int l = i ^ j; if (l > i) { if ((i & k) == 0) CE_DESC(v[i], v[l]); else CE_DESC(v[l], v[i]); } }
}
__device__ __forceinline__ void merge16_desc(float (&a)[16], const float (&b)[16]) {
#pragma unroll
    for (int i = 0; i < 16; ++i) a[i] = vmaxf(a[i], b[15 - i]);
#pragma unroll
    for (int j = 8; j > 0; j >>= 1)
#pragma unroll
        for (int i = 0; i < 16; ++i) { const int l = i ^ j; if (l > i) CE_DESC(a[i], a[l]); }
}
__device__ __forceinline__ void topk_half(const bf16_t* qp, const unsigned char* kl, unsigned hh4, float (&X)[16]) {
    f32x16_t acc[4];
#pragma unroll
    for (int kt = 0; kt < 4; ++kt)
#pragma unroll
        for (int i = 0; i < 16; ++i) acc[kt][i] = 0.f;
#pragma unroll
    for (int ks = 0; ks < 8; ++ks) {
        const bf16x8_t bq = *(const bf16x8_t*)(qp + ks * 16);
#pragma unroll
        for (int kt = 0; kt < 4; ++kt) { const bf16x8_t ak = *(const bf16x8_t*)(kl + kt * 32 * XA_STRIDE + ks * 32); acc[kt] = __builtin_amdgcn_mfma_f32_32x32x16_bf16(ak, bq, acc[kt], 0, 0, 0); }
    }
    float g[4][16];
#pragma unroll
    for (int kt = 0; kt < 4; ++kt)
#pragma unroll
        for (int reg = 0; reg < 16; ++reg) g[kt][reg] = __uint_as_float(((__float_as_uint(acc[kt][reg]) & 0xFFFFFF80u) | hh4) | (unsigned)(kt * 32 + (reg & 3) + 8 * (reg >> 2)));
    sort16_desc(g[0]); sort16_desc(g[1]); sort16_desc(g[2]); sort16_desc(g[3]);
    merge16_desc(g[0], g[1]); merge16_desc(g[2], g[3]); merge16_desc(g[0], g[2]);
#pragma unroll
    for (int i = 0; i < 16; ++i) X[i] = g[0][i];
}
__device__ __forceinline__ unsigned pack_b0(float a, float b, float c, float d) {
    const unsigned ab = __builtin_amdgcn_perm(__float_as_uint(b), __float_as_uint(a), 0x0c0c0400u), cd = __builtin_amdgcn_perm(__float_as_uint(d), __float_as_uint(c), 0x0c0c0400u);
    return __builtin_amdgcn_perm(cd, ab, 0x05040100u);
}
__device__ __forceinline__ unsigned byte_lookup(const unsigned (&pk)[4], unsigned e) {
    const unsigned lo = __builtin_amdgcn_perm(pk[1], pk[0], e & 7u), hi = __builtin_amdgcn_perm(pk[3], pk[2], e & 7u);
    return ((e & 8u) ? hi : lo) & 0x7Fu;
}
__device__ __forceinline__ void phase_topk(KP p, unsigned char* lds, int bid, int nb) {
    const int tid = opaque_tid(), lane = tid & 63, wave = tid >> 6, r32 = lane & 31, hh = lane >> 5;
    const bf16_t* Q = (const bf16_t*)(p->ws + WS_Q); const bf16_t* KB = (const bf16_t*)(p->ws + WS_SKEYB);
    int* idx = (int*)(p->ws + WS_IDX); float* gate = (float*)(p->ws + WS_GATE);
    const float NEG = -3.0e38f;
    int hcur = -1;
    for (int bi = bid; bi < NHEAD * (M / 256); bi += nb) {
        const int hd = bi & 7, tile = (bi >> 3) * 8 + wave; const size_t token = (size_t)tile * 32 + r32;
        if (hd != hcur) { hcur = hd; __syncthreads();
#pragma unroll
            for (int k = 0; k < 8; ++k) { const int c = tid + NT * k, row = c >> 4, o = c & 15;
                *(uint4*)(lds + row * XA_STRIDE + o * 16) = *(const uint4*)(KB + ((size_t)hd * 256 + row) * 128 + o * 8); }
            __syncthreads(); }
        float X0[16], X1[16];
        topk_half(Q + token * D + hd * 256 + 8 * hh, lds + r32 * XA_STRIDE + hh * 16, 4u * hh, X0);
        __builtin_amdgcn_sched_barrier(0);
        topk_half(Q + token * D + hd * 256 + 128 + 8 * hh, lds + (128 + r32) * XA_STRIDE + hh * 16, 4u * hh, X1);
        __builtin_amdgcn_sched_barrier(0);
#pragma unroll
        for (int i = 0; i < 16; ++i) { const auto r = __builtin_amdgcn_permlane32_swap(__float_as_uint(X0[i]), __float_as_uint(X1[i]), false, false); X0[i] = __uint_as_float(r[0]); X1[i] = __uint_as_float(r[1]); }
        merge16_desc(X0, X1);
        float U[16];
#pragma unroll
        for (int i = 0; i < 16; ++i) U[i] = __shfl_xor(X0[i], 32);
        const unsigned hbit = (unsigned)hh << 8;
        float c0[16], c1[16];
#pragma unroll
        for (int j = 0; j < 16; ++j) { float s = X0[0] + U[j]; if (j == 0) s = hh ? NEG : s; c0[j] = __uint_as_float(((__float_as_uint(s) & 0xFFFFFE00u) | hbit) | (unsigned)j); }
        {
            int n = 0;
#pragma unroll
            for (int i = 1; i < 4; ++i)
#pragma unroll
                for (int j = i; j < 16; ++j) if ((i + 1) * (j + 1) <= 16) { float s = X0[i] + U[j]; if (j == i) s = hh ? NEG : s; c1[n] = __uint_as_float(((__float_as_uint(s) & 0xFFFFFE00u) | hbit) | (unsigned)(i * 16 + j)); ++n; }
#pragma unroll
            for (int k = 11; k < 16; ++k) c1[k] = NEG;
        }
        sort16_desc(c0); sort16_desc(c1); merge16_desc(c0, c1);
        float F[16];
#pragma unroll
        for (int i = 0; i < 16; ++i) F[i] = vmaxf(c0[i], __shfl_xor(c0[15 - i], 32));
        float mx = F[0];
#pragma unroll
        for (int i = 1; i < 16; ++i) mx = vmaxf(mx, F[i]);
        float ev[16], sum = 0.f;
#pragma unroll
        for (int i = 0; i < 16; ++i) { ev[i] = __expf(F[i] - mx); sum += ev[i]; }
        const float inv = 1.f / sum;
        unsigned pt[4], pu[4], pa[4], pb[4];
#pragma unroll
        for (int w = 0; w < 4; ++w) { pt[w] = pack_b0(X0[4 * w], X0[4 * w + 1], X0[4 * w + 2], X0[4 * w + 3]); pu[w] = pack_b0(U[4 * w], U[4 * w + 1], U[4 * w + 2], U[4 * w + 3]); }
#pragma unroll
        for (int w = 0; w < 4; ++w) { pa[w] = hh ? pu[w] : pt[w]; pb[w] = hh ? pt[w] : pu[w]; }
        int oi[8]; float og[8];
#pragma unroll
        for (int k = 0; k < 8; ++k) {
            const unsigned pl = __float_as_uint(F[k]) & 0x1FFu, sw = pl >> 8, pi = (pl >> 4) & 15u, pj = pl & 15u;
            const unsigned ai = sw ? pj : pi, bj = sw ? pi : pj;
            oi[k] = (int)(byte_lookup(pa, ai) * NKEYS + byte_lookup(pb, bj)); og[k] = ev[k] * inv;
        }
        int* io = idx + token * NSEL + hd * TOPK + 8 * hh; float* go = gate + token * NSEL + hd * TOPK + 8 * hh;
        *(int4*)io = make_int4(oi[0], oi[1], oi[2], oi[3]); *(int4*)(io + 4) = make_int4(oi[4], oi[5], oi[6], oi[7]);
        *(float4*)go = make_float4(og[0], og[1], og[2], og[3]); *(float4*)(go + 4) = make_float4(og[4], og[5], og[6], og[7]);
    }
}

__device__ __forceinline__ void wave_argmax(float& v, int& i) {
#pragma unroll
    for (int off = 32; off >= 1; off >>= 1) { const float ov = __shfl_xor(v, off); const int oi = __shfl_xor(i, off); if (ov > v || (ov == v && oi < i)) { v = ov; i = oi; } }
}
__device__ __forceinline__ void topk_half_naive(const bf16_t* q, const float* k0, int lane, float& outv, int& outi) {
    const float NEG = -3.0e38f;
    const float* k1 = k0 + 64 * 128;
    float s0 = 0.f, s1 = 0.f;
    for (int k = 0; k < 128; k += 4) {
        const uint2 qq = *(const uint2*)(q + k);
        const float q0 = bf2f((bf16_t)(qq.x & 0xffff)), q1 = bf2f((bf16_t)(qq.x >> 16)), q2 = bf2f((bf16_t)(qq.y & 0xffff)), q3 = bf2f((bf16_t)(qq.y >> 16));
        const float4 a = *(const float4*)(k0 + k), b = *(const float4*)(k1 + k);
        s0 += q0 * a.x + q1 * a.y + q2 * a.z + q3 * a.w; s1 += q0 * b.x + q1 * b.y + q2 * b.z + q3 * b.w;
    }
    float myv = NEG; int myi = 0;
    for (int r = 0; r < TOPK; ++r) {
        float v; int i; if (s0 >= s1) { v = s0; i = lane; } else { v = s1; i = lane + 64; }
        wave_argmax(v, i);
        if (i == lane) s0 = NEG; if (i == lane + 64) s1 = NEG;
        if (lane == r) { myv = v; myi = i; }
    }
    outv = myv; outi = myi;
}
__device__ __forceinline__ void phase_topk_naive(KP p, int bid, int nb) {
    const bf16_t* Q = (const bf16_t*)(p->ws + WS_Q); const float* keys = p->in[I_SKEY];
    int* idx = (int*)(p->ws + WS_IDX); float* gate = (float*)(p->ws + WS_GATE);
    const int tid = opaque_tid(), lane = tid & 63, wave = tid >> 6;
    const float NEG = -3.0e38f;
    for (int task = bid * 8 + wave; task < M * NHEAD; task += nb * 8) {
        const int token = task >> 3, hd = task & 7;
        float tv0, tv1; int ti0, ti1;
        topk_half_naive(Q + (size_t)token * D + hd * 256, keys + ((size_t)(hd * 2) * 128 + lane) * 128, lane, tv0, ti0);
        topk_half_naive(Q + (size_t)token * D + hd * 256 + 128, keys + ((size_t)(hd * 2 + 1) * 128 + lane) * 128, lane, tv1, ti1);
        const float vb = __shfl(tv1, lane & 15);
        float c0 = __shfl(tv0, (lane >> 4)) + vb, c1 = __shfl(tv0, (lane >> 4) + 4) + vb, c2 = __shfl(tv0, (lane >> 4) + 8) + vb, c3 = __shfl(tv0, (lane >> 4) + 12) + vb;
        float selv = NEG; int selc = 0;
        for (int r = 0; r < TOPK; ++r) {
            float v = c0; int i = lane;
            if (c1 > v) { v = c1; i = lane + 64; }
            if (c2 > v) { v = c2; i = lane + 128; }
            if (c3 > v) { v = c3; i = lane + 192; }
            wave_argmax(v, i);
            if (i == lane) c0 = NEG; if (i == lane + 64) c1 = NEG; if (i == lane + 128) c2 = NEG; if (i == lane + 192) c3 = NEG;
            if (lane == r) { selv = v; selc = i; }
        }
        const float mx = __shfl(selv, 0);
        const float e = lane < TOPK ? __expf(selv - mx) : 0.f;
        const float sum = wave_sum(e);
        const int i1 = __shfl(ti0, selc >> 4), i2 = __shfl(ti1, selc & 15);
        if (lane < TOPK) { idx[(size_t)token * NSEL + hd * TOPK + lane] = i1 * NKEYS + i2; gate[(size_t)token * NSEL + hd * TOPK + lane] = e / sum; }
    }
}

typedef float f32x2_t __attribute__((ext_vector_type(2)));
__device__ __forceinline__ float wave_max(float v) {
#pragma unroll
    for (int o = 1; o < 64; o <<= 1) v = fmaxf(v, __shfl_xor(v, o));
    return v;
}
__device__ __forceinline__ void phase_convert_experts(KP p, int bid, int nb) {
    const int tid = opaque_tid(), lane = tid & 63, wave = tid >> 6;
    for (int row = bid * 8 + wave; row < 2 * NKEYS * NKEYS; row += nb * 8) {
        const int t = row >= NKEYS * NKEYS, e = row - t * NKEYS * NKEYS;
        const float* src = (t ? p->in[I_EV] : p->in[I_EU]) + (size_t)e * D;
        unsigned* dst = (unsigned*)(p->ws + (t ? WS_EV8 : WS_EU8) + (size_t)e * D);
        float4 v[8]; float am = 0.f;
#pragma unroll
        for (int j = 0; j < 8; ++j) { v[j] = *(const float4*)(src + lane * 4 + 256 * j); am = fmaxf(am, fmaxf(fmaxf(fabsf(v[j].x), fabsf(v[j].y)), fmaxf(fabsf(v[j].z), fabsf(v[j].w)))); }
        am = wave_max(am);
        int ex = 0; if (am > 0.f) (void)frexpf(am, &ex); else ex = 8;
        const float sc = ldexpf(1.f, 8 - ex);
#pragma unroll
        for (int j = 0; j < 8; ++j) { int w = __builtin_amdgcn_cvt_pk_fp8_f32(v[j].x * sc, v[j].y * sc, 0, false); w = __builtin_amdgcn_cvt_pk_fp8_f32(v[j].z * sc, v[j].w * sc, w, true); dst[lane + 64 * j] = (unsigned)w; }
        if (lane == 0) ((float*)(p->ws + WS_ESCALE))[row] = ldexpf(1.f, ex - 8);
    }
}
__device__ __forceinline__ void phase_peer(KP p, float* lds, int bid, int nb) {
    const bf16_t* H = (const bf16_t*)(p->ws + WS_H); const int* idx = (const int*)(p->ws + WS_IDX); const float* gate = (const float*)(p->ws + WS_GATE);
    const unsigned char* EU = p->ws + WS_EU8; const unsigned char* EV = p->ws + WS_EV8; const float* esc = (const float*)(p->ws + WS_ESCALE); const float* gf = p->in[I_GFIN];
    const int tid = opaque_tid(), lane = tid & 63, wave = tid >> 6;
    for (int i = tid; i < NB * D; i += NT) lds[i] = mod_at(p, i >> 11, 5 * D + (i & (D - 1)));
    __syncthreads();
    for (int token = bid * 8 + wave; token < M; token += nb * 8) {
        f32x2_t hv[16];
#pragma unroll
        for (int j = 0; j < 2; ++j)
#pragma unroll
            for (int hq = 0; hq < 2; ++hq) { const uint4 w = *(const uint4*)(H + (size_t)token * D + lane * 16 + 1024 * j + 8 * hq); const unsigned ww[4] = {w.x, w.y, w.z, w.w};
#pragma unroll
                for (int c = 0; c < 4; ++c) hv[8 * j + 4 * hq + c] = (f32x2_t){__uint_as_float(ww[c] << 16), __uint_as_float(ww[c] & 0xffff0000u)}; }
        const int e0 = idx[(size_t)token * NSEL + lane], e1 = idx[(size_t)token * NSEL + 64 + lane];
        const float us0 = esc[e0], us1 = esc[e1], vs0 = esc[NKEYS * NKEYS + e0], vs1 = esc[NKEYS * NKEYS + e1];
        const float gg0 = gate[(size_t)token * NSEL + lane], gg1 = gate[(size_t)token * NSEL + 64 + lane];
        float act0 = 0.f, act1 = 0.f;
        for (int s = 0; s < NSEL; s += 8) {
            const int ee = s < 64 ? e0 : e1; const int sl = s & 63;
            uint4 r[8][2];
#pragma unroll
            for (int k = 0; k < 8; ++k) { const int e = __builtin_amdgcn_readlane(ee, sl + k); const unsigned char* base = EU + (size_t)e * D + lane * 16;
                r[k][0] = *(const uint4*)base; r[k][1] = *(const uint4*)(base + 1024); }
#pragma unroll
            for (int k = 0; k < 8; ++k) { f32x2_t d2 = {0.f, 0.f};
#pragma unroll
                for (int j = 0; j < 2; ++j) { const unsigned ww[4] = {r[k][j].x, r[k][j].y, r[k][j].z, r[k][j].w};
#pragma unroll
                    for (int c = 0; c < 4; ++c) { d2 = __builtin_elementwise_fma(__builtin_amdgcn_cvt_pk_f32_fp8(ww[c], false), hv[8 * j + 2 * c], d2); d2 = __builtin_elementwise_fma(__builtin_amdgcn_cvt_pk_f32_fp8(ww[c], true), hv[8 * j + 2 * c + 1], d2); } }
                const float d = wave_sum(d2.x + d2.y);
                if (lane == sl + k) { if (s < 64) act0 = d; else act1 = d; } }
        }
        act0 = gelu_t(act0 * us0) * gg0 * vs0; act1 = gelu_t(act1 * us1) * gg1 * vs1;
        f32x2_t acc[16];
#pragma unroll
        for (int j = 0; j < 16; ++j) acc[j] = (f32x2_t){0.f, 0.f};
        for (int s = 0; s < NSEL; s += 8) {
            const int ee = s < 64 ? e0 : e1; const float aa = s < 64 ? act0 : act1; const int sl = s & 63;
            uint4 r[8][2];
#pragma unroll
            for (int k = 0; k < 8; ++k) { const int e = __builtin_amdgcn_readlane(ee, sl + k); const unsigned char* base = EV + (size_t)e * D + lane * 16;
                r[k][0] = *(const uint4*)base; r[k][1] = *(const uint4*)(base + 1024); }
#pragma unroll
            for (int k = 0; k < 8; ++k) { const float a = __builtin_bit_cast(float, __builtin_amdgcn_readlane(__builtin_bit_cast(int, aa), sl + k)); const f32x2_t a2 = {a, a};
#pragma unroll
                for (int j = 0; j < 2; ++j) { const unsigned ww[4] = {r[k][j].x, r[k][j].y, r[k][j].z, r[k][j].w};
#pragma unroll
                    for (int c = 0; c < 4; ++c) { acc[8 * j + 2 * c] = __builtin_elementwise_fma(__builtin_amdgcn_cvt_pk_f32_fp8(ww[c], false), a2, acc[8 * j + 2 * c]); acc[8 * j + 2 * c + 1] = __builtin_elementwise_fma(__builtin_amdgcn_cvt_pk_f32_fp8(ww[c], true), a2, acc[8 * j + 2 * c + 1]); } } }
        }
        const float* gt = lds + (token / SEQ) * D;
        float ss = 0.f;
#pragma unroll
        for (int j = 0; j < 2; ++j)
#pragma unroll
            for (int hq = 0; hq < 4; ++hq) {
                const int col = lane * 16 + 1024 * j + 4 * hq;
                const float4 x1 = *(const float4*)(p->out + (size_t)token * D + col); const float4 g4 = *(const float4*)(gt + col);
                f32x2_t& a0 = acc[8 * j + 2 * hq]; f32x2_t& a1 = acc[8 * j + 2 * hq + 1];
                a0.x = x1.x + g4.x * a0.x; a0.y = x1.y + g4.y * a0.y; a1.x = x1.z + g4.z * a1.x; a1.y = x1.w + g4.w * a1.y;
                ss += a0.x * a0.x + a0.y * a0.y + a1.x * a1.x + a1.y * a1.y;
            }
        const float rstd = rsqrtf(wave_sum(ss) * (1.f / D) + EPS);
#pragma unroll
        for (int j = 0; j < 2; ++j)
#pragma unroll
            for (int hq = 0; hq < 4; ++hq) {
                const int col = lane * 16 + 1024 * j + 4 * hq;
                const float4 g4 = *(const float4*)(gf + col); const f32x2_t a0 = acc[8 * j + 2 * hq], a1 = acc[8 * j + 2 * hq + 1];
                float4 o; o.x = a0.x * rstd * g4.x; o.y = a0.y * rstd * g4.y; o.z = a1.x * rstd * g4.z; o.w = a1.y * rstd * g4.w;
                *(float4*)(p->out + (size_t)token * D + col) = o;
            }
    }
}

extern __shared__ __attribute__((aligned(16))) unsigned char dyn_lds[];
constexpr int LDS_BYTES = 147456;
__global__ void __launch_bounds__(NT) fwd_megakernel(Params p_unused) {
    cg::grid_group grid = cg::this_grid();
    KP p = (KP)__builtin_amdgcn_kernarg_segment_ptr();
    float* lds = (float*)dyn_lds;
    const int bid = blockIdx.x, nb = gridDim.x;
    phase_mod(p, lds, bid, nb);
    __syncthreads();
    phase_convert_weights(p, lds, bid, nb);
    phase_convert_experts(p, bid, nb);
    grid.sync();
    phase_hrows(p, p->in[I_X], p->in[I_GMIX], 0, D, (bf16_t*)(p->ws + WS_H), lds, bid, nb);
    grid.sync();
    { pg8::Gemm g{(const bf16_t*)(p->ws + WS_H), (const bf16_t*)(p->ws + WS_WIN_T), M, NPROJ, D}; pg8::StaticOrder S; S.init(M, NPROJ, nb, bid);
      pg8::EpiProj E{(bf16_t*)(p->ws + WS_PROJ), (float*)(p->ws + WS_SSQV), M};
      pg8::gemm_phase<pg8::EpiProj, pg8::StaticOrder, true, true>((LAS unsigned char*)dyn_lds, g, S, E); }
    grid.sync();
    phase_lru(p, dyn_lds, bid, nb);
    phase_sgu(p, dyn_lds, bid, nb);
    grid.sync();
    { pg8::Gemm g{(const bf16_t*)(p->ws + WS_YMIX), (const bf16_t*)(p->ws + WS_WOUT_T), M, D, D}; pg8::StaticOrder S; S.init(M, D, nb, bid);
      pg8::EpiX1 E{p->in[I_X], p->out, (const float*)(p->ws + WS_MODP), p->in[I_BADA], 2 * D, NMOD, SEQ};
      pg8::gemm_phase<pg8::EpiX1, pg8::StaticOrder, true, true>((LAS unsigned char*)dyn_lds, g, S, E); }
    grid.sync();
    phase_hrows(p, p->out, p->in[I_GFFN], 3 * D, 4 * D, (bf16_t*)(p->ws + WS_H), lds, bid, nb);
    grid.sync();
    { pg8::Gemm g{(const bf16_t*)(p->ws + WS_H), (const bf16_t*)(p->ws + WS_WQ_T), M, D, D}; pg8::StaticOrder S; S.init(M, D, nb, bid);
      pg8::EpiQ E{(bf16_t*)(p->ws + WS_Q), D};
      pg8::gemm_phase<pg8::EpiQ, pg8::StaticOrder, true, true>((LAS unsigned char*)dyn_lds, g, S, E); }
    grid.sync();
    phase_topk(p, dyn_lds, bid, nb);
    grid.sync();
    phase_peer(p, lds, bid, nb);
}

extern "C" void kernel_launch(void* const* d_in, const int* in_sizes, int n_in, void* d_out, int out_size, void* d_ws, size_t ws_size, hipStream_t stream) {
    static int grid_blocks = 0;
    if (grid_blocks == 0) {
        if (n_in != 23 || in_sizes[0] != M * D || out_size != M * D || ws_size < WS_END) { fprintf(stderr, "kernel_launch: unexpected shapes (n_in %d in0 %d out %d ws %zu)\n", n_in, n_in > 0 ? in_sizes[0] : -1, out_size, ws_size); grid_blocks = -1; return; }
        if (hipFuncSetAttribute((const void*)fwd_megakernel, hipFuncAttributeMaxDynamicSharedMemorySize, LDS_BYTES) != hipSuccess) { fprintf(stderr, "hipFuncSetAttribute failed\n"); grid_blocks = -1; return; }
        int dev = 0, cus = 0, per_cu = 0;
        hipGetDevice(&dev);
        hipDeviceGetAttribute(&cus, hipDeviceAttributeMultiprocessorCount, dev);
        if (hipOccupancyMaxActiveBlocksPerMultiprocessor(&per_cu, (const void*)fwd_megakernel, NT, LDS_BYTES) != hipSuccess || per_cu < 1) { fprintf(stderr, "occupancy query failed (%d)\n", per_cu); grid_blocks = -1; return; }
        grid_blocks = cus;
    }
    if (grid_blocks < 0) return;
    Params p{};
    for (int i = 0; i < 23; ++i) p.in[i] = (const float*)d_in[i];
    p.out = (float*)d_out; p.ws = (unsigned char*)d_ws;
    void* args[] = {&p};
    hipError_t e = hipLaunchCooperativeKernel((const void*)fwd_megakernel, dim3(grid_blocks), dim3(NT), args, LDS_BYTES, stream);
    if (e != hipSuccess) fprintf(stderr, "cooperative launch failed: %s (grid %d)\n", hipGetErrorString(e), grid_blocks);
}
```

```cpp
#include <hip/hip_runtime.h>
#include <hip/hip_cooperative_groups.h>
#include <cstdio>
#include <cstdint>

constexpr int D = 2048, NB = 8, SEQ = 2048, M = NB * SEQ;
constexpr int DLRU = 1024, DSGU = 1024, NPROJ = 4096;
constexpr int NMOD = 6 * D;
constexpr int NHEAD = 8, NKEYS = 128, TOPK = 16, NSEL = NHEAD * TOPK;
constexpr float EPS = 1e-6f;
constexpr int NT = 512;
namespace cg = cooperative_groups;

constexpr size_t MiB = 1u << 20;
constexpr size_t WS_CTL = 0;
constexpr size_t WS_MODP = 1 * MiB;
constexpr size_t WS_WGA_T = 3 * MiB;
constexpr size_t WS_WGI_T = 3 * MiB + 262144;
constexpr size_t WS_WSPB = 3 * MiB + 524288;
constexpr size_t WS_SKEYB = 3 * MiB + 786432;
constexpr size_t WS_SSQV = 5 * MiB;
constexpr size_t WS_RSTDV = 8 * MiB;
constexpr size_t WS_WIN_T = 9 * MiB;
constexpr size_t WS_WOUT_T = 25 * MiB;
constexpr size_t WS_WQ_T = 33 * MiB;
constexpr size_t WS_IDX = 41 * MiB;
constexpr size_t WS_GATE = 49 * MiB;
constexpr size_t WS_H = 64 * MiB;
constexpr size_t WS_PROJ = 128 * MiB;
constexpr size_t WS_Q = 128 * MiB;
constexpr size_t WS_YMIX = 256 * MiB;
constexpr size_t WS_EU8 = 320 * MiB;
constexpr size_t WS_EV8 = 352 * MiB;
constexpr size_t WS_ESCALE = 57 * MiB;
constexpr size_t WS_XC = 320 * MiB;
constexpr size_t WS_A = 384 * MiB;
constexpr size_t WS_BB = 448 * MiB;
constexpr size_t WS_END = 512 * MiB;

typedef unsigned short bf16_t;
struct Params { const float* in[23]; float* out; unsigned char* ws; };
typedef const __attribute__((address_space(4))) Params* KP;
enum { I_X = 0, I_C, I_WADA, I_BADA, I_GMIX, I_WIN, I_CONVW, I_CONVB, I_WGA, I_BGA, I_WGI, I_BGI, I_LAM, I_GV, I_WSP, I_BSP, I_WOUT, I_GFFN, I_WQ, I_SKEY, I_EU, I_EV, I_GFIN };

__device__ __forceinline__ int opaque_tid() { int t = threadIdx.x; asm volatile("" : "+v"(t)); return t; }
__device__ __forceinline__ float bf2f(bf16_t v) { return __uint_as_float(((unsigned)v) << 16); }
__device__ __forceinline__ bf16_t f2bf(float f) { unsigned u = __float_as_uint(f); u += 0x7fffu + ((u >> 16) & 1u); return (bf16_t)(u >> 16); }
__device__ __forceinline__ float sigmoidf_(float x) { return 1.f / (1.f + __expf(-x)); }
__device__ __forceinline__ float gelu_t(float x) { const float u = 0.7978845608028654f * (x + 0.044715f * x * x * x); return x * sigmoidf_(2.f * u); }
__device__ __forceinline__ float wave_sum(float v) {
#pragma unroll
    for (int o = 1; o < 64; o <<= 1) v += __shfl_xor(v, o);
    return v;
}
__device__ __forceinline__ float mod_at(KP p, int b, int n) {
    const float* mp = (const float*)(p->ws + WS_MODP);
    float s = p->in[I_BADA][n];
#pragma unroll
    for (int kc = 0; kc < 4; ++kc) s += mp[(size_t)(kc * 8 + b) * NMOD + n];
    return s;
}

__device__ __forceinline__ void phase_mod(KP p, float* lds, int bid, int nb) {
    const int tid = opaque_tid(), lane = tid & 63, wave = tid >> 6;
    const float* c = p->in[I_C]; const float* W = p->in[I_WADA];
    float* modp = (float*)(p->ws + WS_MODP);
    for (int i = tid; i < NB * D; i += NT) { const float v = c[i]; lds[i] = v * sigmoidf_(v); }
    __syncthreads();
    float* red = lds + NB * D;
    for (int item = bid; item < 192; item += nb) {
        const int nt = item % 48, kc = item / 48;
        const int n0 = nt * 256 + lane * 4, k0 = kc * 512 + wave * 64;
        float acc[8][4];
#pragma unroll
        for (int b = 0; b < 8; ++b)
#pragma unroll
            for (int j = 0; j < 4; ++j) acc[b][j] = 0.f;
        for (int kk = 0; kk < 64; ++kk) {
            const float4 w = *(const float4*)(W + (size_t)(k0 + kk) * NMOD + n0);
#pragma unroll
            for (int b = 0; b < 8; ++b) { const float s = lds[b * D + k0 + kk]; acc[b][0] += s * w.x; acc[b][1] += s * w.y; acc[b][2] += s * w.z; acc[b][3] += s * w.w; }
        }
#pragma unroll
        for (int b = 0; b < 8; ++b)
#pragma unroll
            for (int j = 0; j < 4; ++j) red[(wave * 32 + b * 4 + j) * 64 + lane] = acc[b][j];
        __syncthreads();
        for (int o = tid; o < 2048; o += NT) {
            const int b = o >> 8, nn = o & 255, ln = nn >> 2, j = nn & 3;
            float s = 0.f;
#pragma unroll
            for (int w = 0; w < 8; ++w) s += red[(w * 32 + b * 4 + j) * 64 + ln];
            modp[(size_t)(kc * 8 + b) * NMOD + nt * 256 + nn] = s;
        }
        __syncthreads();
    }
}

__device__ __forceinline__ void phase_hrows(KP p, const float* src, const float* gn, int shift_off, int scale_off, bf16_t* dst, float* lds, int bid, int nb) {
    const int tid = opaque_tid(), lane = tid & 63, wave = tid >> 6;
    float* Aw = lds; float* Bw = lds + D;
    for (int item = bid; item < M / 64; item += nb) {
        const int b = item / (SEQ / 64);
        for (int col = tid; col < D; col += NT) { Aw[col] = gn[col] * (1.f + mod_at(p, b, scale_off + col)); Bw[col] = mod_at(p, b, shift_off + col); }
        __syncthreads();
        for (int r = wave; r < 64; r += 8) {
            const size_t row = (size_t)item * 64 + r;
            float4 v[8]; float ss = 0.f;
#pragma unroll
            for (int j = 0; j < 8; ++j) { v[j] = *(const float4*)(src + row * D + lane * 4 + 256 * j); ss += v[j].x * v[j].x + v[j].y * v[j].y + v[j].z * v[j].z + v[j].w * v[j].w; }
            const float rstd = rsqrtf(wave_sum(ss) * (1.f / D) + EPS);
#pragma unroll
            for (int j = 0; j < 8; ++j) {
                const int col = lane * 4 + 256 * j;
                const float o0 = v[j].x * rstd * Aw[col] + Bw[col], o1 = v[j].y * rstd * Aw[col + 1] + Bw[col + 1];
                const float o2 = v[j].z * rstd * Aw[col + 2] + Bw[col + 2], o3 = v[j].w * rstd * Aw[col + 3] + Bw[col + 3];
                uint2 w; w.x = (unsigned)f2bf(o0) | ((unsigned)f2bf(o1) << 16); w.y = (unsigned)f2bf(o2) | ((unsigned)f2bf(o3) << 16);
                *(uint2*)(dst + row * D + col) = w;
            }
        }
        __syncthreads();
    }
}

namespace pg8 {
#define PG8_LAS __attribute__((address_space(3)))
typedef unsigned short bf16_t;
typedef short bf16x8 __attribute__((ext_vector_type(8)));
typedef float f32x4 __attribute__((ext_vector_type(4)));
typedef unsigned u32x4 __attribute__((ext_vector_type(4)));
constexpr int BM = 256, BK = 64, HALF = 128, HTB = HALF * BK * 2  , STAGE_BYTES = 8 * HTB, NXCD = 8, WGM = 8;

__host__ __device__ __forceinline__ int lds_byte(int r, int c) { const int st = (r >> 4) * 2 + (c >> 5), rr = r & 15, cc = c & 31, ob = rr * 64 + cc * 2; return st * 1024 + (ob ^ (((ob >> 9) & 1) << 5)); }
__host__ __device__ __forceinline__ void stage_rc(int b, int& R, int& C) { const int st = b / 1024, sb = b % 1024, swz = sb ^ (((sb >> 9) & 1) << 5); R = (st >> 1) * 16 + swz / 64; C = (st & 1) * 32 + (swz % 64) / 2; }
__host__ __device__ __forceinline__ int perm32(int rho) { const int n = rho >> 4, i = rho & 15; return 8 * (i >> 2) + 4 * n + (i & 3); }

struct Unit { int pm, pn; };
struct Gemm { const bf16_t* A; const bf16_t* Bt; int M, N, K; };

struct StaticOrder {
    int nM, nN, nwg, G, c;
    __host__ __device__ void init(int M, int N, int G_, int c_) { nM = M / BM; nN = N / BM; nwg = nM * nN; G = G_; c = c_; }
    __host__ __device__ bool next(int i, Unit& u) const {
        const long L = (long)i * G + c; if (L >= nwg) return false;
        int wgid = (int)L; { const int q = nwg / NXCD, r = nwg % NXCD, xcd = wgid % NXCD, off = wgid / NXCD; wgid = (xcd < r ? xcd * (q + 1) : r * (q + 1) + (xcd - r) * q) + off; }
        const int nig = WGM * nN, gid = wgid / nig, fm = gid * WGM, gsz = (nM - fm) < WGM ? (nM - fm) : WGM;
        u.pm = fm + ((wgid % nig) % gsz); u.pn = (wgid % nig) / gsz; return true;
    }
    __device__ __forceinline__ void a_ready(const Unit&) const {}
    __device__ __forceinline__ void done(const Unit&) const {}
};


__device__ __forceinline__ unsigned cvt_pk_bf16(float lo, float hi) { unsigned r; asm volatile("v_cvt_pk_bf16_f32 %0, %1, %2" : "=v"(r) : "v"(lo), "v"(hi)); return r; }
__device__ __forceinline__ float gelu_tanh(float x) { const float u = 1.5957691216057308f * (x + 0.044715f * x * x * x); return x * __builtin_amdgcn_rcpf(1.f + __expf(-u)); }
struct EpiProj {
    static constexpr bool PERM = true, AFTER_DRAIN = false;
    bf16_t* proj; float* ssqv; int Mrows;
    __device__ __forceinline__ void operator()(const f32x4 (&acc)[2][2][4][2], const Unit& u, int wr, int wc, int fr, int fq) const {
        const int which = (u.pn * BM) >> 10, colt = (u.pn * BM) & 1023;
        bf16_t* base = proj + (size_t)which * Mrows * 1024;
        const int row0 = u.pm * BM + wr * 64 + fr, col0 = colt + wc * 32 + 8 * fq;
#pragma unroll
        for (int ai = 0; ai < 2; ++ai)
#pragma unroll
            for (int m = 0; m < 4; ++m) { const int row = row0 + ai * HALF + m * 16; bf16_t* rowp = base + (size_t)row * 1024 + col0; float ss = 0.f;
#pragma unroll
                for (int bj = 0; bj < 2; ++bj) { f32x4 v0 = acc[ai][bj][m][0], v1 = acc[ai][bj][m][1];
                    if (which) {
#pragma unroll
                        for (int j = 0; j < 4; ++j) { v0[j] = gelu_tanh(v0[j]); v1[j] = gelu_tanh(v1[j]); } }
                    ss += (v0[0] * v0[0] + v0[1] * v0[1]) + (v0[2] * v0[2] + v0[3] * v0[3]) + (v1[0] * v1[0] + v1[1] * v1[1]) + (v1[2] * v1[2] + v1[3] * v1[3]);
                    u32x4 w; w.x = cvt_pk_bf16(v0[0], v0[1]); w.y = cvt_pk_bf16(v0[2], v0[3]); w.z = cvt_pk_bf16(v1[0], v1[1]); w.w = cvt_pk_bf16(v1[2], v1[3]);
                    *(u32x4*)(rowp + bj * HALF) = w; }
                if (which == 3) { ss += __shfl_xor(ss, 16); ss += __shfl_xor(ss, 32); if (fq == 0) ssqv[(size_t)row * 16 + (u.pn & 3) * 4 + wc] = ss; } }
    }
};
struct EpiX1 {
    static constexpr bool PERM = false, AFTER_DRAIN = false;
    const float* x; float* out; const float* modp; const float* bada; int goff, nmod, seq;
    __device__ __forceinline__ void operator()(const f32x4 (&acc)[2][2][4][2], const Unit& u, int wr, int wc, int fr, int fq) const {
        const int row0 = u.pm * BM + wr * 64 + fr, col0 = u.pn * BM + wc * 32 + 4 * fq, b = (u.pm * BM) / seq;
        f32x4 gv[2][2];
#pragma unroll
        for (int bj = 0; bj < 2; ++bj)
#pragma unroll
            for (int n = 0; n < 2; ++n) { const int c = goff + col0 + bj * HALF + n * 16; f32x4 g = *(const f32x4*)(bada + c);
#pragma unroll
                for (int kc = 0; kc < 4; ++kc) g += *(const f32x4*)(modp + (size_t)(kc * 8 + b) * nmod + c);
                gv[bj][n] = g; }
#pragma unroll
        for (int ai = 0; ai < 2; ++ai)
#pragma unroll
            for (int m = 0; m < 4; ++m) { const size_t off = (size_t)(row0 + ai * HALF + m * 16) * (size_t)(2048) + col0;
#pragma unroll
                for (int bj = 0; bj < 2; ++bj)
#pragma unroll
                    for (int n = 0; n < 2; ++n) { const f32x4 xv = *(const f32x4*)(x + off + bj * HALF + n * 16); *(f32x4*)(out + off + bj * HALF + n * 16) = xv + gv[bj][n] * acc[ai][bj][m][n]; } }
    }
};
struct EpiQ {
    static constexpr bool PERM = true, AFTER_DRAIN = false;
    bf16_t* O; int ldc;
    __device__ __forceinline__ void operator()(const f32x4 (&acc)[2][2][4][2], const Unit& u, int wr, int wc, int fr, int fq) const {
        const int row0 = u.pm * BM + wr * 64 + fr, col0 = u.pn * BM + wc * 32 + 8 * fq;
#pragma unroll
        for (int ai = 0; ai < 2; ++ai)
#pragma unroll
            for (int m = 0; m < 4; ++m) { bf16_t* rowp = O + (size_t)(row0 + ai * HALF + m * 16) * ldc + col0;
#pragma unroll
                for (int bj = 0; bj < 2; ++bj) { const f32x4 v0 = acc[ai][bj][m][0], v1 = acc[ai][bj][m][1];
                    u32x4 w; w.x = cvt_pk_bf16(v0[0], v0[1]); w.y = cvt_pk_bf16(v0[2], v0[3]); w.z = cvt_pk_bf16(v1[0], v1[1]); w.w = cvt_pk_bf16(v1[2], v1[3]);
                    *(u32x4*)(rowp + bj * HALF) = w; } }
    }
};

template <class Epi, class Sched, bool ALIGN_EPI = false, bool SP2 = false>
__device__ __forceinline__ void gemm_phase(PG8_LAS unsigned char* lds, const Gemm g, const Sched& S, const Epi& E) {
    const int tid = opaque_tid(), wid = __builtin_amdgcn_readfirstlane(tid >> 6), lane = tid & 63, wr = wid >> 2, wc = wid & 3, fr = lane & 15, fq = lane >> 4;
    const int K = g.K, nt = K / BK;
    unsigned voffA[2], voffB[2];
#pragma unroll
    for (int i = 0; i < 2; ++i) { int R, C; stage_rc(tid * 16 + i * 8192, R, C); const int Rb = Epi::PERM ? ((R & ~31) + perm32(R & 31)) : R;
        voffA[i] = (unsigned)(R * K + C) * 2u; voffB[i] = (unsigned)(Rb * K + C) * 2u; }
    const size_t kstep = (size_t)(BK * 2);
    const size_t hstep = (size_t)HALF * K * 2;
    const size_t tstep = 2 * hstep;
    const unsigned ldsw = (unsigned)wid * 1024u;
    const int aoff = lds_byte(wr * 64 + fr, fq * 8), boff = lds_byte(wc * 32 + fr, fq * 8);
#define PG8_SA(b, h) (((b) * 2 + (h)) * HTB)
#define PG8_SB(b, h) ((4 + (b) * 2 + (h)) * HTB)
#define PG8_STAGE(bufoff, gbase, voff) do { _Pragma("unroll") for (int _i = 0; _i < 2; ++_i) \
        __builtin_amdgcn_global_load_lds((const unsigned*)((const char*)(gbase) + (voff)[_i]), (PG8_LAS unsigned*)(lds + (bufoff) + ldsw + _i * 8192), 16, 0, 0); } while (0)
#define PG8_LDA(dst, b, h) do { _Pragma("unroll") for (int m = 0; m < 4; ++m) _Pragma("unroll") for (int k = 0; k < 2; ++k) dst[m][k] = *(const PG8_LAS bf16x8*)(lds + PG8_SA(b, h) + aoff + m * 2048 + k * 1024); } while (0)
#define PG8_LDB(dst, b, h) do { _Pragma("unroll") for (int n = 0; n < 2; ++n) _Pragma("unroll") for (int k = 0; k < 2; ++k) dst[n][k] = *(const PG8_LAS bf16x8*)(lds + PG8_SB(b, h) + boff + n * 2048 + k * 1024); } while (0)
#define PG8_MMA(ai, bj, At, Bt) do { __builtin_amdgcn_s_setprio(1); _Pragma("unroll") for (int m = 0; m < 4; ++m) _Pragma("unroll") for (int n = 0; n < 2; ++n) _Pragma("unroll") for (int k = 0; k < 2; ++k) \
        acc[ai][bj][m][n] = __builtin_amdgcn_mfma_f32_16x16x32_bf16(Bt[n][k], At[m][k], acc[ai][bj][m][n], 0, 0, 0); __builtin_amdgcn_s_setprio(0); } while (0)
#define PG8_WAIT_V(n) asm volatile("s_waitcnt vmcnt(" #n ")" ::: "memory")
#define PG8_WAIT_L(n) asm volatile("s_waitcnt lgkmcnt(" #n ")" ::: "memory")
#define PG8_BAR __builtin_amdgcn_s_barrier()
#define PG8_SCHED __builtin_amdgcn_sched_barrier(0)
    Unit cur, nxt; int ui = 0;
    if (!S.next(0, cur)) return;
    f32x4 acc[2][2][4][2];
#pragma unroll
    for (int a = 0; a < 2; ++a)
#pragma unroll
        for (int b = 0; b < 2; ++b)
#pragma unroll
            for (int m = 0; m < 4; ++m)
#pragma unroll
                for (int n = 0; n < 2; ++n) acc[a][b][m][n] = (f32x4){0.f, 0.f, 0.f, 0.f};
    bf16x8 At[4][2], B0[2][2], B1[2][2];
    const char* cA = (const char*)g.A + (size_t)cur.pm * tstep; const char* cB = (const char*)g.Bt + (size_t)cur.pn * tstep;
    S.a_ready(cur);
    if constexpr (SP2) {
        PG8_STAGE(PG8_SB(0, 0), cB, voffB); PG8_STAGE(PG8_SB(0, 1), cB + hstep, voffB); PG8_STAGE(PG8_SA(0, 0), cA, voffA); PG8_STAGE(PG8_SA(0, 1), cA + hstep, voffA);
        if (wr == 1) PG8_BAR;
        PG8_WAIT_V(2); PG8_BAR;
        PG8_STAGE(PG8_SB(1, 0), cB + kstep, voffB); PG8_STAGE(PG8_SA(1, 0), cA + kstep, voffA); PG8_STAGE(PG8_SB(1, 1), cB + hstep + kstep, voffB);
        PG8_WAIT_V(6); PG8_BAR;
    } else {
        PG8_STAGE(PG8_SB(0, 0), cB, voffB); PG8_STAGE(PG8_SA(0, 0), cA, voffA); PG8_STAGE(PG8_SB(0, 1), cB + hstep, voffB); PG8_STAGE(PG8_SA(0, 1), cA + hstep, voffA);
        if (wr == 1) PG8_BAR;
        PG8_WAIT_V(4); PG8_BAR;
        PG8_STAGE(PG8_SB(1, 0), cB + kstep, voffB); PG8_STAGE(PG8_SA(1, 0), cA + kstep, voffA); PG8_STAGE(PG8_SB(1, 1), cB + hstep + kstep, voffB);
        PG8_WAIT_V(6); PG8_BAR;
    }
    for (;;) {
        const bool has_next = S.next(ui + 1, nxt);
        const char* nA = has_next ? (const char*)g.A + (size_t)nxt.pm * tstep : cA; const char* nB = has_next ? (const char*)g.Bt + (size_t)nxt.pn * tstep : cB;
        for (int t = 0; t < nt; t += 2) {
            const bool last = (t == nt - 2);
            const char* a1 = cA + (size_t)(t + 1) * kstep;
            const char* a2 = last ? nA : cA + (size_t)(t + 2) * kstep; const char* b2 = last ? nB : cB + (size_t)(t + 2) * kstep;
            const char* a3 = a2 + kstep; const char* b3 = b2 + kstep;
            if (last && has_next) S.a_ready(nxt);
            if constexpr (SP2) {
            PG8_LDB(B0, 0, 0); PG8_LDB(B1, 0, 1); PG8_SCHED; PG8_LDA(At, 0, 0); PG8_STAGE(PG8_SA(1, 1), a1 + hstep, voffA);
            PG8_WAIT_V(8); PG8_WAIT_L(0); PG8_BAR; PG8_MMA(0, 0, At, B0); PG8_MMA(0, 1, At, B1); PG8_BAR; PG8_SCHED;
            PG8_LDA(At, 0, 1); PG8_STAGE(PG8_SB(0, 0), b2, voffB); PG8_STAGE(PG8_SB(0, 1), b2 + hstep, voffB); PG8_STAGE(PG8_SA(0, 0), a2, voffA);
            PG8_WAIT_V(8); PG8_WAIT_L(0); PG8_BAR; PG8_MMA(1, 0, At, B0); PG8_MMA(1, 1, At, B1); PG8_BAR; PG8_SCHED;
            PG8_LDB(B0, 1, 0); PG8_LDB(B1, 1, 1); PG8_SCHED; PG8_LDA(At, 1, 0); PG8_STAGE(PG8_SA(0, 1), a2 + hstep, voffA);
            PG8_WAIT_V(8); PG8_WAIT_L(0); PG8_BAR; PG8_MMA(0, 0, At, B0); PG8_MMA(0, 1, At, B1); PG8_BAR; PG8_SCHED;
            PG8_LDA(At, 1, 1); PG8_STAGE(PG8_SB(1, 0), b3, voffB); PG8_STAGE(PG8_SB(1, 1), b3 + hstep, voffB); PG8_STAGE(PG8_SA(1, 0), a3, voffA);
            PG8_WAIT_V(8); PG8_WAIT_L(0); PG8_BAR; PG8_MMA(1, 0, At, B0); PG8_MMA(1, 1, At, B1); PG8_BAR; PG8_SCHED;
            } else {
            PG8_LDB(B0, 0, 0); PG8_SCHED; PG8_LDA(At, 0, 0); PG8_STAGE(PG8_SA(1, 1), a1 + hstep, voffA);
            PG8_WAIT_L(8); PG8_BAR; PG8_WAIT_L(0); PG8_MMA(0, 0, At, B0); PG8_BAR; PG8_SCHED;
            PG8_LDB(B1, 0, 1); PG8_STAGE(PG8_SB(0, 0), b2, voffB);
            PG8_BAR; PG8_WAIT_L(0); PG8_MMA(0, 1, At, B1); PG8_BAR;
            PG8_LDA(At, 0, 1); PG8_STAGE(PG8_SA(0, 0), a2, voffA);
            PG8_BAR; PG8_WAIT_L(0); PG8_MMA(1, 0, At, B0); PG8_BAR; PG8_SCHED;
            PG8_STAGE(PG8_SB(0, 1), b2 + hstep, voffB);
            PG8_WAIT_V(6); PG8_BAR; PG8_MMA(1, 1, At, B1); PG8_BAR;
            PG8_LDB(B0, 1, 0); PG8_SCHED; PG8_LDA(At, 1, 0); PG8_STAGE(PG8_SA(0, 1), a2 + hstep, voffA);
            PG8_WAIT_L(8); PG8_BAR; PG8_WAIT_L(0); PG8_MMA(0, 0, At, B0); PG8_BAR; PG8_SCHED;
            PG8_LDB(B1, 1, 1); PG8_STAGE(PG8_SB(1, 0), b3, voffB);
            PG8_BAR; PG8_WAIT_L(0); PG8_MMA(0, 1, At, B1); PG8_BAR;
            PG8_LDA(At, 1, 1); PG8_STAGE(PG8_SA(1, 0), a3, voffA);
            PG8_BAR; PG8_WAIT_L(0); PG8_MMA(1, 0, At, B0); PG8_BAR; PG8_SCHED;
            PG8_STAGE(PG8_SB(1, 1), b3 + hstep, voffB);
            PG8_WAIT_V(6); PG8_BAR; PG8_MMA(1, 1, At, B1); PG8_BAR;
            }
        }
        if constexpr (ALIGN_EPI) { if (wr == 0) PG8_BAR; }
        if constexpr (!Epi::AFTER_DRAIN) { E(acc, cur, wr, wc, fr, fq); S.done(cur); }
        if (!has_next) break;
#pragma unroll
        for (int a = 0; a < 2; ++a)
#pragma unroll
            for (int b = 0; b < 2; ++b)
#pragma unroll
                for (int m = 0; m < 4; ++m)
#pragma unroll
                    for (int n = 0; n < 2; ++n) acc[a][b][m][n] = (f32x4){0.f, 0.f, 0.f, 0.f};
        cur = nxt; cA = nA; cB = nB; ++ui;
        if constexpr (ALIGN_EPI) { if (wr == 1) PG8_BAR; }
    }
    PG8_WAIT_V(0);
    if constexpr (!ALIGN_EPI) { if (wr == 0) PG8_BAR; }
    PG8_BAR;
    if constexpr (Epi::AFTER_DRAIN) { E.fused(acc, cur, wr, wc, fr, fq, lds, wid, lane); S.done(cur); }
#undef PG8_SA
#undef PG8_SB
#undef PG8_STAGE
#undef PG8_LDA
#undef PG8_LDB
#undef PG8_MMA
#undef PG8_WAIT_V
#undef PG8_WAIT_L
#undef PG8_BAR
#undef PG8_SCHED
}
}

#define LAS __attribute__((address_space(3)))
__device__ __forceinline__ unsigned pk2(float lo, float hi) { return (unsigned)f2bf(lo) | ((unsigned)f2bf(hi) << 16); }
__device__ __forceinline__ void transpose_item(const float* W, int K, int N, bf16_t* WT, float* scr, int item, int lane) {
    const int nblk = N / 32, kb = item / nblk, nbk = item % nblk, k0 = 64 * kb, n0 = 32 * nbk;
#pragma unroll 8
    for (int i = 0; i < 32; ++i) { const int kk = 2 * i + (lane >> 5); scr[kk * 33 + (lane & 31)] = W[(size_t)(k0 + kk) * N + n0 + (lane & 31)]; }
    asm volatile("s_waitcnt lgkmcnt(0)" ::: "memory");
    const int c = lane & 7;
#pragma unroll
    for (int j = 0; j < 4; ++j) { const int n = (lane >> 3) + 8 * j; const float* s = scr + (8 * c) * 33 + n;
        uint4 o; o.x = pk2(s[0 * 33], s[1 * 33]); o.y = pk2(s[2 * 33], s[3 * 33]); o.z = pk2(s[4 * 33], s[5 * 33]); o.w = pk2(s[6 * 33], s[7 * 33]);
        *(uint4*)(WT + (size_t)(n0 + n) * K + k0 + 8 * c) = o; }
    asm volatile("s_waitcnt lgkmcnt(0)" ::: "memory");
}
__device__ __forceinline__ void phase_convert_weights(KP p, float* lds, int bid, int nb) {
    const int tid = opaque_tid(), lane = tid & 63, wave = tid >> 6;
    float* scr = lds + wave * (64 * 33);
    const int gw = bid * 8 + wave, ngw = nb * 8;
    constexpr int I_IN = (D / 64) * (NPROJ / 32), I_SQ = (D / 64) * (D / 32), I_G = 8 * (128 / 64) * (128 / 32);
    constexpr int NITEMS = I_IN + 2 * I_SQ + 2 * I_G;
    for (int it = gw; it < NITEMS; it += ngw) {
        int r = it;
        if (r < I_IN) { transpose_item(p->in[I_WIN], D, NPROJ, (bf16_t*)(p->ws + WS_WIN_T), scr, r, lane); continue; } r -= I_IN;
        if (r < I_SQ) { transpose_item(p->in[I_WOUT], D, D, (bf16_t*)(p->ws + WS_WOUT_T), scr, r, lane); continue; } r -= I_SQ;
        if (r < I_SQ) { transpose_item(p->in[I_WQ], D, D, (bf16_t*)(p->ws + WS_WQ_T), scr, r, lane); continue; } r -= I_SQ;
        if (r < I_G) { const int hd = r / 8; transpose_item(p->in[I_WGA] + hd * 16384, 128, 128, (bf16_t*)(p->ws + WS_WGA_T) + hd * 16384, scr, r % 8, lane); continue; } r -= I_G;
        { const int hd = r / 8; transpose_item(p->in[I_WGI] + hd * 16384, 128, 128, (bf16_t*)(p->ws + WS_WGI_T) + hd * 16384, scr, r % 8, lane); }
    }
    bf16_t* wsp = (bf16_t*)(p->ws + WS_WSPB); bf16_t* skb = (bf16_t*)(p->ws + WS_SKEYB);
    for (int e = bid * NT + tid; e < 8 * 128 * 128; e += nb * NT) { const int i = (e >> 7) & 127, j = e & 127; wsp[e] = f2bf(j <= i ? p->in[I_WSP][e] : 0.f); }
    for (int e = bid * NT + tid; e < 8 * 2 * 128 * 128; e += nb * NT) skb[e] = f2bf(p->in[I_SKEY][e]);
}

typedef short bf16x8_t __attribute__((ext_vector_type(8)));
typedef float f32x4_t __attribute__((ext_vector_type(4)));
typedef short s16x4_t __attribute__((ext_vector_type(4)));
constexpr int XA_STRIDE = 272;
constexpr int LRU_XA = 0, LRU_SA = 34816, LRU_SB = LRU_SA + 16384, LRU_SEGP = LRU_SB + 16384, LRU_SEGH = LRU_SEGP + 2048;
__device__ __forceinline__ void phase_lru(KP p, unsigned char* lds, int bid, int nb) {
    const int tid = opaque_tid(), lane = tid & 63, wave = tid >> 6, c16 = lane & 15, q = lane >> 4;
    const bf16_t* XL = (const bf16_t*)(p->ws + WS_PROJ); const bf16_t* YG = XL + (size_t)M * 1024; bf16_t* ymix = (bf16_t*)(p->ws + WS_YMIX);
    float* SA = (float*)(lds + LRU_SA); float* SB = (float*)(lds + LRU_SB); float* SEGP = (float*)(lds + LRU_SEGP); float* SEGH = (float*)(lds + LRU_SEGH);
    for (int unit = bid; unit < NB * 8 * 4; unit += nb) {
        const int b = unit >> 5, hd = (unit >> 2) & 7, cq = unit & 3;
        bf16x8_t wf[2][2][4];
#pragma unroll
        for (int gs = 0; gs < 2; ++gs)
#pragma unroll
            for (int nt = 0; nt < 2; ++nt)
#pragma unroll
                for (int ks = 0; ks < 4; ++ks)
                    wf[gs][nt][ks] = *(const bf16x8_t*)((const bf16_t*)(p->ws + (gs ? WS_WGI_T : WS_WGA_T)) + ((size_t)(hd * 128 + cq * 32 + nt * 16 + c16) * 128 + ks * 32 + 8 * q));
        float ba[2], bi[2], c2[2];
#pragma unroll
        for (int nt = 0; nt < 2; ++nt) { const int ch = hd * 128 + cq * 32 + nt * 16 + c16; ba[nt] = p->in[I_BGA][ch]; bi[nt] = p->in[I_BGI][ch];
            const float lam = p->in[I_LAM][ch]; const float sp = fmaxf(-lam, 0.f) + log1pf(__expf(-fabsf(lam))); c2[nt] = -8.f * sp * 1.4426950408889634f; }
        const int o = tid & 15, rg = tid >> 4;
        float cw[4][8], cb[8];
#pragma unroll
        for (int e = 0; e < 8; ++e) { cb[e] = p->in[I_CONVB][hd * 128 + o * 8 + e];
#pragma unroll
            for (int k = 0; k < 4; ++k) cw[k][e] = p->in[I_CONVW][k * DLRU + hd * 128 + o * 8 + e]; }
        const int sc = tid & 31, seg = tid >> 5;
        float carry = 0.f;
        for (int ch = 0; ch < SEQ / 128; ++ch) {
            const int t0 = ch * 128; const size_t row0 = (size_t)b * SEQ + t0;
            bf16_t yg[8];
#pragma unroll
            for (int k = 0; k < 8; ++k) yg[k] = YG[(row0 + seg * 8 + k) * 1024 + hd * 128 + cq * 32 + sc];
            uint4 xr[7];
#pragma unroll
            for (int i = 0; i < 7; ++i) { const int t = t0 + 4 * rg - 3 + i;
                xr[i] = t >= 0 ? *(const uint4*)(XL + ((size_t)b * SEQ + t) * 1024 + hd * 128 + o * 8) : make_uint4(0u, 0u, 0u, 0u); }
#pragma unroll
            for (int r = 0; r < 4; ++r) {
                float acc8[8];
#pragma unroll
                for (int e = 0; e < 8; ++e) acc8[e] = cb[e];
#pragma unroll
                for (int k = 0; k < 4; ++k) { const uint4 w = xr[r + k]; const unsigned ww[4] = {w.x, w.y, w.z, w.w};
#pragma unroll
                    for (int e2 = 0; e2 < 4; ++e2) { acc8[2 * e2] += cw[k][2 * e2] * __uint_as_float(ww[e2] << 16); acc8[2 * e2 + 1] += cw[k][2 * e2 + 1] * __uint_as_float(ww[e2] & 0xffff0000u); } }
                uint4 ov; ov.x = pk2(acc8[0], acc8[1]); ov.y = pk2(acc8[2], acc8[3]); ov.z = pk2(acc8[4], acc8[5]); ov.w = pk2(acc8[6], acc8[7]);
                *(uint4*)(lds + LRU_XA + (4 * rg + r) * XA_STRIDE + o * 16) = ov;
            }
            __syncthreads();
            f32x4_t acc[2][2];
#pragma unroll
            for (int gs = 0; gs < 2; ++gs)
#pragma unroll
                for (int nt = 0; nt < 2; ++nt) acc[gs][nt] = (f32x4_t){0.f, 0.f, 0.f, 0.f};
#pragma unroll
            for (int ks = 0; ks < 4; ++ks) {
                const bf16x8_t a = *(const bf16x8_t*)(lds + LRU_XA + (16 * wave + c16) * XA_STRIDE + (ks * 32 + 8 * q) * 2);
#pragma unroll
                for (int gs = 0; gs < 2; ++gs)
#pragma unroll
                    for (int nt = 0; nt < 2; ++nt) acc[gs][nt] = __builtin_amdgcn_mfma_f32_16x16x32_bf16(a, wf[gs][nt][ks], acc[gs][nt], 0, 0, 0);
            }
#pragma unroll
            for (int nt = 0; nt < 2; ++nt)
#pragma unroll
                for (int reg = 0; reg < 4; ++reg) {
                    const int t = 16 * wave + 4 * q + reg, jj = nt * 16 + c16;
                    const float za = acc[0][nt][reg] + ba[nt], zi = acc[1][nt][reg] + bi[nt];
                    const float r = __builtin_amdgcn_rcpf(1.f + __expf(-za)), ig = __builtin_amdgcn_rcpf(1.f + __expf(-zi));
                    const float a = __builtin_amdgcn_exp2f(c2[nt] * r);
                    const float xcv = bf2f(*(const bf16_t*)(lds + LRU_XA + t * XA_STRIDE + (cq * 32 + jj) * 2));
                    SA[t * 32 + jj] = a; SB[t * 32 + jj] = __builtin_amdgcn_sqrtf(fmaxf(1.f - a * a, 0.f)) * (ig * xcv);
                }
            __syncthreads();
            float av[8], bv[8];
#pragma unroll
            for (int k = 0; k < 8; ++k) { av[k] = SA[(seg * 8 + k) * 32 + sc]; bv[k] = SB[(seg * 8 + k) * 32 + sc]; }
            float P = 1.f, H = 0.f;
#pragma unroll
            for (int k = 0; k < 8; ++k) { H = av[k] * H + bv[k]; P *= av[k]; }
            SEGP[seg * 32 + sc] = P; SEGH[seg * 32 + sc] = H;
            __syncthreads();
            float run = carry, hin = carry;
#pragma unroll
            for (int s = 0; s < 16; ++s) { if (s == seg) hin = run; run = SEGP[s * 32 + sc] * run + SEGH[s * 32 + sc]; }
            carry = run;
            H = hin;
#pragma unroll
            for (int k = 0; k < 8; ++k) { H = av[k] * H + bv[k]; ymix[(row0 + seg * 8 + k) * D + hd * 128 + cq * 32 + sc] = f2bf(H * bf2f(yg[k])); }
        }
        __syncthreads();
    }
}

constexpr int SGU_RS = 0, SGU_TV = 512, SGU_SS = SGU_TV + 128 * XA_STRIDE, SS_STRIDE = 132;
__device__ __forceinline__ void phase_sgu(KP p, unsigned char* lds, int bid, int nb) {
    const int tid = opaque_tid(), lane = tid & 63, wave = tid >> 6, c16 = lane & 15, q = lane >> 4;
    const bf16_t* UG = (const bf16_t*)(p->ws + WS_PROJ) + (size_t)2 * M * 1024; const bf16_t* VG = UG + (size_t)M * 1024;
    const float* ssqv = (const float*)(p->ws + WS_SSQV); bf16_t* ymix = (bf16_t*)(p->ws + WS_YMIX);
    float* RS = (float*)(lds + SGU_RS); float* SS = (float*)(lds + SGU_SS);
    bf16x8_t wa[8][4]; float gvv[8]; int gcur = -1;
    const int oct = tid & 15;
    for (int it = bid; it < NB * 16 * 8; it += nb) {
        const int g = it & 7; const size_t base = (size_t)(it >> 3) * 128;
        if (g != gcur) { gcur = g;
#pragma unroll
            for (int mt = 0; mt < 8; ++mt)
#pragma unroll
                for (int ks = 0; ks < 4; ++ks) if (ks <= ((16 * mt + 15) >> 5))
                    wa[mt][ks] = *(const bf16x8_t*)((const bf16_t*)(p->ws + WS_WSPB) + ((size_t)(g * 128 + mt * 16 + c16) * 128 + ks * 32 + 8 * q));
#pragma unroll
            for (int e = 0; e < 8; ++e) gvv[e] = p->in[I_GV][g * 128 + oct * 8 + e]; }
        uint4 vch[4], uch[4];
#pragma unroll
        for (int k = 0; k < 4; ++k) { const int row = (tid >> 4) + 32 * k; vch[k] = *(const uint4*)(VG + (base + row) * 1024 + g * 128 + oct * 8); uch[k] = *(const uint4*)(UG + (base + row) * 1024 + g * 128 + oct * 8); }
        if (tid < 128) { float ss = 0.f;
#pragma unroll
            for (int k = 0; k < 16; ++k) ss += ssqv[(base + tid) * 16 + k];
            RS[tid] = rsqrtf(ss * (1.f / 1024.f) + EPS); }
        __syncthreads();
#pragma unroll
        for (int k = 0; k < 4; ++k) { const int row = (tid >> 4) + 32 * k; const float r = RS[row]; const unsigned ww[4] = {vch[k].x, vch[k].y, vch[k].z, vch[k].w}; unsigned oo[4];
#pragma unroll
            for (int e2 = 0; e2 < 4; ++e2) oo[e2] = pk2(__uint_as_float(ww[e2] << 16) * r * gvv[2 * e2], __uint_as_float(ww[e2] & 0xffff0000u) * r * gvv[2 * e2 + 1]);
            *(uint4*)(lds + SGU_TV + row * XA_STRIDE + oct * 16) = make_uint4(oo[0], oo[1], oo[2], oo[3]); }
        __syncthreads();
        bf16x8_t bfr[4];
        { const int q4 = c16 >> 2, p4 = c16 & 3;
#pragma unroll
          for (int ks = 0; ks < 4; ++ks) {
              const unsigned a1 = SGU_TV + (ks * 32 + 8 * q + q4) * XA_STRIDE + (wave * 16 + 4 * p4) * 2;
              const s16x4_t lo = __builtin_amdgcn_ds_read_tr16_b64_v4i16((LAS s16x4_t*)(lds + a1));
              const s16x4_t hi = __builtin_amdgcn_ds_read_tr16_b64_v4i16((LAS s16x4_t*)(lds + a1 + 4 * XA_STRIDE));
              bfr[ks] = __builtin_shufflevector(lo, hi, 0, 1, 2, 3, 4, 5, 6, 7); } }
        f32x4_t acc[8];
#pragma unroll
        for (int mt = 0; mt < 8; ++mt) { acc[mt] = (f32x4_t){0.f, 0.f, 0.f, 0.f};
#pragma unroll
            for (int ks = 0; ks < 4; ++ks) if (ks <= ((16 * mt + 15) >> 5)) acc[mt] = __builtin_amdgcn_mfma_f32_16x16x32_bf16(wa[mt][ks], bfr[ks], acc[mt], 0, 0, 0); }
#pragma unroll
        for (int mt = 0; mt < 8; ++mt)
#pragma unroll
            for (int reg = 0; reg < 4; ++reg) { const int i = mt * 16 + 4 * q + reg; SS[i * SS_STRIDE + wave * 16 + c16] = acc[mt][reg] + p->in[I_BSP][g * 128 + i]; }
        __syncthreads();
#pragma unroll
        for (int k = 0; k < 4; ++k) { const int row = (tid >> 4) + 32 * k; const float4 s0 = *(const float4*)(SS + row * SS_STRIDE + oct * 8), s1 = *(const float4*)(SS + row * SS_STRIDE + oct * 8 + 4);
            const unsigned ww[4] = {uch[k].x, uch[k].y, uch[k].z, uch[k].w}; const float sv[8] = {s0.x, s0.y, s0.z, s0.w, s1.x, s1.y, s1.z, s1.w}; unsigned oo[4];
#pragma unroll
            for (int e2 = 0; e2 < 4; ++e2) oo[e2] = pk2(__uint_as_float(ww[e2] << 16) * sv[2 * e2], __uint_as_float(ww[e2] & 0xffff0000u) * sv[2 * e2 + 1]);
            *(uint4*)(ymix + (base + row) * D + 1024 + g * 128 + oct * 8) = make_uint4(oo[0], oo[1], oo[2], oo[3]); }
        __syncthreads();
    }
}

typedef float f32x16_t __attribute__((ext_vector_type(16)));
__device__ __forceinline__ float vmaxf(float a, float b) { float r; asm("v_max_f32 %0, %1, %2" : "=v"(r) : "v"(a), "v"(b)); return r; }
__device__ __forceinline__ float vminf(float a, float b) { float r; asm("v_min_f32 %0, %1, %2" : "=v"(r) : "v"(a), "v"(b)); return r; }
#define CE_DESC(a, b) do { const float _mx = vmaxf(a, b), _mn = vminf(a, b); a = _mx; b = _mn; } while (0)
__device__ __forceinline__ void sort16_desc(float (&v)[16]) {
#pragma unroll
    for (int k = 2; k <= 16; k <<= 1)
#pragma unroll
        for (int j = k >> 1; j > 0; j >>= 1)
#pragma unroll
            for (int i = 0; i < 16; ++i) { const int l = i ^ j; if (l > i) { if ((i & k) == 0) CE_DESC(v[i], v[l]); else CE_DESC(v[l], v[i]); } }
}
__device__ __forceinline__ void merge16_desc(float (&a)[16], const float (&b)[16]) {
#pragma unroll
    for (int i = 0; i < 16; ++i) a[i] = vmaxf(a[i], b[15 - i]);
#pragma unroll
    for (int j = 8; j > 0; j >>= 1)
#pragma unroll
        for (int i = 0; i < 16; ++i) { const int l = i ^ j; if (l > i) CE_DESC(a[i], a[l]); }
}
__device__ __forceinline__ void topk_half(const bf16_t* qp, const unsigned char* kl, unsigned hh4, float (&X)[16]) {
    f32x16_t acc[4];
#pragma unroll
    for (int kt = 0; kt < 4; ++kt)
#pragma unroll
        for (int i = 0; i < 16; ++i) acc[kt][i] = 0.f;
#pragma unroll
    for (int ks = 0; ks < 8; ++ks) {
        const bf16x8_t bq = *(const bf16x8_t*)(qp + ks * 16);
#pragma unroll
        for (int kt = 0; kt < 4; ++kt) { const bf16x8_t ak = *(const bf16x8_t*)(kl + kt * 32 * XA_STRIDE + ks * 32); acc[kt] = __builtin_amdgcn_mfma_f32_32x32x16_bf16(ak, bq, acc[kt], 0, 0, 0); }
    }
    float g[4][16];
#pragma unroll
    for (int kt = 0; kt < 4; ++kt)
#pragma unroll
        for (int reg = 0; reg < 16; ++reg) g[kt][reg] = __uint_as_float(((__float_as_uint(acc[kt][reg]) & 0xFFFFFF80u) | hh4) | (unsigned)(kt * 32 + (reg & 3) + 8 * (reg >> 2)));
    sort16_desc(g[0]); sort16_desc(g[1]); sort16_desc(g[2]); sort16_desc(g[3]);
    merge16_desc(g[0], g[1]); merge16_desc(g[2], g[3]); merge16_desc(g[0], g[2]);
#pragma unroll
    for (int i = 0; i < 16; ++i) X[i] = g[0][i];
}
__device__ __forceinline__ unsigned pack_b0(float a, float b, float c, float d) {
    const unsigned ab = __builtin_amdgcn_perm(__float_as_uint(b), __float_as_uint(a), 0x0c0c0400u), cd = __builtin_amdgcn_perm(__float_as_uint(d), __float_as_uint(c), 0x0c0c0400u);
    return __builtin_amdgcn_perm(cd, ab, 0x05040100u);
}
__device__ __forceinline__ unsigned byte_lookup(const unsigned (&pk)[4], unsigned e) {
    const unsigned lo = __builtin_amdgcn_perm(pk[1], pk[0], e & 7u), hi = __builtin_amdgcn_perm(pk[3], pk[2], e & 7u);
    return ((e & 8u) ? hi : lo) & 0x7Fu;
}
__device__ __forceinline__ void phase_topk(KP p, unsigned char* lds, int bid, int nb) {
    const int tid = opaque_tid(), lane = tid & 63, wave = tid >> 6, r32 = lane & 31, hh = lane >> 5;
    const bf16_t* Q = (const bf16_t*)(p->ws + WS_Q); const bf16_t* KB = (const bf16_t*)(p->ws + WS_SKEYB);
    int* idx = (int*)(p->ws + WS_IDX); float* gate = (float*)(p->ws + WS_GATE);
    const float NEG = -3.0e38f;
    int hcur = -1;
    for (int bi = bid; bi < NHEAD * (M / 256); bi += nb) {
        const int hd = bi & 7, tile = (bi >> 3) * 8 + wave; const size_t token = (size_t)tile * 32 + r32;
        if (hd != hcur) { hcur = hd; __syncthreads();
#pragma unroll
            for (int k = 0; k < 8; ++k) { const int c = tid + NT * k, row = c >> 4, o = c & 15;
                *(uint4*)(lds + row * XA_STRIDE + o * 16) = *(const uint4*)(KB + ((size_t)hd * 256 + row) * 128 + o * 8); }
            __syncthreads(); }
        float X0[16], X1[16];
        topk_half(Q + token * D + hd * 256 + 8 * hh, lds + r32 * XA_STRIDE + hh * 16, 4u * hh, X0);
        __builtin_amdgcn_sched_barrier(0);
        topk_half(Q + token * D + hd * 256 + 128 + 8 * hh, lds + (128 + r32) * XA_STRIDE + hh * 16, 4u * hh, X1);
        __builtin_amdgcn_sched_barrier(0);
#pragma unroll
        for (int i = 0; i < 16; ++i) { const auto r = __builtin_amdgcn_permlane32_swap(__float_as_uint(X0[i]), __float_as_uint(X1[i]), false, false); X0[i] = __uint_as_float(r[0]); X1[i] = __uint_as_float(r[1]); }
        merge16_desc(X0, X1);
        float U[16];
#pragma unroll
        for (int i = 0; i < 16; ++i) U[i] = __shfl_xor(X0[i], 32);
        const unsigned hbit = (unsigned)hh << 8;
        float c0[16], c1[16];
#pragma unroll
        for (int j = 0; j < 16; ++j) { float s = X0[0] + U[j]; if (j == 0) s = hh ? NEG : s; c0[j] = __uint_as_float(((__float_as_uint(s) & 0xFFFFFE00u) | hbit) | (unsigned)j); }
        {
            int n = 0;
#pragma unroll
            for (int i = 1; i < 4; ++i)
#pragma unroll
                for (int j = i; j < 16; ++j) if ((i + 1) * (j + 1) <= 16) { float s = X0[i] + U[j]; if (j == i) s = hh ? NEG : s; c1[n] = __uint_as_float(((__float_as_uint(s) & 0xFFFFFE00u) | hbit) | (unsigned)(i * 16 + j)); ++n; }
#pragma unroll
            for (int k = 11; k < 16; ++k) c1[k] = NEG;
        }
        sort16_desc(c0); sort16_desc(c1); merge16_desc(c0, c1);
        float F[16];
#pragma unroll
        for (int i = 0; i < 16; ++i) F[i] = vmaxf(c0[i], __shfl_xor(c0[15 - i], 32));
        float mx = F[0];
#pragma unroll
        for (int i = 1; i < 16; ++i) mx = vmaxf(mx, F[i]);
        float ev[16], sum = 0.f;
#pragma unroll
        for (int i = 0; i < 16; ++i) { ev[i] = __expf(F[i] - mx); sum += ev[i]; }
        const float inv = 1.f / sum;
        unsigned pt[4], pu[4], pa[4], pb[4];
#pragma unroll
        for (int w = 0; w < 4; ++w) { pt[w] = pack_b0(X0[4 * w], X0[4 * w + 1], X0[4 * w + 2], X0[4 * w + 3]); pu[w] = pack_b0(U[4 * w], U[4 * w + 1], U[4 * w + 2], U[4 * w + 3]); }
#pragma unroll
        for (int w = 0; w < 4; ++w) { pa[w] = hh ? pu[w] : pt[w]; pb[w] = hh ? pt[w] : pu[w]; }
        int oi[8]; float og[8];
#pragma unroll
        for (int k = 0; k < 8; ++k) {
            const unsigned pl = __float_as_uint(F[k]) & 0x1FFu, sw = pl >> 8, pi = (pl >> 4) & 15u, pj = pl & 15u;
            const unsigned ai = sw ? pj : pi, bj = sw ? pi : pj;
            oi[k] = (int)(byte_lookup(pa, ai) * NKEYS + byte_lookup(pb, bj)); og[k] = ev[k] * inv;
        }
        int* io = idx + token * NSEL + hd * TOPK + 8 * hh; float* go = gate + token * NSEL + hd * TOPK + 8 * hh;
        *(int4*)io = make_int4(oi[0], oi[1], oi[2], oi[3]); *(int4*)(io + 4) = make_int4(oi[4], oi[5], oi[6], oi[7]);
        *(float4*)go = make_float4(og[0], og[1], og[2], og[3]); *(float4*)(go + 4) = make_float4(og[4], og[5], og[6], og[7]);
    }
}

__device__ __forceinline__ void wave_argmax(float& v, int& i) {
#pragma unroll
    for (int off = 32; off >= 1; off >>= 1) { const float ov = __shfl_xor(v, off); const int oi = __shfl_xor(i, off); if (ov > v || (ov == v && oi < i)) { v = ov; i = oi; } }
}
__device__ __forceinline__ void topk_half_naive(const bf16_t* q, const float* k0, int lane, float& outv, int& outi) {
    const float NEG = -3.0e38f;
    const float* k1 = k0 + 64 * 128;
    float s0 = 0.f, s1 = 0.f;
    for (int k = 0; k < 128; k += 4) {
        const uint2 qq = *(const uint2*)(q + k);
        const float q0 = bf2f((bf16_t)(qq.x & 0xffff)), q1 = bf2f((bf16_t)(qq.x >> 16)), q2 = bf2f((bf16_t)(qq.y & 0xffff)), q3 = bf2f((bf16_t)(qq.y >> 16));
        const float4 a = *(const float4*)(k0 + k), b = *(const float4*)(k1 + k);
        s0 += q0 * a.x + q1 * a.y + q2 * a.z + q3 * a.w; s1 += q0 * b.x + q1 * b.y + q2 * b.z + q3 * b.w;
    }
    float myv = NEG; int myi = 0;
    for (int r = 0; r < TOPK; ++r) {
        float v; int i; if (s0 >= s1) { v = s0; i = lane; } else { v = s1; i = lane + 64; }
        wave_argmax(v, i);
        if (i == lane) s0 = NEG; if (i == lane + 64) s1 = NEG;
        if (lane == r) { myv = v; myi = i; }
    }
    outv = myv; outi = myi;
}
__device__ __forceinline__ void phase_topk_naive(KP p, int bid, int nb) {
    const bf16_t* Q = (const bf16_t*)(p->ws + WS_Q); const float* keys = p->in[I_SKEY];
    int* idx = (int*)(p->ws + WS_IDX); float* gate = (float*)(p->ws + WS_GATE);
    const int tid = opaque_tid(), lane = tid & 63, wave = tid >> 6;
    const float NEG = -3.0e38f;
    for (int task = bid * 8 + wave; task < M * NHEAD; task += nb * 8) {
        const int token = task >> 3, hd = task & 7;
        float tv0, tv1; int ti0, ti1;
        topk_half_naive(Q + (size_t)token * D + hd * 256, keys + ((size_t)(hd * 2) * 128 + lane) * 128, lane, tv0, ti0);
        topk_half_naive(Q + (size_t)token * D + hd * 256 + 128, keys + ((size_t)(hd * 2 + 1) * 128 + lane) * 128, lane, tv1, ti1);
        const float vb = __shfl(tv1, lane & 15);
        float c0 = __shfl(tv0, (lane >> 4)) + vb, c1 = __shfl(tv0, (lane >> 4) + 4) + vb, c2 = __shfl(tv0, (lane >> 4) + 8) + vb, c3 = __shfl(tv0, (lane >> 4) + 12) + vb;
        float selv = NEG; int selc = 0;
        for (int r = 0; r < TOPK; ++r) {
            float v = c0; int i = lane;
            if (c1 > v) { v = c1; i = lane + 64; }
            if (c2 > v) { v = c2; i = lane + 128; }
            if (c3 > v) { v = c3; i = lane + 192; }
            wave_argmax(v, i);
            if (i == lane) c0 = NEG; if (i == lane + 64) c1 = NEG; if (i == lane + 128) c2 = NEG; if (i == lane + 192) c3 = NEG;
            if (lane == r) { selv = v; selc = i; }
        }
        const float mx = __shfl(selv, 0);
        const float e = lane < TOPK ? __expf(selv - mx) : 0.f;
        const float sum = wave_sum(e);
        const int i1 = __shfl(ti0, selc >> 4), i2 = __shfl(ti1, selc & 15);
        if (lane < TOPK) { idx[(size_t)token * NSEL + hd * TOPK + lane] = i1 * NKEYS + i2; gate[(size_t)token * NSEL + hd * TOPK + lane] = e / sum; }
    }
}

typedef float f32x2_t __attribute__((ext_vector_type(2)));
__device__ __forceinline__ float wave_max(float v) {
#pragma unroll
    for (int o = 1; o < 64; o <<= 1) v = fmaxf(v, __shfl_xor(v, o));
    return v;
}
__device__ __forceinline__ void phase_convert_experts(KP p, int bid, int nb) {
    const int tid = opaque_tid(), lane = tid & 63, wave = tid >> 6;
    for (int row = bid * 8 + wave; row < 2 * NKEYS * NKEYS; row += nb * 8) {
        const int t = row >= NKEYS * NKEYS, e = row - t * NKEYS * NKEYS;
        const float* src = (t ? p->in[I_EV] : p->in[I_EU]) + (size_t)e * D;
        unsigned* dst = (unsigned*)(p->ws + (t ? WS_EV8 : WS_EU8) + (size_t)e * D);
        float4 v[8]; float am = 0.f;
#pragma unroll
        for (int j = 0; j < 8; ++j) { v[j] = *(const float4*)(src + lane * 4 + 256 * j); am = fmaxf(am, fmaxf(fmaxf(fabsf(v[j].x), fabsf(v[j].y)), fmaxf(fabsf(v[j].z), fabsf(v[j].w)))); }
        am = wave_max(am);
        int ex = 0; if (am > 0.f) (void)frexpf(am, &ex); else ex = 8;
        const float sc = ldexpf(1.f, 8 - ex);
#pragma unroll
        for (int j = 0; j < 8; ++j) { int w = __builtin_amdgcn_cvt_pk_fp8_f32(v[j].x * sc, v[j].y * sc, 0, false); w = __builtin_amdgcn_cvt_pk_fp8_f32(v[j].z * sc, v[j].w * sc, w, true); dst[lane + 64 * j] = (unsigned)w; }
        if (lane == 0) ((float*)(p->ws + WS_ESCALE))[row] = ldexpf(1.f, ex - 8);
    }
}
__device__ __forceinline__ void phase_peer(KP p, float* lds, int bid, int nb) {
    const bf16_t* H = (const bf16_t*)(p->ws + WS_H); const int* idx = (const int*)(p->ws + WS_IDX); const float* gate = (const float*)(p->ws + WS_GATE);
    const unsigned char* EU = p->ws + WS_EU8; const unsigned char* EV = p->ws + WS_EV8; const float* esc = (const float*)(p->ws + WS_ESCALE); const float* gf = p->in[I_GFIN];
    const int tid = opaque_tid(), lane = tid & 63, wave = tid >> 6;
    for (int i = tid; i < NB * D; i += NT) lds[i] = mod_at(p, i >> 11, 5 * D + (i & (D - 1)));
    __syncthreads();
    for (int token = bid * 8 + wave; token < M; token += nb * 8) {
        f32x2_t hv[16];
#pragma unroll
        for (int j = 0; j < 2; ++j)
#pragma unroll
            for (int hq = 0; hq < 2; ++hq) { const uint4 w = *(const uint4*)(H + (size_t)token * D + lane * 16 + 1024 * j + 8 * hq); const unsigned ww[4] = {w.x, w.y, w.z, w.w};
#pragma unroll
                for (int c = 0; c < 4; ++c) hv[8 * j + 4 * hq + c] = (f32x2_t){__uint_as_float(ww[c] << 16), __uint_as_float(ww[c] & 0xffff0000u)}; }
        const int e0 = idx[(size_t)token * NSEL + lane], e1 = idx[(size_t)token * NSEL + 64 + lane];
        const float us0 = esc[e0], us1 = esc[e1], vs0 = esc[NKEYS * NKEYS + e0], vs1 = esc[NKEYS * NKEYS + e1];
        const float gg0 = gate[(size_t)token * NSEL + lane], gg1 = gate[(size_t)token * NSEL + 64 + lane];
        float act0 = 0.f, act1 = 0.f;
        for (int s = 0; s < NSEL; s += 8) {
            const int ee = s < 64 ? e0 : e1; const int sl = s & 63;
            uint4 r[8][2];
#pragma unroll
            for (int k = 0; k < 8; ++k) { const int e = __builtin_amdgcn_readlane(ee, sl + k); const unsigned char* base = EU + (size_t)e * D + lane * 16;
                r[k][0] = *(const uint4*)base; r[k][1] = *(const uint4*)(base + 1024); }
#pragma unroll
            for (int k = 0; k < 8; ++k) { f32x2_t d2 = {0.f, 0.f};
#pragma unroll
                for (int j = 0; j < 2; ++j) { const unsigned ww[4] = {r[k][j].x, r[k][j].y, r[k][j].z, r[k][j].w};
#pragma unroll
                    for (int c = 0; c < 4; ++c) { d2 = __builtin_elementwise_fma(__builtin_amdgcn_cvt_pk_f32_fp8(ww[c], false), hv[8 * j + 2 * c], d2); d2 = __builtin_elementwise_fma(__builtin_amdgcn_cvt_pk_f32_fp8(ww[c], true), hv[8 * j + 2 * c + 1], d2); } }
                const float d = wave_sum(d2.x + d2.y);
                if (lane == sl + k) { if (s < 64) act0 = d; else act1 = d; } }
        }
        act0 = gelu_t(act0 * us0) * gg0 * vs0; act1 = gelu_t(act1 * us1) * gg1 * vs1;
        f32x2_t acc[16];
#pragma unroll
        for (int j = 0; j < 16; ++j) acc[j] = (f32x2_t){0.f, 0.f};
        for (int s = 0; s < NSEL; s += 8) {
            const int ee = s < 64 ? e0 : e1; const float aa = s < 64 ? act0 : act1; const int sl = s & 63;
            uint4 r[8][2];
#pragma unroll
            for (int k = 0; k < 8; ++k) { const int e = __builtin_amdgcn_readlane(ee, sl + k); const unsigned char* base = EV + (size_t)e * D + lane * 16;
                r[k][0] = *(const uint4*)base; r[k][1] = *(const uint4*)(base + 1024); }
#pragma unroll
            for (int k = 0; k < 8; ++k) { const float a = __builtin_bit_cast(float, __builtin_amdgcn_readlane(__builtin_bit_cast(int, aa), sl + k)); const f32x2_t a2 = {a, a};
#pragma unroll
                for (int j = 0; j < 2; ++j) { const unsigned ww[4] = {r[k][j].x, r[k][j].y, r[k][j].z, r[k][j].w};
#pragma unroll
                    for (int c = 0; c < 4; ++c) { acc[8 * j + 2 * c] = __builtin_elementwise_fma(__builtin_amdgcn_cvt_pk_f32_fp8(ww[c], false), a2, acc[8 * j + 2 * c]); acc[8 * j + 2 * c + 1] = __builtin_elementwise_fma(__builtin_amdgcn_cvt_pk_f32_fp8(ww[c], true), a2, acc[8 * j + 2 * c + 1]); } } }
        }
        const float* gt = lds + (token / SEQ) * D;
        float ss = 0.f;
#pragma unroll
        for (int j = 0; j < 2; ++j)
#pragma unroll
            for (int hq = 0; hq < 4; ++hq) {
                const int col = lane * 16 + 1024 * j + 4 * hq;
                const float4 x1 = *(const float4*)(p->out + (size_t)token * D + col); const float4 g4 = *(const float4*)(gt + col);
                f32x2_t& a0 = acc[8 * j + 2 * hq]; f32x2_t& a1 = acc[8 * j + 2 * hq + 1];
                a0.x = x1.x + g4.x * a0.x; a0.y = x1.y + g4.y * a0.y; a1.x = x1.z + g4.z * a1.x; a1.y = x1.w + g4.w * a1.y;
                ss += a0.x * a0.x + a0.y * a0.y + a1.x * a1.x + a1.y * a1.y;
            }
        const float rstd = rsqrtf(wave_sum(ss) * (1.f / D) + EPS);
#pragma unroll
        for (int j = 0; j < 2; ++j)
#pragma unroll
            for (int hq = 0; hq < 4; ++hq) {
                const int col = lane * 16 + 1024 * j + 4 * hq;
                const float4 g4 = *(const float4*)(gf + col); const f32x2_t a0 = acc[8 * j + 2 * hq], a1 = acc[8 * j + 2 * hq + 1];
                float4 o; o.x = a0.x * rstd * g4.x; o.y = a0.y * rstd * g4.y; o.z = a1.x * rstd * g4.z; o.w = a1.y * rstd * g4.w;
                *(float4*)(p->out + (size_t)token * D + col) = o;
            }
    }
}

#define XB_TMO      128
#define XB_XCNT(j)  (256  + 64 * (j))
#define XB_XSUB(j)  (1280 + 64 * (j))
#define XB_XGEN(j)  (2304 + 64 * (j))
#define XB_TOP      3328
#define XB_TOPGEN   3392
#define XCD_BAR_WORDS 3456
#define XB_SPIN_CAP (1u << 18)

__device__ __forceinline__ unsigned xb_ld(unsigned* p)              { return __hip_atomic_load(p, __ATOMIC_RELAXED, __HIP_MEMORY_SCOPE_AGENT); }
__device__ __forceinline__ unsigned xb_add(unsigned* p, unsigned v) { return __hip_atomic_fetch_add(p, v, __ATOMIC_RELAXED, __HIP_MEMORY_SCOPE_AGENT); }
__device__ __forceinline__ unsigned xb_xcc_id() { return (unsigned)__builtin_amdgcn_s_getreg((3 << 11) | 20) & 0xFu; }
#define XB_SPIN(cond, bar) do { unsigned _sp = 0; while (cond) { __builtin_amdgcn_s_sleep(1); \
    if ((++_sp & 255u) == 0u) { if (xb_ld(&(bar)[XB_TMO])) break; if (_sp > XB_SPIN_CAP) { atomicAdd(&(bar)[XB_TMO], 1u); break; } } } } while (0)

struct XcdBarrier {
    unsigned* bar; unsigned x;
    volatile LAS unsigned* st;
};

__device__ __forceinline__ XcdBarrier xcd_barrier_post(unsigned* bar, volatile LAS unsigned* st) {
    XcdBarrier b; b.bar = bar; b.x = xb_xcc_id(); b.st = st;
    if (threadIdx.x == 0) (void)xb_add(&bar[XB_XCNT(b.x)], 1u);
    return b;
}
__device__ __forceinline__ void xcd_barrier_complete(unsigned* bar, unsigned x, unsigned& nloc, unsigned& nx) {
    const unsigned G = gridDim.x * gridDim.y * gridDim.z;
    unsigned sum, cnt, mine, sp = 0u;
    for (;;) {
        sum = 0u; cnt = 0u; mine = 0u;
#pragma unroll
        for (unsigned j = 0; j < 16; ++j) { const unsigned c = xb_ld(&bar[XB_XCNT(j)]); sum += c; cnt += (c > 0u) ? 1u : 0u; mine = (j == x) ? c : mine; }
        if (sum == G) break;
        __builtin_amdgcn_s_sleep(1);
        if ((++sp & 255u) == 0u) { if (xb_ld(&bar[XB_TMO])) break; if (sp > XB_SPIN_CAP) { atomicAdd(&bar[XB_TMO], 1u); break; } }
    }
    nloc = mine > 0u ? mine : 1u; nx = cnt > 0u ? cnt : 1u;
}

__device__ __forceinline__ void xcd_barrier(const XcdBarrier& b) {
    asm volatile("s_waitcnt vmcnt(0)" ::: "memory");
    __syncthreads();
    if (threadIdx.x == 0) {
        unsigned* bar = b.bar;
        __builtin_amdgcn_s_waitcnt(0);
        unsigned nloc = b.st[0], nx = b.st[1];
        if (nloc == 0u) { xcd_barrier_complete(bar, b.x, nloc, nx); b.st[0] = nloc; b.st[1] = nx; }
        const unsigned old = xb_add(&bar[XB_XSUB(b.x)], 1u);
        const unsigned gen = old / nloc;
        if (old + 1u == (gen + 1u) * nloc) {
            __builtin_amdgcn_fence(__ATOMIC_RELEASE, "agent");
            asm volatile("s_waitcnt vmcnt(0)" ::: "memory");
            const unsigned og = xb_add(&bar[XB_TOP], 1u);
            const unsigned tg = og / nx;
            if (og + 1u == (tg + 1u) * nx) xb_add(&bar[XB_TOPGEN], 1u);
            else XB_SPIN(xb_ld(&bar[XB_TOPGEN]) == tg, bar);
            __builtin_amdgcn_fence(__ATOMIC_ACQUIRE, "agent");
            xb_add(&bar[XB_XGEN(b.x)], 1u);
            asm volatile("s_waitcnt vmcnt(0)" ::: "memory");
        } else {
            XB_SPIN(xb_ld(&bar[XB_XGEN(b.x)]) == gen, bar);
            __builtin_amdgcn_fence(__ATOMIC_ACQUIRE, "agent");
            asm volatile("s_waitcnt vmcnt(0)" ::: "memory");
        }
    }
    __syncthreads();
}


extern __shared__ __attribute__((aligned(16))) unsigned char dyn_lds[];
constexpr int LDS_BYTES = 147456;
__global__ void __launch_bounds__(NT) fwd_megakernel(Params p_unused) {
    cg::grid_group grid = cg::this_grid();
    KP p = (KP)__builtin_amdgcn_kernarg_segment_ptr();
    float* lds = (float*)dyn_lds;
    const int bid = blockIdx.x, nb = gridDim.x;
    volatile LAS unsigned* bst = (volatile LAS unsigned*)((LAS unsigned char*)dyn_lds + LDS_BYTES - 16);
    if (threadIdx.x < 4) bst[threadIdx.x] = 0u;
    __syncthreads();
    const XcdBarrier xbar = xcd_barrier_post((unsigned*)(p->ws + WS_CTL), bst);
    phase_mod(p, lds, bid, nb);
    __syncthreads();
    phase_convert_weights(p, lds, bid, nb);
    phase_convert_experts(p, bid, nb);
    grid.sync();
    phase_hrows(p, p->in[I_X], p->in[I_GMIX], 0, D, (bf16_t*)(p->ws + WS_H), lds, bid, nb);
    xcd_barrier(xbar);
    { pg8::Gemm g{(const bf16_t*)(p->ws + WS_H), (const bf16_t*)(p->ws + WS_WIN_T), M, NPROJ, D}; pg8::StaticOrder S; S.init(M, NPROJ, nb, bid);
      pg8::EpiProj E{(bf16_t*)(p->ws + WS_PROJ), (float*)(p->ws + WS_SSQV), M};
      pg8::gemm_phase<pg8::EpiProj, pg8::StaticOrder, true, true>((LAS unsigned char*)dyn_lds, g, S, E); }
    xcd_barrier(xbar);
    phase_lru(p, dyn_lds, bid, nb);
    phase_sgu(p, dyn_lds, bid, nb);
    xcd_barrier(xbar);
    { pg8::Gemm g{(const bf16_t*)(p->ws + WS_YMIX), (const bf16_t*)(p->ws + WS_WOUT_T), M, D, D}; pg8::StaticOrder S; S.init(M, D, nb, bid);
      pg8::EpiX1 E{p->in[I_X], p->out, (const float*)(p->ws + WS_MODP), p->in[I_BADA], 2 * D, NMOD, SEQ};
      pg8::gemm_phase<pg8::EpiX1, pg8::StaticOrder, true, true>((LAS unsigned char*)dyn_lds, g, S, E); }
    xcd_barrier(xbar);
    phase_hrows(p, p->out, p->in[I_GFFN], 3 * D, 4 * D, (bf16_t*)(p->ws + WS_H), lds, bid, nb);
    xcd_barrier(xbar);
    { pg8::Gemm g{(const bf16_t*)(p->ws + WS_H), (const bf16_t*)(p->ws + WS_WQ_T), M, D, D}; pg8::StaticOrder S; S.init(M, D, nb, bid);
      pg8::EpiQ E{(bf16_t*)(p->ws + WS_Q), D};
      pg8::gemm_phase<pg8::EpiQ, pg8::StaticOrder, true, true>((LAS unsigned char*)dyn_lds, g, S, E); }
    xcd_barrier(xbar);
    phase_topk(p, dyn_lds, bid, nb);
    xcd_barrier(xbar);
    phase_peer(p, lds, bid, nb);
}

extern "C" void kernel_launch(void* const* d_in, const int* in_sizes, int n_in, void* d_out, int out_size, void* d_ws, size_t ws_size, hipStream_t stream) {
    static int grid_blocks = 0;
    if (grid_blocks == 0) {
        if (n_in != 23 || in_sizes[0] != M * D || out_size != M * D || ws_size < WS_END) { fprintf(stderr, "kernel_launch: unexpected shapes (n_in %d in0 %d out %d ws %zu)\n", n_in, n_in > 0 ? in_sizes[0] : -1, out_size, ws_size); grid_blocks = -1; return; }
        if (hipFuncSetAttribute((const void*)fwd_megakernel, hipFuncAttributeMaxDynamicSharedMemorySize, LDS_BYTES) != hipSuccess) { fprintf(stderr, "hipFuncSetAttribute failed\n"); grid_blocks = -1; return; }
        int dev = 0, cus = 0, per_cu = 0;
        hipGetDevice(&dev);
        hipDeviceGetAttribute(&cus, hipDeviceAttributeMultiprocessorCount, dev);
        if (hipOccupancyMaxActiveBlocksPerMultiprocessor(&per_cu, (const void*)fwd_megakernel, NT, LDS_BYTES) != hipSuccess || per_cu < 1) { fprintf(stderr, "occupancy query failed (%d)\n", per_cu); grid_blocks = -1; return; }
        grid_blocks = cus;
    }
    if (grid_blocks < 0) return;
    Params p{};
    for (int i = 0; i < 23; ++i) p.in[i] = (const float*)d_in[i];
    p.out = (float*)d_out; p.ws = (unsigned char*)d_ws;
    if (hipMemsetAsync((char*)d_ws + WS_CTL, 0, 16384, stream) != hipSuccess) { fprintf(stderr, "hipMemsetAsync of the barrier words failed\n"); return; }
    void* args[] = {&p};
    hipError_t e = hipLaunchCooperativeKernel((const void*)fwd_megakernel, dim3(grid_blocks), dim3(NT), args, LDS_BYTES, stream);
    if (e != hipSuccess) fprintf(stderr, "cooperative launch failed: %s (grid %d)\n", hipGetErrorString(e), grid_blocks);
}
```

```cpp
#include <hip/hip_runtime.h>
#include <hip/hip_cooperative_groups.h>
#include <cstdio>
#include <cstdint>

constexpr int D = 2048, NB = 8, SEQ = 2048, M = NB * SEQ;
constexpr int DLRU = 1024, DSGU = 1024, NPROJ = 4096;
constexpr int NMOD = 6 * D;
constexpr int NHEAD = 8, NKEYS = 128, TOPK = 16, NSEL = NHEAD * TOPK;
constexpr float EPS = 1e-6f;
constexpr int NT = 512;
namespace cg = cooperative_groups;

constexpr size_t MiB = 1u << 20;
constexpr size_t WS_CTL = 0;
constexpr size_t WS_MODP = 1 * MiB;
constexpr size_t WS_WGA_T = 3 * MiB;
constexpr size_t WS_WGI_T = 3 * MiB + 262144;
constexpr size_t WS_WSPB = 3 * MiB + 524288;
constexpr size_t WS_SKEYB = 3 * MiB + 786432;
constexpr size_t WS_SSQV = 5 * MiB;
constexpr size_t WS_RSTDV = 8 * MiB;
constexpr size_t WS_WIN_T = 9 * MiB;
constexpr size_t WS_WOUT_T = 25 * MiB;
constexpr size_t WS_WQ_T = 33 * MiB;
constexpr size_t WS_IDX = 41 * MiB;
constexpr size_t WS_GATE = 49 * MiB;
constexpr size_t WS_H = 64 * MiB;
constexpr size_t WS_PROJ = 128 * MiB;
constexpr size_t WS_Q = 128 * MiB;
constexpr size_t WS_YMIX = 256 * MiB;
constexpr size_t WS_EU8 = 320 * MiB;
constexpr size_t WS_EV8 = 352 * MiB;
constexpr size_t WS_ESCALE = 57 * MiB;
constexpr size_t WS_XC = 320 * MiB;
constexpr size_t WS_A = 384 * MiB;
constexpr size_t WS_BB = 448 * MiB;
constexpr size_t WS_ACT = 256 * MiB;
constexpr size_t WS_SSQ2 = 264 * MiB;
constexpr size_t WS_PDOT = 384 * MiB;
constexpr size_t WS_END = 512 * MiB;

typedef unsigned short bf16_t;
struct Params { const float* in[23]; float* out; unsigned char* ws; };
typedef const __attribute__((address_space(4))) Params* KP;
enum { I_X = 0, I_C, I_WADA, I_BADA, I_GMIX, I_WIN, I_CONVW, I_CONVB, I_WGA, I_BGA, I_WGI, I_BGI, I_LAM, I_GV, I_WSP, I_BSP, I_WOUT, I_GFFN, I_WQ, I_SKEY, I_EU, I_EV, I_GFIN };

__device__ __forceinline__ int opaque_tid() { int t = threadIdx.x; asm volatile("" : "+v"(t)); return t; }
__device__ __forceinline__ float bf2f(bf16_t v) { return __uint_as_float(((unsigned)v) << 16); }
__device__ __forceinline__ bf16_t f2bf(float f) { unsigned u = __float_as_uint(f); u += 0x7fffu + ((u >> 16) & 1u); return (bf16_t)(u >> 16); }
__device__ __forceinline__ float sigmoidf_(float x) { return 1.f / (1.f + __expf(-x)); }
__device__ __forceinline__ float gelu_t(float x) { const float u = 0.7978845608028654f * (x + 0.044715f * x * x * x); return x * sigmoidf_(2.f * u); }
__device__ __forceinline__ float wave_sum(float v) {
#pragma unroll
    for (int o = 1; o < 64; o <<= 1) v += __shfl_xor(v, o);
    return v;
}
__device__ __forceinline__ float mod_at(KP p, int b, int n) {
    const float* mp = (const float*)(p->ws + WS_MODP);
    float s = p->in[I_BADA][n];
#pragma unroll
    for (int kc = 0; kc < 4; ++kc) s += mp[(size_t)(kc * 8 + b) * NMOD + n];
    return s;
}

__device__ __forceinline__ void phase_mod(KP p, float* lds, int bid, int nb) {
    const int tid = opaque_tid(), lane = tid & 63, wave = tid >> 6;
    const float* c = p->in[I_C]; const float* W = p->in[I_WADA];
    float* modp = (float*)(p->ws + WS_MODP);
    for (int i = tid; i < NB * D; i += NT) { const float v = c[i]; lds[i] = v * sigmoidf_(v); }
    __syncthreads();
    float* red = lds + NB * D;
    for (int item = bid; item < 192; item += nb) {
        const int nt = item % 48, kc = item / 48;
        const int n0 = nt * 256 + lane * 4, k0 = kc * 512 + wave * 64;
        float acc[8][4];
#pragma unroll
        for (int b = 0; b < 8; ++b)
#pragma unroll
            for (int j = 0; j < 4; ++j) acc[b][j] = 0.f;
        for (int kk = 0; kk < 64; ++kk) {
            const float4 w = *(const float4*)(W + (size_t)(k0 + kk) * NMOD + n0);
#pragma unroll
            for (int b = 0; b < 8; ++b) { const float s = lds[b * D + k0 + kk]; acc[b][0] += s * w.x; acc[b][1] += s * w.y; acc[b][2] += s * w.z; acc[b][3] += s * w.w; }
        }
#pragma unroll
        for (int b = 0; b < 8; ++b)
#pragma unroll
            for (int j = 0; j < 4; ++j) red[(wave * 32 + b * 4 + j) * 64 + lane] = acc[b][j];
        __syncthreads();
        for (int o = tid; o < 2048; o += NT) {
            const int b = o >> 8, nn = o & 255, ln = nn >> 2, j = nn & 3;
            float s = 0.f;
#pragma unroll
            for (int w = 0; w < 8; ++w) s += red[(w * 32 + b * 4 + j) * 64 + ln];
            modp[(size_t)(kc * 8 + b) * NMOD + nt * 256 + nn] = s;
        }
        __syncthreads();
    }
}

__device__ __forceinline__ void phase_hrows(KP p, const float* src, const float* gn, int shift_off, int scale_off, bf16_t* dst, float* lds, int bid, int nb) {
    const int tid = opaque_tid(), lane = tid & 63, wave = tid >> 6;
    float* Aw = lds; float* Bw = lds + D;
    for (int item = bid; item < M / 64; item += nb) {
        const int b = item / (SEQ / 64);
        for (int col = tid; col < D; col += NT) { Aw[col] = gn[col] * (1.f + mod_at(p, b, scale_off + col)); Bw[col] = mod_at(p, b, shift_off + col); }
        __syncthreads();
        for (int r = wave; r < 64; r += 8) {
            const size_t row = (size_t)item * 64 + r;
            float4 v[8]; float ss = 0.f;
#pragma unroll
            for (int j = 0; j < 8; ++j) { v[j] = *(const float4*)(src + row * D + lane * 4 + 256 * j); ss += v[j].x * v[j].x + v[j].y * v[j].y + v[j].z * v[j].z + v[j].w * v[j].w; }
            const float rstd = rsqrtf(wave_sum(ss) * (1.f / D) + EPS);
#pragma unroll
            for (int j = 0; j < 8; ++j) {
                const int col = lane * 4 + 256 * j;
                const float o0 = v[j].x * rstd * Aw[col] + Bw[col], o1 = v[j].y * rstd * Aw[col + 1] + Bw[col + 1];
                const float o2 = v[j].z * rstd * Aw[col + 2] + Bw[col + 2], o3 = v[j].w * rstd * Aw[col + 3] + Bw[col + 3];
                uint2 w; w.x = (unsigned)f2bf(o0) | ((unsigned)f2bf(o1) << 16); w.y = (unsigned)f2bf(o2) | ((unsigned)f2bf(o3) << 16);
                *(uint2*)(dst + row * D + col) = w;
            }
        }
        __syncthreads();
    }
}

namespace pg8 {
#define PG8_LAS __attribute__((address_space(3)))
typedef unsigned short bf16_t;
typedef short bf16x8 __attribute__((ext_vector_type(8)));
typedef float f32x4 __attribute__((ext_vector_type(4)));
typedef unsigned u32x4 __attribute__((ext_vector_type(4)));
constexpr int BM = 256, BK = 64, HALF = 128, HTB = HALF * BK * 2  , STAGE_BYTES = 8 * HTB, NXCD = 8, WGM = 8;

__host__ __device__ __forceinline__ int lds_byte(int r, int c) { const int st = (r >> 4) * 2 + (c >> 5), rr = r & 15, cc = c & 31, ob = rr * 64 + cc * 2; return st * 1024 + (ob ^ (((ob >> 9) & 1) << 5)); }
__host__ __device__ __forceinline__ void stage_rc(int b, int& R, int& C) { const int st = b / 1024, sb = b % 1024, swz = sb ^ (((sb >> 9) & 1) << 5); R = (st >> 1) * 16 + swz / 64; C = (st & 1) * 32 + (swz % 64) / 2; }
__host__ __device__ __forceinline__ int perm32(int rho) { const int n = rho >> 4, i = rho & 15; return 8 * (i >> 2) + 4 * n + (i & 3); }

struct Unit { int pm, pn; };
struct Gemm { const bf16_t* A; const bf16_t* Bt; int M, N, K; };

struct StaticOrder {
    int nM, nN, nwg, G, c;
    __host__ __device__ void init(int M, int N, int G_, int c_) { nM = M / BM; nN = N / BM; nwg = nM * nN; G = G_; c = c_; }
    __host__ __device__ bool next(int i, Unit& u) const {
        const long L = (long)i * G + c; if (L >= nwg) return false;
        int wgid = (int)L; { const int q = nwg / NXCD, r = nwg % NXCD, xcd = wgid % NXCD, off = wgid / NXCD; wgid = (xcd < r ? xcd * (q + 1) : r * (q + 1) + (xcd - r) * q) + off; }
        const int nig = WGM * nN, gid = wgid / nig, fm = gid * WGM, gsz = (nM - fm) < WGM ? (nM - fm) : WGM;
        u.pm = fm + ((wgid % nig) % gsz); u.pn = (wgid % nig) / gsz; return true;
    }
    __device__ __forceinline__ void a_ready(const Unit&) const {}
    __device__ __forceinline__ void done(const Unit&) const {}
};


__device__ __forceinline__ unsigned cvt_pk_bf16(float lo, float hi) { unsigned r; asm volatile("v_cvt_pk_bf16_f32 %0, %1, %2" : "=v"(r) : "v"(lo), "v"(hi)); return r; }
__device__ __forceinline__ float gelu_tanh(float x) { const float u = 1.5957691216057308f * (x + 0.044715f * x * x * x); return x * __builtin_amdgcn_rcpf(1.f + __expf(-u)); }
struct EpiProj {
    static constexpr bool PERM = true, AFTER_DRAIN = false;
    bf16_t* proj; float* ssqv; int Mrows;
    __device__ __forceinline__ void operator()(const f32x4 (&acc)[2][2][4][2], const Unit& u, int wr, int wc, int fr, int fq) const {
        const int which = (u.pn * BM) >> 10, colt = (u.pn * BM) & 1023;
        bf16_t* base = proj + (size_t)which * Mrows * 1024;
        const int row0 = u.pm * BM + wr * 64 + fr, col0 = colt + wc * 32 + 8 * fq;
#pragma unroll
        for (int ai = 0; ai < 2; ++ai)
#pragma unroll
            for (int m = 0; m < 4; ++m) { const int row = row0 + ai * HALF + m * 16; bf16_t* rowp = base + (size_t)row * 1024 + col0; float ss = 0.f;
#pragma unroll
                for (int bj = 0; bj < 2; ++bj) { f32x4 v0 = acc[ai][bj][m][0], v1 = acc[ai][bj][m][1];
                    if (which) {
#pragma unroll
                        for (int j = 0; j < 4; ++j) { v0[j] = gelu_tanh(v0[j]); v1[j] = gelu_tanh(v1[j]); } }
                    ss += (v0[0] * v0[0] + v0[1] * v0[1]) + (v0[2] * v0[2] + v0[3] * v0[3]) + (v1[0] * v1[0] + v1[1] * v1[1]) + (v1[2] * v1[2] + v1[3] * v1[3]);
                    u32x4 w; w.x = cvt_pk_bf16(v0[0], v0[1]); w.y = cvt_pk_bf16(v0[2], v0[3]); w.z = cvt_pk_bf16(v1[0], v1[1]); w.w = cvt_pk_bf16(v1[2], v1[3]);
                    *(u32x4*)(rowp + bj * HALF) = w; }
                if (which == 3) { ss += __shfl_xor(ss, 16); ss += __shfl_xor(ss, 32); if (fq == 0) ssqv[(size_t)row * 16 + (u.pn & 3) * 4 + wc] = ss; } }
    }
};
struct EpiX1 {
    static constexpr bool PERM = false, AFTER_DRAIN = false;
    const float* x; float* out; const float* modp; const float* bada; int goff, nmod, seq;
    __device__ __forceinline__ void operator()(const f32x4 (&acc)[2][2][4][2], const Unit& u, int wr, int wc, int fr, int fq) const {
        const int row0 = u.pm * BM + wr * 64 + fr, col0 = u.pn * BM + wc * 32 + 4 * fq, b = (u.pm * BM) / seq;
        f32x4 gv[2][2];
#pragma unroll
        for (int bj = 0; bj < 2; ++bj)
#pragma unroll
            for (int n = 0; n < 2; ++n) { const int c = goff + col0 + bj * HALF + n * 16; f32x4 g = *(const f32x4*)(bada + c);
#pragma unroll
                for (int kc = 0; kc < 4; ++kc) g += *(const f32x4*)(modp + (size_t)(kc * 8 + b) * nmod + c);
                gv[bj][n] = g; }
#pragma unroll
        for (int ai = 0; ai < 2; ++ai)
#pragma unroll
            for (int m = 0; m < 4; ++m) { const size_t off = (size_t)(row0 + ai * HALF + m * 16) * (size_t)(2048) + col0;
#pragma unroll
                for (int bj = 0; bj < 2; ++bj)
#pragma unroll
                    for (int n = 0; n < 2; ++n) { const f32x4 xv = *(const f32x4*)(x + off + bj * HALF + n * 16); *(f32x4*)(out + off + bj * HALF + n * 16) = xv + gv[bj][n] * acc[ai][bj][m][n]; } }
    }
};
struct EpiQ {
    static constexpr bool PERM = true, AFTER_DRAIN = false;
    bf16_t* O; int ldc;
    __device__ __forceinline__ void operator()(const f32x4 (&acc)[2][2][4][2], const Unit& u, int wr, int wc, int fr, int fq) const {
        const int row0 = u.pm * BM + wr * 64 + fr, col0 = u.pn * BM + wc * 32 + 8 * fq;
#pragma unroll
        for (int ai = 0; ai < 2; ++ai)
#pragma unroll
            for (int m = 0; m < 4; ++m) { bf16_t* rowp = O + (size_t)(row0 + ai * HALF + m * 16) * ldc + col0;
#pragma unroll
                for (int bj = 0; bj < 2; ++bj) { const f32x4 v0 = acc[ai][bj][m][0], v1 = acc[ai][bj][m][1];
                    u32x4 w; w.x = cvt_pk_bf16(v0[0], v0[1]); w.y = cvt_pk_bf16(v0[2], v0[3]); w.z = cvt_pk_bf16(v1[0], v1[1]); w.w = cvt_pk_bf16(v1[2], v1[3]);
                    *(u32x4*)(rowp + bj * HALF) = w; } }
    }
};

template <class Epi, class Sched, bool ALIGN_EPI = false, bool SP2 = false>
__device__ __forceinline__ void gemm_phase(PG8_LAS unsigned char* lds, const Gemm g, const Sched& S, const Epi& E) {
    const int tid = opaque_tid(), wid = __builtin_amdgcn_readfirstlane(tid >> 6), lane = tid & 63, wr = wid >> 2, wc = wid & 3, fr = lane & 15, fq = lane >> 4;
    const int K = g.K, nt = K / BK;
    unsigned voffA[2], voffB[2];
#pragma unroll
    for (int i = 0; i < 2; ++i) { int R, C; stage_rc(tid * 16 + i * 8192, R, C); const int Rb = Epi::PERM ? ((R & ~31) + perm32(R & 31)) : R;
        voffA[i] = (unsigned)(R * K + C) * 2u; voffB[i] = (unsigned)(Rb * K + C) * 2u; }
    const size_t kstep = (size_t)(BK * 2);
    const size_t hstep = (size_t)HALF * K * 2;
    const size_t tstep = 2 * hstep;
    const unsigned ldsw = (unsigned)wid * 1024u;
    const int aoff = lds_byte(wr * 64 + fr, fq * 8), boff = lds_byte(wc * 32 + fr, fq * 8);
#define PG8_SA(b, h) (((b) * 2 + (h)) * HTB)
#define PG8_SB(b, h) ((4 + (b) * 2 + (h)) * HTB)
#define PG8_STAGE(bufoff, gbase, voff) do { _Pragma("unroll") for (int _i = 0; _i < 2; ++_i) \
        __builtin_amdgcn_global_load_lds((const unsigned*)((const char*)(gbase) + (voff)[_i]), (PG8_LAS unsigned*)(lds + (bufoff) + ldsw + _i * 8192), 16, 0, 0); } while (0)
#define PG8_LDA(dst, b, h) do { _Pragma("unroll") for (int m = 0; m < 4; ++m) _Pragma("unroll") for (int k = 0; k < 2; ++k) dst[m][k] = *(const PG8_LAS bf16x8*)(lds + PG8_SA(b, h) + aoff + m * 2048 + k * 1024); } while (0)
#define PG8_LDB(dst, b, h) do { _Pragma("unroll") for (int n = 0; n < 2; ++n) _Pragma("unroll") for (int k = 0; k < 2; ++k) dst[n][k] = *(const PG8_LAS bf16x8*)(lds + PG8_SB(b, h) + boff + n * 2048 + k * 1024); } while (0)
#define PG8_MMA(ai, bj, At, Bt) do { __builtin_amdgcn_s_setprio(1); _Pragma("unroll") for (int m = 0; m < 4; ++m) _Pragma("unroll") for (int n = 0; n < 2; ++n) _Pragma("unroll") for (int k = 0; k < 2; ++k) \
        acc[ai][bj][m][n] = __builtin_amdgcn_mfma_f32_16x16x32_bf16(Bt[n][k], At[m][k], acc[ai][bj][m][n], 0, 0, 0); __builtin_amdgcn_s_setprio(0); } while (0)
#define PG8_WAIT_V(n) asm volatile("s_waitcnt vmcnt(" #n ")" ::: "memory")
#define PG8_WAIT_L(n) asm volatile("s_waitcnt lgkmcnt(" #n ")" ::: "memory")
#define PG8_BAR __builtin_amdgcn_s_barrier()
#define PG8_SCHED __builtin_amdgcn_sched_barrier(0)
    Unit cur, nxt; int ui = 0;
    if (!S.next(0, cur)) return;
    f32x4 acc[2][2][4][2];
#pragma unroll
    for (int a = 0; a < 2; ++a)
#pragma unroll
        for (int b = 0; b < 2; ++b)
#pragma unroll
            for (int m = 0; m < 4; ++m)
#pragma unroll
                for (int n = 0; n < 2; ++n) acc[a][b][m][n] = (f32x4){0.f, 0.f, 0.f, 0.f};
    bf16x8 At[4][2], B0[2][2], B1[2][2];
    const char* cA = (const char*)g.A + (size_t)cur.pm * tstep; const char* cB = (const char*)g.Bt + (size_t)cur.pn * tstep;
    S.a_ready(cur);
    if constexpr (SP2) {
        PG8_STAGE(PG8_SB(0, 0), cB, voffB); PG8_STAGE(PG8_SB(0, 1), cB + hstep, voffB); PG8_STAGE(PG8_SA(0, 0), cA, voffA); PG8_STAGE(PG8_SA(0, 1), cA + hstep, voffA);
        if (wr == 1) PG8_BAR;
        PG8_WAIT_V(2); PG8_BAR;
        PG8_STAGE(PG8_SB(1, 0), cB + kstep, voffB); PG8_STAGE(PG8_SA(1, 0), cA + kstep, voffA); PG8_STAGE(PG8_SB(1, 1), cB + hstep + kstep, voffB);
        PG8_WAIT_V(6); PG8_BAR;
    } else {
        PG8_STAGE(PG8_SB(0, 0), cB, voffB); PG8_STAGE(PG8_SA(0, 0), cA, voffA); PG8_STAGE(PG8_SB(0, 1), cB + hstep, voffB); PG8_STAGE(PG8_SA(0, 1), cA + hstep, voffA);
        if (wr == 1) PG8_BAR;
        PG8_WAIT_V(4); PG8_BAR;
        PG8_STAGE(PG8_SB(1, 0), cB + kstep, voffB); PG8_STAGE(PG8_SA(1, 0), cA + kstep, voffA); PG8_STAGE(PG8_SB(1, 1), cB + hstep + kstep, voffB);
        PG8_WAIT_V(6); PG8_BAR;
    }
    for (;;) {
        const bool has_next = S.next(ui + 1, nxt);
        const char* nA = has_next ? (const char*)g.A + (size_t)nxt.pm * tstep : cA; const char* nB = has_next ? (const char*)g.Bt + (size_t)nxt.pn * tstep : cB;
        for (int t = 0; t < nt; t += 2) {
            const bool last = (t == nt - 2);
            const char* a1 = cA + (size_t)(t + 1) * kstep;
            const char* a2 = last ? nA : cA + (size_t)(t + 2) * kstep; const char* b2 = last ? nB : cB + (size_t)(t + 2) * kstep;
            const char* a3 = a2 + kstep; const char* b3 = b2 + kstep;
            if (last && has_next) S.a_ready(nxt);
            if constexpr (SP2) {
            PG8_LDB(B0, 0, 0); PG8_LDB(B1, 0, 1); PG8_SCHED; PG8_LDA(At, 0, 0); PG8_STAGE(PG8_SA(1, 1), a1 + hstep, voffA);
            PG8_WAIT_V(8); PG8_WAIT_L(0); PG8_BAR; PG8_MMA(0, 0, At, B0); PG8_MMA(0, 1, At, B1); PG8_BAR; PG8_SCHED;
            PG8_LDA(At, 0, 1); PG8_STAGE(PG8_SB(0, 0), b2, voffB); PG8_STAGE(PG8_SB(0, 1), b2 + hstep, voffB); PG8_STAGE(PG8_SA(0, 0), a2, voffA);
            PG8_WAIT_V(8); PG8_WAIT_L(0); PG8_BAR; PG8_MMA(1, 0, At, B0); PG8_MMA(1, 1, At, B1); PG8_BAR; PG8_SCHED;
            PG8_LDB(B0, 1, 0); PG8_LDB(B1, 1, 1); PG8_SCHED; PG8_LDA(At, 1, 0); PG8_STAGE(PG8_SA(0, 1), a2 + hstep, voffA);
            PG8_WAIT_V(8); PG8_WAIT_L(0); PG8_BAR; PG8_MMA(0, 0, At, B0); PG8_MMA(0, 1, At, B1); PG8_BAR; PG8_SCHED;
            PG8_LDA(At, 1, 1); PG8_STAGE(PG8_SB(1, 0), b3, voffB); PG8_STAGE(PG8_SB(1, 1), b3 + hstep, voffB); PG8_STAGE(PG8_SA(1, 0), a3, voffA);
            PG8_WAIT_V(8); PG8_WAIT_L(0); PG8_BAR; PG8_MMA(1, 0, At, B0); PG8_MMA(1, 1, At, B1); PG8_BAR; PG8_SCHED;
            } else {
            PG8_LDB(B0, 0, 0); PG8_SCHED; PG8_LDA(At, 0, 0); PG8_STAGE(PG8_SA(1, 1), a1 + hstep, voffA);
            PG8_WAIT_L(8); PG8_BAR; PG8_WAIT_L(0); PG8_MMA(0, 0, At, B0); PG8_BAR; PG8_SCHED;
            PG8_LDB(B1, 0, 1); PG8_STAGE(PG8_SB(0, 0), b2, voffB);
            PG8_BAR; PG8_WAIT_L(0); PG8_MMA(0, 1, At, B1); PG8_BAR;
            PG8_LDA(At, 0, 1); PG8_STAGE(PG8_SA(0, 0), a2, voffA);
            PG8_BAR; PG8_WAIT_L(0); PG8_MMA(1, 0, At, B0); PG8_BAR; PG8_SCHED;
            PG8_STAGE(PG8_SB(0, 1), b2 + hstep, voffB);
            PG8_WAIT_V(6); PG8_BAR; PG8_MMA(1, 1, At, B1); PG8_BAR;
            PG8_LDB(B0, 1, 0); PG8_SCHED; PG8_LDA(At, 1, 0); PG8_STAGE(PG8_SA(0, 1), a2 + hstep, voffA);
            PG8_WAIT_L(8); PG8_BAR; PG8_WAIT_L(0); PG8_MMA(0, 0, At, B0); PG8_BAR; PG8_SCHED;
            PG8_LDB(B1, 1, 1); PG8_STAGE(PG8_SB(1, 0), b3, voffB);
            PG8_BAR; PG8_WAIT_L(0); PG8_MMA(0, 1, At, B1); PG8_BAR;
            PG8_LDA(At, 1, 1); PG8_STAGE(PG8_SA(1, 0), a3, voffA);
            PG8_BAR; PG8_WAIT_L(0); PG8_MMA(1, 0, At, B0); PG8_BAR; PG8_SCHED;
            PG8_STAGE(PG8_SB(1, 1), b3 + hstep, voffB);
            PG8_WAIT_V(6); PG8_BAR; PG8_MMA(1, 1, At, B1); PG8_BAR;
            }
        }
        if constexpr (ALIGN_EPI) { if (wr == 0) PG8_BAR; }
        if constexpr (!Epi::AFTER_DRAIN) { E(acc, cur, wr, wc, fr, fq); S.done(cur); }
        if (!has_next) break;
#pragma unroll
        for (int a = 0; a < 2; ++a)
#pragma unroll
            for (int b = 0; b < 2; ++b)
#pragma unroll
                for (int m = 0; m < 4; ++m)
#pragma unroll
                    for (int n = 0; n < 2; ++n) acc[a][b][m][n] = (f32x4){0.f, 0.f, 0.f, 0.f};
        cur = nxt; cA = nA; cB = nB; ++ui;
        if constexpr (ALIGN_EPI) { if (wr == 1) PG8_BAR; }
    }
    PG8_WAIT_V(0);
    if constexpr (!ALIGN_EPI) { if (wr == 0) PG8_BAR; }
    PG8_BAR;
    if constexpr (Epi::AFTER_DRAIN) { E.fused(acc, cur, wr, wc, fr, fq, lds, wid, lane); S.done(cur); }
#undef PG8_SA
#undef PG8_SB
#undef PG8_STAGE
#undef PG8_LDA
#undef PG8_LDB
#undef PG8_MMA
#undef PG8_WAIT_V
#undef PG8_WAIT_L
#undef PG8_BAR
#undef PG8_SCHED
}
}

#define LAS __attribute__((address_space(3)))
__device__ __forceinline__ unsigned pk2(float lo, float hi) { return (unsigned)f2bf(lo) | ((unsigned)f2bf(hi) << 16); }
__device__ __forceinline__ void transpose_item(const float* W, int K, int N, bf16_t* WT, float* scr, int item, int lane) {
    const int nblk = N / 32, kb = item / nblk, nbk = item % nblk, k0 = 64 * kb, n0 = 32 * nbk;
#pragma unroll 8
    for (int i = 0; i < 32; ++i) { const int kk = 2 * i + (lane >> 5); scr[kk * 33 + (lane & 31)] = W[(size_t)(k0 + kk) * N + n0 + (lane & 31)]; }
    asm volatile("s_waitcnt lgkmcnt(0)" ::: "memory");
    const int c = lane & 7;
#pragma unroll
    for (int j = 0; j < 4; ++j) { const int n = (lane >> 3) + 8 * j; const float* s = scr + (8 * c) * 33 + n;
        uint4 o; o.x = pk2(s[0 * 33], s[1 * 33]); o.y = pk2(s[2 * 33], s[3 * 33]); o.z = pk2(s[4 * 33], s[5 * 33]); o.w = pk2(s[6 * 33], s[7 * 33]);
        *(uint4*)(WT + (size_t)(n0 + n) * K + k0 + 8 * c) = o; }
    asm volatile("s_waitcnt lgkmcnt(0)" ::: "memory");
}
__device__ __forceinline__ void phase_convert_weights(KP p, float* lds, int bid, int nb) {
    const int tid = opaque_tid(), lane = tid & 63, wave = tid >> 6;
    float* scr = lds + wave * (64 * 33);
    const int gw = bid * 8 + wave, ngw = nb * 8;
    constexpr int I_IN = (D / 64) * (NPROJ / 32), I_SQ = (D / 64) * (D / 32), I_G = 8 * (128 / 64) * (128 / 32);
    constexpr int NITEMS = I_IN + 2 * I_SQ + 2 * I_G;
    for (int it = gw; it < NITEMS; it += ngw) {
        int r = it;
        if (r < I_IN) { transpose_item(p->in[I_WIN], D, NPROJ, (bf16_t*)(p->ws + WS_WIN_T), scr, r, lane); continue; } r -= I_IN;
        if (r < I_SQ) { transpose_item(p->in[I_WOUT], D, D, (bf16_t*)(p->ws + WS_WOUT_T), scr, r, lane); continue; } r -= I_SQ;
        if (r < I_SQ) { transpose_item(p->in[I_WQ], D, D, (bf16_t*)(p->ws + WS_WQ_T), scr, r, lane); continue; } r -= I_SQ;
        if (r < I_G) { const int hd = r / 8; transpose_item(p->in[I_WGA] + hd * 16384, 128, 128, (bf16_t*)(p->ws + WS_WGA_T) + hd * 16384, scr, r % 8, lane); continue; } r -= I_G;
        { const int hd = r / 8; transpose_item(p->in[I_WGI] + hd * 16384, 128, 128, (bf16_t*)(p->ws + WS_WGI_T) + hd * 16384, scr, r % 8, lane); }
    }
    bf16_t* wsp = (bf16_t*)(p->ws + WS_WSPB); bf16_t* skb = (bf16_t*)(p->ws + WS_SKEYB);
    for (int e = bid * NT + tid; e < 8 * 128 * 128; e += nb * NT) { const int i = (e >> 7) & 127, j = e & 127; wsp[e] = f2bf(j <= i ? p->in[I_WSP][e] : 0.f); }
    for (int e = bid * NT + tid; e < 8 * 2 * 128 * 128; e += nb * NT) skb[e] = f2bf(p->in[I_SKEY][e]);
}

typedef short bf16x8_t __attribute__((ext_vector_type(8)));
typedef float f32x4_t __attribute__((ext_vector_type(4)));
typedef short s16x4_t __attribute__((ext_vector_type(4)));
constexpr int XA_STRIDE = 272;
constexpr int LRU_XA = 0, LRU_SA = 34816, LRU_SB = LRU_SA + 16384, LRU_SEGP = LRU_SB + 16384, LRU_SEGH = LRU_SEGP + 2048;
__device__ __forceinline__ void phase_lru(KP p, unsigned char* lds, int bid, int nb) {
    const int tid = opaque_tid(), lane = tid & 63, wave = tid >> 6, c16 = lane & 15, q = lane >> 4;
    const bf16_t* XL = (const bf16_t*)(p->ws + WS_PROJ); const bf16_t* YG = XL + (size_t)M * 1024; bf16_t* ymix = (bf16_t*)(p->ws + WS_YMIX);
    float* SA = (float*)(lds + LRU_SA); float* SB = (float*)(lds + LRU_SB); float* SEGP = (float*)(lds + LRU_SEGP); float* SEGH = (float*)(lds + LRU_SEGH);
    for (int unit = bid; unit < NB * 8 * 4; unit += nb) {
        const int b = unit >> 5, hd = (unit >> 2) & 7, cq = unit & 3;
        bf16x8_t wf[2][2][4];
#pragma unroll
        for (int gs = 0; gs < 2; ++gs)
#pragma unroll
            for (int nt = 0; nt < 2; ++nt)
#pragma unroll
                for (int ks = 0; ks < 4; ++ks)
                    wf[gs][nt][ks] = *(const bf16x8_t*)((const bf16_t*)(p->ws + (gs ? WS_WGI_T : WS_WGA_T)) + ((size_t)(hd * 128 + cq * 32 + nt * 16 + c16) * 128 + ks * 32 + 8 * q));
        float ba[2], bi[2], c2[2];
#pragma unroll
        for (int nt = 0; nt < 2; ++nt) { const int ch = hd * 128 + cq * 32 + nt * 16 + c16; ba[nt] = p->in[I_BGA][ch]; bi[nt] = p->in[I_BGI][ch];
            const float lam = p->in[I_LAM][ch]; const float sp = fmaxf(-lam, 0.f) + log1pf(__expf(-fabsf(lam))); c2[nt] = -8.f * sp * 1.4426950408889634f; }
        const int o = tid & 15, rg = tid >> 4;
        float cw[4][8], cb[8];
#pragma unroll
        for (int e = 0; e < 8; ++e) { cb[e] = p->in[I_CONVB][hd * 128 + o * 8 + e];
#pragma unroll
            for (int k = 0; k < 4; ++k) cw[k][e] = p->in[I_CONVW][k * DLRU + hd * 128 + o * 8 + e]; }
        const int sc = tid & 31, seg = tid >> 5;
        float carry = 0.f;
        for (int ch = 0; ch < SEQ / 128; ++ch) {
            const int t0 = ch * 128; const size_t row0 = (size_t)b * SEQ + t0;
            bf16_t yg[8];
#pragma unroll
            for (int k = 0; k < 8; ++k) yg[k] = YG[(row0 + seg * 8 + k) * 1024 + hd * 128 + cq * 32 + sc];
            uint4 xr[7];
#pragma unroll
            for (int i = 0; i < 7; ++i) { const int t = t0 + 4 * rg - 3 + i;
                xr[i] = t >= 0 ? *(const uint4*)(XL + ((size_t)b * SEQ + t) * 1024 + hd * 128 + o * 8) : make_uint4(0u, 0u, 0u, 0u); }
#pragma unroll
            for (int r = 0; r < 4; ++r) {
                float acc8[8];
#pragma unroll
                for (int e = 0; e < 8; ++e) acc8[e] = cb[e];
#pragma unroll
                for (int k = 0; k < 4; ++k) { const uint4 w = xr[r + k]; const unsigned ww[4] = {w.x, w.y, w.z, w.w};
#pragma unroll
                    for (int e2 = 0; e2 < 4; ++e2) { acc8[2 * e2] += cw[k][2 * e2] * __uint_as_float(ww[e2] << 16); acc8[2 * e2 + 1] += cw[k][2 * e2 + 1] * __uint_as_float(ww[e2] & 0xffff0000u); } }
                uint4 ov; ov.x = pk2(acc8[0], acc8[1]); ov.y = pk2(acc8[2], acc8[3]); ov.z = pk2(acc8[4], acc8[5]); ov.w = pk2(acc8[6], acc8[7]);
                *(uint4*)(lds + LRU_XA + (4 * rg + r) * XA_STRIDE + o * 16) = ov;
            }
            __syncthreads();
            f32x4_t acc[2][2];
#pragma unroll
            for (int gs = 0; gs < 2; ++gs)
#pragma unroll
                for (int nt = 0; nt < 2; ++nt) acc[gs][nt] = (f32x4_t){0.f, 0.f, 0.f, 0.f};
#pragma unroll
            for (int ks = 0; ks < 4; ++ks) {
                const bf16x8_t a = *(const bf16x8_t*)(lds + LRU_XA + (16 * wave + c16) * XA_STRIDE + (ks * 32 + 8 * q) * 2);
#pragma unroll
                for (int gs = 0; gs < 2; ++gs)
#pragma unroll
                    for (int nt = 0; nt < 2; ++nt) acc[gs][nt] = __builtin_amdgcn_mfma_f32_16x16x32_bf16(a, wf[gs][nt][ks], acc[gs][nt], 0, 0, 0);
            }
#pragma unroll
            for (int nt = 0; nt < 2; ++nt)
#pragma unroll
                for (int reg = 0; reg < 4; ++reg) {
                    const int t = 16 * wave + 4 * q + reg, jj = nt * 16 + c16;
                    const float za = acc[0][nt][reg] + ba[nt], zi = acc[1][nt][reg] + bi[nt];
                    const float r = __builtin_amdgcn_rcpf(1.f + __expf(-za)), ig = __builtin_amdgcn_rcpf(1.f + __expf(-zi));
                    const float a = __builtin_amdgcn_exp2f(c2[nt] * r);
                    const float xcv = bf2f(*(const bf16_t*)(lds + LRU_XA + t * XA_STRIDE + (cq * 32 + jj) * 2));
                    SA[t * 32 + jj] = a; SB[t * 32 + jj] = __builtin_amdgcn_sqrtf(fmaxf(1.f - a * a, 0.f)) * (ig * xcv);
                }
            __syncthreads();
            float av[8], bv[8];
#pragma unroll
            for (int k = 0; k < 8; ++k) { av[k] = SA[(seg * 8 + k) * 32 + sc]; bv[k] = SB[(seg * 8 + k) * 32 + sc]; }
            float P = 1.f, H = 0.f;
#pragma unroll
            for (int k = 0; k < 8; ++k) { H = av[k] * H + bv[k]; P *= av[k]; }
            SEGP[seg * 32 + sc] = P; SEGH[seg * 32 + sc] = H;
            __syncthreads();
            float run = carry, hin = carry;
#pragma unroll
            for (int s = 0; s < 16; ++s) { if (s == seg) hin = run; run = SEGP[s * 32 + sc] * run + SEGH[s * 32 + sc]; }
            carry = run;
            H = hin;
#pragma unroll
            for (int k = 0; k < 8; ++k) { H = av[k] * H + bv[k]; ymix[(row0 + seg * 8 + k) * D + hd * 128 + cq * 32 + sc] = f2bf(H * bf2f(yg[k])); }
        }
        __syncthreads();
    }
}

constexpr int SGU_RS = 0, SGU_TV = 512, SGU_SS = SGU_TV + 128 * XA_STRIDE, SS_STRIDE = 132;
__device__ __forceinline__ void phase_sgu(KP p, unsigned char* lds, int bid, int nb) {
    const int tid = opaque_tid(), lane = tid & 63, wave = tid >> 6, c16 = lane & 15, q = lane >> 4;
    const bf16_t* UG = (const bf16_t*)(p->ws + WS_PROJ) + (size_t)2 * M * 1024; const bf16_t* VG = UG + (size_t)M * 1024;
    const float* ssqv = (const float*)(p->ws + WS_SSQV); bf16_t* ymix = (bf16_t*)(p->ws + WS_YMIX);
    float* RS = (float*)(lds + SGU_RS); float* SS = (float*)(lds + SGU_SS);
    bf16x8_t wa[8][4]; float gvv[8]; int gcur = -1;
    const int oct = tid & 15;
    for (int it = bid; it < NB * 16 * 8; it += nb) {
        const int g = it & 7; const size_t base = (size_t)(it >> 3) * 128;
        if (g != gcur) { gcur = g;
#pragma unroll
            for (int mt = 0; mt < 8; ++mt)
#pragma unroll
                for (int ks = 0; ks < 4; ++ks) if (ks <= ((16 * mt + 15) >> 5))
                    wa[mt][ks] = *(const bf16x8_t*)((const bf16_t*)(p->ws + WS_WSPB) + ((size_t)(g * 128 + mt * 16 + c16) * 128 + ks * 32 + 8 * q));
#pragma unroll
            for (int e = 0; e < 8; ++e) gvv[e] = p->in[I_GV][g * 128 + oct * 8 + e]; }
        uint4 vch[4], uch[4];
#pragma unroll
        for (int k = 0; k < 4; ++k) { const int row = (tid >> 4) + 32 * k; vch[k] = *(const uint4*)(VG + (base + row) * 1024 + g * 128 + oct * 8); uch[k] = *(const uint4*)(UG + (base + row) * 1024 + g * 128 + oct * 8); }
        if (tid < 128) { float ss = 0.f;
#pragma unroll
            for (int k = 0; k < 16; ++k) ss += ssqv[(base + tid) * 16 + k];
            RS[tid] = rsqrtf(ss * (1.f / 1024.f) + EPS); }
        __syncthreads();
#pragma unroll
        for (int k = 0; k < 4; ++k) { const int row = (tid >> 4) + 32 * k; const float r = RS[row]; const unsigned ww[4] = {vch[k].x, vch[k].y, vch[k].z, vch[k].w}; unsigned oo[4];
#pragma unroll
            for (int e2 = 0; e2 < 4; ++e2) oo[e2] = pk2(__uint_as_float(ww[e2] << 16) * r * gvv[2 * e2], __uint_as_float(ww[e2] & 0xffff0000u) * r * gvv[2 * e2 + 1]);
            *(uint4*)(lds + SGU_TV + row * XA_STRIDE + oct * 16) = make_uint4(oo[0], oo[1], oo[2], oo[3]); }
        __syncthreads();
        bf16x8_t bfr[4];
        { const int q4 = c16 >> 2, p4 = c16 & 3;
#pragma unroll
          for (int ks = 0; ks < 4; ++ks) {
              const unsigned a1 = SGU_TV + (ks * 32 + 8 * q + q4) * XA_STRIDE + (wave * 16 + 4 * p4) * 2;
              const s16x4_t lo = __builtin_amdgcn_ds_read_tr16_b64_v4i16((LAS s16x4_t*)(lds + a1));
              const s16x4_t hi = __builtin_amdgcn_ds_read_tr16_b64_v4i16((LAS s16x4_t*)(lds + a1 + 4 * XA_STRIDE));
              bfr[ks] = __builtin_shufflevector(lo, hi, 0, 1, 2, 3, 4, 5, 6, 7); } }
        f32x4_t acc[8];
#pragma unroll
        for (int mt = 0; mt < 8; ++mt) { acc[mt] = (f32x4_t){0.f, 0.f, 0.f, 0.f};
#pragma unroll
            for (int ks = 0; ks < 4; ++ks) if (ks <= ((16 * mt + 15) >> 5)) acc[mt] = __builtin_amdgcn_mfma_f32_16x16x32_bf16(wa[mt][ks], bfr[ks], acc[mt], 0, 0, 0); }
#pragma unroll
        for (int mt = 0; mt < 8; ++mt)
#pragma unroll
            for (int reg = 0; reg < 4; ++reg) { const int i = mt * 16 + 4 * q + reg; SS[i * SS_STRIDE + wave * 16 + c16] = acc[mt][reg] + p->in[I_BSP][g * 128 + i]; }
        __syncthreads();
#pragma unroll
        for (int k = 0; k < 4; ++k) { const int row = (tid >> 4) + 32 * k; const float4 s0 = *(const float4*)(SS + row * SS_STRIDE + oct * 8), s1 = *(const float4*)(SS + row * SS_STRIDE + oct * 8 + 4);
            const unsigned ww[4] = {uch[k].x, uch[k].y, uch[k].z, uch[k].w}; const float sv[8] = {s0.x, s0.y, s0.z, s0.w, s1.x, s1.y, s1.z, s1.w}; unsigned oo[4];
#pragma unroll
            for (int e2 = 0; e2 < 4; ++e2) oo[e2] = pk2(__uint_as_float(ww[e2] << 16) * sv[2 * e2], __uint_as_float(ww[e2] & 0xffff0000u) * sv[2 * e2 + 1]);
            *(uint4*)(ymix + (base + row) * D + 1024 + g * 128 + oct * 8) = make_uint4(oo[0], oo[1], oo[2], oo[3]); }
        __syncthreads();
    }
}

typedef float f32x16_t __attribute__((ext_vector_type(16)));
__device__ __forceinline__ float vmaxf(float a, float b) { float r; asm("v_max_f32 %0, %1, %2" : "=v"(r) : "v"(a), "v"(b)); return r; }
__device__ __forceinline__ float vminf(float a, float b) { float r; asm("v_min_f32 %0, %1, %2" : "=v"(r) : "v"(a), "v"(b)); return r; }
#define CE_DESC(a, b) do { const float _mx = vmaxf(a, b), _mn = vminf(a, b); a = _mx; b = _mn; } while (0)
__device__ __forceinline__ void sort16_desc(float (&v)[16]) {
#pragma unroll
    for (int k = 2; k <= 16; k <<= 1)
#pragma unroll
        for (int j = k >> 1; j > 0; j >>= 1)
#pragma unroll
            for (int i = 0; i < 16; ++i) { const int l = i ^ j; if (l > i) { if ((i & k) == 0) CE_DESC(v[i], v[l]); else CE_DESC(v[l], v[i]); } }
}
__device__ __forceinline__ void merge16_desc(float (&a)[16], const float (&b)[16]) {
#pragma unroll
    for (int i = 0; i < 16; ++i) a[i] = vmaxf(a[i], b[15 - i]);
#pragma unroll
    for (int j = 8; j > 0; j >>= 1)
#pragma unroll
        for (int i = 0; i < 16; ++i) { const int l = i ^ j; if (l > i) CE_DESC(a[i], a[l]); }
}
__device__ __forceinline__ void topk_half(const bf16_t* qp, const unsigned char* kl, unsigned hh4, float (&X)[16]) {
    f32x16_t acc[4];
#pragma unroll
    for (int kt = 0; kt < 4; ++kt)
#pragma unroll
        for (int i = 0; i < 16; ++i) acc[kt][i] = 0.f;
#pragma unroll
    for (int ks = 0; ks < 8; ++ks) {
        const bf16x8_t bq = *(const bf16x8_t*)(qp + ks * 16);
#pragma unroll
        for (int kt = 0; kt < 4; ++kt) { const bf16x8_t ak = *(const bf16x8_t*)(kl + kt * 32 * XA_STRIDE + ks * 32); acc[kt] = __builtin_amdgcn_mfma_f32_32x32x16_bf16(ak, bq, acc[kt], 0, 0, 0); }
    }
    float g[4][16];
#pragma unroll
    for (int kt = 0; kt < 4; ++kt)
#pragma unroll
        for (int reg = 0; reg < 16; ++reg) g[kt][reg] = __uint_as_float(((__float_as_uint(acc[kt][reg]) & 0xFFFFFF80u) | hh4) | (unsigned)(kt * 32 + (reg & 3) + 8 * (reg >> 2)));
    sort16_desc(g[0]); sort16_desc(g[1]); sort16_desc(g[2]); sort16_desc(g[3]);
    merge16_desc(g[0], g[1]); merge16_desc(g[2], g[3]); merge16_desc(g[0], g[2]);
#pragma unroll
    for (int i = 0; i < 16; ++i) X[i] = g[0][i];
}
__device__ __forceinline__ unsigned pack_b0(float a, float b, float c, float d) {
    const unsigned ab = __builtin_amdgcn_perm(__float_as_uint(b), __float_as_uint(a), 0x0c0c0400u), cd = __builtin_amdgcn_perm(__float_as_uint(d), __float_as_uint(c), 0x0c0c0400u);
    return __builtin_amdgcn_perm(cd, ab, 0x05040100u);
}
__device__ __forceinline__ unsigned byte_lookup(const unsigned (&pk)[4], unsigned e) {
    const unsigned lo = __builtin_amdgcn_perm(pk[1], pk[0], e & 7u), hi = __builtin_amdgcn_perm(pk[3], pk[2], e & 7u);
    return ((e & 8u) ? hi : lo) & 0x7Fu;
}
__device__ __forceinline__ void phase_topk(KP p, unsigned char* lds, int bid, int nb) {
    const int tid = opaque_tid(), lane = tid & 63, wave = tid >> 6, r32 = lane & 31, hh = lane >> 5;
    const bf16_t* Q = (const bf16_t*)(p->ws + WS_Q); const bf16_t* KB = (const bf16_t*)(p->ws + WS_SKEYB);
    int* idx = (int*)(p->ws + WS_IDX); float* gate = (float*)(p->ws + WS_GATE);
    const float NEG = -3.0e38f;
    int hcur = -1;
    for (int bi = bid; bi < NHEAD * (M / 256); bi += nb) {
        const int hd = bi & 7, tile = (bi >> 3) * 8 + wave; const size_t token = (size_t)tile * 32 + r32;
        if (hd != hcur) { hcur = hd; __syncthreads();
#pragma unroll
            for (int k = 0; k < 8; ++k) { const int c = tid + NT * k, row = c >> 4, o = c & 15;
                *(uint4*)(lds + row * XA_STRIDE + o * 16) = *(const uint4*)(KB + ((size_t)hd * 256 + row) * 128 + o * 8); }
            __syncthreads(); }
        float X0[16], X1[16];
        topk_half(Q + token * D + hd * 256 + 8 * hh, lds + r32 * XA_STRIDE + hh * 16, 4u * hh, X0);
        __builtin_amdgcn_sched_barrier(0);
        topk_half(Q + token * D + hd * 256 + 128 + 8 * hh, lds + (128 + r32) * XA_STRIDE + hh * 16, 4u * hh, X1);
        __builtin_amdgcn_sched_barrier(0);
#pragma unroll
        for (int i = 0; i < 16; ++i) { const auto r = __builtin_amdgcn_permlane32_swap(__float_as_uint(X0[i]), __float_as_uint(X1[i]), false, false); X0[i] = __uint_as_float(r[0]); X1[i] = __uint_as_float(r[1]); }
        merge16_desc(X0, X1);
        float U[16];
#pragma unroll
        for (int i = 0; i < 16; ++i) U[i] = __shfl_xor(X0[i], 32);
        const unsigned hbit = (unsigned)hh << 8;
        float c0[16], c1[16];
#pragma unroll
        for (int j = 0; j < 16; ++j) { float s = X0[0] + U[j]; if (j == 0) s = hh ? NEG : s; c0[j] = __uint_as_float(((__float_as_uint(s) & 0xFFFFFE00u) | hbit) | (unsigned)j); }
        {
            int n = 0;
#pragma unroll
            for (int i = 1; i < 4; ++i)
#pragma unroll
                for (int j = i; j < 16; ++j) if ((i + 1) * (j + 1) <= 16) { float s = X0[i] + U[j]; if (j == i) s = hh ? NEG : s; c1[n] = __uint_as_float(((__float_as_uint(s) & 0xFFFFFE00u) | hbit) | (unsigned)(i * 16 + j)); ++n; }
#pragma unroll
            for (int k = 11; k < 16; ++k) c1[k] = NEG;
        }
        sort16_desc(c0); sort16_desc(c1); merge16_desc(c0, c1);
        float F[16];
#pragma unroll
        for (int i = 0; i < 16; ++i) F[i] = vmaxf(c0[i], __shfl_xor(c0[15 - i], 32));
        float mx = F[0];
#pragma unroll
        for (int i = 1; i < 16; ++i) mx = vmaxf(mx, F[i]);
        float ev[16], sum = 0.f;
#pragma unroll
        for (int i = 0; i < 16; ++i) { ev[i] = __expf(F[i] - mx); sum += ev[i]; }
        const float inv = 1.f / sum;
        unsigned pt[4], pu[4], pa[4], pb[4];
#pragma unroll
        for (int w = 0; w < 4; ++w) { pt[w] = pack_b0(X0[4 * w], X0[4 * w + 1], X0[4 * w + 2], X0[4 * w + 3]); pu[w] = pack_b0(U[4 * w], U[4 * w + 1], U[4 * w + 2], U[4 * w + 3]); }
#pragma unroll
        for (int w = 0; w < 4; ++w) { pa[w] = hh ? pu[w] : pt[w]; pb[w] = hh ? pt[w] : pu[w]; }
        int oi[8]; float og[8];
#pragma unroll
        for (int k = 0; k < 8; ++k) {
            const unsigned pl = __float_as_uint(F[k]) & 0x1FFu, sw = pl >> 8, pi = (pl >> 4) & 15u, pj = pl & 15u;
            const unsigned ai = sw ? pj : pi, bj = sw ? pi : pj;
            oi[k] = (int)(byte_lookup(pa, ai) * NKEYS + byte_lookup(pb, bj)); og[k] = ev[k] * inv;
        }
        int* io = idx + token * NSEL + hd * TOPK + 8 * hh; float* go = gate + token * NSEL + hd * TOPK + 8 * hh;
        *(int4*)io = make_int4(oi[0], oi[1], oi[2], oi[3]); *(int4*)(io + 4) = make_int4(oi[4], oi[5], oi[6], oi[7]);
        *(float4*)go = make_float4(og[0], og[1], og[2], og[3]); *(float4*)(go + 4) = make_float4(og[4], og[5], og[6], og[7]);
    }
}

__device__ __forceinline__ void wave_argmax(float& v, int& i) {
#pragma unroll
    for (int off = 32; off >= 1; off >>= 1) { const float ov = __shfl_xor(v, off); const int oi = __shfl_xor(i, off); if (ov > v || (ov == v && oi < i)) { v = ov; i = oi; } }
}
__device__ __forceinline__ void topk_half_naive(const bf16_t* q, const float* k0, int lane, float& outv, int& outi) {
    const float NEG = -3.0e38f;
    const float* k1 = k0 + 64 * 128;
    float s0 = 0.f, s1 = 0.f;
    for (int k = 0; k < 128; k += 4) {
        const uint2 qq = *(const uint2*)(q + k);
        const float q0 = bf2f((bf16_t)(qq.x & 0xffff)), q1 = bf2f((bf16_t)(qq.x >> 16)), q2 = bf2f((bf16_t)(qq.y & 0xffff)), q3 = bf2f((bf16_t)(qq.y >> 16));
        const float4 a = *(const float4*)(k0 + k), b = *(const float4*)(k1 + k);
        s0 += q0 * a.x + q1 * a.y + q2 * a.z + q3 * a.w; s1 += q0 * b.x + q1 * b.y + q2 * b.z + q3 * b.w;
    }
    float myv = NEG; int myi = 0;
    for (int r = 0; r < TOPK; ++r) {
        float v; int i; if (s0 >= s1) { v = s0; i = lane; } else { v = s1; i = lane + 64; }
        wave_argmax(v, i);
        if (i == lane) s0 = NEG; if (i == lane + 64) s1 = NEG;
        if (lane == r) { myv = v; myi = i; }
    }
    outv = myv; outi = myi;
}
__device__ __forceinline__ void phase_topk_naive(KP p, int bid, int nb) {
    const bf16_t* Q = (const bf16_t*)(p->ws + WS_Q); const float* keys = p->in[I_SKEY];
    int* idx = (int*)(p->ws + WS_IDX); float* gate = (float*)(p->ws + WS_GATE);
    const int tid = opaque_tid(), lane = tid & 63, wave = tid >> 6;
    const float NEG = -3.0e38f;
    for (int task = bid * 8 + wave; task < M * NHEAD; task += nb * 8) {
        const int token = task >> 3, hd = task & 7;
        float tv0, tv1; int ti0, ti1;
        topk_half_naive(Q + (size_t)token * D + hd * 256, keys + ((size_t)(hd * 2) * 128 + lane) * 128, lane, tv0, ti0);
        topk_half_naive(Q + (size_t)token * D + hd * 256 + 128, keys + ((size_t)(hd * 2 + 1) * 128 + lane) * 128, lane, tv1, ti1);
        const float vb = __shfl(tv1, lane & 15);
        float c0 = __shfl(tv0, (lane >> 4)) + vb, c1 = __shfl(tv0, (lane >> 4) + 4) + vb, c2 = __shfl(tv0, (lane >> 4) + 8) + vb, c3 = __shfl(tv0, (lane >> 4) + 12) + vb;
        float selv = NEG; int selc = 0;
        for (int r = 0; r < TOPK; ++r) {
            float v = c0; int i = lane;
            if (c1 > v) { v = c1; i = lane + 64; }
            if (c2 > v) { v = c2; i = lane + 128; }
            if (c3 > v) { v = c3; i = lane + 192; }
            wave_argmax(v, i);
            if (i == lane) c0 = NEG; if (i == lane + 64) c1 = NEG; if (i == lane + 128) c2 = NEG; if (i == lane + 192) c3 = NEG;
            if (lane == r) { selv = v; selc = i; }
        }
        const float mx = __shfl(selv, 0);
        const float e = lane < TOPK ? __expf(selv - mx) : 0.f;
        const float sum = wave_sum(e);
        const int i1 = __shfl(ti0, selc >> 4), i2 = __shfl(ti1, selc & 15);
        if (lane < TOPK) { idx[(size_t)token * NSEL + hd * TOPK + lane] = i1 * NKEYS + i2; gate[(size_t)token * NSEL + hd * TOPK + lane] = e / sum; }
    }
}

typedef float f32x2_t __attribute__((ext_vector_type(2)));
constexpr size_t GRP_BYTES = (size_t)NKEYS * NKEYS * 128;
constexpr int NGRP = D / 128;
__device__ __forceinline__ float wave_max(float v) {
#pragma unroll
    for (int o = 1; o < 64; o <<= 1) v = fmaxf(v, __shfl_xor(v, o));
    return v;
}
__device__ __forceinline__ void phase_convert_experts(KP p, int bid, int nb) {
    const int tid = opaque_tid(), lane = tid & 63, wave = tid >> 6;
    for (int row = bid * 8 + wave; row < 2 * NKEYS * NKEYS; row += nb * 8) {
        const int t = row >= NKEYS * NKEYS, e = row - t * NKEYS * NKEYS;
        const float* src = (t ? p->in[I_EV] : p->in[I_EU]) + (size_t)e * D;
        unsigned char* dst = p->ws + (t ? WS_EV8 : WS_EU8) + (size_t)e * 128 + (size_t)(lane >> 5) * GRP_BYTES + (lane & 31) * 4;
        float4 v[8]; float am = 0.f;
#pragma unroll
        for (int j = 0; j < 8; ++j) { v[j] = *(const float4*)(src + lane * 4 + 256 * j); am = fmaxf(am, fmaxf(fmaxf(fabsf(v[j].x), fabsf(v[j].y)), fmaxf(fabsf(v[j].z), fabsf(v[j].w)))); }
        am = wave_max(am);
        int ex = 0; if (am > 0.f) (void)frexpf(am, &ex); else ex = 8;
        const float sc = ldexpf(1.f, 8 - ex);
#pragma unroll
        for (int j = 0; j < 8; ++j) { int w = __builtin_amdgcn_cvt_pk_fp8_f32(v[j].x * sc, v[j].y * sc, 0, false); w = __builtin_amdgcn_cvt_pk_fp8_f32(v[j].z * sc, v[j].w * sc, w, true); *(unsigned*)(dst + (size_t)(2 * j) * GRP_BYTES) = (unsigned)w; }
        if (lane == 0) ((float*)(p->ws + WS_ESCALE))[row] = ldexpf(1.f, ex - 8);
    }
}
__device__ __forceinline__ unsigned xb_xcc_id();
constexpr int PEER_TT = 8;
constexpr int PEER_NTILE = M / PEER_TT;
constexpr int CW_UQ = 4096, CW_VQ = 8192;
__device__ __forceinline__ float dpp_xor1(float v) { return __builtin_bit_cast(float, __builtin_amdgcn_update_dpp(0, __builtin_bit_cast(int, v), 0xB1, 0xF, 0xF, true)); }
__device__ __forceinline__ float dpp_xor2(float v) { return __builtin_bit_cast(float, __builtin_amdgcn_update_dpp(0, __builtin_bit_cast(int, v), 0x4E, 0xF, 0xF, true)); }
__device__ __forceinline__ float dpp_hmirror(float v) { return __builtin_bit_cast(float, __builtin_amdgcn_update_dpp(0, __builtin_bit_cast(int, v), 0x141, 0xF, 0xF, true)); }
template <bool VPASS>
__device__ __forceinline__ void phase_peer_gather(KP p, float* lds, int bid, int nb) {
    const int tid = opaque_tid(), lane = tid & 63, k = lane >> 3, c = lane & 7;
    const bf16_t* H = (const bf16_t*)(p->ws + WS_H); const int* idx = (const int*)(p->ws + WS_IDX);
    const unsigned char* TAB = p->ws + (VPASS ? WS_EV8 : WS_EU8);
    float* pdot = (float*)(p->ws + WS_PDOT); const float* act = (const float*)(p->ws + WS_ACT); float* ssq2 = (float*)(p->ws + WS_SSQ2);
    unsigned* ctr = (unsigned*)(p->ws + WS_CTL) + (VPASS ? CW_VQ : CW_UQ);
    if (VPASS) { for (int i = tid; i < NB * D; i += NT) lds[i] = mod_at(p, i >> 11, 5 * D + (i & (D - 1))); __syncthreads(); }
    const unsigned slot0 = xb_xcc_id() & 7u;
    const int vcol = 16 * c + 8 * (k & 1) + 4 * ((k >> 1) & 1) + 2 * (k >> 2);
    for (int sl = 0; sl < 8; ++sl) {
        const int slot = (int)((slot0 + sl) & 7u);
        for (;;) {
            unsigned q = 0; if (lane == 0) q = __hip_atomic_fetch_add(ctr + 64 * slot, 1u, __ATOMIC_RELAXED, __HIP_MEMORY_SCOPE_AGENT);
            q = (unsigned)__builtin_amdgcn_readfirstlane((int)q);
            if (q >= 2u * PEER_NTILE) break;
            const int g = slot * 2 + (int)(q / PEER_NTILE), tile = (int)(q % PEER_NTILE);
            const unsigned char* tg = TAB + (size_t)g * GRP_BYTES + c * 16;
            for (int tt = 0; tt < PEER_TT; ++tt) {
                const size_t token = (size_t)tile * PEER_TT + tt;
                int e[16];
#pragma unroll
                for (int i = 0; i < 4; ++i) { const int4 v = *(const int4*)(idx + token * NSEL + 16 * k + 4 * i); e[4 * i] = v.x; e[4 * i + 1] = v.y; e[4 * i + 2] = v.z; e[4 * i + 3] = v.w; }
                uint4 r[16];
#pragma unroll
                for (int j = 0; j < 16; ++j) r[j] = *(const uint4*)(tg + (size_t)e[j] * 128);
                if (!VPASS) {
                    f32x2_t hv[8];
#pragma unroll
                    for (int hq = 0; hq < 2; ++hq) { const uint4 w = *(const uint4*)(H + token * D + g * 128 + 16 * c + 8 * hq); const unsigned ww[4] = {w.x, w.y, w.z, w.w};
#pragma unroll
                        for (int cc = 0; cc < 4; ++cc) hv[4 * hq + cc] = (f32x2_t){__uint_as_float(ww[cc] << 16), __uint_as_float(ww[cc] & 0xffff0000u)}; }
                    float p0 = 0.f, p1 = 0.f;
#pragma unroll
                    for (int j = 0; j < 16; ++j) { const unsigned ww[4] = {r[j].x, r[j].y, r[j].z, r[j].w}; f32x2_t d2 = {0.f, 0.f};
#pragma unroll
                        for (int cc = 0; cc < 4; ++cc) { d2 = __builtin_elementwise_fma(__builtin_amdgcn_cvt_pk_f32_fp8(ww[cc], false), hv[2 * cc], d2); d2 = __builtin_elementwise_fma(__builtin_amdgcn_cvt_pk_f32_fp8(ww[cc], true), hv[2 * cc + 1], d2); }
                        float d = d2.x + d2.y; d += dpp_xor1(d); d += dpp_xor2(d); d += dpp_hmirror(d);
                        if (j < 8) p0 = (c == j) ? d : p0; else p1 = (c == j - 8) ? d : p1; }
                    float* po = pdot + ((size_t)g * M + token) * NSEL + 16 * k + c;
                    po[0] = p0; po[8] = p1;
                } else {
                    float a[16];
#pragma unroll
                    for (int i = 0; i < 4; ++i) { const float4 v = *(const float4*)(act + token * NSEL + 16 * k + 4 * i); a[4 * i] = v.x; a[4 * i + 1] = v.y; a[4 * i + 2] = v.z; a[4 * i + 3] = v.w; }
                    f32x2_t acc[8];
#pragma unroll
                    for (int m = 0; m < 8; ++m) acc[m] = (f32x2_t){0.f, 0.f};
#pragma unroll
                    for (int j = 0; j < 16; ++j) { const unsigned ww[4] = {r[j].x, r[j].y, r[j].z, r[j].w}; const f32x2_t a2 = {a[j], a[j]};
#pragma unroll
                        for (int cc = 0; cc < 4; ++cc) { acc[2 * cc] = __builtin_elementwise_fma(__builtin_amdgcn_cvt_pk_f32_fp8(ww[cc], false), a2, acc[2 * cc]); acc[2 * cc + 1] = __builtin_elementwise_fma(__builtin_amdgcn_cvt_pk_f32_fp8(ww[cc], true), a2, acc[2 * cc + 1]); } }
                    f32x2_t b4[4];
#pragma unroll
                    for (int m = 0; m < 4; ++m) { const f32x2_t keep = (k & 1) ? acc[4 + m] : acc[m], send = (k & 1) ? acc[m] : acc[4 + m]; b4[m].x = keep.x + __shfl_xor(send.x, 8); b4[m].y = keep.y + __shfl_xor(send.y, 8); }
                    f32x2_t b2[2];
#pragma unroll
                    for (int m = 0; m < 2; ++m) { const f32x2_t keep = (k & 2) ? b4[2 + m] : b4[m], send = (k & 2) ? b4[m] : b4[2 + m]; b2[m].x = keep.x + __shfl_xor(send.x, 16); b2[m].y = keep.y + __shfl_xor(send.y, 16); }
                    f32x2_t o2; { const f32x2_t keep = (k & 4) ? b2[1] : b2[0], send = (k & 4) ? b2[0] : b2[1]; o2.x = keep.x + __shfl_xor(send.x, 32); o2.y = keep.y + __shfl_xor(send.y, 32); }
                    const int col = g * 128 + vcol;
                    float* xo = p->out + token * D + col; const float2 x1 = *(const float2*)xo; const float2 gt = *(const float2*)(lds + (token / SEQ) * D + col);
                    const float y0 = x1.x + gt.x * o2.x, y1 = x1.y + gt.y * o2.y;
                    *(float2*)xo = make_float2(y0, y1);
                    const float ss = wave_sum(y0 * y0 + y1 * y1);
                    if (lane == 0) ssq2[(size_t)g * M + token] = ss;
                }
            }
        }
    }
}
__device__ __forceinline__ void phase_peer_act(KP p, int bid, int nb) {
    const int tid = opaque_tid(), lane = tid & 63, wave = tid >> 6;
    const int* idx = (const int*)(p->ws + WS_IDX); const float* gate = (const float*)(p->ws + WS_GATE); const float* esc = (const float*)(p->ws + WS_ESCALE);
    const float* pdot = (const float*)(p->ws + WS_PDOT); float* act = (float*)(p->ws + WS_ACT);
    for (int token = bid * 8 + wave; token < M; token += nb * 8) {
        float d0 = 0.f, d1 = 0.f;
#pragma unroll
        for (int g = 0; g < NGRP; ++g) { d0 += pdot[((size_t)g * M + token) * NSEL + lane]; d1 += pdot[((size_t)g * M + token) * NSEL + 64 + lane]; }
        const int e0 = idx[(size_t)token * NSEL + lane], e1 = idx[(size_t)token * NSEL + 64 + lane];
        act[(size_t)token * NSEL + lane] = gelu_t(d0 * esc[e0]) * gate[(size_t)token * NSEL + lane] * esc[NKEYS * NKEYS + e0];
        act[(size_t)token * NSEL + 64 + lane] = gelu_t(d1 * esc[e1]) * gate[(size_t)token * NSEL + 64 + lane] * esc[NKEYS * NKEYS + e1];
    }
}
__device__ __forceinline__ void phase_final_norm(KP p, int bid, int nb) {
    const int tid = opaque_tid(), lane = tid & 63, wave = tid >> 6;
    const float* ssq2 = (const float*)(p->ws + WS_SSQ2); const float* gf = p->in[I_GFIN];
    for (int token = bid * 8 + wave; token < M; token += nb * 8) {
        float ss = 0.f;
#pragma unroll
        for (int g = 0; g < NGRP; ++g) ss += ssq2[(size_t)g * M + token];
        const float rstd = rsqrtf(ss * (1.f / D) + EPS);
        float* row = p->out + (size_t)token * D;
#pragma unroll
        for (int j = 0; j < 8; ++j) { const int col = lane * 4 + 256 * j; const float4 v = *(const float4*)(row + col); const float4 g4 = *(const float4*)(gf + col);
            *(float4*)(row + col) = make_float4(v.x * rstd * g4.x, v.y * rstd * g4.y, v.z * rstd * g4.z, v.w * rstd * g4.w); }
    }
}

#define XB_TMO      128
#define XB_XCNT(j)  (256  + 64 * (j))
#define XB_XSUB(j)  (1280 + 64 * (j))
#define XB_XGEN(j)  (2304 + 64 * (j))
#define XB_TOP      3328
#define XB_TOPGEN   3392
#define XCD_BAR_WORDS 3456
#define XB_SPIN_CAP (1u << 18)

__device__ __forceinline__ unsigned xb_ld(unsigned* p)              { return __hip_atomic_load(p, __ATOMIC_RELAXED, __HIP_MEMORY_SCOPE_AGENT); }
__device__ __forceinline__ unsigned xb_add(unsigned* p, unsigned v) { return __hip_atomic_fetch_add(p, v, __ATOMIC_RELAXED, __HIP_MEMORY_SCOPE_AGENT); }
__device__ __forceinline__ unsigned xb_xcc_id() { return (unsigned)__builtin_amdgcn_s_getreg((3 << 11) | 20) & 0xFu; }
#define XB_SPIN(cond, bar) do { unsigned _sp = 0; while (cond) { __builtin_amdgcn_s_sleep(1); \
    if ((++_sp & 255u) == 0u) { if (xb_ld(&(bar)[XB_TMO])) break; if (_sp > XB_SPIN_CAP) { atomicAdd(&(bar)[XB_TMO], 1u); break; } } } } while (0)

struct XcdBarrier {
    unsigned* bar; unsigned x;
    volatile LAS unsigned* st;
};

__device__ __forceinline__ XcdBarrier xcd_barrier_post(unsigned* bar, volatile LAS unsigned* st) {
    XcdBarrier b; b.bar = bar; b.x = xb_xcc_id(); b.st = st;
    if (threadIdx.x == 0) (void)xb_add(&bar[XB_XCNT(b.x)], 1u);
    return b;
}
__device__ __forceinline__ void xcd_barrier_complete(unsigned* bar, unsigned x, unsigned& nloc, unsigned& nx) {
    const unsigned G = gridDim.x * gridDim.y * gridDim.z;
    unsigned sum, cnt, mine, sp = 0u;
    for (;;) {
        sum = 0u; cnt = 0u; mine = 0u;
#pragma unroll
        for (unsigned j = 0; j < 16; ++j) { const unsigned c = xb_ld(&bar[XB_XCNT(j)]); sum += c; cnt += (c > 0u) ? 1u : 0u; mine = (j == x) ? c : mine; }
        if (sum == G) break;
        __builtin_amdgcn_s_sleep(1);
        if ((++sp & 255u) == 0u) { if (xb_ld(&bar[XB_TMO])) break; if (sp > XB_SPIN_CAP) { atomicAdd(&bar[XB_TMO], 1u); break; } }
    }
    nloc = mine > 0u ? mine : 1u; nx = cnt > 0u ? cnt : 1u;
}

__device__ __forceinline__ void xcd_barrier(const XcdBarrier& b) {
    asm volatile("s_waitcnt vmcnt(0)" ::: "memory");
    __syncthreads();
    if (threadIdx.x == 0) {
        unsigned* bar = b.bar;
        __builtin_amdgcn_s_waitcnt(0);
        unsigned nloc = b.st[0], nx = b.st[1];
        if (nloc == 0u) { xcd_barrier_complete(bar, b.x, nloc, nx); b.st[0] = nloc; b.st[1] = nx; }
        const unsigned old = xb_add(&bar[XB_XSUB(b.x)], 1u);
        const unsigned gen = old / nloc;
        if (old + 1u == (gen + 1u) * nloc) {
            __builtin_amdgcn_fence(__ATOMIC_RELEASE, "agent");
            asm volatile("s_waitcnt vmcnt(0)" ::: "memory");
            const unsigned og = xb_add(&bar[XB_TOP], 1u);
            const unsigned tg = og / nx;
            if (og + 1u == (tg + 1u) * nx) xb_add(&bar[XB_TOPGEN], 1u);
            else XB_SPIN(xb_ld(&bar[XB_TOPGEN]) == tg, bar);
            __builtin_amdgcn_fence(__ATOMIC_ACQUIRE, "agent");
            xb_add(&bar[XB_XGEN(b.x)], 1u);
            asm volatile("s_waitcnt vmcnt(0)" ::: "memory");
        } else {
            XB_SPIN(xb_ld(&bar[XB_XGEN(b.x)]) == gen, bar);
            __builtin_amdgcn_fence(__ATOMIC_ACQUIRE, "agent");
            asm volatile("s_waitcnt vmcnt(0)" ::: "memory");
        }
    }
    __syncthreads();
}


extern __shared__ __attribute__((aligned(16))) unsigned char dyn_lds[];
constexpr int LDS_BYTES = 147456;
__global__ void __launch_bounds__(NT) fwd_megakernel(Params p_unused) {
    cg::grid_group grid = cg::this_grid();
    KP p = (KP)__builtin_amdgcn_kernarg_segment_ptr();
    float* lds = (float*)dyn_lds;
    const int bid = blockIdx.x, nb = gridDim.x;
    volatile LAS unsigned* bst = (volatile LAS unsigned*)((LAS unsigned char*)dyn_lds + LDS_BYTES - 16);
    if (threadIdx.x < 4) bst[threadIdx.x] = 0u;
    __syncthreads();
    const XcdBarrier xbar = xcd_barrier_post((unsigned*)(p->ws + WS_CTL), bst);
    phase_mod(p, lds, bid, nb);
    __syncthreads();
    phase_convert_weights(p, lds, bid, nb);
    phase_convert_experts(p, bid, nb);
    grid.sync();
    phase_hrows(p, p->in[I_X], p->in[I_GMIX], 0, D, (bf16_t*)(p->ws + WS_H), lds, bid, nb);
    xcd_barrier(xbar);
    { pg8::Gemm g{(const bf16_t*)(p->ws + WS_H), (const bf16_t*)(p->ws + WS_WIN_T), M, NPROJ, D}; pg8::StaticOrder S; S.init(M, NPROJ, nb, bid);
      pg8::EpiProj E{(bf16_t*)(p->ws + WS_PROJ), (float*)(p->ws + WS_SSQV), M};
      pg8::gemm_phase<pg8::EpiProj, pg8::StaticOrder, true, true>((LAS unsigned char*)dyn_lds, g, S, E); }
    xcd_barrier(xbar);
    phase_lru(p, dyn_lds, bid, nb);
    phase_sgu(p, dyn_lds, bid, nb);
    xcd_barrier(xbar);
    { pg8::Gemm g{(const bf16_t*)(p->ws + WS_YMIX), (const bf16_t*)(p->ws + WS_WOUT_T), M, D, D}; pg8::StaticOrder S; S.init(M, D, nb, bid);
      pg8::EpiX1 E{p->in[I_X], p->out, (const float*)(p->ws + WS_MODP), p->in[I_BADA], 2 * D, NMOD, SEQ};
      pg8::gemm_phase<pg8::EpiX1, pg8::StaticOrder, true, true>((LAS unsigned char*)dyn_lds, g, S, E); }
    xcd_barrier(xbar);
    phase_hrows(p, p->out, p->in[I_GFFN], 3 * D, 4 * D, (bf16_t*)(p->ws + WS_H), lds, bid, nb);
    xcd_barrier(xbar);
    { pg8::Gemm g{(const bf16_t*)(p->ws + WS_H), (const bf16_t*)(p->ws + WS_WQ_T), M, D, D}; pg8::StaticOrder S; S.init(M, D, nb, bid);
      pg8::EpiQ E{(bf16_t*)(p->ws + WS_Q), D};
      pg8::gemm_phase<pg8::EpiQ, pg8::StaticOrder, true, true>((LAS unsigned char*)dyn_lds, g, S, E); }
    xcd_barrier(xbar);
    phase_topk(p, dyn_lds, bid, nb);
    xcd_barrier(xbar);
    phase_peer_gather<false>(p, lds, bid, nb);
    xcd_barrier(xbar);
    phase_peer_act(p, bid, nb);
    xcd_barrier(xbar);
    phase_peer_gather<true>(p, lds, bid, nb);
    xcd_barrier(xbar);
    phase_final_norm(p, bid, nb);
}

extern "C" void kernel_launch(void* const* d_in, const int* in_sizes, int n_in, void* d_out, int out_size, void* d_ws, size_t ws_size, hipStream_t stream) {
    static int grid_blocks = 0;
    if (grid_blocks == 0) {
        if (n_in != 23 || in_sizes[0] != M * D || out_size != M * D || ws_size < WS_END) { fprintf(stderr, "kernel_launch: unexpected shapes (n_in %d in0 %d out %d ws %zu)\n", n_in, n_in > 0 ? in_sizes[0] : -1, out_size, ws_size); grid_blocks = -1; return; }
        if (hipFuncSetAttribute((const void*)fwd_megakernel, hipFuncAttributeMaxDynamicSharedMemorySize, LDS_BYTES) != hipSuccess) { fprintf(stderr, "hipFuncSetAttribute failed\n"); grid_blocks = -1; return; }
        int dev = 0, cus = 0, per_cu = 0;
        hipGetDevice(&dev);
        hipDeviceGetAttribute(&cus, hipDeviceAttributeMultiprocessorCount, dev);
        if (hipOccupancyMaxActiveBlocksPerMultiprocessor(&per_cu, (const void*)fwd_megakernel, NT, LDS_BYTES) != hipSuccess || per_cu < 1) { fprintf(stderr, "occupancy query failed (%d)\n", per_cu); grid_blocks = -1; return; }
        grid_blocks = cus;
    }
    if (grid_blocks < 0) return;
    Params p{};
    for (int i = 0; i < 23; ++i) p.in[i] = (const float*)d_in[i];
    p.out = (float*)d_out; p.ws = (unsigned char*)d_ws;
    if (hipMemsetAsync((char*)d_ws + WS_CTL, 0, 65536, stream) != hipSuccess) { fprintf(stderr, "hipMemsetAsync of the barrier words failed\n"); return; }
    void* args[] = {&p};
    hipError_t e = hipLaunchCooperativeKernel((const void*)fwd_megakernel, dim3(grid_blocks), dim3(NT), args, LDS_BYTES, stream);
    if (e != hipSuccess) fprintf(stderr, "cooperative launch failed: %s (grid %d)\n", hipGetErrorString(e), grid_blocks);
}
```

```cpp
#include <hip/hip_runtime.h>
#include <hip/hip_cooperative_groups.h>
#include <cstdio>
#include <cstdint>

constexpr int D = 2048, NB = 8, SEQ = 2048, M = NB * SEQ;
constexpr int DLRU = 1024, DSGU = 1024, NPROJ = 4096;
constexpr int NMOD = 6 * D;
constexpr int NHEAD = 8, NKEYS = 128, TOPK = 16, NSEL = NHEAD * TOPK;
constexpr float EPS = 1e-6f;
constexpr int NT = 512;
namespace cg = cooperative_groups;

constexpr size_t MiB = 1u << 20;
constexpr size_t WS_CTL = 0;
constexpr size_t WS_MODP = 1 * MiB;
constexpr size_t WS_WGA_T = 3 * MiB;
constexpr size_t WS_WGI_T = 3 * MiB + 262144;
constexpr size_t WS_WSPB = 3 * MiB + 524288;
constexpr size_t WS_SKEYB = 3 * MiB + 786432;
constexpr size_t WS_SSQV = 5 * MiB;
constexpr size_t WS_RSTDV = 8 * MiB;
constexpr size_t WS_WIN_T = 9 * MiB;
constexpr size_t WS_WOUT_T = 25 * MiB;
constexpr size_t WS_WQ_T = 33 * MiB;
constexpr size_t WS_IDX = 41 * MiB;
constexpr size_t WS_GATE = 49 * MiB;
constexpr size_t WS_H = 64 * MiB;
constexpr size_t WS_PROJ = 128 * MiB;
constexpr size_t WS_Q = 128 * MiB;
constexpr size_t WS_YMIX = 256 * MiB;
constexpr size_t WS_EU8 = 320 * MiB;
constexpr size_t WS_EV8 = 352 * MiB;
constexpr size_t WS_ESCALE = 57 * MiB;
constexpr size_t WS_XC = 320 * MiB;
constexpr size_t WS_A = 384 * MiB;
constexpr size_t WS_BB = 448 * MiB;
constexpr size_t WS_ACT = 256 * MiB;
constexpr size_t WS_SSQ2 = 264 * MiB;
constexpr size_t WS_PDOT = 384 * MiB;
constexpr size_t WS_END = 512 * MiB;

typedef unsigned short bf16_t;
struct Params { const float* in[23]; float* out; unsigned char* ws; };
typedef const __attribute__((address_space(4))) Params* KP;
enum { I_X = 0, I_C, I_WADA, I_BADA, I_GMIX, I_WIN, I_CONVW, I_CONVB, I_WGA, I_BGA, I_WGI, I_BGI, I_LAM, I_GV, I_WSP, I_BSP, I_WOUT, I_GFFN, I_WQ, I_SKEY, I_EU, I_EV, I_GFIN };

__device__ __forceinline__ int opaque_tid() { int t = threadIdx.x; asm volatile("" : "+v"(t)); return t; }
__device__ __forceinline__ float bf2f(bf16_t v) { return __uint_as_float(((unsigned)v) << 16); }
__device__ __forceinline__ bf16_t f2bf(float f) { unsigned u = __float_as_uint(f); u += 0x7fffu + ((u >> 16) & 1u); return (bf16_t)(u >> 16); }
__device__ __forceinline__ float sigmoidf_(float x) { return 1.f / (1.f + __expf(-x)); }
__device__ __forceinline__ float gelu_t(float x) { const float u = 0.7978845608028654f * (x + 0.044715f * x * x * x); return x * sigmoidf_(2.f * u); }
__device__ __forceinline__ float wave_sum(float v) {
#pragma unroll
    for (int o = 1; o < 64; o <<= 1) v += __shfl_xor(v, o);
    return v;
}
__device__ __forceinline__ float mod_at(KP p, int b, int n) {
    const float* mp = (const float*)(p->ws + WS_MODP);
    float s = p->in[I_BADA][n];
#pragma unroll
    for (int kc = 0; kc < 4; ++kc) s += mp[(size_t)(kc * 8 + b) * NMOD + n];
    return s;
}

__device__ __forceinline__ void phase_mod(KP p, float* lds, int bid, int nb) {
    const int tid = opaque_tid(), lane = tid & 63, wave = tid >> 6;
    const float* c = p->in[I_C]; const float* W = p->in[I_WADA];
    float* modp = (float*)(p->ws + WS_MODP);
    for (int i = tid; i < NB * D; i += NT) { const float v = c[i]; lds[i] = v * sigmoidf_(v); }
    __syncthreads();
    float* red = lds + NB * D;
    for (int item = bid; item < 192; item += nb) {
        const int nt = item % 48, kc = item / 48;
        const int n0 = nt * 256 + lane * 4, k0 = kc * 512 + wave * 64;
        float acc[8][4];
#pragma unroll
        for (int b = 0; b < 8; ++b)
#pragma unroll
            for (int j = 0; j < 4; ++j) acc[b][j] = 0.f;
        for (int kk = 0; kk < 64; ++kk) {
            const float4 w = *(const float4*)(W + (size_t)(k0 + kk) * NMOD + n0);
#pragma unroll
            for (int b = 0; b < 8; ++b) { const float s = lds[b * D + k0 + kk]; acc[b][0] += s * w.x; acc[b][1] += s * w.y; acc[b][2] += s * w.z; acc[b][3] += s * w.w; }
        }
#pragma unroll
        for (int b = 0; b < 8; ++b)
#pragma unroll
            for (int j = 0; j < 4; ++j) red[(wave * 32 + b * 4 + j) * 64 + lane] = acc[b][j];
        __syncthreads();
        for (int o = tid; o < 2048; o += NT) {
            const int b = o >> 8, nn = o & 255, ln = nn >> 2, j = nn & 3;
            float s = 0.f;
#pragma unroll
            for (int w = 0; w < 8; ++w) s += red[(w * 32 + b * 4 + j) * 64 + ln];
            modp[(size_t)(kc * 8 + b) * NMOD + nt * 256 + nn] = s;
        }
        __syncthreads();
    }
}

__device__ __forceinline__ void phase_hrows(KP p, const float* src, const float* gn, int shift_off, int scale_off, bf16_t* dst, float* lds, int bid, int nb) {
    const int tid = opaque_tid(), lane = tid & 63, wave = tid >> 6;
    float* Aw = lds; float* Bw = lds + D;
    for (int item = bid; item < M / 64; item += nb) {
        const int b = item / (SEQ / 64);
        for (int col = tid; col < D; col += NT) { Aw[col] = gn[col] * (1.f + mod_at(p, b, scale_off + col)); Bw[col] = mod_at(p, b, shift_off + col); }
        __syncthreads();
        for (int r = wave; r < 64; r += 8) {
            const size_t row = (size_t)item * 64 + r;
            float4 v[8]; float ss = 0.f;
#pragma unroll
            for (int j = 0; j < 8; ++j) { v[j] = *(const float4*)(src + row * D + lane * 4 + 256 * j); ss += v[j].x * v[j].x + v[j].y * v[j].y + v[j].z * v[j].z + v[j].w * v[j].w; }
            const float rstd = rsqrtf(wave_sum(ss) * (1.f / D) + EPS);
#pragma unroll
            for (int j = 0; j < 8; ++j) {
                const int col = lane * 4 + 256 * j;
                const float o0 = v[j].x * rstd * Aw[col] + Bw[col], o1 = v[j].y * rstd * Aw[col + 1] + Bw[col + 1];
                const float o2 = v[j].z * rstd * Aw[col + 2] + Bw[col + 2], o3 = v[j].w * rstd * Aw[col + 3] + Bw[col + 3];
                uint2 w; w.x = (unsigned)f2bf(o0) | ((unsigned)f2bf(o1) << 16); w.y = (unsigned)f2bf(o2) | ((unsigned)f2bf(o3) << 16);
                *(uint2*)(dst + row * D + col) = w;
            }
        }
        __syncthreads();
    }
}

namespace pg8 {
#define PG8_LAS __attribute__((address_space(3)))
typedef unsigned short bf16_t;
typedef short bf16x8 __attribute__((ext_vector_type(8)));
typedef float f32x4 __attribute__((ext_vector_type(4)));
typedef unsigned u32x4 __attribute__((ext_vector_type(4)));
constexpr int BM = 256, BK = 64, HALF = 128, HTB = HALF * BK * 2  , STAGE_BYTES = 8 * HTB, NXCD = 8, WGM = 8;

__host__ __device__ __forceinline__ int lds_byte(int r, int c) { const int st = (r >> 4) * 2 + (c >> 5), rr = r & 15, cc = c & 31, ob = rr * 64 + cc * 2; return st * 1024 + (ob ^ (((ob >> 9) & 1) << 5)); }
__host__ __device__ __forceinline__ void stage_rc(int b, int& R, int& C) { const int st = b / 1024, sb = b % 1024, swz = sb ^ (((sb >> 9) & 1) << 5); R = (st >> 1) * 16 + swz / 64; C = (st & 1) * 32 + (swz % 64) / 2; }
__host__ __device__ __forceinline__ int perm32(int rho) { const int n = rho >> 4, i = rho & 15; return 8 * (i >> 2) + 4 * n + (i & 3); }

struct Unit { int pm, pn; };
struct Gemm { const bf16_t* A; const bf16_t* Bt; int M, N, K; };

struct StaticOrder {
    int nM, nN, nwg, G, c;
    __host__ __device__ void init(int M, int N, int G_, int c_) { nM = M / BM; nN = N / BM; nwg = nM * nN; G = G_; c = c_; }
    __host__ __device__ bool next(int i, Unit& u) const {
        const long L = (long)i * G + c; if (L >= nwg) return false;
        int wgid = (int)L; { const int q = nwg / NXCD, r = nwg % NXCD, xcd = wgid % NXCD, off = wgid / NXCD; wgid = (xcd < r ? xcd * (q + 1) : r * (q + 1) + (xcd - r) * q) + off; }
        const int nig = WGM * nN, gid = wgid / nig, fm = gid * WGM, gsz = (nM - fm) < WGM ? (nM - fm) : WGM;
        u.pm = fm + ((wgid % nig) % gsz); u.pn = (wgid % nig) / gsz; return true;
    }
    __device__ __forceinline__ void a_ready(const Unit&) const {}
    __device__ __forceinline__ void done(const Unit&) const {}
};


__device__ __forceinline__ unsigned cvt_pk_bf16(float lo, float hi) { unsigned r; asm volatile("v_cvt_pk_bf16_f32 %0, %1, %2" : "=v"(r) : "v"(lo), "v"(hi)); return r; }
__device__ __forceinline__ float gelu_tanh(float x) { const float u = 1.5957691216057308f * (x + 0.044715f * x * x * x); return x * __builtin_amdgcn_rcpf(1.f + __expf(-u)); }
struct EpiProj {
    static constexpr bool PERM = true, AFTER_DRAIN = false;
    bf16_t* proj; float* ssqv; int Mrows;
    __device__ __forceinline__ void operator()(const f32x4 (&acc)[2][2][4][2], const Unit& u, int wr, int wc, int fr, int fq) const {
        const int which = (u.pn * BM) >> 10, colt = (u.pn * BM) & 1023;
        bf16_t* base = proj + (size_t)which * Mrows * 1024;
        const int row0 = u.pm * BM + wr * 64 + fr, col0 = colt + wc * 32 + 8 * fq;
#pragma unroll
        for (int ai = 0; ai < 2; ++ai)
#pragma unroll
            for (int m = 0; m < 4; ++m) { const int row = row0 + ai * HALF + m * 16; bf16_t* rowp = base + (size_t)row * 1024 + col0; float ss = 0.f;
#pragma unroll
                for (int bj = 0; bj < 2; ++bj) { f32x4 v0 = acc[ai][bj][m][0], v1 = acc[ai][bj][m][1];
                    if (which) {
#pragma unroll
                        for (int j = 0; j < 4; ++j) { v0[j] = gelu_tanh(v0[j]); v1[j] = gelu_tanh(v1[j]); } }
                    ss += (v0[0] * v0[0] + v0[1] * v0[1]) + (v0[2] * v0[2] + v0[3] * v0[3]) + (v1[0] * v1[0] + v1[1] * v1[1]) + (v1[2] * v1[2] + v1[3] * v1[3]);
                    u32x4 w; w.x = cvt_pk_bf16(v0[0], v0[1]); w.y = cvt_pk_bf16(v0[2], v0[3]); w.z = cvt_pk_bf16(v1[0], v1[1]); w.w = cvt_pk_bf16(v1[2], v1[3]);
                    *(u32x4*)(rowp + bj * HALF) = w; }
                if (which == 3) { ss += __shfl_xor(ss, 16); ss += __shfl_xor(ss, 32); if (fq == 0) ssqv[(size_t)row * 16 + (u.pn & 3) * 4 + wc] = ss; } }
    }
};
struct EpiX1 {
    static constexpr bool PERM = false, AFTER_DRAIN = false;
    const float* x; float* out; const float* modp; const float* bada; int goff, nmod, seq;
    __device__ __forceinline__ void operator()(const f32x4 (&acc)[2][2][4][2], const Unit& u, int wr, int wc, int fr, int fq) const {
        const int row0 = u.pm * BM + wr * 64 + fr, col0 = u.pn * BM + wc * 32 + 4 * fq, b = (u.pm * BM) / seq;
        f32x4 gv[2][2];
#pragma unroll
        for (int bj = 0; bj < 2; ++bj)
#pragma unroll
            for (int n = 0; n < 2; ++n) { const int c = goff + col0 + bj * HALF + n * 16; f32x4 g = *(const f32x4*)(bada + c);
#pragma unroll
                for (int kc = 0; kc < 4; ++kc) g += *(const f32x4*)(modp + (size_t)(kc * 8 + b) * nmod + c);
                gv[bj][n] = g; }
#pragma unroll
        for (int ai = 0; ai < 2; ++ai)
#pragma unroll
            for (int m = 0; m < 4; ++m) { const size_t off = (size_t)(row0 + ai * HALF + m * 16) * (size_t)(2048) + col0;
#pragma unroll
                for (int bj = 0; bj < 2; ++bj)
#pragma unroll
                    for (int n = 0; n < 2; ++n) { const f32x4 xv = *(const f32x4*)(x + off + bj * HALF + n * 16); *(f32x4*)(out + off + bj * HALF + n * 16) = xv + gv[bj][n] * acc[ai][bj][m][n]; } }
    }
};
struct EpiQ {
    static constexpr bool PERM = true, AFTER_DRAIN = false;
    bf16_t* O; int ldc;
    __device__ __forceinline__ void operator()(const f32x4 (&acc)[2][2][4][2], const Unit& u, int wr, int wc, int fr, int fq) const {
        const int row0 = u.pm * BM + wr * 64 + fr, col0 = u.pn * BM + wc * 32 + 8 * fq;
#pragma unroll
        for (int ai = 0; ai < 2; ++ai)
#pragma unroll
            for (int m = 0; m < 4; ++m) { bf16_t* rowp = O + (size_t)(row0 + ai * HALF + m * 16) * ldc + col0;
#pragma unroll
                for (int bj = 0; bj < 2; ++bj) { const f32x4 v0 = acc[ai][bj][m][0], v1 = acc[ai][bj][m][1];
                    u32x4 w; w.x = cvt_pk_bf16(v0[0], v0[1]); w.y = cvt_pk_bf16(v0[2], v0[3]); w.z = cvt_pk_bf16(v1[0], v1[1]); w.w = cvt_pk_bf16(v1[2], v1[3]);
                    *(u32x4*)(rowp + bj * HALF) = w; } }
    }
};

template <class Epi, class Sched, bool ALIGN_EPI = false, bool SP2 = false>
__device__ __forceinline__ void gemm_phase(PG8_LAS unsigned char* lds, const Gemm g, const Sched& S, const Epi& E) {
    const int tid = opaque_tid(), wid = __builtin_amdgcn_readfirstlane(tid >> 6), lane = tid & 63, wr = wid >> 2, wc = wid & 3, fr = lane & 15, fq = lane >> 4;
    const int K = g.K, nt = K / BK;
    unsigned voffA[2], voffB[2];
#pragma unroll
    for (int i = 0; i < 2; ++i) { int R, C; stage_rc(tid * 16 + i * 8192, R, C); const int Rb = Epi::PERM ? ((R & ~31) + perm32(R & 31)) : R;
        voffA[i] = (unsigned)(R * K + C) * 2u; voffB[i] = (unsigned)(Rb * K + C) * 2u; }
    const size_t kstep = (size_t)(BK * 2);
    const size_t hstep = (size_t)HALF * K * 2;
    const size_t tstep = 2 * hstep;
    const unsigned ldsw = (unsigned)wid * 1024u;
    const int aoff = lds_byte(wr * 64 + fr, fq * 8), boff = lds_byte(wc * 32 + fr, fq * 8);
#define PG8_SA(b, h) (((b) * 2 + (h)) * HTB)
#define PG8_SB(b, h) ((4 + (b) * 2 + (h)) * HTB)
#define PG8_STAGE(bufoff, gbase, voff) do { _Pragma("unroll") for (int _i = 0; _i < 2; ++_i) \
        __builtin_amdgcn_global_load_lds((const unsigned*)((const char*)(gbase) + (voff)[_i]), (PG8_LAS unsigned*)(lds + (bufoff) + ldsw + _i * 8192), 16, 0, 0); } while (0)
#define PG8_LDA(dst, b, h) do { _Pragma("unroll") for (int m = 0; m < 4; ++m) _Pragma("unroll") for (int k = 0; k < 2; ++k) dst[m][k] = *(const PG8_LAS bf16x8*)(lds + PG8_SA(b, h) + aoff + m * 2048 + k * 1024); } while (0)
#define PG8_LDB(dst, b, h) do { _Pragma("unroll") for (int n = 0; n < 2; ++n) _Pragma("unroll") for (int k = 0; k < 2; ++k) dst[n][k] = *(const PG8_LAS bf16x8*)(lds + PG8_SB(b, h) + boff + n * 2048 + k * 1024); } while (0)
#define PG8_MMA(ai, bj, At, Bt) do { __builtin_amdgcn_s_setprio(1); _Pragma("unroll") for (int m = 0; m < 4; ++m) _Pragma("unroll") for (int n = 0; n < 2; ++n) _Pragma("unroll") for (int k = 0; k < 2; ++k) \
        acc[ai][bj][m][n] = __builtin_amdgcn_mfma_f32_16x16x32_bf16(Bt[n][k], At[m][k], acc[ai][bj][m][n], 0, 0, 0); __builtin_amdgcn_s_setprio(0); } while (0)
#define PG8_WAIT_V(n) asm volatile("s_waitcnt vmcnt(" #n ")" ::: "memory")
#define PG8_WAIT_L(n) asm volatile("s_waitcnt lgkmcnt(" #n ")" ::: "memory")
#define PG8_BAR __builtin_amdgcn_s_barrier()
#define PG8_SCHED __builtin_amdgcn_sched_barrier(0)
    Unit cur, nxt; int ui = 0;
    if (!S.next(0, cur)) return;
    f32x4 acc[2][2][4][2];
#pragma unroll
    for (int a = 0; a < 2; ++a)
#pragma unroll
        for (int b = 0; b < 2; ++b)
#pragma unroll
            for (int m = 0; m < 4; ++m)
#pragma unroll
                for (int n = 0; n < 2; ++n) acc[a][b][m][n] = (f32x4){0.f, 0.f, 0.f, 0.f};
    bf16x8 At[4][2], B0[2][2], B1[2][2];
    const char* cA = (const char*)g.A + (size_t)cur.pm * tstep; const char* cB = (const char*)g.Bt + (size_t)cur.pn * tstep;
    S.a_ready(cur);
    if constexpr (SP2) {
        PG8_STAGE(PG8_SB(0, 0), cB, voffB); PG8_STAGE(PG8_SB(0, 1), cB + hstep, voffB); PG8_STAGE(PG8_SA(0, 0), cA, voffA); PG8_STAGE(PG8_SA(0, 1), cA + hstep, voffA);
        if (wr == 1) PG8_BAR;
        PG8_WAIT_V(2); PG8_BAR;
        PG8_STAGE(PG8_SB(1, 0), cB + kstep, voffB); PG8_STAGE(PG8_SA(1, 0), cA + kstep, voffA); PG8_STAGE(PG8_SB(1, 1), cB + hstep + kstep, voffB);
        PG8_WAIT_V(6); PG8_BAR;
    } else {
        PG8_STAGE(PG8_SB(0, 0), cB, voffB); PG8_STAGE(PG8_SA(0, 0), cA, voffA); PG8_STAGE(PG8_SB(0, 1), cB + hstep, voffB); PG8_STAGE(PG8_SA(0, 1), cA + hstep, voffA);
        if (wr == 1) PG8_BAR;
        PG8_WAIT_V(4); PG8_BAR;
        PG8_STAGE(PG8_SB(1, 0), cB + kstep, voffB); PG8_STAGE(PG8_SA(1, 0), cA + kstep, voffA); PG8_STAGE(PG8_SB(1, 1), cB + hstep + kstep, voffB);
        PG8_WAIT_V(6); PG8_BAR;
    }
    for (;;) {
        const bool has_next = S.next(ui + 1, nxt);
        const char* nA = has_next ? (const char*)g.A + (size_t)nxt.pm * tstep : cA; const char* nB = has_next ? (const char*)g.Bt + (size_t)nxt.pn * tstep : cB;
        for (int t = 0; t < nt; t += 2) {
            const bool last = (t == nt - 2);
            const char* a1 = cA + (size_t)(t + 1) * kstep;
            const char* a2 = last ? nA : cA + (size_t)(t + 2) * kstep; const char* b2 = last ? nB : cB + (size_t)(t + 2) * kstep;
            const char* a3 = a2 + kstep; const char* b3 = b2 + kstep;
            if (last && has_next) S.a_ready(nxt);
            if constexpr (SP2) {
            PG8_LDB(B0, 0, 0); PG8_LDB(B1, 0, 1); PG8_SCHED; PG8_LDA(At, 0, 0); PG8_STAGE(PG8_SA(1, 1), a1 + hstep, voffA);
            PG8_WAIT_V(8); PG8_WAIT_L(0); PG8_BAR; PG8_MMA(0, 0, At, B0); PG8_MMA(0, 1, At, B1); PG8_BAR; PG8_SCHED;
            PG8_LDA(At, 0, 1); PG8_STAGE(PG8_SB(0, 0), b2, voffB); PG8_STAGE(PG8_SB(0, 1), b2 + hstep, voffB); PG8_STAGE(PG8_SA(0, 0), a2, voffA);
            PG8_WAIT_V(8); PG8_WAIT_L(0); PG8_BAR; PG8_MMA(1, 0, At, B0); PG8_MMA(1, 1, At, B1); PG8_BAR; PG8_SCHED;
            PG8_LDB(B0, 1, 0); PG8_LDB(B1, 1, 1); PG8_SCHED; PG8_LDA(At, 1, 0); PG8_STAGE(PG8_SA(0, 1), a2 + hstep, voffA);
            PG8_WAIT_V(8); PG8_WAIT_L(0); PG8_BAR; PG8_MMA(0, 0, At, B0); PG8_MMA(0, 1, At, B1); PG8_BAR; PG8_SCHED;
            PG8_LDA(At, 1, 1); PG8_STAGE(PG8_SB(1, 0), b3, voffB); PG8_STAGE(PG8_SB(1, 1), b3 + hstep, voffB); PG8_STAGE(PG8_SA(1, 0), a3, voffA);
            PG8_WAIT_V(8); PG8_WAIT_L(0); PG8_BAR; PG8_MMA(1, 0, At, B0); PG8_MMA(1, 1, At, B1); PG8_BAR; PG8_SCHED;
            } else {
            PG8_LDB(B0, 0, 0); PG8_SCHED; PG8_LDA(At, 0, 0); PG8_STAGE(PG8_SA(1, 1), a1 + hstep, voffA);
            PG8_WAIT_L(8); PG8_BAR; PG8_WAIT_L(0); PG8_MMA(0, 0, At, B0); PG8_BAR; PG8_SCHED;
            PG8_LDB(B1, 0, 1); PG8_STAGE(PG8_SB(0, 0), b2, voffB);
            PG8_BAR; PG8_WAIT_L(0); PG8_MMA(0, 1, At, B1); PG8_BAR;
            PG8_LDA(At, 0, 1); PG8_STAGE(PG8_SA(0, 0), a2, voffA);
            PG8_BAR; PG8_WAIT_L(0); PG8_MMA(1, 0, At, B0); PG8_BAR; PG8_SCHED;
            PG8_STAGE(PG8_SB(0, 1), b2 + hstep, voffB);
            PG8_WAIT_V(6); PG8_BAR; PG8_MMA(1, 1, At, B1); PG8_BAR;
            PG8_LDB(B0, 1, 0); PG8_SCHED; PG8_LDA(At, 1, 0); PG8_STAGE(PG8_SA(0, 1), a2 + hstep, voffA);
            PG8_WAIT_L(8); PG8_BAR; PG8_WAIT_L(0); PG8_MMA(0, 0, At, B0); PG8_BAR; PG8_SCHED;
            PG8_LDB(B1, 1, 1); PG8_STAGE(PG8_SB(1, 0), b3, voffB);
            PG8_BAR; PG8_WAIT_L(0); PG8_MMA(0, 1, At, B1); PG8_BAR;
            PG8_LDA(At, 1, 1); PG8_STAGE(PG8_SA(1, 0), a3, voffA);
            PG8_BAR; PG8_WAIT_L(0); PG8_MMA(1, 0, At, B0); PG8_BAR; PG8_SCHED;
            PG8_STAGE(PG8_SB(1, 1), b3 + hstep, voffB);
            PG8_WAIT_V(6); PG8_BAR; PG8_MMA(1, 1, At, B1); PG8_BAR;
            }
        }
        if constexpr (ALIGN_EPI) { if (wr == 0) PG8_BAR; }
        if constexpr (!Epi::AFTER_DRAIN) { E(acc, cur, wr, wc, fr, fq); S.done(cur); }
        if (!has_next) break;
#pragma unroll
        for (int a = 0; a < 2; ++a)
#pragma unroll
            for (int b = 0; b < 2; ++b)
#pragma unroll
                for (int m = 0; m < 4; ++m)
#pragma unroll
                    for (int n = 0; n < 2; ++n) acc[a][b][m][n] = (f32x4){0.f, 0.f, 0.f, 0.f};
        cur = nxt; cA = nA; cB = nB; ++ui;
        if constexpr (ALIGN_EPI) { if (wr == 1) PG8_BAR; }
    }
    PG8_WAIT_V(0);
    if constexpr (!ALIGN_EPI) { if (wr == 0) PG8_BAR; }
    PG8_BAR;
    if constexpr (Epi::AFTER_DRAIN) { E.fused(acc, cur, wr, wc, fr, fq, lds, wid, lane); S.done(cur); }
#undef PG8_SA
#undef PG8_SB
#undef PG8_STAGE
#undef PG8_LDA
#undef PG8_LDB
#undef PG8_MMA
#undef PG8_WAIT_V
#undef PG8_WAIT_L
#undef PG8_BAR
#undef PG8_SCHED
}
}

#define LAS __attribute__((address_space(3)))
__device__ __forceinline__ unsigned pk2(float lo, float hi) { return (unsigned)f2bf(lo) | ((unsigned)f2bf(hi) << 16); }
__device__ __forceinline__ void transpose_item(const float* W, int K, int N, bf16_t* WT, float* scr, int item, int lane) {
    const int nblk = N / 32, kb = item / nblk, nbk = item % nblk, k0 = 64 * kb, n0 = 32 * nbk;
#pragma unroll 8
    for (int i = 0; i < 32; ++i) { const int kk = 2 * i + (lane >> 5); scr[kk * 33 + (lane & 31)] = W[(size_t)(k0 + kk) * N + n0 + (lane & 31)]; }
    asm volatile("s_waitcnt lgkmcnt(0)" ::: "memory");
    const int c = lane & 7;
#pragma unroll
    for (int j = 0; j < 4; ++j) { const int n = (lane >> 3) + 8 * j; const float* s = scr + (8 * c) * 33 + n;
        uint4 o; o.x = pk2(s[0 * 33], s[1 * 33]); o.y = pk2(s[2 * 33], s[3 * 33]); o.z = pk2(s[4 * 33], s[5 * 33]); o.w = pk2(s[6 * 33], s[7 * 33]);
        *(uint4*)(WT + (size_t)(n0 + n) * K + k0 + 8 * c) = o; }
    asm volatile("s_waitcnt lgkmcnt(0)" ::: "memory");
}
__device__ __forceinline__ void phase_convert_weights(KP p, float* lds, int bid, int nb) {
    const int tid = opaque_tid(), lane = tid & 63, wave = tid >> 6;
    float* scr = lds + wave * (64 * 33);
    const int gw = bid * 8 + wave, ngw = nb * 8;
    constexpr int I_IN = (D / 64) * (NPROJ / 32), I_SQ = (D / 64) * (D / 32), I_G = 8 * (128 / 64) * (128 / 32);
    constexpr int NITEMS = I_IN + 2 * I_SQ + 2 * I_G;
    for (int it = gw; it < NITEMS; it += ngw) {
        int r = it;
        if (r < I_IN) { transpose_item(p->in[I_WIN], D, NPROJ, (bf16_t*)(p->ws + WS_WIN_T), scr, r, lane); continue; } r -= I_IN;
        if (r < I_SQ) { transpose_item(p->in[I_WOUT], D, D, (bf16_t*)(p->ws + WS_WOUT_T), scr, r, lane); continue; } r -= I_SQ;
        if (r < I_SQ) { transpose_item(p->in[I_WQ], D, D, (bf16_t*)(p->ws + WS_WQ_T), scr, r, lane); continue; } r -= I_SQ;
        if (r < I_G) { const int hd = r / 8; transpose_item(p->in[I_WGA] + hd * 16384, 128, 128, (bf16_t*)(p->ws + WS_WGA_T) + hd * 16384, scr, r % 8, lane); continue; } r -= I_G;
        { const int hd = r / 8; transpose_item(p->in[I_WGI] + hd * 16384, 128, 128, (bf16_t*)(p->ws + WS_WGI_T) + hd * 16384, scr, r % 8, lane); }
    }
    bf16_t* wsp = (bf16_t*)(p->ws + WS_WSPB); bf16_t* skb = (bf16_t*)(p->ws + WS_SKEYB);
    for (int e = bid * NT + tid; e < 8 * 128 * 128; e += nb * NT) { const int i = (e >> 7) & 127, j = e & 127; wsp[e] = f2bf(j <= i ? p->in[I_WSP][e] : 0.f); }
    for (int e = bid * NT + tid; e < 8 * 2 * 128 * 128; e += nb * NT) skb[e] = f2bf(p->in[I_SKEY][e]);
}

typedef short bf16x8_t __attribute__((ext_vector_type(8)));
typedef float f32x4_t __attribute__((ext_vector_type(4)));
typedef short s16x4_t __attribute__((ext_vector_type(4)));
constexpr int XA_STRIDE = 272;
constexpr int LRU_XA = 0, LRU_SA = 34816, LRU_SB = LRU_SA + 16384, LRU_SEGP = LRU_SB + 16384, LRU_SEGH = LRU_SEGP + 2048;
__device__ __forceinline__ void phase_lru(KP p, unsigned char* lds, int bid, int nb) {
    const int tid = opaque_tid(), lane = tid & 63, wave = tid >> 6, c16 = lane & 15, q = lane >> 4;
    const bf16_t* XL = (const bf16_t*)(p->ws + WS_PROJ); const bf16_t* YG = XL + (size_t)M * 1024; bf16_t* ymix = (bf16_t*)(p->ws + WS_YMIX);
    float* SA = (float*)(lds + LRU_SA); float* SB = (float*)(lds + LRU_SB); float* SEGP = (float*)(lds + LRU_SEGP); float* SEGH = (float*)(lds + LRU_SEGH);
    for (int unit = bid; unit < NB * 8 * 4; unit += nb) {
        const int b = unit >> 5, hd = (unit >> 2) & 7, cq = unit & 3;
        bf16x8_t wf[2][2][4];
#pragma unroll
        for (int gs = 0; gs < 2; ++gs)
#pragma unroll
            for (int nt = 0; nt < 2; ++nt)
#pragma unroll
                for (int ks = 0; ks < 4; ++ks)
                    wf[gs][nt][ks] = *(const bf16x8_t*)((const bf16_t*)(p->ws + (gs ? WS_WGI_T : WS_WGA_T)) + ((size_t)(hd * 128 + cq * 32 + nt * 16 + c16) * 128 + ks * 32 + 8 * q));
        float ba[2], bi[2], c2[2];
#pragma unroll
        for (int nt = 0; nt < 2; ++nt) { const int ch = hd * 128 + cq * 32 + nt * 16 + c16; ba[nt] = p->in[I_BGA][ch]; bi[nt] = p->in[I_BGI][ch];
            const float lam = p->in[I_LAM][ch]; const float sp = fmaxf(-lam, 0.f) + log1pf(__expf(-fabsf(lam))); c2[nt] = -8.f * sp * 1.4426950408889634f; }
        const int o = tid & 15, rg = tid >> 4;
        float cw[4][8], cb[8];
#pragma unroll
        for (int e = 0; e < 8; ++e) { cb[e] = p->in[I_CONVB][hd * 128 + o * 8 + e];
#pragma unroll
            for (int k = 0; k < 4; ++k) cw[k][e] = p->in[I_CONVW][k * DLRU + hd * 128 + o * 8 + e]; }
        const int sc = tid & 31, seg = tid >> 5;
        float carry = 0.f;
        for (int ch = 0; ch < SEQ / 128; ++ch) {
            const int t0 = ch * 128; const size_t row0 = (size_t)b * SEQ + t0;
            bf16_t yg[8];
#pragma unroll
            for (int k = 0; k < 8; ++k) yg[k] = YG[(row0 + seg * 8 + k) * 1024 + hd * 128 + cq * 32 + sc];
            uint4 xr[7];
#pragma unroll
            for (int i = 0; i < 7; ++i) { const int t = t0 + 4 * rg - 3 + i;
                xr[i] = t >= 0 ? *(const uint4*)(XL + ((size_t)b * SEQ + t) * 1024 + hd * 128 + o * 8) : make_uint4(0u, 0u, 0u, 0u); }
#pragma unroll
            for (int r = 0; r < 4; ++r) {
                float acc8[8];
#pragma unroll
                for (int e = 0; e < 8; ++e) acc8[e] = cb[e];
#pragma unroll
                for (int k = 0; k < 4; ++k) { const uint4 w = xr[r + k]; const unsigned ww[4] = {w.x, w.y, w.z, w.w};
#pragma unroll
                    for (int e2 = 0; e2 < 4; ++e2) { acc8[2 * e2] += cw[k][2 * e2] * __uint_as_float(ww[e2] << 16); acc8[2 * e2 + 1] += cw[k][2 * e2 + 1] * __uint_as_float(ww[e2] & 0xffff0000u); } }
                uint4 ov; ov.x = pk2(acc8[0], acc8[1]); ov.y = pk2(acc8[2], acc8[3]); ov.z = pk2(acc8[4], acc8[5]); ov.w = pk2(acc8[6], acc8[7]);
                *(uint4*)(lds + LRU_XA + (4 * rg + r) * XA_STRIDE + o * 16) = ov;
            }
            __syncthreads();
            f32x4_t acc[2][2];
#pragma unroll
            for (int gs = 0; gs < 2; ++gs)
#pragma unroll
                for (int nt = 0; nt < 2; ++nt) acc[gs][nt] = (f32x4_t){0.f, 0.f, 0.f, 0.f};
#pragma unroll
            for (int ks = 0; ks < 4; ++ks) {
                const bf16x8_t a = *(const bf16x8_t*)(lds + LRU_XA + (16 * wave + c16) * XA_STRIDE + (ks * 32 + 8 * q) * 2);
#pragma unroll
                for (int gs = 0; gs < 2; ++gs)
#pragma unroll
                    for (int nt = 0; nt < 2; ++nt) acc[gs][nt] = __builtin_amdgcn_mfma_f32_16x16x32_bf16(a, wf[gs][nt][ks], acc[gs][nt], 0, 0, 0);
            }
#pragma unroll
            for (int nt = 0; nt < 2; ++nt)
#pragma unroll
                for (int reg = 0; reg < 4; ++reg) {
                    const int t = 16 * wave + 4 * q + reg, jj = nt * 16 + c16;
                    const float za = acc[0][nt][reg] + ba[nt], zi = acc[1][nt][reg] + bi[nt];
                    const float r = __builtin_amdgcn_rcpf(1.f + __expf(-za)), ig = __builtin_amdgcn_rcpf(1.f + __expf(-zi));
                    const float a = __builtin_amdgcn_exp2f(c2[nt] * r);
                    const float xcv = bf2f(*(const bf16_t*)(lds + LRU_XA + t * XA_STRIDE + (cq * 32 + jj) * 2));
                    SA[t * 32 + jj] = a; SB[t * 32 + jj] = __builtin_amdgcn_sqrtf(fmaxf(1.f - a * a, 0.f)) * (ig * xcv);
                }
            __syncthreads();
            float av[8], bv[8];
#pragma unroll
            for (int k = 0; k < 8; ++k) { av[k] = SA[(seg * 8 + k) * 32 + sc]; bv[k] = SB[(seg * 8 + k) * 32 + sc]; }
            float P = 1.f, H = 0.f;
#pragma unroll
            for (int k = 0; k < 8; ++k) { H = av[k] * H + bv[k]; P *= av[k]; }
            SEGP[seg * 32 + sc] = P; SEGH[seg * 32 + sc] = H;
            __syncthreads();
            float run = carry, hin = carry;
#pragma unroll
            for (int s = 0; s < 16; ++s) { if (s == seg) hin = run; run = SEGP[s * 32 + sc] * run + SEGH[s * 32 + sc]; }
            carry = run;
            H = hin;
#pragma unroll
            for (int k = 0; k < 8; ++k) { H = av[k] * H + bv[k]; ymix[(row0 + seg * 8 + k) * D + hd * 128 + cq * 32 + sc] = f2bf(H * bf2f(yg[k])); }
        }
        __syncthreads();
    }
}

constexpr int SGU_RS = 0, SGU_TV = 512, SGU_SS = SGU_TV + 128 * XA_STRIDE, SS_STRIDE = 132;
__device__ __forceinline__ void phase_sgu(KP p, unsigned char* lds, int bid, int nb) {
    const int tid = opaque_tid(), lane = tid & 63, wave = tid >> 6, c16 = lane & 15, q = lane >> 4;
    const bf16_t* UG = (const bf16_t*)(p->ws + WS_PROJ) + (size_t)2 * M * 1024; const bf16_t* VG = UG + (size_t)M * 1024;
    const float* ssqv = (const float*)(p->ws + WS_SSQV); bf16_t* ymix = (bf16_t*)(p->ws + WS_YMIX);
    float* RS = (float*)(lds + SGU_RS); float* SS = (float*)(lds + SGU_SS);
    bf16x8_t wa[8][4]; float gvv[8]; int gcur = -1;
    const int oct = tid & 15;
    for (int it = bid; it < NB * 16 * 8; it += nb) {
        const int g = it & 7; const size_t base = (size_t)(it >> 3) * 128;
        if (g != gcur) { gcur = g;
#pragma unroll
            for (int mt = 0; mt < 8; ++mt)
#pragma unroll
                for (int ks = 0; ks < 4; ++ks) if (ks <= ((16 * mt + 15) >> 5))
                    wa[mt][ks] = *(const bf16x8_t*)((const bf16_t*)(p->ws + WS_WSPB) + ((size_t)(g * 128 + mt * 16 + c16) * 128 + ks * 32 + 8 * q));
#pragma unroll
            for (int e = 0; e < 8; ++e) gvv[e] = p->in[I_GV][g * 128 + oct * 8 + e]; }
        uint4 vch[4], uch[4];
#pragma unroll
        for (int k = 0; k < 4; ++k) { const int row = (tid >> 4) + 32 * k; vch[k] = *(const uint4*)(VG + (base + row) * 1024 + g * 128 + oct * 8); uch[k] = *(const uint4*)(UG + (base + row) * 1024 + g * 128 + oct * 8); }
        if (tid < 128) { float ss = 0.f;
#pragma unroll
            for (int k = 0; k < 16; ++k) ss += ssqv[(base + tid) * 16 + k];
            RS[tid] = rsqrtf(ss * (1.f / 1024.f) + EPS); }
        __syncthreads();
#pragma unroll
        for (int k = 0; k < 4; ++k) { const int row = (tid >> 4) + 32 * k; const float r = RS[row]; const unsigned ww[4] = {vch[k].x, vch[k].y, vch[k].z, vch[k].w}; unsigned oo[4];
#pragma unroll
            for (int e2 = 0; e2 < 4; ++e2) oo[e2] = pk2(__uint_as_float(ww[e2] << 16) * r * gvv[2 * e2], __uint_as_float(ww[e2] & 0xffff0000u) * r * gvv[2 * e2 + 1]);
            *(uint4*)(lds + SGU_TV + row * XA_STRIDE + oct * 16) = make_uint4(oo[0], oo[1], oo[2], oo[3]); }
        __syncthreads();
        bf16x8_t bfr[4];
        { const int q4 = c16 >> 2, p4 = c16 & 3;
#pragma unroll
          for (int ks = 0; ks < 4; ++ks) {
              const unsigned a1 = SGU_TV + (ks * 32 + 8 * q + q4) * XA_STRIDE + (wave * 16 + 4 * p4) * 2;
              const s16x4_t lo = __builtin_amdgcn_ds_read_tr16_b64_v4i16((LAS s16x4_t*)(lds + a1));
              const s16x4_t hi = __builtin_amdgcn_ds_read_tr16_b64_v4i16((LAS s16x4_t*)(lds + a1 + 4 * XA_STRIDE));
              bfr[ks] = __builtin_shufflevector(lo, hi, 0, 1, 2, 3, 4, 5, 6, 7); } }
        f32x4_t acc[8];
#pragma unroll
        for (int mt = 0; mt < 8; ++mt) { acc[mt] = (f32x4_t){0.f, 0.f, 0.f, 0.f};
#pragma unroll
            for (int ks = 0; ks < 4; ++ks) if (ks <= ((16 * mt + 15) >> 5)) acc[mt] = __builtin_amdgcn_mfma_f32_16x16x32_bf16(wa[mt][ks], bfr[ks], acc[mt], 0, 0, 0); }
#pragma unroll
        for (int mt = 0; mt < 8; ++mt)
#pragma unroll
            for (int reg = 0; reg < 4; ++reg) { const int i = mt * 16 + 4 * q + reg; SS[i * SS_STRIDE + wave * 16 + c16] = acc[mt][reg] + p->in[I_BSP][g * 128 + i]; }
        __syncthreads();
#pragma unroll
        for (int k = 0; k < 4; ++k) { const int row = (tid >> 4) + 32 * k; const float4 s0 = *(const float4*)(SS + row * SS_STRIDE + oct * 8), s1 = *(const float4*)(SS + row * SS_STRIDE + oct * 8 + 4);
            const unsigned ww[4] = {uch[k].x, uch[k].y, uch[k].z, uch[k].w}; const float sv[8] = {s0.x, s0.y, s0.z, s0.w, s1.x, s1.y, s1.z, s1.w}; unsigned oo[4];
#pragma unroll
            for (int e2 = 0; e2 < 4; ++e2) oo[e2] = pk2(__uint_as_float(ww[e2] << 16) * sv[2 * e2], __uint_as_float(ww[e2] & 0xffff0000u) * sv[2 * e2 + 1]);
            *(uint4*)(ymix + (base + row) * D + 1024 + g * 128 + oct * 8) = make_uint4(oo[0], oo[1], oo[2], oo[3]); }
        __syncthreads();
    }
}

typedef float f32x16_t __attribute__((ext_vector_type(16)));
__device__ __forceinline__ float vmaxf(float a, float b) { float r; asm("v_max_f32 %0, %1, %2" : "=v"(r) : "v"(a), "v"(b)); return r; }
__device__ __forceinline__ float vminf(float a, float b) { float r; asm("v_min_f32 %0, %1, %2" : "=v"(r) : "v"(a), "v"(b)); return r; }
#define CE_DESC(a, b) do { const float _mx = vmaxf(a, b), _mn = vminf(a, b); a = _mx; b = _mn; } while (0)
__device__ __forceinline__ void sort16_desc(float (&v)[16]) {
#pragma unroll
    for (int k = 2; k <= 16; k <<= 1)
#pragma unroll
        for (int j = k >> 1; j > 0; j >>= 1)
#pragma unroll
            for (int i = 0; i < 16; ++i) { const int l = i ^ j; if (l > i) { if ((i & k) == 0) CE_DESC(v[i], v[l]); else CE_DESC(v[l], v[i]); } }
}
__device__ __forceinline__ void merge16_desc(float (&a)[16], const float (&b)[16]) {
#pragma unroll
    for (int i = 0; i < 16; ++i) a[i] = vmaxf(a[i], b[15 - i]);
#pragma unroll
    for (int j = 8; j > 0; j >>= 1)
#pragma unroll
        for (int i = 0; i < 16; ++i) { const int l = i ^ j; if (l > i) CE_DESC(a[i], a[l]); }
}
__device__ __forceinline__ void topk_half(const bf16_t* qp, const unsigned char* kl, unsigned hh4, float (&X)[16]) {
    f32x16_t acc[4];
#pragma unroll
    for (int kt = 0; kt < 4; ++kt)
#pragma unroll
        for (int i = 0; i < 16; ++i) acc[kt][i] = 0.f;
#pragma unroll
    for (int ks = 0; ks < 8; ++ks) {
        const bf16x8_t bq = *(const bf16x8_t*)(qp + ks * 16);
#pragma unroll
        for (int kt = 0; kt < 4; ++kt) { const bf16x8_t ak = *(const bf16x8_t*)(kl + kt * 32 * XA_STRIDE + ks * 32); acc[kt] = __builtin_amdgcn_mfma_f32_32x32x16_bf16(ak, bq, acc[kt], 0, 0, 0); }
    }
    float g[4][16];
#pragma unroll
    for (int kt = 0; kt < 4; ++kt)
#pragma unroll
        for (int reg = 0; reg < 16; ++reg) g[kt][reg] = __uint_as_float(((__float_as_uint(acc[kt][reg]) & 0xFFFFFF80u) | hh4) | (unsigned)(kt * 32 + (reg & 3) + 8 * (reg >> 2)));
    sort16_desc(g[0]); sort16_desc(g[1]); sort16_desc(g[2]); sort16_desc(g[3]);
    merge16_desc(g[0], g[1]); merge16_desc(g[2], g[3]); merge16_desc(g[0], g[2]);
#pragma unroll
    for (int i = 0; i < 16; ++i) X[i] = g[0][i];
}
__device__ __forceinline__ unsigned pack_b0(float a, float b, float c, float d) {
    const unsigned ab = __builtin_amdgcn_perm(__float_as_uint(b), __float_as_uint(a), 0x0c0c0400u), cd = __builtin_amdgcn_perm(__float_as_uint(d), __float_as_uint(c), 0x0c0c0400u);
    return __builtin_amdgcn_perm(cd, ab, 0x05040100u);
}
__device__ __forceinline__ unsigned byte_lookup(const unsigned (&pk)[4], unsigned e) {
    const unsigned lo = __builtin_amdgcn_perm(pk[1], pk[0], e & 7u), hi = __builtin_amdgcn_perm(pk[3], pk[2], e & 7u);
    return ((e & 8u) ? hi : lo) & 0x7Fu;
}
__device__ __forceinline__ void phase_topk(KP p, unsigned char* lds, int bid, int nb) {
    const int tid = opaque_tid(), lane = tid & 63, wave = tid >> 6, r32 = lane & 31, hh = lane >> 5;
    const bf16_t* Q = (const bf16_t*)(p->ws + WS_Q); const bf16_t* KB = (const bf16_t*)(p->ws + WS_SKEYB);
    int* idx = (int*)(p->ws + WS_IDX); float* gate = (float*)(p->ws + WS_GATE);
    const float NEG = -3.0e38f;
    int hcur = -1;
    for (int bi = bid; bi < NHEAD * (M / 256); bi += nb) {
        const int hd = bi & 7, tile = (bi >> 3) * 8 + wave; const size_t token = (size_t)tile * 32 + r32;
        if (hd != hcur) { hcur = hd; __syncthreads();
#pragma unroll
            for (int k = 0; k < 8; ++k) { const int c = tid + NT * k, row = c >> 4, o = c & 15;
                *(uint4*)(lds + row * XA_STRIDE + o * 16) = *(const uint4*)(KB + ((size_t)hd * 256 + row) * 128 + o * 8); }
            __syncthreads(); }
        float X0[16], X1[16];
        topk_half(Q + token * D + hd * 256 + 8 * hh, lds + r32 * XA_STRIDE + hh * 16, 4u * hh, X0);
        __builtin_amdgcn_sched_barrier(0);
        topk_half(Q + token * D + hd * 256 + 128 + 8 * hh, lds + (128 + r32) * XA_STRIDE + hh * 16, 4u * hh, X1);
        __builtin_amdgcn_sched_barrier(0);
#pragma unroll
        for (int i = 0; i < 16; ++i) { const auto r = __builtin_amdgcn_permlane32_swap(__float_as_uint(X0[i]), __float_as_uint(X1[i]), false, false); X0[i] = __uint_as_float(r[0]); X1[i] = __uint_as_float(r[1]); }
        merge16_desc(X0, X1);
        float U[16];
#pragma unroll
        for (int i = 0; i < 16; ++i) U[i] = __shfl_xor(X0[i], 32);
        const unsigned hbit = (unsigned)hh << 8;
        float c0[16], c1[16];
#pragma unroll
        for (int j = 0; j < 16; ++j) { float s = X0[0] + U[j]; if (j == 0) s = hh ? NEG : s; c0[j] = __uint_as_float(((__float_as_uint(s) & 0xFFFFFE00u) | hbit) | (unsigned)j); }
        {
            int n = 0;
#pragma unroll
            for (int i = 1; i < 4; ++i)
#pragma unroll
                for (int j = i; j < 16; ++j) if ((i + 1) * (j + 1) <= 16) { float s = X0[i] + U[j]; if (j == i) s = hh ? NEG : s; c1[n] = __uint_as_float(((__float_as_uint(s) & 0xFFFFFE00u) | hbit) | (unsigned)(i * 16 + j)); ++n; }
#pragma unroll
            for (int k = 11; k < 16; ++k) c1[k] = NEG;
        }
        sort16_desc(c0); sort16_desc(c1); merge16_desc(c0, c1);
        float F[16];
#pragma unroll
        for (int i = 0; i < 16; ++i) F[i] = vmaxf(c0[i], __shfl_xor(c0[15 - i], 32));
        float mx = F[0];
#pragma unroll
        for (int i = 1; i < 16; ++i) mx = vmaxf(mx, F[i]);
        float ev[16], sum = 0.f;
#pragma unroll
        for (int i = 0; i < 16; ++i) { ev[i] = __expf(F[i] - mx); sum += ev[i]; }
        const float inv = 1.f / sum;
        unsigned pt[4], pu[4], pa[4], pb[4];
#pragma unroll
        for (int w = 0; w < 4; ++w) { pt[w] = pack_b0(X0[4 * w], X0[4 * w + 1], X0[4 * w + 2], X0[4 * w + 3]); pu[w] = pack_b0(U[4 * w], U[4 * w + 1], U[4 * w + 2], U[4 * w + 3]); }
#pragma unroll
        for (int w = 0; w < 4; ++w) { pa[w] = hh ? pu[w] : pt[w]; pb[w] = hh ? pt[w] : pu[w]; }
        int oi[8]; float og[8];
#pragma unroll
        for (int k = 0; k < 8; ++k) {
            const unsigned pl = __float_as_uint(F[k]) & 0x1FFu, sw = pl >> 8, pi = (pl >> 4) & 15u, pj = pl & 15u;
            const unsigned ai = sw ? pj : pi, bj = sw ? pi : pj;
            oi[k] = (int)(byte_lookup(pa, ai) * NKEYS + byte_lookup(pb, bj)); og[k] = ev[k] * inv;
        }
        int* io = idx + token * NSEL + hd * TOPK + 8 * hh; float* go = gate + token * NSEL + hd * TOPK + 8 * hh;
        *(int4*)io = make_int4(oi[0], oi[1], oi[2], oi[3]); *(int4*)(io + 4) = make_int4(oi[4], oi[5], oi[6], oi[7]);
        *(float4*)go = make_float4(og[0], og[1], og[2], og[3]); *(float4*)(go + 4) = make_float4(og[4], og[5], og[6], og[7]);
    }
}

__device__ __forceinline__ void wave_argmax(float& v, int& i) {
#pragma unroll
    for (int off = 32; off >= 1; off >>= 1) { const float ov = __shfl_xor(v, off); const int oi = __shfl_xor(i, off); if (ov > v || (ov == v && oi < i)) { v = ov; i = oi; } }
}
__device__ __forceinline__ void topk_half_naive(const bf16_t* q, const float* k0, int lane, float& outv, int& outi) {
    const float NEG = -3.0e38f;
    const float* k1 = k0 + 64 * 128;
    float s0 = 0.f, s1 = 0.f;
    for (int k = 0; k < 128; k += 4) {
        const uint2 qq = *(const uint2*)(q + k);
        const float q0 = bf2f((bf16_t)(qq.x & 0xffff)), q1 = bf2f((bf16_t)(qq.x >> 16)), q2 = bf2f((bf16_t)(qq.y & 0xffff)), q3 = bf2f((bf16_t)(qq.y >> 16));
        const float4 a = *(const float4*)(k0 + k), b = *(const float4*)(k1 + k);
        s0 += q0 * a.x + q1 * a.y + q2 * a.z + q3 * a.w; s1 += q0 * b.x + q1 * b.y + q2 * b.z + q3 * b.w;
    }
    float myv = NEG; int myi = 0;
    for (int r = 0; r < TOPK; ++r) {
        float v; int i; if (s0 >= s1) { v = s0; i = lane; } else { v = s1; i = lane + 64; }
        wave_argmax(v, i);
        if (i == lane) s0 = NEG; if (i == lane + 64) s1 = NEG;
        if (lane == r) { myv = v; myi = i; }
    }
    outv = myv; outi = myi;
}
__device__ __forceinline__ void phase_topk_naive(KP p, int bid, int nb) {
    const bf16_t* Q = (const bf16_t*)(p->ws + WS_Q); const float* keys = p->in[I_SKEY];
    int* idx = (int*)(p->ws + WS_IDX); float* gate = (float*)(p->ws + WS_GATE);
    const int tid = opaque_tid(), lane = tid & 63, wave = tid >> 6;
    const float NEG = -3.0e38f;
    for (int task = bid * 8 + wave; task < M * NHEAD; task += nb * 8) {
        const int token = task >> 3, hd = task & 7;
        float tv0, tv1; int ti0, ti1;
        topk_half_naive(Q + (size_t)token * D + hd * 256, keys + ((size_t)(hd * 2) * 128 + lane) * 128, lane, tv0, ti0);
        topk_half_naive(Q + (size_t)token * D + hd * 256 + 128, keys + ((size_t)(hd * 2 + 1) * 128 + lane) * 128, lane, tv1, ti1);
        const float vb = __shfl(tv1, lane & 15);
        float c0 = __shfl(tv0, (lane >> 4)) + vb, c1 = __shfl(tv0, (lane >> 4) + 4) + vb, c2 = __shfl(tv0, (lane >> 4) + 8) + vb, c3 = __shfl(tv0, (lane >> 4) + 12) + vb;
        float selv = NEG; int selc = 0;
        for (int r = 0; r < TOPK; ++r) {
            float v = c0; int i = lane;
            if (c1 > v) { v = c1; i = lane + 64; }
            if (c2 > v) { v = c2; i = lane + 128; }
            if (c3 > v) { v = c3; i = lane + 192; }
            wave_argmax(v, i);
            if (i == lane) c0 = NEG; if (i == lane + 64) c1 = NEG; if (i == lane + 128) c2 = NEG; if (i == lane + 192) c3 = NEG;
            if (lane == r) { selv = v; selc = i; }
        }
        const float mx = __shfl(selv, 0);
        const float e = lane < TOPK ? __expf(selv - mx) : 0.f;
        const float sum = wave_sum(e);
        const int i1 = __shfl(ti0, selc >> 4), i2 = __shfl(ti1, selc & 15);
        if (lane < TOPK) { idx[(size_t)token * NSEL + hd * TOPK + lane] = i1 * NKEYS + i2; gate[(size_t)token * NSEL + hd * TOPK + lane] = e / sum; }
    }
}

typedef float f32x2_t __attribute__((ext_vector_type(2)));
constexpr size_t GRP_BYTES = (size_t)NKEYS * NKEYS * 128;
constexpr int NGRP = D / 128;
__device__ __forceinline__ float wave_max(float v) {
#pragma unroll
    for (int o = 1; o < 64; o <<= 1) v = fmaxf(v, __shfl_xor(v, o));
    return v;
}
__device__ __forceinline__ void phase_convert_experts(KP p, int bid, int nb) {
    const int tid = opaque_tid(), lane = tid & 63, wave = tid >> 6;
    for (int row = bid * 8 + wave; row < 2 * NKEYS * NKEYS; row += nb * 8) {
        const int t = row >= NKEYS * NKEYS, e = row - t * NKEYS * NKEYS;
        const float* src = (t ? p->in[I_EV] : p->in[I_EU]) + (size_t)e * D;
        unsigned char* dst = p->ws + (t ? WS_EV8 : WS_EU8) + (size_t)e * 128 + (size_t)(lane >> 5) * GRP_BYTES + (lane & 31) * 4;
        float4 v[8]; float am = 0.f;
#pragma unroll
        for (int j = 0; j < 8; ++j) { v[j] = *(const float4*)(src + lane * 4 + 256 * j); am = fmaxf(am, fmaxf(fmaxf(fabsf(v[j].x), fabsf(v[j].y)), fmaxf(fabsf(v[j].z), fabsf(v[j].w)))); }
        am = wave_max(am);
        int ex = 0; if (am > 0.f) (void)frexpf(am, &ex); else ex = 8;
        const float sc = ldexpf(1.f, 8 - ex);
#pragma unroll
        for (int j = 0; j < 8; ++j) { int w = __builtin_amdgcn_cvt_pk_fp8_f32(v[j].x * sc, v[j].y * sc, 0, false); w = __builtin_amdgcn_cvt_pk_fp8_f32(v[j].z * sc, v[j].w * sc, w, true); *(unsigned*)(dst + (size_t)(2 * j) * GRP_BYTES) = (unsigned)w; }
        if (lane == 0) ((float*)(p->ws + WS_ESCALE))[row] = ldexpf(1.f, ex - 8);
    }
}
__device__ __forceinline__ unsigned xb_xcc_id();
constexpr int PEER_TT = 16;
constexpr int PEER_NTILE = M / PEER_TT;
constexpr int CW_UQ = 4096, CW_VQ = 8192;
__device__ __forceinline__ float dpp_xor1(float v) { return __builtin_bit_cast(float, __builtin_amdgcn_update_dpp(0, __builtin_bit_cast(int, v), 0xB1, 0xF, 0xF, true)); }
__device__ __forceinline__ float dpp_xor2(float v) { return __builtin_bit_cast(float, __builtin_amdgcn_update_dpp(0, __builtin_bit_cast(int, v), 0x4E, 0xF, 0xF, true)); }
__device__ __forceinline__ float dpp_hmirror(float v) { return __builtin_bit_cast(float, __builtin_amdgcn_update_dpp(0, __builtin_bit_cast(int, v), 0x141, 0xF, 0xF, true)); }
__device__ __forceinline__ void pg_load_ids(const int* idx, size_t token, int k, unsigned c16, unsigned (&off)[16]) {
#pragma unroll
    for (int i = 0; i < 4; ++i) { const int4 v = *(const int4*)(idx + token * NSEL + 16 * k + 4 * i); off[4 * i] = ((unsigned)v.x << 7) + c16; off[4 * i + 1] = ((unsigned)v.y << 7) + c16; off[4 * i + 2] = ((unsigned)v.z << 7) + c16; off[4 * i + 3] = ((unsigned)v.w << 7) + c16; }
}
__device__ __forceinline__ void pg_load_lines(const unsigned char* tg, const unsigned (&off)[16], uint4 (&r)[16]) {
#pragma unroll
    for (int j = 0; j < 16; ++j) r[j] = *(const uint4*)(tg + off[j]);
}
__device__ __forceinline__ void pg_compute_u(const uint4 (&r)[16], const uint4 (&hw)[2], float* po, int c) {
    f32x2_t hv[8];
#pragma unroll
    for (int hq = 0; hq < 2; ++hq) { const unsigned ww[4] = {hw[hq].x, hw[hq].y, hw[hq].z, hw[hq].w};
#pragma unroll
        for (int cc = 0; cc < 4; ++cc) hv[4 * hq + cc] = (f32x2_t){__uint_as_float(ww[cc] << 16), __uint_as_float(ww[cc] & 0xffff0000u)}; }
    float d[16];
#pragma unroll
    for (int j = 0; j < 16; ++j) { const unsigned ww[4] = {r[j].x, r[j].y, r[j].z, r[j].w}; f32x2_t d2 = {0.f, 0.f};
#pragma unroll
        for (int cc = 0; cc < 4; ++cc) { d2 = __builtin_elementwise_fma(__builtin_amdgcn_cvt_pk_f32_fp8(ww[cc], false), hv[2 * cc], d2); d2 = __builtin_elementwise_fma(__builtin_amdgcn_cvt_pk_f32_fp8(ww[cc], true), hv[2 * cc + 1], d2); }
        d[j] = d2.x + d2.y; }
#pragma unroll
    for (int j = 0; j < 16; ++j) d[j] += dpp_xor1(d[j]);
#pragma unroll
    for (int j = 0; j < 16; ++j) d[j] += dpp_xor2(d[j]);
#pragma unroll
    for (int j = 0; j < 16; ++j) d[j] += dpp_hmirror(d[j]);
    float p0 = 0.f, p1 = 0.f;
#pragma unroll
    for (int j = 0; j < 8; ++j) { p0 = (c == j) ? d[j] : p0; p1 = (c == j) ? d[j + 8] : p1; }
    po[0] = p0; po[8] = p1;
}
__device__ __forceinline__ void pg_compute_v(const uint4 (&r)[16], const f32x4_t (&aw)[4], float* xo, const float* gtp, float* ssp, int k, int lane) {
    f32x2_t acc[8];
#pragma unroll
    for (int m = 0; m < 8; ++m) acc[m] = (f32x2_t){0.f, 0.f};
#pragma unroll
    for (int j = 0; j < 16; ++j) { const unsigned ww[4] = {r[j].x, r[j].y, r[j].z, r[j].w}; const float aj = aw[j >> 2][j & 3]; const f32x2_t a2 = {aj, aj};
#pragma unroll
        for (int cc = 0; cc < 4; ++cc) { acc[2 * cc] = __builtin_elementwise_fma(__builtin_amdgcn_cvt_pk_f32_fp8(ww[cc], false), a2, acc[2 * cc]); acc[2 * cc + 1] = __builtin_elementwise_fma(__builtin_amdgcn_cvt_pk_f32_fp8(ww[cc], true), a2, acc[2 * cc + 1]); } }
    f32x2_t b4[4];
#pragma unroll
    for (int m = 0; m < 4; ++m) { const f32x2_t keep = (k & 1) ? acc[4 + m] : acc[m], send = (k & 1) ? acc[m] : acc[4 + m]; b4[m].x = keep.x + __shfl_xor(send.x, 8); b4[m].y = keep.y + __shfl_xor(send.y, 8); }
    f32x2_t b2[2];
#pragma unroll
    for (int m = 0; m < 2; ++m) { const f32x2_t keep = (k & 2) ? b4[2 + m] : b4[m], send = (k & 2) ? b4[m] : b4[2 + m]; b2[m].x = keep.x + __shfl_xor(send.x, 16); b2[m].y = keep.y + __shfl_xor(send.y, 16); }
    f32x2_t o2; { const f32x2_t keep = (k & 4) ? b2[1] : b2[0], send = (k & 4) ? b2[0] : b2[1]; o2.x = keep.x + __shfl_xor(send.x, 32); o2.y = keep.y + __shfl_xor(send.y, 32); }
    const float2 x1 = *(const float2*)xo; const float2 gt = *(const float2*)gtp;
    const float y0 = x1.x + gt.x * o2.x, y1 = x1.y + gt.y * o2.y;
    *(float2*)xo = make_float2(y0, y1);
    const float ss = wave_sum(y0 * y0 + y1 * y1);
    if (lane == 0) *ssp = ss;
}
template <bool VPASS>
__device__ __forceinline__ void phase_peer_gather(KP p, float* lds, int bid, int nb) {
    const int tid = opaque_tid(), lane = tid & 63, k = lane >> 3, c = lane & 7;
    const bf16_t* H = (const bf16_t*)(p->ws + WS_H); const int* idx = (const int*)(p->ws + WS_IDX);
    const unsigned char* TAB = p->ws + (VPASS ? WS_EV8 : WS_EU8);
    float* pdot = (float*)(p->ws + WS_PDOT); const float* act = (const float*)(p->ws + WS_ACT); float* ssq2 = (float*)(p->ws + WS_SSQ2);
    unsigned* ctr = (unsigned*)(p->ws + WS_CTL) + (VPASS ? CW_VQ : CW_UQ);
    if (VPASS) { for (int i = tid; i < NB * D; i += NT) lds[i] = mod_at(p, i >> 11, 5 * D + (i & (D - 1))); __syncthreads(); }
    const unsigned slot0 = xb_xcc_id() & 7u, c16 = 16u * (unsigned)c;
    const int vcol = 16 * c + 8 * (k & 1) + 4 * ((k >> 1) & 1) + 2 * (k >> 2);
    for (int sl = 0; sl < 8; ++sl) {
        const int slot = (int)((slot0 + sl) & 7u);
        for (;;) {
            unsigned q = 0; if (lane == 0) q = __hip_atomic_fetch_add(ctr + 64 * slot, 1u, __ATOMIC_RELAXED, __HIP_MEMORY_SCOPE_AGENT);
            q = (unsigned)__builtin_amdgcn_readfirstlane((int)q);
            if (q >= 2u * PEER_NTILE) break;
            const int g = slot * 2 + (int)(q / PEER_NTILE), tile = (int)(q % PEER_NTILE);
            const unsigned char* tg = TAB + (size_t)g * GRP_BYTES;
            const size_t tok0 = (size_t)tile * PEER_TT;
            unsigned oA[16], oB[16]; uint4 rA[16], rB[16]; uint4 hA[2], hB[2]; f32x4_t aA[4], aB[4];
#define PG_AUX(tok, hX, aX) do { if (!VPASS) { hX[0] = *(const uint4*)(H + (tok) * D + g * 128 + 16 * c); hX[1] = *(const uint4*)(H + (tok) * D + g * 128 + 16 * c + 8); } \
            else { _Pragma("unroll") for (int i_ = 0; i_ < 4; ++i_) aX[i_] = *(const f32x4_t*)(act + (tok) * NSEL + 16 * k + 4 * i_); } } while (0)
#define PG_COMPUTE(tok, rX, hX, aX) do { if (!VPASS) pg_compute_u(rX, hX, pdot + ((size_t)g * M + (tok)) * NSEL + 16 * k + c, c); \
            else pg_compute_v(rX, aX, p->out + (tok) * D + g * 128 + vcol, lds + ((tok) / SEQ) * D + g * 128 + vcol, ssq2 + (size_t)g * M + (tok), k, lane); } while (0)
            pg_load_ids(idx, tok0, k, c16, oA); pg_load_lines(tg, oA, rA); PG_AUX(tok0, hA, aA); pg_load_ids(idx, tok0 + 1, k, c16, oB);
            for (int tt = 0; tt < PEER_TT; tt += 2) {
                pg_load_lines(tg, oB, rB); PG_AUX(tok0 + tt + 1, hB, aB);
                if (tt + 2 < PEER_TT) pg_load_ids(idx, tok0 + tt + 2, k, c16, oA);
                PG_COMPUTE(tok0 + tt, rA, hA, aA);
                if (tt + 2 < PEER_TT) { pg_load_lines(tg, oA, rA); PG_AUX(tok0 + tt + 2, hA, aA); pg_load_ids(idx, tok0 + tt + 3, k, c16, oB); }
                PG_COMPUTE(tok0 + tt + 1, rB, hB, aB);
            }
#undef PG_AUX
#undef PG_COMPUTE
        }
    }
}
__device__ __forceinline__ void phase_peer_act(KP p, int bid, int nb) {
    const int tid = opaque_tid(), lane = tid & 63, wave = tid >> 6;
    const int* idx = (const int*)(p->ws + WS_IDX); const float* gate = (const float*)(p->ws + WS_GATE); const float* esc = (const float*)(p->ws + WS_ESCALE);
    const float* pdot = (const float*)(p->ws + WS_PDOT); float* act = (float*)(p->ws + WS_ACT);
    for (int token = bid * 8 + wave; token < M; token += nb * 8) {
        float d0 = 0.f, d1 = 0.f;
#pragma unroll
        for (int g = 0; g < NGRP; ++g) { d0 += pdot[((size_t)g * M + token) * NSEL + lane]; d1 += pdot[((size_t)g * M + token) * NSEL + 64 + lane]; }
        const int e0 = idx[(size_t)token * NSEL + lane], e1 = idx[(size_t)token * NSEL + 64 + lane];
        act[(size_t)token * NSEL + lane] = gelu_t(d0 * esc[e0]) * gate[(size_t)token * NSEL + lane] * esc[NKEYS * NKEYS + e0];
        act[(size_t)token * NSEL + 64 + lane] = gelu_t(d1 * esc[e1]) * gate[(size_t)token * NSEL + 64 + lane] * esc[NKEYS * NKEYS + e1];
    }
}
__device__ __forceinline__ void phase_final_norm(KP p, int bid, int nb) {
    const int tid = opaque_tid(), lane = tid & 63, wave = tid >> 6;
    const float* ssq2 = (const float*)(p->ws + WS_SSQ2); const float* gf = p->in[I_GFIN];
    for (int token = bid * 8 + wave; token < M; token += nb * 8) {
        float ss = 0.f;
#pragma unroll
        for (int g = 0; g < NGRP; ++g) ss += ssq2[(size_t)g * M + token];
        const float rstd = rsqrtf(ss * (1.f / D) + EPS);
        float* row = p->out + (size_t)token * D;
#pragma unroll
        for (int j = 0; j < 8; ++j) { const int col = lane * 4 + 256 * j; const float4 v = *(const float4*)(row + col); const float4 g4 = *(const float4*)(gf + col);
            *(float4*)(row + col) = make_float4(v.x * rstd * g4.x, v.y * rstd * g4.y, v.z * rstd * g4.z, v.w * rstd * g4.w); }
    }
}

#define XB_TMO      128
#define XB_XCNT(j)  (256  + 64 * (j))
#define XB_XSUB(j)  (1280 + 64 * (j))
#define XB_XGEN(j)  (2304 + 64 * (j))
#define XB_TOP      3328
#define XB_TOPGEN   3392
#define XCD_BAR_WORDS 3456
#define XB_SPIN_CAP (1u << 18)

__device__ __forceinline__ unsigned xb_ld(unsigned* p)              { return __hip_atomic_load(p, __ATOMIC_RELAXED, __HIP_MEMORY_SCOPE_AGENT); }
__device__ __forceinline__ unsigned xb_add(unsigned* p, unsigned v) { return __hip_atomic_fetch_add(p, v, __ATOMIC_RELAXED, __HIP_MEMORY_SCOPE_AGENT); }
__device__ __forceinline__ unsigned xb_xcc_id() { return (unsigned)__builtin_amdgcn_s_getreg((3 << 11) | 20) & 0xFu; }
#define XB_SPIN(cond, bar) do { unsigned _sp = 0; while (cond) { __builtin_amdgcn_s_sleep(1); \
    if ((++_sp & 255u) == 0u) { if (xb_ld(&(bar)[XB_TMO])) break; if (_sp > XB_SPIN_CAP) { atomicAdd(&(bar)[XB_TMO], 1u); break; } } } } while (0)

struct XcdBarrier {
    unsigned* bar; unsigned x;
    volatile LAS unsigned* st;
};

__device__ __forceinline__ XcdBarrier xcd_barrier_post(unsigned* bar, volatile LAS unsigned* st) {
    XcdBarrier b; b.bar = bar; b.x = xb_xcc_id(); b.st = st;
    if (threadIdx.x == 0) (void)xb_add(&bar[XB_XCNT(b.x)], 1u);
    return b;
}
__device__ __forceinline__ void xcd_barrier_complete(unsigned* bar, unsigned x, unsigned& nloc, unsigned& nx) {
    const unsigned G = gridDim.x * gridDim.y * gridDim.z;
    unsigned sum, cnt, mine, sp = 0u;
    for (;;) {
        sum = 0u; cnt = 0u; mine = 0u;
#pragma unroll
        for (unsigned j = 0; j < 16; ++j) { const unsigned c = xb_ld(&bar[XB_XCNT(j)]); sum += c; cnt += (c > 0u) ? 1u : 0u; mine = (j == x) ? c : mine; }
        if (sum == G) break;
        __builtin_amdgcn_s_sleep(1);
        if ((++sp & 255u) == 0u) { if (xb_ld(&bar[XB_TMO])) break; if (sp > XB_SPIN_CAP) { atomicAdd(&bar[XB_TMO], 1u); break; } }
    }
    nloc = mine > 0u ? mine : 1u; nx = cnt > 0u ? cnt : 1u;
}

__device__ __forceinline__ void xcd_barrier(const XcdBarrier& b) {
    asm volatile("s_waitcnt vmcnt(0)" ::: "memory");
    __syncthreads();
    if (threadIdx.x == 0) {
        unsigned* bar = b.bar;
        __builtin_amdgcn_s_waitcnt(0);
        unsigned nloc = b.st[0], nx = b.st[1];
        if (nloc == 0u) { xcd_barrier_complete(bar, b.x, nloc, nx); b.st[0] = nloc; b.st[1] = nx; }
        const unsigned old = xb_add(&bar[XB_XSUB(b.x)], 1u);
        const unsigned gen = old / nloc;
        if (old + 1u == (gen + 1u) * nloc) {
            __builtin_amdgcn_fence(__ATOMIC_RELEASE, "agent");
            asm volatile("s_waitcnt vmcnt(0)" ::: "memory");
            const unsigned og = xb_add(&bar[XB_TOP], 1u);
            const unsigned tg = og / nx;
            if (og + 1u == (tg + 1u) * nx) xb_add(&bar[XB_TOPGEN], 1u);
            else XB_SPIN(xb_ld(&bar[XB_TOPGEN]) == tg, bar);
            __builtin_amdgcn_fence(__ATOMIC_ACQUIRE, "agent");
            xb_add(&bar[XB_XGEN(b.x)], 1u);
            asm volatile("s_waitcnt vmcnt(0)" ::: "memory");
        } else {
            XB_SPIN(xb_ld(&bar[XB_XGEN(b.x)]) == gen, bar);
            __builtin_amdgcn_fence(__ATOMIC_ACQUIRE, "agent");
            asm volatile("s_waitcnt vmcnt(0)" ::: "memory");
        }
    }
    __syncthreads();
}


extern __shared__ __attribute__((aligned(16))) unsigned char dyn_lds[];
constexpr int LDS_BYTES = 147456;
__global__ void __launch_bounds__(NT) fwd_megakernel(Params p_unused) {
    cg::grid_group grid = cg::this_grid();
    KP p = (KP)__builtin_amdgcn_kernarg_segment_ptr();
    float* lds = (float*)dyn_lds;
    const int bid = blockIdx.x, nb = gridDim.x;
    volatile LAS unsigned* bst = (volatile LAS unsigned*)((LAS unsigned char*)dyn_lds + LDS_BYTES - 16);
    if (threadIdx.x < 4) bst[threadIdx.x] = 0u;
    __syncthreads();
    const XcdBarrier xbar = xcd_barrier_post((unsigned*)(p->ws + WS_CTL), bst);
    phase_mod(p, lds, bid, nb);
    __syncthreads();
    phase_convert_weights(p, lds, bid, nb);
    phase_convert_experts(p, bid, nb);
    grid.sync();
    phase_hrows(p, p->in[I_X], p->in[I_GMIX], 0, D, (bf16_t*)(p->ws + WS_H), lds, bid, nb);
    xcd_barrier(xbar);
    { pg8::Gemm g{(const bf16_t*)(p->ws + WS_H), (const bf16_t*)(p->ws + WS_WIN_T), M, NPROJ, D}; pg8::StaticOrder S; S.init(M, NPROJ, nb, bid);
      pg8::EpiProj E{(bf16_t*)(p->ws + WS_PROJ), (float*)(p->ws + WS_SSQV), M};
      pg8::gemm_phase<pg8::EpiProj, pg8::StaticOrder, true, true>((LAS unsigned char*)dyn_lds, g, S, E); }
    xcd_barrier(xbar);
    phase_lru(p, dyn_lds, bid, nb);
    phase_sgu(p, dyn_lds, bid, nb);
    xcd_barrier(xbar);
    { pg8::Gemm g{(const bf16_t*)(p->ws + WS_YMIX), (const bf16_t*)(p->ws + WS_WOUT_T), M, D, D}; pg8::StaticOrder S; S.init(M, D, nb, bid);
      pg8::EpiX1 E{p->in[I_X], p->out, (const float*)(p->ws + WS_MODP), p->in[I_BADA], 2 * D, NMOD, SEQ};
      pg8::gemm_phase<pg8::EpiX1, pg8::StaticOrder, true, true>((LAS unsigned char*)dyn_lds, g, S, E); }
    xcd_barrier(xbar);
    phase_hrows(p, p->out, p->in[I_GFFN], 3 * D, 4 * D, (bf16_t*)(p->ws + WS_H), lds, bid, nb);
    xcd_barrier(xbar);
    { pg8::Gemm g{(const bf16_t*)(p->ws + WS_H), (const bf16_t*)(p->ws + WS_WQ_T), M, D, D}; pg8::StaticOrder S; S.init(M, D, nb, bid);
      pg8::EpiQ E{(bf16_t*)(p->ws + WS_Q), D};
      pg8::gemm_phase<pg8::EpiQ, pg8::StaticOrder, true, true>((LAS unsigned char*)dyn_lds, g, S, E); }
    xcd_barrier(xbar);
    phase_topk(p, dyn_lds, bid, nb);
    xcd_barrier(xbar);
    phase_peer_gather<false>(p, lds, bid, nb);
    xcd_barrier(xbar);
    phase_peer_act(p, bid, nb);
    xcd_barrier(xbar);
    phase_peer_gather<true>(p, lds, bid, nb);
    xcd_barrier(xbar);
    phase_final_norm(p, bid, nb);
}

extern "C" void kernel_launch(void* const* d_in, const int* in_sizes, int n_in, void* d_out, int out_size, void* d_ws, size_t ws_size, hipStream_t stream) {
    static int grid_blocks = 0;
    if (grid_blocks == 0) {
        if (n_in != 23 || in_sizes[0] != M * D || out_size != M * D || ws_size < WS_END) { fprintf(stderr, "kernel_launch: unexpected shapes (n_in %d in0 %d out %d ws %zu)\n", n_in, n_in > 0 ? in_sizes[0] : -1, out_size, ws_size); grid_blocks = -1; return; }
        if (hipFuncSetAttribute((const void*)fwd_megakernel, hipFuncAttributeMaxDynamicSharedMemorySize, LDS_BYTES) != hipSuccess) { fprintf(stderr, "hipFuncSetAttribute failed\n"); grid_blocks = -1; return; }
        int dev = 0, cus = 0, per_cu = 0;
        hipGetDevice(&dev);
        hipDeviceGetAttribute(&cus, hipDeviceAttributeMultiprocessorCount, dev);
        if (hipOccupancyMaxActiveBlocksPerMultiprocessor(&per_cu, (const void*)fwd_megakernel, NT, LDS_BYTES) != hipSuccess || per_cu < 1) { fprintf(stderr, "occupancy query failed (%d)\n", per_cu); grid_blocks = -1; return; }
        grid_blocks = cus;
    }
    if (grid_blocks < 0) return;
    Params p{};
    for (int i = 0; i < 23; ++i) p.in[i] = (const float*)d_in[i];
    p.out = (float*)d_out; p.ws = (unsigned char*)d_ws;
    if (hipMemsetAsync((char*)d_ws + WS_CTL, 0, 65536, stream) != hipSuccess) { fprintf(stderr, "hipMemsetAsync of the barrier words failed\n"); return; }
    void* args[] = {&p};
    hipError_t e = hipLaunchCooperativeKernel((const void*)fwd_megakernel, dim3(grid_blocks), dim3(NT), args, LDS_BYTES, stream);
    if (e != hipSuccess) fprintf(stderr, "cooperative launch failed: %s (grid %d)\n", hipGetErrorString(e), grid_blocks);
}
```

```cpp
#include <hip/hip_runtime.h>
#include <hip/hip_cooperative_groups.h>
#include <cstdio>
#include <cstdint>

constexpr int D = 2048, NB = 8, SEQ = 2048, M = NB * SEQ;
constexpr int DLRU = 1024, DSGU = 1024, NPROJ = 4096;
constexpr int NMOD = 6 * D;
constexpr int NHEAD = 8, NKEYS = 128, TOPK = 16, NSEL = NHEAD * TOPK;
constexpr float EPS = 1e-6f;
constexpr int NT = 512;
namespace cg = cooperative_groups;

constexpr size_t MiB = 1u << 20;
constexpr size_t WS_CTL = 0;
constexpr size_t WS_MODP = 1 * MiB;
constexpr size_t WS_WGA_T = 3 * MiB;
constexpr size_t WS_WGI_T = 3 * MiB + 262144;
constexpr size_t WS_WSPB = 3 * MiB + 524288;
constexpr size_t WS_SKEYB = 3 * MiB + 786432;
constexpr size_t WS_SSQV = 5 * MiB;
constexpr size_t WS_RSTDV = 8 * MiB;
constexpr size_t WS_WIN_T = 9 * MiB;
constexpr size_t WS_WOUT_T = 25 * MiB;
constexpr size_t WS_WQ_T = 33 * MiB;
constexpr size_t WS_IDX = 41 * MiB;
constexpr size_t WS_GATE = 49 * MiB;
constexpr size_t WS_H = 64 * MiB;
constexpr size_t WS_PROJ = 128 * MiB;
constexpr size_t WS_Q = 128 * MiB;
constexpr size_t WS_YMIX = 256 * MiB;
constexpr size_t WS_EU8 = 320 * MiB;
constexpr size_t WS_EV8 = 352 * MiB;
constexpr size_t WS_ESCALE = 57 * MiB;
constexpr size_t WS_XC = 320 * MiB;
constexpr size_t WS_A = 384 * MiB;
constexpr size_t WS_BB = 448 * MiB;
constexpr size_t WS_ACT = 256 * MiB;
constexpr size_t WS_SSQ2 = 264 * MiB;
constexpr size_t WS_PDOT = 384 * MiB;
constexpr size_t WS_END = 512 * MiB;

typedef unsigned short bf16_t;
struct Params { const float* in[23]; float* out; unsigned char* ws; };
typedef const __attribute__((address_space(4))) Params* KP;
enum { I_X = 0, I_C, I_WADA, I_BADA, I_GMIX, I_WIN, I_CONVW, I_CONVB, I_WGA, I_BGA, I_WGI, I_BGI, I_LAM, I_GV, I_WSP, I_BSP, I_WOUT, I_GFFN, I_WQ, I_SKEY, I_EU, I_EV, I_GFIN };

__device__ __forceinline__ int opaque_tid() { int t = threadIdx.x; asm volatile("" : "+v"(t)); return t; }
__device__ __forceinline__ float bf2f(bf16_t v) { return __uint_as_float(((unsigned)v) << 16); }
__device__ __forceinline__ bf16_t f2bf(float f) { unsigned u = __float_as_uint(f); u += 0x7fffu + ((u >> 16) & 1u); return (bf16_t)(u >> 16); }
__device__ __forceinline__ float sigmoidf_(float x) { return 1.f / (1.f + __expf(-x)); }
__device__ __forceinline__ float gelu_t(float x) { const float u = 0.7978845608028654f * (x + 0.044715f * x * x * x); return x * sigmoidf_(2.f * u); }
__device__ __forceinline__ float wave_sum(float v) {
#pragma unroll
    for (int o = 1; o < 64; o <<= 1) v += __shfl_xor(v, o);
    return v;
}
__device__ __forceinline__ float mod_at(KP p, int b, int n) {
    const float* mp = (const float*)(p->ws + WS_MODP);
    float s = p->in[I_BADA][n];
#pragma unroll
    for (int kc = 0; kc < 4; ++kc) s += mp[(size_t)(kc * 8 + b) * NMOD + n];
    return s;
}

__device__ __forceinline__ void phase_mod(KP p, float* lds, int bid, int nb) {
    const int tid = opaque_tid(), lane = tid & 63, wave = tid >> 6;
    const float* c = p->in[I_C]; const float* W = p->in[I_WADA];
    float* modp = (float*)(p->ws + WS_MODP);
    for (int i = tid; i < NB * D; i += NT) { const float v = c[i]; lds[i] = v * sigmoidf_(v); }
    __syncthreads();
    float* red = lds + NB * D;
    for (int item = bid; item < 192; item += nb) {
        const int nt = item % 48, kc = item / 48;
        const int n0 = nt * 256 + lane * 4, k0 = kc * 512 + wave * 64;
        float acc[8][4];
#pragma unroll
        for (int b = 0; b < 8; ++b)
#pragma unroll
            for (int j = 0; j < 4; ++j) acc[b][j] = 0.f;
        for (int kk = 0; kk < 64; ++kk) {
            const float4 w = *(const float4*)(W + (size_t)(k0 + kk) * NMOD + n0);
#pragma unroll
            for (int b = 0; b < 8; ++b) { const float s = lds[b * D + k0 + kk]; acc[b][0] += s * w.x; acc[b][1] += s * w.y; acc[b][2] += s * w.z; acc[b][3] += s * w.w; }
        }
#pragma unroll
        for (int b = 0; b < 8; ++b)
#pragma unroll
            for (int j = 0; j < 4; ++j) red[(wave * 32 + b * 4 + j) * 64 + lane] = acc[b][j];
        __syncthreads();
        for (int o = tid; o < 2048; o += NT) {
            const int b = o >> 8, nn = o & 255, ln = nn >> 2, j = nn & 3;
            float s = 0.f;
#pragma unroll
            for (int w = 0; w < 8; ++w) s += red[(w * 32 + b * 4 + j) * 64 + ln];
            modp[(size_t)(kc * 8 + b) * NMOD + nt * 256 + nn] = s;
        }
        __syncthreads();
    }
}

__device__ __forceinline__ void phase_hrows(KP p, const float* src, const float* gn, int shift_off, int scale_off, bf16_t* dst, float* lds, int bid, int nb) {
    const int tid = opaque_tid(), lane = tid & 63, wave = tid >> 6;
    float* Aw = lds; float* Bw = lds + D;
    for (int item = bid; item < M / 64; item += nb) {
        const int b = item / (SEQ / 64);
        for (int col = tid; col < D; col += NT) { Aw[col] = gn[col] * (1.f + mod_at(p, b, scale_off + col)); Bw[col] = mod_at(p, b, shift_off + col); }
        __syncthreads();
        for (int r = wave; r < 64; r += 8) {
            const size_t row = (size_t)item * 64 + r;
            float4 v[8]; float ss = 0.f;
#pragma unroll
            for (int j = 0; j < 8; ++j) { v[j] = *(const float4*)(src + row * D + lane * 4 + 256 * j); ss += v[j].x * v[j].x + v[j].y * v[j].y + v[j].z * v[j].z + v[j].w * v[j].w; }
            const float rstd = rsqrtf(wave_sum(ss) * (1.f / D) + EPS);
#pragma unroll
            for (int j = 0; j < 8; ++j) {
                const int col = lane * 4 + 256 * j;
                const float o0 = v[j].x * rstd * Aw[col] + Bw[col], o1 = v[j].y * rstd * Aw[col + 1] + Bw[col + 1];
                const float o2 = v[j].z * rstd * Aw[col + 2] + Bw[col + 2], o3 = v[j].w * rstd * Aw[col + 3] + Bw[col + 3];
                uint2 w; w.x = (unsigned)f2bf(o0) | ((unsigned)f2bf(o1) << 16); w.y = (unsigned)f2bf(o2) | ((unsigned)f2bf(o3) << 16);
                *(uint2*)(dst + row * D + col) = w;
            }
        }
        __syncthreads();
    }
}

namespace pg8 {
#define PG8_LAS __attribute__((address_space(3)))
typedef unsigned short bf16_t;
typedef short bf16x8 __attribute__((ext_vector_type(8)));
typedef float f32x4 __attribute__((ext_vector_type(4)));
typedef unsigned u32x4 __attribute__((ext_vector_type(4)));
constexpr int BM = 256, BK = 64, HALF = 128, HTB = HALF * BK * 2  , STAGE_BYTES = 8 * HTB, NXCD = 8, WGM = 8;

__host__ __device__ __forceinline__ int lds_byte(int r, int c) { const int st = (r >> 4) * 2 + (c >> 5), rr = r & 15, cc = c & 31, ob = rr * 64 + cc * 2; return st * 1024 + (ob ^ (((ob >> 9) & 1) << 5)); }
__host__ __device__ __forceinline__ void stage_rc(int b, int& R, int& C) { const int st = b / 1024, sb = b % 1024, swz = sb ^ (((sb >> 9) & 1) << 5); R = (st >> 1) * 16 + swz / 64; C = (st & 1) * 32 + (swz % 64) / 2; }
__host__ __device__ __forceinline__ int perm32(int rho) { const int n = rho >> 4, i = rho & 15; return 8 * (i >> 2) + 4 * n + (i & 3); }

struct Unit { int pm, pn; };
struct Gemm { const bf16_t* A; const bf16_t* Bt; int M, N, K; };

struct StaticOrder {
    int nM, nN, nwg, G, c;
    __host__ __device__ void init(int M, int N, int G_, int c_) { nM = M / BM; nN = N / BM; nwg = nM * nN; G = G_; c = c_; }
    __host__ __device__ bool next(int i, Unit& u) const {
        const long L = (long)i * G + c; if (L >= nwg) return false;
        int wgid = (int)L; { const int q = nwg / NXCD, r = nwg % NXCD, xcd = wgid % NXCD, off = wgid / NXCD; wgid = (xcd < r ? xcd * (q + 1) : r * (q + 1) + (xcd - r) * q) + off; }
        const int nig = WGM * nN, gid = wgid / nig, fm = gid * WGM, gsz = (nM - fm) < WGM ? (nM - fm) : WGM;
        u.pm = fm + ((wgid % nig) % gsz); u.pn = (wgid % nig) / gsz; return true;
    }
    __device__ __forceinline__ void a_ready(const Unit&) const {}
    __device__ __forceinline__ void done(const Unit&) const {}
};


__device__ __forceinline__ unsigned cvt_pk_bf16(float lo, float hi) { unsigned r; asm volatile("v_cvt_pk_bf16_f32 %0, %1, %2" : "=v"(r) : "v"(lo), "v"(hi)); return r; }
__device__ __forceinline__ float gelu_tanh(float x) { const float u = 1.5957691216057308f * (x + 0.044715f * x * x * x); return x * __builtin_amdgcn_rcpf(1.f + __expf(-u)); }
struct EpiProj {
    static constexpr bool PERM = true, AFTER_DRAIN = false;
    bf16_t* proj; float* ssqv; int Mrows;
    __device__ __forceinline__ void operator()(const f32x4 (&acc)[2][2][4][2], const Unit& u, int wr, int wc, int fr, int fq) const {
        const int which = (u.pn * BM) >> 10, colt = (u.pn * BM) & 1023;
        bf16_t* base = proj + (size_t)which * Mrows * 1024;
        const int row0 = u.pm * BM + wr * 64 + fr, col0 = colt + wc * 32 + 8 * fq;
#pragma unroll
        for (int ai = 0; ai < 2; ++ai)
#pragma unroll
            for (int m = 0; m < 4; ++m) { const int row = row0 + ai * HALF + m * 16; bf16_t* rowp = base + (size_t)row * 1024 + col0; float ss = 0.f;
#pragma unroll
                for (int bj = 0; bj < 2; ++bj) { f32x4 v0 = acc[ai][bj][m][0], v1 = acc[ai][bj][m][1];
                    if (which) {
#pragma unroll
                        for (int j = 0; j < 4; ++j) { v0[j] = gelu_tanh(v0[j]); v1[j] = gelu_tanh(v1[j]); } }
                    ss += (v0[0] * v0[0] + v0[1] * v0[1]) + (v0[2] * v0[2] + v0[3] * v0[3]) + (v1[0] * v1[0] + v1[1] * v1[1]) + (v1[2] * v1[2] + v1[3] * v1[3]);
                    u32x4 w; w.x = cvt_pk_bf16(v0[0], v0[1]); w.y = cvt_pk_bf16(v0[2], v0[3]); w.z = cvt_pk_bf16(v1[0], v1[1]); w.w = cvt_pk_bf16(v1[2], v1[3]);
                    *(u32x4*)(rowp + bj * HALF) = w; }
                if (which == 3) { ss += __shfl_xor(ss, 16); ss += __shfl_xor(ss, 32); if (fq == 0) ssqv[(size_t)row * 16 + (u.pn & 3) * 4 + wc] = ss; } }
    }
};
struct EpiX1 {
    static constexpr bool PERM = false, AFTER_DRAIN = false;
    const float* x; float* out; const float* modp; const float* bada; int goff, nmod, seq;
    __device__ __forceinline__ void operator()(const f32x4 (&acc)[2][2][4][2], const Unit& u, int wr, int wc, int fr, int fq) const {
        const int row0 = u.pm * BM + wr * 64 + fr, col0 = u.pn * BM + wc * 32 + 4 * fq, b = (u.pm * BM) / seq;
        f32x4 gv[2][2];
#pragma unroll
        for (int bj = 0; bj < 2; ++bj)
#pragma unroll
            for (int n = 0; n < 2; ++n) { const int c = goff + col0 + bj * HALF + n * 16; f32x4 g = *(const f32x4*)(bada + c);
#pragma unroll
                for (int kc = 0; kc < 4; ++kc) g += *(const f32x4*)(modp + (size_t)(kc * 8 + b) * nmod + c);
                gv[bj][n] = g; }
#pragma unroll
        for (int ai = 0; ai < 2; ++ai)
#pragma unroll
            for (int m = 0; m < 4; ++m) { const size_t off = (size_t)(row0 + ai * HALF + m * 16) * (size_t)(2048) + col0;
#pragma unroll
                for (int bj = 0; bj < 2; ++bj)
#pragma unroll
                    for (int n = 0; n < 2; ++n) { const f32x4 xv = *(const f32x4*)(x + off + bj * HALF + n * 16); *(f32x4*)(out + off + bj * HALF + n * 16) = xv + gv[bj][n] * acc[ai][bj][m][n]; } }
    }
};
struct EpiQ {
    static constexpr bool PERM = true, AFTER_DRAIN = false;
    bf16_t* O; int ldc;
    __device__ __forceinline__ void operator()(const f32x4 (&acc)[2][2][4][2], const Unit& u, int wr, int wc, int fr, int fq) const {
        const int row0 = u.pm * BM + wr * 64 + fr, col0 = u.pn * BM + wc * 32 + 8 * fq;
#pragma unroll
        for (int ai = 0; ai < 2; ++ai)
#pragma unroll
            for (int m = 0; m < 4; ++m) { bf16_t* rowp = O + (size_t)(row0 + ai * HALF + m * 16) * ldc + col0;
#pragma unroll
                for (int bj = 0; bj < 2; ++bj) { const f32x4 v0 = acc[ai][bj][m][0], v1 = acc[ai][bj][m][1];
                    u32x4 w; w.x = cvt_pk_bf16(v0[0], v0[1]); w.y = cvt_pk_bf16(v0[2], v0[3]); w.z = cvt_pk_bf16(v1[0], v1[1]); w.w = cvt_pk_bf16(v1[2], v1[3]);
                    *(u32x4*)(rowp + bj * HALF) = w; } }
    }
};

template <class Epi, class Sched, bool ALIGN_EPI = false, bool SP2 = false>
__device__ __forceinline__ void gemm_phase(PG8_LAS unsigned char* lds, const Gemm g, const Sched& S, const Epi& E) {
    const int tid = opaque_tid(), wid = __builtin_amdgcn_readfirstlane(tid >> 6), lane = tid & 63, wr = wid >> 2, wc = wid & 3, fr = lane & 15, fq = lane >> 4;
    const int K = g.K, nt = K / BK;
    unsigned voffA[2], voffB[2];
#pragma unroll
    for (int i = 0; i < 2; ++i) { int R, C; stage_rc(tid * 16 + i * 8192, R, C); const int Rb = Epi::PERM ? ((R & ~31) + perm32(R & 31)) : R;
        voffA[i] = (unsigned)(R * K + C) * 2u; voffB[i] = (unsigned)(Rb * K + C) * 2u; }
    const size_t kstep = (size_t)(BK * 2);
    const size_t hstep = (size_t)HALF * K * 2;
    const size_t tstep = 2 * hstep;
    const unsigned ldsw = (unsigned)wid * 1024u;
    const int aoff = lds_byte(wr * 64 + fr, fq * 8), boff = lds_byte(wc * 32 + fr, fq * 8);
#define PG8_SA(b, h) (((b) * 2 + (h)) * HTB)
#define PG8_SB(b, h) ((4 + (b) * 2 + (h)) * HTB)
#define PG8_STAGE(bufoff, gbase, voff) do { _Pragma("unroll") for (int _i = 0; _i < 2; ++_i) \
        __builtin_amdgcn_global_load_lds((const unsigned*)((const char*)(gbase) + (voff)[_i]), (PG8_LAS unsigned*)(lds + (bufoff) + ldsw + _i * 8192), 16, 0, 0); } while (0)
#define PG8_LDA(dst, b, h) do { _Pragma("unroll") for (int m = 0; m < 4; ++m) _Pragma("unroll") for (int k = 0; k < 2; ++k) dst[m][k] = *(const PG8_LAS bf16x8*)(lds + PG8_SA(b, h) + aoff + m * 2048 + k * 1024); } while (0)
#define PG8_LDB(dst, b, h) do { _Pragma("unroll") for (int n = 0; n < 2; ++n) _Pragma("unroll") for (int k = 0; k < 2; ++k) dst[n][k] = *(const PG8_LAS bf16x8*)(lds + PG8_SB(b, h) + boff + n * 2048 + k * 1024); } while (0)
#define PG8_MMA(ai, bj, At, Bt) do { __builtin_amdgcn_s_setprio(1); _Pragma("unroll") for (int m = 0; m < 4; ++m) _Pragma("unroll") for (int n = 0; n < 2; ++n) _Pragma("unroll") for (int k = 0; k < 2; ++k) \
        acc[ai][bj][m][n] = __builtin_amdgcn_mfma_f32_16x16x32_bf16(Bt[n][k], At[m][k], acc[ai][bj][m][n], 0, 0, 0); __builtin_amdgcn_s_setprio(0); } while (0)
#define PG8_WAIT_V(n) asm volatile("s_waitcnt vmcnt(" #n ")" ::: "memory")
#define PG8_WAIT_L(n) asm volatile("s_waitcnt lgkmcnt(" #n ")" ::: "memory")
#define PG8_BAR __builtin_amdgcn_s_barrier()
#define PG8_SCHED __builtin_amdgcn_sched_barrier(0)
    Unit cur, nxt; int ui = 0;
    if (!S.next(0, cur)) return;
    f32x4 acc[2][2][4][2];
#pragma unroll
    for (int a = 0; a < 2; ++a)
#pragma unroll
        for (int b = 0; b < 2; ++b)
#pragma unroll
            for (int m = 0; m < 4; ++m)
#pragma unroll
                for (int n = 0; n < 2; ++n) acc[a][b][m][n] = (f32x4){0.f, 0.f, 0.f, 0.f};
    bf16x8 At[4][2], B0[2][2], B1[2][2];
    const char* cA = (const char*)g.A + (size_t)cur.pm * tstep; const char* cB = (const char*)g.Bt + (size_t)cur.pn * tstep;
    S.a_ready(cur);
    if constexpr (SP2) {
        PG8_STAGE(PG8_SB(0, 0), cB, voffB); PG8_STAGE(PG8_SB(0, 1), cB + hstep, voffB); PG8_STAGE(PG8_SA(0, 0), cA, voffA); PG8_STAGE(PG8_SA(0, 1), cA + hstep, voffA);
        if (wr == 1) PG8_BAR;
        PG8_WAIT_V(2); PG8_BAR;
        PG8_STAGE(PG8_SB(1, 0), cB + kstep, voffB); PG8_STAGE(PG8_SA(1, 0), cA + kstep, voffA); PG8_STAGE(PG8_SB(1, 1), cB + hstep + kstep, voffB);
        PG8_WAIT_V(6); PG8_BAR;
    } else {
        PG8_STAGE(PG8_SB(0, 0), cB, voffB); PG8_STAGE(PG8_SA(0, 0), cA, voffA); PG8_STAGE(PG8_SB(0, 1), cB + hstep, voffB); PG8_STAGE(PG8_SA(0, 1), cA + hstep, voffA);
        if (wr == 1) PG8_BAR;
        PG8_WAIT_V(4); PG8_BAR;
        PG8_STAGE(PG8_SB(1, 0), cB + kstep, voffB); PG8_STAGE(PG8_SA(1, 0), cA + kstep, voffA); PG8_STAGE(PG8_SB(1, 1), cB + hstep + kstep, voffB);
        PG8_WAIT_V(6); PG8_BAR;
    }
    for (;;) {
        const bool has_next = S.next(ui + 1, nxt);
        const char* nA = has_next ? (const char*)g.A + (size_t)nxt.pm * tstep : cA; const char* nB = has_next ? (const char*)g.Bt + (size_t)nxt.pn * tstep : cB;
        for (int t = 0; t < nt; t += 2) {
            const bool last = (t == nt - 2);
            const char* a1 = cA + (size_t)(t + 1) * kstep;
            const char* a2 = last ? nA : cA + (size_t)(t + 2) * kstep; const char* b2 = last ? nB : cB + (size_t)(t + 2) * kstep;
            const char* a3 = a2 + kstep; const char* b3 = b2 + kstep;
            if (last && has_next) S.a_ready(nxt);
            if constexpr (SP2) {
            PG8_LDB(B0, 0, 0); PG8_LDB(B1, 0, 1); PG8_SCHED; PG8_LDA(At, 0, 0); PG8_STAGE(PG8_SA(1, 1), a1 + hstep, voffA);
            PG8_WAIT_V(8); PG8_WAIT_L(0); PG8_BAR; PG8_MMA(0, 0, At, B0); PG8_MMA(0, 1, At, B1); PG8_BAR; PG8_SCHED;
            PG8_LDA(At, 0, 1); PG8_STAGE(PG8_SB(0, 0), b2, voffB); PG8_STAGE(PG8_SB(0, 1), b2 + hstep, voffB); PG8_STAGE(PG8_SA(0, 0), a2, voffA);
            PG8_WAIT_V(8); PG8_WAIT_L(0); PG8_BAR; PG8_MMA(1, 0, At, B0); PG8_MMA(1, 1, At, B1); PG8_BAR; PG8_SCHED;
            PG8_LDB(B0, 1, 0); PG8_LDB(B1, 1, 1); PG8_SCHED; PG8_LDA(At, 1, 0); PG8_STAGE(PG8_SA(0, 1), a2 + hstep, voffA);
            PG8_WAIT_V(8); PG8_WAIT_L(0); PG8_BAR; PG8_MMA(0, 0, At, B0); PG8_MMA(0, 1, At, B1); PG8_BAR; PG8_SCHED;
            PG8_LDA(At, 1, 1); PG8_STAGE(PG8_SB(1, 0), b3, voffB); PG8_STAGE(PG8_SB(1, 1), b3 + hstep, voffB); PG8_STAGE(PG8_SA(1, 0), a3, voffA);
            PG8_WAIT_V(8); PG8_WAIT_L(0); PG8_BAR; PG8_MMA(1, 0, At, B0); PG8_MMA(1, 1, At, B1); PG8_BAR; PG8_SCHED;
            } else {
            PG8_LDB(B0, 0, 0); PG8_SCHED; PG8_LDA(At, 0, 0); PG8_STAGE(PG8_SA(1, 1), a1 + hstep, voffA);
            PG8_WAIT_L(8); PG8_BAR; PG8_WAIT_L(0); PG8_MMA(0, 0, At, B0); PG8_BAR; PG8_SCHED;
            PG8_LDB(B1, 0, 1); PG8_STAGE(PG8_SB(0, 0), b2, voffB);
            PG8_BAR; PG8_WAIT_L(0); PG8_MMA(0, 1, At, B1); PG8_BAR;
            PG8_LDA(At, 0, 1); PG8_STAGE(PG8_SA(0, 0), a2, voffA);
            PG8_BAR; PG8_WAIT_L(0); PG8_MMA(1, 0, At, B0); PG8_BAR; PG8_SCHED;
            PG8_STAGE(PG8_SB(0, 1), b2 + hstep, voffB);
            PG8_WAIT_V(6); PG8_BAR; PG8_MMA(1, 1, At, B1); PG8_BAR;
            PG8_LDB(B0, 1, 0); PG8_SCHED; PG8_LDA(At, 1, 0); PG8_STAGE(PG8_SA(0, 1), a2 + hstep, voffA);
            PG8_WAIT_L(8); PG8_BAR; PG8_WAIT_L(0); PG8_MMA(0, 0, At, B0); PG8_BAR; PG8_SCHED;
            PG8_LDB(B1, 1, 1); PG8_STAGE(PG8_SB(1, 0), b3, voffB);
            PG8_BAR; PG8_WAIT_L(0); PG8_MMA(0, 1, At, B1); PG8_BAR;
            PG8_LDA(At, 1, 1); PG8_STAGE(PG8_SA(1, 0), a3, voffA);
            PG8_BAR; PG8_WAIT_L(0); PG8_MMA(1, 0, At, B0); PG8_BAR; PG8_SCHED;
            PG8_STAGE(PG8_SB(1, 1), b3 + hstep, voffB);
            PG8_WAIT_V(6); PG8_BAR; PG8_MMA(1, 1, At, B1); PG8_BAR;
            }
        }
        if constexpr (ALIGN_EPI) { if (wr == 0) PG8_BAR; }
        if constexpr (!Epi::AFTER_DRAIN) { E(acc, cur, wr, wc, fr, fq); S.done(cur); }
        if (!has_next) break;
#pragma unroll
        for (int a = 0; a < 2; ++a)
#pragma unroll
            for (int b = 0; b < 2; ++b)
#pragma unroll
                for (int m = 0; m < 4; ++m)
#pragma unroll
                    for (int n = 0; n < 2; ++n) acc[a][b][m][n] = (f32x4){0.f, 0.f, 0.f, 0.f};
        cur = nxt; cA = nA; cB = nB; ++ui;
        if constexpr (ALIGN_EPI) { if (wr == 1) PG8_BAR; }
    }
    PG8_WAIT_V(0);
    if constexpr (!ALIGN_EPI) { if (wr == 0) PG8_BAR; }
    PG8_BAR;
    if constexpr (Epi::AFTER_DRAIN) { E.fused(acc, cur, wr, wc, fr, fq, lds, wid, lane); S.done(cur); }
#undef PG8_SA
#undef PG8_SB
#undef PG8_STAGE
#undef PG8_LDA
#undef PG8_LDB
#undef PG8_MMA
#undef PG8_WAIT_V
#undef PG8_WAIT_L
#undef PG8_BAR
#undef PG8_SCHED
}
}

#define LAS __attribute__((address_space(3)))
__device__ __forceinline__ unsigned pk2(float lo, float hi) { return (unsigned)f2bf(lo) | ((unsigned)f2bf(hi) << 16); }
__device__ __forceinline__ void transpose_item(const float* W, int K, int N, bf16_t* WT, float* scr, int item, int lane) {
    const int nblk = N / 32, kb = item / nblk, nbk = item % nblk, k0 = 64 * kb, n0 = 32 * nbk;
#pragma unroll 8
    for (int i = 0; i < 32; ++i) { const int kk = 2 * i + (lane >> 5); scr[kk * 33 + (lane & 31)] = W[(size_t)(k0 + kk) * N + n0 + (lane & 31)]; }
    asm volatile("s_waitcnt lgkmcnt(0)" ::: "memory");
    const int c = lane & 7;
#pragma unroll
    for (int j = 0; j < 4; ++j) { const int n = (lane >> 3) + 8 * j; const float* s = scr + (8 * c) * 33 + n;
        uint4 o; o.x = pk2(s[0 * 33], s[1 * 33]); o.y = pk2(s[2 * 33], s[3 * 33]); o.z = pk2(s[4 * 33], s[5 * 33]); o.w = pk2(s[6 * 33], s[7 * 33]);
        *(uint4*)(WT + (size_t)(n0 + n) * K + k0 + 8 * c) = o; }
    asm volatile("s_waitcnt lgkmcnt(0)" ::: "memory");
}
__device__ __forceinline__ void phase_convert_weights(KP p, float* lds, int bid, int nb) {
    const int tid = opaque_tid(), lane = tid & 63, wave = tid >> 6;
    float* scr = lds + wave * (64 * 33);
    const int gw = bid * 8 + wave, ngw = nb * 8;
    constexpr int I_IN = (D / 64) * (NPROJ / 32), I_SQ = (D / 64) * (D / 32), I_G = 8 * (128 / 64) * (128 / 32);
    constexpr int NITEMS = I_IN + 2 * I_SQ + 2 * I_G;
    for (int it = gw; it < NITEMS; it += ngw) {
        int r = it;
        if (r < I_IN) { transpose_item(p->in[I_WIN], D, NPROJ, (bf16_t*)(p->ws + WS_WIN_T), scr, r, lane); continue; } r -= I_IN;
        if (r < I_SQ) { transpose_item(p->in[I_WOUT], D, D, (bf16_t*)(p->ws + WS_WOUT_T), scr, r, lane); continue; } r -= I_SQ;
        if (r < I_SQ) { transpose_item(p->in[I_WQ], D, D, (bf16_t*)(p->ws + WS_WQ_T), scr, r, lane); continue; } r -= I_SQ;
        if (r < I_G) { const int hd = r / 8; transpose_item(p->in[I_WGA] + hd * 16384, 128, 128, (bf16_t*)(p->ws + WS_WGA_T) + hd * 16384, scr, r % 8, lane); continue; } r -= I_G;
        { const int hd = r / 8; transpose_item(p->in[I_WGI] + hd * 16384, 128, 128, (bf16_t*)(p->ws + WS_WGI_T) + hd * 16384, scr, r % 8, lane); }
    }
    bf16_t* wsp = (bf16_t*)(p->ws + WS_WSPB); bf16_t* skb = (bf16_t*)(p->ws + WS_SKEYB);
    for (int e = bid * NT + tid; e < 8 * 128 * 128; e += nb * NT) { const int i = (e >> 7) & 127, j = e & 127; wsp[e] = f2bf(j <= i ? p->in[I_WSP][e] : 0.f); }
    for (int e = bid * NT + tid; e < 8 * 2 * 128 * 128; e += nb * NT) skb[e] = f2bf(p->in[I_SKEY][e]);
}

typedef short bf16x8_t __attribute__((ext_vector_type(8)));
typedef float f32x4_t __attribute__((ext_vector_type(4)));
typedef short s16x4_t __attribute__((ext_vector_type(4)));
constexpr int XA_STRIDE = 272;
constexpr int LRU_XA = 0, LRU_SA = 34816, LRU_SB = LRU_SA + 16384, LRU_SEGP = LRU_SB + 16384, LRU_SEGH = LRU_SEGP + 2048;
__device__ __forceinline__ void phase_lru(KP p, unsigned char* lds, int bid, int nb) {
    const int tid = opaque_tid(), lane = tid & 63, wave = tid >> 6, c16 = lane & 15, q = lane >> 4;
    const bf16_t* XL = (const bf16_t*)(p->ws + WS_PROJ); const bf16_t* YG = XL + (size_t)M * 1024; bf16_t* ymix = (bf16_t*)(p->ws + WS_YMIX);
    float* SA = (float*)(lds + LRU_SA); float* SB = (float*)(lds + LRU_SB); float* SEGP = (float*)(lds + LRU_SEGP); float* SEGH = (float*)(lds + LRU_SEGH);
    for (int unit = bid; unit < NB * 8 * 4; unit += nb) {
        const int b = unit >> 5, hd = (unit >> 2) & 7, cq = unit & 3;
        bf16x8_t wf[2][2][4];
#pragma unroll
        for (int gs = 0; gs < 2; ++gs)
#pragma unroll
            for (int nt = 0; nt < 2; ++nt)
#pragma unroll
                for (int ks = 0; ks < 4; ++ks)
                    wf[gs][nt][ks] = *(const bf16x8_t*)((const bf16_t*)(p->ws + (gs ? WS_WGI_T : WS_WGA_T)) + ((size_t)(hd * 128 + cq * 32 + nt * 16 + c16) * 128 + ks * 32 + 8 * q));
        float ba[2], bi[2], c2[2];
#pragma unroll
        for (int nt = 0; nt < 2; ++nt) { const int ch = hd * 128 + cq * 32 + nt * 16 + c16; ba[nt] = p->in[I_BGA][ch]; bi[nt] = p->in[I_BGI][ch];
            const float lam = p->in[I_LAM][ch]; const float sp = fmaxf(-lam, 0.f) + log1pf(__expf(-fabsf(lam))); c2[nt] = -8.f * sp * 1.4426950408889634f; }
        const int o = tid & 15, rg = tid >> 4;
        float cw[4][8], cb[8];
#pragma unroll
        for (int e = 0; e < 8; ++e) { cb[e] = p->in[I_CONVB][hd * 128 + o * 8 + e];
#pragma unroll
            for (int k = 0; k < 4; ++k) cw[k][e] = p->in[I_CONVW][k * DLRU + hd * 128 + o * 8 + e]; }
        const int sc = tid & 31, seg = tid >> 5;
        float carry = 0.f;
        for (int ch = 0; ch < SEQ / 128; ++ch) {
            const int t0 = ch * 128; const size_t row0 = (size_t)b * SEQ + t0;
            bf16_t yg[8];
#pragma unroll
            for (int k = 0; k < 8; ++k) yg[k] = YG[(row0 + seg * 8 + k) * 1024 + hd * 128 + cq * 32 + sc];
            uint4 xr[7];
#pragma unroll
            for (int i = 0; i < 7; ++i) { const int t = t0 + 4 * rg - 3 + i;
                xr[i] = t >= 0 ? *(const uint4*)(XL + ((size_t)b * SEQ + t) * 1024 + hd * 128 + o * 8) : make_uint4(0u, 0u, 0u, 0u); }
#pragma unroll
            for (int r = 0; r < 4; ++r) {
                float acc8[8];
#pragma unroll
                for (int e = 0; e < 8; ++e) acc8[e] = cb[e];
#pragma unroll
                for (int k = 0; k < 4; ++k) { const uint4 w = xr[r + k]; const unsigned ww[4] = {w.x, w.y, w.z, w.w};
#pragma unroll
                    for (int e2 = 0; e2 < 4; ++e2) { acc8[2 * e2] += cw[k][2 * e2] * __uint_as_float(ww[e2] << 16); acc8[2 * e2 + 1] += cw[k][2 * e2 + 1] * __uint_as_float(ww[e2] & 0xffff0000u); } }
                uint4 ov; ov.x = pk2(acc8[0], acc8[1]); ov.y = pk2(acc8[2], acc8[3]); ov.z = pk2(acc8[4], acc8[5]); ov.w = pk2(acc8[6], acc8[7]);
                *(uint4*)(lds + LRU_XA + (4 * rg + r) * XA_STRIDE + o * 16) = ov;
            }
            __syncthreads();
            f32x4_t acc[2][2];
#pragma unroll
            for (int gs = 0; gs < 2; ++gs)
#pragma unroll
                for (int nt = 0; nt < 2; ++nt) acc[gs][nt] = (f32x4_t){0.f, 0.f, 0.f, 0.f};
#pragma unroll
            for (int ks = 0; ks < 4; ++ks) {
                const bf16x8_t a = *(const bf16x8_t*)(lds + LRU_XA + (16 * wave + c16) * XA_STRIDE + (ks * 32 + 8 * q) * 2);
#pragma unroll
                for (int gs = 0; gs < 2; ++gs)
#pragma unroll
                    for (int nt = 0; nt < 2; ++nt) acc[gs][nt] = __builtin_amdgcn_mfma_f32_16x16x32_bf16(a, wf[gs][nt][ks], acc[gs][nt], 0, 0, 0);
            }
#pragma unroll
            for (int nt = 0; nt < 2; ++nt)
#pragma unroll
                for (int reg = 0; reg < 4; ++reg) {
                    const int t = 16 * wave + 4 * q + reg, jj = nt * 16 + c16;
                    const float za = acc[0][nt][reg] + ba[nt], zi = acc[1][nt][reg] + bi[nt];
                    const float r = __builtin_amdgcn_rcpf(1.f + __expf(-za)), ig = __builtin_amdgcn_rcpf(1.f + __expf(-zi));
                    const float a = __builtin_amdgcn_exp2f(c2[nt] * r);
                    const float xcv = bf2f(*(const bf16_t*)(lds + LRU_XA + t * XA_STRIDE + (cq * 32 + jj) * 2));
                    SA[t * 32 + jj] = a; SB[t * 32 + jj] = __builtin_amdgcn_sqrtf(fmaxf(1.f - a * a, 0.f)) * (ig * xcv);
                }
            __syncthreads();
            float av[8], bv[8];
#pragma unroll
            for (int k = 0; k < 8; ++k) { av[k] = SA[(seg * 8 + k) * 32 + sc]; bv[k] = SB[(seg * 8 + k) * 32 + sc]; }
            float P = 1.f, H = 0.f;
#pragma unroll
            for (int k = 0; k < 8; ++k) { H = av[k] * H + bv[k]; P *= av[k]; }
            SEGP[seg * 32 + sc] = P; SEGH[seg * 32 + sc] = H;
            __syncthreads();
            float run = carry, hin = carry;
#pragma unroll
            for (int s = 0; s < 16; ++s) { if (s == seg) hin = run; run = SEGP[s * 32 + sc] * run + SEGH[s * 32 + sc]; }
            carry = run;
            H = hin;
#pragma unroll
            for (int k = 0; k < 8; ++k) { H = av[k] * H + bv[k]; ymix[(row0 + seg * 8 + k) * D + hd * 128 + cq * 32 + sc] = f2bf(H * bf2f(yg[k])); }
        }
        __syncthreads();
    }
}

constexpr int SGU_RS = 0, SGU_TV = 512, SGU_SS = SGU_TV + 128 * XA_STRIDE, SS_STRIDE = 132;
__device__ __forceinline__ void phase_sgu(KP p, unsigned char* lds, int bid, int nb) {
    const int tid = opaque_tid(), lane = tid & 63, wave = tid >> 6, c16 = lane & 15, q = lane >> 4;
    const bf16_t* UG = (const bf16_t*)(p->ws + WS_PROJ) + (size_t)2 * M * 1024; const bf16_t* VG = UG + (size_t)M * 1024;
    const float* ssqv = (const float*)(p->ws + WS_SSQV); bf16_t* ymix = (bf16_t*)(p->ws + WS_YMIX);
    float* RS = (float*)(lds + SGU_RS); float* SS = (float*)(lds + SGU_SS);
    bf16x8_t wa[8][4]; float gvv[8]; int gcur = -1;
    const int oct = tid & 15;
    for (int it = bid; it < NB * 16 * 8; it += nb) {
        const int g = it & 7; const size_t base = (size_t)(it >> 3) * 128;
        if (g != gcur) { gcur = g;
#pragma unroll
            for (int mt = 0; mt < 8; ++mt)
#pragma unroll
                for (int ks = 0; ks < 4; ++ks) if (ks <= ((16 * mt + 15) >> 5))
                    wa[mt][ks] = *(const bf16x8_t*)((const bf16_t*)(p->ws + WS_WSPB) + ((size_t)(g * 128 + mt * 16 + c16) * 128 + ks * 32 + 8 * q));
#pragma unroll
            for (int e = 0; e < 8; ++e) gvv[e] = p->in[I_GV][g * 128 + oct * 8 + e]; }
        uint4 vch[4], uch[4];
#pragma unroll
        for (int k = 0; k < 4; ++k) { const int row = (tid >> 4) + 32 * k; vch[k] = *(const uint4*)(VG + (base + row) * 1024 + g * 128 + oct * 8); uch[k] = *(const uint4*)(UG + (base + row) * 1024 + g * 128 + oct * 8); }
        if (tid < 128) { float ss = 0.f;
#pragma unroll
            for (int k = 0; k < 16; ++k) ss += ssqv[(base + tid) * 16 + k];
            RS[tid] = rsqrtf(ss * (1.f / 1024.f) + EPS); }
        __syncthreads();
#pragma unroll
        for (int k = 0; k < 4; ++k) { const int row = (tid >> 4) + 32 * k; const float r = RS[row]; const unsigned ww[4] = {vch[k].x, vch[k].y, vch[k].z, vch[k].w}; unsigned oo[4];
#pragma unroll
            for (int e2 = 0; e2 < 4; ++e2) oo[e2] = pk2(__uint_as_float(ww[e2] << 16) * r * gvv[2 * e2], __uint_as_float(ww[e2] & 0xffff0000u) * r * gvv[2 * e2 + 1]);
            *(uint4*)(lds + SGU_TV + row * XA_STRIDE + oct * 16) = make_uint4(oo[0], oo[1], oo[2], oo[3]); }
        __syncthreads();
        bf16x8_t bfr[4];
        { const int q4 = c16 >> 2, p4 = c16 & 3;
#pragma unroll
          for (int ks = 0; ks < 4; ++ks) {
              const unsigned a1 = SGU_TV + (ks * 32 + 8 * q + q4) * XA_STRIDE + (wave * 16 + 4 * p4) * 2;
              const s16x4_t lo = __builtin_amdgcn_ds_read_tr16_b64_v4i16((LAS s16x4_t*)(lds + a1));
              const s16x4_t hi = __builtin_amdgcn_ds_read_tr16_b64_v4i16((LAS s16x4_t*)(lds + a1 + 4 * XA_STRIDE));
              bfr[ks] = __builtin_shufflevector(lo, hi, 0, 1, 2, 3, 4, 5, 6, 7); } }
        f32x4_t acc[8];
#pragma unroll
        for (int mt = 0; mt < 8; ++mt) { acc[mt] = (f32x4_t){0.f, 0.f, 0.f, 0.f};
#pragma unroll
            for (int ks = 0; ks < 4; ++ks) if (ks <= ((16 * mt + 15) >> 5)) acc[mt] = __builtin_amdgcn_mfma_f32_16x16x32_bf16(wa[mt][ks], bfr[ks], acc[mt], 0, 0, 0); }
#pragma unroll
        for (int mt = 0; mt < 8; ++mt)
#pragma unroll
            for (int reg = 0; reg < 4; ++reg) { const int i = mt * 16 + 4 * q + reg; SS[i * SS_STRIDE + wave * 16 + c16] = acc[mt][reg] + p->in[I_BSP][g * 128 + i]; }
        __syncthreads();
#pragma unroll
        for (int k = 0; k < 4; ++k) { const int row = (tid >> 4) + 32 * k; const float4 s0 = *(const float4*)(SS + row * SS_STRIDE + oct * 8), s1 = *(const float4*)(SS + row * SS_STRIDE + oct * 8 + 4);
            const unsigned ww[4] = {uch[k].x, uch[k].y, uch[k].z, uch[k].w}; const float sv[8] = {s0.x, s0.y, s0.z, s0.w, s1.x, s1.y, s1.z, s1.w}; unsigned oo[4];
#pragma unroll
            for (int e2 = 0; e2 < 4; ++e2) oo[e2] = pk2(__uint_as_float(ww[e2] << 16) * sv[2 * e2], __uint_as_float(ww[e2] & 0xffff0000u) * sv[2 * e2 + 1]);
            *(uint4*)(ymix + (base + row) * D + 1024 + g * 128 + oct * 8) = make_uint4(oo[0], oo[1], oo[2], oo[3]); }
        __syncthreads();
    }
}

typedef float f32x16_t __attribute__((ext_vector_type(16)));
__device__ __forceinline__ float vmaxf(float a, float b) { float r; asm("v_max_f32 %0, %1, %2" : "=v"(r) : "v"(a), "v"(b)); return r; }
__device__ __forceinline__ float vminf(float a, float b) { float r; asm("v_min_f32 %0, %1, %2" : "=v"(r) : "v"(a), "v"(b)); return r; }
#define CE_DESC(a, b) do { const float _mx = vmaxf(a, b), _mn = vminf(a, b); a = _mx; b = _mn; } while (0)
__device__ __forceinline__ void sort16_desc(float (&v)[16]) {
#pragma unroll
    for (int k = 2; k <= 16; k <<= 1)
#pragma unroll
        for (int j = k >> 1; j > 0; j >>= 1)
#pragma unroll
            for (int i = 0; i < 16; ++i) { const int l = i ^ j; if (l > i) { if ((i & k) == 0) CE_DESC(v[i], v[l]); else CE_DESC(v[l], v[i]); } }
}
__device__ __forceinline__ void merge16_desc(float (&a)[16], const float (&b)[16]) {
#pragma unroll
    for (int i = 0; i < 16; ++i) a[i] = vmaxf(a[i], b[15 - i]);
#pragma unroll
    for (int j = 8; j > 0; j >>= 1)
#pragma unroll
        for (int i = 0; i < 16; ++i) { const int l = i ^ j; if (l > i) CE_DESC(a[i], a[l]); }
}
__device__ __forceinline__ void topk_half(const bf16_t* qp, const unsigned char* kl, unsigned hh4, float (&X)[16]) {
    f32x16_t acc[4];
#pragma unroll
    for (int kt = 0; kt < 4; ++kt)
#pragma unroll
        for (int i = 0; i < 16; ++i) acc[kt][i] = 0.f;
#pragma unroll
    for (int ks = 0; ks < 8; ++ks) {
        const bf16x8_t bq = *(const bf16x8_t*)(qp + ks * 16);
#pragma unroll
        for (int kt = 0; kt < 4; ++kt) { const bf16x8_t ak = *(const bf16x8_t*)(kl + kt * 32 * XA_STRIDE + ks * 32); acc[kt] = __builtin_amdgcn_mfma_f32_32x32x16_bf16(ak, bq, acc[kt], 0, 0, 0); }
    }
    float g[4][16];
#pragma unroll
    for (int kt = 0; kt < 4; ++kt)
#pragma unroll
        for (int reg = 0; reg < 16; ++reg) g[kt][reg] = __uint_as_float(((__float_as_uint(acc[kt][reg]) & 0xFFFFFF80u) | hh4) | (unsigned)(kt * 32 + (reg & 3) + 8 * (reg >> 2)));
    sort16_desc(g[0]); sort16_desc(g[1]); sort16_desc(g[2]); sort16_desc(g[3]);
    merge16_desc(g[0], g[1]); merge16_desc(g[2], g[3]); merge16_desc(g[0], g[2]);
#pragma unroll
    for (int i = 0; i < 16; ++i) X[i] = g[0][i];
}
__device__ __forceinline__ unsigned pack_b0(float a, float b, float c, float d) {
    const unsigned ab = __builtin_amdgcn_perm(__float_as_uint(b), __float_as_uint(a), 0x0c0c0400u), cd = __builtin_amdgcn_perm(__float_as_uint(d), __float_as_uint(c), 0x0c0c0400u);
    return __builtin_amdgcn_perm(cd, ab, 0x05040100u);
}
__device__ __forceinline__ unsigned byte_lookup(const unsigned (&pk)[4], unsigned e) {
    const unsigned lo = __builtin_amdgcn_perm(pk[1], pk[0], e & 7u), hi = __builtin_amdgcn_perm(pk[3], pk[2], e & 7u);
    return ((e & 8u) ? hi : lo) & 0x7Fu;
}
__device__ __forceinline__ void phase_topk(KP p, unsigned char* lds, int bid, int nb) {
    const int tid = opaque_tid(), lane = tid & 63, wave = tid >> 6, r32 = lane & 31, hh = lane >> 5;
    const bf16_t* Q = (const bf16_t*)(p->ws + WS_Q); const bf16_t* KB = (const bf16_t*)(p->ws + WS_SKEYB);
    int* idx = (int*)(p->ws + WS_IDX); float* gate = (float*)(p->ws + WS_GATE);
    const float NEG = -3.0e38f;
    int hcur = -1;
    for (int bi = bid; bi < NHEAD * (M / 256); bi += nb) {
        const int hd = bi & 7, tile = (bi >> 3) * 8 + wave; const size_t token = (size_t)tile * 32 + r32;
        if (hd != hcur) { hcur = hd; __syncthreads();
#pragma unroll
            for (int k = 0; k < 8; ++k) { const int c = tid + NT * k, row = c >> 4, o = c & 15;
                *(uint4*)(lds + row * XA_STRIDE + o * 16) = *(const uint4*)(KB + ((size_t)hd * 256 + row) * 128 + o * 8); }
            __syncthreads(); }
        float X0[16], X1[16];
        topk_half(Q + token * D + hd * 256 + 8 * hh, lds + r32 * XA_STRIDE + hh * 16, 4u * hh, X0);
        __builtin_amdgcn_sched_barrier(0);
        topk_half(Q + token * D + hd * 256 + 128 + 8 * hh, lds + (128 + r32) * XA_STRIDE + hh * 16, 4u * hh, X1);
        __builtin_amdgcn_sched_barrier(0);
#pragma unroll
        for (int i = 0; i < 16; ++i) { const auto r = __builtin_amdgcn_permlane32_swap(__float_as_uint(X0[i]), __float_as_uint(X1[i]), false, false); X0[i] = __uint_as_float(r[0]); X1[i] = __uint_as_float(r[1]); }
        merge16_desc(X0, X1);
        float U[16];
#pragma unroll
        for (int i = 0; i < 16; ++i) U[i] = __shfl_xor(X0[i], 32);
        const unsigned hbit = (unsigned)hh << 8;
        float c0[16], c1[16];
#pragma unroll
        for (int j = 0; j < 16; ++j) { float s = X0[0] + U[j]; if (j == 0) s = hh ? NEG : s; c0[j] = __uint_as_float(((__float_as_uint(s) & 0xFFFFFE00u) | hbit) | (unsigned)j); }
        {
            int n = 0;
#pragma unroll
            for (int i = 1; i < 4; ++i)
#pragma unroll
                for (int j = i; j < 16; ++j) if ((i + 1) * (j + 1) <= 16) { float s = X0[i] + U[j]; if (j == i) s = hh ? NEG : s; c1[n] = __uint_as_float(((__float_as_uint(s) & 0xFFFFFE00u) | hbit) | (unsigned)(i * 16 + j)); ++n; }
#pragma unroll
            for (int k = 11; k < 16; ++k) c1[k] = NEG;
        }
        sort16_desc(c0); sort16_desc(c1); merge16_desc(c0, c1);
        float F[16];
#pragma unroll
        for (int i = 0; i < 16; ++i) F[i] = vmaxf(c0[i], __shfl_xor(c0[15 - i], 32));
        float mx = F[0];
#pragma unroll
        for (int i = 1; i < 16; ++i) mx = vmaxf(mx, F[i]);
        float ev[16], sum = 0.f;
#pragma unroll
        for (int i = 0; i < 16; ++i) { ev[i] = __expf(F[i] - mx); sum += ev[i]; }
        const float inv = 1.f / sum;
        unsigned pt[4], pu[4], pa[4], pb[4];
#pragma unroll
        for (int w = 0; w < 4; ++w) { pt[w] = pack_b0(X0[4 * w], X0[4 * w + 1], X0[4 * w + 2], X0[4 * w + 3]); pu[w] = pack_b0(U[4 * w], U[4 * w + 1], U[4 * w + 2], U[4 * w + 3]); }
#pragma unroll
        for (int w = 0; w < 4; ++w) { pa[w] = hh ? pu[w] : pt[w]; pb[w] = hh ? pt[w] : pu[w]; }
        int oi[8]; float og[8];
#pragma unroll
        for (int k = 0; k < 8; ++k) {
            const unsigned pl = __float_as_uint(F[k]) & 0x1FFu, sw = pl >> 8, pi = (pl >> 4) & 15u, pj = pl & 15u;
            const unsigned ai = sw ? pj : pi, bj = sw ? pi : pj;
            oi[k] = (int)(byte_lookup(pa, ai) * NKEYS + byte_lookup(pb, bj)); og[k] = ev[k] * inv;
        }
        int* io = idx + token * NSEL + hd * TOPK + 8 * hh; float* go = gate + token * NSEL + hd * TOPK + 8 * hh;
        *(int4*)io = make_int4(oi[0], oi[1], oi[2], oi[3]); *(int4*)(io + 4) = make_int4(oi[4], oi[5], oi[6], oi[7]);
        *(float4*)go = make_float4(og[0], og[1], og[2], og[3]); *(float4*)(go + 4) = make_float4(og[4], og[5], og[6], og[7]);
    }
}

__device__ __forceinline__ void wave_argmax(float& v, int& i) {
#pragma unroll
    for (int off = 32; off >= 1; off >>= 1) { const float ov = __shfl_xor(v, off); const int oi = __shfl_xor(i, off); if (ov > v || (ov == v && oi < i)) { v = ov; i = oi; } }
}
__device__ __forceinline__ void topk_half_naive(const bf16_t* q, const float* k0, int lane, float& outv, int& outi) {
    const float NEG = -3.0e38f;
    const float* k1 = k0 + 64 * 128;
    float s0 = 0.f, s1 = 0.f;
    for (int k = 0; k < 128; k += 4) {
        const uint2 qq = *(const uint2*)(q + k);
        const float q0 = bf2f((bf16_t)(qq.x & 0xffff)), q1 = bf2f((bf16_t)(qq.x >> 16)), q2 = bf2f((bf16_t)(qq.y & 0xffff)), q3 = bf2f((bf16_t)(qq.y >> 16));
        const float4 a = *(const float4*)(k0 + k), b = *(const float4*)(k1 + k);
        s0 += q0 * a.x + q1 * a.y + q2 * a.z + q3 * a.w; s1 += q0 * b.x + q1 * b.y + q2 * b.z + q3 * b.w;
    }
    float myv = NEG; int myi = 0;
    for (int r = 0; r < TOPK; ++r) {
        float v; int i; if (s0 >= s1) { v = s0; i = lane; } else { v = s1; i = lane + 64; }
        wave_argmax(v, i);
        if (i == lane) s0 = NEG; if (i == lane + 64) s1 = NEG;
        if (lane == r) { myv = v; myi = i; }
    }
    outv = myv; outi = myi;
}
__device__ __forceinline__ void phase_topk_naive(KP p, int bid, int nb) {
    const bf16_t* Q = (const bf16_t*)(p->ws + WS_Q); const float* keys = p->in[I_SKEY];
    int* idx = (int*)(p->ws + WS_IDX); float* gate = (float*)(p->ws + WS_GATE);
    const int tid = opaque_tid(), lane = tid & 63, wave = tid >> 6;
    const float NEG = -3.0e38f;
    for (int task = bid * 8 + wave; task < M * NHEAD; task += nb * 8) {
        const int token = task >> 3, hd = task & 7;
        float tv0, tv1; int ti0, ti1;
        topk_half_naive(Q + (size_t)token * D + hd * 256, keys + ((size_t)(hd * 2) * 128 + lane) * 128, lane, tv0, ti0);
        topk_half_naive(Q + (size_t)token * D + hd * 256 + 128, keys + ((size_t)(hd * 2 + 1) * 128 + lane) * 128, lane, tv1, ti1);
        const float vb = __shfl(tv1, lane & 15);
        float c0 = __shfl(tv0, (lane >> 4)) + vb, c1 = __shfl(tv0, (lane >> 4) + 4) + vb, c2 = __shfl(tv0, (lane >> 4) + 8) + vb, c3 = __shfl(tv0, (lane >> 4) + 12) + vb;
        float selv = NEG; int selc = 0;
        for (int r = 0; r < TOPK; ++r) {
            float v = c0; int i = lane;
            if (c1 > v) { v = c1; i = lane + 64; }
            if (c2 > v) { v = c2; i = lane + 128; }
            if (c3 > v) { v = c3; i = lane + 192; }
            wave_argmax(v, i);
            if (i == lane) c0 = NEG; if (i == lane + 64) c1 = NEG; if (i == lane + 128) c2 = NEG; if (i == lane + 192) c3 = NEG;
            if (lane == r) { selv = v; selc = i; }
        }
        const float mx = __shfl(selv, 0);
        const float e = lane < TOPK ? __expf(selv - mx) : 0.f;
        const float sum = wave_sum(e);
        const int i1 = __shfl(ti0, selc >> 4), i2 = __shfl(ti1, selc & 15);
        if (lane < TOPK) { idx[(size_t)token * NSEL + hd * TOPK + lane] = i1 * NKEYS + i2; gate[(size_t)token * NSEL + hd * TOPK + lane] = e / sum; }
    }
}

typedef float f32x2_t __attribute__((ext_vector_type(2)));
constexpr size_t GRP_BYTES = (size_t)NKEYS * NKEYS * 128;
constexpr int NGRP = D / 128;
__device__ __forceinline__ float wave_max(float v) {
#pragma unroll
    for (int o = 1; o < 64; o <<= 1) v = fmaxf(v, __shfl_xor(v, o));
    return v;
}
__device__ __forceinline__ void phase_convert_experts(KP p, int bid, int nb) {
    const int tid = opaque_tid(), lane = tid & 63, wave = tid >> 6;
    for (int row = bid * 8 + wave; row < 2 * NKEYS * NKEYS; row += nb * 8) {
        const int t = row >= NKEYS * NKEYS, e = row - t * NKEYS * NKEYS;
        const float* src = (t ? p->in[I_EV] : p->in[I_EU]) + (size_t)e * D;
        unsigned char* dst = p->ws + (t ? WS_EV8 : WS_EU8) + (size_t)e * 128 + (size_t)(lane >> 5) * GRP_BYTES + (lane & 31) * 4;
        float4 v[8]; float am = 0.f;
#pragma unroll
        for (int j = 0; j < 8; ++j) { v[j] = *(const float4*)(src + lane * 4 + 256 * j); am = fmaxf(am, fmaxf(fmaxf(fabsf(v[j].x), fabsf(v[j].y)), fmaxf(fabsf(v[j].z), fabsf(v[j].w)))); }
        am = wave_max(am);
        int ex = 0; if (am > 0.f) (void)frexpf(am, &ex); else ex = 8;
        const float sc = ldexpf(1.f, 8 - ex);
#pragma unroll
        for (int j = 0; j < 8; ++j) { int w = __builtin_amdgcn_cvt_pk_fp8_f32(v[j].x * sc, v[j].y * sc, 0, false); w = __builtin_amdgcn_cvt_pk_fp8_f32(v[j].z * sc, v[j].w * sc, w, true); *(unsigned*)(dst + (size_t)(2 * j) * GRP_BYTES) = (unsigned)w; }
        if (lane == 0) ((float*)(p->ws + WS_ESCALE))[row] = ldexpf(1.f, ex - 8);
    }
}
__device__ __forceinline__ unsigned xb_xcc_id();
constexpr int PEER_TT = 16;
constexpr int PEER_NTILE = M / PEER_TT;
constexpr int CW_UQ = 4096, CW_VQ = 8192;
__device__ __forceinline__ float dpp_xor1(float v) { return __builtin_bit_cast(float, __builtin_amdgcn_update_dpp(0, __builtin_bit_cast(int, v), 0xB1, 0xF, 0xF, true)); }
__device__ __forceinline__ float dpp_xor2(float v) { return __builtin_bit_cast(float, __builtin_amdgcn_update_dpp(0, __builtin_bit_cast(int, v), 0x4E, 0xF, 0xF, true)); }
__device__ __forceinline__ float dpp_hmirror(float v) { return __builtin_bit_cast(float, __builtin_amdgcn_update_dpp(0, __builtin_bit_cast(int, v), 0x141, 0xF, 0xF, true)); }
__device__ __forceinline__ void pg_load_ids(const int* idx, size_t token, int k, unsigned c16, unsigned (&off)[16]) {
#pragma unroll
    for (int i = 0; i < 4; ++i) { const int4 v = *(const int4*)(idx + token * NSEL + 16 * k + 4 * i); off[4 * i] = ((unsigned)v.x << 7) + c16; off[4 * i + 1] = ((unsigned)v.y << 7) + c16; off[4 * i + 2] = ((unsigned)v.z << 7) + c16; off[4 * i + 3] = ((unsigned)v.w << 7) + c16; }
}
__device__ __forceinline__ void pg_load_lines(const unsigned char* tg, const unsigned (&off)[16], uint4 (&r)[16]) {
#pragma unroll
    for (int j = 0; j < 16; ++j) r[j] = *(const uint4*)(tg + off[j]);
}
typedef _Float16 h2_t __attribute__((ext_vector_type(2)));
__device__ __forceinline__ void pg_compute_u(const uint4 (&r)[16], const uint4 (&hw)[2], float* po, int c) {
    h2_t hv[8];
#pragma unroll
    for (int hq = 0; hq < 2; ++hq) { const unsigned ww[4] = {hw[hq].x, hw[hq].y, hw[hq].z, hw[hq].w};
#pragma unroll
        for (int cc = 0; cc < 4; ++cc) { h2_t t; t.x = (_Float16)__uint_as_float(ww[cc] << 16); t.y = (_Float16)__uint_as_float(ww[cc] & 0xffff0000u); hv[4 * hq + cc] = t; } }
    float d[16];
#pragma unroll
    for (int j = 0; j < 16; ++j) { const unsigned ww[4] = {r[j].x, r[j].y, r[j].z, r[j].w}; float s = 0.f;
#pragma unroll
        for (int cc = 0; cc < 4; ++cc) { s = __builtin_amdgcn_fdot2(__builtin_bit_cast(h2_t, __builtin_amdgcn_cvt_scalef32_pk_f16_fp8(ww[cc], 1.0f, false)), hv[2 * cc], s, false); s = __builtin_amdgcn_fdot2(__builtin_bit_cast(h2_t, __builtin_amdgcn_cvt_scalef32_pk_f16_fp8(ww[cc], 1.0f, true)), hv[2 * cc + 1], s, false); }
        d[j] = s; }
#pragma unroll
    for (int j = 0; j < 16; ++j) d[j] += dpp_xor1(d[j]);
#pragma unroll
    for (int j = 0; j < 16; ++j) d[j] += dpp_xor2(d[j]);
#pragma unroll
    for (int j = 0; j < 16; ++j) d[j] += dpp_hmirror(d[j]);
    float p0 = 0.f, p1 = 0.f;
#pragma unroll
    for (int j = 0; j < 8; ++j) { p0 = (c == j) ? d[j] : p0; p1 = (c == j) ? d[j + 8] : p1; }
    po[0] = p0; po[8] = p1;
}
__device__ __forceinline__ void pg_compute_v(const uint4 (&r)[16], const f32x4_t (&aw)[4], float* xo, const float* gtp, float* ssp, int k, int lane) {
    h2_t hacc[8];
#pragma unroll
    for (int m = 0; m < 8; ++m) hacc[m] = (h2_t){(_Float16)0.f, (_Float16)0.f};
#pragma unroll
    for (int j = 0; j < 16; ++j) { const unsigned ww[4] = {r[j].x, r[j].y, r[j].z, r[j].w}; const _Float16 aj = (_Float16)(aw[j >> 2][j & 3] * 256.f); const h2_t a2 = {aj, aj};
#pragma unroll
        for (int cc = 0; cc < 4; ++cc) { hacc[2 * cc] = __builtin_elementwise_fma(__builtin_bit_cast(h2_t, __builtin_amdgcn_cvt_scalef32_pk_f16_fp8(ww[cc], 1.0f, false)), a2, hacc[2 * cc]); hacc[2 * cc + 1] = __builtin_elementwise_fma(__builtin_bit_cast(h2_t, __builtin_amdgcn_cvt_scalef32_pk_f16_fp8(ww[cc], 1.0f, true)), a2, hacc[2 * cc + 1]); } }
    f32x2_t acc[8];
#pragma unroll
    for (int m = 0; m < 8; ++m) acc[m] = (f32x2_t){(float)hacc[m].x * (1.f / 256.f), (float)hacc[m].y * (1.f / 256.f)};
    f32x2_t b4[4];
#pragma unroll
    for (int m = 0; m < 4; ++m) { const f32x2_t keep = (k & 1) ? acc[4 + m] : acc[m], send = (k & 1) ? acc[m] : acc[4 + m]; b4[m].x = keep.x + __shfl_xor(send.x, 8); b4[m].y = keep.y + __shfl_xor(send.y, 8); }
    f32x2_t b2[2];
#pragma unroll
    for (int m = 0; m < 2; ++m) { const f32x2_t keep = (k & 2) ? b4[2 + m] : b4[m], send = (k & 2) ? b4[m] : b4[2 + m]; b2[m].x = keep.x + __shfl_xor(send.x, 16); b2[m].y = keep.y + __shfl_xor(send.y, 16); }
    f32x2_t o2; { const f32x2_t keep = (k & 4) ? b2[1] : b2[0], send = (k & 4) ? b2[0] : b2[1]; o2.x = keep.x + __shfl_xor(send.x, 32); o2.y = keep.y + __shfl_xor(send.y, 32); }
    const float2 x1 = *(const float2*)xo; const float2 gt = *(const float2*)gtp;
    const float y0 = x1.x + gt.x * o2.x, y1 = x1.y + gt.y * o2.y;
    *(float2*)xo = make_float2(y0, y1);
    const float ss = wave_sum(y0 * y0 + y1 * y1);
    if (lane == 0) *ssp = ss;
}
template <bool VPASS>
__device__ __forceinline__ void phase_peer_gather(KP p, float* lds, int bid, int nb) {
    const int tid = opaque_tid(), lane = tid & 63, k = lane >> 3, c = lane & 7;
    const bf16_t* H = (const bf16_t*)(p->ws + WS_H); const int* idx = (const int*)(p->ws + WS_IDX);
    const unsigned char* TAB = p->ws + (VPASS ? WS_EV8 : WS_EU8);
    float* pdot = (float*)(p->ws + WS_PDOT); const float* act = (const float*)(p->ws + WS_ACT); float* ssq2 = (float*)(p->ws + WS_SSQ2);
    unsigned* ctr = (unsigned*)(p->ws + WS_CTL) + (VPASS ? CW_VQ : CW_UQ);
    if (VPASS) { for (int i = tid; i < NB * D; i += NT) lds[i] = mod_at(p, i >> 11, 5 * D + (i & (D - 1))); __syncthreads(); }
    const unsigned slot0 = xb_xcc_id() & 7u, c16 = 16u * (unsigned)c;
    const int vcol = 16 * c + 8 * (k & 1) + 4 * ((k >> 1) & 1) + 2 * (k >> 2);
    for (int sl = 0; sl < 8; ++sl) {
        const int slot = (int)((slot0 + sl) & 7u);
        for (;;) {
            unsigned q = 0; if (lane == 0) q = __hip_atomic_fetch_add(ctr + 64 * slot, 1u, __ATOMIC_RELAXED, __HIP_MEMORY_SCOPE_AGENT);
            q = (unsigned)__builtin_amdgcn_readfirstlane((int)q);
            if (q >= 2u * PEER_NTILE) break;
            const int g = slot * 2 + (int)(q / PEER_NTILE), tile = (int)(q % PEER_NTILE);
            const unsigned char* tg = TAB + (size_t)g * GRP_BYTES;
            const size_t tok0 = (size_t)tile * PEER_TT;
            unsigned oA[16], oB[16]; uint4 rA[16], rB[16]; uint4 hA[2], hB[2]; f32x4_t aA[4], aB[4];
#define PG_AUX(tok, hX, aX) do { if (!VPASS) { hX[0] = *(const uint4*)(H + (tok) * D + g * 128 + 16 * c); hX[1] = *(const uint4*)(H + (tok) * D + g * 128 + 16 * c + 8); } \
            else { _Pragma("unroll") for (int i_ = 0; i_ < 4; ++i_) aX[i_] = *(const f32x4_t*)(act + (tok) * NSEL + 16 * k + 4 * i_); } } while (0)
#define PG_COMPUTE(tok, rX, hX, aX) do { if (!VPASS) pg_compute_u(rX, hX, pdot + ((size_t)g * M + (tok)) * NSEL + 16 * k + c, c); \
            else pg_compute_v(rX, aX, p->out + (tok) * D + g * 128 + vcol, lds + ((tok) / SEQ) * D + g * 128 + vcol, ssq2 + (size_t)g * M + (tok), k, lane); } while (0)
            pg_load_ids(idx, tok0, k, c16, oA); pg_load_lines(tg, oA, rA); PG_AUX(tok0, hA, aA); pg_load_ids(idx, tok0 + 1, k, c16, oB);
            for (int tt = 0; tt < PEER_TT; tt += 2) {
                pg_load_lines(tg, oB, rB); PG_AUX(tok0 + tt + 1, hB, aB);
                if (tt + 2 < PEER_TT) pg_load_ids(idx, tok0 + tt + 2, k, c16, oA);
                PG_COMPUTE(tok0 + tt, rA, hA, aA);
                if (tt + 2 < PEER_TT) { pg_load_lines(tg, oA, rA); PG_AUX(tok0 + tt + 2, hA, aA); pg_load_ids(idx, tok0 + tt + 3, k, c16, oB); }
                PG_COMPUTE(tok0 + tt + 1, rB, hB, aB);
            }
#undef PG_AUX
#undef PG_COMPUTE
        }
    }
}
__device__ __forceinline__ void phase_peer_act(KP p, int bid, int nb) {
    const int tid = opaque_tid(), lane = tid & 63, wave = tid >> 6;
    const int* idx = (const int*)(p->ws + WS_IDX); const float* gate = (const float*)(p->ws + WS_GATE); const float* esc = (const float*)(p->ws + WS_ESCALE);
    const float* pdot = (const float*)(p->ws + WS_PDOT); float* act = (float*)(p->ws + WS_ACT);
    for (int token = bid * 8 + wave; token < M; token += nb * 8) {
        float d0 = 0.f, d1 = 0.f;
#pragma unroll
        for (int g = 0; g < NGRP; ++g) { d0 += pdot[((size_t)g * M + token) * NSEL + lane]; d1 += pdot[((size_t)g * M + token) * NSEL + 64 + lane]; }
        const int e0 = idx[(size_t)token * NSEL + lane], e1 = idx[(size_t)token * NSEL + 64 + lane];
        act[(size_t)token * NSEL + lane] = gelu_t(d0 * esc[e0]) * gate[(size_t)token * NSEL + lane] * esc[NKEYS * NKEYS + e0];
        act[(size_t)token * NSEL + 64 + lane] = gelu_t(d1 * esc[e1]) * gate[(size_t)token * NSEL + 64 + lane] * esc[NKEYS * NKEYS + e1];
    }
}
__device__ __forceinline__ void phase_final_norm(KP p, int bid, int nb) {
    const int tid = opaque_tid(), lane = tid & 63, wave = tid >> 6;
    const float* ssq2 = (const float*)(p->ws + WS_SSQ2); const float* gf = p->in[I_GFIN];
    for (int token = bid * 8 + wave; token < M; token += nb * 8) {
        float ss = 0.f;
#pragma unroll
        for (int g = 0; g < NGRP; ++g) ss += ssq2[(size_t)g * M + token];
        const float rstd = rsqrtf(ss * (1.f / D) + EPS);
        float* row = p->out + (size_t)token * D;
#pragma unroll
        for (int j = 0; j < 8; ++j) { const int col = lane * 4 + 256 * j; const float4 v = *(const float4*)(row + col); const float4 g4 = *(const float4*)(gf + col);
            *(float4*)(row + col) = make_float4(v.x * rstd * g4.x, v.y * rstd * g4.y, v.z * rstd * g4.z, v.w * rstd * g4.w); }
    }
}

#define XB_TMO      128
#define XB_XCNT(j)  (256  + 64 * (j))
#define XB_XSUB(j)  (1280 + 64 * (j))
#define XB_XGEN(j)  (2304 + 64 * (j))
#define XB_TOP      3328
#define XB_TOPGEN   3392
#define XCD_BAR_WORDS 3456
#define XB_SPIN_CAP (1u << 18)

__device__ __forceinline__ unsigned xb_ld(unsigned* p)              { return __hip_atomic_load(p, __ATOMIC_RELAXED, __HIP_MEMORY_SCOPE_AGENT); }
__device__ __forceinline__ unsigned xb_add(unsigned* p, unsigned v) { return __hip_atomic_fetch_add(p, v, __ATOMIC_RELAXED, __HIP_MEMORY_SCOPE_AGENT); }
__device__ __forceinline__ unsigned xb_xcc_id() { return (unsigned)__builtin_amdgcn_s_getreg((3 << 11) | 20) & 0xFu; }
#define XB_SPIN(cond, bar) do { unsigned _sp = 0; while (cond) { __builtin_amdgcn_s_sleep(1); \
    if ((++_sp & 255u) == 0u) { if (xb_ld(&(bar)[XB_TMO])) break; if (_sp > XB_SPIN_CAP) { atomicAdd(&(bar)[XB_TMO], 1u); break; } } } } while (0)

struct XcdBarrier {
    unsigned* bar; unsigned x;
    volatile LAS unsigned* st;
};

__device__ __forceinline__ XcdBarrier xcd_barrier_post(unsigned* bar, volatile LAS unsigned* st) {
    XcdBarrier b; b.bar = bar; b.x = xb_xcc_id(); b.st = st;
    if (threadIdx.x == 0) (void)xb_add(&bar[XB_XCNT(b.x)], 1u);
    return b;
}
__device__ __forceinline__ void xcd_barrier_complete(unsigned* bar, unsigned x, unsigned& nloc, unsigned& nx) {
    const unsigned G = gridDim.x * gridDim.y * gridDim.z;
    unsigned sum, cnt, mine, sp = 0u;
    for (;;) {
        sum = 0u; cnt = 0u; mine = 0u;
#pragma unroll
        for (unsigned j = 0; j < 16; ++j) { const unsigned c = xb_ld(&bar[XB_XCNT(j)]); sum += c; cnt += (c > 0u) ? 1u : 0u; mine = (j == x) ? c : mine; }
        if (sum == G) break;
        __builtin_amdgcn_s_sleep(1);
        if ((++sp & 255u) == 0u) { if (xb_ld(&bar[XB_TMO])) break; if (sp > XB_SPIN_CAP) { atomicAdd(&bar[XB_TMO], 1u); break; } }
    }
    nloc = mine > 0u ? mine : 1u; nx = cnt > 0u ? cnt : 1u;
}

__device__ __forceinline__ void xcd_barrier(const XcdBarrier& b) {
    asm volatile("s_waitcnt vmcnt(0)" ::: "memory");
    __syncthreads();
    if (threadIdx.x == 0) {
        unsigned* bar = b.bar;
        __builtin_amdgcn_s_waitcnt(0);
        unsigned nloc = b.st[0], nx = b.st[1];
        if (nloc == 0u) { xcd_barrier_complete(bar, b.x, nloc, nx); b.st[0] = nloc; b.st[1] = nx; }
        const unsigned old = xb_add(&bar[XB_XSUB(b.x)], 1u);
        const unsigned gen = old / nloc;
        if (old + 1u == (gen + 1u) * nloc) {
            __builtin_amdgcn_fence(__ATOMIC_RELEASE, "agent");
            asm volatile("s_waitcnt vmcnt(0)" ::: "memory");
            const unsigned og = xb_add(&bar[XB_TOP], 1u);
            const unsigned tg = og / nx;
            if (og + 1u == (tg + 1u) * nx) xb_add(&bar[XB_TOPGEN], 1u);
            else XB_SPIN(xb_ld(&bar[XB_TOPGEN]) == tg, bar);
            __builtin_amdgcn_fence(__ATOMIC_ACQUIRE, "agent");
            xb_add(&bar[XB_XGEN(b.x)], 1u);
            asm volatile("s_waitcnt vmcnt(0)" ::: "memory");
        } else {
            XB_SPIN(xb_ld(&bar[XB_XGEN(b.x)]) == gen, bar);
            __builtin_amdgcn_fence(__ATOMIC_ACQUIRE, "agent");
            asm volatile("s_waitcnt vmcnt(0)" ::: "memory");
        }
    }
    __syncthreads();
}


extern __shared__ __attribute__((aligned(16))) unsigned char dyn_lds[];
constexpr int LDS_BYTES = 147456;
__global__ void __launch_bounds__(NT) fwd_megakernel(Params p_unused) {
    cg::grid_group grid = cg::this_grid();
    KP p = (KP)__builtin_amdgcn_kernarg_segment_ptr();
    float* lds = (float*)dyn_lds;
    const int bid = blockIdx.x, nb = gridDim.x;
    volatile LAS unsigned* bst = (volatile LAS unsigned*)((LAS unsigned char*)dyn_lds + LDS_BYTES - 16);
    if (threadIdx.x < 4) bst[threadIdx.x] = 0u;
    __syncthreads();
    const XcdBarrier xbar = xcd_barrier_post((unsigned*)(p->ws + WS_CTL), bst);
    phase_mod(p, lds, bid, nb);
    __syncthreads();
    phase_convert_weights(p, lds, bid, nb);
    phase_convert_experts(p, bid, nb);
    grid.sync();
    phase_hrows(p, p->in[I_X], p->in[I_GMIX], 0, D, (bf16_t*)(p->ws + WS_H), lds, bid, nb);
    xcd_barrier(xbar);
    { pg8::Gemm g{(const bf16_t*)(p->ws + WS_H), (const bf16_t*)(p->ws + WS_WIN_T), M, NPROJ, D}; pg8::StaticOrder S; S.init(M, NPROJ, nb, bid);
      pg8::EpiProj E{(bf16_t*)(p->ws + WS_PROJ), (float*)(p->ws + WS_SSQV), M};
      pg8::gemm_phase<pg8::EpiProj, pg8::StaticOrder, true, true>((LAS unsigned char*)dyn_lds, g, S, E); }
    xcd_barrier(xbar);
    phase_lru(p, dyn_lds, bid, nb);
    phase_sgu(p, dyn_lds, bid, nb);
    xcd_barrier(xbar);
    { pg8::Gemm g{(const bf16_t*)(p->ws + WS_YMIX), (const bf16_t*)(p->ws + WS_WOUT_T), M, D, D}; pg8::StaticOrder S; S.init(M, D, nb, bid);
      pg8::EpiX1 E{p->in[I_X], p->out, (const float*)(p->ws + WS_MODP), p->in[I_BADA], 2 * D, NMOD, SEQ};
      pg8::gemm_phase<pg8::EpiX1, pg8::StaticOrder, true, true>((LAS unsigned char*)dyn_lds, g, S, E); }
    xcd_barrier(xbar);
    phase_hrows(p, p->out, p->in[I_GFFN], 3 * D, 4 * D, (bf16_t*)(p->ws + WS_H), lds, bid, nb);
    xcd_barrier(xbar);
    { pg8::Gemm g{(const bf16_t*)(p->ws + WS_H), (const bf16_t*)(p->ws + WS_WQ_T), M, D, D}; pg8::StaticOrder S; S.init(M, D, nb, bid);
      pg8::EpiQ E{(bf16_t*)(p->ws + WS_Q), D};
      pg8::gemm_phase<pg8::EpiQ, pg8::StaticOrder, true, true>((LAS unsigned char*)dyn_lds, g, S, E); }
    xcd_barrier(xbar);
    phase_topk(p, dyn_lds, bid, nb);
    xcd_barrier(xbar);
    phase_peer_gather<false>(p, lds, bid, nb);
    xcd_barrier(xbar);
    phase_peer_act(p, bid, nb);
    xcd_barrier(xbar);
    phase_peer_gather<true>(p, lds, bid, nb);
    xcd_barrier(xbar);
    phase_final_norm(p, bid, nb);
}

extern "C" void kernel_launch(void* const* d_in, const int* in_sizes, int n_in, void* d_out, int out_size, void* d_ws, size_t ws_size, hipStream_t stream) {
    static int grid_blocks = 0;
    if (grid_blocks == 0) {
        if (n_in != 23 || in_sizes[0] != M * D || out_size != M * D || ws_size < WS_END) { fprintf(stderr, "kernel_launch: unexpected shapes (n_in %d in0 %d out %d ws %zu)\n", n_in, n_in > 0 ? in_sizes[0] : -1, out_size, ws_size); grid_blocks = -1; return; }
        if (hipFuncSetAttribute((const void*)fwd_megakernel, hipFuncAttributeMaxDynamicSharedMemorySize, LDS_BYTES) != hipSuccess) { fprintf(stderr, "hipFuncSetAttribute failed\n"); grid_blocks = -1; return; }
        int dev = 0, cus = 0, per_cu = 0;
        hipGetDevice(&dev);
        hipDeviceGetAttribute(&cus, hipDeviceAttributeMultiprocessorCount, dev);
        if (hipOccupancyMaxActiveBlocksPerMultiprocessor(&per_cu, (const void*)fwd_megakernel, NT, LDS_BYTES) != hipSuccess || per_cu < 1) { fprintf(stderr, "occupancy query failed (%d)\n", per_cu); grid_blocks = -1; return; }
        grid_blocks = cus;
    }
    if (grid_blocks < 0) return;
    Params p{};
    for (int i = 0; i < 23; ++i) p.in[i] = (const float*)d_in[i];
    p.out = (float*)d_out; p.ws = (unsigned char*)d_ws;
    if (hipMemsetAsync((char*)d_ws + WS_CTL, 0, 65536, stream) != hipSuccess) { fprintf(stderr, "hipMemsetAsync of the barrier words failed\n"); return; }
    void* args[] = {&p};
    hipError_t e = hipLaunchCooperativeKernel((const void*)fwd_megakernel, dim3(grid_blocks), dim3(NT), args, LDS_BYTES, stream);
    if (e != hipSuccess) fprintf(stderr, "cooperative launch failed: %s (grid %d)\n", hipGetErrorString(e), grid_blocks);
}
```

```cpp
#include <hip/hip_runtime.h>
#include <hip/hip_cooperative_groups.h>
#include <cstdio>
#include <cstdint>

constexpr int D = 2048, NB = 8, SEQ = 2048, M = NB * SEQ;
constexpr int DLRU = 1024, DSGU = 1024, NPROJ = 4096;
constexpr int NMOD = 6 * D;
constexpr int NHEAD = 8, NKEYS = 128, TOPK = 16, NSEL = NHEAD * TOPK;
constexpr float EPS = 1e-6f;
constexpr int NT = 512;
namespace cg = cooperative_groups;

constexpr size_t MiB = 1u << 20;
constexpr size_t WS_CTL = 0;
constexpr size_t WS_MODP = 1 * MiB;
constexpr size_t WS_WGA_T = 3 * MiB;
constexpr size_t WS_WGI_T = 3 * MiB + 262144;
constexpr size_t WS_WSPB = 3 * MiB + 524288;
constexpr size_t WS_SKEYB = 3 * MiB + 786432;
constexpr size_t WS_SSQV = 5 * MiB;
constexpr size_t WS_RSTDV = 8 * MiB;
constexpr size_t WS_WIN_T = 9 * MiB;
constexpr size_t WS_WOUT_T = 25 * MiB;
constexpr size_t WS_WQ_T = 33 * MiB;
constexpr size_t WS_IDX = 41 * MiB;
constexpr size_t WS_GATE = 49 * MiB;
constexpr size_t WS_H = 64 * MiB;
constexpr size_t WS_PROJ = 128 * MiB;
constexpr size_t WS_Q = 128 * MiB;
constexpr size_t WS_YMIX = 256 * MiB;
constexpr size_t WS_EU8 = 320 * MiB;
constexpr size_t WS_EV8 = 352 * MiB;
constexpr size_t WS_ESCALE = 57 * MiB;
constexpr size_t WS_XC = 320 * MiB;
constexpr size_t WS_A = 384 * MiB;
constexpr size_t WS_BB = 448 * MiB;
constexpr size_t WS_ACT = 256 * MiB;
constexpr size_t WS_SSQ2 = 264 * MiB;
constexpr size_t WS_PDOT = 384 * MiB;
constexpr size_t WS_HSCALE1 = 58 * MiB;
constexpr size_t WS_END = 512 * MiB;

typedef unsigned short bf16_t;
struct Params { const float* in[23]; float* out; unsigned char* ws; };
typedef const __attribute__((address_space(4))) Params* KP;
enum { I_X = 0, I_C, I_WADA, I_BADA, I_GMIX, I_WIN, I_CONVW, I_CONVB, I_WGA, I_BGA, I_WGI, I_BGI, I_LAM, I_GV, I_WSP, I_BSP, I_WOUT, I_GFFN, I_WQ, I_SKEY, I_EU, I_EV, I_GFIN };

__device__ __forceinline__ int opaque_tid_(int wv) { asm volatile("" : "+s"(wv)); int t = wv * 64 + (int)__builtin_amdgcn_mbcnt_hi(~0u, __builtin_amdgcn_mbcnt_lo(~0u, 0u)); asm volatile("" : "+v"(t)); return t; }
#define opaque_tid() opaque_tid_(wv_)
__device__ __forceinline__ float bf2f(bf16_t v) { return __uint_as_float(((unsigned)v) << 16); }
__device__ __forceinline__ bf16_t f2bf(float f) { unsigned u = __float_as_uint(f); u += 0x7fffu + ((u >> 16) & 1u); return (bf16_t)(u >> 16); }
__device__ __forceinline__ float sigmoidf_(float x) { return 1.f / (1.f + __expf(-x)); }
__device__ __forceinline__ float gelu_t(float x) { const float u = 0.7978845608028654f * (x + 0.044715f * x * x * x); return x * sigmoidf_(2.f * u); }
__device__ __forceinline__ float wave_sum(float v) {
#pragma unroll
    for (int o = 1; o < 64; o <<= 1) v += __shfl_xor(v, o);
    return v;
}
__device__ __forceinline__ float wave_max(float v) {
#pragma unroll
    for (int o = 1; o < 64; o <<= 1) v = fmaxf(v, __shfl_xor(v, o));
    return v;
}
__device__ __forceinline__ float pow2_scale_from_max(float am) { int ex = 0; if (am > 0.f) (void)frexpf(am, &ex); else ex = 8; return ldexpf(1.f, 8 - ex); }
__device__ __forceinline__ unsigned pk4_fp8(float a, float b, float c, float d) {
    int w = __builtin_amdgcn_cvt_pk_fp8_f32(fminf(fmaxf(a, -448.f), 448.f), fminf(fmaxf(b, -448.f), 448.f), 0, false);
    return (unsigned)__builtin_amdgcn_cvt_pk_fp8_f32(fminf(fmaxf(c, -448.f), 448.f), fminf(fmaxf(d, -448.f), 448.f), w, true);
}
__device__ __forceinline__ float mod_at(KP p, int b, int n) {
    const float* mp = (const float*)(p->ws + WS_MODP);
    float s = p->in[I_BADA][n];
#pragma unroll
    for (int kc = 0; kc < 4; ++kc) s += mp[(size_t)(kc * 8 + b) * NMOD + n];
    return s;
}

__device__ __forceinline__ void phase_mod(KP p, float* lds, int bid, int nb, int wv_) {
    const int tid = opaque_tid(), lane = tid & 63, wave = tid >> 6;
    const float* c = p->in[I_C]; const float* W = p->in[I_WADA];
    float* modp = (float*)(p->ws + WS_MODP);
    for (int i = tid; i < NB * D; i += NT) { const float v = c[i]; lds[i] = v * sigmoidf_(v); }
    __syncthreads();
    float* red = lds + NB * D;
    for (int item = bid; item < 192; item += nb) {
        const int nt = item % 48, kc = item / 48;
        const int n0 = nt * 256 + lane * 4, k0 = kc * 512 + wave * 64;
        float acc[8][4];
#pragma unroll
        for (int b = 0; b < 8; ++b)
#pragma unroll
            for (int j = 0; j < 4; ++j) acc[b][j] = 0.f;
        for (int kk = 0; kk < 64; ++kk) {
            const float4 w = *(const float4*)(W + (size_t)(k0 + kk) * NMOD + n0);
#pragma unroll
            for (int b = 0; b < 8; ++b) { const float s = lds[b * D + k0 + kk]; acc[b][0] += s * w.x; acc[b][1] += s * w.y; acc[b][2] += s * w.z; acc[b][3] += s * w.w; }
        }
#pragma unroll
        for (int b = 0; b < 8; ++b)
#pragma unroll
            for (int j = 0; j < 4; ++j) red[(wave * 32 + b * 4 + j) * 64 + lane] = acc[b][j];
        __syncthreads();
        for (int o = tid; o < 2048; o += NT) {
            const int b = o >> 8, nn = o & 255, ln = nn >> 2, j = nn & 3;
            float s = 0.f;
#pragma unroll
            for (int w = 0; w < 8; ++w) s += red[(w * 32 + b * 4 + j) * 64 + ln];
            modp[(size_t)(kc * 8 + b) * NMOD + nt * 256 + nn] = s;
        }
        __syncthreads();
    }
}

template <bool F8OUT>
__device__ __forceinline__ void phase_hrows(KP p, const float* src, const float* gn, int shift_off, int scale_off, bf16_t* dst, float* lds, int bid, int nb, int wv_) {
    const int tid = opaque_tid(), lane = tid & 63, wave = tid >> 6;
    float* Aw = lds; float* Bw = lds + D;
    for (int item = bid; item < M / 64; item += nb) {
        const int b = item / (SEQ / 64);
        for (int col = tid; col < D; col += NT) { Aw[col] = gn[col] * (1.f + mod_at(p, b, scale_off + col)); Bw[col] = mod_at(p, b, shift_off + col); }
        __syncthreads();
        for (int r = wave; r < 64; r += 8) {
            const size_t row = (size_t)item * 64 + r;
            float4 v[8]; float ss = 0.f;
#pragma unroll
            for (int j = 0; j < 8; ++j) { v[j] = *(const float4*)(src + row * D + lane * 4 + 256 * j); ss += v[j].x * v[j].x + v[j].y * v[j].y + v[j].z * v[j].z + v[j].w * v[j].w; }
            const float rstd = rsqrtf(wave_sum(ss) * (1.f / D) + EPS);
            float am = 0.f;
#pragma unroll
            for (int j = 0; j < 8; ++j) {
                const int col = lane * 4 + 256 * j;
                const float o0 = v[j].x * rstd * Aw[col] + Bw[col], o1 = v[j].y * rstd * Aw[col + 1] + Bw[col + 1];
                const float o2 = v[j].z * rstd * Aw[col + 2] + Bw[col + 2], o3 = v[j].w * rstd * Aw[col + 3] + Bw[col + 3];
                if (F8OUT) { v[j] = make_float4(o0, o1, o2, o3); am = fmaxf(am, fmaxf(fmaxf(fabsf(o0), fabsf(o1)), fmaxf(fabsf(o2), fabsf(o3)))); }
                else { uint2 w; w.x = (unsigned)f2bf(o0) | ((unsigned)f2bf(o1) << 16); w.y = (unsigned)f2bf(o2) | ((unsigned)f2bf(o3) << 16); *(uint2*)(dst + row * D + col) = w; }
            }
            if (F8OUT) {
                const float sc = pow2_scale_from_max(wave_max(am));
                unsigned* d8 = (unsigned*)((unsigned char*)dst + row * D);
#pragma unroll
                for (int j = 0; j < 8; ++j) d8[lane + 64 * j] = pk4_fp8(v[j].x * sc, v[j].y * sc, v[j].z * sc, v[j].w * sc);
                if (lane == 0) ((float*)(p->ws + WS_HSCALE1))[row] = 1.f / sc;
            }
        }
        __syncthreads();
    }
}

namespace pg8 {
#define PG8_LAS __attribute__((address_space(3)))
typedef unsigned short bf16_t;
typedef short bf16x8 __attribute__((ext_vector_type(8)));
typedef float f32x4 __attribute__((ext_vector_type(4)));
typedef unsigned u32x4 __attribute__((ext_vector_type(4)));
constexpr int BM = 256, BK = 64, HALF = 128, HTB = HALF * BK * 2  , STAGE_BYTES = 8 * HTB, NXCD = 8, WGM = 8;

__host__ __device__ __forceinline__ int lds_byte(int r, int c) { const int st = (r >> 4) * 2 + (c >> 5), rr = r & 15, cc = c & 31, ob = rr * 64 + cc * 2; return st * 1024 + (ob ^ (((ob >> 9) & 1) << 5)); }
__host__ __device__ __forceinline__ void stage_rc(int b, int& R, int& C) { const int st = b / 1024, sb = b % 1024, swz = sb ^ (((sb >> 9) & 1) << 5); R = (st >> 1) * 16 + swz / 64; C = (st & 1) * 32 + (swz % 64) / 2; }
__host__ __device__ __forceinline__ int perm32(int rho) { const int n = rho >> 4, i = rho & 15; return 8 * (i >> 2) + 4 * n + (i & 3); }

struct Unit { int pm, pn; };
struct Gemm { const bf16_t* A; const bf16_t* Bt; int M, N, K; };

struct StaticOrder {
    int nM, nN, nwg, G, c;
    __host__ __device__ void init(int M, int N, int G_, int c_) { nM = M / BM; nN = N / BM; nwg = nM * nN; G = G_; c = c_; }
    __host__ __device__ bool next(int i, Unit& u) const {
        const long L = (long)i * G + c; if (L >= nwg) return false;
        int wgid = (int)L; { const int q = nwg / NXCD, r = nwg % NXCD, xcd = wgid % NXCD, off = wgid / NXCD; wgid = (xcd < r ? xcd * (q + 1) : r * (q + 1) + (xcd - r) * q) + off; }
        const int nig = WGM * nN, gid = wgid / nig, fm = gid * WGM, gsz = (nM - fm) < WGM ? (nM - fm) : WGM;
        u.pm = fm + ((wgid % nig) % gsz); u.pn = (wgid % nig) / gsz; return true;
    }
    __device__ __forceinline__ void a_ready(const Unit&) const {}
    __device__ __forceinline__ void done(const Unit&) const {}
};


__device__ __forceinline__ unsigned cvt_pk_bf16(float lo, float hi) { unsigned r; asm volatile("v_cvt_pk_bf16_f32 %0, %1, %2" : "=v"(r) : "v"(lo), "v"(hi)); return r; }
__device__ __forceinline__ float gelu_tanh(float x) { const float u = 1.5957691216057308f * (x + 0.044715f * x * x * x); return x * __builtin_amdgcn_rcpf(1.f + __expf(-u)); }
struct EpiProj {
    static constexpr bool PERM = true, AFTER_DRAIN = false;
    bf16_t* proj; float* ssqv; int Mrows; const float* rowscale; const float* cscale;
    __device__ __forceinline__ void operator()(const f32x4 (&acc)[2][2][4][2], const Unit& u, int wr, int wc, int fr, int fq) const {
        const int which = (u.pn * BM) >> 10, colt = (u.pn * BM) & 1023; const float cs = *cscale;
        bf16_t* base = proj + (size_t)which * Mrows * 1024;
        const int row0 = u.pm * BM + wr * 64 + fr, col0 = colt + wc * 32 + 8 * fq;
#pragma unroll
        for (int ai = 0; ai < 2; ++ai)
#pragma unroll
            for (int m = 0; m < 4; ++m) { const int row = row0 + ai * HALF + m * 16; bf16_t* rowp = base + (size_t)row * 1024 + col0; float ss = 0.f; const float f = cs * rowscale[row];
#pragma unroll
                for (int bj = 0; bj < 2; ++bj) { f32x4 v0 = acc[ai][bj][m][0] * f, v1 = acc[ai][bj][m][1] * f;
                    if (which) {
#pragma unroll
                        for (int j = 0; j < 4; ++j) { v0[j] = gelu_tanh(v0[j]); v1[j] = gelu_tanh(v1[j]); } }
                    ss += (v0[0] * v0[0] + v0[1] * v0[1]) + (v0[2] * v0[2] + v0[3] * v0[3]) + (v1[0] * v1[0] + v1[1] * v1[1]) + (v1[2] * v1[2] + v1[3] * v1[3]);
                    u32x4 w; w.x = cvt_pk_bf16(v0[0], v0[1]); w.y = cvt_pk_bf16(v0[2], v0[3]); w.z = cvt_pk_bf16(v1[0], v1[1]); w.w = cvt_pk_bf16(v1[2], v1[3]);
                    *(u32x4*)(rowp + bj * HALF) = w; }
                if (which == 3) { ss += __shfl_xor(ss, 16); ss += __shfl_xor(ss, 32); if (fq == 0) ssqv[(size_t)row * 16 + (u.pn & 3) * 4 + wc] = ss; } }
    }
};
struct EpiX1 {
    static constexpr bool PERM = false, AFTER_DRAIN = false;
    const float* x; float* out; const float* modp; const float* bada; int goff, nmod, seq; const float* cscale; float cscale2;
    __device__ __forceinline__ void operator()(const f32x4 (&acc)[2][2][4][2], const Unit& u, int wr, int wc, int fr, int fq) const {
        const int row0 = u.pm * BM + wr * 64 + fr, col0 = u.pn * BM + wc * 32 + 4 * fq, b = (u.pm * BM) / seq;
        f32x4 gv[2][2];
#pragma unroll
        for (int bj = 0; bj < 2; ++bj)
#pragma unroll
            for (int n = 0; n < 2; ++n) { const int c = goff + col0 + bj * HALF + n * 16; f32x4 g = *(const f32x4*)(bada + c);
#pragma unroll
                for (int kc = 0; kc < 4; ++kc) g += *(const f32x4*)(modp + (size_t)(kc * 8 + b) * nmod + c);
                gv[bj][n] = g * (*cscale * cscale2); }
#pragma unroll
        for (int ai = 0; ai < 2; ++ai)
#pragma unroll
            for (int m = 0; m < 4; ++m) { const size_t off = (size_t)(row0 + ai * HALF + m * 16) * (size_t)(2048) + col0;
#pragma unroll
                for (int bj = 0; bj < 2; ++bj)
#pragma unroll
                    for (int n = 0; n < 2; ++n) { const f32x4 xv = *(const f32x4*)(x + off + bj * HALF + n * 16); *(f32x4*)(out + off + bj * HALF + n * 16) = xv + gv[bj][n] * acc[ai][bj][m][n]; } }
    }
};
struct EpiQ {
    static constexpr bool PERM = true, AFTER_DRAIN = false;
    bf16_t* O; int ldc;
    __device__ __forceinline__ void operator()(const f32x4 (&acc)[2][2][4][2], const Unit& u, int wr, int wc, int fr, int fq) const {
        const int row0 = u.pm * BM + wr * 64 + fr, col0 = u.pn * BM + wc * 32 + 8 * fq;
#pragma unroll
        for (int ai = 0; ai < 2; ++ai)
#pragma unroll
            for (int m = 0; m < 4; ++m) { bf16_t* rowp = O + (size_t)(row0 + ai * HALF + m * 16) * ldc + col0;
#pragma unroll
                for (int bj = 0; bj < 2; ++bj) { const f32x4 v0 = acc[ai][bj][m][0], v1 = acc[ai][bj][m][1];
                    u32x4 w; w.x = cvt_pk_bf16(v0[0], v0[1]); w.y = cvt_pk_bf16(v0[2], v0[3]); w.z = cvt_pk_bf16(v1[0], v1[1]); w.w = cvt_pk_bf16(v1[2], v1[3]);
                    *(u32x4*)(rowp + bj * HALF) = w; } }
    }
};

template <class Epi, class Sched, bool ALIGN_EPI = false, bool SP2 = false, bool FP8 = false>
__device__ __forceinline__ void gemm_phase(PG8_LAS unsigned char* lds, const Gemm g, const Sched& S, const Epi& E, int wv_) {
    const int tid = opaque_tid(), wid = __builtin_amdgcn_readfirstlane(tid >> 6), lane = tid & 63, wr = wid >> 2, wc = wid & 3, fr = lane & 15, fq = lane >> 4;
    const int K = g.K, nt = K / BK;
    unsigned voffA[2], voffB[2];
#pragma unroll
    for (int i = 0; i < 2; ++i) { int R, C; stage_rc(tid * 16 + i * 8192, R, C); const int Rb = Epi::PERM ? ((R & ~31) + perm32(R & 31)) : R;
        voffA[i] = (unsigned)(R * K + C) * 2u; voffB[i] = (unsigned)(Rb * K + C) * 2u; }
    const size_t kstep = (size_t)(BK * 2);
    const size_t hstep = (size_t)HALF * K * 2;
    const size_t tstep = 2 * hstep;
    const unsigned ldsw = (unsigned)wid * 1024u;
    const int aoff = lds_byte(wr * 64 + fr, fq * 8), boff = lds_byte(wc * 32 + fr, fq * 8);
#define PG8_SA(b, h) (((b) * 2 + (h)) * HTB)
#define PG8_SB(b, h) ((4 + (b) * 2 + (h)) * HTB)
#define PG8_STAGE(bufoff, gbase, voff) do { _Pragma("unroll") for (int _i = 0; _i < 2; ++_i) \
        __builtin_amdgcn_global_load_lds((const unsigned*)((const char*)(gbase) + (voff)[_i]), (PG8_LAS unsigned*)(lds + (bufoff) + ldsw + _i * 8192), 16, 0, 0); } while (0)
#define PG8_LDA(dst, b, h) do { _Pragma("unroll") for (int m = 0; m < 4; ++m) _Pragma("unroll") for (int k = 0; k < 2; ++k) dst[m][k] = *(const PG8_LAS bf16x8*)(lds + PG8_SA(b, h) + aoff + m * 2048 + k * 1024); } while (0)
#define PG8_LDB(dst, b, h) do { _Pragma("unroll") for (int n = 0; n < 2; ++n) _Pragma("unroll") for (int k = 0; k < 2; ++k) dst[n][k] = *(const PG8_LAS bf16x8*)(lds + PG8_SB(b, h) + boff + n * 2048 + k * 1024); } while (0)
#define PG8_MMA(ai, bj, At, Bt) do { __builtin_amdgcn_s_setprio(1); _Pragma("unroll") for (int m = 0; m < 4; ++m) _Pragma("unroll") for (int n = 0; n < 2; ++n) { \
        if constexpr (FP8) { typedef int v4i_ __attribute__((ext_vector_type(4))); typedef int v8i_ __attribute__((ext_vector_type(8))); \
            const v8i_ a8 = __builtin_shufflevector(__builtin_bit_cast(v4i_, Bt[n][0]), __builtin_bit_cast(v4i_, Bt[n][1]), 0, 1, 2, 3, 4, 5, 6, 7), b8 = __builtin_shufflevector(__builtin_bit_cast(v4i_, At[m][0]), __builtin_bit_cast(v4i_, At[m][1]), 0, 1, 2, 3, 4, 5, 6, 7); \
            asm volatile("v_mfma_scale_f32_16x16x128_f8f6f4 %0, %1, %2, %0, %3, %3 op_sel_hi:[0,0,0]" : "+v"(acc[ai][bj][m][n]) : "v"(a8), "v"(b8), "v"(one8)); } \
        else { _Pragma("unroll") for (int k = 0; k < 2; ++k) acc[ai][bj][m][n] = __builtin_amdgcn_mfma_f32_16x16x32_bf16(Bt[n][k], At[m][k], acc[ai][bj][m][n], 0, 0, 0); } } \
        __builtin_amdgcn_s_setprio(0); } while (0)
#define PG8_WAIT_V(n) asm volatile("s_waitcnt vmcnt(" #n ")" ::: "memory")
#define PG8_WAIT_L(n) asm volatile("s_waitcnt lgkmcnt(" #n ")" ::: "memory")
#define PG8_BAR __builtin_amdgcn_s_barrier()
#define PG8_SCHED __builtin_amdgcn_sched_barrier(0)
    Unit cur, nxt; int ui = 0;
    if (!S.next(0, cur)) return;
    f32x4 acc[2][2][4][2];
#pragma unroll
    for (int a = 0; a < 2; ++a)
#pragma unroll
        for (int b = 0; b < 2; ++b)
#pragma unroll
            for (int m = 0; m < 4; ++m)
#pragma unroll
                for (int n = 0; n < 2; ++n) acc[a][b][m][n] = (f32x4){0.f, 0.f, 0.f, 0.f};
    bf16x8 At[4][2], B0[2][2], B1[2][2];
    int one8 = 0x7F7F7F7F; asm volatile("" : "+v"(one8));
    const char* cA = (const char*)g.A + (size_t)cur.pm * tstep; const char* cB = (const char*)g.Bt + (size_t)cur.pn * tstep;
    S.a_ready(cur);
    if constexpr (SP2) {
        PG8_STAGE(PG8_SB(0, 0), cB, voffB); PG8_STAGE(PG8_SB(0, 1), cB + hstep, voffB); PG8_STAGE(PG8_SA(0, 0), cA, voffA); PG8_STAGE(PG8_SA(0, 1), cA + hstep, voffA);
        if (wr == 1) PG8_BAR;
        PG8_WAIT_V(2); PG8_BAR;
        PG8_STAGE(PG8_SB(1, 0), cB + kstep, voffB); PG8_STAGE(PG8_SA(1, 0), cA + kstep, voffA); PG8_STAGE(PG8_SB(1, 1), cB + hstep + kstep, voffB);
        PG8_WAIT_V(6); PG8_BAR;
    } else {
        PG8_STAGE(PG8_SB(0, 0), cB, voffB); PG8_STAGE(PG8_SA(0, 0), cA, voffA); PG8_STAGE(PG8_SB(0, 1), cB + hstep, voffB); PG8_STAGE(PG8_SA(0, 1), cA + hstep, voffA);
        if (wr == 1) PG8_BAR;
        PG8_WAIT_V(4); PG8_BAR;
        PG8_STAGE(PG8_SB(1, 0), cB + kstep, voffB); PG8_STAGE(PG8_SA(1, 0), cA + kstep, voffA); PG8_STAGE(PG8_SB(1, 1), cB + hstep + kstep, voffB);
        PG8_WAIT_V(6); PG8_BAR;
    }
    for (;;) {
        const bool has_next = S.next(ui + 1, nxt);
        const char* nA = has_next ? (const char*)g.A + (size_t)nxt.pm * tstep : cA; const char* nB = has_next ? (const char*)g.Bt + (size_t)nxt.pn * tstep : cB;
        for (int t = 0; t < nt; t += 2) {
            const bool last = (t == nt - 2);
            const char* a1 = cA + (size_t)(t + 1) * kstep;
            const char* a2 = last ? nA : cA + (size_t)(t + 2) * kstep; const char* b2 = last ? nB : cB + (size_t)(t + 2) * kstep;
            const char* a3 = a2 + kstep; const char* b3 = b2 + kstep;
            if (last && has_next) S.a_ready(nxt);
            if constexpr (SP2) {
            PG8_LDB(B0, 0, 0); PG8_LDB(B1, 0, 1); PG8_SCHED; PG8_LDA(At, 0, 0); PG8_STAGE(PG8_SA(1, 1), a1 + hstep, voffA);
            PG8_WAIT_V(8); PG8_WAIT_L(0); PG8_BAR; PG8_MMA(0, 0, At, B0); PG8_MMA(0, 1, At, B1); PG8_BAR; PG8_SCHED;
            PG8_LDA(At, 0, 1); PG8_STAGE(PG8_SB(0, 0), b2, voffB); PG8_STAGE(PG8_SB(0, 1), b2 + hstep, voffB); PG8_STAGE(PG8_SA(0, 0), a2, voffA);
            PG8_WAIT_V(8); PG8_WAIT_L(0); PG8_BAR; PG8_MMA(1, 0, At, B0); PG8_MMA(1, 1, At, B1); PG8_BAR; PG8_SCHED;
            PG8_LDB(B0, 1, 0); PG8_LDB(B1, 1, 1); PG8_SCHED; PG8_LDA(At, 1, 0); PG8_STAGE(PG8_SA(0, 1), a2 + hstep, voffA);
            PG8_WAIT_V(8); PG8_WAIT_L(0); PG8_BAR; PG8_MMA(0, 0, At, B0); PG8_MMA(0, 1, At, B1); PG8_BAR; PG8_SCHED;
            PG8_LDA(At, 1, 1); PG8_STAGE(PG8_SB(1, 0), b3, voffB); PG8_STAGE(PG8_SB(1, 1), b3 + hstep, voffB); PG8_STAGE(PG8_SA(1, 0), a3, voffA);
            PG8_WAIT_V(8); PG8_WAIT_L(0); PG8_BAR; PG8_MMA(1, 0, At, B0); PG8_MMA(1, 1, At, B1); PG8_BAR; PG8_SCHED;
            } else {
            PG8_LDB(B0, 0, 0); PG8_SCHED; PG8_LDA(At, 0, 0); PG8_STAGE(PG8_SA(1, 1), a1 + hstep, voffA);
            PG8_WAIT_L(8); PG8_BAR; PG8_WAIT_L(0); PG8_MMA(0, 0, At, B0); PG8_BAR; PG8_SCHED;
            PG8_LDB(B1, 0, 1); PG8_STAGE(PG8_SB(0, 0), b2, voffB);
            PG8_BAR; PG8_WAIT_L(0); PG8_MMA(0, 1, At, B1); PG8_BAR;
            PG8_LDA(At, 0, 1); PG8_STAGE(PG8_SA(0, 0), a2, voffA);
            PG8_BAR; PG8_WAIT_L(0); PG8_MMA(1, 0, At, B0); PG8_BAR; PG8_SCHED;
            PG8_STAGE(PG8_SB(0, 1), b2 + hstep, voffB);
            PG8_WAIT_V(6); PG8_BAR; PG8_MMA(1, 1, At, B1); PG8_BAR;
            PG8_LDB(B0, 1, 0); PG8_SCHED; PG8_LDA(At, 1, 0); PG8_STAGE(PG8_SA(0, 1), a2 + hstep, voffA);
            PG8_WAIT_L(8); PG8_BAR; PG8_WAIT_L(0); PG8_MMA(0, 0, At, B0); PG8_BAR; PG8_SCHED;
            PG8_LDB(B1, 1, 1); PG8_STAGE(PG8_SB(1, 0), b3, voffB);
            PG8_BAR; PG8_WAIT_L(0); PG8_MMA(0, 1, At, B1); PG8_BAR;
            PG8_LDA(At, 1, 1); PG8_STAGE(PG8_SA(1, 0), a3, voffA);
            PG8_BAR; PG8_WAIT_L(0); PG8_MMA(1, 0, At, B0); PG8_BAR; PG8_SCHED;
            PG8_STAGE(PG8_SB(1, 1), b3 + hstep, voffB);
            PG8_WAIT_V(6); PG8_BAR; PG8_MMA(1, 1, At, B1); PG8_BAR;
            }
        }
        if constexpr (FP8) {
            asm volatile("s_nop 15\n\ts_nop 7" ::: "memory");
#pragma unroll
            for (int a_ = 0; a_ < 2; ++a_)
#pragma unroll
                for (int b_ = 0; b_ < 2; ++b_)
#pragma unroll
                    for (int m_ = 0; m_ < 4; ++m_) asm volatile("" : "+v"(acc[a_][b_][m_][0]), "+v"(acc[a_][b_][m_][1]));
        }
        if constexpr (ALIGN_EPI) { if (wr == 0) PG8_BAR; }
        if constexpr (!Epi::AFTER_DRAIN) { E(acc, cur, wr, wc, fr, fq); S.done(cur); }
        if (!has_next) break;
#pragma unroll
        for (int a = 0; a < 2; ++a)
#pragma unroll
            for (int b = 0; b < 2; ++b)
#pragma unroll
                for (int m = 0; m < 4; ++m)
#pragma unroll
                    for (int n = 0; n < 2; ++n) acc[a][b][m][n] = (f32x4){0.f, 0.f, 0.f, 0.f};
        cur = nxt; cA = nA; cB = nB; ++ui;
        if constexpr (ALIGN_EPI) { if (wr == 1) PG8_BAR; }
    }
    PG8_WAIT_V(0);
    if constexpr (!ALIGN_EPI) { if (wr == 0) PG8_BAR; }
    PG8_BAR;
    if constexpr (Epi::AFTER_DRAIN) { E.fused(acc, cur, wr, wc, fr, fq, lds, wid, lane); S.done(cur); }
#undef PG8_SA
#undef PG8_SB
#undef PG8_STAGE
#undef PG8_LDA
#undef PG8_LDB
#undef PG8_MMA
#undef PG8_WAIT_V
#undef PG8_WAIT_L
#undef PG8_BAR
#undef PG8_SCHED
}
}

#define LAS __attribute__((address_space(3)))
__device__ __forceinline__ unsigned pk2(float lo, float hi) { return (unsigned)f2bf(lo) | ((unsigned)f2bf(hi) << 16); }
__device__ __forceinline__ void transpose_item(const float* W, int K, int N, bf16_t* WT, float* scr, int item, int lane) {
    const int nblk = N / 32, kb = item / nblk, nbk = item % nblk, k0 = 64 * kb, n0 = 32 * nbk;
#pragma unroll 8
    for (int i = 0; i < 32; ++i) { const int kk = 2 * i + (lane >> 5); scr[kk * 33 + (lane & 31)] = W[(size_t)(k0 + kk) * N + n0 + (lane & 31)]; }
    asm volatile("s_waitcnt lgkmcnt(0)" ::: "memory");
    const int c = lane & 7;
#pragma unroll
    for (int j = 0; j < 4; ++j) { const int n = (lane >> 3) + 8 * j; const float* s = scr + (8 * c) * 33 + n;
        uint4 o; o.x = pk2(s[0 * 33], s[1 * 33]); o.y = pk2(s[2 * 33], s[3 * 33]); o.z = pk2(s[4 * 33], s[5 * 33]); o.w = pk2(s[6 * 33], s[7 * 33]);
        *(uint4*)(WT + (size_t)(n0 + n) * K + k0 + 8 * c) = o; }
    asm volatile("s_waitcnt lgkmcnt(0)" ::: "memory");
}
constexpr int CW_AMAX_WIN = 2048, CW_AMAX_WOUT = 2112, CW_WSCALE = 2176;
__device__ __forceinline__ void phase_amax(KP p, int bid, int nb, int wv_) {
    const int tid = opaque_tid(), lane = tid & 63;
    for (int t = 0; t < 2; ++t) {
        const float4* w = (const float4*)(t ? p->in[I_WOUT] : p->in[I_WIN]); const size_t n4 = (size_t)D * (t ? D : NPROJ) / 4;
        float am = 0.f;
        for (size_t i = (size_t)bid * NT + tid; i < n4; i += (size_t)nb * NT) { const float4 v = w[i]; am = fmaxf(am, fmaxf(fmaxf(fabsf(v.x), fabsf(v.y)), fmaxf(fabsf(v.z), fabsf(v.w)))); }
        am = wave_max(am);
        if (lane == 0) atomicMax((unsigned*)(p->ws + WS_CTL) + (t ? CW_AMAX_WOUT : CW_AMAX_WIN), __float_as_uint(am));
    }
}
__device__ __forceinline__ void transpose_item8(const float* W, int K, int N, unsigned char* WT, float* scr, int item, int lane, float sc) {
    const int nblk = N / 32, kb = item / nblk, nbk = item % nblk, k0 = 64 * kb, n0 = 32 * nbk;
#pragma unroll 8
    for (int i = 0; i < 32; ++i) { const int kk = 2 * i + (lane >> 5); scr[kk * 33 + (lane & 31)] = W[(size_t)(k0 + kk) * N + n0 + (lane & 31)]; }
    asm volatile("s_waitcnt lgkmcnt(0)" ::: "memory");
    const int c = lane & 3;
#pragma unroll
    for (int j = 0; j < 2; ++j) { const int n = (lane >> 2) + 16 * j; const float* s = scr + (16 * c) * 33 + n;
        uint4 o; o.x = pk4_fp8(s[0 * 33] * sc, s[1 * 33] * sc, s[2 * 33] * sc, s[3 * 33] * sc); o.y = pk4_fp8(s[4 * 33] * sc, s[5 * 33] * sc, s[6 * 33] * sc, s[7 * 33] * sc);
        o.z = pk4_fp8(s[8 * 33] * sc, s[9 * 33] * sc, s[10 * 33] * sc, s[11 * 33] * sc); o.w = pk4_fp8(s[12 * 33] * sc, s[13 * 33] * sc, s[14 * 33] * sc, s[15 * 33] * sc);
        *(uint4*)(WT + (size_t)(n0 + n) * K + k0 + 16 * c) = o; }
    asm volatile("s_waitcnt lgkmcnt(0)" ::: "memory");
}
__device__ __forceinline__ void phase_convert_weights8(KP p, float* lds, int bid, int nb, int wv_) {
    const int tid = opaque_tid(), lane = tid & 63, wave = tid >> 6;
    float* scr = lds + 4096 + wave * (64 * 33);
    const unsigned* ctl = (const unsigned*)(p->ws + WS_CTL);
    const float sc_in = pow2_scale_from_max(__uint_as_float(__hip_atomic_load(ctl + CW_AMAX_WIN, __ATOMIC_RELAXED, __HIP_MEMORY_SCOPE_AGENT))), sc_out = pow2_scale_from_max(__uint_as_float(__hip_atomic_load(ctl + CW_AMAX_WOUT, __ATOMIC_RELAXED, __HIP_MEMORY_SCOPE_AGENT)));
    if (bid == 0 && tid == 0) { ((float*)(p->ws + WS_CTL))[CW_WSCALE] = 1.f / sc_in; ((float*)(p->ws + WS_CTL))[CW_WSCALE + 1] = 1.f / sc_out; }
    const int gw = bid * 8 + wave, ngw = nb * 8;
    constexpr int I_IN = (D / 64) * (NPROJ / 32), I_SQ = (D / 64) * (D / 32);
    for (int it = gw; it < I_IN + I_SQ; it += ngw) {
        if (it < I_IN) transpose_item8(p->in[I_WIN], D, NPROJ, p->ws + WS_WIN_T, scr, it, lane, sc_in);
        else transpose_item8(p->in[I_WOUT], D, D, p->ws + WS_WOUT_T, scr, it - I_IN, lane, sc_out);
    }
}
__device__ __forceinline__ void phase_convert_weights(KP p, float* lds, int bid, int nb, int wv_) {
    const int tid = opaque_tid(), lane = tid & 63, wave = tid >> 6;
    float* scr = lds + wave * (64 * 33);
    const int gw = bid * 8 + wave, ngw = nb * 8;
    constexpr int I_SQ = (D / 64) * (D / 32), I_G = 8 * (128 / 64) * (128 / 32);
    constexpr int NITEMS = I_SQ + 2 * I_G;
    for (int it = gw; it < NITEMS; it += ngw) {
        int r = it;
        if (r < I_SQ) { transpose_item(p->in[I_WQ], D, D, (bf16_t*)(p->ws + WS_WQ_T), scr, r, lane); continue; } r -= I_SQ;
        if (r < I_G) { const int hd = r / 8; transpose_item(p->in[I_WGA] + hd * 16384, 128, 128, (bf16_t*)(p->ws + WS_WGA_T) + hd * 16384, scr, r % 8, lane); continue; } r -= I_G;
        { const int hd = r / 8; transpose_item(p->in[I_WGI] + hd * 16384, 128, 128, (bf16_t*)(p->ws + WS_WGI_T) + hd * 16384, scr, r % 8, lane); }
    }
    bf16_t* wsp = (bf16_t*)(p->ws + WS_WSPB); bf16_t* skb = (bf16_t*)(p->ws + WS_SKEYB);
    for (int e = bid * NT + tid; e < 8 * 128 * 128; e += nb * NT) { const int i = (e >> 7) & 127, j = e & 127; wsp[e] = f2bf(j <= i ? p->in[I_WSP][e] : 0.f); }
    for (int e = bid * NT + tid; e < 8 * 2 * 128 * 128; e += nb * NT) skb[e] = f2bf(p->in[I_SKEY][e]);
}

typedef short bf16x8_t __attribute__((ext_vector_type(8)));
typedef float f32x4_t __attribute__((ext_vector_type(4)));
typedef short s16x4_t __attribute__((ext_vector_type(4)));
constexpr float YMIX_SCALE = 8.f;
constexpr int XA_STRIDE = 272;
constexpr int LRU_XA = 0, LRU_SA = 34816, LRU_SB = LRU_SA + 16384, LRU_SEGP = LRU_SB + 16384, LRU_SEGH = LRU_SEGP + 2048;
__device__ __forceinline__ void phase_lru(KP p, unsigned char* lds, int bid, int nb, int wv_) {
    const int tid = opaque_tid(), lane = tid & 63, wave = tid >> 6, c16 = lane & 15, q = lane >> 4;
    const bf16_t* XL = (const bf16_t*)(p->ws + WS_PROJ); const bf16_t* YG = XL + (size_t)M * 1024; bf16_t* ymix = (bf16_t*)(p->ws + WS_YMIX);
    float* SA = (float*)(lds + LRU_SA); float* SB = (float*)(lds + LRU_SB); float* SEGP = (float*)(lds + LRU_SEGP); float* SEGH = (float*)(lds + LRU_SEGH);
    for (int unit = bid; unit < NB * 8 * 4; unit += nb) {
        const int b = unit >> 5, hd = (unit >> 2) & 7, cq = unit & 3;
        bf16x8_t wf[2][2][4];
#pragma unroll
        for (int gs = 0; gs < 2; ++gs)
#pragma unroll
            for (int nt = 0; nt < 2; ++nt)
#pragma unroll
                for (int ks = 0; ks < 4; ++ks)
                    wf[gs][nt][ks] = *(const bf16x8_t*)((const bf16_t*)(p->ws + (gs ? WS_WGI_T : WS_WGA_T)) + ((size_t)(hd * 128 + cq * 32 + nt * 16 + c16) * 128 + ks * 32 + 8 * q));
        float ba[2], bi[2], c2[2];
#pragma unroll
        for (int nt = 0; nt < 2; ++nt) { const int ch = hd * 128 + cq * 32 + nt * 16 + c16; ba[nt] = p->in[I_BGA][ch]; bi[nt] = p->in[I_BGI][ch];
            const float lam = p->in[I_LAM][ch]; const float sp = fmaxf(-lam, 0.f) + log1pf(__expf(-fabsf(lam))); c2[nt] = -8.f * sp * 1.4426950408889634f; }
        const int o = tid & 15, rg = tid >> 4;
        float cw[4][8], cb[8];
#pragma unroll
        for (int e = 0; e < 8; ++e) { cb[e] = p->in[I_CONVB][hd * 128 + o * 8 + e];
#pragma unroll
            for (int k = 0; k < 4; ++k) cw[k][e] = p->in[I_CONVW][k * DLRU + hd * 128 + o * 8 + e]; }
        const int sc = tid & 31, seg = tid >> 5;
        float carry = 0.f;
        for (int ch = 0; ch < SEQ / 128; ++ch) {
            const int t0 = ch * 128; const size_t row0 = (size_t)b * SEQ + t0;
            bf16_t yg[8];
#pragma unroll
            for (int k = 0; k < 8; ++k) yg[k] = YG[(row0 + seg * 8 + k) * 1024 + hd * 128 + cq * 32 + sc];
            uint4 xr[7];
#pragma unroll
            for (int i = 0; i < 7; ++i) { const int t = t0 + 4 * rg - 3 + i; const int tc = t < 0 ? 0 : t; const unsigned keep = t < 0 ? 0u : 0xffffffffu;
                const uint4 w = *(const uint4*)(XL + ((size_t)b * SEQ + tc) * 1024 + hd * 128 + o * 8); xr[i] = make_uint4(w.x & keep, w.y & keep, w.z & keep, w.w & keep); }
#pragma unroll
            for (int r = 0; r < 4; ++r) {
                float acc8[8];
#pragma unroll
                for (int e = 0; e < 8; ++e) acc8[e] = cb[e];
#pragma unroll
                for (int k = 0; k < 4; ++k) { const uint4 w = xr[r + k]; const unsigned ww[4] = {w.x, w.y, w.z, w.w};
#pragma unroll
                    for (int e2 = 0; e2 < 4; ++e2) { acc8[2 * e2] += cw[k][2 * e2] * __uint_as_float(ww[e2] << 16); acc8[2 * e2 + 1] += cw[k][2 * e2 + 1] * __uint_as_float(ww[e2] & 0xffff0000u); } }
                uint4 ov; ov.x = pk2(acc8[0], acc8[1]); ov.y = pk2(acc8[2], acc8[3]); ov.z = pk2(acc8[4], acc8[5]); ov.w = pk2(acc8[6], acc8[7]);
                *(uint4*)(lds + LRU_XA + (4 * rg + r) * XA_STRIDE + o * 16) = ov;
            }
            __syncthreads();
            f32x4_t acc[2][2];
#pragma unroll
            for (int gs = 0; gs < 2; ++gs)
#pragma unroll
                for (int nt = 0; nt < 2; ++nt) acc[gs][nt] = (f32x4_t){0.f, 0.f, 0.f, 0.f};
#pragma unroll
            for (int ks = 0; ks < 4; ++ks) {
                const bf16x8_t a = *(const bf16x8_t*)(lds + LRU_XA + (16 * wave + c16) * XA_STRIDE + (ks * 32 + 8 * q) * 2);
#pragma unroll
                for (int gs = 0; gs < 2; ++gs)
#pragma unroll
                    for (int nt = 0; nt < 2; ++nt) acc[gs][nt] = __builtin_amdgcn_mfma_f32_16x16x32_bf16(a, wf[gs][nt][ks], acc[gs][nt], 0, 0, 0);
            }
#pragma unroll
            for (int nt = 0; nt < 2; ++nt)
#pragma unroll
                for (int reg = 0; reg < 4; ++reg) {
                    const int t = 16 * wave + 4 * q + reg, jj = nt * 16 + c16;
                    const float za = acc[0][nt][reg] + ba[nt], zi = acc[1][nt][reg] + bi[nt];
                    const float r = __builtin_amdgcn_rcpf(1.f + __expf(-za)), ig = __builtin_amdgcn_rcpf(1.f + __expf(-zi));
                    const float a = __builtin_amdgcn_exp2f(c2[nt] * r);
                    const float xcv = bf2f(*(const bf16_t*)(lds + LRU_XA + t * XA_STRIDE + (cq * 32 + jj) * 2));
                    SA[t * 32 + jj] = a; SB[t * 32 + jj] = __builtin_amdgcn_sqrtf(fmaxf(1.f - a * a, 0.f)) * (ig * xcv);
                }
            __syncthreads();
            float av[8], bv[8];
#pragma unroll
            for (int k = 0; k < 8; ++k) { av[k] = SA[(seg * 8 + k) * 32 + sc]; bv[k] = SB[(seg * 8 + k) * 32 + sc]; }
            float P = 1.f, H = 0.f;
#pragma unroll
            for (int k = 0; k < 8; ++k) { H = av[k] * H + bv[k]; P *= av[k]; }
            SEGP[seg * 32 + sc] = P; SEGH[seg * 32 + sc] = H;
            __syncthreads();
            float run = carry, hin = carry;
            int segl = seg; asm volatile("" : "+v"(segl));
#pragma unroll
            for (int s = 0; s < 16; ++s) { if (s == segl) hin = run; run = SEGP[s * 32 + sc] * run + SEGH[s * 32 + sc]; }
            carry = run;
            H = hin;
#pragma unroll
            for (int k = 0; k < 8; ++k) { H = av[k] * H + bv[k]; ((unsigned char*)ymix)[(row0 + seg * 8 + k) * D + hd * 128 + cq * 32 + sc] = (unsigned char)(pk4_fp8(H * bf2f(yg[k]) * YMIX_SCALE, 0.f, 0.f, 0.f) & 0xffu); }
        }
        __syncthreads();
    }
}

constexpr int SGU_RS = 0, SGU_TV = 512, SGU_SS = SGU_TV + 128 * XA_STRIDE, SS_STRIDE = 132;
__device__ __forceinline__ void phase_sgu(KP p, unsigned char* lds, int bid, int nb, int wv_) {
    const int tid = opaque_tid(), lane = tid & 63, wave = tid >> 6, c16 = lane & 15, q = lane >> 4;
    const bf16_t* UG = (const bf16_t*)(p->ws + WS_PROJ) + (size_t)2 * M * 1024; const bf16_t* VG = UG + (size_t)M * 1024;
    const float* ssqv = (const float*)(p->ws + WS_SSQV); bf16_t* ymix = (bf16_t*)(p->ws + WS_YMIX);
    float* RS = (float*)(lds + SGU_RS); float* SS = (float*)(lds + SGU_SS);
    bf16x8_t wa[8][4]; float gvv[8]; int gcur = -1;
    const int oct = tid & 15;
    for (int it = bid; it < NB * 16 * 8; it += nb) {
        const int g = it & 7; const size_t base = (size_t)(it >> 3) * 128;
        if (g != gcur) { gcur = g;
#pragma unroll
            for (int mt = 0; mt < 8; ++mt)
#pragma unroll
                for (int ks = 0; ks < 4; ++ks) if (ks <= ((16 * mt + 15) >> 5))
                    wa[mt][ks] = *(const bf16x8_t*)((const bf16_t*)(p->ws + WS_WSPB) + ((size_t)(g * 128 + mt * 16 + c16) * 128 + ks * 32 + 8 * q));
#pragma unroll
            for (int e = 0; e < 8; ++e) gvv[e] = p->in[I_GV][g * 128 + oct * 8 + e]; }
        uint4 vch[4], uch[4];
#pragma unroll
        for (int k = 0; k < 4; ++k) { const int row = (tid >> 4) + 32 * k; vch[k] = *(const uint4*)(VG + (base + row) * 1024 + g * 128 + oct * 8); uch[k] = *(const uint4*)(UG + (base + row) * 1024 + g * 128 + oct * 8); }
        if (tid < 128) { float ss = 0.f;
#pragma unroll
            for (int k = 0; k < 16; ++k) ss += ssqv[(base + tid) * 16 + k];
            RS[tid] = rsqrtf(ss * (1.f / 1024.f) + EPS); }
        __syncthreads();
#pragma unroll
        for (int k = 0; k < 4; ++k) { const int row = (tid >> 4) + 32 * k; const float r = RS[row]; const unsigned ww[4] = {vch[k].x, vch[k].y, vch[k].z, vch[k].w}; unsigned oo[4];
#pragma unroll
            for (int e2 = 0; e2 < 4; ++e2) oo[e2] = pk2(__uint_as_float(ww[e2] << 16) * r * gvv[2 * e2], __uint_as_float(ww[e2] & 0xffff0000u) * r * gvv[2 * e2 + 1]);
            *(uint4*)(lds + SGU_TV + row * XA_STRIDE + oct * 16) = make_uint4(oo[0], oo[1], oo[2], oo[3]); }
        __syncthreads();
        bf16x8_t bfr[4];
        { const int q4 = c16 >> 2, p4 = c16 & 3;
#pragma unroll
          for (int ks = 0; ks < 4; ++ks) {
              const unsigned a1 = SGU_TV + (ks * 32 + 8 * q + q4) * XA_STRIDE + (wave * 16 + 4 * p4) * 2;
              const s16x4_t lo = __builtin_amdgcn_ds_read_tr16_b64_v4i16((LAS s16x4_t*)(lds + a1));
              const s16x4_t hi = __builtin_amdgcn_ds_read_tr16_b64_v4i16((LAS s16x4_t*)(lds + a1 + 4 * XA_STRIDE));
              bfr[ks] = __builtin_shufflevector(lo, hi, 0, 1, 2, 3, 4, 5, 6, 7); } }
        f32x4_t acc[8];
#pragma unroll
        for (int mt = 0; mt < 8; ++mt) { acc[mt] = (f32x4_t){0.f, 0.f, 0.f, 0.f};
#pragma unroll
            for (int ks = 0; ks < 4; ++ks) if (ks <= ((16 * mt + 15) >> 5)) acc[mt] = __builtin_amdgcn_mfma_f32_16x16x32_bf16(wa[mt][ks], bfr[ks], acc[mt], 0, 0, 0); }
#pragma unroll
        for (int mt = 0; mt < 8; ++mt)
#pragma unroll
            for (int reg = 0; reg < 4; ++reg) { const int i = mt * 16 + 4 * q + reg; SS[i * SS_STRIDE + wave * 16 + c16] = acc[mt][reg] + p->in[I_BSP][g * 128 + i]; }
        __syncthreads();
#pragma unroll
        for (int k = 0; k < 4; ++k) { const int row = (tid >> 4) + 32 * k; const float4 s0 = *(const float4*)(SS + row * SS_STRIDE + oct * 8), s1 = *(const float4*)(SS + row * SS_STRIDE + oct * 8 + 4);
            const unsigned ww[4] = {uch[k].x, uch[k].y, uch[k].z, uch[k].w}; const float sv[8] = {s0.x, s0.y, s0.z, s0.w, s1.x, s1.y, s1.z, s1.w}; unsigned oo[4];
#pragma unroll
            for (int e2 = 0; e2 < 2; ++e2) oo[e2] = pk4_fp8(__uint_as_float(ww[2 * e2] << 16) * sv[4 * e2] * YMIX_SCALE, __uint_as_float(ww[2 * e2] & 0xffff0000u) * sv[4 * e2 + 1] * YMIX_SCALE,
                                                          __uint_as_float(ww[2 * e2 + 1] << 16) * sv[4 * e2 + 2] * YMIX_SCALE, __uint_as_float(ww[2 * e2 + 1] & 0xffff0000u) * sv[4 * e2 + 3] * YMIX_SCALE);
            *(uint2*)((unsigned char*)ymix + (base + row) * D + 1024 + g * 128 + oct * 8) = make_uint2(oo[0], oo[1]); }
        __syncthreads();
    }
}

typedef float f32x16_t __attribute__((ext_vector_type(16)));
__device__ __forceinline__ float vmaxf(float a, float b) { float r; asm("v_max_f32 %0, %1, %2" : "=v"(r) : "v"(a), "v"(b)); return r; }
__device__ __forceinline__ float vminf(float a, float b) { float r; asm("v_min_f32 %0, %1, %2" : "=v"(r) : "v"(a), "v"(b)); return r; }
#define CE_DESC(a, b) do { const float _mx = vmaxf(a, b), _mn = vminf(a, b); a = _mx; b = _mn; } while (0)
__device__ __forceinline__ void sort16_desc(float (&v)[16]) {
#pragma unroll
    for (int k = 2; k <= 16; k <<= 1)
#pragma unroll
        for (int j = k >> 1; j > 0; j >>= 1)
#pragma unroll
            for (int i = 0; i < 16; ++i) { const int l = i ^ j; if (l > i) { if ((i & k) == 0) CE_DESC(v[i], v[l]); else CE_DESC(v[l], v[i]); } }
}
__device__ __forceinline__ void merge16_desc(float (&a)[16], const float (&b)[16]) {
#pragma unroll
    for (int i = 0; i < 16; ++i) a[i] = vmaxf(a[i], b[15 - i]);
#pragma unroll
    for (int j = 8; j > 0; j >>= 1)
#pragma unroll
        for (int i = 0; i < 16; ++i) { const int l = i ^ j; if (l > i) CE_DESC(a[i], a[l]); }
}
__device__ __forceinline__ void topk_half(const bf16_t* qp, const unsigned char* kl, unsigned hh4, float (&X)[16]) {
    f32x16_t acc[4];
#pragma unroll
    for (int kt = 0; kt < 4; ++kt)
#pragma unroll
        for (int i = 0; i < 16; ++i) acc[kt][i] = 0.f;
#pragma unroll 4
    for (int ks = 0; ks < 8; ++ks) {
        const bf16x8_t bq = *(const bf16x8_t*)(qp + ks * 16);
#pragma unroll
        for (int kt = 0; kt < 4; ++kt) { const bf16x8_t ak = *(const bf16x8_t*)(kl + kt * 32 * XA_STRIDE + ks * 32); acc[kt] = __builtin_amdgcn_mfma_f32_32x32x16_bf16(ak, bq, acc[kt], 0, 0, 0); }
    }
    float g[4][16];
#pragma unroll
    for (int kt = 0; kt < 4; ++kt)
#pragma unroll
        for (int reg = 0; reg < 16; ++reg) g[kt][reg] = __uint_as_float(((__float_as_uint(acc[kt][reg]) & 0xFFFFFF80u) | hh4) | (unsigned)(kt * 32 + (reg & 3) + 8 * (reg >> 2)));
    sort16_desc(g[0]); sort16_desc(g[1]); __builtin_amdgcn_sched_barrier(0); merge16_desc(g[0], g[1]); __builtin_amdgcn_sched_barrier(0);
    sort16_desc(g[2]); sort16_desc(g[3]); __builtin_amdgcn_sched_barrier(0); merge16_desc(g[2], g[3]); __builtin_amdgcn_sched_barrier(0); merge16_desc(g[0], g[2]);
#pragma unroll
    for (int i = 0; i < 16; ++i) X[i] = g[0][i];
}
__device__ __forceinline__ unsigned pack_b0(float a, float b, float c, float d) {
    const unsigned ab = __builtin_amdgcn_perm(__float_as_uint(b), __float_as_uint(a), 0x0c0c0400u), cd = __builtin_amdgcn_perm(__float_as_uint(d), __float_as_uint(c), 0x0c0c0400u);
    return __builtin_amdgcn_perm(cd, ab, 0x05040100u);
}
__device__ __forceinline__ unsigned byte_lookup(const unsigned (&pk)[4], unsigned e) {
    const unsigned lo = __builtin_amdgcn_perm(pk[1], pk[0], e & 7u), hi = __builtin_amdgcn_perm(pk[3], pk[2], e & 7u);
    return ((e & 8u) ? hi : lo) & 0x7Fu;
}
__device__ __forceinline__ void phase_topk(KP p, unsigned char* lds, int bid, int nb, int wv_) {
    const int tid = opaque_tid(), lane = tid & 63, wave = tid >> 6, r32 = lane & 31, hh = lane >> 5;
    const bf16_t* Q = (const bf16_t*)(p->ws + WS_Q); const bf16_t* KB = (const bf16_t*)(p->ws + WS_SKEYB);
    int* idx = (int*)(p->ws + WS_IDX); float* gate = (float*)(p->ws + WS_GATE);
    const float NEG = -3.0e38f;
    int hcur = -1;
    for (int bi = bid; bi < NHEAD * (M / 256); bi += nb) {
        const int hd = bi & 7, tile = (bi >> 3) * 8 + wave; const size_t token = (size_t)tile * 32 + r32;
        if (hd != hcur) { hcur = hd; __syncthreads();
#pragma unroll
            for (int k = 0; k < 8; ++k) { const int c = tid + NT * k, row = c >> 4, o = c & 15;
                *(uint4*)(lds + row * XA_STRIDE + o * 16) = *(const uint4*)(KB + ((size_t)hd * 256 + row) * 128 + o * 8); }
            __syncthreads(); }
        float X0[16], X1[16];
        topk_half(Q + token * D + hd * 256 + 8 * hh, lds + r32 * XA_STRIDE + hh * 16, 4u * hh, X0);
        __builtin_amdgcn_sched_barrier(0);
        topk_half(Q + token * D + hd * 256 + 128 + 8 * hh, lds + (128 + r32) * XA_STRIDE + hh * 16, 4u * hh, X1);
        __builtin_amdgcn_sched_barrier(0);
#pragma unroll
        for (int i = 0; i < 16; ++i) { const auto r = __builtin_amdgcn_permlane32_swap(__float_as_uint(X0[i]), __float_as_uint(X1[i]), false, false); X0[i] = __uint_as_float(r[0]); X1[i] = __uint_as_float(r[1]); }
        merge16_desc(X0, X1);
        float U[16];
#pragma unroll
        for (int i = 0; i < 16; ++i) U[i] = __shfl_xor(X0[i], 32);
        const unsigned hbit = (unsigned)hh << 8;
        float c0[16], c1[16];
#pragma unroll
        for (int j = 0; j < 16; ++j) { float s = X0[0] + U[j]; if (j == 0) s = hh ? NEG : s; c0[j] = __uint_as_float(((__float_as_uint(s) & 0xFFFFFE00u) | hbit) | (unsigned)j); }
        {
            int n = 0;
#pragma unroll
            for (int i = 1; i < 4; ++i)
#pragma unroll
                for (int j = i; j < 16; ++j) if ((i + 1) * (j + 1) <= 16) { float s = X0[i] + U[j]; if (j == i) s = hh ? NEG : s; c1[n] = __uint_as_float(((__float_as_uint(s) & 0xFFFFFE00u) | hbit) | (unsigned)(i * 16 + j)); ++n; }
#pragma unroll
            for (int k = 11; k < 16; ++k) c1[k] = NEG;
        }
        sort16_desc(c0); sort16_desc(c1); merge16_desc(c0, c1);
        float F[16];
#pragma unroll
        for (int i = 0; i < 16; ++i) F[i] = vmaxf(c0[i], __shfl_xor(c0[15 - i], 32));
        float mx = F[0];
#pragma unroll
        for (int i = 1; i < 16; ++i) mx = vmaxf(mx, F[i]);
        float ev[16], sum = 0.f;
#pragma unroll
        for (int i = 0; i < 16; ++i) { ev[i] = __expf(F[i] - mx); sum += ev[i]; }
        const float inv = 1.f / sum;
        unsigned pt[4], pu[4], pa[4], pb[4];
#pragma unroll
        for (int w = 0; w < 4; ++w) { pt[w] = pack_b0(X0[4 * w], X0[4 * w + 1], X0[4 * w + 2], X0[4 * w + 3]); pu[w] = pack_b0(U[4 * w], U[4 * w + 1], U[4 * w + 2], U[4 * w + 3]); }
#pragma unroll
        for (int w = 0; w < 4; ++w) { pa[w] = hh ? pu[w] : pt[w]; pb[w] = hh ? pt[w] : pu[w]; }
        int oi[8]; float og[8];
#pragma unroll
        for (int k = 0; k < 8; ++k) {
            const unsigned pl = __float_as_uint(F[k]) & 0x1FFu, sw = pl >> 8, pi = (pl >> 4) & 15u, pj = pl & 15u;
            const unsigned ai = sw ? pj : pi, bj = sw ? pi : pj;
            oi[k] = (int)(byte_lookup(pa, ai) * NKEYS + byte_lookup(pb, bj)); og[k] = ev[k] * inv;
        }
        int* io = idx + token * NSEL + hd * TOPK + 8 * hh; float* go = gate + token * NSEL + hd * TOPK + 8 * hh;
        *(int4*)io = make_int4(oi[0], oi[1], oi[2], oi[3]); *(int4*)(io + 4) = make_int4(oi[4], oi[5], oi[6], oi[7]);
        *(float4*)go = make_float4(og[0], og[1], og[2], og[3]); *(float4*)(go + 4) = make_float4(og[4], og[5], og[6], og[7]);
    }
}

__device__ __forceinline__ void wave_argmax(float& v, int& i) {
#pragma unroll
    for (int off = 32; off >= 1; off >>= 1) { const float ov = __shfl_xor(v, off); const int oi = __shfl_xor(i, off); if (ov > v || (ov == v && oi < i)) { v = ov; i = oi; } }
}
__device__ __forceinline__ void topk_half_naive(const bf16_t* q, const float* k0, int lane, float& outv, int& outi) {
    const float NEG = -3.0e38f;
    const float* k1 = k0 + 64 * 128;
    float s0 = 0.f, s1 = 0.f;
    for (int k = 0; k < 128; k += 4) {
        const uint2 qq = *(const uint2*)(q + k);
        const float q0 = bf2f((bf16_t)(qq.x & 0xffff)), q1 = bf2f((bf16_t)(qq.x >> 16)), q2 = bf2f((bf16_t)(qq.y & 0xffff)), q3 = bf2f((bf16_t)(qq.y >> 16));
        const float4 a = *(const float4*)(k0 + k), b = *(const float4*)(k1 + k);
        s0 += q0 * a.x + q1 * a.y + q2 * a.z + q3 * a.w; s1 += q0 * b.x + q1 * b.y + q2 * b.z + q3 * b.w;
    }
    float myv = NEG; int myi = 0;
    for (int r = 0; r < TOPK; ++r) {
        float v; int i; if (s0 >= s1) { v = s0; i = lane; } else { v = s1; i = lane + 64; }
        wave_argmax(v, i);
        if (i == lane) s0 = NEG; if (i == lane + 64) s1 = NEG;
        if (lane == r) { myv = v; myi = i; }
    }
    outv = myv; outi = myi;
}
__device__ __forceinline__ void phase_topk_naive(KP p, int bid, int nb, int wv_) {
    const bf16_t* Q = (const bf16_t*)(p->ws + WS_Q); const float* keys = p->in[I_SKEY];
    int* idx = (int*)(p->ws + WS_IDX); float* gate = (float*)(p->ws + WS_GATE);
    const int tid = opaque_tid(), lane = tid & 63, wave = tid >> 6;
    const float NEG = -3.0e38f;
    for (int task = bid * 8 + wave; task < M * NHEAD; task += nb * 8) {
        const int token = task >> 3, hd = task & 7;
        float tv0, tv1; int ti0, ti1;
        topk_half_naive(Q + (size_t)token * D + hd * 256, keys + ((size_t)(hd * 2) * 128 + lane) * 128, lane, tv0, ti0);
        topk_half_naive(Q + (size_t)token * D + hd * 256 + 128, keys + ((size_t)(hd * 2 + 1) * 128 + lane) * 128, lane, tv1, ti1);
        const float vb = __shfl(tv1, lane & 15);
        float c0 = __shfl(tv0, (lane >> 4)) + vb, c1 = __shfl(tv0, (lane >> 4) + 4) + vb, c2 = __shfl(tv0, (lane >> 4) + 8) + vb, c3 = __shfl(tv0, (lane >> 4) + 12) + vb;
        float selv = NEG; int selc = 0;
        for (int r = 0; r < TOPK; ++r) {
            float v = c0; int i = lane;
            if (c1 > v) { v = c1; i = lane + 64; }
            if (c2 > v) { v = c2; i = lane + 128; }
            if (c3 > v) { v = c3; i = lane + 192; }
            wave_argmax(v, i);
            if (i == lane) c0 = NEG; if (i == lane + 64) c1 = NEG; if (i == lane + 128) c2 = NEG; if (i == lane + 192) c3 = NEG;
            if (lane == r) { selv = v; selc = i; }
        }
        const float mx = __shfl(selv, 0);
        const float e = lane < TOPK ? __expf(selv - mx) : 0.f;
        const float sum = wave_sum(e);
        const int i1 = __shfl(ti0, selc >> 4), i2 = __shfl(ti1, selc & 15);
        if (lane < TOPK) { idx[(size_t)token * NSEL + hd * TOPK + lane] = i1 * NKEYS + i2; gate[(size_t)token * NSEL + hd * TOPK + lane] = e / sum; }
    }
}

typedef float f32x2_t __attribute__((ext_vector_type(2)));
constexpr size_t GRP_BYTES = (size_t)NKEYS * NKEYS * 128;
constexpr int NGRP = D / 128;
__device__ __forceinline__ void phase_convert_experts(KP p, int bid, int nb, int wv_) {
    const int tid = opaque_tid(), lane = tid & 63, wave = tid >> 6;
    for (int row = bid * 8 + wave; row < 2 * NKEYS * NKEYS; row += nb * 8) {
        const int t = row >= NKEYS * NKEYS, e = row - t * NKEYS * NKEYS;
        const float* src = (t ? p->in[I_EV] : p->in[I_EU]) + (size_t)e * D;
        unsigned char* dst = p->ws + (t ? WS_EV8 : WS_EU8) + (size_t)e * 128 + (size_t)(lane >> 5) * GRP_BYTES + (lane & 31) * 4;
        float4 v[8]; float am = 0.f;
#pragma unroll
        for (int j = 0; j < 8; ++j) { v[j] = *(const float4*)(src + lane * 4 + 256 * j); am = fmaxf(am, fmaxf(fmaxf(fabsf(v[j].x), fabsf(v[j].y)), fmaxf(fabsf(v[j].z), fabsf(v[j].w)))); }
        am = wave_max(am);
        int ex = 0; if (am > 0.f) (void)frexpf(am, &ex); else ex = 8;
        const float sc = ldexpf(1.f, 8 - ex);
#pragma unroll
        for (int j = 0; j < 8; ++j) { int w = __builtin_amdgcn_cvt_pk_fp8_f32(v[j].x * sc, v[j].y * sc, 0, false); w = __builtin_amdgcn_cvt_pk_fp8_f32(v[j].z * sc, v[j].w * sc, w, true); *(unsigned*)(dst + (size_t)(2 * j) * GRP_BYTES) = (unsigned)w; }
        if (lane == 0) ((float*)(p->ws + WS_ESCALE))[row] = ldexpf(1.f, ex - 8);
    }
}
__device__ __forceinline__ unsigned xb_xcc_id();
constexpr int PEER_TT = 16;
constexpr int PEER_NTILE = M / PEER_TT;
constexpr int CW_UQ = 4096, CW_VQ = 8192;
__device__ __forceinline__ float dpp_xor1(float v) { return __builtin_bit_cast(float, __builtin_amdgcn_update_dpp(0, __builtin_bit_cast(int, v), 0xB1, 0xF, 0xF, true)); }
__device__ __forceinline__ float dpp_xor2(float v) { return __builtin_bit_cast(float, __builtin_amdgcn_update_dpp(0, __builtin_bit_cast(int, v), 0x4E, 0xF, 0xF, true)); }
__device__ __forceinline__ float dpp_hmirror(float v) { return __builtin_bit_cast(float, __builtin_amdgcn_update_dpp(0, __builtin_bit_cast(int, v), 0x141, 0xF, 0xF, true)); }
__device__ __forceinline__ void pg_load_ids(const int* idx, size_t token, int k, unsigned c16, unsigned (&off)[16]) {
#pragma unroll
    for (int i = 0; i < 4; ++i) { const int4 v = *(const int4*)(idx + token * NSEL + 16 * k + 4 * i); off[4 * i] = ((unsigned)v.x << 7) + c16; off[4 * i + 1] = ((unsigned)v.y << 7) + c16; off[4 * i + 2] = ((unsigned)v.z << 7) + c16; off[4 * i + 3] = ((unsigned)v.w << 7) + c16; }
}
__device__ __forceinline__ void pg_load_lines(const unsigned char* tg, const unsigned (&off)[16], uint4 (&r)[16]) {
#pragma unroll
    for (int j = 0; j < 16; ++j) r[j] = *(const uint4*)(tg + off[j]);
}
typedef _Float16 h2_t __attribute__((ext_vector_type(2)));
__device__ __forceinline__ void pg_compute_u(const uint4 (&r)[16], const uint4 (&hw)[2], float* po, int c) {
    h2_t hv[8];
#pragma unroll
    for (int hq = 0; hq < 2; ++hq) { const unsigned ww[4] = {hw[hq].x, hw[hq].y, hw[hq].z, hw[hq].w};
#pragma unroll
        for (int cc = 0; cc < 4; ++cc) { h2_t t; t.x = (_Float16)__uint_as_float(ww[cc] << 16); t.y = (_Float16)__uint_as_float(ww[cc] & 0xffff0000u); hv[4 * hq + cc] = t; } }
    float d[16];
#pragma unroll
    for (int j = 0; j < 16; ++j) { const unsigned ww[4] = {r[j].x, r[j].y, r[j].z, r[j].w}; float s = 0.f;
#pragma unroll
        for (int cc = 0; cc < 4; ++cc) { s = __builtin_amdgcn_fdot2(__builtin_bit_cast(h2_t, __builtin_amdgcn_cvt_scalef32_pk_f16_fp8(ww[cc], 1.0f, false)), hv[2 * cc], s, false); s = __builtin_amdgcn_fdot2(__builtin_bit_cast(h2_t, __builtin_amdgcn_cvt_scalef32_pk_f16_fp8(ww[cc], 1.0f, true)), hv[2 * cc + 1], s, false); }
        d[j] = s; }
#pragma unroll
    for (int j = 0; j < 16; ++j) d[j] += dpp_xor1(d[j]);
#pragma unroll
    for (int j = 0; j < 16; ++j) d[j] += dpp_xor2(d[j]);
#pragma unroll
    for (int j = 0; j < 16; ++j) d[j] += dpp_hmirror(d[j]);
    float p0 = 0.f, p1 = 0.f;
#pragma unroll
    for (int j = 0; j < 8; ++j) { p0 = (c == j) ? d[j] : p0; p1 = (c == j) ? d[j + 8] : p1; }
    po[0] = p0; po[8] = p1;
}
__device__ __forceinline__ void pg_compute_v(const uint4 (&r)[16], const f32x4_t (&aw)[4], float* xo, const float* gtp, float* ssp, int k, int lane) {
    h2_t hacc[8];
#pragma unroll
    for (int m = 0; m < 8; ++m) hacc[m] = (h2_t){(_Float16)0.f, (_Float16)0.f};
#pragma unroll
    for (int j = 0; j < 16; ++j) { const unsigned ww[4] = {r[j].x, r[j].y, r[j].z, r[j].w}; const _Float16 aj = (_Float16)(aw[j >> 2][j & 3] * 256.f); const h2_t a2 = {aj, aj};
#pragma unroll
        for (int cc = 0; cc < 4; ++cc) { hacc[2 * cc] = __builtin_elementwise_fma(__builtin_bit_cast(h2_t, __builtin_amdgcn_cvt_scalef32_pk_f16_fp8(ww[cc], 1.0f, false)), a2, hacc[2 * cc]); hacc[2 * cc + 1] = __builtin_elementwise_fma(__builtin_bit_cast(h2_t, __builtin_amdgcn_cvt_scalef32_pk_f16_fp8(ww[cc], 1.0f, true)), a2, hacc[2 * cc + 1]); } }
    f32x2_t acc[8];
#pragma unroll
    for (int m = 0; m < 8; ++m) acc[m] = (f32x2_t){(float)hacc[m].x * (1.f / 256.f), (float)hacc[m].y * (1.f / 256.f)};
    f32x2_t b4[4];
#pragma unroll
    for (int m = 0; m < 4; ++m) { const f32x2_t keep = (k & 1) ? acc[4 + m] : acc[m], send = (k & 1) ? acc[m] : acc[4 + m]; b4[m].x = keep.x + __shfl_xor(send.x, 8); b4[m].y = keep.y + __shfl_xor(send.y, 8); }
    f32x2_t b2[2];
#pragma unroll
    for (int m = 0; m < 2; ++m) { const f32x2_t keep = (k & 2) ? b4[2 + m] : b4[m], send = (k & 2) ? b4[m] : b4[2 + m]; b2[m].x = keep.x + __shfl_xor(send.x, 16); b2[m].y = keep.y + __shfl_xor(send.y, 16); }
    f32x2_t o2; { const f32x2_t keep = (k & 4) ? b2[1] : b2[0], send = (k & 4) ? b2[0] : b2[1]; o2.x = keep.x + __shfl_xor(send.x, 32); o2.y = keep.y + __shfl_xor(send.y, 32); }
    const float2 x1 = *(const float2*)xo; const float2 gt = *(const float2*)gtp;
    const float y0 = x1.x + gt.x * o2.x, y1 = x1.y + gt.y * o2.y;
    *(float2*)xo = make_float2(y0, y1);
    const float ss = wave_sum(y0 * y0 + y1 * y1);
    if (lane == 0) *ssp = ss;
}
template <bool VPASS>
__device__ __forceinline__ void phase_peer_gather(KP p, float* lds, int bid, int nb, int wv_) {
    const int tid = opaque_tid(), lane = tid & 63, k = lane >> 3, c = lane & 7;
    const bf16_t* H = (const bf16_t*)(p->ws + WS_H); const int* idx = (const int*)(p->ws + WS_IDX);
    const unsigned char* TAB = p->ws + (VPASS ? WS_EV8 : WS_EU8);
    float* pdot = (float*)(p->ws + WS_PDOT); const float* act = (const float*)(p->ws + WS_ACT); float* ssq2 = (float*)(p->ws + WS_SSQ2);
    unsigned* ctr = (unsigned*)(p->ws + WS_CTL) + (VPASS ? CW_VQ : CW_UQ);
    if (VPASS) { for (int i = tid; i < NB * D; i += NT) lds[i] = mod_at(p, i >> 11, 5 * D + (i & (D - 1))); __syncthreads(); }
    const unsigned slot0 = xb_xcc_id() & 7u, c16 = 16u * (unsigned)c;
    const int vcol = 16 * c + 8 * (k & 1) + 4 * ((k >> 1) & 1) + 2 * (k >> 2);
    for (int sl = 0; sl < 8; ++sl) {
        const int slot = (int)((slot0 + sl) & 7u);
        for (;;) {
            unsigned q = 0; if (lane == 0) q = __hip_atomic_fetch_add(ctr + 64 * slot, 1u, __ATOMIC_RELAXED, __HIP_MEMORY_SCOPE_AGENT);
            q = (unsigned)__builtin_amdgcn_readfirstlane((int)q);
            if (q >= 2u * PEER_NTILE) break;
            const int g = slot * 2 + (int)(q / PEER_NTILE), tile = (int)(q % PEER_NTILE);
            const unsigned char* tg = TAB + (size_t)g * GRP_BYTES;
            const size_t tok0 = (size_t)tile * PEER_TT;
            unsigned oA[16], oB[16]; uint4 rA[16], rB[16]; uint4 hA[2], hB[2]; f32x4_t aA[4], aB[4];
#define PG_AUX(tok, hX, aX) do { if (!VPASS) { hX[0] = *(const uint4*)(H + (tok) * D + g * 128 + 16 * c); hX[1] = *(const uint4*)(H + (tok) * D + g * 128 + 16 * c + 8); } \
            else { _Pragma("unroll") for (int i_ = 0; i_ < 4; ++i_) aX[i_] = *(const f32x4_t*)(act + (tok) * NSEL + 16 * k + 4 * i_); } } while (0)
#define PG_COMPUTE(tok, rX, hX, aX) do { if (!VPASS) pg_compute_u(rX, hX, pdot + ((size_t)g * M + (tok)) * NSEL + 16 * k + c, c); \
            else pg_compute_v(rX, aX, p->out + (tok) * D + g * 128 + vcol, lds + ((tok) / SEQ) * D + g * 128 + vcol, ssq2 + (size_t)g * M + (tok), k, lane); } while (0)
            pg_load_ids(idx, tok0, k, c16, oA); pg_load_lines(tg, oA, rA); PG_AUX(tok0, hA, aA); pg_load_ids(idx, tok0 + 1, k, c16, oB);
            for (int tt = 0; tt < PEER_TT; tt += 2) {
                pg_load_lines(tg, oB, rB); PG_AUX(tok0 + tt + 1, hB, aB);
                if (tt + 2 < PEER_TT) pg_load_ids(idx, tok0 + tt + 2, k, c16, oA);
                PG_COMPUTE(tok0 + tt, rA, hA, aA);
                if (tt + 2 < PEER_TT) { pg_load_lines(tg, oA, rA); PG_AUX(tok0 + tt + 2, hA, aA); pg_load_ids(idx, tok0 + tt + 3, k, c16, oB); }
                PG_COMPUTE(tok0 + tt + 1, rB, hB, aB);
            }
#undef PG_AUX
#undef PG_COMPUTE
        }
    }
}
__device__ __forceinline__ void phase_peer_act(KP p, int bid, int nb, int wv_) {
    const int tid = opaque_tid(), lane = tid & 63, wave = tid >> 6;
    const int* idx = (const int*)(p->ws + WS_IDX); const float* gate = (const float*)(p->ws + WS_GATE); const float* esc = (const float*)(p->ws + WS_ESCALE);
    const float* pdot = (const float*)(p->ws + WS_PDOT); float* act = (float*)(p->ws + WS_ACT);
    for (int token = bid * 8 + wave; token < M; token += nb * 8) {
        float d0 = 0.f, d1 = 0.f;
#pragma unroll
        for (int g = 0; g < NGRP; ++g) { d0 += pdot[((size_t)g * M + token) * NSEL + lane]; d1 += pdot[((size_t)g * M + token) * NSEL + 64 + lane]; }
        const int e0 = idx[(size_t)token * NSEL + lane], e1 = idx[(size_t)token * NSEL + 64 + lane];
        act[(size_t)token * NSEL + lane] = gelu_t(d0 * esc[e0]) * gate[(size_t)token * NSEL + lane] * esc[NKEYS * NKEYS + e0];
        act[(size_t)token * NSEL + 64 + lane] = gelu_t(d1 * esc[e1]) * gate[(size_t)token * NSEL + 64 + lane] * esc[NKEYS * NKEYS + e1];
    }
}
__device__ __forceinline__ void phase_final_norm(KP p, int bid, int nb, int wv_) {
    const int tid = opaque_tid(), lane = tid & 63, wave = tid >> 6;
    const float* ssq2 = (const float*)(p->ws + WS_SSQ2); const float* gf = p->in[I_GFIN];
    for (int token = bid * 8 + wave; token < M; token += nb * 8) {
        float ss = 0.f;
#pragma unroll
        for (int g = 0; g < NGRP; ++g) ss += ssq2[(size_t)g * M + token];
        const float rstd = rsqrtf(ss * (1.f / D) + EPS);
        float* row = p->out + (size_t)token * D;
#pragma unroll
        for (int j = 0; j < 8; ++j) { const int col = lane * 4 + 256 * j; const float4 v = *(const float4*)(row + col); const float4 g4 = *(const float4*)(gf + col);
            *(float4*)(row + col) = make_float4(v.x * rstd * g4.x, v.y * rstd * g4.y, v.z * rstd * g4.z, v.w * rstd * g4.w); }
    }
}

#define XB_TMO      128
#define XB_XCNT(j)  (256  + 64 * (j))
#define XB_XSUB(j)  (1280 + 64 * (j))
#define XB_XGEN(j)  (2304 + 64 * (j))
#define XB_TOP      3328
#define XB_TOPGEN   3392
#define XCD_BAR_WORDS 3456
#define XB_SPIN_CAP (1u << 18)

__device__ __forceinline__ unsigned xb_ld(unsigned* p)              { return __hip_atomic_load(p, __ATOMIC_RELAXED, __HIP_MEMORY_SCOPE_AGENT); }
__device__ __forceinline__ unsigned xb_add(unsigned* p, unsigned v) { return __hip_atomic_fetch_add(p, v, __ATOMIC_RELAXED, __HIP_MEMORY_SCOPE_AGENT); }
__device__ __forceinline__ unsigned xb_xcc_id() { return (unsigned)__builtin_amdgcn_s_getreg((3 << 11) | 20) & 0xFu; }
#define XB_SPIN(cond, bar) do { unsigned _sp = 0; while (cond) { __builtin_amdgcn_s_sleep(1); \
    if ((++_sp & 255u) == 0u) { if (xb_ld(&(bar)[XB_TMO])) break; if (_sp > XB_SPIN_CAP) { atomicAdd(&(bar)[XB_TMO], 1u); break; } } } } while (0)

struct XcdBarrier {
    unsigned* bar; unsigned x;
    volatile LAS unsigned* st;
};

__device__ __forceinline__ XcdBarrier xcd_barrier_post(unsigned* bar, volatile LAS unsigned* st) {
    XcdBarrier b; b.bar = bar; b.x = xb_xcc_id(); b.st = st;
    if (threadIdx.x == 0) (void)xb_add(&bar[XB_XCNT(b.x)], 1u);
    return b;
}
__device__ __forceinline__ void xcd_barrier_complete(unsigned* bar, unsigned x, unsigned& nloc, unsigned& nx) {
    const unsigned G = gridDim.x * gridDim.y * gridDim.z;
    unsigned sum, cnt, mine, sp = 0u;
    for (;;) {
        sum = 0u; cnt = 0u; mine = 0u;
#pragma unroll
        for (unsigned j = 0; j < 16; ++j) { const unsigned c = xb_ld(&bar[XB_XCNT(j)]); sum += c; cnt += (c > 0u) ? 1u : 0u; mine = (j == x) ? c : mine; }
        if (sum == G) break;
        __builtin_amdgcn_s_sleep(1);
        if ((++sp & 255u) == 0u) { if (xb_ld(&bar[XB_TMO])) break; if (sp > XB_SPIN_CAP) { atomicAdd(&bar[XB_TMO], 1u); break; } }
    }
    nloc = mine > 0u ? mine : 1u; nx = cnt > 0u ? cnt : 1u;
}

__device__ __forceinline__ void xcd_barrier(const XcdBarrier& b, bool leader) {
    asm volatile("s_waitcnt vmcnt(0)" ::: "memory");
    __syncthreads();
    if (leader) {
        unsigned* bar = b.bar;
        __builtin_amdgcn_s_waitcnt(0);
        unsigned nloc = b.st[0], nx = b.st[1];
        if (nloc == 0u) { xcd_barrier_complete(bar, b.x, nloc, nx); b.st[0] = nloc; b.st[1] = nx; }
        const unsigned old = xb_add(&bar[XB_XSUB(b.x)], 1u);
        const unsigned gen = old / nloc;
        if (old + 1u == (gen + 1u) * nloc) {
            __builtin_amdgcn_fence(__ATOMIC_RELEASE, "agent");
            asm volatile("s_waitcnt vmcnt(0)" ::: "memory");
            const unsigned og = xb_add(&bar[XB_TOP], 1u);
            const unsigned tg = og / nx;
            if (og + 1u == (tg + 1u) * nx) xb_add(&bar[XB_TOPGEN], 1u);
            else XB_SPIN(xb_ld(&bar[XB_TOPGEN]) == tg, bar);
            __builtin_amdgcn_fence(__ATOMIC_ACQUIRE, "agent");
            xb_add(&bar[XB_XGEN(b.x)], 1u);
            asm volatile("s_waitcnt vmcnt(0)" ::: "memory");
        } else {
            XB_SPIN(xb_ld(&bar[XB_XGEN(b.x)]) == gen, bar);
            __builtin_amdgcn_fence(__ATOMIC_ACQUIRE, "agent");
            asm volatile("s_waitcnt vmcnt(0)" ::: "memory");
        }
    }
    __syncthreads();
}


extern __shared__ __attribute__((aligned(16))) unsigned char dyn_lds[];
constexpr int LDS_BYTES = 147456;
__global__ void __launch_bounds__(NT) fwd_megakernel(Params p_unused) {
    KP p = (KP)__builtin_amdgcn_kernarg_segment_ptr();
    float* lds = (float*)dyn_lds;
    const int bid = blockIdx.x, nb = gridDim.x, wv_ = __builtin_amdgcn_readfirstlane((int)(threadIdx.x >> 6));
    volatile LAS unsigned* bst = (volatile LAS unsigned*)((LAS unsigned char*)dyn_lds + LDS_BYTES - 16);
    if (threadIdx.x < 4) bst[threadIdx.x] = 0u;
    __syncthreads();
    (void)xcd_barrier_post((unsigned*)(p->ws + WS_CTL), bst);
#define GRID_BAR() do { XcdBarrier xb_; xb_.bar = (unsigned*)(p->ws + WS_CTL); xb_.x = xb_xcc_id(); xb_.st = (volatile LAS unsigned*)((LAS unsigned char*)dyn_lds + LDS_BYTES - 16); xcd_barrier(xb_, opaque_tid() == 0); } while (0)
    phase_mod(p, lds, bid, nb, wv_);
    __syncthreads();
    phase_convert_weights(p, lds, bid, nb, wv_);
    phase_amax(p, bid, nb, wv_);
    phase_convert_experts(p, bid, nb, wv_);
    cg::this_grid().sync();
    phase_hrows<true>(p, p->in[I_X], p->in[I_GMIX], 0, D, (bf16_t*)(p->ws + WS_H), lds, bid, nb, wv_);
    phase_convert_weights8(p, lds, bid, nb, wv_);
    GRID_BAR();
    { pg8::Gemm g{(const bf16_t*)(p->ws + WS_H), (const bf16_t*)(p->ws + WS_WIN_T), M, NPROJ, D / 2}; pg8::StaticOrder S; S.init(M, NPROJ, nb, bid);
      pg8::EpiProj E{(bf16_t*)(p->ws + WS_PROJ), (float*)(p->ws + WS_SSQV), M, (const float*)(p->ws + WS_HSCALE1), (const float*)(p->ws + WS_CTL) + CW_WSCALE};
      pg8::gemm_phase<pg8::EpiProj, pg8::StaticOrder, true, true, true>((LAS unsigned char*)dyn_lds, g, S, E, wv_); }
    GRID_BAR();
    phase_lru(p, dyn_lds, bid, nb, wv_);
    phase_sgu(p, dyn_lds, bid, nb, wv_);
    GRID_BAR();
    { pg8::Gemm g{(const bf16_t*)(p->ws + WS_YMIX), (const bf16_t*)(p->ws + WS_WOUT_T), M, D, D / 2}; pg8::StaticOrder S; S.init(M, D, nb, bid);
      pg8::EpiX1 E{p->in[I_X], p->out, (const float*)(p->ws + WS_MODP), p->in[I_BADA], 2 * D, NMOD, SEQ, (const float*)(p->ws + WS_CTL) + CW_WSCALE + 1, 1.f / YMIX_SCALE};
      pg8::gemm_phase<pg8::EpiX1, pg8::StaticOrder, true, true, true>((LAS unsigned char*)dyn_lds, g, S, E, wv_); }
    GRID_BAR();
    phase_hrows<false>(p, p->out, p->in[I_GFFN], 3 * D, 4 * D, (bf16_t*)(p->ws + WS_H), lds, bid, nb, wv_);
    GRID_BAR();
    { pg8::Gemm g{(const bf16_t*)(p->ws + WS_H), (const bf16_t*)(p->ws + WS_WQ_T), M, D, D}; pg8::StaticOrder S; S.init(M, D, nb, bid);
      pg8::EpiQ E{(bf16_t*)(p->ws + WS_Q), D};
      pg8::gemm_phase<pg8::EpiQ, pg8::StaticOrder, true, true>((LAS unsigned char*)dyn_lds, g, S, E, wv_); }
    GRID_BAR();
    phase_topk(p, dyn_lds, bid, nb, wv_);
    GRID_BAR();
    phase_peer_gather<false>(p, lds, bid, nb, wv_);
    GRID_BAR();
    phase_peer_act(p, bid, nb, wv_);
    GRID_BAR();
    phase_peer_gather<true>(p, lds, bid, nb, wv_);
    GRID_BAR();
    phase_final_norm(p, bid, nb, wv_);
}

extern "C" void kernel_launch(void* const* d_in, const int* in_sizes, int n_in, void* d_out, int out_size, void* d_ws, size_t ws_size, hipStream_t stream) {
    static int grid_blocks = 0;
    if (grid_blocks == 0) {
        if (n_in != 23 || in_sizes[0] != M * D || out_size != M * D || ws_size < WS_END) { fprintf(stderr, "kernel_launch: unexpected shapes (n_in %d in0 %d out %d ws %zu)\n", n_in, n_in > 0 ? in_sizes[0] : -1, out_size, ws_size); grid_blocks = -1; return; }
        if (hipFuncSetAttribute((const void*)fwd_megakernel, hipFuncAttributeMaxDynamicSharedMemorySize, LDS_BYTES) != hipSuccess) { fprintf(stderr, "hipFuncSetAttribute failed\n"); grid_blocks = -1; return; }
        int dev = 0, cus = 0, per_cu = 0;
        hipGetDevice(&dev);
        hipDeviceGetAttribute(&cus, hipDeviceAttributeMultiprocessorCount, dev);
        if (hipOccupancyMaxActiveBlocksPerMultiprocessor(&per_cu, (const void*)fwd_megakernel, NT, LDS_BYTES) != hipSuccess || per_cu < 1) { fprintf(stderr, "occupancy query failed (%d)\n", per_cu); grid_blocks = -1; return; }
        grid_blocks = cus;
    }
    if (grid_blocks < 0) return;
    Params p{};
    for (int i = 0; i < 23; ++i) p.in[i] = (const float*)d_in[i];
    p.out = (float*)d_out; p.ws = (unsigned char*)d_ws;
    if (hipMemsetAsync((char*)d_ws + WS_CTL, 0, 65536, stream) != hipSuccess) { fprintf(stderr, "hipMemsetAsync of the barrier words failed\n"); return; }
    void* args[] = {&p};
    hipError_t e = hipLaunchCooperativeKernel((const void*)fwd_megakernel, dim3(grid_blocks), dim3(NT), args, LDS_BYTES, stream);
    if (e != hipSuccess) fprintf(stderr, "cooperative launch failed: %s (grid %d)\n", hipGetErrorString(e), grid_blocks);
}
```

```cpp
#include <hip/hip_runtime.h>
#include <hip/hip_cooperative_groups.h>
#include <cstdio>
#include <cstdint>

constexpr int D = 2048, NB = 8, SEQ = 2048, M = NB * SEQ;
constexpr int DLRU = 1024, DSGU = 1024, NPROJ = 4096;
constexpr int NMOD = 6 * D;
constexpr int NHEAD = 8, NKEYS = 128, TOPK = 16, NSEL = NHEAD * TOPK;
constexpr float EPS = 1e-6f;
constexpr int NT = 512;
namespace cg = cooperative_groups;

constexpr size_t MiB = 1u << 20;
constexpr size_t WS_CTL = 0;
constexpr size_t WS_MODP = 1 * MiB;
constexpr size_t WS_WGA_T = 3 * MiB;
constexpr size_t WS_WGI_T = 3 * MiB + 262144;
constexpr size_t WS_WSPB = 3 * MiB + 524288;
constexpr size_t WS_SKEYB = 3 * MiB + 786432;
constexpr size_t WS_SSQV = 5 * MiB;
constexpr size_t WS_RSTDV = 8 * MiB;
constexpr size_t WS_WIN_T = 9 * MiB;
constexpr size_t WS_WOUT_T = 25 * MiB;
constexpr size_t WS_WQ_T = 33 * MiB;
constexpr size_t WS_IDX = 41 * MiB;
constexpr size_t WS_GATE = 49 * MiB;
constexpr size_t WS_H = 64 * MiB;
constexpr size_t WS_PROJ = 128 * MiB;
constexpr size_t WS_Q = 128 * MiB;
constexpr size_t WS_YMIX = 256 * MiB;
constexpr size_t WS_EU8 = 320 * MiB;
constexpr size_t WS_EV8 = 352 * MiB;
constexpr size_t WS_ESCALE = 57 * MiB;
constexpr size_t WS_XC = 320 * MiB;
constexpr size_t WS_A = 384 * MiB;
constexpr size_t WS_BB = 448 * MiB;
constexpr size_t WS_ACT = 256 * MiB;
constexpr size_t WS_SSQ2 = 264 * MiB;
constexpr size_t WS_PDOT = 384 * MiB;
constexpr size_t WS_HSCALE1 = 58 * MiB;
constexpr size_t WS_HSC = 59 * MiB;
constexpr size_t WS_ASC = 60 * MiB;
constexpr size_t WS_H8I = 288 * MiB;
constexpr size_t WS_END = 512 * MiB;

typedef unsigned short bf16_t;
struct Params { const float* in[23]; float* out; unsigned char* ws; };
typedef const __attribute__((address_space(4))) Params* KP;
enum { I_X = 0, I_C, I_WADA, I_BADA, I_GMIX, I_WIN, I_CONVW, I_CONVB, I_WGA, I_BGA, I_WGI, I_BGI, I_LAM, I_GV, I_WSP, I_BSP, I_WOUT, I_GFFN, I_WQ, I_SKEY, I_EU, I_EV, I_GFIN };

__device__ __forceinline__ int opaque_tid_(int wv) { asm volatile("" : "+s"(wv)); int t = wv * 64 + (int)__builtin_amdgcn_mbcnt_hi(~0u, __builtin_amdgcn_mbcnt_lo(~0u, 0u)); asm volatile("" : "+v"(t)); return t; }
#define opaque_tid() opaque_tid_(wv_)
__device__ __forceinline__ float bf2f(bf16_t v) { return __uint_as_float(((unsigned)v) << 16); }
__device__ __forceinline__ bf16_t f2bf(float f) { unsigned u = __float_as_uint(f); u += 0x7fffu + ((u >> 16) & 1u); return (bf16_t)(u >> 16); }
__device__ __forceinline__ float sigmoidf_(float x) { return 1.f / (1.f + __expf(-x)); }
__device__ __forceinline__ float gelu_t(float x) { const float u = 0.7978845608028654f * (x + 0.044715f * x * x * x); return x * sigmoidf_(2.f * u); }
__device__ __forceinline__ float wave_sum(float v) {
#pragma unroll
    for (int o = 1; o < 64; o <<= 1) v += __shfl_xor(v, o);
    return v;
}
__device__ __forceinline__ float wave_max(float v) {
#pragma unroll
    for (int o = 1; o < 64; o <<= 1) v = fmaxf(v, __shfl_xor(v, o));
    return v;
}
__device__ __forceinline__ float pow2_scale_from_max(float am) { int ex = 0; if (am > 0.f) (void)frexpf(am, &ex); else ex = 8; return ldexpf(1.f, 8 - ex); }
__device__ __forceinline__ unsigned pk4_fp8(float a, float b, float c, float d) {
    int w = __builtin_amdgcn_cvt_pk_fp8_f32(fminf(fmaxf(a, -448.f), 448.f), fminf(fmaxf(b, -448.f), 448.f), 0, false);
    return (unsigned)__builtin_amdgcn_cvt_pk_fp8_f32(fminf(fmaxf(c, -448.f), 448.f), fminf(fmaxf(d, -448.f), 448.f), w, true);
}
__device__ __forceinline__ unsigned pk4_i8(float a, float b, float c, float d) {
    const int ia = __float2int_rn(a), ib = __float2int_rn(b), ic = __float2int_rn(c), id = __float2int_rn(d);
    return ((unsigned)ia & 0xffu) | (((unsigned)ib & 0xffu) << 8) | (((unsigned)ic & 0xffu) << 16) | ((unsigned)id << 24);
}
__device__ __forceinline__ float mod_at(KP p, int b, int n) {
    const float* mp = (const float*)(p->ws + WS_MODP);
    float s = p->in[I_BADA][n];
#pragma unroll
    for (int kc = 0; kc < 4; ++kc) s += mp[(size_t)(kc * 8 + b) * NMOD + n];
    return s;
}

__device__ __forceinline__ void phase_mod(KP p, float* lds, int bid, int nb, int wv_) {
    const int tid = opaque_tid(), lane = tid & 63, wave = tid >> 6;
    const float* c = p->in[I_C]; const float* W = p->in[I_WADA];
    float* modp = (float*)(p->ws + WS_MODP);
    for (int i = tid; i < NB * D; i += NT) { const float v = c[i]; lds[i] = v * sigmoidf_(v); }
    __syncthreads();
    float* red = lds + NB * D;
    for (int item = bid; item < 192; item += nb) {
        const int nt = item % 48, kc = item / 48;
        const int n0 = nt * 256 + lane * 4, k0 = kc * 512 + wave * 64;
        float acc[8][4];
#pragma unroll
        for (int b = 0; b < 8; ++b)
#pragma unroll
            for (int j = 0; j < 4; ++j) acc[b][j] = 0.f;
        for (int kk = 0; kk < 64; ++kk) {
            const float4 w = *(const float4*)(W + (size_t)(k0 + kk) * NMOD + n0);
#pragma unroll
            for (int b = 0; b < 8; ++b) { const float s = lds[b * D + k0 + kk]; acc[b][0] += s * w.x; acc[b][1] += s * w.y; acc[b][2] += s * w.z; acc[b][3] += s * w.w; }
        }
#pragma unroll
        for (int b = 0; b < 8; ++b)
#pragma unroll
            for (int j = 0; j < 4; ++j) red[(wave * 32 + b * 4 + j) * 64 + lane] = acc[b][j];
        __syncthreads();
        for (int o = tid; o < 2048; o += NT) {
            const int b = o >> 8, nn = o & 255, ln = nn >> 2, j = nn & 3;
            float s = 0.f;
#pragma unroll
            for (int w = 0; w < 8; ++w) s += red[(w * 32 + b * 4 + j) * 64 + ln];
            modp[(size_t)(kc * 8 + b) * NMOD + nt * 256 + nn] = s;
        }
        __syncthreads();
    }
}

template <bool F8OUT, bool I8COPY = false>
__device__ __forceinline__ void phase_hrows(KP p, const float* src, const float* gn, int shift_off, int scale_off, bf16_t* dst, float* lds, int bid, int nb, int wv_) {
    const int tid = opaque_tid(), lane = tid & 63, wave = tid >> 6;
    float* Aw = lds; float* Bw = lds + D;
    for (int item = bid; item < M / 64; item += nb) {
        const int b = item / (SEQ / 64);
        for (int col = tid; col < D; col += NT) { Aw[col] = gn[col] * (1.f + mod_at(p, b, scale_off + col)); Bw[col] = mod_at(p, b, shift_off + col); }
        __syncthreads();
        for (int r = wave; r < 64; r += 8) {
            const size_t row = (size_t)item * 64 + r;
            float4 v[8]; float ss = 0.f;
#pragma unroll
            for (int j = 0; j < 8; ++j) { v[j] = *(const float4*)(src + row * D + lane * 4 + 256 * j); ss += v[j].x * v[j].x + v[j].y * v[j].y + v[j].z * v[j].z + v[j].w * v[j].w; }
            const float rstd = rsqrtf(wave_sum(ss) * (1.f / D) + EPS);
            float am = 0.f;
#pragma unroll
            for (int j = 0; j < 8; ++j) {
                const int col = lane * 4 + 256 * j;
                const float o0 = v[j].x * rstd * Aw[col] + Bw[col], o1 = v[j].y * rstd * Aw[col + 1] + Bw[col + 1];
                const float o2 = v[j].z * rstd * Aw[col + 2] + Bw[col + 2], o3 = v[j].w * rstd * Aw[col + 3] + Bw[col + 3];
                if (F8OUT || I8COPY) { v[j] = make_float4(o0, o1, o2, o3); am = fmaxf(am, fmaxf(fmaxf(fabsf(o0), fabsf(o1)), fmaxf(fabsf(o2), fabsf(o3)))); }
                if (!F8OUT) { uint2 w; w.x = (unsigned)f2bf(o0) | ((unsigned)f2bf(o1) << 16); w.y = (unsigned)f2bf(o2) | ((unsigned)f2bf(o3) << 16); *(uint2*)(dst + row * D + col) = w; }
            }
            if (I8COPY) {
                am = wave_max(am); const float sc = am > 0.f ? 127.f / am : 0.f;
                unsigned* d8 = (unsigned*)(p->ws + WS_H8I + row * D);
#pragma unroll
                for (int j = 0; j < 8; ++j) d8[lane + 64 * j] = pk4_i8(v[j].x * sc, v[j].y * sc, v[j].z * sc, v[j].w * sc);
                if (lane == 0) ((float*)(p->ws + WS_HSC))[row] = am * (1.f / 127.f);
            }
            if (F8OUT) {
                const float sc = pow2_scale_from_max(wave_max(am));
                unsigned* d8 = (unsigned*)((unsigned char*)dst + row * D);
#pragma unroll
                for (int j = 0; j < 8; ++j) d8[lane + 64 * j] = pk4_fp8(v[j].x * sc, v[j].y * sc, v[j].z * sc, v[j].w * sc);
                if (lane == 0) ((float*)(p->ws + WS_HSCALE1))[row] = 1.f / sc;
            }
        }
        __syncthreads();
    }
}

namespace pg8 {
#define PG8_LAS __attribute__((address_space(3)))
typedef unsigned short bf16_t;
typedef short bf16x8 __attribute__((ext_vector_type(8)));
typedef float f32x4 __attribute__((ext_vector_type(4)));
typedef unsigned u32x4 __attribute__((ext_vector_type(4)));
constexpr int BM = 256, BK = 64, HALF = 128, HTB = HALF * BK * 2  , STAGE_BYTES = 8 * HTB, NXCD = 8, WGM = 8;

__host__ __device__ __forceinline__ int lds_byte(int r, int c) { const int st = (r >> 4) * 2 + (c >> 5), rr = r & 15, cc = c & 31, ob = rr * 64 + cc * 2; return st * 1024 + (ob ^ (((ob >> 9) & 1) << 5)); }
__host__ __device__ __forceinline__ void stage_rc(int b, int& R, int& C) { const int st = b / 1024, sb = b % 1024, swz = sb ^ (((sb >> 9) & 1) << 5); R = (st >> 1) * 16 + swz / 64; C = (st & 1) * 32 + (swz % 64) / 2; }
__host__ __device__ __forceinline__ int perm32(int rho) { const int n = rho >> 4, i = rho & 15; return 8 * (i >> 2) + 4 * n + (i & 3); }

struct Unit { int pm, pn; };
struct Gemm { const bf16_t* A; const bf16_t* Bt; int M, N, K; };

struct StaticOrder {
    int nM, nN, nwg, G, c;
    __host__ __device__ void init(int M, int N, int G_, int c_) { nM = M / BM; nN = N / BM; nwg = nM * nN; G = G_; c = c_; }
    __host__ __device__ bool next(int i, Unit& u) const {
        const long L = (long)i * G + c; if (L >= nwg) return false;
        int wgid = (int)L; { const int q = nwg / NXCD, r = nwg % NXCD, xcd = wgid % NXCD, off = wgid / NXCD; wgid = (xcd < r ? xcd * (q + 1) : r * (q + 1) + (xcd - r) * q) + off; }
        const int nig = WGM * nN, gid = wgid / nig, fm = gid * WGM, gsz = (nM - fm) < WGM ? (nM - fm) : WGM;
        u.pm = fm + ((wgid % nig) % gsz); u.pn = (wgid % nig) / gsz; return true;
    }
    __device__ __forceinline__ void a_ready(const Unit&) const {}
    __device__ __forceinline__ void done(const Unit&) const {}
};


__device__ __forceinline__ unsigned cvt_pk_bf16(float lo, float hi) { unsigned r; asm volatile("v_cvt_pk_bf16_f32 %0, %1, %2" : "=v"(r) : "v"(lo), "v"(hi)); return r; }
__device__ __forceinline__ float gelu_tanh(float x) { const float u = 1.5957691216057308f * (x + 0.044715f * x * x * x); return x * __builtin_amdgcn_rcpf(1.f + __expf(-u)); }
struct EpiProj {
    static constexpr bool PERM = true, AFTER_DRAIN = false;
    bf16_t* proj; float* ssqv; int Mrows; const float* rowscale; const float* cscale;
    __device__ __forceinline__ void operator()(const f32x4 (&acc)[2][2][4][2], const Unit& u, int wr, int wc, int fr, int fq) const {
        const int which = (u.pn * BM) >> 10, colt = (u.pn * BM) & 1023; const float cs = *cscale;
        bf16_t* base = proj + (size_t)which * Mrows * 1024;
        const int row0 = u.pm * BM + wr * 64 + fr, col0 = colt + wc * 32 + 8 * fq;
#pragma unroll
        for (int ai = 0; ai < 2; ++ai)
#pragma unroll
            for (int m = 0; m < 4; ++m) { const int row = row0 + ai * HALF + m * 16; bf16_t* rowp = base + (size_t)row * 1024 + col0; float ss = 0.f; const float f = cs * rowscale[row];
#pragma unroll
                for (int bj = 0; bj < 2; ++bj) { f32x4 v0 = acc[ai][bj][m][0] * f, v1 = acc[ai][bj][m][1] * f;
                    if (which) {
#pragma unroll
                        for (int j = 0; j < 4; ++j) { v0[j] = gelu_tanh(v0[j]); v1[j] = gelu_tanh(v1[j]); } }
                    ss += (v0[0] * v0[0] + v0[1] * v0[1]) + (v0[2] * v0[2] + v0[3] * v0[3]) + (v1[0] * v1[0] + v1[1] * v1[1]) + (v1[2] * v1[2] + v1[3] * v1[3]);
                    u32x4 w; w.x = cvt_pk_bf16(v0[0], v0[1]); w.y = cvt_pk_bf16(v0[2], v0[3]); w.z = cvt_pk_bf16(v1[0], v1[1]); w.w = cvt_pk_bf16(v1[2], v1[3]);
                    *(u32x4*)(rowp + bj * HALF) = w; }
                if (which == 3) { ss += __shfl_xor(ss, 16); ss += __shfl_xor(ss, 32); if (fq == 0) ssqv[(size_t)row * 16 + (u.pn & 3) * 4 + wc] = ss; } }
    }
};
struct EpiX1 {
    static constexpr bool PERM = false, AFTER_DRAIN = false;
    const float* x; float* out; const float* modp; const float* bada; int goff, nmod, seq; const float* cscale; float cscale2;
    __device__ __forceinline__ void operator()(const f32x4 (&acc)[2][2][4][2], const Unit& u, int wr, int wc, int fr, int fq) const {
        const int row0 = u.pm * BM + wr * 64 + fr, col0 = u.pn * BM + wc * 32 + 4 * fq, b = (u.pm * BM) / seq;
        f32x4 gv[2][2];
#pragma unroll
        for (int bj = 0; bj < 2; ++bj)
#pragma unroll
            for (int n = 0; n < 2; ++n) { const int c = goff + col0 + bj * HALF + n * 16; f32x4 g = *(const f32x4*)(bada + c);
#pragma unroll
                for (int kc = 0; kc < 4; ++kc) g += *(const f32x4*)(modp + (size_t)(kc * 8 + b) * nmod + c);
                gv[bj][n] = g * (*cscale * cscale2); }
#pragma unroll
        for (int ai = 0; ai < 2; ++ai)
#pragma unroll
            for (int m = 0; m < 4; ++m) { const size_t off = (size_t)(row0 + ai * HALF + m * 16) * (size_t)(2048) + col0;
#pragma unroll
                for (int bj = 0; bj < 2; ++bj)
#pragma unroll
                    for (int n = 0; n < 2; ++n) { const f32x4 xv = *(const f32x4*)(x + off + bj * HALF + n * 16); *(f32x4*)(out + off + bj * HALF + n * 16) = xv + gv[bj][n] * acc[ai][bj][m][n]; } }
    }
};
struct EpiQ {
    static constexpr bool PERM = true, AFTER_DRAIN = false;
    bf16_t* O; int ldc;
    __device__ __forceinline__ void operator()(const f32x4 (&acc)[2][2][4][2], const Unit& u, int wr, int wc, int fr, int fq) const {
        const int row0 = u.pm * BM + wr * 64 + fr, col0 = u.pn * BM + wc * 32 + 8 * fq;
#pragma unroll
        for (int ai = 0; ai < 2; ++ai)
#pragma unroll
            for (int m = 0; m < 4; ++m) { bf16_t* rowp = O + (size_t)(row0 + ai * HALF + m * 16) * ldc + col0;
#pragma unroll
                for (int bj = 0; bj < 2; ++bj) { const f32x4 v0 = acc[ai][bj][m][0], v1 = acc[ai][bj][m][1];
                    u32x4 w; w.x = cvt_pk_bf16(v0[0], v0[1]); w.y = cvt_pk_bf16(v0[2], v0[3]); w.z = cvt_pk_bf16(v1[0], v1[1]); w.w = cvt_pk_bf16(v1[2], v1[3]);
                    *(u32x4*)(rowp + bj * HALF) = w; } }
    }
};

template <class Epi, class Sched, bool ALIGN_EPI = false, bool SP2 = false, bool FP8 = false>
__device__ __forceinline__ void gemm_phase(PG8_LAS unsigned char* lds, const Gemm g, const Sched& S, const Epi& E, int wv_) {
    const int tid = opaque_tid(), wid = __builtin_amdgcn_readfirstlane(tid >> 6), lane = tid & 63, wr = wid >> 2, wc = wid & 3, fr = lane & 15, fq = lane >> 4;
    const int K = g.K, nt = K / BK;
    unsigned voffA[2], voffB[2];
#pragma unroll
    for (int i = 0; i < 2; ++i) { int R, C; stage_rc(tid * 16 + i * 8192, R, C); const int Rb = Epi::PERM ? ((R & ~31) + perm32(R & 31)) : R;
        voffA[i] = (unsigned)(R * K + C) * 2u; voffB[i] = (unsigned)(Rb * K + C) * 2u; }
    const size_t kstep = (size_t)(BK * 2);
    const size_t hstep = (size_t)HALF * K * 2;
    const size_t tstep = 2 * hstep;
    const unsigned ldsw = (unsigned)wid * 1024u;
    const int aoff = lds_byte(wr * 64 + fr, fq * 8), boff = lds_byte(wc * 32 + fr, fq * 8);
#define PG8_SA(b, h) (((b) * 2 + (h)) * HTB)
#define PG8_SB(b, h) ((4 + (b) * 2 + (h)) * HTB)
#define PG8_STAGE(bufoff, gbase, voff) do { _Pragma("unroll") for (int _i = 0; _i < 2; ++_i) \
        __builtin_amdgcn_global_load_lds((const unsigned*)((const char*)(gbase) + (voff)[_i]), (PG8_LAS unsigned*)(lds + (bufoff) + ldsw + _i * 8192), 16, 0, 0); } while (0)
#define PG8_LDA(dst, b, h) do { _Pragma("unroll") for (int m = 0; m < 4; ++m) _Pragma("unroll") for (int k = 0; k < 2; ++k) dst[m][k] = *(const PG8_LAS bf16x8*)(lds + PG8_SA(b, h) + aoff + m * 2048 + k * 1024); } while (0)
#define PG8_LDB(dst, b, h) do { _Pragma("unroll") for (int n = 0; n < 2; ++n) _Pragma("unroll") for (int k = 0; k < 2; ++k) dst[n][k] = *(const PG8_LAS bf16x8*)(lds + PG8_SB(b, h) + boff + n * 2048 + k * 1024); } while (0)
#define PG8_MMA(ai, bj, At, Bt) do { __builtin_amdgcn_s_setprio(1); _Pragma("unroll") for (int m = 0; m < 4; ++m) _Pragma("unroll") for (int n = 0; n < 2; ++n) { \
        if constexpr (FP8) { typedef int v4i_ __attribute__((ext_vector_type(4))); typedef int v8i_ __attribute__((ext_vector_type(8))); \
            const v8i_ a8 = __builtin_shufflevector(__builtin_bit_cast(v4i_, Bt[n][0]), __builtin_bit_cast(v4i_, Bt[n][1]), 0, 1, 2, 3, 4, 5, 6, 7), b8 = __builtin_shufflevector(__builtin_bit_cast(v4i_, At[m][0]), __builtin_bit_cast(v4i_, At[m][1]), 0, 1, 2, 3, 4, 5, 6, 7); \
            asm volatile("v_mfma_scale_f32_16x16x128_f8f6f4 %0, %1, %2, %0, %3, %3 op_sel_hi:[0,0,0]" : "+v"(acc[ai][bj][m][n]) : "v"(a8), "v"(b8), "v"(one8)); } \
        else { _Pragma("unroll") for (int k = 0; k < 2; ++k) acc[ai][bj][m][n] = __builtin_amdgcn_mfma_f32_16x16x32_bf16(Bt[n][k], At[m][k], acc[ai][bj][m][n], 0, 0, 0); } } \
        __builtin_amdgcn_s_setprio(0); } while (0)
#define PG8_WAIT_V(n) asm volatile("s_waitcnt vmcnt(" #n ")" ::: "memory")
#define PG8_WAIT_L(n) asm volatile("s_waitcnt lgkmcnt(" #n ")" ::: "memory")
#define PG8_BAR __builtin_amdgcn_s_barrier()
#define PG8_SCHED __builtin_amdgcn_sched_barrier(0)
    Unit cur, nxt; int ui = 0;
    if (!S.next(0, cur)) return;
    f32x4 acc[2][2][4][2];
#pragma unroll
    for (int a = 0; a < 2; ++a)
#pragma unroll
        for (int b = 0; b < 2; ++b)
#pragma unroll
            for (int m = 0; m < 4; ++m)
#pragma unroll
                for (int n = 0; n < 2; ++n) acc[a][b][m][n] = (f32x4){0.f, 0.f, 0.f, 0.f};
    bf16x8 At[4][2], B0[2][2], B1[2][2];
    int one8 = 0x7F7F7F7F; asm volatile("" : "+v"(one8));
    const char* cA = (const char*)g.A + (size_t)cur.pm * tstep; const char* cB = (const char*)g.Bt + (size_t)cur.pn * tstep;
    S.a_ready(cur);
    if constexpr (SP2) {
        PG8_STAGE(PG8_SB(0, 0), cB, voffB); PG8_STAGE(PG8_SB(0, 1), cB + hstep, voffB); PG8_STAGE(PG8_SA(0, 0), cA, voffA); PG8_STAGE(PG8_SA(0, 1), cA + hstep, voffA);
        if (wr == 1) PG8_BAR;
        PG8_WAIT_V(2); PG8_BAR;
        PG8_STAGE(PG8_SB(1, 0), cB + kstep, voffB); PG8_STAGE(PG8_SA(1, 0), cA + kstep, voffA); PG8_STAGE(PG8_SB(1, 1), cB + hstep + kstep, voffB);
        PG8_WAIT_V(6); PG8_BAR;
    } else {
        PG8_STAGE(PG8_SB(0, 0), cB, voffB); PG8_STAGE(PG8_SA(0, 0), cA, voffA); PG8_STAGE(PG8_SB(0, 1), cB + hstep, voffB); PG8_STAGE(PG8_SA(0, 1), cA + hstep, voffA);
        if (wr == 1) PG8_BAR;
        PG8_WAIT_V(4); PG8_BAR;
        PG8_STAGE(PG8_SB(1, 0), cB + kstep, voffB); PG8_STAGE(PG8_SA(1, 0), cA + kstep, voffA); PG8_STAGE(PG8_SB(1, 1), cB + hstep + kstep, voffB);
        PG8_WAIT_V(6); PG8_BAR;
    }
    for (;;) {
        const bool has_next = S.next(ui + 1, nxt);
        const char* nA = has_next ? (const char*)g.A + (size_t)nxt.pm * tstep : cA; const char* nB = has_next ? (const char*)g.Bt + (size_t)nxt.pn * tstep : cB;
        for (int t = 0; t < nt; t += 2) {
            const bool last = (t == nt - 2);
            const char* a1 = cA + (size_t)(t + 1) * kstep;
            const char* a2 = last ? nA : cA + (size_t)(t + 2) * kstep; const char* b2 = last ? nB : cB + (size_t)(t + 2) * kstep;
            const char* a3 = a2 + kstep; const char* b3 = b2 + kstep;
            if (last && has_next) S.a_ready(nxt);
            if constexpr (SP2) {
            PG8_LDB(B0, 0, 0); PG8_LDB(B1, 0, 1); PG8_SCHED; PG8_LDA(At, 0, 0); PG8_STAGE(PG8_SA(1, 1), a1 + hstep, voffA);
            PG8_WAIT_V(8); PG8_WAIT_L(0); PG8_BAR; PG8_MMA(0, 0, At, B0); PG8_MMA(0, 1, At, B1); PG8_BAR; PG8_SCHED;
            PG8_LDA(At, 0, 1); PG8_STAGE(PG8_SB(0, 0), b2, voffB); PG8_STAGE(PG8_SB(0, 1), b2 + hstep, voffB); PG8_STAGE(PG8_SA(0, 0), a2, voffA);
            PG8_WAIT_V(8); PG8_WAIT_L(0); PG8_BAR; PG8_MMA(1, 0, At, B0); PG8_MMA(1, 1, At, B1); PG8_BAR; PG8_SCHED;
            PG8_LDB(B0, 1, 0); PG8_LDB(B1, 1, 1); PG8_SCHED; PG8_LDA(At, 1, 0); PG8_STAGE(PG8_SA(0, 1), a2 + hstep, voffA);
            PG8_WAIT_V(8); PG8_WAIT_L(0); PG8_BAR; PG8_MMA(0, 0, At, B0); PG8_MMA(0, 1, At, B1); PG8_BAR; PG8_SCHED;
            PG8_LDA(At, 1, 1); PG8_STAGE(PG8_SB(1, 0), b3, voffB); PG8_STAGE(PG8_SB(1, 1), b3 + hstep, voffB); PG8_STAGE(PG8_SA(1, 0), a3, voffA);
            PG8_WAIT_V(8); PG8_WAIT_L(0); PG8_BAR; PG8_MMA(1, 0, At, B0); PG8_MMA(1, 1, At, B1); PG8_BAR; PG8_SCHED;
            } else {
            PG8_LDB(B0, 0, 0); PG8_SCHED; PG8_LDA(At, 0, 0); PG8_STAGE(PG8_SA(1, 1), a1 + hstep, voffA);
            PG8_WAIT_L(8); PG8_BAR; PG8_WAIT_L(0); PG8_MMA(0, 0, At, B0); PG8_BAR; PG8_SCHED;
            PG8_LDB(B1, 0, 1); PG8_STAGE(PG8_SB(0, 0), b2, voffB);
            PG8_BAR; PG8_WAIT_L(0); PG8_MMA(0, 1, At, B1); PG8_BAR;
            PG8_LDA(At, 0, 1); PG8_STAGE(PG8_SA(0, 0), a2, voffA);
            PG8_BAR; PG8_WAIT_L(0); PG8_MMA(1, 0, At, B0); PG8_BAR; PG8_SCHED;
            PG8_STAGE(PG8_SB(0, 1), b2 + hstep, voffB);
            PG8_WAIT_V(6); PG8_BAR; PG8_MMA(1, 1, At, B1); PG8_BAR;
            PG8_LDB(B0, 1, 0); PG8_SCHED; PG8_LDA(At, 1, 0); PG8_STAGE(PG8_SA(0, 1), a2 + hstep, voffA);
            PG8_WAIT_L(8); PG8_BAR; PG8_WAIT_L(0); PG8_MMA(0, 0, At, B0); PG8_BAR; PG8_SCHED;
            PG8_LDB(B1, 1, 1); PG8_STAGE(PG8_SB(1, 0), b3, voffB);
            PG8_BAR; PG8_WAIT_L(0); PG8_MMA(0, 1, At, B1); PG8_BAR;
            PG8_LDA(At, 1, 1); PG8_STAGE(PG8_SA(1, 0), a3, voffA);
            PG8_BAR; PG8_WAIT_L(0); PG8_MMA(1, 0, At, B0); PG8_BAR; PG8_SCHED;
            PG8_STAGE(PG8_SB(1, 1), b3 + hstep, voffB);
            PG8_WAIT_V(6); PG8_BAR; PG8_MMA(1, 1, At, B1); PG8_BAR;
            }
        }
        if constexpr (FP8) {
            asm volatile("s_nop 15\n\ts_nop 7" ::: "memory");
#pragma unroll
            for (int a_ = 0; a_ < 2; ++a_)
#pragma unroll
                for (int b_ = 0; b_ < 2; ++b_)
#pragma unroll
                    for (int m_ = 0; m_ < 4; ++m_) asm volatile("" : "+v"(acc[a_][b_][m_][0]), "+v"(acc[a_][b_][m_][1]));
        }
        if constexpr (ALIGN_EPI) { if (wr == 0) PG8_BAR; }
        if constexpr (!Epi::AFTER_DRAIN) { E(acc, cur, wr, wc, fr, fq); S.done(cur); }
        if (!has_next) break;
#pragma unroll
        for (int a = 0; a < 2; ++a)
#pragma unroll
            for (int b = 0; b < 2; ++b)
#pragma unroll
                for (int m = 0; m < 4; ++m)
#pragma unroll
                    for (int n = 0; n < 2; ++n) acc[a][b][m][n] = (f32x4){0.f, 0.f, 0.f, 0.f};
        cur = nxt; cA = nA; cB = nB; ++ui;
        if constexpr (ALIGN_EPI) { if (wr == 1) PG8_BAR; }
    }
    PG8_WAIT_V(0);
    if constexpr (!ALIGN_EPI) { if (wr == 0) PG8_BAR; }
    PG8_BAR;
    if constexpr (Epi::AFTER_DRAIN) { E.fused(acc, cur, wr, wc, fr, fq, lds, wid, lane); S.done(cur); }
#undef PG8_SA
#undef PG8_SB
#undef PG8_STAGE
#undef PG8_LDA
#undef PG8_LDB
#undef PG8_MMA
#undef PG8_WAIT_V
#undef PG8_WAIT_L
#undef PG8_BAR
#undef PG8_SCHED
}
}

#define LAS __attribute__((address_space(3)))
__device__ __forceinline__ unsigned pk2(float lo, float hi) { return (unsigned)f2bf(lo) | ((unsigned)f2bf(hi) << 16); }
__device__ __forceinline__ void transpose_item(const float* W, int K, int N, bf16_t* WT, float* scr, int item, int lane) {
    const int nblk = N / 32, kb = item / nblk, nbk = item % nblk, k0 = 64 * kb, n0 = 32 * nbk;
#pragma unroll 8
    for (int i = 0; i < 32; ++i) { const int kk = 2 * i + (lane >> 5); scr[kk * 33 + (lane & 31)] = W[(size_t)(k0 + kk) * N + n0 + (lane & 31)]; }
    asm volatile("s_waitcnt lgkmcnt(0)" ::: "memory");
    const int c = lane & 7;
#pragma unroll
    for (int j = 0; j < 4; ++j) { const int n = (lane >> 3) + 8 * j; const float* s = scr + (8 * c) * 33 + n;
        uint4 o; o.x = pk2(s[0 * 33], s[1 * 33]); o.y = pk2(s[2 * 33], s[3 * 33]); o.z = pk2(s[4 * 33], s[5 * 33]); o.w = pk2(s[6 * 33], s[7 * 33]);
        *(uint4*)(WT + (size_t)(n0 + n) * K + k0 + 8 * c) = o; }
    asm volatile("s_waitcnt lgkmcnt(0)" ::: "memory");
}
constexpr int CW_AMAX_WIN = 2048, CW_AMAX_WOUT = 2112, CW_WSCALE = 2176;
__device__ __forceinline__ void phase_amax(KP p, int bid, int nb, int wv_) {
    const int tid = opaque_tid(), lane = tid & 63;
    for (int t = 0; t < 2; ++t) {
        const float4* w = (const float4*)(t ? p->in[I_WOUT] : p->in[I_WIN]); const size_t n4 = (size_t)D * (t ? D : NPROJ) / 4;
        float am = 0.f;
        for (size_t i = (size_t)bid * NT + tid; i < n4; i += (size_t)nb * NT) { const float4 v = w[i]; am = fmaxf(am, fmaxf(fmaxf(fabsf(v.x), fabsf(v.y)), fmaxf(fabsf(v.z), fabsf(v.w)))); }
        am = wave_max(am);
        if (lane == 0) atomicMax((unsigned*)(p->ws + WS_CTL) + (t ? CW_AMAX_WOUT : CW_AMAX_WIN), __float_as_uint(am));
    }
}
__device__ __forceinline__ void transpose_item8(const float* W, int K, int N, unsigned char* WT, float* scr, int item, int lane, float sc) {
    const int nblk = N / 32, kb = item / nblk, nbk = item % nblk, k0 = 64 * kb, n0 = 32 * nbk;
#pragma unroll 8
    for (int i = 0; i < 32; ++i) { const int kk = 2 * i + (lane >> 5); scr[kk * 33 + (lane & 31)] = W[(size_t)(k0 + kk) * N + n0 + (lane & 31)]; }
    asm volatile("s_waitcnt lgkmcnt(0)" ::: "memory");
    const int c = lane & 3;
#pragma unroll
    for (int j = 0; j < 2; ++j) { const int n = (lane >> 2) + 16 * j; const float* s = scr + (16 * c) * 33 + n;
        uint4 o; o.x = pk4_fp8(s[0 * 33] * sc, s[1 * 33] * sc, s[2 * 33] * sc, s[3 * 33] * sc); o.y = pk4_fp8(s[4 * 33] * sc, s[5 * 33] * sc, s[6 * 33] * sc, s[7 * 33] * sc);
        o.z = pk4_fp8(s[8 * 33] * sc, s[9 * 33] * sc, s[10 * 33] * sc, s[11 * 33] * sc); o.w = pk4_fp8(s[12 * 33] * sc, s[13 * 33] * sc, s[14 * 33] * sc, s[15 * 33] * sc);
        *(uint4*)(WT + (size_t)(n0 + n) * K + k0 + 16 * c) = o; }
    asm volatile("s_waitcnt lgkmcnt(0)" ::: "memory");
}
__device__ __forceinline__ void phase_convert_weights8(KP p, float* lds, int bid, int nb, int wv_) {
    const int tid = opaque_tid(), lane = tid & 63, wave = tid >> 6;
    float* scr = lds + 4096 + wave * (64 * 33);
    const unsigned* ctl = (const unsigned*)(p->ws + WS_CTL);
    const float sc_in = pow2_scale_from_max(__uint_as_float(__hip_atomic_load(ctl + CW_AMAX_WIN, __ATOMIC_RELAXED, __HIP_MEMORY_SCOPE_AGENT))), sc_out = pow2_scale_from_max(__uint_as_float(__hip_atomic_load(ctl + CW_AMAX_WOUT, __ATOMIC_RELAXED, __HIP_MEMORY_SCOPE_AGENT)));
    if (bid == 0 && tid == 0) { ((float*)(p->ws + WS_CTL))[CW_WSCALE] = 1.f / sc_in; ((float*)(p->ws + WS_CTL))[CW_WSCALE + 1] = 1.f / sc_out; }
    const int gw = bid * 8 + wave, ngw = nb * 8;
    constexpr int I_IN = (D / 64) * (NPROJ / 32), I_SQ = (D / 64) * (D / 32);
    for (int it = gw; it < I_IN + I_SQ; it += ngw) {
        if (it < I_IN) transpose_item8(p->in[I_WIN], D, NPROJ, p->ws + WS_WIN_T, scr, it, lane, sc_in);
        else transpose_item8(p->in[I_WOUT], D, D, p->ws + WS_WOUT_T, scr, it - I_IN, lane, sc_out);
    }
}
__device__ __forceinline__ void phase_convert_weights(KP p, float* lds, int bid, int nb, int wv_) {
    const int tid = opaque_tid(), lane = tid & 63, wave = tid >> 6;
    float* scr = lds + wave * (64 * 33);
    const int gw = bid * 8 + wave, ngw = nb * 8;
    constexpr int I_SQ = (D / 64) * (D / 32), I_G = 8 * (128 / 64) * (128 / 32);
    constexpr int NITEMS = I_SQ + 2 * I_G;
    for (int it = gw; it < NITEMS; it += ngw) {
        int r = it;
        if (r < I_SQ) { transpose_item(p->in[I_WQ], D, D, (bf16_t*)(p->ws + WS_WQ_T), scr, r, lane); continue; } r -= I_SQ;
        if (r < I_G) { const int hd = r / 8; transpose_item(p->in[I_WGA] + hd * 16384, 128, 128, (bf16_t*)(p->ws + WS_WGA_T) + hd * 16384, scr, r % 8, lane); continue; } r -= I_G;
        { const int hd = r / 8; transpose_item(p->in[I_WGI] + hd * 16384, 128, 128, (bf16_t*)(p->ws + WS_WGI_T) + hd * 16384, scr, r % 8, lane); }
    }
    bf16_t* wsp = (bf16_t*)(p->ws + WS_WSPB); bf16_t* skb = (bf16_t*)(p->ws + WS_SKEYB);
    for (int e = bid * NT + tid; e < 8 * 128 * 128; e += nb * NT) { const int i = (e >> 7) & 127, j = e & 127; wsp[e] = f2bf(j <= i ? p->in[I_WSP][e] : 0.f); }
    for (int e = bid * NT + tid; e < 8 * 2 * 128 * 128; e += nb * NT) skb[e] = f2bf(p->in[I_SKEY][e]);
}

typedef short bf16x8_t __attribute__((ext_vector_type(8)));
typedef float f32x4_t __attribute__((ext_vector_type(4)));
typedef short s16x4_t __attribute__((ext_vector_type(4)));
constexpr float YMIX_SCALE = 8.f;
constexpr int XA_STRIDE = 272;
constexpr int LRU_XA = 0, LRU_SA = 34816, LRU_SB = LRU_SA + 16384, LRU_SEGP = LRU_SB + 16384, LRU_SEGH = LRU_SEGP + 2048;
__device__ __forceinline__ void phase_lru(KP p, unsigned char* lds, int bid, int nb, int wv_) {
    const int tid = opaque_tid(), lane = tid & 63, wave = tid >> 6, c16 = lane & 15, q = lane >> 4;
    const bf16_t* XL = (const bf16_t*)(p->ws + WS_PROJ); const bf16_t* YG = XL + (size_t)M * 1024; bf16_t* ymix = (bf16_t*)(p->ws + WS_YMIX);
    float* SA = (float*)(lds + LRU_SA); float* SB = (float*)(lds + LRU_SB); float* SEGP = (float*)(lds + LRU_SEGP); float* SEGH = (float*)(lds + LRU_SEGH);
    for (int unit = bid; unit < NB * 8 * 4; unit += nb) {
        const int b = unit >> 5, hd = (unit >> 2) & 7, cq = unit & 3;
        bf16x8_t wf[2][2][4];
#pragma unroll
        for (int gs = 0; gs < 2; ++gs)
#pragma unroll
            for (int nt = 0; nt < 2; ++nt)
#pragma unroll
                for (int ks = 0; ks < 4; ++ks)
                    wf[gs][nt][ks] = *(const bf16x8_t*)((const bf16_t*)(p->ws + (gs ? WS_WGI_T : WS_WGA_T)) + ((size_t)(hd * 128 + cq * 32 + nt * 16 + c16) * 128 + ks * 32 + 8 * q));
        float ba[2], bi[2], c2[2];
#pragma unroll
        for (int nt = 0; nt < 2; ++nt) { const int ch = hd * 128 + cq * 32 + nt * 16 + c16; ba[nt] = p->in[I_BGA][ch]; bi[nt] = p->in[I_BGI][ch];
            const float lam = p->in[I_LAM][ch]; const float sp = fmaxf(-lam, 0.f) + log1pf(__expf(-fabsf(lam))); c2[nt] = -8.f * sp * 1.4426950408889634f; }
        const int o = tid & 15, rg = tid >> 4;
        float cw[4][8], cb[8];
#pragma unroll
        for (int e = 0; e < 8; ++e) { cb[e] = p->in[I_CONVB][hd * 128 + o * 8 + e];
#pragma unroll
            for (int k = 0; k < 4; ++k) cw[k][e] = p->in[I_CONVW][k * DLRU + hd * 128 + o * 8 + e]; }
        const int sc = tid & 31, seg = tid >> 5;
        float carry = 0.f;
        for (int ch = 0; ch < SEQ / 128; ++ch) {
            const int t0 = ch * 128; const size_t row0 = (size_t)b * SEQ + t0;
            bf16_t yg[8];
#pragma unroll
            for (int k = 0; k < 8; ++k) yg[k] = YG[(row0 + seg * 8 + k) * 1024 + hd * 128 + cq * 32 + sc];
            uint4 xr[7];
#pragma unroll
            for (int i = 0; i < 7; ++i) { const int t = t0 + 4 * rg - 3 + i; const int tc = t < 0 ? 0 : t; const unsigned keep = t < 0 ? 0u : 0xffffffffu;
                const uint4 w = *(const uint4*)(XL + ((size_t)b * SEQ + tc) * 1024 + hd * 128 + o * 8); xr[i] = make_uint4(w.x & keep, w.y & keep, w.z & keep, w.w & keep); }
#pragma unroll
            for (int r = 0; r < 4; ++r) {
                float acc8[8];
#pragma unroll
                for (int e = 0; e < 8; ++e) acc8[e] = cb[e];
#pragma unroll
                for (int k = 0; k < 4; ++k) { const uint4 w = xr[r + k]; const unsigned ww[4] = {w.x, w.y, w.z, w.w};
#pragma unroll
                    for (int e2 = 0; e2 < 4; ++e2) { acc8[2 * e2] += cw[k][2 * e2] * __uint_as_float(ww[e2] << 16); acc8[2 * e2 + 1] += cw[k][2 * e2 + 1] * __uint_as_float(ww[e2] & 0xffff0000u); } }
                uint4 ov; ov.x = pk2(acc8[0], acc8[1]); ov.y = pk2(acc8[2], acc8[3]); ov.z = pk2(acc8[4], acc8[5]); ov.w = pk2(acc8[6], acc8[7]);
                *(uint4*)(lds + LRU_XA + (4 * rg + r) * XA_STRIDE + o * 16) = ov;
            }
            __syncthreads();
            f32x4_t acc[2][2];
#pragma unroll
            for (int gs = 0; gs < 2; ++gs)
#pragma unroll
                for (int nt = 0; nt < 2; ++nt) acc[gs][nt] = (f32x4_t){0.f, 0.f, 0.f, 0.f};
#pragma unroll
            for (int ks = 0; ks < 4; ++ks) {
                const bf16x8_t a = *(const bf16x8_t*)(lds + LRU_XA + (16 * wave + c16) * XA_STRIDE + (ks * 32 + 8 * q) * 2);
#pragma unroll
                for (int gs = 0; gs < 2; ++gs)
#pragma unroll
                    for (int nt = 0; nt < 2; ++nt) acc[gs][nt] = __builtin_amdgcn_mfma_f32_16x16x32_bf16(a, wf[gs][nt][ks], acc[gs][nt], 0, 0, 0);
            }
#pragma unroll
            for (int nt = 0; nt < 2; ++nt)
#pragma unroll
                for (int reg = 0; reg < 4; ++reg) {
                    const int t = 16 * wave + 4 * q + reg, jj = nt * 16 + c16;
                    const float za = acc[0][nt][reg] + ba[nt], zi = acc[1][nt][reg] + bi[nt];
                    const float r = __builtin_amdgcn_rcpf(1.f + __expf(-za)), ig = __builtin_amdgcn_rcpf(1.f + __expf(-zi));
                    const float a = __builtin_amdgcn_exp2f(c2[nt] * r);
                    const float xcv = bf2f(*(const bf16_t*)(lds + LRU_XA + t * XA_STRIDE + (cq * 32 + jj) * 2));
                    SA[t * 32 + jj] = a; SB[t * 32 + jj] = __builtin_amdgcn_sqrtf(fmaxf(1.f - a * a, 0.f)) * (ig * xcv);
                }
            __syncthreads();
            float av[8], bv[8];
#pragma unroll
            for (int k = 0; k < 8; ++k) { av[k] = SA[(seg * 8 + k) * 32 + sc]; bv[k] = SB[(seg * 8 + k) * 32 + sc]; }
            float P = 1.f, H = 0.f;
#pragma unroll
            for (int k = 0; k < 8; ++k) { H = av[k] * H + bv[k]; P *= av[k]; }
            SEGP[seg * 32 + sc] = P; SEGH[seg * 32 + sc] = H;
            __syncthreads();
            float run = carry, hin = carry;
            int segl = seg; asm volatile("" : "+v"(segl));
#pragma unroll
            for (int s = 0; s < 16; ++s) { if (s == segl) hin = run; run = SEGP[s * 32 + sc] * run + SEGH[s * 32 + sc]; }
            carry = run;
            H = hin;
#pragma unroll
            for (int k = 0; k < 8; ++k) { H = av[k] * H + bv[k]; ((unsigned char*)ymix)[(row0 + seg * 8 + k) * D + hd * 128 + cq * 32 + sc] = (unsigned char)(pk4_fp8(H * bf2f(yg[k]) * YMIX_SCALE, 0.f, 0.f, 0.f) & 0xffu); }
        }
        __syncthreads();
    }
}

constexpr int SGU_RS = 0, SGU_TV = 512, SGU_SS = SGU_TV + 128 * XA_STRIDE, SS_STRIDE = 132;
__device__ __forceinline__ void phase_sgu(KP p, unsigned char* lds, int bid, int nb, int wv_) {
    const int tid = opaque_tid(), lane = tid & 63, wave = tid >> 6, c16 = lane & 15, q = lane >> 4;
    const bf16_t* UG = (const bf16_t*)(p->ws + WS_PROJ) + (size_t)2 * M * 1024; const bf16_t* VG = UG + (size_t)M * 1024;
    const float* ssqv = (const float*)(p->ws + WS_SSQV); bf16_t* ymix = (bf16_t*)(p->ws + WS_YMIX);
    float* RS = (float*)(lds + SGU_RS); float* SS = (float*)(lds + SGU_SS);
    bf16x8_t wa[8][4]; float gvv[8]; int gcur = -1;
    const int oct = tid & 15;
    for (int it = bid; it < NB * 16 * 8; it += nb) {
        const int g = it & 7; const size_t base = (size_t)(it >> 3) * 128;
        if (g != gcur) { gcur = g;
#pragma unroll
            for (int mt = 0; mt < 8; ++mt)
#pragma unroll
                for (int ks = 0; ks < 4; ++ks) if (ks <= ((16 * mt + 15) >> 5))
                    wa[mt][ks] = *(const bf16x8_t*)((const bf16_t*)(p->ws + WS_WSPB) + ((size_t)(g * 128 + mt * 16 + c16) * 128 + ks * 32 + 8 * q));
#pragma unroll
            for (int e = 0; e < 8; ++e) gvv[e] = p->in[I_GV][g * 128 + oct * 8 + e]; }
        uint4 vch[4], uch[4];
#pragma unroll
        for (int k = 0; k < 4; ++k) { const int row = (tid >> 4) + 32 * k; vch[k] = *(const uint4*)(VG + (base + row) * 1024 + g * 128 + oct * 8); uch[k] = *(const uint4*)(UG + (base + row) * 1024 + g * 128 + oct * 8); }
        if (tid < 128) { float ss = 0.f;
#pragma unroll
            for (int k = 0; k < 16; ++k) ss += ssqv[(base + tid) * 16 + k];
            RS[tid] = rsqrtf(ss * (1.f / 1024.f) + EPS); }
        __syncthreads();
#pragma unroll
        for (int k = 0; k < 4; ++k) { const int row = (tid >> 4) + 32 * k; const float r = RS[row]; const unsigned ww[4] = {vch[k].x, vch[k].y, vch[k].z, vch[k].w}; unsigned oo[4];
#pragma unroll
            for (int e2 = 0; e2 < 4; ++e2) oo[e2] = pk2(__uint_as_float(ww[e2] << 16) * r * gvv[2 * e2], __uint_as_float(ww[e2] & 0xffff0000u) * r * gvv[2 * e2 + 1]);
            *(uint4*)(lds + SGU_TV + row * XA_STRIDE + oct * 16) = make_uint4(oo[0], oo[1], oo[2], oo[3]); }
        __syncthreads();
        bf16x8_t bfr[4];
        { const int q4 = c16 >> 2, p4 = c16 & 3;
#pragma unroll
          for (int ks = 0; ks < 4; ++ks) {
              const unsigned a1 = SGU_TV + (ks * 32 + 8 * q + q4) * XA_STRIDE + (wave * 16 + 4 * p4) * 2;
              const s16x4_t lo = __builtin_amdgcn_ds_read_tr16_b64_v4i16((LAS s16x4_t*)(lds + a1));
              const s16x4_t hi = __builtin_amdgcn_ds_read_tr16_b64_v4i16((LAS s16x4_t*)(lds + a1 + 4 * XA_STRIDE));
              bfr[ks] = __builtin_shufflevector(lo, hi, 0, 1, 2, 3, 4, 5, 6, 7); } }
        f32x4_t acc[8];
#pragma unroll
        for (int mt = 0; mt < 8; ++mt) { acc[mt] = (f32x4_t){0.f, 0.f, 0.f, 0.f};
#pragma unroll
            for (int ks = 0; ks < 4; ++ks) if (ks <= ((16 * mt + 15) >> 5)) acc[mt] = __builtin_amdgcn_mfma_f32_16x16x32_bf16(wa[mt][ks], bfr[ks], acc[mt], 0, 0, 0); }
#pragma unroll
        for (int mt = 0; mt < 8; ++mt)
#pragma unroll
            for (int reg = 0; reg < 4; ++reg) { const int i = mt * 16 + 4 * q + reg; SS[i * SS_STRIDE + wave * 16 + c16] = acc[mt][reg] + p->in[I_BSP][g * 128 + i]; }
        __syncthreads();
#pragma unroll
        for (int k = 0; k < 4; ++k) { const int row = (tid >> 4) + 32 * k; const float4 s0 = *(const float4*)(SS + row * SS_STRIDE + oct * 8), s1 = *(const float4*)(SS + row * SS_STRIDE + oct * 8 + 4);
            const unsigned ww[4] = {uch[k].x, uch[k].y, uch[k].z, uch[k].w}; const float sv[8] = {s0.x, s0.y, s0.z, s0.w, s1.x, s1.y, s1.z, s1.w}; unsigned oo[4];
#pragma unroll
            for (int e2 = 0; e2 < 2; ++e2) oo[e2] = pk4_fp8(__uint_as_float(ww[2 * e2] << 16) * sv[4 * e2] * YMIX_SCALE, __uint_as_float(ww[2 * e2] & 0xffff0000u) * sv[4 * e2 + 1] * YMIX_SCALE,
                                                          __uint_as_float(ww[2 * e2 + 1] << 16) * sv[4 * e2 + 2] * YMIX_SCALE, __uint_as_float(ww[2 * e2 + 1] & 0xffff0000u) * sv[4 * e2 + 3] * YMIX_SCALE);
            *(uint2*)((unsigned char*)ymix + (base + row) * D + 1024 + g * 128 + oct * 8) = make_uint2(oo[0], oo[1]); }
        __syncthreads();
    }
}

typedef float f32x16_t __attribute__((ext_vector_type(16)));
__device__ __forceinline__ float vmaxf(float a, float b) { float r; asm("v_max_f32 %0, %1, %2" : "=v"(r) : "v"(a), "v"(b)); return r; }
__device__ __forceinline__ float vminf(float a, float b) { float r; asm("v_min_f32 %0, %1, %2" : "=v"(r) : "v"(a), "v"(b)); return r; }
#define CE_DESC(a, b) do { const float _mx = vmaxf(a, b), _mn = vminf(a, b); a = _mx; b = _mn; } while (0)
__device__ __forceinline__ void sort16_desc(float (&v)[16]) {
#pragma unroll
    for (int k = 2; k <= 16; k <<= 1)
#pragma unroll
        for (int j = k >> 1; j > 0; j >>= 1)
#pragma unroll
            for (int i = 0; i < 16; ++i) { const int l = i ^ j; if (l > i) { if ((i & k) == 0) CE_DESC(v[i], v[l]); else CE_DESC(v[l], v[i]); } }
}
__device__ __forceinline__ void merge16_desc(float (&a)[16], const float (&b)[16]) {
#pragma unroll
    for (int i = 0; i < 16; ++i) a[i] = vmaxf(a[i], b[15 - i]);
#pragma unroll
    for (int j = 8; j > 0; j >>= 1)
#pragma unroll
        for (int i = 0; i < 16; ++i) { const int l = i ^ j; if (l > i) CE_DESC(a[i], a[l]); }
}
__device__ __forceinline__ void topk_half(const bf16_t* qp, const unsigned char* kl, unsigned hh4, float (&X)[16]) {
    f32x16_t acc[4];
#pragma unroll
    for (int kt = 0; kt < 4; ++kt)
#pragma unroll
        for (int i = 0; i < 16; ++i) acc[kt][i] = 0.f;
#pragma unroll 4
    for (int ks = 0; ks < 8; ++ks) {
        const bf16x8_t bq = *(const bf16x8_t*)(qp + ks * 16);
#pragma unroll
        for (int kt = 0; kt < 4; ++kt) { const bf16x8_t ak = *(const bf16x8_t*)(kl + kt * 32 * XA_STRIDE + ks * 32); acc[kt] = __builtin_amdgcn_mfma_f32_32x32x16_bf16(ak, bq, acc[kt], 0, 0, 0); }
    }
    float g[4][16];
#pragma unroll
    for (int kt = 0; kt < 4; ++kt)
#pragma unroll
        for (int reg = 0; reg < 16; ++reg) g[kt][reg] = __uint_as_float(((__float_as_uint(acc[kt][reg]) & 0xFFFFFF80u) | hh4) | (unsigned)(kt * 32 + (reg & 3) + 8 * (reg >> 2)));
    sort16_desc(g[0]); sort16_desc(g[1]); __builtin_amdgcn_sched_barrier(0); merge16_desc(g[0], g[1]); __builtin_amdgcn_sched_barrier(0);
    sort16_desc(g[2]); sort16_desc(g[3]); __builtin_amdgcn_sched_barrier(0); merge16_desc(g[2], g[3]); __builtin_amdgcn_sched_barrier(0); merge16_desc(g[0], g[2]);
#pragma unroll
    for (int i = 0; i < 16; ++i) X[i] = g[0][i];
}
__device__ __forceinline__ unsigned pack_b0(float a, float b, float c, float d) {
    const unsigned ab = __builtin_amdgcn_perm(__float_as_uint(b), __float_as_uint(a), 0x0c0c0400u), cd = __builtin_amdgcn_perm(__float_as_uint(d), __float_as_uint(c), 0x0c0c0400u);
    return __builtin_amdgcn_perm(cd, ab, 0x05040100u);
}
__device__ __forceinline__ unsigned byte_lookup(const unsigned (&pk)[4], unsigned e) {
    const unsigned lo = __builtin_amdgcn_perm(pk[1], pk[0], e & 7u), hi = __builtin_amdgcn_perm(pk[3], pk[2], e & 7u);
    return ((e & 8u) ? hi : lo) & 0x7Fu;
}
__device__ __forceinline__ void phase_topk(KP p, unsigned char* lds, int bid, int nb, int wv_) {
    const int tid = opaque_tid(), lane = tid & 63, wave = tid >> 6, r32 = lane & 31, hh = lane >> 5;
    const bf16_t* Q = (const bf16_t*)(p->ws + WS_Q); const bf16_t* KB = (const bf16_t*)(p->ws + WS_SKEYB);
    int* idx = (int*)(p->ws + WS_IDX); float* gate = (float*)(p->ws + WS_GATE);
    const float NEG = -3.0e38f;
    int hcur = -1;
    for (int bi = bid; bi < NHEAD * (M / 256); bi += nb) {
        const int hd = bi & 7, tile = (bi >> 3) * 8 + wave; const size_t token = (size_t)tile * 32 + r32;
        if (hd != hcur) { hcur = hd; __syncthreads();
#pragma unroll
            for (int k = 0; k < 8; ++k) { const int c = tid + NT * k, row = c >> 4, o = c & 15;
                *(uint4*)(lds + row * XA_STRIDE + o * 16) = *(const uint4*)(KB + ((size_t)hd * 256 + row) * 128 + o * 8); }
            __syncthreads(); }
        float X0[16], X1[16];
        topk_half(Q + token * D + hd * 256 + 8 * hh, lds + r32 * XA_STRIDE + hh * 16, 4u * hh, X0);
        __builtin_amdgcn_sched_barrier(0);
        topk_half(Q + token * D + hd * 256 + 128 + 8 * hh, lds + (128 + r32) * XA_STRIDE + hh * 16, 4u * hh, X1);
        __builtin_amdgcn_sched_barrier(0);
#pragma unroll
        for (int i = 0; i < 16; ++i) { const auto r = __builtin_amdgcn_permlane32_swap(__float_as_uint(X0[i]), __float_as_uint(X1[i]), false, false); X0[i] = __uint_as_float(r[0]); X1[i] = __uint_as_float(r[1]); }
        merge16_desc(X0, X1);
        float U[16];
#pragma unroll
        for (int i = 0; i < 16; ++i) U[i] = __shfl_xor(X0[i], 32);
        const unsigned hbit = (unsigned)hh << 8;
        float c0[16], c1[16];
#pragma unroll
        for (int j = 0; j < 16; ++j) { float s = X0[0] + U[j]; if (j == 0) s = hh ? NEG : s; c0[j] = __uint_as_float(((__float_as_uint(s) & 0xFFFFFE00u) | hbit) | (unsigned)j); }
        {
            int n = 0;
#pragma unroll
            for (int i = 1; i < 4; ++i)
#pragma unroll
                for (int j = i; j < 16; ++j) if ((i + 1) * (j + 1) <= 16) { float s = X0[i] + U[j]; if (j == i) s = hh ? NEG : s; c1[n] = __uint_as_float(((__float_as_uint(s) & 0xFFFFFE00u) | hbit) | (unsigned)(i * 16 + j)); ++n; }
#pragma unroll
            for (int k = 11; k < 16; ++k) c1[k] = NEG;
        }
        sort16_desc(c0); sort16_desc(c1); merge16_desc(c0, c1);
        float F[16];
#pragma unroll
        for (int i = 0; i < 16; ++i) F[i] = vmaxf(c0[i], __shfl_xor(c0[15 - i], 32));
        float mx = F[0];
#pragma unroll
        for (int i = 1; i < 16; ++i) mx = vmaxf(mx, F[i]);
        float ev[16], sum = 0.f;
#pragma unroll
        for (int i = 0; i < 16; ++i) { ev[i] = __expf(F[i] - mx); sum += ev[i]; }
        const float inv = 1.f / sum;
        unsigned pt[4], pu[4], pa[4], pb[4];
#pragma unroll
        for (int w = 0; w < 4; ++w) { pt[w] = pack_b0(X0[4 * w], X0[4 * w + 1], X0[4 * w + 2], X0[4 * w + 3]); pu[w] = pack_b0(U[4 * w], U[4 * w + 1], U[4 * w + 2], U[4 * w + 3]); }
#pragma unroll
        for (int w = 0; w < 4; ++w) { pa[w] = hh ? pu[w] : pt[w]; pb[w] = hh ? pt[w] : pu[w]; }
        int oi[8]; float og[8];
#pragma unroll
        for (int k = 0; k < 8; ++k) {
            const unsigned pl = __float_as_uint(F[k]) & 0x1FFu, sw = pl >> 8, pi = (pl >> 4) & 15u, pj = pl & 15u;
            const unsigned ai = sw ? pj : pi, bj = sw ? pi : pj;
            oi[k] = (int)(byte_lookup(pa, ai) * NKEYS + byte_lookup(pb, bj)); og[k] = ev[k] * inv;
        }
        int* io = idx + token * NSEL + hd * TOPK + 8 * hh; float* go = gate + token * NSEL + hd * TOPK + 8 * hh;
        *(int4*)io = make_int4(oi[0], oi[1], oi[2], oi[3]); *(int4*)(io + 4) = make_int4(oi[4], oi[5], oi[6], oi[7]);
        *(float4*)go = make_float4(og[0], og[1], og[2], og[3]); *(float4*)(go + 4) = make_float4(og[4], og[5], og[6], og[7]);
    }
}

__device__ __forceinline__ void wave_argmax(float& v, int& i) {
#pragma unroll
    for (int off = 32; off >= 1; off >>= 1) { const float ov = __shfl_xor(v, off); const int oi = __shfl_xor(i, off); if (ov > v || (ov == v && oi < i)) { v = ov; i = oi; } }
}
__device__ __forceinline__ void topk_half_naive(const bf16_t* q, const float* k0, int lane, float& outv, int& outi) {
    const float NEG = -3.0e38f;
    const float* k1 = k0 + 64 * 128;
    float s0 = 0.f, s1 = 0.f;
    for (int k = 0; k < 128; k += 4) {
        const uint2 qq = *(const uint2*)(q + k);
        const float q0 = bf2f((bf16_t)(qq.x & 0xffff)), q1 = bf2f((bf16_t)(qq.x >> 16)), q2 = bf2f((bf16_t)(qq.y & 0xffff)), q3 = bf2f((bf16_t)(qq.y >> 16));
        const float4 a = *(const float4*)(k0 + k), b = *(const float4*)(k1 + k);
        s0 += q0 * a.x + q1 * a.y + q2 * a.z + q3 * a.w; s1 += q0 * b.x + q1 * b.y + q2 * b.z + q3 * b.w;
    }
    float myv = NEG; int myi = 0;
    for (int r = 0; r < TOPK; ++r) {
        float v; int i; if (s0 >= s1) { v = s0; i = lane; } else { v = s1; i = lane + 64; }
        wave_argmax(v, i);
        if (i == lane) s0 = NEG; if (i == lane + 64) s1 = NEG;
        if (lane == r) { myv = v; myi = i; }
    }
    outv = myv; outi = myi;
}
__device__ __forceinline__ void phase_topk_naive(KP p, int bid, int nb, int wv_) {
    const bf16_t* Q = (const bf16_t*)(p->ws + WS_Q); const float* keys = p->in[I_SKEY];
    int* idx = (int*)(p->ws + WS_IDX); float* gate = (float*)(p->ws + WS_GATE);
    const int tid = opaque_tid(), lane = tid & 63, wave = tid >> 6;
    const float NEG = -3.0e38f;
    for (int task = bid * 8 + wave; task < M * NHEAD; task += nb * 8) {
        const int token = task >> 3, hd = task & 7;
        float tv0, tv1; int ti0, ti1;
        topk_half_naive(Q + (size_t)token * D + hd * 256, keys + ((size_t)(hd * 2) * 128 + lane) * 128, lane, tv0, ti0);
        topk_half_naive(Q + (size_t)token * D + hd * 256 + 128, keys + ((size_t)(hd * 2 + 1) * 128 + lane) * 128, lane, tv1, ti1);
        const float vb = __shfl(tv1, lane & 15);
        float c0 = __shfl(tv0, (lane >> 4)) + vb, c1 = __shfl(tv0, (lane >> 4) + 4) + vb, c2 = __shfl(tv0, (lane >> 4) + 8) + vb, c3 = __shfl(tv0, (lane >> 4) + 12) + vb;
        float selv = NEG; int selc = 0;
        for (int r = 0; r < TOPK; ++r) {
            float v = c0; int i = lane;
            if (c1 > v) { v = c1; i = lane + 64; }
            if (c2 > v) { v = c2; i = lane + 128; }
            if (c3 > v) { v = c3; i = lane + 192; }
            wave_argmax(v, i);
            if (i == lane) c0 = NEG; if (i == lane + 64) c1 = NEG; if (i == lane + 128) c2 = NEG; if (i == lane + 192) c3 = NEG;
            if (lane == r) { selv = v; selc = i; }
        }
        const float mx = __shfl(selv, 0);
        const float e = lane < TOPK ? __expf(selv - mx) : 0.f;
        const float sum = wave_sum(e);
        const int i1 = __shfl(ti0, selc >> 4), i2 = __shfl(ti1, selc & 15);
        if (lane < TOPK) { idx[(size_t)token * NSEL + hd * TOPK + lane] = i1 * NKEYS + i2; gate[(size_t)token * NSEL + hd * TOPK + lane] = e / sum; }
    }
}

typedef float f32x2_t __attribute__((ext_vector_type(2)));
constexpr size_t GRP_BYTES = (size_t)NKEYS * NKEYS * 128;
constexpr int NGRP = D / 128;
__device__ __forceinline__ void phase_convert_experts(KP p, int bid, int nb, int wv_) {
    const int tid = opaque_tid(), lane = tid & 63, wave = tid >> 6;
    for (int row = bid * 8 + wave; row < 2 * NKEYS * NKEYS; row += nb * 8) {
        const int t = row >= NKEYS * NKEYS, e = row - t * NKEYS * NKEYS;
        const float* src = (t ? p->in[I_EV] : p->in[I_EU]) + (size_t)e * D;
        unsigned char* dst = p->ws + (t ? WS_EV8 : WS_EU8) + (size_t)e * 128 + (size_t)(lane >> 5) * GRP_BYTES + (lane & 31) * 4;
        float4 v[8]; float am = 0.f;
#pragma unroll
        for (int j = 0; j < 8; ++j) { v[j] = *(const float4*)(src + lane * 4 + 256 * j); am = fmaxf(am, fmaxf(fmaxf(fabsf(v[j].x), fabsf(v[j].y)), fmaxf(fabsf(v[j].z), fabsf(v[j].w)))); }
        am = wave_max(am);
        const float sc = am > 0.f ? 127.f / am : 0.f;
#pragma unroll
        for (int j = 0; j < 8; ++j) *(unsigned*)(dst + (size_t)(2 * j) * GRP_BYTES) = pk4_i8(v[j].x * sc, v[j].y * sc, v[j].z * sc, v[j].w * sc);
        if (lane == 0) ((float*)(p->ws + WS_ESCALE))[row] = am * (1.f / 127.f);
    }
}
__device__ __forceinline__ unsigned xb_xcc_id();
constexpr int PEER_TT = 16;
constexpr int PEER_NTILE = M / PEER_TT;
constexpr int CW_UQ = 4096, CW_VQ = 8192;
__device__ __forceinline__ float dpp_xor1(float v) { return __builtin_bit_cast(float, __builtin_amdgcn_update_dpp(0, __builtin_bit_cast(int, v), 0xB1, 0xF, 0xF, true)); }
__device__ __forceinline__ float dpp_xor2(float v) { return __builtin_bit_cast(float, __builtin_amdgcn_update_dpp(0, __builtin_bit_cast(int, v), 0x4E, 0xF, 0xF, true)); }
__device__ __forceinline__ float dpp_hmirror(float v) { return __builtin_bit_cast(float, __builtin_amdgcn_update_dpp(0, __builtin_bit_cast(int, v), 0x141, 0xF, 0xF, true)); }
__device__ __forceinline__ void pg_load_ids(const int* idx, size_t token, int k, unsigned c16, unsigned (&off)[16]) {
#pragma unroll
    for (int i = 0; i < 4; ++i) { const int4 v = *(const int4*)(idx + token * NSEL + 16 * k + 4 * i); off[4 * i] = ((unsigned)v.x << 7) + c16; off[4 * i + 1] = ((unsigned)v.y << 7) + c16; off[4 * i + 2] = ((unsigned)v.z << 7) + c16; off[4 * i + 3] = ((unsigned)v.w << 7) + c16; }
}
__device__ __forceinline__ void pg_load_lines(const unsigned char* tg, const unsigned (&off)[16], uint4 (&r)[16]) {
#pragma unroll
    for (int j = 0; j < 16; ++j) r[j] = *(const uint4*)(tg + off[j]);
}
typedef _Float16 h2_t __attribute__((ext_vector_type(2)));
__device__ __forceinline__ int dppi(int v, int ctrl_sel) { return ctrl_sel == 0 ? __builtin_amdgcn_update_dpp(0, v, 0xB1, 0xF, 0xF, true) : ctrl_sel == 1 ? __builtin_amdgcn_update_dpp(0, v, 0x4E, 0xF, 0xF, true) : __builtin_amdgcn_update_dpp(0, v, 0x141, 0xF, 0xF, true); }
__device__ __forceinline__ void pg_compute_u(const uint4 (&r)[16], const uint4 (&hw)[2], int* po, int c) {
    int d[16];
#pragma unroll
    for (int j = 0; j < 16; ++j) { int s = 0; s = __builtin_amdgcn_sdot4((int)r[j].x, (int)hw[0].x, s, false); s = __builtin_amdgcn_sdot4((int)r[j].y, (int)hw[0].y, s, false); s = __builtin_amdgcn_sdot4((int)r[j].z, (int)hw[0].z, s, false); s = __builtin_amdgcn_sdot4((int)r[j].w, (int)hw[0].w, s, false); d[j] = s; }
#pragma unroll
    for (int j = 0; j < 16; ++j) d[j] += dppi(d[j], 0);
#pragma unroll
    for (int j = 0; j < 16; ++j) d[j] += dppi(d[j], 1);
#pragma unroll
    for (int j = 0; j < 16; ++j) d[j] += dppi(d[j], 2);
    int p0 = 0, p1 = 0;
#pragma unroll
    for (int j = 0; j < 8; ++j) { p0 = (c == j) ? d[j] : p0; p1 = (c == j) ? d[j + 8] : p1; }
    po[0] = p0; po[8] = p1;
}
__device__ __forceinline__ void pg_compute_v(const uint4 (&r)[16], const f32x4_t (&aw)[4], float* xo, const float* gtp, float* ssp, float asc, int k, int lane) {
    int acc[16];
#pragma unroll
    for (int m = 0; m < 16; ++m) acc[m] = 0;
    const uint4 a16 = __builtin_bit_cast(uint4, aw[0]); const unsigned aa[4] = {a16.x, a16.y, a16.z, a16.w};
#pragma unroll
    for (int jq = 0; jq < 4; ++jq) {
        const unsigned rr[4][4] = {{r[4 * jq].x, r[4 * jq].y, r[4 * jq].z, r[4 * jq].w}, {r[4 * jq + 1].x, r[4 * jq + 1].y, r[4 * jq + 1].z, r[4 * jq + 1].w},
                                   {r[4 * jq + 2].x, r[4 * jq + 2].y, r[4 * jq + 2].z, r[4 * jq + 2].w}, {r[4 * jq + 3].x, r[4 * jq + 3].y, r[4 * jq + 3].z, r[4 * jq + 3].w}};
#pragma unroll
        for (int cc = 0; cc < 4; ++cc) {
            const unsigned t0 = __builtin_amdgcn_perm(rr[1][cc], rr[0][cc], 0x05010400u), t1 = __builtin_amdgcn_perm(rr[1][cc], rr[0][cc], 0x07030602u);
            const unsigned t2 = __builtin_amdgcn_perm(rr[3][cc], rr[2][cc], 0x05010400u), t3 = __builtin_amdgcn_perm(rr[3][cc], rr[2][cc], 0x07030602u);
            acc[4 * cc + 0] = __builtin_amdgcn_sdot4((int)__builtin_amdgcn_perm(t2, t0, 0x05040100u), (int)aa[jq], acc[4 * cc + 0], false);
            acc[4 * cc + 1] = __builtin_amdgcn_sdot4((int)__builtin_amdgcn_perm(t2, t0, 0x07060302u), (int)aa[jq], acc[4 * cc + 1], false);
            acc[4 * cc + 2] = __builtin_amdgcn_sdot4((int)__builtin_amdgcn_perm(t3, t1, 0x05040100u), (int)aa[jq], acc[4 * cc + 2], false);
            acc[4 * cc + 3] = __builtin_amdgcn_sdot4((int)__builtin_amdgcn_perm(t3, t1, 0x07060302u), (int)aa[jq], acc[4 * cc + 3], false);
        }
    }
    int b8[8];
#pragma unroll
    for (int m = 0; m < 8; ++m) { const int keep = (k & 1) ? acc[8 + m] : acc[m], send = (k & 1) ? acc[m] : acc[8 + m]; b8[m] = keep + __shfl_xor(send, 8); }
    int b4[4];
#pragma unroll
    for (int m = 0; m < 4; ++m) { const int keep = (k & 2) ? b8[4 + m] : b8[m], send = (k & 2) ? b8[m] : b8[4 + m]; b4[m] = keep + __shfl_xor(send, 16); }
    int o2[2];
#pragma unroll
    for (int m = 0; m < 2; ++m) { const int keep = (k & 4) ? b4[2 + m] : b4[m], send = (k & 4) ? b4[m] : b4[2 + m]; o2[m] = keep + __shfl_xor(send, 32); }
    const float2 x1 = *(const float2*)xo; const float2 gt = *(const float2*)gtp;
    const float y0 = x1.x + gt.x * ((float)o2[0] * asc), y1 = x1.y + gt.y * ((float)o2[1] * asc);
    *(float2*)xo = make_float2(y0, y1);
    const float ss = wave_sum(y0 * y0 + y1 * y1);
    if (lane == 0) *ssp = ss;
}
template <bool VPASS>
__device__ __forceinline__ void phase_peer_gather(KP p, float* lds, int bid, int nb, int wv_) {
    const int tid = opaque_tid(), lane = tid & 63, k = lane >> 3, c = lane & 7;
    const unsigned char* H8 = p->ws + WS_H8I; const int* idx = (const int*)(p->ws + WS_IDX); const float* ascp = (const float*)(p->ws + WS_ASC);
    const unsigned char* TAB = p->ws + (VPASS ? WS_EV8 : WS_EU8);
    int* pdot = (int*)(p->ws + WS_PDOT); const unsigned char* act = p->ws + WS_ACT; float* ssq2 = (float*)(p->ws + WS_SSQ2);
    unsigned* ctr = (unsigned*)(p->ws + WS_CTL) + (VPASS ? CW_VQ : CW_UQ);
    if (VPASS) { for (int i = tid; i < NB * D; i += NT) lds[i] = mod_at(p, i >> 11, 5 * D + (i & (D - 1))); __syncthreads(); }
    const unsigned slot0 = xb_xcc_id() & 7u, c16 = 16u * (unsigned)c;
    const int vcol = 16 * c + 8 * (k & 1) + 4 * ((k >> 1) & 1) + 2 * (k >> 2);
    for (int sl = 0; sl < 8; ++sl) {
        const int slot = (int)((slot0 + sl) & 7u);
        for (;;) {
            unsigned q = 0; if (lane == 0) q = __hip_atomic_fetch_add(ctr + 64 * slot, 1u, __ATOMIC_RELAXED, __HIP_MEMORY_SCOPE_AGENT);
            q = (unsigned)__builtin_amdgcn_readfirstlane((int)q);
            if (q >= 2u * PEER_NTILE) break;
            const int g = slot * 2 + (int)(q / PEER_NTILE), tile = (int)(q % PEER_NTILE);
            const unsigned char* tg = TAB + (size_t)g * GRP_BYTES;
            const size_t tok0 = (size_t)tile * PEER_TT;
            unsigned oA[16], oB[16]; uint4 rA[16], rB[16]; uint4 hA[2], hB[2]; f32x4_t aA[4], aB[4];
#define PG_AUX(tok, hX, aX) do { if (!VPASS) { hX[0] = *(const uint4*)(H8 + (tok) * D + g * 128 + 16 * c); } \
            else { aX[0] = *(const f32x4_t*)(act + (tok) * NSEL + 16 * k); aX[1][0] = ascp[(tok)]; } } while (0)
#define PG_COMPUTE(tok, rX, hX, aX) do { if (!VPASS) pg_compute_u(rX, hX, pdot + ((size_t)g * M + (tok)) * NSEL + 16 * k + c, c); \
            else pg_compute_v(rX, aX, p->out + (tok) * D + g * 128 + vcol, lds + ((tok) / SEQ) * D + g * 128 + vcol, ssq2 + (size_t)g * M + (tok), aX[1][0], k, lane); } while (0)
            pg_load_ids(idx, tok0, k, c16, oA); pg_load_lines(tg, oA, rA); PG_AUX(tok0, hA, aA); pg_load_ids(idx, tok0 + 1, k, c16, oB);
            for (int tt = 0; tt < PEER_TT; tt += 2) {
                pg_load_lines(tg, oB, rB); PG_AUX(tok0 + tt + 1, hB, aB);
                if (tt + 2 < PEER_TT) pg_load_ids(idx, tok0 + tt + 2, k, c16, oA);
                PG_COMPUTE(tok0 + tt, rA, hA, aA);
                if (tt + 2 < PEER_TT) { pg_load_lines(tg, oA, rA); PG_AUX(tok0 + tt + 2, hA, aA); pg_load_ids(idx, tok0 + tt + 3, k, c16, oB); }
                PG_COMPUTE(tok0 + tt + 1, rB, hB, aB);
            }
#undef PG_AUX
#undef PG_COMPUTE
        }
    }
}
__device__ __forceinline__ void phase_peer_act(KP p, int bid, int nb, int wv_) {
    const int tid = opaque_tid(), lane = tid & 63, wave = tid >> 6;
    const int* idx = (const int*)(p->ws + WS_IDX); const float* gate = (const float*)(p->ws + WS_GATE); const float* esc = (const float*)(p->ws + WS_ESCALE);
    const int* pdot = (const int*)(p->ws + WS_PDOT); signed char* act = (signed char*)(p->ws + WS_ACT);
    for (int token = bid * 8 + wave; token < M; token += nb * 8) {
        int d0 = 0, d1 = 0;
#pragma unroll
        for (int g = 0; g < NGRP; ++g) { d0 += pdot[((size_t)g * M + token) * NSEL + lane]; d1 += pdot[((size_t)g * M + token) * NSEL + 64 + lane]; }
        const int e0 = idx[(size_t)token * NSEL + lane], e1 = idx[(size_t)token * NSEL + 64 + lane];
        const float hs = ((const float*)(p->ws + WS_HSC))[token];
        const float a0 = gelu_t((float)d0 * (esc[e0] * hs)) * gate[(size_t)token * NSEL + lane] * esc[NKEYS * NKEYS + e0];
        const float a1 = gelu_t((float)d1 * (esc[e1] * hs)) * gate[(size_t)token * NSEL + 64 + lane] * esc[NKEYS * NKEYS + e1];
        const float am = wave_max(fmaxf(fabsf(a0), fabsf(a1))); const float sc = am > 0.f ? 127.f / am : 0.f;
        act[(size_t)token * NSEL + lane] = (signed char)__float2int_rn(a0 * sc); act[(size_t)token * NSEL + 64 + lane] = (signed char)__float2int_rn(a1 * sc);
        if (lane == 0) ((float*)(p->ws + WS_ASC))[token] = am * (1.f / 127.f);
    }
}
__device__ __forceinline__ void phase_final_norm(KP p, int bid, int nb, int wv_) {
    const int tid = opaque_tid(), lane = tid & 63, wave = tid >> 6;
    const float* ssq2 = (const float*)(p->ws + WS_SSQ2); const float* gf = p->in[I_GFIN];
    for (int token = bid * 8 + wave; token < M; token += nb * 8) {
        float ss = 0.f;
#pragma unroll
        for (int g = 0; g < NGRP; ++g) ss += ssq2[(size_t)g * M + token];
        const float rstd = rsqrtf(ss * (1.f / D) + EPS);
        float* row = p->out + (size_t)token * D;
#pragma unroll
        for (int j = 0; j < 8; ++j) { const int col = lane * 4 + 256 * j; const float4 v = *(const float4*)(row + col); const float4 g4 = *(const float4*)(gf + col);
            *(float4*)(row + col) = make_float4(v.x * rstd * g4.x, v.y * rstd * g4.y, v.z * rstd * g4.z, v.w * rstd * g4.w); }
    }
}

#define XB_TMO      128
#define XB_XCNT(j)  (256  + 64 * (j))
#define XB_XSUB(j)  (1280 + 64 * (j))
#define XB_XGEN(j)  (2304 + 64 * (j))
#define XB_TOP      3328
#define XB_TOPGEN   3392
#define XCD_BAR_WORDS 3456
#define XB_SPIN_CAP (1u << 18)

__device__ __forceinline__ unsigned xb_ld(unsigned* p)              { return __hip_atomic_load(p, __ATOMIC_RELAXED, __HIP_MEMORY_SCOPE_AGENT); }
__device__ __forceinline__ unsigned xb_add(unsigned* p, unsigned v) { return __hip_atomic_fetch_add(p, v, __ATOMIC_RELAXED, __HIP_MEMORY_SCOPE_AGENT); }
__device__ __forceinline__ unsigned xb_xcc_id() { return (unsigned)__builtin_amdgcn_s_getreg((3 << 11) | 20) & 0xFu; }
#define XB_SPIN(cond, bar) do { unsigned _sp = 0; while (cond) { __builtin_amdgcn_s_sleep(1); \
    if ((++_sp & 255u) == 0u) { if (xb_ld(&(bar)[XB_TMO])) break; if (_sp > XB_SPIN_CAP) { atomicAdd(&(bar)[XB_TMO], 1u); break; } } } } while (0)

struct XcdBarrier {
    unsigned* bar; unsigned x;
    volatile LAS unsigned* st;
};

__device__ __forceinline__ XcdBarrier xcd_barrier_post(unsigned* bar, volatile LAS unsigned* st) {
    XcdBarrier b; b.bar = bar; b.x = xb_xcc_id(); b.st = st;
    if (threadIdx.x == 0) (void)xb_add(&bar[XB_XCNT(b.x)], 1u);
    return b;
}
__device__ __forceinline__ void xcd_barrier_complete(unsigned* bar, unsigned x, unsigned& nloc, unsigned& nx) {
    const unsigned G = gridDim.x * gridDim.y * gridDim.z;
    unsigned sum, cnt, mine, sp = 0u;
    for (;;) {
        sum = 0u; cnt = 0u; mine = 0u;
#pragma unroll
        for (unsigned j = 0; j < 16; ++j) { const unsigned c = xb_ld(&bar[XB_XCNT(j)]); sum += c; cnt += (c > 0u) ? 1u : 0u; mine = (j == x) ? c : mine; }
        if (sum == G) break;
        __builtin_amdgcn_s_sleep(1);
        if ((++sp & 255u) == 0u) { if (xb_ld(&bar[XB_TMO])) break; if (sp > XB_SPIN_CAP) { atomicAdd(&bar[XB_TMO], 1u); break; } }
    }
    nloc = mine > 0u ? mine : 1u; nx = cnt > 0u ? cnt : 1u;
}

__device__ __forceinline__ void xcd_barrier(const XcdBarrier& b, bool leader) {
    asm volatile("s_waitcnt vmcnt(0)" ::: "memory");
    __syncthreads();
    if (leader) {
        unsigned* bar = b.bar;
        __builtin_amdgcn_s_waitcnt(0);
        unsigned nloc = b.st[0], nx = b.st[1];
        if (nloc == 0u) { xcd_barrier_complete(bar, b.x, nloc, nx); b.st[0] = nloc; b.st[1] = nx; }
        const unsigned old = xb_add(&bar[XB_XSUB(b.x)], 1u);
        const unsigned gen = old / nloc;
        if (old + 1u == (gen + 1u) * nloc) {
            __builtin_amdgcn_fence(__ATOMIC_RELEASE, "agent");
            asm volatile("s_waitcnt vmcnt(0)" ::: "memory");
            const unsigned og = xb_add(&bar[XB_TOP], 1u);
            const unsigned tg = og / nx;
            if (og + 1u == (tg + 1u) * nx) xb_add(&bar[XB_TOPGEN], 1u);
            else XB_SPIN(xb_ld(&bar[XB_TOPGEN]) == tg, bar);
            __builtin_amdgcn_fence(__ATOMIC_ACQUIRE, "agent");
            xb_add(&bar[XB_XGEN(b.x)], 1u);
            asm volatile("s_waitcnt vmcnt(0)" ::: "memory");
        } else {
            XB_SPIN(xb_ld(&bar[XB_XGEN(b.x)]) == gen, bar);
            __builtin_amdgcn_fence(__ATOMIC_ACQUIRE, "agent");
            asm volatile("s_waitcnt vmcnt(0)" ::: "memory");
        }
    }
    __syncthreads();
}


extern __shared__ __attribute__((aligned(16))) unsigned char dyn_lds[];
constexpr int LDS_BYTES = 147456;
__global__ void __launch_bounds__(NT) fwd_megakernel(Params p_unused) {
    KP p = (KP)__builtin_amdgcn_kernarg_segment_ptr();
    float* lds = (float*)dyn_lds;
    const int bid = blockIdx.x, nb = gridDim.x, wv_ = __builtin_amdgcn_readfirstlane((int)(threadIdx.x >> 6));
    volatile LAS unsigned* bst = (volatile LAS unsigned*)((LAS unsigned char*)dyn_lds + LDS_BYTES - 16);
    if (threadIdx.x < 4) bst[threadIdx.x] = 0u;
    __syncthreads();
    (void)xcd_barrier_post((unsigned*)(p->ws + WS_CTL), bst);
#define GRID_BAR() do { XcdBarrier xb_; xb_.bar = (unsigned*)(p->ws + WS_CTL); xb_.x = xb_xcc_id(); xb_.st = (volatile LAS unsigned*)((LAS unsigned char*)dyn_lds + LDS_BYTES - 16); xcd_barrier(xb_, opaque_tid() == 0); } while (0)
    phase_mod(p, lds, bid, nb, wv_);
    __syncthreads();
    phase_convert_weights(p, lds, bid, nb, wv_);
    phase_amax(p, bid, nb, wv_);
    phase_convert_experts(p, bid, nb, wv_);
    cg::this_grid().sync();
    phase_hrows<true>(p, p->in[I_X], p->in[I_GMIX], 0, D, (bf16_t*)(p->ws + WS_H), lds, bid, nb, wv_);
    phase_convert_weights8(p, lds, bid, nb, wv_);
    GRID_BAR();
    { pg8::Gemm g{(const bf16_t*)(p->ws + WS_H), (const bf16_t*)(p->ws + WS_WIN_T), M, NPROJ, D / 2}; pg8::StaticOrder S; S.init(M, NPROJ, nb, bid);
      pg8::EpiProj E{(bf16_t*)(p->ws + WS_PROJ), (float*)(p->ws + WS_SSQV), M, (const float*)(p->ws + WS_HSCALE1), (const float*)(p->ws + WS_CTL) + CW_WSCALE};
      pg8::gemm_phase<pg8::EpiProj, pg8::StaticOrder, true, true, true>((LAS unsigned char*)dyn_lds, g, S, E, wv_); }
    GRID_BAR();
    phase_lru(p, dyn_lds, bid, nb, wv_);
    phase_sgu(p, dyn_lds, bid, nb, wv_);
    GRID_BAR();
    { pg8::Gemm g{(const bf16_t*)(p->ws + WS_YMIX), (const bf16_t*)(p->ws + WS_WOUT_T), M, D, D / 2}; pg8::StaticOrder S; S.init(M, D, nb, bid);
      pg8::EpiX1 E{p->in[I_X], p->out, (const float*)(p->ws + WS_MODP), p->in[I_BADA], 2 * D, NMOD, SEQ, (const float*)(p->ws + WS_CTL) + CW_WSCALE + 1, 1.f / YMIX_SCALE};
      pg8::gemm_phase<pg8::EpiX1, pg8::StaticOrder, true, true, true>((LAS unsigned char*)dyn_lds, g, S, E, wv_); }
    GRID_BAR();
    phase_hrows<false, true>(p, p->out, p->in[I_GFFN], 3 * D, 4 * D, (bf16_t*)(p->ws + WS_H), lds, bid, nb, wv_);
    GRID_BAR();
    { pg8::Gemm g{(const bf16_t*)(p->ws + WS_H), (const bf16_t*)(p->ws + WS_WQ_T), M, D, D}; pg8::StaticOrder S; S.init(M, D, nb, bid);
      pg8::EpiQ E{(bf16_t*)(p->ws + WS_Q), D};
      pg8::gemm_phase<pg8::EpiQ, pg8::StaticOrder, true, true>((LAS unsigned char*)dyn_lds, g, S, E, wv_); }
    GRID_BAR();
    phase_topk(p, dyn_lds, bid, nb, wv_);
    GRID_BAR();
    phase_peer_gather<false>(p, lds, bid, nb, wv_);
    GRID_BAR();
    phase_peer_act(p, bid, nb, wv_);
    GRID_BAR();
    phase_peer_gather<true>(p, lds, bid, nb, wv_);
    GRID_BAR();
    phase_final_norm(p, bid, nb, wv_);
}

extern "C" void kernel_launch(void* const* d_in, const int* in_sizes, int n_in, void* d_out, int out_size, void* d_ws, size_t ws_size, hipStream_t stream) {
    static int grid_blocks = 0;
    if (grid_blocks == 0) {
        if (n_in != 23 || in_sizes[0] != M * D || out_size != M * D || ws_size < WS_END) { fprintf(stderr, "kernel_launch: unexpected shapes (n_in %d in0 %d out %d ws %zu)\n", n_in, n_in > 0 ? in_sizes[0] : -1, out_size, ws_size); grid_blocks = -1; return; }
        if (hipFuncSetAttribute((const void*)fwd_megakernel, hipFuncAttributeMaxDynamicSharedMemorySize, LDS_BYTES) != hipSuccess) { fprintf(stderr, "hipFuncSetAttribute failed\n"); grid_blocks = -1; return; }
        int dev = 0, cus = 0, per_cu = 0;
        hipGetDevice(&dev);
        hipDeviceGetAttribute(&cus, hipDeviceAttributeMultiprocessorCount, dev);
        if (hipOccupancyMaxActiveBlocksPerMultiprocessor(&per_cu, (const void*)fwd_megakernel, NT, LDS_BYTES) != hipSuccess || per_cu < 1) { fprintf(stderr, "occupancy query failed (%d)\n", per_cu); grid_blocks = -1; return; }
        grid_blocks = cus;
    }
    if (grid_blocks < 0) return;
    Params p{};
    for (int i = 0; i < 23; ++i) p.in[i] = (const float*)d_in[i];
    p.out = (float*)d_out; p.ws = (unsigned char*)d_ws;
    if (hipMemsetAsync((char*)d_ws + WS_CTL, 0, 65536, stream) != hipSuccess) { fprintf(stderr, "hipMemsetAsync of the barrier words failed\n"); return; }
    void* args[] = {&p};
    hipError_t e = hipLaunchCooperativeKernel((const void*)fwd_megakernel, dim3(grid_blocks), dim3(NT), args, LDS_BYTES, stream);
    if (e != hipSuccess) fprintf(stderr, "cooperative launch failed: %s (grid %d)\n", hipGetErrorString(e), grid_blocks);
}
```

```cpp
#include <hip/hip_runtime.h>
#include <hip/hip_cooperative_groups.h>
#include <cstdio>
#include <cstdint>

constexpr int D = 2048, NB = 8, SEQ = 2048, M = NB * SEQ;
constexpr int DLRU = 1024, DSGU = 1024, NPROJ = 4096;
constexpr int NMOD = 6 * D;
constexpr int NHEAD = 8, NKEYS = 128, TOPK = 16, NSEL = NHEAD * TOPK;
constexpr float EPS = 1e-6f;
constexpr int NT = 512;
namespace cg = cooperative_groups;

constexpr size_t MiB = 1u << 20;
constexpr size_t WS_CTL = 0;
constexpr size_t WS_MODP = 1 * MiB;
constexpr size_t WS_WGA_T = 3 * MiB;
constexpr size_t WS_WGI_T = 3 * MiB + 262144;
constexpr size_t WS_WSPB = 3 * MiB + 524288;
constexpr size_t WS_SKEYB = 3 * MiB + 786432;
constexpr size_t WS_SSQV = 5 * MiB;
constexpr size_t WS_RSTDV = 8 * MiB;
constexpr size_t WS_WIN_T = 9 * MiB;
constexpr size_t WS_WOUT_T = 25 * MiB;
constexpr size_t WS_WQ_T = 33 * MiB;
constexpr size_t WS_IDX = 41 * MiB;
constexpr size_t WS_GATE = 49 * MiB;
constexpr size_t WS_H = 64 * MiB;
constexpr size_t WS_PROJ = 128 * MiB;
constexpr size_t WS_Q = 128 * MiB;
constexpr size_t WS_YMIX = 256 * MiB;
constexpr size_t WS_EU8 = 320 * MiB;
constexpr size_t WS_EV8 = 352 * MiB;
constexpr size_t WS_ESCALE = 57 * MiB;
constexpr size_t WS_XC = 320 * MiB;
constexpr size_t WS_A = 384 * MiB;
constexpr size_t WS_BB = 448 * MiB;
constexpr size_t WS_ACT = 256 * MiB;
constexpr size_t WS_SSQ2 = 264 * MiB;
constexpr size_t WS_PDOT = 384 * MiB;
constexpr size_t WS_HSCALE1 = 58 * MiB;
constexpr size_t WS_HSC = 59 * MiB;
constexpr size_t WS_ASC = 60 * MiB;
constexpr size_t WS_H8I = 288 * MiB;
constexpr size_t WS_Y16 = 128 * MiB;
constexpr size_t WS_END = 512 * MiB;

typedef unsigned short bf16_t;
struct Params { const float* in[23]; float* out; unsigned char* ws; };
typedef const __attribute__((address_space(4))) Params* KP;
enum { I_X = 0, I_C, I_WADA, I_BADA, I_GMIX, I_WIN, I_CONVW, I_CONVB, I_WGA, I_BGA, I_WGI, I_BGI, I_LAM, I_GV, I_WSP, I_BSP, I_WOUT, I_GFFN, I_WQ, I_SKEY, I_EU, I_EV, I_GFIN };

__device__ __forceinline__ int opaque_tid_(int wv) { asm volatile("" : "+s"(wv)); int t = wv * 64 + (int)__builtin_amdgcn_mbcnt_hi(~0u, __builtin_amdgcn_mbcnt_lo(~0u, 0u)); asm volatile("" : "+v"(t)); return t; }
#define opaque_tid() opaque_tid_(wv_)
__device__ __forceinline__ float bf2f(bf16_t v) { return __uint_as_float(((unsigned)v) << 16); }
__device__ __forceinline__ bf16_t f2bf(float f) { unsigned u = __float_as_uint(f); u += 0x7fffu + ((u >> 16) & 1u); return (bf16_t)(u >> 16); }
__device__ __forceinline__ float sigmoidf_(float x) { return 1.f / (1.f + __expf(-x)); }
__device__ __forceinline__ float gelu_t(float x) { const float u = 0.7978845608028654f * (x + 0.044715f * x * x * x); return x * sigmoidf_(2.f * u); }
__device__ __forceinline__ float wave_sum(float v) {
#pragma unroll
    for (int o = 1; o < 64; o <<= 1) v += __shfl_xor(v, o);
    return v;
}
__device__ __forceinline__ float wave_max(float v) {
#pragma unroll
    for (int o = 1; o < 64; o <<= 1) v = fmaxf(v, __shfl_xor(v, o));
    return v;
}
__device__ __forceinline__ float pow2_scale_from_max(float am) { int ex = 0; if (am > 0.f) (void)frexpf(am, &ex); else ex = 8; return ldexpf(1.f, 8 - ex); }
__device__ __forceinline__ unsigned pk4_fp8(float a, float b, float c, float d) {
    int w = __builtin_amdgcn_cvt_pk_fp8_f32(fminf(fmaxf(a, -448.f), 448.f), fminf(fmaxf(b, -448.f), 448.f), 0, false);
    return (unsigned)__builtin_amdgcn_cvt_pk_fp8_f32(fminf(fmaxf(c, -448.f), 448.f), fminf(fmaxf(d, -448.f), 448.f), w, true);
}
__device__ __forceinline__ unsigned pk4_i8(float a, float b, float c, float d) {
    const int ia = __float2int_rn(a), ib = __float2int_rn(b), ic = __float2int_rn(c), id = __float2int_rn(d);
    return ((unsigned)ia & 0xffu) | (((unsigned)ib & 0xffu) << 8) | (((unsigned)ic & 0xffu) << 16) | ((unsigned)id << 24);
}
__device__ __forceinline__ float mod_at(KP p, int b, int n) {
    const float* mp = (const float*)(p->ws + WS_MODP);
    float s = p->in[I_BADA][n];
#pragma unroll
    for (int kc = 0; kc < 4; ++kc) s += mp[(size_t)(kc * 8 + b) * NMOD + n];
    return s;
}

__device__ __forceinline__ void phase_mod(KP p, float* lds, int bid, int nb, int wv_) {
    const int tid = opaque_tid(), lane = tid & 63, wave = tid >> 6;
    const float* c = p->in[I_C]; const float* W = p->in[I_WADA];
    float* modp = (float*)(p->ws + WS_MODP);
    for (int i = tid; i < NB * D; i += NT) { const float v = c[i]; lds[i] = v * sigmoidf_(v); }
    __syncthreads();
    float* red = lds + NB * D;
    for (int item = bid; item < 192; item += nb) {
        const int nt = item % 48, kc = item / 48;
        const int n0 = nt * 256 + lane * 4, k0 = kc * 512 + wave * 64;
        float acc[8][4];
#pragma unroll
        for (int b = 0; b < 8; ++b)
#pragma unroll
            for (int j = 0; j < 4; ++j) acc[b][j] = 0.f;
        for (int kk = 0; kk < 64; ++kk) {
            const float4 w = *(const float4*)(W + (size_t)(k0 + kk) * NMOD + n0);
#pragma unroll
            for (int b = 0; b < 8; ++b) { const float s = lds[b * D + k0 + kk]; acc[b][0] += s * w.x; acc[b][1] += s * w.y; acc[b][2] += s * w.z; acc[b][3] += s * w.w; }
        }
#pragma unroll
        for (int b = 0; b < 8; ++b)
#pragma unroll
            for (int j = 0; j < 4; ++j) red[(wave * 32 + b * 4 + j) * 64 + lane] = acc[b][j];
        __syncthreads();
        for (int o = tid; o < 2048; o += NT) {
            const int b = o >> 8, nn = o & 255, ln = nn >> 2, j = nn & 3;
            float s = 0.f;
#pragma unroll
            for (int w = 0; w < 8; ++w) s += red[(w * 32 + b * 4 + j) * 64 + ln];
            modp[(size_t)(kc * 8 + b) * NMOD + nt * 256 + nn] = s;
        }
        __syncthreads();
    }
}

template <bool F8OUT, bool I8COPY = false>
__device__ __forceinline__ void phase_hrows(KP p, const float* src, const float* gn, int shift_off, int scale_off, bf16_t* dst, float* lds, int bid, int nb, int wv_) {
    const int tid = opaque_tid(), lane = tid & 63, wave = tid >> 6;
    float* Aw = lds; float* Bw = lds + D;
    for (int item = bid; item < M / 64; item += nb) {
        const int b = item / (SEQ / 64);
        for (int col = tid; col < D; col += NT) { Aw[col] = gn[col] * (1.f + mod_at(p, b, scale_off + col)); Bw[col] = mod_at(p, b, shift_off + col); }
        __syncthreads();
        for (int r = wave; r < 64; r += 8) {
            const size_t row = (size_t)item * 64 + r;
            float4 v[8]; float ss = 0.f;
#pragma unroll
            for (int j = 0; j < 8; ++j) { v[j] = *(const float4*)(src + row * D + lane * 4 + 256 * j); ss += v[j].x * v[j].x + v[j].y * v[j].y + v[j].z * v[j].z + v[j].w * v[j].w; }
            const float rstd = rsqrtf(wave_sum(ss) * (1.f / D) + EPS);
            float am = 0.f;
#pragma unroll
            for (int j = 0; j < 8; ++j) {
                const int col = lane * 4 + 256 * j;
                const float o0 = v[j].x * rstd * Aw[col] + Bw[col], o1 = v[j].y * rstd * Aw[col + 1] + Bw[col + 1];
                const float o2 = v[j].z * rstd * Aw[col + 2] + Bw[col + 2], o3 = v[j].w * rstd * Aw[col + 3] + Bw[col + 3];
                if (F8OUT || I8COPY) { v[j] = make_float4(o0, o1, o2, o3); am = fmaxf(am, fmaxf(fmaxf(fabsf(o0), fabsf(o1)), fmaxf(fabsf(o2), fabsf(o3)))); }
                if (!F8OUT) { uint2 w; w.x = (unsigned)f2bf(o0) | ((unsigned)f2bf(o1) << 16); w.y = (unsigned)f2bf(o2) | ((unsigned)f2bf(o3) << 16); *(uint2*)(dst + row * D + col) = w; }
            }
            if (I8COPY) {
                am = wave_max(am); const float sc = am > 0.f ? 127.f / am : 0.f;
                unsigned* d8 = (unsigned*)(p->ws + WS_H8I + row * D);
#pragma unroll
                for (int j = 0; j < 8; ++j) d8[lane + 64 * j] = pk4_i8(v[j].x * sc, v[j].y * sc, v[j].z * sc, v[j].w * sc);
                if (lane == 0) ((float*)(p->ws + WS_HSC))[row] = am * (1.f / 127.f);
            }
            if (F8OUT) {
                const float sc = pow2_scale_from_max(wave_max(am));
                unsigned* d8 = (unsigned*)((unsigned char*)dst + row * D);
#pragma unroll
                for (int j = 0; j < 8; ++j) d8[lane + 64 * j] = pk4_fp8(v[j].x * sc, v[j].y * sc, v[j].z * sc, v[j].w * sc);
                if (lane == 0) ((float*)(p->ws + WS_HSCALE1))[row] = 1.f / sc;
            }
        }
        __syncthreads();
    }
}

namespace pg8 {
#define PG8_LAS __attribute__((address_space(3)))
typedef unsigned short bf16_t;
typedef short bf16x8 __attribute__((ext_vector_type(8)));
typedef float f32x4 __attribute__((ext_vector_type(4)));
typedef unsigned u32x4 __attribute__((ext_vector_type(4)));
constexpr int BM = 256, BK = 64, HALF = 128, HTB = HALF * BK * 2  , STAGE_BYTES = 8 * HTB, NXCD = 8, WGM = 8;

__host__ __device__ __forceinline__ int lds_byte(int r, int c) { const int st = (r >> 4) * 2 + (c >> 5), rr = r & 15, cc = c & 31, ob = rr * 64 + cc * 2; return st * 1024 + (ob ^ (((ob >> 9) & 1) << 5)); }
__host__ __device__ __forceinline__ void stage_rc(int b, int& R, int& C) { const int st = b / 1024, sb = b % 1024, swz = sb ^ (((sb >> 9) & 1) << 5); R = (st >> 1) * 16 + swz / 64; C = (st & 1) * 32 + (swz % 64) / 2; }
__host__ __device__ __forceinline__ int perm32(int rho) { const int n = rho >> 4, i = rho & 15; return 8 * (i >> 2) + 4 * n + (i & 3); }

struct Unit { int pm, pn; };
struct Gemm { const bf16_t* A; const bf16_t* Bt; int M, N, K; };

struct StaticOrder {
    int nM, nN, nwg, G, c;
    __host__ __device__ void init(int M, int N, int G_, int c_) { nM = M / BM; nN = N / BM; nwg = nM * nN; G = G_; c = c_; }
    __host__ __device__ bool next(int i, Unit& u) const {
        const long L = (long)i * G + c; if (L >= nwg) return false;
        int wgid = (int)L; { const int q = nwg / NXCD, r = nwg % NXCD, xcd = wgid % NXCD, off = wgid / NXCD; wgid = (xcd < r ? xcd * (q + 1) : r * (q + 1) + (xcd - r) * q) + off; }
        const int nig = WGM * nN, gid = wgid / nig, fm = gid * WGM, gsz = (nM - fm) < WGM ? (nM - fm) : WGM;
        u.pm = fm + ((wgid % nig) % gsz); u.pn = (wgid % nig) / gsz; return true;
    }
    __device__ __forceinline__ void a_ready(const Unit&) const {}
    __device__ __forceinline__ void done(const Unit&) const {}
};


__device__ __forceinline__ unsigned cvt_pk_bf16(float lo, float hi) { unsigned r; asm volatile("v_cvt_pk_bf16_f32 %0, %1, %2" : "=v"(r) : "v"(lo), "v"(hi)); return r; }
__device__ __forceinline__ float gelu_tanh(float x) { const float u = 1.5957691216057308f * (x + 0.044715f * x * x * x); return x * __builtin_amdgcn_rcpf(1.f + __expf(-u)); }
struct EpiProj {
    static constexpr bool PERM = true, AFTER_DRAIN = false;
    bf16_t* proj; float* ssqv; int Mrows; const float* rowscale; const float* cscale;
    __device__ __forceinline__ void operator()(const f32x4 (&acc)[2][2][4][2], const Unit& u, int wr, int wc, int fr, int fq) const {
        const int which = (u.pn * BM) >> 10, colt = (u.pn * BM) & 1023; const float cs = *cscale;
        bf16_t* base = proj + (size_t)which * Mrows * 1024;
        const int row0 = u.pm * BM + wr * 64 + fr, col0 = colt + wc * 32 + 8 * fq;
#pragma unroll
        for (int ai = 0; ai < 2; ++ai)
#pragma unroll
            for (int m = 0; m < 4; ++m) { const int row = row0 + ai * HALF + m * 16; bf16_t* rowp = base + (size_t)row * 1024 + col0; float ss = 0.f; const float f = cs * rowscale[row];
#pragma unroll
                for (int bj = 0; bj < 2; ++bj) { f32x4 v0 = acc[ai][bj][m][0] * f, v1 = acc[ai][bj][m][1] * f;
                    if (which) {
#pragma unroll
                        for (int j = 0; j < 4; ++j) { v0[j] = gelu_tanh(v0[j]); v1[j] = gelu_tanh(v1[j]); } }
                    ss += (v0[0] * v0[0] + v0[1] * v0[1]) + (v0[2] * v0[2] + v0[3] * v0[3]) + (v1[0] * v1[0] + v1[1] * v1[1]) + (v1[2] * v1[2] + v1[3] * v1[3]);
                    u32x4 w; w.x = cvt_pk_bf16(v0[0], v0[1]); w.y = cvt_pk_bf16(v0[2], v0[3]); w.z = cvt_pk_bf16(v1[0], v1[1]); w.w = cvt_pk_bf16(v1[2], v1[3]);
                    *(u32x4*)(rowp + bj * HALF) = w; }
                if (which == 3) { ss += __shfl_xor(ss, 16); ss += __shfl_xor(ss, 32); if (fq == 0) ssqv[(size_t)row * 16 + (u.pn & 3) * 4 + wc] = ss; } }
    }
};
struct EpiX1 {
    static constexpr bool PERM = false, AFTER_DRAIN = false;
    const float* x; float* out; const float* modp; const float* bada; int goff, nmod, seq; const float* cscale; float cscale2;
    __device__ __forceinline__ void operator()(const f32x4 (&acc)[2][2][4][2], const Unit& u, int wr, int wc, int fr, int fq) const {
        const int row0 = u.pm * BM + wr * 64 + fr, col0 = u.pn * BM + wc * 32 + 4 * fq, b = (u.pm * BM) / seq;
        f32x4 gv[2][2];
#pragma unroll
        for (int bj = 0; bj < 2; ++bj)
#pragma unroll
            for (int n = 0; n < 2; ++n) { const int c = goff + col0 + bj * HALF + n * 16; f32x4 g = *(const f32x4*)(bada + c);
#pragma unroll
                for (int kc = 0; kc < 4; ++kc) g += *(const f32x4*)(modp + (size_t)(kc * 8 + b) * nmod + c);
                gv[bj][n] = g * (*cscale * cscale2); }
#pragma unroll
        for (int ai = 0; ai < 2; ++ai)
#pragma unroll
            for (int m = 0; m < 4; ++m) { const size_t off = (size_t)(row0 + ai * HALF + m * 16) * (size_t)(2048) + col0;
#pragma unroll
                for (int bj = 0; bj < 2; ++bj)
#pragma unroll
                    for (int n = 0; n < 2; ++n) { const f32x4 xv = *(const f32x4*)(x + off + bj * HALF + n * 16); *(f32x4*)(out + off + bj * HALF + n * 16) = xv + gv[bj][n] * acc[ai][bj][m][n]; } }
    }
};
struct EpiQ {
    static constexpr bool PERM = true, AFTER_DRAIN = false;
    bf16_t* O; int ldc;
    __device__ __forceinline__ void operator()(const f32x4 (&acc)[2][2][4][2], const Unit& u, int wr, int wc, int fr, int fq) const {
        const int row0 = u.pm * BM + wr * 64 + fr, col0 = u.pn * BM + wc * 32 + 8 * fq;
#pragma unroll
        for (int ai = 0; ai < 2; ++ai)
#pragma unroll
            for (int m = 0; m < 4; ++m) { bf16_t* rowp = O + (size_t)(row0 + ai * HALF + m * 16) * ldc + col0;
#pragma unroll
                for (int bj = 0; bj < 2; ++bj) { const f32x4 v0 = acc[ai][bj][m][0], v1 = acc[ai][bj][m][1];
                    u32x4 w; w.x = cvt_pk_bf16(v0[0], v0[1]); w.y = cvt_pk_bf16(v0[2], v0[3]); w.z = cvt_pk_bf16(v1[0], v1[1]); w.w = cvt_pk_bf16(v1[2], v1[3]);
                    *(u32x4*)(rowp + bj * HALF) = w; } }
    }
};

template <class Epi, class Sched, bool ALIGN_EPI = false, bool SP2 = false, bool FP8 = false>
__device__ __forceinline__ void gemm_phase(PG8_LAS unsigned char* lds, const Gemm g, const Sched& S, const Epi& E, int wv_) {
    const int tid = opaque_tid(), wid = __builtin_amdgcn_readfirstlane(tid >> 6), lane = tid & 63, wr = wid >> 2, wc = wid & 3, fr = lane & 15, fq = lane >> 4;
    const int K = g.K, nt = K / BK;
    unsigned voffA[2], voffB[2];
#pragma unroll
    for (int i = 0; i < 2; ++i) { int R, C; stage_rc(tid * 16 + i * 8192, R, C); const int Rb = Epi::PERM ? ((R & ~31) + perm32(R & 31)) : R;
        voffA[i] = (unsigned)(R * K + C) * 2u; voffB[i] = (unsigned)(Rb * K + C) * 2u; }
    const size_t kstep = (size_t)(BK * 2);
    const size_t hstep = (size_t)HALF * K * 2;
    const size_t tstep = 2 * hstep;
    const unsigned ldsw = (unsigned)wid * 1024u;
    const int aoff = lds_byte(wr * 64 + fr, fq * 8), boff = lds_byte(wc * 32 + fr, fq * 8);
#define PG8_SA(b, h) (((b) * 2 + (h)) * HTB)
#define PG8_SB(b, h) ((4 + (b) * 2 + (h)) * HTB)
#define PG8_STAGE(bufoff, gbase, voff) do { _Pragma("unroll") for (int _i = 0; _i < 2; ++_i) \
        __builtin_amdgcn_global_load_lds((const unsigned*)((const char*)(gbase) + (voff)[_i]), (PG8_LAS unsigned*)(lds + (bufoff) + ldsw + _i * 8192), 16, 0, 0); } while (0)
#define PG8_LDA(dst, b, h) do { _Pragma("unroll") for (int m = 0; m < 4; ++m) _Pragma("unroll") for (int k = 0; k < 2; ++k) dst[m][k] = *(const PG8_LAS bf16x8*)(lds + PG8_SA(b, h) + aoff + m * 2048 + k * 1024); } while (0)
#define PG8_LDB(dst, b, h) do { _Pragma("unroll") for (int n = 0; n < 2; ++n) _Pragma("unroll") for (int k = 0; k < 2; ++k) dst[n][k] = *(const PG8_LAS bf16x8*)(lds + PG8_SB(b, h) + boff + n * 2048 + k * 1024); } while (0)
#define PG8_MMA(ai, bj, At, Bt) do { __builtin_amdgcn_s_setprio(1); _Pragma("unroll") for (int m = 0; m < 4; ++m) _Pragma("unroll") for (int n = 0; n < 2; ++n) { \
        if constexpr (FP8) { typedef int v4i_ __attribute__((ext_vector_type(4))); typedef int v8i_ __attribute__((ext_vector_type(8))); \
            const v8i_ a8 = __builtin_shufflevector(__builtin_bit_cast(v4i_, Bt[n][0]), __builtin_bit_cast(v4i_, Bt[n][1]), 0, 1, 2, 3, 4, 5, 6, 7), b8 = __builtin_shufflevector(__builtin_bit_cast(v4i_, At[m][0]), __builtin_bit_cast(v4i_, At[m][1]), 0, 1, 2, 3, 4, 5, 6, 7); \
            asm volatile("v_mfma_scale_f32_16x16x128_f8f6f4 %0, %1, %2, %0, %3, %3 op_sel_hi:[0,0,0]" : "+v"(acc[ai][bj][m][n]) : "v"(a8), "v"(b8), "v"(one8)); } \
        else { _Pragma("unroll") for (int k = 0; k < 2; ++k) acc[ai][bj][m][n] = __builtin_amdgcn_mfma_f32_16x16x32_bf16(Bt[n][k], At[m][k], acc[ai][bj][m][n], 0, 0, 0); } } \
        __builtin_amdgcn_s_setprio(0); } while (0)
#define PG8_WAIT_V(n) asm volatile("s_waitcnt vmcnt(" #n ")" ::: "memory")
#define PG8_WAIT_L(n) asm volatile("s_waitcnt lgkmcnt(" #n ")" ::: "memory")
#define PG8_BAR __builtin_amdgcn_s_barrier()
#define PG8_SCHED __builtin_amdgcn_sched_barrier(0)
    Unit cur, nxt; int ui = 0;
    if (!S.next(0, cur)) return;
    f32x4 acc[2][2][4][2];
#pragma unroll
    for (int a = 0; a < 2; ++a)
#pragma unroll
        for (int b = 0; b < 2; ++b)
#pragma unroll
            for (int m = 0; m < 4; ++m)
#pragma unroll
                for (int n = 0; n < 2; ++n) acc[a][b][m][n] = (f32x4){0.f, 0.f, 0.f, 0.f};
    bf16x8 At[4][2], B0[2][2], B1[2][2];
    int one8 = 0x7F7F7F7F; asm volatile("" : "+v"(one8));
    const char* cA = (const char*)g.A + (size_t)cur.pm * tstep; const char* cB = (const char*)g.Bt + (size_t)cur.pn * tstep;
    S.a_ready(cur);
    if constexpr (SP2) {
        PG8_STAGE(PG8_SB(0, 0), cB, voffB); PG8_STAGE(PG8_SB(0, 1), cB + hstep, voffB); PG8_STAGE(PG8_SA(0, 0), cA, voffA); PG8_STAGE(PG8_SA(0, 1), cA + hstep, voffA);
        if (wr == 1) PG8_BAR;
        PG8_WAIT_V(2); PG8_BAR;
        PG8_STAGE(PG8_SB(1, 0), cB + kstep, voffB); PG8_STAGE(PG8_SA(1, 0), cA + kstep, voffA); PG8_STAGE(PG8_SB(1, 1), cB + hstep + kstep, voffB);
        PG8_WAIT_V(6); PG8_BAR;
    } else {
        PG8_STAGE(PG8_SB(0, 0), cB, voffB); PG8_STAGE(PG8_SA(0, 0), cA, voffA); PG8_STAGE(PG8_SB(0, 1), cB + hstep, voffB); PG8_STAGE(PG8_SA(0, 1), cA + hstep, voffA);
        if (wr == 1) PG8_BAR;
        PG8_WAIT_V(4); PG8_BAR;
        PG8_STAGE(PG8_SB(1, 0), cB + kstep, voffB); PG8_STAGE(PG8_SA(1, 0), cA + kstep, voffA); PG8_STAGE(PG8_SB(1, 1), cB + hstep + kstep, voffB);
        PG8_WAIT_V(6); PG8_BAR;
    }
    for (;;) {
        const bool has_next = S.next(ui + 1, nxt);
        const char* nA = has_next ? (const char*)g.A + (size_t)nxt.pm * tstep : cA; const char* nB = has_next ? (const char*)g.Bt + (size_t)nxt.pn * tstep : cB;
        for (int t = 0; t < nt; t += 2) {
            const bool last = (t == nt - 2);
            const char* a1 = cA + (size_t)(t + 1) * kstep;
            const char* a2 = last ? nA : cA + (size_t)(t + 2) * kstep; const char* b2 = last ? nB : cB + (size_t)(t + 2) * kstep;
            const char* a3 = a2 + kstep; const char* b3 = b2 + kstep;
            if (last && has_next) S.a_ready(nxt);
            if constexpr (SP2) {
            PG8_LDB(B0, 0, 0); PG8_LDB(B1, 0, 1); PG8_SCHED; PG8_LDA(At, 0, 0); PG8_STAGE(PG8_SA(1, 1), a1 + hstep, voffA);
            PG8_WAIT_V(8); PG8_WAIT_L(0); PG8_BAR; PG8_MMA(0, 0, At, B0); PG8_MMA(0, 1, At, B1); PG8_BAR; PG8_SCHED;
            PG8_LDA(At, 0, 1); PG8_STAGE(PG8_SB(0, 0), b2, voffB); PG8_STAGE(PG8_SB(0, 1), b2 + hstep, voffB); PG8_STAGE(PG8_SA(0, 0), a2, voffA);
            PG8_WAIT_V(8); PG8_WAIT_L(0); PG8_BAR; PG8_MMA(1, 0, At, B0); PG8_MMA(1, 1, At, B1); PG8_BAR; PG8_SCHED;
            PG8_LDB(B0, 1, 0); PG8_LDB(B1, 1, 1); PG8_SCHED; PG8_LDA(At, 1, 0); PG8_STAGE(PG8_SA(0, 1), a2 + hstep, voffA);
            PG8_WAIT_V(8); PG8_WAIT_L(0); PG8_BAR; PG8_MMA(0, 0, At, B0); PG8_MMA(0, 1, At, B1); PG8_BAR; PG8_SCHED;
            PG8_LDA(At, 1, 1); PG8_STAGE(PG8_SB(1, 0), b3, voffB); PG8_STAGE(PG8_SB(1, 1), b3 + hstep, voffB); PG8_STAGE(PG8_SA(1, 0), a3, voffA);
            PG8_WAIT_V(8); PG8_WAIT_L(0); PG8_BAR; PG8_MMA(1, 0, At, B0); PG8_MMA(1, 1, At, B1); PG8_BAR; PG8_SCHED;
            } else {
            PG8_LDB(B0, 0, 0); PG8_SCHED; PG8_LDA(At, 0, 0); PG8_STAGE(PG8_SA(1, 1), a1 + hstep, voffA);
            PG8_WAIT_L(8); PG8_BAR; PG8_WAIT_L(0); PG8_MMA(0, 0, At, B0); PG8_BAR; PG8_SCHED;
            PG8_LDB(B1, 0, 1); PG8_STAGE(PG8_SB(0, 0), b2, voffB);
            PG8_BAR; PG8_WAIT_L(0); PG8_MMA(0, 1, At, B1); PG8_BAR;
            PG8_LDA(At, 0, 1); PG8_STAGE(PG8_SA(0, 0), a2, voffA);
            PG8_BAR; PG8_WAIT_L(0); PG8_MMA(1, 0, At, B0); PG8_BAR; PG8_SCHED;
            PG8_STAGE(PG8_SB(0, 1), b2 + hstep, voffB);
            PG8_WAIT_V(6); PG8_BAR; PG8_MMA(1, 1, At, B1); PG8_BAR;
            PG8_LDB(B0, 1, 0); PG8_SCHED; PG8_LDA(At, 1, 0); PG8_STAGE(PG8_SA(0, 1), a2 + hstep, voffA);
            PG8_WAIT_L(8); PG8_BAR; PG8_WAIT_L(0); PG8_MMA(0, 0, At, B0); PG8_BAR; PG8_SCHED;
            PG8_LDB(B1, 1, 1); PG8_STAGE(PG8_SB(1, 0), b3, voffB);
            PG8_BAR; PG8_WAIT_L(0); PG8_MMA(0, 1, At, B1); PG8_BAR;
            PG8_LDA(At, 1, 1); PG8_STAGE(PG8_SA(1, 0), a3, voffA);
            PG8_BAR; PG8_WAIT_L(0); PG8_MMA(1, 0, At, B0); PG8_BAR; PG8_SCHED;
            PG8_STAGE(PG8_SB(1, 1), b3 + hstep, voffB);
            PG8_WAIT_V(6); PG8_BAR; PG8_MMA(1, 1, At, B1); PG8_BAR;
            }
        }
        if constexpr (FP8) {
            asm volatile("s_nop 15\n\ts_nop 7" ::: "memory");
#pragma unroll
            for (int a_ = 0; a_ < 2; ++a_)
#pragma unroll
                for (int b_ = 0; b_ < 2; ++b_)
#pragma unroll
                    for (int m_ = 0; m_ < 4; ++m_) asm volatile("" : "+v"(acc[a_][b_][m_][0]), "+v"(acc[a_][b_][m_][1]));
        }
        if constexpr (ALIGN_EPI) { if (wr == 0) PG8_BAR; }
        if constexpr (!Epi::AFTER_DRAIN) { E(acc, cur, wr, wc, fr, fq); S.done(cur); }
        if (!has_next) break;
#pragma unroll
        for (int a = 0; a < 2; ++a)
#pragma unroll
            for (int b = 0; b < 2; ++b)
#pragma unroll
                for (int m = 0; m < 4; ++m)
#pragma unroll
                    for (int n = 0; n < 2; ++n) acc[a][b][m][n] = (f32x4){0.f, 0.f, 0.f, 0.f};
        cur = nxt; cA = nA; cB = nB; ++ui;
        if constexpr (ALIGN_EPI) { if (wr == 1) PG8_BAR; }
    }
    PG8_WAIT_V(0);
    if constexpr (!ALIGN_EPI) { if (wr == 0) PG8_BAR; }
    PG8_BAR;
    if constexpr (Epi::AFTER_DRAIN) { E.fused(acc, cur, wr, wc, fr, fq, lds, wid, lane); S.done(cur); }
#undef PG8_SA
#undef PG8_SB
#undef PG8_STAGE
#undef PG8_LDA
#undef PG8_LDB
#undef PG8_MMA
#undef PG8_WAIT_V
#undef PG8_WAIT_L
#undef PG8_BAR
#undef PG8_SCHED
}
}

#define LAS __attribute__((address_space(3)))
__device__ __forceinline__ unsigned pk2(float lo, float hi) { return (unsigned)f2bf(lo) | ((unsigned)f2bf(hi) << 16); }
__device__ __forceinline__ void transpose_item(const float* W, int K, int N, bf16_t* WT, float* scr, int item, int lane) {
    const int nblk = N / 32, kb = item / nblk, nbk = item % nblk, k0 = 64 * kb, n0 = 32 * nbk;
#pragma unroll 8
    for (int i = 0; i < 32; ++i) { const int kk = 2 * i + (lane >> 5); scr[kk * 33 + (lane & 31)] = W[(size_t)(k0 + kk) * N + n0 + (lane & 31)]; }
    asm volatile("s_waitcnt lgkmcnt(0)" ::: "memory");
    const int c = lane & 7;
#pragma unroll
    for (int j = 0; j < 4; ++j) { const int n = (lane >> 3) + 8 * j; const float* s = scr + (8 * c) * 33 + n;
        uint4 o; o.x = pk2(s[0 * 33], s[1 * 33]); o.y = pk2(s[2 * 33], s[3 * 33]); o.z = pk2(s[4 * 33], s[5 * 33]); o.w = pk2(s[6 * 33], s[7 * 33]);
        *(uint4*)(WT + (size_t)(n0 + n) * K + k0 + 8 * c) = o; }
    asm volatile("s_waitcnt lgkmcnt(0)" ::: "memory");
}
constexpr int CW_AMAX_WIN = 2048, CW_AMAX_WOUT = 2112, CW_WSCALE = 2176;
__device__ __forceinline__ void phase_amax(KP p, int bid, int nb, int wv_) {
    const int tid = opaque_tid(), lane = tid & 63;
    for (int t = 0; t < 2; ++t) {
        const float4* w = (const float4*)(t ? p->in[I_WOUT] : p->in[I_WIN]); const size_t n4 = (size_t)D * (t ? D : NPROJ) / 4;
        float am = 0.f;
        for (size_t i = (size_t)bid * NT + tid; i < n4; i += (size_t)nb * NT) { const float4 v = w[i]; am = fmaxf(am, fmaxf(fmaxf(fabsf(v.x), fabsf(v.y)), fmaxf(fabsf(v.z), fabsf(v.w)))); }
        am = wave_max(am);
        if (lane == 0) atomicMax((unsigned*)(p->ws + WS_CTL) + (t ? CW_AMAX_WOUT : CW_AMAX_WIN), __float_as_uint(am));
    }
}
__device__ __forceinline__ void transpose_item8(const float* W, int K, int N, unsigned char* WT, float* scr, int item, int lane, float sc) {
    const int nblk = N / 32, kb = item / nblk, nbk = item % nblk, k0 = 64 * kb, n0 = 32 * nbk;
#pragma unroll 8
    for (int i = 0; i < 32; ++i) { const int kk = 2 * i + (lane >> 5); scr[kk * 33 + (lane & 31)] = W[(size_t)(k0 + kk) * N + n0 + (lane & 31)]; }
    asm volatile("s_waitcnt lgkmcnt(0)" ::: "memory");
    const int c = lane & 3;
#pragma unroll
    for (int j = 0; j < 2; ++j) { const int n = (lane >> 2) + 16 * j; const float* s = scr + (16 * c) * 33 + n;
        uint4 o; o.x = pk4_fp8(s[0 * 33] * sc, s[1 * 33] * sc, s[2 * 33] * sc, s[3 * 33] * sc); o.y = pk4_fp8(s[4 * 33] * sc, s[5 * 33] * sc, s[6 * 33] * sc, s[7 * 33] * sc);
        o.z = pk4_fp8(s[8 * 33] * sc, s[9 * 33] * sc, s[10 * 33] * sc, s[11 * 33] * sc); o.w = pk4_fp8(s[12 * 33] * sc, s[13 * 33] * sc, s[14 * 33] * sc, s[15 * 33] * sc);
        *(uint4*)(WT + (size_t)(n0 + n) * K + k0 + 16 * c) = o; }
    asm volatile("s_waitcnt lgkmcnt(0)" ::: "memory");
}
__device__ __forceinline__ void phase_convert_weights8(KP p, float* lds, int bid, int nb, int wv_) {
    const int tid = opaque_tid(), lane = tid & 63, wave = tid >> 6;
    float* scr = lds + 4096 + wave * (64 * 33);
    const unsigned* ctl = (const unsigned*)(p->ws + WS_CTL);
    const float sc_in = pow2_scale_from_max(__uint_as_float(__hip_atomic_load(ctl + CW_AMAX_WIN, __ATOMIC_RELAXED, __HIP_MEMORY_SCOPE_AGENT))), sc_out = pow2_scale_from_max(__uint_as_float(__hip_atomic_load(ctl + CW_AMAX_WOUT, __ATOMIC_RELAXED, __HIP_MEMORY_SCOPE_AGENT)));
    if (bid == 0 && tid == 0) { ((float*)(p->ws + WS_CTL))[CW_WSCALE] = 1.f / sc_in; ((float*)(p->ws + WS_CTL))[CW_WSCALE + 1] = 1.f / sc_out; }
    const int gw = bid * 8 + wave, ngw = nb * 8;
    constexpr int I_IN = (D / 64) * (NPROJ / 32), I_SQ = (D / 64) * (D / 32);
    for (int it = gw; it < I_IN + I_SQ; it += ngw) {
        if (it < I_IN) transpose_item8(p->in[I_WIN], D, NPROJ, p->ws + WS_WIN_T, scr, it, lane, sc_in);
        else transpose_item8(p->in[I_WOUT], D, D, p->ws + WS_WOUT_T, scr, it - I_IN, lane, sc_out);
    }
}
__device__ __forceinline__ void phase_convert_weights(KP p, float* lds, int bid, int nb, int wv_) {
    const int tid = opaque_tid(), lane = tid & 63, wave = tid >> 6;
    float* scr = lds + wave * (64 * 33);
    const int gw = bid * 8 + wave, ngw = nb * 8;
    constexpr int I_SQ = (D / 64) * (D / 32), I_G = 8 * (128 / 64) * (128 / 32);
    constexpr int NITEMS = I_SQ + 2 * I_G;
    for (int it = gw; it < NITEMS; it += ngw) {
        int r = it;
        if (r < I_SQ) { transpose_item(p->in[I_WQ], D, D, (bf16_t*)(p->ws + WS_WQ_T), scr, r, lane); continue; } r -= I_SQ;
        if (r < I_G) { const int hd = r / 8; transpose_item(p->in[I_WGA] + hd * 16384, 128, 128, (bf16_t*)(p->ws + WS_WGA_T) + hd * 16384, scr, r % 8, lane); continue; } r -= I_G;
        { const int hd = r / 8; transpose_item(p->in[I_WGI] + hd * 16384, 128, 128, (bf16_t*)(p->ws + WS_WGI_T) + hd * 16384, scr, r % 8, lane); }
    }
    bf16_t* wsp = (bf16_t*)(p->ws + WS_WSPB); bf16_t* skb = (bf16_t*)(p->ws + WS_SKEYB);
    for (int e = bid * NT + tid; e < 8 * 128 * 128; e += nb * NT) { const int i = (e >> 7) & 127, j = e & 127; wsp[e] = f2bf(j <= i ? p->in[I_WSP][e] : 0.f); }
    for (int e = bid * NT + tid; e < 8 * 2 * 128 * 128; e += nb * NT) skb[e] = f2bf(p->in[I_SKEY][e]);
}

typedef short bf16x8_t __attribute__((ext_vector_type(8)));
typedef float f32x4_t __attribute__((ext_vector_type(4)));
typedef short s16x4_t __attribute__((ext_vector_type(4)));
constexpr float YMIX_SCALE = 8.f;
constexpr int XA_STRIDE = 272;
constexpr int LRU_XA = 0, LRU_SA = 34816, LRU_SB = LRU_SA + 16384, LRU_SEGP = LRU_SB + 16384, LRU_SEGH = LRU_SEGP + 2048;
__device__ __forceinline__ void phase_lru(KP p, unsigned char* lds, int bid, int nb, int wv_) {
    const int tid = opaque_tid(), lane = tid & 63, wave = tid >> 6, c16 = lane & 15, q = lane >> 4;
    const bf16_t* XL = (const bf16_t*)(p->ws + WS_PROJ); const bf16_t* YG = XL + (size_t)M * 1024; bf16_t* ymix = (bf16_t*)(p->ws + WS_YMIX);
    float* SA = (float*)(lds + LRU_SA); float* SB = (float*)(lds + LRU_SB); float* SEGP = (float*)(lds + LRU_SEGP); float* SEGH = (float*)(lds + LRU_SEGH);
    for (int unit = bid; unit < NB * 8 * 4; unit += nb) {
        const int b = unit >> 5, hd = (unit >> 2) & 7, cq = unit & 3;
        bf16x8_t wf[2][2][4];
#pragma unroll
        for (int gs = 0; gs < 2; ++gs)
#pragma unroll
            for (int nt = 0; nt < 2; ++nt)
#pragma unroll
                for (int ks = 0; ks < 4; ++ks)
                    wf[gs][nt][ks] = *(const bf16x8_t*)((const bf16_t*)(p->ws + (gs ? WS_WGI_T : WS_WGA_T)) + ((size_t)(hd * 128 + cq * 32 + nt * 16 + c16) * 128 + ks * 32 + 8 * q));
        float ba[2], bi[2], c2[2];
#pragma unroll
        for (int nt = 0; nt < 2; ++nt) { const int ch = hd * 128 + cq * 32 + nt * 16 + c16; ba[nt] = p->in[I_BGA][ch]; bi[nt] = p->in[I_BGI][ch];
            const float lam = p->in[I_LAM][ch]; const float sp = fmaxf(-lam, 0.f) + log1pf(__expf(-fabsf(lam))); c2[nt] = -8.f * sp * 1.4426950408889634f; }
        const int o = tid & 15, rg = tid >> 4;
        float cw[4][8], cb[8];
#pragma unroll
        for (int e = 0; e < 8; ++e) { cb[e] = p->in[I_CONVB][hd * 128 + o * 8 + e];
#pragma unroll
            for (int k = 0; k < 4; ++k) cw[k][e] = p->in[I_CONVW][k * DLRU + hd * 128 + o * 8 + e]; }
        const int sc = tid & 31, seg = tid >> 5;
        float carry = 0.f;
        for (int ch = 0; ch < SEQ / 128; ++ch) {
            const int t0 = ch * 128; const size_t row0 = (size_t)b * SEQ + t0;
            bf16_t yg[8];
#pragma unroll
            for (int k = 0; k < 8; ++k) yg[k] = YG[(row0 + seg * 8 + k) * 1024 + hd * 128 + cq * 32 + sc];
            uint4 xr[7];
#pragma unroll
            for (int i = 0; i < 7; ++i) { const int t = t0 + 4 * rg - 3 + i; const int tc = t < 0 ? 0 : t; const unsigned keep = t < 0 ? 0u : 0xffffffffu;
                const uint4 w = *(const uint4*)(XL + ((size_t)b * SEQ + tc) * 1024 + hd * 128 + o * 8); xr[i] = make_uint4(w.x & keep, w.y & keep, w.z & keep, w.w & keep); }
#pragma unroll
            for (int r = 0; r < 4; ++r) {
                float acc8[8];
#pragma unroll
                for (int e = 0; e < 8; ++e) acc8[e] = cb[e];
#pragma unroll
                for (int k = 0; k < 4; ++k) { const uint4 w = xr[r + k]; const unsigned ww[4] = {w.x, w.y, w.z, w.w};
#pragma unroll
                    for (int e2 = 0; e2 < 4; ++e2) { acc8[2 * e2] += cw[k][2 * e2] * __uint_as_float(ww[e2] << 16); acc8[2 * e2 + 1] += cw[k][2 * e2 + 1] * __uint_as_float(ww[e2] & 0xffff0000u); } }
                uint4 ov; ov.x = pk2(acc8[0], acc8[1]); ov.y = pk2(acc8[2], acc8[3]); ov.z = pk2(acc8[4], acc8[5]); ov.w = pk2(acc8[6], acc8[7]);
                *(uint4*)(lds + LRU_XA + (4 * rg + r) * XA_STRIDE + o * 16) = ov;
            }
            __syncthreads();
            f32x4_t acc[2][2];
#pragma unroll
            for (int gs = 0; gs < 2; ++gs)
#pragma unroll
                for (int nt = 0; nt < 2; ++nt) acc[gs][nt] = (f32x4_t){0.f, 0.f, 0.f, 0.f};
#pragma unroll
            for (int ks = 0; ks < 4; ++ks) {
                const bf16x8_t a = *(const bf16x8_t*)(lds + LRU_XA + (16 * wave + c16) * XA_STRIDE + (ks * 32 + 8 * q) * 2);
#pragma unroll
                for (int gs = 0; gs < 2; ++gs)
#pragma unroll
                    for (int nt = 0; nt < 2; ++nt) acc[gs][nt] = __builtin_amdgcn_mfma_f32_16x16x32_bf16(a, wf[gs][nt][ks], acc[gs][nt], 0, 0, 0);
            }
#pragma unroll
            for (int nt = 0; nt < 2; ++nt)
#pragma unroll
                for (int reg = 0; reg < 4; ++reg) {
                    const int t = 16 * wave + 4 * q + reg, jj = nt * 16 + c16;
                    const float za = acc[0][nt][reg] + ba[nt], zi = acc[1][nt][reg] + bi[nt];
                    const float r = __builtin_amdgcn_rcpf(1.f + __expf(-za)), ig = __builtin_amdgcn_rcpf(1.f + __expf(-zi));
                    const float a = __builtin_amdgcn_exp2f(c2[nt] * r);
                    const float xcv = bf2f(*(const bf16_t*)(lds + LRU_XA + t * XA_STRIDE + (cq * 32 + jj) * 2));
                    SA[t * 32 + jj] = a; SB[t * 32 + jj] = __builtin_amdgcn_sqrtf(fmaxf(1.f - a * a, 0.f)) * (ig * xcv);
                }
            __syncthreads();
            float av[8], bv[8];
#pragma unroll
            for (int k = 0; k < 8; ++k) { av[k] = SA[(seg * 8 + k) * 32 + sc]; bv[k] = SB[(seg * 8 + k) * 32 + sc]; }
            float P = 1.f, H = 0.f;
#pragma unroll
            for (int k = 0; k < 8; ++k) { H = av[k] * H + bv[k]; P *= av[k]; }
            SEGP[seg * 32 + sc] = P; SEGH[seg * 32 + sc] = H;
            __syncthreads();
            float run = carry, hin = carry;
            int segl = seg; asm volatile("" : "+v"(segl));
#pragma unroll
            for (int s = 0; s < 16; ++s) { if (s == segl) hin = run; run = SEGP[s * 32 + sc] * run + SEGH[s * 32 + sc]; }
            carry = run;
            H = hin;
#pragma unroll
            for (int k = 0; k < 8; ++k) { H = av[k] * H + bv[k]; ((unsigned char*)ymix)[(row0 + seg * 8 + k) * D + hd * 128 + cq * 32 + sc] = (unsigned char)(pk4_fp8(H * bf2f(yg[k]) * YMIX_SCALE, 0.f, 0.f, 0.f) & 0xffu); }
        }
        __syncthreads();
    }
}

constexpr int SGU_RS = 0, SGU_TV = 512, SGU_SS = SGU_TV + 128 * XA_STRIDE, SS_STRIDE = 132;
__device__ __forceinline__ void phase_sgu(KP p, unsigned char* lds, int bid, int nb, int wv_) {
    const int tid = opaque_tid(), lane = tid & 63, wave = tid >> 6, c16 = lane & 15, q = lane >> 4;
    const bf16_t* UG = (const bf16_t*)(p->ws + WS_PROJ) + (size_t)2 * M * 1024; const bf16_t* VG = UG + (size_t)M * 1024;
    const float* ssqv = (const float*)(p->ws + WS_SSQV); bf16_t* ymix = (bf16_t*)(p->ws + WS_YMIX);
    float* RS = (float*)(lds + SGU_RS); float* SS = (float*)(lds + SGU_SS);
    bf16x8_t wa[8][4]; float gvv[8]; int gcur = -1;
    const int oct = tid & 15;
    for (int it = bid; it < NB * 16 * 8; it += nb) {
        const int g = it & 7; const size_t base = (size_t)(it >> 3) * 128;
        if (g != gcur) { gcur = g;
#pragma unroll
            for (int mt = 0; mt < 8; ++mt)
#pragma unroll
                for (int ks = 0; ks < 4; ++ks) if (ks <= ((16 * mt + 15) >> 5))
                    wa[mt][ks] = *(const bf16x8_t*)((const bf16_t*)(p->ws + WS_WSPB) + ((size_t)(g * 128 + mt * 16 + c16) * 128 + ks * 32 + 8 * q));
#pragma unroll
            for (int e = 0; e < 8; ++e) gvv[e] = p->in[I_GV][g * 128 + oct * 8 + e]; }
        uint4 vch[4], uch[4];
#pragma unroll
        for (int k = 0; k < 4; ++k) { const int row = (tid >> 4) + 32 * k; vch[k] = *(const uint4*)(VG + (base + row) * 1024 + g * 128 + oct * 8); uch[k] = *(const uint4*)(UG + (base + row) * 1024 + g * 128 + oct * 8); }
        if (tid < 128) { float ss = 0.f;
#pragma unroll
            for (int k = 0; k < 16; ++k) ss += ssqv[(base + tid) * 16 + k];
            RS[tid] = rsqrtf(ss * (1.f / 1024.f) + EPS); }
        __syncthreads();
#pragma unroll
        for (int k = 0; k < 4; ++k) { const int row = (tid >> 4) + 32 * k; const float r = RS[row]; const unsigned ww[4] = {vch[k].x, vch[k].y, vch[k].z, vch[k].w}; unsigned oo[4];
#pragma unroll
            for (int e2 = 0; e2 < 4; ++e2) oo[e2] = pk2(__uint_as_float(ww[e2] << 16) * r * gvv[2 * e2], __uint_as_float(ww[e2] & 0xffff0000u) * r * gvv[2 * e2 + 1]);
            *(uint4*)(lds + SGU_TV + row * XA_STRIDE + oct * 16) = make_uint4(oo[0], oo[1], oo[2], oo[3]); }
        __syncthreads();
        bf16x8_t bfr[4];
        { const int q4 = c16 >> 2, p4 = c16 & 3;
#pragma unroll
          for (int ks = 0; ks < 4; ++ks) {
              const unsigned a1 = SGU_TV + (ks * 32 + 8 * q + q4) * XA_STRIDE + (wave * 16 + 4 * p4) * 2;
              const s16x4_t lo = __builtin_amdgcn_ds_read_tr16_b64_v4i16((LAS s16x4_t*)(lds + a1));
              const s16x4_t hi = __builtin_amdgcn_ds_read_tr16_b64_v4i16((LAS s16x4_t*)(lds + a1 + 4 * XA_STRIDE));
              bfr[ks] = __builtin_shufflevector(lo, hi, 0, 1, 2, 3, 4, 5, 6, 7); } }
        f32x4_t acc[8];
#pragma unroll
        for (int mt = 0; mt < 8; ++mt) { acc[mt] = (f32x4_t){0.f, 0.f, 0.f, 0.f};
#pragma unroll
            for (int ks = 0; ks < 4; ++ks) if (ks <= ((16 * mt + 15) >> 5)) acc[mt] = __builtin_amdgcn_mfma_f32_16x16x32_bf16(wa[mt][ks], bfr[ks], acc[mt], 0, 0, 0); }
#pragma unroll
        for (int mt = 0; mt < 8; ++mt)
#pragma unroll
            for (int reg = 0; reg < 4; ++reg) { const int i = mt * 16 + 4 * q + reg; SS[i * SS_STRIDE + wave * 16 + c16] = acc[mt][reg] + p->in[I_BSP][g * 128 + i]; }
        __syncthreads();
#pragma unroll
        for (int k = 0; k < 4; ++k) { const int row = (tid >> 4) + 32 * k; const float4 s0 = *(const float4*)(SS + row * SS_STRIDE + oct * 8), s1 = *(const float4*)(SS + row * SS_STRIDE + oct * 8 + 4);
            const unsigned ww[4] = {uch[k].x, uch[k].y, uch[k].z, uch[k].w}; const float sv[8] = {s0.x, s0.y, s0.z, s0.w, s1.x, s1.y, s1.z, s1.w}; unsigned oo[4];
#pragma unroll
            for (int e2 = 0; e2 < 2; ++e2) oo[e2] = pk4_fp8(__uint_as_float(ww[2 * e2] << 16) * sv[4 * e2] * YMIX_SCALE, __uint_as_float(ww[2 * e2] & 0xffff0000u) * sv[4 * e2 + 1] * YMIX_SCALE,
                                                          __uint_as_float(ww[2 * e2 + 1] << 16) * sv[4 * e2 + 2] * YMIX_SCALE, __uint_as_float(ww[2 * e2 + 1] & 0xffff0000u) * sv[4 * e2 + 3] * YMIX_SCALE);
            *(uint2*)((unsigned char*)ymix + (base + row) * D + 1024 + g * 128 + oct * 8) = make_uint2(oo[0], oo[1]); }
        __syncthreads();
    }
}

typedef float f32x16_t __attribute__((ext_vector_type(16)));
__device__ __forceinline__ float vmaxf(float a, float b) { float r; asm("v_max_f32 %0, %1, %2" : "=v"(r) : "v"(a), "v"(b)); return r; }
__device__ __forceinline__ float vminf(float a, float b) { float r; asm("v_min_f32 %0, %1, %2" : "=v"(r) : "v"(a), "v"(b)); return r; }
#define CE_DESC(a, b) do { const float _mx = vmaxf(a, b), _mn = vminf(a, b); a = _mx; b = _mn; } while (0)
__device__ __forceinline__ void sort16_desc(float (&v)[16]) {
#pragma unroll
    for (int k = 2; k <= 16; k <<= 1)
#pragma unroll
        for (int j = k >> 1; j > 0; j >>= 1)
#pragma unroll
            for (int i = 0; i < 16; ++i) { const int l = i ^ j; if (l > i) { if ((i & k) == 0) CE_DESC(v[i], v[l]); else CE_DESC(v[l], v[i]); } }
}
__device__ __forceinline__ void merge16_desc(float (&a)[16], const float (&b)[16]) {
#pragma unroll
    for (int i = 0; i < 16; ++i) a[i] = vmaxf(a[i], b[15 - i]);
#pragma unroll
    for (int j = 8; j > 0; j >>= 1)
#pragma unroll
        for (int i = 0; i < 16; ++i) { const int l = i ^ j; if (l > i) CE_DESC(a[i], a[l]); }
}
__device__ __forceinline__ void topk_half(const bf16_t* qp, const unsigned char* kl, unsigned hh4, float (&X)[16]) {
    f32x16_t acc[4];
#pragma unroll
    for (int kt = 0; kt < 4; ++kt)
#pragma unroll
        for (int i = 0; i < 16; ++i) acc[kt][i] = 0.f;
#pragma unroll 4
    for (int ks = 0; ks < 8; ++ks) {
        const bf16x8_t bq = *(const bf16x8_t*)(qp + ks * 16);
#pragma unroll
        for (int kt = 0; kt < 4; ++kt) { const bf16x8_t ak = *(const bf16x8_t*)(kl + kt * 32 * XA_STRIDE + ks * 32); acc[kt] = __builtin_amdgcn_mfma_f32_32x32x16_bf16(ak, bq, acc[kt], 0, 0, 0); }
    }
    float g[4][16];
#pragma unroll
    for (int kt = 0; kt < 4; ++kt)
#pragma unroll
        for (int reg = 0; reg < 16; ++reg) g[kt][reg] = __uint_as_float(((__float_as_uint(acc[kt][reg]) & 0xFFFFFF80u) | hh4) | (unsigned)(kt * 32 + (reg & 3) + 8 * (reg >> 2)));
    sort16_desc(g[0]); sort16_desc(g[1]); __builtin_amdgcn_sched_barrier(0); merge16_desc(g[0], g[1]); __builtin_amdgcn_sched_barrier(0);
    sort16_desc(g[2]); sort16_desc(g[3]); __builtin_amdgcn_sched_barrier(0); merge16_desc(g[2], g[3]); __builtin_amdgcn_sched_barrier(0); merge16_desc(g[0], g[2]);
#pragma unroll
    for (int i = 0; i < 16; ++i) X[i] = g[0][i];
}
__device__ __forceinline__ unsigned pack_b0(float a, float b, float c, float d) {
    const unsigned ab = __builtin_amdgcn_perm(__float_as_uint(b), __float_as_uint(a), 0x0c0c0400u), cd = __builtin_amdgcn_perm(__float_as_uint(d), __float_as_uint(c), 0x0c0c0400u);
    return __builtin_amdgcn_perm(cd, ab, 0x05040100u);
}
__device__ __forceinline__ unsigned byte_lookup(const unsigned (&pk)[4], unsigned e) {
    const unsigned lo = __builtin_amdgcn_perm(pk[1], pk[0], e & 7u), hi = __builtin_amdgcn_perm(pk[3], pk[2], e & 7u);
    return ((e & 8u) ? hi : lo) & 0x7Fu;
}
__device__ __forceinline__ void phase_topk(KP p, unsigned char* lds, int bid, int nb, int wv_) {
    const int tid = opaque_tid(), lane = tid & 63, wave = tid >> 6, r32 = lane & 31, hh = lane >> 5;
    const bf16_t* Q = (const bf16_t*)(p->ws + WS_Q); const bf16_t* KB = (const bf16_t*)(p->ws + WS_SKEYB);
    int* idx = (int*)(p->ws + WS_IDX); float* gate = (float*)(p->ws + WS_GATE);
    const float NEG = -3.0e38f;
    int hcur = -1;
    for (int bi = bid; bi < NHEAD * (M / 256); bi += nb) {
        const int hd = bi & 7, tile = (bi >> 3) * 8 + wave; const size_t token = (size_t)tile * 32 + r32;
        if (hd != hcur) { hcur = hd; __syncthreads();
#pragma unroll
            for (int k = 0; k < 8; ++k) { const int c = tid + NT * k, row = c >> 4, o = c & 15;
                *(uint4*)(lds + row * XA_STRIDE + o * 16) = *(const uint4*)(KB + ((size_t)hd * 256 + row) * 128 + o * 8); }
            __syncthreads(); }
        float X0[16], X1[16];
        topk_half(Q + token * D + hd * 256 + 8 * hh, lds + r32 * XA_STRIDE + hh * 16, 4u * hh, X0);
        __builtin_amdgcn_sched_barrier(0);
        topk_half(Q + token * D + hd * 256 + 128 + 8 * hh, lds + (128 + r32) * XA_STRIDE + hh * 16, 4u * hh, X1);
        __builtin_amdgcn_sched_barrier(0);
#pragma unroll
        for (int i = 0; i < 16; ++i) { const auto r = __builtin_amdgcn_permlane32_swap(__float_as_uint(X0[i]), __float_as_uint(X1[i]), false, false); X0[i] = __uint_as_float(r[0]); X1[i] = __uint_as_float(r[1]); }
        merge16_desc(X0, X1);
        float U[16];
#pragma unroll
        for (int i = 0; i < 16; ++i) U[i] = __shfl_xor(X0[i], 32);
        const unsigned hbit = (unsigned)hh << 8;
        float c0[16], c1[16];
#pragma unroll
        for (int j = 0; j < 16; ++j) { float s = X0[0] + U[j]; if (j == 0) s = hh ? NEG : s; c0[j] = __uint_as_float(((__float_as_uint(s) & 0xFFFFFE00u) | hbit) | (unsigned)j); }
        {
            int n = 0;
#pragma unroll
            for (int i = 1; i < 4; ++i)
#pragma unroll
                for (int j = i; j < 16; ++j) if ((i + 1) * (j + 1) <= 16) { float s = X0[i] + U[j]; if (j == i) s = hh ? NEG : s; c1[n] = __uint_as_float(((__float_as_uint(s) & 0xFFFFFE00u) | hbit) | (unsigned)(i * 16 + j)); ++n; }
#pragma unroll
            for (int k = 11; k < 16; ++k) c1[k] = NEG;
        }
        sort16_desc(c0); sort16_desc(c1); merge16_desc(c0, c1);
        float F[16];
#pragma unroll
        for (int i = 0; i < 16; ++i) F[i] = vmaxf(c0[i], __shfl_xor(c0[15 - i], 32));
        float mx = F[0];
#pragma unroll
        for (int i = 1; i < 16; ++i) mx = vmaxf(mx, F[i]);
        float ev[16], sum = 0.f;
#pragma unroll
        for (int i = 0; i < 16; ++i) { ev[i] = __expf(F[i] - mx); sum += ev[i]; }
        const float inv = 1.f / sum;
        unsigned pt[4], pu[4], pa[4], pb[4];
#pragma unroll
        for (int w = 0; w < 4; ++w) { pt[w] = pack_b0(X0[4 * w], X0[4 * w + 1], X0[4 * w + 2], X0[4 * w + 3]); pu[w] = pack_b0(U[4 * w], U[4 * w + 1], U[4 * w + 2], U[4 * w + 3]); }
#pragma unroll
        for (int w = 0; w < 4; ++w) { pa[w] = hh ? pu[w] : pt[w]; pb[w] = hh ? pt[w] : pu[w]; }
        int oi[8]; float og[8];
#pragma unroll
        for (int k = 0; k < 8; ++k) {
            const unsigned pl = __float_as_uint(F[k]) & 0x1FFu, sw = pl >> 8, pi = (pl >> 4) & 15u, pj = pl & 15u;
            const unsigned ai = sw ? pj : pi, bj = sw ? pi : pj;
            oi[k] = (int)(byte_lookup(pa, ai) * NKEYS + byte_lookup(pb, bj)); og[k] = ev[k] * inv;
        }
        int* io = idx + token * NSEL + hd * TOPK + 8 * hh; float* go = gate + token * NSEL + hd * TOPK + 8 * hh;
        *(int4*)io = make_int4(oi[0], oi[1], oi[2], oi[3]); *(int4*)(io + 4) = make_int4(oi[4], oi[5], oi[6], oi[7]);
        *(float4*)go = make_float4(og[0], og[1], og[2], og[3]); *(float4*)(go + 4) = make_float4(og[4], og[5], og[6], og[7]);
    }
}

__device__ __forceinline__ void wave_argmax(float& v, int& i) {
#pragma unroll
    for (int off = 32; off >= 1; off >>= 1) { const float ov = __shfl_xor(v, off); const int oi = __shfl_xor(i, off); if (ov > v || (ov == v && oi < i)) { v = ov; i = oi; } }
}
__device__ __forceinline__ void topk_half_naive(const bf16_t* q, const float* k0, int lane, float& outv, int& outi) {
    const float NEG = -3.0e38f;
    const float* k1 = k0 + 64 * 128;
    float s0 = 0.f, s1 = 0.f;
    for (int k = 0; k < 128; k += 4) {
        const uint2 qq = *(const uint2*)(q + k);
        const float q0 = bf2f((bf16_t)(qq.x & 0xffff)), q1 = bf2f((bf16_t)(qq.x >> 16)), q2 = bf2f((bf16_t)(qq.y & 0xffff)), q3 = bf2f((bf16_t)(qq.y >> 16));
        const float4 a = *(const float4*)(k0 + k), b = *(const float4*)(k1 + k);
        s0 += q0 * a.x + q1 * a.y + q2 * a.z + q3 * a.w; s1 += q0 * b.x + q1 * b.y + q2 * b.z + q3 * b.w;
    }
    float myv = NEG; int myi = 0;
    for (int r = 0; r < TOPK; ++r) {
        float v; int i; if (s0 >= s1) { v = s0; i = lane; } else { v = s1; i = lane + 64; }
        wave_argmax(v, i);
        if (i == lane) s0 = NEG; if (i == lane + 64) s1 = NEG;
        if (lane == r) { myv = v; myi = i; }
    }
    outv = myv; outi = myi;
}
__device__ __forceinline__ void phase_topk_naive(KP p, int bid, int nb, int wv_) {
    const bf16_t* Q = (const bf16_t*)(p->ws + WS_Q); const float* keys = p->in[I_SKEY];
    int* idx = (int*)(p->ws + WS_IDX); float* gate = (float*)(p->ws + WS_GATE);
    const int tid = opaque_tid(), lane = tid & 63, wave = tid >> 6;
    const float NEG = -3.0e38f;
    for (int task = bid * 8 + wave; task < M * NHEAD; task += nb * 8) {
        const int token = task >> 3, hd = task & 7;
        float tv0, tv1; int ti0, ti1;
        topk_half_naive(Q + (size_t)token * D + hd * 256, keys + ((size_t)(hd * 2) * 128 + lane) * 128, lane, tv0, ti0);
        topk_half_naive(Q + (size_t)token * D + hd * 256 + 128, keys + ((size_t)(hd * 2 + 1) * 128 + lane) * 128, lane, tv1, ti1);
        const float vb = __shfl(tv1, lane & 15);
        float c0 = __shfl(tv0, (lane >> 4)) + vb, c1 = __shfl(tv0, (lane >> 4) + 4) + vb, c2 = __shfl(tv0, (lane >> 4) + 8) + vb, c3 = __shfl(tv0, (lane >> 4) + 12) + vb;
        float selv = NEG; int selc = 0;
        for (int r = 0; r < TOPK; ++r) {
            float v = c0; int i = lane;
            if (c1 > v) { v = c1; i = lane + 64; }
            if (c2 > v) { v = c2; i = lane + 128; }
            if (c3 > v) { v = c3; i = lane + 192; }
            wave_argmax(v, i);
            if (i == lane) c0 = NEG; if (i == lane + 64) c1 = NEG; if (i == lane + 128) c2 = NEG; if (i == lane + 192) c3 = NEG;
            if (lane == r) { selv = v; selc = i; }
        }
        const float mx = __shfl(selv, 0);
        const float e = lane < TOPK ? __expf(selv - mx) : 0.f;
        const float sum = wave_sum(e);
        const int i1 = __shfl(ti0, selc >> 4), i2 = __shfl(ti1, selc & 15);
        if (lane < TOPK) { idx[(size_t)token * NSEL + hd * TOPK + lane] = i1 * NKEYS + i2; gate[(size_t)token * NSEL + hd * TOPK + lane] = e / sum; }
    }
}

typedef float f32x2_t __attribute__((ext_vector_type(2)));
constexpr size_t GRP_BYTES = (size_t)NKEYS * NKEYS * 128;
constexpr int NGRP = D / 128;
__device__ __forceinline__ void phase_convert_experts(KP p, int bid, int nb, int wv_) {
    const int tid = opaque_tid(), lane = tid & 63, wave = tid >> 6;
    for (int row = bid * 8 + wave; row < 2 * NKEYS * NKEYS; row += nb * 8) {
        const int t = row >= NKEYS * NKEYS, e = row - t * NKEYS * NKEYS;
        const float* src = (t ? p->in[I_EV] : p->in[I_EU]) + (size_t)e * D;
        unsigned char* dst = p->ws + (t ? WS_EV8 : WS_EU8) + (size_t)e * 128 + (size_t)(lane >> 5) * GRP_BYTES + (lane & 31) * 4;
        float4 v[8]; float am = 0.f;
#pragma unroll
        for (int j = 0; j < 8; ++j) { v[j] = *(const float4*)(src + lane * 4 + 256 * j); am = fmaxf(am, fmaxf(fmaxf(fabsf(v[j].x), fabsf(v[j].y)), fmaxf(fabsf(v[j].z), fabsf(v[j].w)))); }
        am = wave_max(am);
        const float sc = am > 0.f ? 127.f / am : 0.f;
#pragma unroll
        for (int j = 0; j < 8; ++j) *(unsigned*)(dst + (size_t)(2 * j) * GRP_BYTES) = pk4_i8(v[j].x * sc, v[j].y * sc, v[j].z * sc, v[j].w * sc);
        if (lane == 0) ((float*)(p->ws + WS_ESCALE))[row] = am * (1.f / 127.f);
    }
}
__device__ __forceinline__ unsigned xb_xcc_id();
constexpr int PEER_TT = 16;
constexpr int PEER_NTILE = M / PEER_TT;
constexpr int CW_UQ = 4096, CW_VQ = 8192;
__device__ __forceinline__ float dpp_xor1(float v) { return __builtin_bit_cast(float, __builtin_amdgcn_update_dpp(0, __builtin_bit_cast(int, v), 0xB1, 0xF, 0xF, true)); }
__device__ __forceinline__ float dpp_xor2(float v) { return __builtin_bit_cast(float, __builtin_amdgcn_update_dpp(0, __builtin_bit_cast(int, v), 0x4E, 0xF, 0xF, true)); }
__device__ __forceinline__ float dpp_hmirror(float v) { return __builtin_bit_cast(float, __builtin_amdgcn_update_dpp(0, __builtin_bit_cast(int, v), 0x141, 0xF, 0xF, true)); }
__device__ __forceinline__ void pg_load_ids(const int* idx, size_t token, int k, unsigned c16, unsigned (&off)[16]) {
#pragma unroll
    for (int i = 0; i < 4; ++i) { const int4 v = *(const int4*)(idx + token * NSEL + 16 * k + 4 * i); off[4 * i] = ((unsigned)v.x << 7) + c16; off[4 * i + 1] = ((unsigned)v.y << 7) + c16; off[4 * i + 2] = ((unsigned)v.z << 7) + c16; off[4 * i + 3] = ((unsigned)v.w << 7) + c16; }
}
__device__ __forceinline__ void pg_load_lines(const unsigned char* tg, const unsigned (&off)[16], uint4 (&r)[16]) {
#pragma unroll
    for (int j = 0; j < 16; ++j) r[j] = *(const uint4*)(tg + off[j]);
}
typedef _Float16 h2_t __attribute__((ext_vector_type(2)));
__device__ __forceinline__ int dppi(int v, int ctrl_sel) { return ctrl_sel == 0 ? __builtin_amdgcn_update_dpp(0, v, 0xB1, 0xF, 0xF, true) : ctrl_sel == 1 ? __builtin_amdgcn_update_dpp(0, v, 0x4E, 0xF, 0xF, true) : __builtin_amdgcn_update_dpp(0, v, 0x141, 0xF, 0xF, true); }
__device__ __forceinline__ void pg_compute_u(const uint4 (&r)[16], const uint4 (&hw)[2], int* po, int c) {
    int d[16];
#pragma unroll
    for (int j = 0; j < 16; ++j) { int s = 0; s = __builtin_amdgcn_sdot4((int)r[j].x, (int)hw[0].x, s, false); s = __builtin_amdgcn_sdot4((int)r[j].y, (int)hw[0].y, s, false); s = __builtin_amdgcn_sdot4((int)r[j].z, (int)hw[0].z, s, false); s = __builtin_amdgcn_sdot4((int)r[j].w, (int)hw[0].w, s, false); d[j] = s; }
#pragma unroll
    for (int j = 0; j < 16; ++j) d[j] += dppi(d[j], 0);
#pragma unroll
    for (int j = 0; j < 16; ++j) d[j] += dppi(d[j], 1);
#pragma unroll
    for (int j = 0; j < 16; ++j) d[j] += dppi(d[j], 2);
    int p0 = 0, p1 = 0;
#pragma unroll
    for (int j = 0; j < 8; ++j) { p0 = (c == j) ? d[j] : p0; p1 = (c == j) ? d[j + 8] : p1; }
    po[0] = p0; po[8] = p1;
}
__device__ __forceinline__ void pg_compute_v(const uint4 (&r)[16], const f32x4_t (&aw)[4], const float* xo, unsigned* yo, const float* gtp, float* ssp, float asc, int k, int lane) {
    int acc[16];
#pragma unroll
    for (int m = 0; m < 16; ++m) acc[m] = 0;
    const uint4 a16 = __builtin_bit_cast(uint4, aw[0]); const unsigned aa[4] = {a16.x, a16.y, a16.z, a16.w};
#pragma unroll
    for (int jq = 0; jq < 4; ++jq) {
        const unsigned rr[4][4] = {{r[4 * jq].x, r[4 * jq].y, r[4 * jq].z, r[4 * jq].w}, {r[4 * jq + 1].x, r[4 * jq + 1].y, r[4 * jq + 1].z, r[4 * jq + 1].w},
                                   {r[4 * jq + 2].x, r[4 * jq + 2].y, r[4 * jq + 2].z, r[4 * jq + 2].w}, {r[4 * jq + 3].x, r[4 * jq + 3].y, r[4 * jq + 3].z, r[4 * jq + 3].w}};
#pragma unroll
        for (int cc = 0; cc < 4; ++cc) {
            const unsigned t0 = __builtin_amdgcn_perm(rr[1][cc], rr[0][cc], 0x05010400u), t1 = __builtin_amdgcn_perm(rr[1][cc], rr[0][cc], 0x07030602u);
            const unsigned t2 = __builtin_amdgcn_perm(rr[3][cc], rr[2][cc], 0x05010400u), t3 = __builtin_amdgcn_perm(rr[3][cc], rr[2][cc], 0x07030602u);
            acc[4 * cc + 0] = __builtin_amdgcn_sdot4((int)__builtin_amdgcn_perm(t2, t0, 0x05040100u), (int)aa[jq], acc[4 * cc + 0], false);
            acc[4 * cc + 1] = __builtin_amdgcn_sdot4((int)__builtin_amdgcn_perm(t2, t0, 0x07060302u), (int)aa[jq], acc[4 * cc + 1], false);
            acc[4 * cc + 2] = __builtin_amdgcn_sdot4((int)__builtin_amdgcn_perm(t3, t1, 0x05040100u), (int)aa[jq], acc[4 * cc + 2], false);
            acc[4 * cc + 3] = __builtin_amdgcn_sdot4((int)__builtin_amdgcn_perm(t3, t1, 0x07060302u), (int)aa[jq], acc[4 * cc + 3], false);
        }
    }
    int b8[8];
#pragma unroll
    for (int m = 0; m < 8; ++m) { const int keep = (k & 1) ? acc[8 + m] : acc[m], send = (k & 1) ? acc[m] : acc[8 + m]; b8[m] = keep + __shfl_xor(send, 8); }
    int b4[4];
#pragma unroll
    for (int m = 0; m < 4; ++m) { const int keep = (k & 2) ? b8[4 + m] : b8[m], send = (k & 2) ? b8[m] : b8[4 + m]; b4[m] = keep + __shfl_xor(send, 16); }
    int o2[2];
#pragma unroll
    for (int m = 0; m < 2; ++m) { const int keep = (k & 4) ? b4[2 + m] : b4[m], send = (k & 4) ? b4[m] : b4[2 + m]; o2[m] = keep + __shfl_xor(send, 32); }
    const float2 x1 = *(const float2*)xo; const float2 gt = *(const float2*)gtp;
    const float y0 = x1.x + gt.x * ((float)o2[0] * asc), y1 = x1.y + gt.y * ((float)o2[1] * asc);
    *yo = pk2(y0, y1);
    const float ss = wave_sum(y0 * y0 + y1 * y1);
    if (lane == 0) *ssp = ss;
}
template <bool VPASS>
__device__ __forceinline__ void phase_peer_gather(KP p, float* lds, int bid, int nb, int wv_) {
    const int tid = opaque_tid(), lane = tid & 63, k = lane >> 3, c = lane & 7;
    const unsigned char* H8 = p->ws + WS_H8I; const int* idx = (const int*)(p->ws + WS_IDX); const float* ascp = (const float*)(p->ws + WS_ASC);
    const unsigned char* TAB = p->ws + (VPASS ? WS_EV8 : WS_EU8);
    int* pdot = (int*)(p->ws + WS_PDOT); const unsigned char* act = p->ws + WS_ACT; float* ssq2 = (float*)(p->ws + WS_SSQ2);
    unsigned* ctr = (unsigned*)(p->ws + WS_CTL) + (VPASS ? CW_VQ : CW_UQ);
    if (VPASS) { for (int i = tid; i < NB * D; i += NT) lds[i] = mod_at(p, i >> 11, 5 * D + (i & (D - 1))); __syncthreads(); }
    const unsigned slot0 = xb_xcc_id() & 7u, c16 = 16u * (unsigned)c;
    const int vcol = 16 * c + 8 * (k & 1) + 4 * ((k >> 1) & 1) + 2 * (k >> 2);
    for (int sl = 0; sl < 8; ++sl) {
        const int slot = (int)((slot0 + sl) & 7u);
        for (;;) {
            unsigned q = 0; if (lane == 0) q = __hip_atomic_fetch_add(ctr + 64 * slot, 1u, __ATOMIC_RELAXED, __HIP_MEMORY_SCOPE_AGENT);
            q = (unsigned)__builtin_amdgcn_readfirstlane((int)q);
            if (q >= 2u * PEER_NTILE) break;
            const int g = slot * 2 + (int)(q / PEER_NTILE), tile = (int)(q % PEER_NTILE);
            const unsigned char* tg = TAB + (size_t)g * GRP_BYTES;
            const size_t tok0 = (size_t)tile * PEER_TT;
            unsigned oA[16], oB[16]; uint4 rA[16], rB[16]; uint4 hA[2], hB[2]; f32x4_t aA[4], aB[4];
#define PG_AUX(tok, hX, aX) do { if (!VPASS) { hX[0] = *(const uint4*)(H8 + (tok) * D + g * 128 + 16 * c); } \
            else { aX[0] = *(const f32x4_t*)(act + (tok) * NSEL + 16 * k); aX[1][0] = ascp[(tok)]; } } while (0)
#define PG_COMPUTE(tok, rX, hX, aX) do { if (!VPASS) pg_compute_u(rX, hX, pdot + ((size_t)g * M + (tok)) * NSEL + 16 * k + c, c); \
            else pg_compute_v(rX, aX, p->out + (tok) * D + g * 128 + vcol, (unsigned*)(p->ws + WS_Y16) + ((tok) * D + g * 128 + vcol) / 2, lds + ((tok) / SEQ) * D + g * 128 + vcol, ssq2 + (size_t)g * M + (tok), aX[1][0], k, lane); } while (0)
            pg_load_ids(idx, tok0, k, c16, oA); pg_load_lines(tg, oA, rA); PG_AUX(tok0, hA, aA); pg_load_ids(idx, tok0 + 1, k, c16, oB);
            for (int tt = 0; tt < PEER_TT; tt += 2) {
                pg_load_lines(tg, oB, rB); PG_AUX(tok0 + tt + 1, hB, aB);
                if (tt + 2 < PEER_TT) pg_load_ids(idx, tok0 + tt + 2, k, c16, oA);
                PG_COMPUTE(tok0 + tt, rA, hA, aA);
                if (tt + 2 < PEER_TT) { pg_load_lines(tg, oA, rA); PG_AUX(tok0 + tt + 2, hA, aA); pg_load_ids(idx, tok0 + tt + 3, k, c16, oB); }
                PG_COMPUTE(tok0 + tt + 1, rB, hB, aB);
            }
#undef PG_AUX
#undef PG_COMPUTE
        }
    }
}
__device__ __forceinline__ void phase_peer_act(KP p, int bid, int nb, int wv_) {
    const int tid = opaque_tid(), lane = tid & 63, wave = tid >> 6;
    const int* idx = (const int*)(p->ws + WS_IDX); const float* gate = (const float*)(p->ws + WS_GATE); const float* esc = (const float*)(p->ws + WS_ESCALE);
    const int* pdot = (const int*)(p->ws + WS_PDOT); signed char* act = (signed char*)(p->ws + WS_ACT);
    for (int token = bid * 8 + wave; token < M; token += nb * 8) {
        int d0 = 0, d1 = 0;
#pragma unroll
        for (int g = 0; g < NGRP; ++g) { d0 += pdot[((size_t)g * M + token) * NSEL + lane]; d1 += pdot[((size_t)g * M + token) * NSEL + 64 + lane]; }
        const int e0 = idx[(size_t)token * NSEL + lane], e1 = idx[(size_t)token * NSEL + 64 + lane];
        const float hs = ((const float*)(p->ws + WS_HSC))[token];
        const float a0 = gelu_t((float)d0 * (esc[e0] * hs)) * gate[(size_t)token * NSEL + lane] * esc[NKEYS * NKEYS + e0];
        const float a1 = gelu_t((float)d1 * (esc[e1] * hs)) * gate[(size_t)token * NSEL + 64 + lane] * esc[NKEYS * NKEYS + e1];
        const float am = wave_max(fmaxf(fabsf(a0), fabsf(a1))); const float sc = am > 0.f ? 127.f / am : 0.f;
        act[(size_t)token * NSEL + lane] = (signed char)__float2int_rn(a0 * sc); act[(size_t)token * NSEL + 64 + lane] = (signed char)__float2int_rn(a1 * sc);
        if (lane == 0) ((float*)(p->ws + WS_ASC))[token] = am * (1.f / 127.f);
    }
}
__device__ __forceinline__ void phase_final_norm(KP p, int bid, int nb, int wv_) {
    const int tid = opaque_tid(), lane = tid & 63, wave = tid >> 6;
    const float* ssq2 = (const float*)(p->ws + WS_SSQ2); const float* gf = p->in[I_GFIN];
    for (int token = bid * 8 + wave; token < M; token += nb * 8) {
        float ss = 0.f;
#pragma unroll
        for (int g = 0; g < NGRP; ++g) ss += ssq2[(size_t)g * M + token];
        const float rstd = rsqrtf(ss * (1.f / D) + EPS);
        float* row = p->out + (size_t)token * D; const bf16_t* yrow = (const bf16_t*)(p->ws + WS_Y16) + (size_t)token * D;
#pragma unroll
        for (int j = 0; j < 4; ++j) { const int col = lane * 8 + 512 * j; const uint4 w = *(const uint4*)(yrow + col); const float4 ga = *(const float4*)(gf + col), gb = *(const float4*)(gf + col + 4);
            *(float4*)(row + col) = make_float4(__uint_as_float(w.x << 16) * rstd * ga.x, __uint_as_float(w.x & 0xffff0000u) * rstd * ga.y, __uint_as_float(w.y << 16) * rstd * ga.z, __uint_as_float(w.y & 0xffff0000u) * rstd * ga.w);
            *(float4*)(row + col + 4) = make_float4(__uint_as_float(w.z << 16) * rstd * gb.x, __uint_as_float(w.z & 0xffff0000u) * rstd * gb.y, __uint_as_float(w.w << 16) * rstd * gb.z, __uint_as_float(w.w & 0xffff0000u) * rstd * gb.w); }
    }
}

#define XB_TMO      128
#define XB_XCNT(j)  (256  + 64 * (j))
#define XB_XSUB(j)  (1280 + 64 * (j))
#define XB_XGEN(j)  (2304 + 64 * (j))
#define XB_TOP      3328
#define XB_TOPGEN   3392
#define XCD_BAR_WORDS 3456
#define XB_SPIN_CAP (1u << 18)

__device__ __forceinline__ unsigned xb_ld(unsigned* p)              { return __hip_atomic_load(p, __ATOMIC_RELAXED, __HIP_MEMORY_SCOPE_AGENT); }
__device__ __forceinline__ unsigned xb_add(unsigned* p, unsigned v) { return __hip_atomic_fetch_add(p, v, __ATOMIC_RELAXED, __HIP_MEMORY_SCOPE_AGENT); }
__device__ __forceinline__ unsigned xb_xcc_id() { return (unsigned)__builtin_amdgcn_s_getreg((3 << 11) | 20) & 0xFu; }
#define XB_SPIN(cond, bar) do { unsigned _sp = 0; while (cond) { __builtin_amdgcn_s_sleep(1); \
    if ((++_sp & 255u) == 0u) { if (xb_ld(&(bar)[XB_TMO])) break; if (_sp > XB_SPIN_CAP) { atomicAdd(&(bar)[XB_TMO], 1u); break; } } } } while (0)

struct XcdBarrier {
    unsigned* bar; unsigned x;
    volatile LAS unsigned* st;
};

__device__ __forceinline__ XcdBarrier xcd_barrier_post(unsigned* bar, volatile LAS unsigned* st) {
    XcdBarrier b; b.bar = bar; b.x = xb_xcc_id(); b.st = st;
    if (threadIdx.x == 0) (void)xb_add(&bar[XB_XCNT(b.x)], 1u);
    return b;
}
__device__ __forceinline__ void xcd_barrier_complete(unsigned* bar, unsigned x, unsigned& nloc, unsigned& nx) {
    const unsigned G = gridDim.x * gridDim.y * gridDim.z;
    unsigned sum, cnt, mine, sp = 0u;
    for (;;) {
        sum = 0u; cnt = 0u; mine = 0u;
#pragma unroll
        for (unsigned j = 0; j < 16; ++j) { const unsigned c = xb_ld(&bar[XB_XCNT(j)]); sum += c; cnt += (c > 0u) ? 1u : 0u; mine = (j == x) ? c : mine; }
        if (sum == G) break;
        __builtin_amdgcn_s_sleep(1);
        if ((++sp & 255u) == 0u) { if (xb_ld(&bar[XB_TMO])) break; if (sp > XB_SPIN_CAP) { atomicAdd(&bar[XB_TMO], 1u); break; } }
    }
    nloc = mine > 0u ? mine : 1u; nx = cnt > 0u ? cnt : 1u;
}

__device__ __forceinline__ void xcd_barrier(const XcdBarrier& b, bool leader) {
    asm volatile("s_waitcnt vmcnt(0)" ::: "memory");
    __syncthreads();
    if (leader) {
        unsigned* bar = b.bar;
        __builtin_amdgcn_s_waitcnt(0);
        unsigned nloc = b.st[0], nx = b.st[1];
        if (nloc == 0u) { xcd_barrier_complete(bar, b.x, nloc, nx); b.st[0] = nloc; b.st[1] = nx; }
        const unsigned old = xb_add(&bar[XB_XSUB(b.x)], 1u);
        const unsigned gen = old / nloc;
        if (old + 1u == (gen + 1u) * nloc) {
            __builtin_amdgcn_fence(__ATOMIC_RELEASE, "agent");
            asm volatile("s_waitcnt vmcnt(0)" ::: "memory");
            const unsigned og = xb_add(&bar[XB_TOP], 1u);
            const unsigned tg = og / nx;
            if (og + 1u == (tg + 1u) * nx) xb_add(&bar[XB_TOPGEN], 1u);
            else XB_SPIN(xb_ld(&bar[XB_TOPGEN]) == tg, bar);
            __builtin_amdgcn_fence(__ATOMIC_ACQUIRE, "agent");
            xb_add(&bar[XB_XGEN(b.x)], 1u);
            asm volatile("s_waitcnt vmcnt(0)" ::: "memory");
        } else {
            XB_SPIN(xb_ld(&bar[XB_XGEN(b.x)]) == gen, bar);
            __builtin_amdgcn_fence(__ATOMIC_ACQUIRE, "agent");
            asm volatile("s_waitcnt vmcnt(0)" ::: "memory");
        }
    }
    __syncthreads();
}


extern __shared__ __attribute__((aligned(16))) unsigned char dyn_lds[];
constexpr int LDS_BYTES = 147456;
__global__ void __launch_bounds__(NT) fwd_megakernel(Params p_unused) {
    KP p = (KP)__builtin_amdgcn_kernarg_segment_ptr();
    float* lds = (float*)dyn_lds;
    const int bid = blockIdx.x, nb = gridDim.x, wv_ = __builtin_amdgcn_readfirstlane((int)(threadIdx.x >> 6));
    volatile LAS unsigned* bst = (volatile LAS unsigned*)((LAS unsigned char*)dyn_lds + LDS_BYTES - 16);
    if (threadIdx.x < 4) bst[threadIdx.x] = 0u;
    __syncthreads();
    (void)xcd_barrier_post((unsigned*)(p->ws + WS_CTL), bst);
#define GRID_BAR() do { XcdBarrier xb_; xb_.bar = (unsigned*)(p->ws + WS_CTL); xb_.x = xb_xcc_id(); xb_.st = (volatile LAS unsigned*)((LAS unsigned char*)dyn_lds + LDS_BYTES - 16); xcd_barrier(xb_, opaque_tid() == 0); } while (0)
    phase_mod(p, lds, bid, nb, wv_);
    __syncthreads();
    phase_convert_weights(p, lds, bid, nb, wv_);
    phase_amax(p, bid, nb, wv_);
    phase_convert_experts(p, bid, nb, wv_);
    if (p->ws == nullptr) cg::this_grid().sync();
    GRID_BAR();
    phase_hrows<true>(p, p->in[I_X], p->in[I_GMIX], 0, D, (bf16_t*)(p->ws + WS_H), lds, bid, nb, wv_);
    phase_convert_weights8(p, lds, bid, nb, wv_);
    GRID_BAR();
    { pg8::Gemm g{(const bf16_t*)(p->ws + WS_H), (const bf16_t*)(p->ws + WS_WIN_T), M, NPROJ, D / 2}; pg8::StaticOrder S; S.init(M, NPROJ, nb, bid);
      pg8::EpiProj E{(bf16_t*)(p->ws + WS_PROJ), (float*)(p->ws + WS_SSQV), M, (const float*)(p->ws + WS_HSCALE1), (const float*)(p->ws + WS_CTL) + CW_WSCALE};
      pg8::gemm_phase<pg8::EpiProj, pg8::StaticOrder, true, true, true>((LAS unsigned char*)dyn_lds, g, S, E, wv_); }
    GRID_BAR();
    phase_lru(p, dyn_lds, bid, nb, wv_);
    phase_sgu(p, dyn_lds, bid, nb, wv_);
    GRID_BAR();
    { pg8::Gemm g{(const bf16_t*)(p->ws + WS_YMIX), (const bf16_t*)(p->ws + WS_WOUT_T), M, D, D / 2}; pg8::StaticOrder S; S.init(M, D, nb, bid);
      pg8::EpiX1 E{p->in[I_X], p->out, (const float*)(p->ws + WS_MODP), p->in[I_BADA], 2 * D, NMOD, SEQ, (const float*)(p->ws + WS_CTL) + CW_WSCALE + 1, 1.f / YMIX_SCALE};
      pg8::gemm_phase<pg8::EpiX1, pg8::StaticOrder, true, true, true>((LAS unsigned char*)dyn_lds, g, S, E, wv_); }
    GRID_BAR();
    phase_hrows<false, true>(p, p->out, p->in[I_GFFN], 3 * D, 4 * D, (bf16_t*)(p->ws + WS_H), lds, bid, nb, wv_);
    GRID_BAR();
    { pg8::Gemm g{(const bf16_t*)(p->ws + WS_H), (const bf16_t*)(p->ws + WS_WQ_T), M, D, D}; pg8::StaticOrder S; S.init(M, D, nb, bid);
      pg8::EpiQ E{(bf16_t*)(p->ws + WS_Q), D};
      pg8::gemm_phase<pg8::EpiQ, pg8::StaticOrder, true, true>((LAS unsigned char*)dyn_lds, g, S, E, wv_); }
    GRID_BAR();
    phase_topk(p, dyn_lds, bid, nb, wv_);
    GRID_BAR();
    phase_peer_gather<false>(p, lds, bid, nb, wv_);
    GRID_BAR();
    phase_peer_act(p, bid, nb, wv_);
    GRID_BAR();
    phase_peer_gather<true>(p, lds, bid, nb, wv_);
    GRID_BAR();
    phase_final_norm(p, bid, nb, wv_);
}

extern "C" void kernel_launch(void* const* d_in, const int* in_sizes, int n_in, void* d_out, int out_size, void* d_ws, size_t ws_size, hipStream_t stream) {
    static int grid_blocks = 0;
    if (grid_blocks == 0) {
        if (n_in != 23 || in_sizes[0] != M * D || out_size != M * D || ws_size < WS_END) { fprintf(stderr, "kernel_launch: unexpected shapes (n_in %d in0 %d out %d ws %zu)\n", n_in, n_in > 0 ? in_sizes[0] : -1, out_size, ws_size); grid_blocks = -1; return; }
        if (hipFuncSetAttribute((const void*)fwd_megakernel, hipFuncAttributeMaxDynamicSharedMemorySize, LDS_BYTES) != hipSuccess) { fprintf(stderr, "hipFuncSetAttribute failed\n"); grid_blocks = -1; return; }
        int dev = 0, cus = 0, per_cu = 0;
        hipGetDevice(&dev);
        hipDeviceGetAttribute(&cus, hipDeviceAttributeMultiprocessorCount, dev);
        if (hipOccupancyMaxActiveBlocksPerMultiprocessor(&per_cu, (const void*)fwd_megakernel, NT, LDS_BYTES) != hipSuccess || per_cu < 1) { fprintf(stderr, "occupancy query failed (%d)\n", per_cu); grid_blocks = -1; return; }
        grid_blocks = cus;
    }
    if (grid_blocks < 0) return;
    Params p{};
    for (int i = 0; i < 23; ++i) p.in[i] = (const float*)d_in[i];
    p.out = (float*)d_out; p.ws = (unsigned char*)d_ws;
    if (hipMemsetAsync((char*)d_ws + WS_CTL, 0, 65536, stream) != hipSuccess) { fprintf(stderr, "hipMemsetAsync of the barrier words failed\n"); return; }
    void* args[] = {&p};
    hipError_t e = hipLaunchCooperativeKernel((const void*)fwd_megakernel, dim3(grid_blocks), dim3(NT), args, LDS_BYTES, stream);
    if (e != hipSuccess) fprintf(stderr, "cooperative launch failed: %s (grid %d)\n", hipGetErrorString(e), grid_blocks);
}
```

```cpp
#include <hip/hip_runtime.h>
#include <hip/hip_cooperative_groups.h>
#include <cstdio>
#include <cstdint>

constexpr int D = 2048, NB = 8, SEQ = 2048, M = NB * SEQ;
constexpr int DLRU = 1024, DSGU = 1024, NPROJ = 4096;
constexpr int NMOD = 6 * D;
constexpr int NHEAD = 8, NKEYS = 128, TOPK = 16, NSEL = NHEAD * TOPK;
constexpr float EPS = 1e-6f;
constexpr int NT = 512;
namespace cg = cooperative_groups;

constexpr size_t MiB = 1u << 20;
constexpr size_t WS_CTL = 0;
constexpr size_t WS_MODP = 1 * MiB;
constexpr size_t WS_WGA_T = 3 * MiB;
constexpr size_t WS_WGI_T = 3 * MiB + 262144;
constexpr size_t WS_WSPB = 3 * MiB + 524288;
constexpr size_t WS_SKEYB = 3 * MiB + 786432;
constexpr size_t WS_SSQV = 5 * MiB;
constexpr size_t WS_RSTDV = 8 * MiB;
constexpr size_t WS_WIN_T = 9 * MiB;
constexpr size_t WS_WOUT_T = 25 * MiB;
constexpr size_t WS_WQ_T = 33 * MiB;
constexpr size_t WS_IDX = 41 * MiB;
constexpr size_t WS_GATE = 49 * MiB;
constexpr size_t WS_H = 64 * MiB;
constexpr size_t WS_PROJ = 128 * MiB;
constexpr size_t WS_Q = 128 * MiB;
constexpr size_t WS_YMIX = 256 * MiB;
constexpr size_t WS_EU8 = 320 * MiB;
constexpr size_t WS_EV8 = 352 * MiB;
constexpr size_t WS_ESCALE = 57 * MiB;
constexpr size_t WS_XC = 320 * MiB;
constexpr size_t WS_A = 384 * MiB;
constexpr size_t WS_BB = 448 * MiB;
constexpr size_t WS_ACT = 256 * MiB;
constexpr size_t WS_SSQ2 = 264 * MiB;
constexpr size_t WS_PDOT = 384 * MiB;
constexpr size_t WS_HSCALE1 = 58 * MiB;
constexpr size_t WS_HSC = 59 * MiB;
constexpr size_t WS_ASC = 60 * MiB;
constexpr size_t WS_H8I = 288 * MiB;
constexpr size_t WS_Y16 = 128 * MiB;
constexpr size_t WS_IDX16 = 61 * MiB;
constexpr size_t WS_IDXT = 72 * MiB;
constexpr size_t WS_SSQP = 80 * MiB;
constexpr size_t WS_X1B = 192 * MiB;
constexpr size_t WS_MODS = 448 * MiB;
constexpr size_t WS_END = 512 * MiB;

typedef unsigned short bf16_t;
struct Params { const float* in[23]; float* out; unsigned char* ws; };
typedef const __attribute__((address_space(4))) Params* KP;
enum { I_X = 0, I_C, I_WADA, I_BADA, I_GMIX, I_WIN, I_CONVW, I_CONVB, I_WGA, I_BGA, I_WGI, I_BGI, I_LAM, I_GV, I_WSP, I_BSP, I_WOUT, I_GFFN, I_WQ, I_SKEY, I_EU, I_EV, I_GFIN };

__device__ __forceinline__ int opaque_tid_(int wv) { asm volatile("" : "+s"(wv)); int t = wv * 64 + (int)__builtin_amdgcn_mbcnt_hi(~0u, __builtin_amdgcn_mbcnt_lo(~0u, 0u)); asm volatile("" : "+v"(t)); return t; }
#define opaque_tid() opaque_tid_(wv_)
__device__ __forceinline__ float bf2f(bf16_t v) { return __uint_as_float(((unsigned)v) << 16); }
__device__ __forceinline__ bf16_t f2bf(float f) { unsigned u = __float_as_uint(f); u += 0x7fffu + ((u >> 16) & 1u); return (bf16_t)(u >> 16); }
__device__ __forceinline__ float sigmoidf_(float x) { return 1.f / (1.f + __expf(-x)); }
__device__ __forceinline__ float gelu_t(float x) { const float u = 0.7978845608028654f * (x + 0.044715f * x * x * x); return x * sigmoidf_(2.f * u); }
__device__ __forceinline__ float wave_sum(float v) {
#pragma unroll
    for (int o = 1; o < 64; o <<= 1) v += __shfl_xor(v, o);
    return v;
}
__device__ __forceinline__ float wave_max(float v) {
#pragma unroll
    for (int o = 1; o < 64; o <<= 1) v = fmaxf(v, __shfl_xor(v, o));
    return v;
}
__device__ __forceinline__ float pow2_scale_from_max(float am) { int ex = 0; if (am > 0.f) (void)frexpf(am, &ex); else ex = 8; return ldexpf(1.f, 8 - ex); }
__device__ __forceinline__ unsigned pk4_fp8(float a, float b, float c, float d) {
    int w = __builtin_amdgcn_cvt_pk_fp8_f32(fminf(fmaxf(a, -448.f), 448.f), fminf(fmaxf(b, -448.f), 448.f), 0, false);
    return (unsigned)__builtin_amdgcn_cvt_pk_fp8_f32(fminf(fmaxf(c, -448.f), 448.f), fminf(fmaxf(d, -448.f), 448.f), w, true);
}
__device__ __forceinline__ unsigned pk4_i8(float a, float b, float c, float d) {
    const int ia = __float2int_rn(a), ib = __float2int_rn(b), ic = __float2int_rn(c), id = __float2int_rn(d);
    return ((unsigned)ia & 0xffu) | (((unsigned)ib & 0xffu) << 8) | (((unsigned)ic & 0xffu) << 16) | ((unsigned)id << 24);
}
__device__ __forceinline__ float mod_at(KP p, int b, int n) {
    const float* mp = (const float*)(p->ws + WS_MODP);
    float s = p->in[I_BADA][n];
#pragma unroll
    for (int kc = 0; kc < 4; ++kc) s += mp[(size_t)(kc * 8 + b) * NMOD + n];
    return s;
}

__device__ __forceinline__ void phase_mod(KP p, float* lds, int bid, int nb, int wv_) {
    const int tid = opaque_tid(), lane = tid & 63, wave = tid >> 6;
    const float* c = p->in[I_C]; const float* W = p->in[I_WADA];
    float* modp = (float*)(p->ws + WS_MODP);
    for (int i = tid; i < NB * D; i += NT) { const float v = c[i]; lds[i] = v * sigmoidf_(v); }
    __syncthreads();
    float* red = lds + NB * D;
    for (int item = bid; item < 192; item += nb) {
        const int nt = item % 48, kc = item / 48;
        const int n0 = nt * 256 + lane * 4, k0 = kc * 512 + wave * 64;
        float acc[8][4];
#pragma unroll
        for (int b = 0; b < 8; ++b)
#pragma unroll
            for (int j = 0; j < 4; ++j) acc[b][j] = 0.f;
        for (int kk = 0; kk < 64; ++kk) {
            const float4 w = *(const float4*)(W + (size_t)(k0 + kk) * NMOD + n0);
#pragma unroll
            for (int b = 0; b < 8; ++b) { const float s = lds[b * D + k0 + kk]; acc[b][0] += s * w.x; acc[b][1] += s * w.y; acc[b][2] += s * w.z; acc[b][3] += s * w.w; }
        }
#pragma unroll
        for (int b = 0; b < 8; ++b)
#pragma unroll
            for (int j = 0; j < 4; ++j) red[(wave * 32 + b * 4 + j) * 64 + lane] = acc[b][j];
        __syncthreads();
        for (int o = tid; o < 2048; o += NT) {
            const int b = o >> 8, nn = o & 255, ln = nn >> 2, j = nn & 3;
            float s = 0.f;
#pragma unroll
            for (int w = 0; w < 8; ++w) s += red[(w * 32 + b * 4 + j) * 64 + ln];
            modp[(size_t)(kc * 8 + b) * NMOD + nt * 256 + nn] = s;
        }
        __syncthreads();
    }
}

template <bool F8OUT, bool I8COPY = false, bool NOBF16 = false, bool SRC16 = false>
__device__ __forceinline__ void phase_hrows(KP p, const float* src, const float* gn, int shift_off, int scale_off, bf16_t* dst, float* lds, int bid, int nb, int wv_) {
    const int tid = opaque_tid(), lane = tid & 63, wave = tid >> 6;
    float* Aw = lds; float* Bw = lds + D;
    for (int item = bid; item < M / 64; item += nb) {
        const int b = item / (SEQ / 64);
        for (int col = tid; col < D; col += NT) { if (SRC16) { const float* ms = (const float*)(p->ws + WS_MODS) + (size_t)b * NMOD; Aw[col] = gn[col] * (1.f + ms[scale_off + col]); Bw[col] = ms[shift_off + col]; }
                                                 else { Aw[col] = gn[col] * (1.f + mod_at(p, b, scale_off + col)); Bw[col] = mod_at(p, b, shift_off + col); } }
        __syncthreads();
        for (int r = wave; r < 64; r += 8) {
            const size_t row = (size_t)item * 64 + r;
            float4 v[8]; float ss = 0.f;
#pragma unroll
            for (int j = 0; j < 8; ++j) { if (SRC16) { const uint2 w = *(const uint2*)((const bf16_t*)src + row * D + lane * 4 + 256 * j); v[j] = make_float4(__uint_as_float(w.x << 16), __uint_as_float(w.x & 0xffff0000u), __uint_as_float(w.y << 16), __uint_as_float(w.y & 0xffff0000u)); }
                                          else v[j] = *(const float4*)(src + row * D + lane * 4 + 256 * j);
                                          ss += v[j].x * v[j].x + v[j].y * v[j].y + v[j].z * v[j].z + v[j].w * v[j].w; }
            const float rstd = rsqrtf(wave_sum(ss) * (1.f / D) + EPS);
            float am = 0.f;
#pragma unroll
            for (int j = 0; j < 8; ++j) {
                const int col = lane * 4 + 256 * j;
                const float o0 = v[j].x * rstd * Aw[col] + Bw[col], o1 = v[j].y * rstd * Aw[col + 1] + Bw[col + 1];
                const float o2 = v[j].z * rstd * Aw[col + 2] + Bw[col + 2], o3 = v[j].w * rstd * Aw[col + 3] + Bw[col + 3];
                if (F8OUT || I8COPY) { v[j] = make_float4(o0, o1, o2, o3); am = fmaxf(am, fmaxf(fmaxf(fabsf(o0), fabsf(o1)), fmaxf(fabsf(o2), fabsf(o3)))); }
                if (!F8OUT && !NOBF16) { uint2 w; w.x = (unsigned)f2bf(o0) | ((unsigned)f2bf(o1) << 16); w.y = (unsigned)f2bf(o2) | ((unsigned)f2bf(o3) << 16); *(uint2*)(dst + row * D + col) = w; }
            }
            if (I8COPY) {
                am = wave_max(am); const float sc = am > 0.f ? 127.f / am : 0.f;
                unsigned* d8 = (unsigned*)(p->ws + WS_H8I + row * D);
#pragma unroll
                for (int j = 0; j < 8; ++j) d8[lane + 64 * j] = pk4_i8(v[j].x * sc, v[j].y * sc, v[j].z * sc, v[j].w * sc);
                if (lane == 0) ((float*)(p->ws + WS_HSC))[row] = am * (1.f / 127.f);
            }
            if (F8OUT) {
                am = wave_max(am); const float sc = am > 0.f ? 127.f / am : 0.f;
                unsigned* d8 = (unsigned*)((unsigned char*)dst + row * D);
#pragma unroll
                for (int j = 0; j < 8; ++j) d8[lane + 64 * j] = pk4_i8(v[j].x * sc, v[j].y * sc, v[j].z * sc, v[j].w * sc);
                if (lane == 0) ((float*)(p->ws + WS_HSCALE1))[row] = am * (1.f / 127.f);
            }
        }
        __syncthreads();
    }
}

namespace pg8 {
#define PG8_LAS __attribute__((address_space(3)))
typedef unsigned short bf16_t;
typedef short bf16x8 __attribute__((ext_vector_type(8)));
typedef float f32x4 __attribute__((ext_vector_type(4)));
typedef unsigned u32x4 __attribute__((ext_vector_type(4)));
constexpr int BM = 256, BK = 64, HALF = 128, HTB = HALF * BK * 2  , STAGE_BYTES = 8 * HTB, NXCD = 8, WGM = 8;

__host__ __device__ __forceinline__ int lds_byte(int r, int c) { const int st = (r >> 4) * 2 + (c >> 5), rr = r & 15, cc = c & 31, ob = rr * 64 + cc * 2; return st * 1024 + (ob ^ (((ob >> 9) & 1) << 5)); }
__host__ __device__ __forceinline__ void stage_rc(int b, int& R, int& C) { const int st = b / 1024, sb = b % 1024, swz = sb ^ (((sb >> 9) & 1) << 5); R = (st >> 1) * 16 + swz / 64; C = (st & 1) * 32 + (swz % 64) / 2; }
__host__ __device__ __forceinline__ int perm32(int rho) { const int n = rho >> 4, i = rho & 15; return 8 * (i >> 2) + 4 * n + (i & 3); }

struct Unit { int pm, pn; };
struct Gemm { const bf16_t* A; const bf16_t* Bt; int M, N, K; };

struct StaticOrder {
    int nM, nN, nwg, G, c;
    __host__ __device__ void init(int M, int N, int G_, int c_) { nM = M / BM; nN = N / BM; nwg = nM * nN; G = G_; c = c_; }
    __host__ __device__ bool next(int i, Unit& u) const {
        const long L = (long)i * G + c; if (L >= nwg) return false;
        int wgid = (int)L; { const int q = nwg / NXCD, r = nwg % NXCD, xcd = wgid % NXCD, off = wgid / NXCD; wgid = (xcd < r ? xcd * (q + 1) : r * (q + 1) + (xcd - r) * q) + off; }
        const int nig = WGM * nN, gid = wgid / nig, fm = gid * WGM, gsz = (nM - fm) < WGM ? (nM - fm) : WGM;
        u.pm = fm + ((wgid % nig) % gsz); u.pn = (wgid % nig) / gsz; return true;
    }
    __device__ __forceinline__ void a_ready(const Unit&) const {}
    __device__ __forceinline__ void done(const Unit&) const {}
};


__device__ __forceinline__ unsigned cvt_pk_bf16(float lo, float hi) { unsigned r; asm volatile("v_cvt_pk_bf16_f32 %0, %1, %2" : "=v"(r) : "v"(lo), "v"(hi)); return r; }
__device__ __forceinline__ float gelu_tanh(float x) { const float u = 1.5957691216057308f * (x + 0.044715f * x * x * x); return x * __builtin_amdgcn_rcpf(1.f + __expf(-u)); }
template <bool ACCI  > struct EpiProj {
    static constexpr bool PERM = true, AFTER_DRAIN = false;
    bf16_t* proj; float* ssqv; int Mrows; const float* rowscale; const float* cscale;
    __device__ __forceinline__ void operator()(const f32x4 (&acc)[2][2][4][2], const Unit& u, int wr, int wc, int fr, int fq) const {
        const int which = (u.pn * BM) >> 10, colt = (u.pn * BM) & 1023; const float cs = *cscale;
        bf16_t* base = proj + (size_t)which * Mrows * 1024;
        const int row0 = u.pm * BM + wr * 64 + fr, col0 = colt + wc * 32 + 8 * fq;
#pragma unroll
        for (int ai = 0; ai < 2; ++ai)
#pragma unroll
            for (int m = 0; m < 4; ++m) { const int row = row0 + ai * HALF + m * 16; bf16_t* rowp = base + (size_t)row * 1024 + col0; float ss = 0.f; const float f = cs * rowscale[row];
#pragma unroll
                for (int bj = 0; bj < 2; ++bj) { f32x4 v0 = acc[ai][bj][m][0], v1 = acc[ai][bj][m][1];
                    if (ACCI) { typedef int v4j_ __attribute__((ext_vector_type(4))); const v4j_ i0 = __builtin_bit_cast(v4j_, v0), i1 = __builtin_bit_cast(v4j_, v1);
                        v0 = (f32x4){(float)i0[0], (float)i0[1], (float)i0[2], (float)i0[3]}; v1 = (f32x4){(float)i1[0], (float)i1[1], (float)i1[2], (float)i1[3]}; }
                    v0 = v0 * f; v1 = v1 * f;
                    if (which) {
#pragma unroll
                        for (int j = 0; j < 4; ++j) { v0[j] = gelu_tanh(v0[j]); v1[j] = gelu_tanh(v1[j]); } }
                    ss += (v0[0] * v0[0] + v0[1] * v0[1]) + (v0[2] * v0[2] + v0[3] * v0[3]) + (v1[0] * v1[0] + v1[1] * v1[1]) + (v1[2] * v1[2] + v1[3] * v1[3]);
                    u32x4 w; w.x = cvt_pk_bf16(v0[0], v0[1]); w.y = cvt_pk_bf16(v0[2], v0[3]); w.z = cvt_pk_bf16(v1[0], v1[1]); w.w = cvt_pk_bf16(v1[2], v1[3]);
                    *(u32x4*)(rowp + bj * HALF) = w; }
                if (which == 3) { ss += __shfl_xor(ss, 16); ss += __shfl_xor(ss, 32); if (fq == 0) ssqv[(size_t)row * 16 + (u.pn & 3) * 4 + wc] = ss; } }
    }
};
struct EpiX1 {
    static constexpr bool PERM = false, AFTER_DRAIN = false;
    const float* x; bf16_t* out; const float* modp; const float* bada; int goff, nmod, seq; const float* cscale; float cscale2;
    __device__ __forceinline__ void operator()(const f32x4 (&acc)[2][2][4][2], const Unit& u, int wr, int wc, int fr, int fq) const {
        const int row0 = u.pm * BM + wr * 64 + fr, col0 = u.pn * BM + wc * 32 + 4 * fq, b = (u.pm * BM) / seq;
        f32x4 gv[2][2];
#pragma unroll
        for (int bj = 0; bj < 2; ++bj)
#pragma unroll
            for (int n = 0; n < 2; ++n) { const int c = goff + col0 + bj * HALF + n * 16; const f32x4 g = *(const f32x4*)(modp + (size_t)b * nmod + c);
                gv[bj][n] = g * (*cscale * cscale2); }
#pragma unroll
        for (int ai = 0; ai < 2; ++ai)
#pragma unroll
            for (int m = 0; m < 4; ++m) { const size_t off = (size_t)(row0 + ai * HALF + m * 16) * (size_t)(2048) + col0;
#pragma unroll
                for (int bj = 0; bj < 2; ++bj)
#pragma unroll
                    for (int n = 0; n < 2; ++n) { const f32x4 xv = *(const f32x4*)(x + off + bj * HALF + n * 16); const f32x4 r = xv + gv[bj][n] * acc[ai][bj][m][n];
                        uint2 w; w.x = (unsigned)f2bf(r[0]) | ((unsigned)f2bf(r[1]) << 16); w.y = (unsigned)f2bf(r[2]) | ((unsigned)f2bf(r[3]) << 16); *(uint2*)(out + off + bj * HALF + n * 16) = w; } }
    }
};
struct EpiQ {
    static constexpr bool PERM = true, AFTER_DRAIN = false;
    bf16_t* O; int ldc; const float* rowscale; const float* cscale;
    __device__ __forceinline__ void operator()(const f32x4 (&acc)[2][2][4][2], const Unit& u, int wr, int wc, int fr, int fq) const {
        const int row0 = u.pm * BM + wr * 64 + fr, col0 = u.pn * BM + wc * 32 + 8 * fq;
#pragma unroll
        for (int ai = 0; ai < 2; ++ai)
#pragma unroll
            for (int m = 0; m < 4; ++m) { bf16_t* rowp = O + (size_t)(row0 + ai * HALF + m * 16) * ldc + col0; const float f = *cscale * rowscale[row0 + ai * HALF + m * 16];
#pragma unroll
                for (int bj = 0; bj < 2; ++bj) { typedef int v4j_ __attribute__((ext_vector_type(4))); const v4j_ i0 = __builtin_bit_cast(v4j_, acc[ai][bj][m][0]), i1 = __builtin_bit_cast(v4j_, acc[ai][bj][m][1]);
                    const f32x4 v0 = (f32x4){(float)i0[0], (float)i0[1], (float)i0[2], (float)i0[3]} * f, v1 = (f32x4){(float)i1[0], (float)i1[1], (float)i1[2], (float)i1[3]} * f;
                    u32x4 w; w.x = cvt_pk_bf16(v0[0], v0[1]); w.y = cvt_pk_bf16(v0[2], v0[3]); w.z = cvt_pk_bf16(v1[0], v1[1]); w.w = cvt_pk_bf16(v1[2], v1[3]);
                    *(u32x4*)(rowp + bj * HALF) = w; } }
    }
};

template <class Epi, class Sched, bool ALIGN_EPI = false, bool SP2 = false, int OPK = 0>
__device__ __forceinline__ void gemm_phase(PG8_LAS unsigned char* lds, const Gemm g, const Sched& S, const Epi& E, int wv_) {
    const int tid = opaque_tid(), wid = __builtin_amdgcn_readfirstlane(tid >> 6), lane = tid & 63, wr = wid >> 2, wc = wid & 3, fr = lane & 15, fq = lane >> 4;
    const int K = g.K, nt = K / BK;
    unsigned voffA[2], voffB[2];
#pragma unroll
    for (int i = 0; i < 2; ++i) { int R, C; stage_rc(tid * 16 + i * 8192, R, C); const int Rb = Epi::PERM ? ((R & ~31) + perm32(R & 31)) : R;
        voffA[i] = (unsigned)(R * K + C) * 2u; voffB[i] = (unsigned)(Rb * K + C) * 2u; }
    const size_t kstep = (size_t)(BK * 2);
    const size_t hstep = (size_t)HALF * K * 2;
    const size_t tstep = 2 * hstep;
    const unsigned ldsw = (unsigned)wid * 1024u;
    const int aoff = lds_byte(wr * 64 + fr, fq * 8), boff = lds_byte(wc * 32 + fr, fq * 8);
#define PG8_SA(b, h) (((b) * 2 + (h)) * HTB)
#define PG8_SB(b, h) ((4 + (b) * 2 + (h)) * HTB)
#define PG8_STAGE(bufoff, gbase, voff) do { _Pragma("unroll") for (int _i = 0; _i < 2; ++_i) \
        __builtin_amdgcn_global_load_lds((const unsigned*)((const char*)(gbase) + (voff)[_i]), (PG8_LAS unsigned*)(lds + (bufoff) + ldsw + _i * 8192), 16, 0, 0); } while (0)
#define PG8_LDA(dst, b, h) do { _Pragma("unroll") for (int m = 0; m < 4; ++m) _Pragma("unroll") for (int k = 0; k < 2; ++k) dst[m][k] = *(const PG8_LAS bf16x8*)(lds + PG8_SA(b, h) + aoff + m * 2048 + k * 1024); } while (0)
#define PG8_LDB(dst, b, h) do { _Pragma("unroll") for (int n = 0; n < 2; ++n) _Pragma("unroll") for (int k = 0; k < 2; ++k) dst[n][k] = *(const PG8_LAS bf16x8*)(lds + PG8_SB(b, h) + boff + n * 2048 + k * 1024); } while (0)
#define PG8_MMA(ai, bj, At, Bt) do { __builtin_amdgcn_s_setprio(1); _Pragma("unroll") for (int m = 0; m < 4; ++m) _Pragma("unroll") for (int n = 0; n < 2; ++n) { \
        if constexpr (OPK == 2) { typedef int v4j_ __attribute__((ext_vector_type(4))); _Pragma("unroll") for (int k = 0; k < 2; ++k) \
            acc[ai][bj][m][n] = __builtin_bit_cast(f32x4, __builtin_amdgcn_mfma_i32_16x16x64_i8(__builtin_bit_cast(v4j_, Bt[n][k]), __builtin_bit_cast(v4j_, At[m][k]), __builtin_bit_cast(v4j_, acc[ai][bj][m][n]), 0, 0, 0)); } \
        else if constexpr (OPK == 1) { typedef int v4i_ __attribute__((ext_vector_type(4))); typedef int v8i_ __attribute__((ext_vector_type(8))); \
            const v8i_ a8 = __builtin_shufflevector(__builtin_bit_cast(v4i_, Bt[n][0]), __builtin_bit_cast(v4i_, Bt[n][1]), 0, 1, 2, 3, 4, 5, 6, 7), b8 = __builtin_shufflevector(__builtin_bit_cast(v4i_, At[m][0]), __builtin_bit_cast(v4i_, At[m][1]), 0, 1, 2, 3, 4, 5, 6, 7); \
            asm volatile("v_mfma_scale_f32_16x16x128_f8f6f4 %0, %1, %2, %0, %3, %3 op_sel_hi:[0,0,0]" : "+v"(acc[ai][bj][m][n]) : "v"(a8), "v"(b8), "v"(one8)); } \
        else { _Pragma("unroll") for (int k = 0; k < 2; ++k) acc[ai][bj][m][n] = __builtin_amdgcn_mfma_f32_16x16x32_bf16(Bt[n][k], At[m][k], acc[ai][bj][m][n], 0, 0, 0); } } \
        __builtin_amdgcn_s_setprio(0); } while (0)
#define PG8_WAIT_V(n) asm volatile("s_waitcnt vmcnt(" #n ")" ::: "memory")
#define PG8_WAIT_L(n) asm volatile("s_waitcnt lgkmcnt(" #n ")" ::: "memory")
#define PG8_BAR __builtin_amdgcn_s_barrier()
#define PG8_SCHED __builtin_amdgcn_sched_barrier(0)
    Unit cur, nxt; int ui = 0;
    if (!S.next(0, cur)) return;
    f32x4 acc[2][2][4][2];
#pragma unroll
    for (int a = 0; a < 2; ++a)
#pragma unroll
        for (int b = 0; b < 2; ++b)
#pragma unroll
            for (int m = 0; m < 4; ++m)
#pragma unroll
                for (int n = 0; n < 2; ++n) acc[a][b][m][n] = (f32x4){0.f, 0.f, 0.f, 0.f};
    bf16x8 At[4][2], B0[2][2], B1[2][2];
    int one8 = 0x7F7F7F7F; asm volatile("" : "+v"(one8));
    const char* cA = (const char*)g.A + (size_t)cur.pm * tstep; const char* cB = (const char*)g.Bt + (size_t)cur.pn * tstep;
    S.a_ready(cur);
    if constexpr (SP2) {
        PG8_STAGE(PG8_SB(0, 0), cB, voffB); PG8_STAGE(PG8_SB(0, 1), cB + hstep, voffB); PG8_STAGE(PG8_SA(0, 0), cA, voffA); PG8_STAGE(PG8_SA(0, 1), cA + hstep, voffA);
        if (wr == 1) PG8_BAR;
        PG8_WAIT_V(2); PG8_BAR;
        PG8_STAGE(PG8_SB(1, 0), cB + kstep, voffB); PG8_STAGE(PG8_SA(1, 0), cA + kstep, voffA); PG8_STAGE(PG8_SB(1, 1), cB + hstep + kstep, voffB);
        PG8_WAIT_V(6); PG8_BAR;
    } else {
        PG8_STAGE(PG8_SB(0, 0), cB, voffB); PG8_STAGE(PG8_SA(0, 0), cA, voffA); PG8_STAGE(PG8_SB(0, 1), cB + hstep, voffB); PG8_STAGE(PG8_SA(0, 1), cA + hstep, voffA);
        if (wr == 1) PG8_BAR;
        PG8_WAIT_V(4); PG8_BAR;
        PG8_STAGE(PG8_SB(1, 0), cB + kstep, voffB); PG8_STAGE(PG8_SA(1, 0), cA + kstep, voffA); PG8_STAGE(PG8_SB(1, 1), cB + hstep + kstep, voffB);
        PG8_WAIT_V(6); PG8_BAR;
    }
    for (;;) {
        const bool has_next = S.next(ui + 1, nxt);
        const char* nA = has_next ? (const char*)g.A + (size_t)nxt.pm * tstep : cA; const char* nB = has_next ? (const char*)g.Bt + (size_t)nxt.pn * tstep : cB;
        for (int t = 0; t < nt; t += 2) {
            const bool last = (t == nt - 2);
            const char* a1 = cA + (size_t)(t + 1) * kstep;
            const char* a2 = last ? nA : cA + (size_t)(t + 2) * kstep; const char* b2 = last ? nB : cB + (size_t)(t + 2) * kstep;
            const char* a3 = a2 + kstep; const char* b3 = b2 + kstep;
            if (last && has_next) S.a_ready(nxt);
            if constexpr (SP2) {
            PG8_LDB(B0, 0, 0); PG8_LDB(B1, 0, 1); PG8_SCHED; PG8_LDA(At, 0, 0); PG8_STAGE(PG8_SA(1, 1), a1 + hstep, voffA);
            PG8_WAIT_V(8); PG8_WAIT_L(0); PG8_BAR; PG8_MMA(0, 0, At, B0); PG8_MMA(0, 1, At, B1); PG8_BAR; PG8_SCHED;
            PG8_LDA(At, 0, 1); PG8_STAGE(PG8_SB(0, 0), b2, voffB); PG8_STAGE(PG8_SB(0, 1), b2 + hstep, voffB); PG8_STAGE(PG8_SA(0, 0), a2, voffA);
            PG8_WAIT_V(8); PG8_WAIT_L(0); PG8_BAR; PG8_MMA(1, 0, At, B0); PG8_MMA(1, 1, At, B1); PG8_BAR; PG8_SCHED;
            PG8_LDB(B0, 1, 0); PG8_LDB(B1, 1, 1); PG8_SCHED; PG8_LDA(At, 1, 0); PG8_STAGE(PG8_SA(0, 1), a2 + hstep, voffA);
            PG8_WAIT_V(8); PG8_WAIT_L(0); PG8_BAR; PG8_MMA(0, 0, At, B0); PG8_MMA(0, 1, At, B1); PG8_BAR; PG8_SCHED;
            PG8_LDA(At, 1, 1); PG8_STAGE(PG8_SB(1, 0), b3, voffB); PG8_STAGE(PG8_SB(1, 1), b3 + hstep, voffB); PG8_STAGE(PG8_SA(1, 0), a3, voffA);
            PG8_WAIT_V(8); PG8_WAIT_L(0); PG8_BAR; PG8_MMA(1, 0, At, B0); PG8_MMA(1, 1, At, B1); PG8_BAR; PG8_SCHED;
            } else {
            PG8_LDB(B0, 0, 0); PG8_SCHED; PG8_LDA(At, 0, 0); PG8_STAGE(PG8_SA(1, 1), a1 + hstep, voffA);
            PG8_WAIT_L(8); PG8_BAR; PG8_WAIT_L(0); PG8_MMA(0, 0, At, B0); PG8_BAR; PG8_SCHED;
            PG8_LDB(B1, 0, 1); PG8_STAGE(PG8_SB(0, 0), b2, voffB);
            PG8_BAR; PG8_WAIT_L(0); PG8_MMA(0, 1, At, B1); PG8_BAR;
            PG8_LDA(At, 0, 1); PG8_STAGE(PG8_SA(0, 0), a2, voffA);
            PG8_BAR; PG8_WAIT_L(0); PG8_MMA(1, 0, At, B0); PG8_BAR; PG8_SCHED;
            PG8_STAGE(PG8_SB(0, 1), b2 + hstep, voffB);
            PG8_WAIT_V(6); PG8_BAR; PG8_MMA(1, 1, At, B1); PG8_BAR;
            PG8_LDB(B0, 1, 0); PG8_SCHED; PG8_LDA(At, 1, 0); PG8_STAGE(PG8_SA(0, 1), a2 + hstep, voffA);
            PG8_WAIT_L(8); PG8_BAR; PG8_WAIT_L(0); PG8_MMA(0, 0, At, B0); PG8_BAR; PG8_SCHED;
            PG8_LDB(B1, 1, 1); PG8_STAGE(PG8_SB(1, 0), b3, voffB);
            PG8_BAR; PG8_WAIT_L(0); PG8_MMA(0, 1, At, B1); PG8_BAR;
            PG8_LDA(At, 1, 1); PG8_STAGE(PG8_SA(1, 0), a3, voffA);
            PG8_BAR; PG8_WAIT_L(0); PG8_MMA(1, 0, At, B0); PG8_BAR; PG8_SCHED;
            PG8_STAGE(PG8_SB(1, 1), b3 + hstep, voffB);
            PG8_WAIT_V(6); PG8_BAR; PG8_MMA(1, 1, At, B1); PG8_BAR;
            }
        }
        if constexpr (OPK == 1) {
            asm volatile("s_nop 15\n\ts_nop 7" ::: "memory");
#pragma unroll
            for (int a_ = 0; a_ < 2; ++a_)
#pragma unroll
                for (int b_ = 0; b_ < 2; ++b_)
#pragma unroll
                    for (int m_ = 0; m_ < 4; ++m_) asm volatile("" : "+v"(acc[a_][b_][m_][0]), "+v"(acc[a_][b_][m_][1]));
        }
        if constexpr (ALIGN_EPI) { if (wr == 0) PG8_BAR; }
        if constexpr (!Epi::AFTER_DRAIN) { E(acc, cur, wr, wc, fr, fq); S.done(cur); }
        if (!has_next) break;
#pragma unroll
        for (int a = 0; a < 2; ++a)
#pragma unroll
            for (int b = 0; b < 2; ++b)
#pragma unroll
                for (int m = 0; m < 4; ++m)
#pragma unroll
                    for (int n = 0; n < 2; ++n) acc[a][b][m][n] = (f32x4){0.f, 0.f, 0.f, 0.f};
        cur = nxt; cA = nA; cB = nB; ++ui;
        if constexpr (ALIGN_EPI) { if (wr == 1) PG8_BAR; }
    }
    PG8_WAIT_V(0);
    if constexpr (!ALIGN_EPI) { if (wr == 0) PG8_BAR; }
    PG8_BAR;
    if constexpr (Epi::AFTER_DRAIN) { E.fused(acc, cur, wr, wc, fr, fq, lds, wid, lane); S.done(cur); }
#undef PG8_SA
#undef PG8_SB
#undef PG8_STAGE
#undef PG8_LDA
#undef PG8_LDB
#undef PG8_MMA
#undef PG8_WAIT_V
#undef PG8_WAIT_L
#undef PG8_BAR
#undef PG8_SCHED
}
}

#define LAS __attribute__((address_space(3)))
extern __shared__ __attribute__((aligned(16))) unsigned char dyn_lds[];
__device__ __forceinline__ LAS unsigned char* dyn_lds_base() { return (LAS unsigned char*)dyn_lds; }
typedef unsigned v2u_t __attribute__((ext_vector_type(2)));
typedef int v4i_t __attribute__((ext_vector_type(4)));
__device__ __forceinline__ unsigned pk2(float lo, float hi) { return (unsigned)f2bf(lo) | ((unsigned)f2bf(hi) << 16); }
__device__ __forceinline__ void transpose_item(const float* W, int K, int N, bf16_t* WT, float* scr, int item, int lane) {
    const int nblk = N / 32, kb = item / nblk, nbk = item % nblk, k0 = 64 * kb, n0 = 32 * nbk;
#pragma unroll 8
    for (int i = 0; i < 32; ++i) { const int kk = 2 * i + (lane >> 5); scr[kk * 33 + (lane & 31)] = W[(size_t)(k0 + kk) * N + n0 + (lane & 31)]; }
    asm volatile("s_waitcnt lgkmcnt(0)" ::: "memory");
    const int c = lane & 7;
#pragma unroll
    for (int j = 0; j < 4; ++j) { const int n = (lane >> 3) + 8 * j; const float* s = scr + (8 * c) * 33 + n;
        uint4 o; o.x = pk2(s[0 * 33], s[1 * 33]); o.y = pk2(s[2 * 33], s[3 * 33]); o.z = pk2(s[4 * 33], s[5 * 33]); o.w = pk2(s[6 * 33], s[7 * 33]);
        *(uint4*)(WT + (size_t)(n0 + n) * K + k0 + 8 * c) = o; }
    asm volatile("s_waitcnt lgkmcnt(0)" ::: "memory");
}
constexpr int CW_AMAX_WIN = 2048, CW_AMAX_WOUT = 2112, CW_WSCALE = 2176, CW_AMAX_WQ = 2240;
__device__ __forceinline__ void phase_amax(KP p, int bid, int nb, int wv_) {
    const int tid = opaque_tid(), lane = tid & 63;
    for (int t = 0; t < 3; ++t) {
        const float4* w = (const float4*)(t == 2 ? p->in[I_WQ] : t ? p->in[I_WOUT] : p->in[I_WIN]); const size_t n4 = (size_t)D * (t ? D : NPROJ) / 4;
        float am = 0.f;
        for (size_t i = (size_t)bid * NT + tid; i < n4; i += (size_t)nb * NT) { const float4 v = w[i]; am = fmaxf(am, fmaxf(fmaxf(fabsf(v.x), fabsf(v.y)), fmaxf(fabsf(v.z), fabsf(v.w)))); }
        am = wave_max(am);
        if (lane == 0) atomicMax((unsigned*)(p->ws + WS_CTL) + (t == 2 ? CW_AMAX_WQ : t ? CW_AMAX_WOUT : CW_AMAX_WIN), __float_as_uint(am));
    }
}
template <bool I8>
__device__ __forceinline__ void transpose_item8(const float* W, int K, int N, unsigned char* WT, float* scr, int item, int lane, float sc) {
    const int nblk = N / 32, kb = item / nblk, nbk = item % nblk, k0 = 64 * kb, n0 = 32 * nbk;
#pragma unroll 8
    for (int i = 0; i < 32; ++i) { const int kk = 2 * i + (lane >> 5); scr[kk * 33 + (lane & 31)] = W[(size_t)(k0 + kk) * N + n0 + (lane & 31)]; }
    asm volatile("s_waitcnt lgkmcnt(0)" ::: "memory");
    const int c = lane & 3;
#pragma unroll
    for (int j = 0; j < 2; ++j) { const int n = (lane >> 2) + 16 * j; const float* s = scr + (16 * c) * 33 + n;
        uint4 o;
        if (I8) { o.x = pk4_i8(s[0 * 33] * sc, s[1 * 33] * sc, s[2 * 33] * sc, s[3 * 33] * sc); o.y = pk4_i8(s[4 * 33] * sc, s[5 * 33] * sc, s[6 * 33] * sc, s[7 * 33] * sc);
            o.z = pk4_i8(s[8 * 33] * sc, s[9 * 33] * sc, s[10 * 33] * sc, s[11 * 33] * sc); o.w = pk4_i8(s[12 * 33] * sc, s[13 * 33] * sc, s[14 * 33] * sc, s[15 * 33] * sc); }
        else { o.x = pk4_fp8(s[0 * 33] * sc, s[1 * 33] * sc, s[2 * 33] * sc, s[3 * 33] * sc); o.y = pk4_fp8(s[4 * 33] * sc, s[5 * 33] * sc, s[6 * 33] * sc, s[7 * 33] * sc);
            o.z = pk4_fp8(s[8 * 33] * sc, s[9 * 33] * sc, s[10 * 33] * sc, s[11 * 33] * sc); o.w = pk4_fp8(s[12 * 33] * sc, s[13 * 33] * sc, s[14 * 33] * sc, s[15 * 33] * sc); }
        *(uint4*)(WT + (size_t)(n0 + n) * K + k0 + 16 * c) = o; }
    asm volatile("s_waitcnt lgkmcnt(0)" ::: "memory");
}
__device__ __forceinline__ void phase_convert_weights8(KP p, float* lds, int bid, int nb, int wv_) {
    const int tid = opaque_tid(), lane = tid & 63, wave = tid >> 6;
    float* scr = lds + 4096 + wave * (64 * 33);
    const unsigned* ctl = (const unsigned*)(p->ws + WS_CTL);
    const float am_in = __uint_as_float(__hip_atomic_load(ctl + CW_AMAX_WIN, __ATOMIC_RELAXED, __HIP_MEMORY_SCOPE_AGENT)); const float sc_in = am_in > 0.f ? 127.f / am_in : 0.f;
    const float sc_out = pow2_scale_from_max(__uint_as_float(__hip_atomic_load(ctl + CW_AMAX_WOUT, __ATOMIC_RELAXED, __HIP_MEMORY_SCOPE_AGENT)));
    if (bid == 0 && tid == 0) { ((float*)(p->ws + WS_CTL))[CW_WSCALE] = am_in * (1.f / 127.f); ((float*)(p->ws + WS_CTL))[CW_WSCALE + 1] = 1.f / sc_out; }
    const int gw = bid * 8 + wave, ngw = nb * 8;
    constexpr int I_IN = (D / 64) * (NPROJ / 32), I_SQ = (D / 64) * (D / 32);
    const float am_q = __uint_as_float(__hip_atomic_load(ctl + CW_AMAX_WQ, __ATOMIC_RELAXED, __HIP_MEMORY_SCOPE_AGENT)); const float sc_q = am_q > 0.f ? 127.f / am_q : 0.f;
    if (bid == 0 && tid == 0) ((float*)(p->ws + WS_CTL))[CW_WSCALE + 2] = am_q * (1.f / 127.f);
    for (int it = gw; it < I_IN + 2 * I_SQ; it += ngw) {
        if (it < I_IN) transpose_item8<true>(p->in[I_WIN], D, NPROJ, p->ws + WS_WIN_T, scr, it, lane, sc_in);
        else if (it < I_IN + I_SQ) transpose_item8<false>(p->in[I_WOUT], D, D, p->ws + WS_WOUT_T, scr, it - I_IN, lane, sc_out);
        else transpose_item8<true>(p->in[I_WQ], D, D, p->ws + WS_WQ_T, scr, it - I_IN - I_SQ, lane, sc_q);
    }
}
__device__ __forceinline__ void phase_convert_weights(KP p, float* lds, int bid, int nb, int wv_) {
    const int tid = opaque_tid(), lane = tid & 63, wave = tid >> 6;
    float* scr = lds + wave * (64 * 33);
    const int gw = bid * 8 + wave, ngw = nb * 8;
    constexpr int I_SQ = (D / 64) * (D / 32), I_G = 8 * (128 / 64) * (128 / 32);
    constexpr int NITEMS = 2 * I_G;
    for (int it = gw; it < NITEMS; it += ngw) {
        int r = it;

        if (r < I_G) { const int hd = r / 8; transpose_item(p->in[I_WGA] + hd * 16384, 128, 128, (bf16_t*)(p->ws + WS_WGA_T) + hd * 16384, scr, r % 8, lane); continue; } r -= I_G;
        { const int hd = r / 8; transpose_item(p->in[I_WGI] + hd * 16384, 128, 128, (bf16_t*)(p->ws + WS_WGI_T) + hd * 16384, scr, r % 8, lane); }
    }
    bf16_t* wsp = (bf16_t*)(p->ws + WS_WSPB); bf16_t* skb = (bf16_t*)(p->ws + WS_SKEYB);
    for (int e = bid * NT + tid; e < 8 * 128 * 128; e += nb * NT) { const int i = (e >> 7) & 127, j = e & 127; wsp[e] = f2bf(j <= i ? p->in[I_WSP][e] : 0.f); }
    for (int e = bid * NT + tid; e < 8 * 2 * 128 * 128; e += nb * NT) skb[e] = f2bf(p->in[I_SKEY][e]);
}

typedef short bf16x8_t __attribute__((ext_vector_type(8)));
typedef float f32x4_t __attribute__((ext_vector_type(4)));
typedef short s16x4_t __attribute__((ext_vector_type(4)));
constexpr float YMIX_SCALE = 8.f;
constexpr int XA_STRIDE = 272;
constexpr int LRU_XA = 0, LRU_SA = 34816, LRU_SB = LRU_SA + 16384, LRU_SEGP = LRU_SB + 16384, LRU_SEGH = LRU_SEGP + 2048, LRU_WF = LRU_SEGH + 2048, LRU_SA1 = LRU_WF + 64 * 272, LRU_SB1 = LRU_SA1 + 16384;
__device__ __forceinline__ void phase_lru(KP p, unsigned char* lds, int bid, int nb, int wv_) {
    const int tid = opaque_tid(), lane = tid & 63, wave = tid >> 6, c16 = lane & 15, q = lane >> 4;
    const bf16_t* XL = (const bf16_t*)(p->ws + WS_PROJ); const bf16_t* YG = XL + (size_t)M * 1024; bf16_t* ymix = (bf16_t*)(p->ws + WS_YMIX);
    float* SA = (float*)(lds + LRU_SA); float* SB = (float*)(lds + LRU_SB); float* SEGP = (float*)(lds + LRU_SEGP); float* SEGH = (float*)(lds + LRU_SEGH);
    for (int unit = bid; unit < NB * 8 * 4; unit += nb) {
        const int b = unit >> 5, hd = (unit >> 2) & 7, cq = unit & 3;
        for (int i = tid; i < 2 * 32 * 16; i += NT) { const int gs = i >> 9, j = (i >> 4) & 31, o16 = i & 15;
            *(uint4*)(lds + LRU_WF + (gs * 32 + j) * XA_STRIDE + o16 * 16) = *(const uint4*)((const bf16_t*)(p->ws + (gs ? WS_WGI_T : WS_WGA_T)) + (size_t)(hd * 128 + cq * 32 + j) * 128 + o16 * 8); }
        float ba[2], bi[2], c2[2];
#pragma unroll
        for (int nt = 0; nt < 2; ++nt) { const int ch = hd * 128 + cq * 32 + nt * 16 + c16; ba[nt] = p->in[I_BGA][ch]; bi[nt] = p->in[I_BGI][ch];
            const float lam = p->in[I_LAM][ch]; const float sp = fmaxf(-lam, 0.f) + log1pf(__expf(-fabsf(lam))); c2[nt] = -8.f * sp * 1.4426950408889634f; }
        const int o = tid & 15, rg = tid >> 4;
        float cw[4][8], cb[8];
#pragma unroll
        for (int e = 0; e < 8; ++e) { cb[e] = p->in[I_CONVB][hd * 128 + o * 8 + e];
#pragma unroll
            for (int k = 0; k < 4; ++k) cw[k][e] = p->in[I_CONVW][k * DLRU + hd * 128 + o * 8 + e]; }
        const int sc = tid & 31, seg = tid >> 5;
        float carry = 0.f;
        uint4 xr[7];
#define LRU_LOAD_X(t0_) do { _Pragma("unroll") for (int i = 0; i < 7; ++i) { const int t = (t0_) + 4 * rg - 3 + i; const int tc = t < 0 ? 0 : t; const unsigned keep = t < 0 ? 0u : 0xffffffffu; \
            const uint4 w = *(const uint4*)(XL + ((size_t)b * SEQ + tc) * 1024 + hd * 128 + o * 8); xr[i] = make_uint4(w.x & keep, w.y & keep, w.z & keep, w.w & keep); } } while (0)
        LRU_LOAD_X(0);
        bf16_t yg[8];
        float av[8], bv[8];
#pragma unroll
        for (int k = 0; k < 8; ++k) { yg[k] = 0; av[k] = 0.f; bv[k] = 0.f; }
        for (int it = 0; it <= SEQ / 128; ++it) {
            const bool hc = it < SEQ / 128, hp = it > 0;
            const int t0 = it * 128; const size_t row0 = (size_t)b * SEQ + t0, rowp = row0 - 128;
            float* SAc = (float*)(lds + ((it & 1) ? LRU_SA1 : LRU_SA)); float* SBc = (float*)(lds + ((it & 1) ? LRU_SB1 : LRU_SB));
            const float* SAp = (const float*)(lds + ((it & 1) ? LRU_SA : LRU_SA1)); const float* SBp = (const float*)(lds + ((it & 1) ? LRU_SB : LRU_SB1));
            if (hc) {
#pragma unroll
                for (int r = 0; r < 4; ++r) {
                    float acc8[8];
#pragma unroll
                    for (int e = 0; e < 8; ++e) acc8[e] = cb[e];
#pragma unroll
                    for (int k = 0; k < 4; ++k) { const uint4 w = xr[r + k]; const unsigned ww[4] = {w.x, w.y, w.z, w.w};
#pragma unroll
                        for (int e2 = 0; e2 < 4; ++e2) { acc8[2 * e2] += cw[k][2 * e2] * __uint_as_float(ww[e2] << 16); acc8[2 * e2 + 1] += cw[k][2 * e2 + 1] * __uint_as_float(ww[e2] & 0xffff0000u); } }
                    uint4 ov; ov.x = pk2(acc8[0], acc8[1]); ov.y = pk2(acc8[2], acc8[3]); ov.z = pk2(acc8[4], acc8[5]); ov.w = pk2(acc8[6], acc8[7]);
                    *(uint4*)(lds + LRU_XA + (4 * rg + r) * XA_STRIDE + o * 16) = ov;
                }
                if (it + 1 < SEQ / 128) LRU_LOAD_X(t0 + 128);
            }
            if (hp) {
#pragma unroll
                for (int k = 0; k < 8; ++k) yg[k] = YG[(rowp + seg * 8 + k) * 1024 + hd * 128 + cq * 32 + sc];
#pragma unroll
                for (int k = 0; k < 8; ++k) { av[k] = SAp[(seg * 8 + k) * 32 + sc]; bv[k] = SBp[(seg * 8 + k) * 32 + sc]; }
                float P = 1.f, H = 0.f;
#pragma unroll
                for (int k = 0; k < 8; ++k) { H = av[k] * H + bv[k]; P *= av[k]; }
                SEGP[seg * 32 + sc] = P; SEGH[seg * 32 + sc] = H;
            }
            __syncthreads();
            if (hc) {
                f32x4_t acc[2][2];
#pragma unroll
                for (int gs = 0; gs < 2; ++gs)
#pragma unroll
                    for (int nt = 0; nt < 2; ++nt) acc[gs][nt] = (f32x4_t){0.f, 0.f, 0.f, 0.f};
#pragma unroll
                for (int ks = 0; ks < 4; ++ks) {
                    const bf16x8_t a = *(const bf16x8_t*)(lds + LRU_XA + (16 * wave + c16) * XA_STRIDE + (ks * 32 + 8 * q) * 2);
#pragma unroll
                    for (int gs = 0; gs < 2; ++gs)
#pragma unroll
                        for (int nt = 0; nt < 2; ++nt) { const bf16x8_t wfr = *(const bf16x8_t*)(lds + LRU_WF + (gs * 32 + nt * 16 + c16) * XA_STRIDE + (ks * 32 + 8 * q) * 2);
                            acc[gs][nt] = __builtin_amdgcn_mfma_f32_16x16x32_bf16(a, wfr, acc[gs][nt], 0, 0, 0); }
                }
#pragma unroll
                for (int nt = 0; nt < 2; ++nt)
#pragma unroll
                    for (int reg = 0; reg < 4; ++reg) {
                        const int t = 16 * wave + 4 * q + reg, jj = nt * 16 + c16;
                        const float za = acc[0][nt][reg] + ba[nt], zi = acc[1][nt][reg] + bi[nt];
                        const float r = __builtin_amdgcn_rcpf(1.f + __expf(-za)), ig = __builtin_amdgcn_rcpf(1.f + __expf(-zi));
                        const float a = __builtin_amdgcn_exp2f(c2[nt] * r);
                        const float xcv = bf2f(*(const bf16_t*)(lds + LRU_XA + t * XA_STRIDE + (cq * 32 + jj) * 2));
                        SAc[t * 32 + jj] = a; SBc[t * 32 + jj] = __builtin_amdgcn_sqrtf(fmaxf(1.f - a * a, 0.f)) * (ig * xcv);
                    }
            }
            if (hp) {
                float run = carry, hin = carry;
                int segl = seg; asm volatile("" : "+v"(segl));
#pragma unroll
                for (int s = 0; s < 16; ++s) { if (s == segl) hin = run; run = SEGP[s * 32 + sc] * run + SEGH[s * 32 + sc]; }
                carry = run;
                float H = hin;
#pragma unroll
                for (int k = 0; k < 8; ++k) { H = av[k] * H + bv[k]; ((unsigned char*)ymix)[(rowp + seg * 8 + k) * D + hd * 128 + cq * 32 + sc] = (unsigned char)(pk4_fp8(H * bf2f(yg[k]) * YMIX_SCALE, 0.f, 0.f, 0.f) & 0xffu); }
            }
            __syncthreads();
        }
        __syncthreads();
#undef LRU_LOAD_X
    }
}

constexpr int SGU_RS = 0, SGU_TV = 512, SGU_SS = SGU_TV + 128 * XA_STRIDE, SS_STRIDE = 132;
__device__ __forceinline__ void phase_sgu(KP p, unsigned char* lds, int bid, int nb, int wv_) {
    const int tid = opaque_tid(), lane = tid & 63, wave = tid >> 6, c16 = lane & 15, q = lane >> 4;
    const bf16_t* UG = (const bf16_t*)(p->ws + WS_PROJ) + (size_t)2 * M * 1024; const bf16_t* VG = UG + (size_t)M * 1024;
    const float* ssqv = (const float*)(p->ws + WS_SSQV); bf16_t* ymix = (bf16_t*)(p->ws + WS_YMIX);
    float* RS = (float*)(lds + SGU_RS); float* SS = (float*)(lds + SGU_SS);
    bf16x8_t wa[8][4]; float gvv[8]; int gcur = -1;
    const int oct = tid & 15;
    for (int it = bid; it < NB * 16 * 8; it += nb) {
        const int g = it & 7; const size_t base = (size_t)(it >> 3) * 128;
        if (g != gcur) { gcur = g;
#pragma unroll
            for (int mt = 0; mt < 8; ++mt)
#pragma unroll
                for (int ks = 0; ks < 4; ++ks) if (ks <= ((16 * mt + 15) >> 5))
                    wa[mt][ks] = *(const bf16x8_t*)((const bf16_t*)(p->ws + WS_WSPB) + ((size_t)(g * 128 + mt * 16 + c16) * 128 + ks * 32 + 8 * q));
#pragma unroll
            for (int e = 0; e < 8; ++e) gvv[e] = p->in[I_GV][g * 128 + oct * 8 + e]; }
        uint4 vch[4], uch[4];
#pragma unroll
        for (int k = 0; k < 4; ++k) { const int row = (tid >> 4) + 32 * k; vch[k] = *(const uint4*)(VG + (base + row) * 1024 + g * 128 + oct * 8); uch[k] = *(const uint4*)(UG + (base + row) * 1024 + g * 128 + oct * 8); }
        if (tid < 128) { float ss = 0.f;
#pragma unroll
            for (int k = 0; k < 16; ++k) ss += ssqv[(base + tid) * 16 + k];
            RS[tid] = rsqrtf(ss * (1.f / 1024.f) + EPS); }
        __syncthreads();
#pragma unroll
        for (int k = 0; k < 4; ++k) { const int row = (tid >> 4) + 32 * k; const float r = RS[row]; const unsigned ww[4] = {vch[k].x, vch[k].y, vch[k].z, vch[k].w}; unsigned oo[4];
#pragma unroll
            for (int e2 = 0; e2 < 4; ++e2) oo[e2] = pk2(__uint_as_float(ww[e2] << 16) * r * gvv[2 * e2], __uint_as_float(ww[e2] & 0xffff0000u) * r * gvv[2 * e2 + 1]);
            *(uint4*)(lds + SGU_TV + row * XA_STRIDE + oct * 16) = make_uint4(oo[0], oo[1], oo[2], oo[3]); }
        __syncthreads();
        bf16x8_t bfr[4];
        { const int q4 = c16 >> 2, p4 = c16 & 3;
#pragma unroll
          for (int ks = 0; ks < 4; ++ks) {
              const unsigned a1 = SGU_TV + (ks * 32 + 8 * q + q4) * XA_STRIDE + (wave * 16 + 4 * p4) * 2;
              const s16x4_t lo = __builtin_amdgcn_ds_read_tr16_b64_v4i16((LAS s16x4_t*)(lds + a1));
              const s16x4_t hi = __builtin_amdgcn_ds_read_tr16_b64_v4i16((LAS s16x4_t*)(lds + a1 + 4 * XA_STRIDE));
              bfr[ks] = __builtin_shufflevector(lo, hi, 0, 1, 2, 3, 4, 5, 6, 7); } }
        f32x4_t acc[8];
#pragma unroll
        for (int mt = 0; mt < 8; ++mt) { acc[mt] = (f32x4_t){0.f, 0.f, 0.f, 0.f};
#pragma unroll
            for (int ks = 0; ks < 4; ++ks) if (ks <= ((16 * mt + 15) >> 5)) acc[mt] = __builtin_amdgcn_mfma_f32_16x16x32_bf16(wa[mt][ks], bfr[ks], acc[mt], 0, 0, 0); }
#pragma unroll
        for (int mt = 0; mt < 8; ++mt)
#pragma unroll
            for (int reg = 0; reg < 4; ++reg) { const int i = mt * 16 + 4 * q + reg; SS[i * SS_STRIDE + wave * 16 + c16] = acc[mt][reg] + p->in[I_BSP][g * 128 + i]; }
        __syncthreads();
#pragma unroll
        for (int k = 0; k < 4; ++k) { const int row = (tid >> 4) + 32 * k; const float4 s0 = *(const float4*)(SS + row * SS_STRIDE + oct * 8), s1 = *(const float4*)(SS + row * SS_STRIDE + oct * 8 + 4);
            const unsigned ww[4] = {uch[k].x, uch[k].y, uch[k].z, uch[k].w}; const float sv[8] = {s0.x, s0.y, s0.z, s0.w, s1.x, s1.y, s1.z, s1.w}; unsigned oo[4];
#pragma unroll
            for (int e2 = 0; e2 < 2; ++e2) oo[e2] = pk4_fp8(__uint_as_float(ww[2 * e2] << 16) * sv[4 * e2] * YMIX_SCALE, __uint_as_float(ww[2 * e2] & 0xffff0000u) * sv[4 * e2 + 1] * YMIX_SCALE,
                                                          __uint_as_float(ww[2 * e2 + 1] << 16) * sv[4 * e2 + 2] * YMIX_SCALE, __uint_as_float(ww[2 * e2 + 1] & 0xffff0000u) * sv[4 * e2 + 3] * YMIX_SCALE);
            *(uint2*)((unsigned char*)ymix + (base + row) * D + 1024 + g * 128 + oct * 8) = make_uint2(oo[0], oo[1]); }
        __syncthreads();
    }
}

typedef float f32x16_t __attribute__((ext_vector_type(16)));
__device__ __forceinline__ float vmaxf(float a, float b) { float r; asm("v_max_f32 %0, %1, %2" : "=v"(r) : "v"(a), "v"(b)); return r; }
__device__ __forceinline__ float vminf(float a, float b) { float r; asm("v_min_f32 %0, %1, %2" : "=v"(r) : "v"(a), "v"(b)); return r; }
#define CE_DESC(a, b) do { const float _mx = vmaxf(a, b), _mn = vminf(a, b); a = _mx; b = _mn; } while (0)
__device__ __forceinline__ void sort16_desc(float (&v)[16]) {
#pragma unroll
    for (int k = 2; k <= 16; k <<= 1)
#pragma unroll
        for (int j = k >> 1; j > 0; j >>= 1)
#pragma unroll
            for (int i = 0; i < 16; ++i) { const int l = i ^ j; if (l > i) { if ((i & k) == 0) CE_DESC(v[i], v[l]); else CE_DESC(v[l], v[i]); } }
}
__device__ __forceinline__ void merge16_desc(float (&a)[16], const float (&b)[16]) {
#pragma unroll
    for (int i = 0; i < 16; ++i) a[i] = vmaxf(a[i], b[15 - i]);
#pragma unroll
    for (int j = 8; j > 0; j >>= 1)
#pragma unroll
        for (int i = 0; i < 16; ++i) { const int l = i ^ j; if (l > i) CE_DESC(a[i], a[l]); }
}
__device__ __forceinline__ void topk_half(const bf16_t* qp, const unsigned char* kl, unsigned hh4, float (&X)[16]) {
    f32x16_t acc[4];
#pragma unroll
    for (int kt = 0; kt < 4; ++kt)
#pragma unroll
        for (int i = 0; i < 16; ++i) acc[kt][i] = 0.f;
#pragma unroll 4
    for (int ks = 0; ks < 8; ++ks) {
        const bf16x8_t bq = *(const bf16x8_t*)(qp + ks * 16);
#pragma unroll
        for (int kt = 0; kt < 4; ++kt) { const bf16x8_t ak = *(const bf16x8_t*)(kl + kt * 32 * XA_STRIDE + ks * 32); acc[kt] = __builtin_amdgcn_mfma_f32_32x32x16_bf16(ak, bq, acc[kt], 0, 0, 0); }
    }
    float g[4][16];
#pragma unroll
    for (int kt = 0; kt < 4; ++kt)
#pragma unroll
        for (int reg = 0; reg < 16; ++reg) g[kt][reg] = __uint_as_float(((__float_as_uint(acc[kt][reg]) & 0xFFFFFF80u) | hh4) | (unsigned)(kt * 32 + (reg & 3) + 8 * (reg >> 2)));
    sort16_desc(g[0]); sort16_desc(g[1]); __builtin_amdgcn_sched_barrier(0); merge16_desc(g[0], g[1]); __builtin_amdgcn_sched_barrier(0);
    sort16_desc(g[2]); sort16_desc(g[3]); __builtin_amdgcn_sched_barrier(0); merge16_desc(g[2], g[3]); __builtin_amdgcn_sched_barrier(0); merge16_desc(g[0], g[2]);
#pragma unroll
    for (int i = 0; i < 16; ++i) X[i] = g[0][i];
}
__device__ __forceinline__ unsigned pack_b0(float a, float b, float c, float d) {
    const unsigned ab = __builtin_amdgcn_perm(__float_as_uint(b), __float_as_uint(a), 0x0c0c0400u), cd = __builtin_amdgcn_perm(__float_as_uint(d), __float_as_uint(c), 0x0c0c0400u);
    return __builtin_amdgcn_perm(cd, ab, 0x05040100u);
}
__device__ __forceinline__ unsigned byte_lookup(const unsigned (&pk)[4], unsigned e) {
    const unsigned lo = __builtin_amdgcn_perm(pk[1], pk[0], e & 7u), hi = __builtin_amdgcn_perm(pk[3], pk[2], e & 7u);
    return ((e & 8u) ? hi : lo) & 0x7Fu;
}
__device__ __forceinline__ void phase_topk(KP p, unsigned char* lds, int bid, int nb, int wv_) {
    const int tid = opaque_tid(), lane = tid & 63, wave = tid >> 6, r32 = lane & 31, hh = lane >> 5;
    const bf16_t* Q = (const bf16_t*)(p->ws + WS_Q); const bf16_t* KB = (const bf16_t*)(p->ws + WS_SKEYB);
    int* idx = (int*)(p->ws + WS_IDX); float* gate = (float*)(p->ws + WS_GATE);
    const float NEG = -3.0e38f;
    int hcur = -1;
    for (int bi = bid; bi < NHEAD * (M / 256); bi += nb) {
        const int hd = bi & 7, tile = (bi >> 3) * 8 + wave; const size_t token = (size_t)tile * 32 + r32;
        if (hd != hcur) { hcur = hd; __syncthreads();
#pragma unroll
            for (int k = 0; k < 8; ++k) { const int c = tid + NT * k, row = c >> 4, o = c & 15;
                *(uint4*)(lds + row * XA_STRIDE + o * 16) = *(const uint4*)(KB + ((size_t)hd * 256 + row) * 128 + o * 8); }
            __syncthreads(); }
        float X0[16], X1[16];
        topk_half(Q + token * D + hd * 256 + 8 * hh, lds + r32 * XA_STRIDE + hh * 16, 4u * hh, X0);
        __builtin_amdgcn_sched_barrier(0);
        topk_half(Q + token * D + hd * 256 + 128 + 8 * hh, lds + (128 + r32) * XA_STRIDE + hh * 16, 4u * hh, X1);
        __builtin_amdgcn_sched_barrier(0);
#pragma unroll
        for (int i = 0; i < 16; ++i) { const auto r = __builtin_amdgcn_permlane32_swap(__float_as_uint(X0[i]), __float_as_uint(X1[i]), false, false); X0[i] = __uint_as_float(r[0]); X1[i] = __uint_as_float(r[1]); }
        merge16_desc(X0, X1);
        float U[16];
#pragma unroll
        for (int i = 0; i < 16; ++i) U[i] = __shfl_xor(X0[i], 32);
        const unsigned hbit = (unsigned)hh << 8;
        float c0[16], c1[16];
#pragma unroll
        for (int j = 0; j < 16; ++j) { float s = X0[0] + U[j]; if (j == 0) s = hh ? NEG : s; c0[j] = __uint_as_float(((__float_as_uint(s) & 0xFFFFFE00u) | hbit) | (unsigned)j); }
        {
            int n = 0;
#pragma unroll
            for (int i = 1; i < 4; ++i)
#pragma unroll
                for (int j = i; j < 16; ++j) if ((i + 1) * (j + 1) <= 16) { float s = X0[i] + U[j]; if (j == i) s = hh ? NEG : s; c1[n] = __uint_as_float(((__float_as_uint(s) & 0xFFFFFE00u) | hbit) | (unsigned)(i * 16 + j)); ++n; }
#pragma unroll
            for (int k = 11; k < 16; ++k) c1[k] = NEG;
        }
        sort16_desc(c0); sort16_desc(c1); merge16_desc(c0, c1);
        float F[16];
#pragma unroll
        for (int i = 0; i < 16; ++i) F[i] = vmaxf(c0[i], __shfl_xor(c0[15 - i], 32));
        float mx = F[0];
#pragma unroll
        for (int i = 1; i < 16; ++i) mx = vmaxf(mx, F[i]);
        float ev[16], sum = 0.f;
#pragma unroll
        for (int i = 0; i < 16; ++i) { ev[i] = __expf(F[i] - mx); sum += ev[i]; }
        const float inv = 1.f / sum;
        unsigned pt[4], pu[4], pa[4], pb[4];
#pragma unroll
        for (int w = 0; w < 4; ++w) { pt[w] = pack_b0(X0[4 * w], X0[4 * w + 1], X0[4 * w + 2], X0[4 * w + 3]); pu[w] = pack_b0(U[4 * w], U[4 * w + 1], U[4 * w + 2], U[4 * w + 3]); }
#pragma unroll
        for (int w = 0; w < 4; ++w) { pa[w] = hh ? pu[w] : pt[w]; pb[w] = hh ? pt[w] : pu[w]; }
        int oi[8]; float og[8];
#pragma unroll
        for (int k = 0; k < 8; ++k) {
            const unsigned pl = __float_as_uint(F[k]) & 0x1FFu, sw = pl >> 8, pi = (pl >> 4) & 15u, pj = pl & 15u;
            const unsigned ai = sw ? pj : pi, bj = sw ? pi : pj;
            oi[k] = (int)(byte_lookup(pa, ai) * NKEYS + byte_lookup(pb, bj)); og[k] = ev[k] * inv;
        }
        int* io = idx + token * NSEL + hd * TOPK + 8 * hh; float* go = gate + token * NSEL + hd * TOPK + 8 * hh;
        { typedef __fp16 h2v_ __attribute__((ext_vector_type(2)));
          const h2v_ g0 = __builtin_amdgcn_cvt_pkrtz(og[0], og[1]), g1 = __builtin_amdgcn_cvt_pkrtz(og[2], og[3]), g2 = __builtin_amdgcn_cvt_pkrtz(og[4], og[5]), g3 = __builtin_amdgcn_cvt_pkrtz(og[6], og[7]);
          *(uint4*)((unsigned short*)(p->ws + WS_GATE) + token * NSEL + hd * TOPK + 8 * hh) = make_uint4(__builtin_bit_cast(unsigned, g0), __builtin_bit_cast(unsigned, g1), __builtin_bit_cast(unsigned, g2), __builtin_bit_cast(unsigned, g3)); }
        *(uint4*)((unsigned short*)(p->ws + WS_IDX16) + token * NSEL + hd * TOPK + 8 * hh) = make_uint4((unsigned)oi[0] | ((unsigned)oi[1] << 16), (unsigned)oi[2] | ((unsigned)oi[3] << 16), (unsigned)oi[4] | ((unsigned)oi[5] << 16), (unsigned)oi[6] | ((unsigned)oi[7] << 16));
    }
}

__device__ __forceinline__ void wave_argmax(float& v, int& i) {
#pragma unroll
    for (int off = 32; off >= 1; off >>= 1) { const float ov = __shfl_xor(v, off); const int oi = __shfl_xor(i, off); if (ov > v || (ov == v && oi < i)) { v = ov; i = oi; } }
}
__device__ __forceinline__ void topk_half_naive(const bf16_t* q, const float* k0, int lane, float& outv, int& outi) {
    const float NEG = -3.0e38f;
    const float* k1 = k0 + 64 * 128;
    float s0 = 0.f, s1 = 0.f;
    for (int k = 0; k < 128; k += 4) {
        const uint2 qq = *(const uint2*)(q + k);
        const float q0 = bf2f((bf16_t)(qq.x & 0xffff)), q1 = bf2f((bf16_t)(qq.x >> 16)), q2 = bf2f((bf16_t)(qq.y & 0xffff)), q3 = bf2f((bf16_t)(qq.y >> 16));
        const float4 a = *(const float4*)(k0 + k), b = *(const float4*)(k1 + k);
        s0 += q0 * a.x + q1 * a.y + q2 * a.z + q3 * a.w; s1 += q0 * b.x + q1 * b.y + q2 * b.z + q3 * b.w;
    }
    float myv = NEG; int myi = 0;
    for (int r = 0; r < TOPK; ++r) {
        float v; int i; if (s0 >= s1) { v = s0; i = lane; } else { v = s1; i = lane + 64; }
        wave_argmax(v, i);
        if (i == lane) s0 = NEG; if (i == lane + 64) s1 = NEG;
        if (lane == r) { myv = v; myi = i; }
    }
    outv = myv; outi = myi;
}
__device__ __forceinline__ void phase_topk_naive(KP p, int bid, int nb, int wv_) {
    const bf16_t* Q = (const bf16_t*)(p->ws + WS_Q); const float* keys = p->in[I_SKEY];
    int* idx = (int*)(p->ws + WS_IDX); float* gate = (float*)(p->ws + WS_GATE);
    const int tid = opaque_tid(), lane = tid & 63, wave = tid >> 6;
    const float NEG = -3.0e38f;
    for (int task = bid * 8 + wave; task < M * NHEAD; task += nb * 8) {
        const int token = task >> 3, hd = task & 7;
        float tv0, tv1; int ti0, ti1;
        topk_half_naive(Q + (size_t)token * D + hd * 256, keys + ((size_t)(hd * 2) * 128 + lane) * 128, lane, tv0, ti0);
        topk_half_naive(Q + (size_t)token * D + hd * 256 + 128, keys + ((size_t)(hd * 2 + 1) * 128 + lane) * 128, lane, tv1, ti1);
        const float vb = __shfl(tv1, lane & 15);
        float c0 = __shfl(tv0, (lane >> 4)) + vb, c1 = __shfl(tv0, (lane >> 4) + 4) + vb, c2 = __shfl(tv0, (lane >> 4) + 8) + vb, c3 = __shfl(tv0, (lane >> 4) + 12) + vb;
        float selv = NEG; int selc = 0;
        for (int r = 0; r < TOPK; ++r) {
            float v = c0; int i = lane;
            if (c1 > v) { v = c1; i = lane + 64; }
            if (c2 > v) { v = c2; i = lane + 128; }
            if (c3 > v) { v = c3; i = lane + 192; }
            wave_argmax(v, i);
            if (i == lane) c0 = NEG; if (i == lane + 64) c1 = NEG; if (i == lane + 128) c2 = NEG; if (i == lane + 192) c3 = NEG;
            if (lane == r) { selv = v; selc = i; }
        }
        const float mx = __shfl(selv, 0);
        const float e = lane < TOPK ? __expf(selv - mx) : 0.f;
        const float sum = wave_sum(e);
        const int i1 = __shfl(ti0, selc >> 4), i2 = __shfl(ti1, selc & 15);
        if (lane < TOPK) { idx[(size_t)token * NSEL + hd * TOPK + lane] = i1 * NKEYS + i2; gate[(size_t)token * NSEL + hd * TOPK + lane] = e / sum; }
    }
}

typedef float f32x2_t __attribute__((ext_vector_type(2)));
constexpr size_t GRP_BYTES = (size_t)NKEYS * NKEYS * 128;
constexpr int NGRP = D / 128;
constexpr size_t VSL_BYTES = (size_t)NKEYS * NKEYS * 8;
constexpr int NVSL = D / 8;
__device__ __forceinline__ void phase_convert_experts(KP p, int bid, int nb, int wv_) {
    const int tid = opaque_tid(), lane = tid & 63, wave = tid >> 6;
    constexpr int PITCH = D + 16;
    LAS unsigned char* tile = dyn_lds_base();
    __syncthreads();
    for (int rb = bid; rb < 2 * NKEYS * NKEYS / 16; rb += nb) {
        const int t = rb * 16 >= NKEYS * NKEYS;
#pragma unroll 1
        for (int i2 = 0; i2 < 2; ++i2) {
            const int r16 = wave * 2 + i2, row = rb * 16 + r16, e = row - t * NKEYS * NKEYS;
            const float* src = (t ? p->in[I_EV] : p->in[I_EU]) + (size_t)e * D;
            float4 v[8]; float am = 0.f;
#pragma unroll
            for (int j = 0; j < 8; ++j) { v[j] = *(const float4*)(src + lane * 4 + 256 * j); am = fmaxf(am, fmaxf(fmaxf(fabsf(v[j].x), fabsf(v[j].y)), fmaxf(fabsf(v[j].z), fabsf(v[j].w)))); }
            am = wave_max(am);
            const float sc = am > 0.f ? 127.f / am : 0.f;
            if (!t) {
                unsigned char* dst = p->ws + WS_EU8 + (size_t)e * 128 + (size_t)(lane >> 5) * GRP_BYTES + (lane & 31) * 4;
#pragma unroll
                for (int j = 0; j < 8; ++j) *(unsigned*)(dst + (size_t)(2 * j) * GRP_BYTES) = pk4_i8(v[j].x * sc, v[j].y * sc, v[j].z * sc, v[j].w * sc);
            } else {
#pragma unroll
                for (int j = 0; j < 8; ++j) *(LAS unsigned*)(tile + r16 * PITCH + lane * 4 + 256 * j) = pk4_i8(v[j].x * sc, v[j].y * sc, v[j].z * sc, v[j].w * sc);
            }
            if (lane == 0) ((float*)(p->ws + WS_ESCALE))[row] = am * (1.f / 127.f);
        }
        if (t) {
            __syncthreads();
            const int e0 = rb * 16 - NKEYS * NKEYS, pc = tid & 7;
#pragma unroll
            for (int rd = 0; rd < 4; ++rd) { const int slc = rd * 64 + (tid >> 3);
                const v2u_t lo = *(LAS const v2u_t*)(tile + (2 * pc) * PITCH + slc * 8), hi = *(LAS const v2u_t*)(tile + (2 * pc + 1) * PITCH + slc * 8);
                *(uint4*)(p->ws + WS_EV8 + (size_t)slc * VSL_BYTES + (size_t)(e0 + 2 * pc) * 8) = make_uint4(lo[0], lo[1], hi[0], hi[1]); }
            __syncthreads();
        }
    }
}
__device__ __forceinline__ unsigned xb_xcc_id();
constexpr int PEER_TT = 16;
constexpr int PEER_NTILE = M / PEER_TT;
constexpr int CW_UQ = 4096, CW_VQ = 8192;
__device__ __forceinline__ float dpp_xor1(float v) { return __builtin_bit_cast(float, __builtin_amdgcn_update_dpp(0, __builtin_bit_cast(int, v), 0xB1, 0xF, 0xF, true)); }
__device__ __forceinline__ float dpp_xor2(float v) { return __builtin_bit_cast(float, __builtin_amdgcn_update_dpp(0, __builtin_bit_cast(int, v), 0x4E, 0xF, 0xF, true)); }
__device__ __forceinline__ float dpp_hmirror(float v) { return __builtin_bit_cast(float, __builtin_amdgcn_update_dpp(0, __builtin_bit_cast(int, v), 0x141, 0xF, 0xF, true)); }
__device__ __forceinline__ void pg_load_ids(const unsigned short* idx16, size_t token, int k, unsigned c16, unsigned (&off)[16]) {
#pragma unroll
    for (int i = 0; i < 2; ++i) { const uint4 v = *(const uint4*)(idx16 + token * NSEL + 16 * k + 8 * i); const unsigned w[4] = {v.x, v.y, v.z, v.w};
#pragma unroll
        for (int j = 0; j < 4; ++j) { off[8 * i + 2 * j] = ((w[j] & 0xffffu) << 7) + c16; off[8 * i + 2 * j + 1] = ((w[j] >> 16) << 7) + c16; } }
}
__device__ __forceinline__ void pg_load_lines(const unsigned char* tg, const unsigned (&off)[16], uint4 (&r)[16]) {
#pragma unroll
    for (int j = 0; j < 16; ++j) r[j] = *(const uint4*)(tg + off[j]);
}
typedef _Float16 h2_t __attribute__((ext_vector_type(2)));
__device__ __forceinline__ int dppi(int v, int ctrl_sel) { return ctrl_sel == 0 ? __builtin_amdgcn_update_dpp(0, v, 0xB1, 0xF, 0xF, true) : ctrl_sel == 1 ? __builtin_amdgcn_update_dpp(0, v, 0x4E, 0xF, 0xF, true) : __builtin_amdgcn_update_dpp(0, v, 0x141, 0xF, 0xF, true); }
__device__ __forceinline__ int dot4_0(int a, int b) { int d; asm("v_dot4_i32_i8 %0, %1, %2, 0" : "=v"(d) : "v"(a), "v"(b)); return d; }
__device__ __forceinline__ void pg_compute_u(const uint4 (&r)[16], const uint4 (&hw)[2], short* po, int c) {
    int d[16];
#pragma unroll
    for (int j = 0; j < 16; ++j) { int s = 0; s = __builtin_amdgcn_sdot4((int)r[j].x, (int)hw[0].x, s, false); s = __builtin_amdgcn_sdot4((int)r[j].y, (int)hw[0].y, s, false); s = __builtin_amdgcn_sdot4((int)r[j].z, (int)hw[0].z, s, false); s = __builtin_amdgcn_sdot4((int)r[j].w, (int)hw[0].w, s, false); d[j] = s; }
#pragma unroll
    for (int j = 0; j < 16; ++j) d[j] += dppi(d[j], 0);
#pragma unroll
    for (int j = 0; j < 16; ++j) d[j] += dppi(d[j], 1);
#pragma unroll
    for (int j = 0; j < 16; ++j) d[j] += dppi(d[j], 2);
    int p0 = 0, p1 = 0;
#pragma unroll
    for (int j = 0; j < 8; ++j) { p0 = (c == j) ? d[2 * j] : p0; p1 = (c == j) ? d[2 * j + 1] : p1; }
    *(unsigned*)po = ((unsigned)((p0 + 32) >> 6) & 0xffffu) | ((unsigned)((p1 + 32) >> 6) << 16);
}
__device__ __forceinline__ void pg_compute_v(const uint4 (&r)[16], const f32x4_t (&aw)[4], const float* xo, unsigned* yo, const float* gtp, float* ssp, float asc, int k, int lane) {
    int acc[16];
#pragma unroll
    for (int m = 0; m < 16; ++m) acc[m] = 0;
    const uint4 a16 = __builtin_bit_cast(uint4, aw[0]); const unsigned aa[4] = {a16.x, a16.y, a16.z, a16.w};
#pragma unroll
    for (int jq = 0; jq < 4; ++jq) {
        const unsigned rr[4][4] = {{r[4 * jq].x, r[4 * jq].y, r[4 * jq].z, r[4 * jq].w}, {r[4 * jq + 1].x, r[4 * jq + 1].y, r[4 * jq + 1].z, r[4 * jq + 1].w},
                                   {r[4 * jq + 2].x, r[4 * jq + 2].y, r[4 * jq + 2].z, r[4 * jq + 2].w}, {r[4 * jq + 3].x, r[4 * jq + 3].y, r[4 * jq + 3].z, r[4 * jq + 3].w}};
#pragma unroll
        for (int cc = 0; cc < 4; ++cc) {
            const unsigned t0 = __builtin_amdgcn_perm(rr[1][cc], rr[0][cc], 0x05010400u), t1 = __builtin_amdgcn_perm(rr[1][cc], rr[0][cc], 0x07030602u);
            const unsigned t2 = __builtin_amdgcn_perm(rr[3][cc], rr[2][cc], 0x05010400u), t3 = __builtin_amdgcn_perm(rr[3][cc], rr[2][cc], 0x07030602u);
            acc[4 * cc + 0] = __builtin_amdgcn_sdot4((int)__builtin_amdgcn_perm(t2, t0, 0x05040100u), (int)aa[jq], acc[4 * cc + 0], false);
            acc[4 * cc + 1] = __builtin_amdgcn_sdot4((int)__builtin_amdgcn_perm(t2, t0, 0x07060302u), (int)aa[jq], acc[4 * cc + 1], false);
            acc[4 * cc + 2] = __builtin_amdgcn_sdot4((int)__builtin_amdgcn_perm(t3, t1, 0x05040100u), (int)aa[jq], acc[4 * cc + 2], false);
            acc[4 * cc + 3] = __builtin_amdgcn_sdot4((int)__builtin_amdgcn_perm(t3, t1, 0x07060302u), (int)aa[jq], acc[4 * cc + 3], false);
        }
    }
    int b8[8];
#pragma unroll
    for (int m = 0; m < 8; ++m) { const int u = acc[m] + __builtin_amdgcn_update_dpp(0, acc[m], 0x128, 0xF, 0xF, true), w = acc[8 + m] + __builtin_amdgcn_update_dpp(0, acc[8 + m], 0x128, 0xF, 0xF, true); b8[m] = (k & 1) ? w : u; }
    int b4[4];
#pragma unroll
    for (int m = 0; m < 4; ++m) { const auto r = __builtin_amdgcn_permlane16_swap((unsigned)b8[m], (unsigned)b8[4 + m], false, false); b4[m] = (int)(r[0] + r[1]); }
    int o2[2];
#pragma unroll
    for (int m = 0; m < 2; ++m) { const auto r = __builtin_amdgcn_permlane32_swap((unsigned)b4[m], (unsigned)b4[2 + m], false, false); o2[m] = (int)(r[0] + r[1]); }
    const float2 gt = *(const float2*)gtp;
    const float y0 = aw[1][1] + gt.x * ((float)o2[0] * asc), y1 = aw[1][2] + gt.y * ((float)o2[1] * asc);
    *yo = pk2(y0, y1);
    float ss = y0 * y0 + y1 * y1;
    ss += dpp_xor1(ss); ss += dpp_xor2(ss); ss += dpp_hmirror(ss);
    ss += __builtin_bit_cast(float, __builtin_amdgcn_update_dpp(0, __builtin_bit_cast(int, ss), 0x140, 0xF, 0xF, true));
    { const auto r = __builtin_amdgcn_permlane16_swap(__float_as_uint(ss), __float_as_uint(ss), false, false); ss = __uint_as_float(r[0]) + __uint_as_float(r[1]); }
    { const auto r = __builtin_amdgcn_permlane32_swap(__float_as_uint(ss), __float_as_uint(ss), false, false); ss = __uint_as_float(r[0]) + __uint_as_float(r[1]); }
    if (lane == 0) *ssp = ss;
}
template <bool VPASS>
__device__ __forceinline__ void phase_peer_gather(KP p, float* lds, int bid, int nb, int wv_) {
    const int tid = opaque_tid(), lane = tid & 63, k = lane >> 3, c = lane & 7;
    const unsigned char* H8 = p->ws + WS_H8I; const unsigned short* idx = (const unsigned short*)(p->ws + WS_IDX16); const float* ascp = (const float*)(p->ws + WS_ASC);
    const unsigned char* TAB = p->ws + (VPASS ? WS_EV8 : WS_EU8);
    int* pdot = (int*)(p->ws + WS_PDOT); const unsigned char* act = p->ws + WS_ACT; float* ssq2 = (float*)(p->ws + WS_SSQ2);
    unsigned* ctr = (unsigned*)(p->ws + WS_CTL) + (VPASS ? CW_VQ : CW_UQ);
    if (VPASS) { for (int i = tid; i < NB * D; i += NT) lds[i] = mod_at(p, i >> 11, 5 * D + (i & (D - 1))); __syncthreads(); }
    const unsigned slot0 = xb_xcc_id() & 7u, c16 = 16u * (unsigned)c;
    const int vcol = 16 * c + 8 * (k & 1) + 4 * ((k >> 1) & 1) + 2 * (k >> 2);
    for (int sl = 0; sl < 8; ++sl) {
        const int slot = (int)((slot0 + sl) & 7u);
        for (;;) {
            unsigned q = 0; if (lane == 0) q = __hip_atomic_fetch_add(ctr + 64 * slot, 1u, __ATOMIC_RELAXED, __HIP_MEMORY_SCOPE_AGENT);
            q = (unsigned)__builtin_amdgcn_readfirstlane((int)q);
            if (q >= 2u * PEER_NTILE) break;
            const int g = slot * 2 + (int)(q / PEER_NTILE), tile = (int)(q % PEER_NTILE);
            const unsigned char* tg = TAB + (size_t)g * GRP_BYTES;
            const size_t tok0 = (size_t)tile * PEER_TT;
            unsigned oA[16], oB[16]; uint4 rA[16], rB[16]; uint4 hA[2], hB[2]; f32x4_t aA[4], aB[4];
#define PG_AUX(tok, hX, aX) do { if (!VPASS) { hX[0] = *(const uint4*)(H8 + (tok) * D + g * 128 + 16 * c); } \
            else { aX[0] = *(const f32x4_t*)(act + (tok) * NSEL + 16 * k); aX[1][0] = ascp[(tok)]; const float2 x1_ = *(const float2*)(p->out + (tok) * D + g * 128 + vcol); aX[1][1] = x1_.x; aX[1][2] = x1_.y; } } while (0)
#define PG_COMPUTE(tok, rX, hX, aX) do { if (!VPASS) pg_compute_u(rX, hX, (short*)pdot + ((size_t)g * M + (tok)) * NSEL + 16 * k + 2 * c, c); \
            else pg_compute_v(rX, aX, p->out + (tok) * D + g * 128 + vcol, (unsigned*)(p->ws + WS_Y16) + ((tok) * D + g * 128 + vcol) / 2, lds + ((tok) / SEQ) * D + g * 128 + vcol, ssq2 + (size_t)g * M + (tok), aX[1][0], k, lane); } while (0)
            pg_load_ids(idx, tok0, k, c16, oA); pg_load_lines(tg, oA, rA); PG_AUX(tok0, hA, aA); pg_load_ids(idx, tok0 + 1, k, c16, oB);
            for (int tt = 0; tt < PEER_TT; tt += 2) {
                pg_load_lines(tg, oB, rB); PG_AUX(tok0 + tt + 1, hB, aB);
                if (tt + 2 < PEER_TT) pg_load_ids(idx, tok0 + tt + 2, k, c16, oA);
                PG_COMPUTE(tok0 + tt, rA, hA, aA);
                if (tt + 2 < PEER_TT) { pg_load_lines(tg, oA, rA); PG_AUX(tok0 + tt + 2, hA, aA); pg_load_ids(idx, tok0 + tt + 3, k, c16, oB); }
                PG_COMPUTE(tok0 + tt + 1, rB, hB, aB);
            }
#undef PG_AUX
#undef PG_COMPUTE
        }
    }
}
__device__ __forceinline__ unsigned u4c(const uint4& v, int i) { return i == 0 ? v.x : i == 1 ? v.y : i == 2 ? v.z : v.w; }
__device__ __forceinline__ void phase_peer_v(KP p, unsigned char* lds, int bid, int nb, int wv_) {
    const int tid = opaque_tid(), lane = tid & 63, wave = tid >> 6;
    const unsigned char* actt = p->ws + WS_ACT; const unsigned char* idxt = p->ws + WS_IDXT; const float* ascp = (const float*)(p->ws + WS_ASC);
    float* gtl = (float*)(lds + VSL_BYTES);
    const unsigned lbase = (unsigned)(size_t)(LAS unsigned char*)lds;
    for (int si = bid; si < NVSL; si += nb) {
        const int sl = ((si & 7) << 5) | (si >> 3);
        __syncthreads();
        { const unsigned char* src = p->ws + WS_EV8 + (size_t)sl * VSL_BYTES;
#pragma unroll 4
          for (int i = 0; i < (int)(VSL_BYTES / 16 / NT); ++i) *(uint4*)(lds + ((size_t)i * NT + tid) * 16) = *(const uint4*)(src + ((size_t)i * NT + tid) * 16);
          if (tid < 64) gtl[tid] = ((const float*)(p->ws + WS_MODS))[(size_t)(tid >> 3) * NMOD + 5 * D + sl * 8 + (tid & 7)]; }
        __syncthreads();
        uint4 W0[3], W1[3], AA[3];
#define PV_LOADCH(slot, btx, cx) do { W0[slot] = *(const uint4*)(idxt + (((size_t)(btx) * 16 + 2 * (cx)) * 64 + lane) * 16); W1[slot] = *(const uint4*)(idxt + (((size_t)(btx) * 16 + 2 * (cx) + 1) * 64 + lane) * 16); \
                                       AA[slot] = *(const uint4*)(actt + (((size_t)(btx) * 8 + (cx)) * 64 + lane) * 16); } while (0)
#define PV_ISSUE(g) do { const int sl_ = ((g) >> 2) % 3, q_ = (g) & 3; const unsigned wa_ = u4c(q_ < 2 ? W0[sl_] : W1[sl_], 2 * (q_ & 1)), wb_ = u4c(q_ < 2 ? W0[sl_] : W1[sl_], 2 * (q_ & 1) + 1); unsigned o0_, o1_, o2_, o3_; \
            asm("v_mad_u32_u16 %0, %1, 8, %2 op_sel:[0,0,0,0]" : "=v"(o0_) : "v"(wa_), "v"(lbase)); asm("v_mad_u32_u16 %0, %1, 8, %2 op_sel:[1,0,0,0]" : "=v"(o1_) : "v"(wa_), "v"(lbase)); \
            asm("v_mad_u32_u16 %0, %1, 8, %2 op_sel:[0,0,0,0]" : "=v"(o2_) : "v"(wb_), "v"(lbase)); asm("v_mad_u32_u16 %0, %1, 8, %2 op_sel:[1,0,0,0]" : "=v"(o3_) : "v"(wb_), "v"(lbase)); \
            VB[(g) % 3][0] = *(LAS const v2u_t*)(size_t)o0_; VB[(g) % 3][1] = *(LAS const v2u_t*)(size_t)o1_; VB[(g) % 3][2] = *(LAS const v2u_t*)(size_t)o2_; VB[(g) % 3][3] = *(LAS const v2u_t*)(size_t)o3_; } while (0)
        PV_LOADCH(0, wave, 0); PV_LOADCH(1, wave, 1);
        for (int bt = wave; bt < M / 64; bt += NT / 64) {
            const size_t token = (size_t)bt * 64 + lane;
            const int btn = bt + NT / 64 < M / 64 ? bt + NT / 64 : bt;
            const uint4 xw = *(const uint4*)((const bf16_t*)(p->ws + WS_X1B) + token * D + sl * 8);
            const float4 xa = make_float4(__uint_as_float(xw.x << 16), __uint_as_float(xw.x & 0xffff0000u), __uint_as_float(xw.y << 16), __uint_as_float(xw.y & 0xffff0000u)), xb = make_float4(__uint_as_float(xw.z << 16), __uint_as_float(xw.z & 0xffff0000u), __uint_as_float(xw.w << 16), __uint_as_float(xw.w & 0xffff0000u));
            const float asc = ascp[token];
            int acc[8];
            v2u_t VB[3][4];
            PV_ISSUE(0); PV_ISSUE(1);
#pragma unroll
            for (int g = 0; g < 32; ++g) {
                if ((g & 3) == 0) { const int c = g >> 2; if (c + 2 < 8) PV_LOADCH((c + 2) % 3, bt, c + 2); else PV_LOADCH((c + 2) % 3, btn, c + 2 - 8); }
                if (g + 2 < 32) PV_ISSUE(g + 2);
                __builtin_amdgcn_sched_barrier(0);
                const unsigned a4 = u4c(AA[(g >> 2) % 3], g & 3);
#pragma unroll
                for (int d = 0; d < 2; ++d) {
                    const unsigned r0 = VB[g % 3][0][d], r1 = VB[g % 3][1][d], r2 = VB[g % 3][2][d], r3 = VB[g % 3][3][d];
                    const unsigned t0 = __builtin_amdgcn_perm(r1, r0, 0x05010400u), t1 = __builtin_amdgcn_perm(r1, r0, 0x07030602u), t2 = __builtin_amdgcn_perm(r3, r2, 0x05010400u), t3 = __builtin_amdgcn_perm(r3, r2, 0x07030602u);
                    const int c0 = (int)__builtin_amdgcn_perm(t2, t0, 0x05040100u), c1 = (int)__builtin_amdgcn_perm(t2, t0, 0x07060302u), c2 = (int)__builtin_amdgcn_perm(t3, t1, 0x05040100u), c3 = (int)__builtin_amdgcn_perm(t3, t1, 0x07060302u);
                    if (g == 0) { acc[4 * d] = dot4_0(c0, (int)a4); acc[4 * d + 1] = dot4_0(c1, (int)a4); acc[4 * d + 2] = dot4_0(c2, (int)a4); acc[4 * d + 3] = dot4_0(c3, (int)a4); }
                    else { acc[4 * d] = __builtin_amdgcn_sdot4(c0, (int)a4, acc[4 * d], false); acc[4 * d + 1] = __builtin_amdgcn_sdot4(c1, (int)a4, acc[4 * d + 1], false);
                           acc[4 * d + 2] = __builtin_amdgcn_sdot4(c2, (int)a4, acc[4 * d + 2], false); acc[4 * d + 3] = __builtin_amdgcn_sdot4(c3, (int)a4, acc[4 * d + 3], false); }
                }
                __builtin_amdgcn_sched_barrier(0);
            }
            { const uint4 t0_ = W0[0], t1_ = W1[0], t2_ = AA[0]; W0[0] = W0[2]; W1[0] = W1[2]; AA[0] = AA[2]; W0[1] = t0_; W1[1] = t1_; AA[1] = t2_; }
            const float* gt = gtl + (bt >> 5) * 8;
            const float y0 = xa.x + gt[0] * ((float)acc[0] * asc), y1 = xa.y + gt[1] * ((float)acc[1] * asc), y2 = xa.z + gt[2] * ((float)acc[2] * asc), y3 = xa.w + gt[3] * ((float)acc[3] * asc);
            const float y4 = xb.x + gt[4] * ((float)acc[4] * asc), y5 = xb.y + gt[5] * ((float)acc[5] * asc), y6 = xb.z + gt[6] * ((float)acc[6] * asc), y7 = xb.w + gt[7] * ((float)acc[7] * asc);
            *(uint4*)((bf16_t*)(p->ws + WS_Y16) + ((size_t)sl * M + token) * 8) = make_uint4(pk2(y0, y1), pk2(y2, y3), pk2(y4, y5), pk2(y6, y7));
            ((float*)(p->ws + WS_SSQP))[(size_t)sl * M + token] = ((y0 * y0 + y1 * y1) + (y2 * y2 + y3 * y3)) + ((y4 * y4 + y5 * y5) + (y6 * y6 + y7 * y7));
        }
    }
}
#undef PV_LOADCH
#undef PV_ISSUE
__device__ __forceinline__ void phase_peer_act(KP p, int bid, int nb, int wv_) {
    const int tid = opaque_tid(), lane = tid & 63, wave = tid >> 6;
    const int* idx = (const int*)(p->ws + WS_IDX); const float* gate = (const float*)(p->ws + WS_GATE); const float* esc = (const float*)(p->ws + WS_ESCALE);
    const unsigned* pdot = (const unsigned*)(p->ws + WS_PDOT); unsigned char* act = p->ws + WS_ACT;
    for (int token = bid * 8 + wave; token < M; token += nb * 8) {
        int d0 = 0, d1 = 0;
#pragma unroll
        for (int g = 0; g < NGRP; ++g) { const unsigned w = pdot[((size_t)g * M + token) * (NSEL / 2) + lane]; d0 += (int)(short)(w & 0xffffu); d1 += (int)w >> 16; }
        const unsigned ew = ((const unsigned*)(p->ws + WS_IDX16))[(size_t)token * (NSEL / 2) + lane], gw = ((const unsigned*)(p->ws + WS_GATE))[(size_t)token * (NSEL / 2) + lane];
        typedef __fp16 h2v_ __attribute__((ext_vector_type(2))); const h2v_ gh = __builtin_bit_cast(h2v_, gw);
        const int2 e = make_int2((int)(ew & 0xffffu), (int)(ew >> 16)); const float2 gt2 = make_float2((float)gh[0], (float)gh[1]);
        const float hs = ((const float*)(p->ws + WS_HSC))[token] * 64.f;
        const float a0 = gelu_t((float)d0 * (esc[e.x] * hs)) * gt2.x * esc[NKEYS * NKEYS + e.x];
        const float a1 = gelu_t((float)d1 * (esc[e.y] * hs)) * gt2.y * esc[NKEYS * NKEYS + e.y];
        const float am = wave_max(fmaxf(fabsf(a0), fabsf(a1))); const float sc = am > 0.f ? 127.f / am : 0.f;
        { const size_t bt = (size_t)(token >> 6), tl = (size_t)(token & 63);
          *(unsigned short*)(act + ((bt * 8 + (lane >> 3)) * 64 + tl) * 16 + (2 * lane & 15)) = (unsigned short)(((unsigned)__float2int_rn(a0 * sc) & 0xffu) | (((unsigned)__float2int_rn(a1 * sc) & 0xffu) << 8));
          *(unsigned*)((unsigned short*)(p->ws + WS_IDXT) + ((bt * 16 + (lane >> 2)) * 64 + tl) * 8 + (2 * lane & 7)) = (unsigned)e.x | ((unsigned)e.y << 16); }
        if (lane == 0) ((float*)(p->ws + WS_ASC))[token] = am * (1.f / 127.f);
    }
}
__device__ __forceinline__ void phase_final_norm(KP p, int bid, int nb, int wv_) {
    const int tid = opaque_tid();
    const float* gf = p->in[I_GFIN]; const float* ssqp = (const float*)(p->ws + WS_SSQP); const bf16_t* y16 = (const bf16_t*)(p->ws + WS_Y16);
    constexpr int PITCH = 2 * D + 16;
    LAS unsigned char* img = dyn_lds_base(); LAS float* part = (LAS float*)(img + 32 * PITCH);
    const float4 g4 = *(const float4*)(gf + 4 * tid);
    for (int item = bid; item < M / 32; item += nb) {
        const size_t tok0 = (size_t)item * 32; const int tk = tid & 31;
        __syncthreads();
        float ss = 0.f;
#pragma unroll
        for (int k = 0; k < 16; ++k) { const int sc = (k * NT + tid) >> 5;
            const uint4 w = *(const uint4*)(y16 + ((size_t)sc * M + tok0 + tk) * 8); *(LAS v4i_t*)(img + tk * PITCH + sc * 16) = __builtin_bit_cast(v4i_t, w);
            ss += ssqp[(size_t)sc * M + tok0 + tk]; }
        part[tid] = ss;
        __syncthreads();
#pragma unroll 8
        for (int r = 0; r < 32; ++r) {
            float s2 = 0.f;
#pragma unroll
            for (int j = 0; j < 16; ++j) s2 += part[r + 32 * j];
            const float rstd = rsqrtf(s2 * (1.f / D) + EPS);
            const v2u_t w = *(LAS const v2u_t*)(img + r * PITCH + tid * 8);
            *(float4*)(p->out + (tok0 + r) * D + 4 * tid) = make_float4(__uint_as_float(w[0] << 16) * rstd * g4.x, __uint_as_float(w[0] & 0xffff0000u) * rstd * g4.y, __uint_as_float(w[1] << 16) * rstd * g4.z, __uint_as_float(w[1] & 0xffff0000u) * rstd * g4.w);
        }
    }
}

#define XB_TMO      128
#define XB_XCNT(j)  (256  + 64 * (j))
#define XB_XSUB(j)  (1280 + 64 * (j))
#define XB_XGEN(j)  (2304 + 64 * (j))
#define XB_TOP      3328
#define XB_TOPGEN   3392
#define XCD_BAR_WORDS 3456
#define XB_SPIN_CAP (1u << 18)

__device__ __forceinline__ unsigned xb_ld(unsigned* p)              { return __hip_atomic_load(p, __ATOMIC_RELAXED, __HIP_MEMORY_SCOPE_AGENT); }
__device__ __forceinline__ unsigned xb_add(unsigned* p, unsigned v) { return __hip_atomic_fetch_add(p, v, __ATOMIC_RELAXED, __HIP_MEMORY_SCOPE_AGENT); }
__device__ __forceinline__ unsigned xb_xcc_id() { return (unsigned)__builtin_amdgcn_s_getreg((3 << 11) | 20) & 0xFu; }
#define XB_SPIN(cond, bar) do { unsigned _sp = 0; while (cond) { __builtin_amdgcn_s_sleep(1); \
    if ((++_sp & 255u) == 0u) { if (xb_ld(&(bar)[XB_TMO])) break; if (_sp > XB_SPIN_CAP) { atomicAdd(&(bar)[XB_TMO], 1u); break; } } } } while (0)

struct XcdBarrier {
    unsigned* bar; unsigned x;
    volatile LAS unsigned* st;
};

__device__ __forceinline__ XcdBarrier xcd_barrier_post(unsigned* bar, volatile LAS unsigned* st) {
    XcdBarrier b; b.bar = bar; b.x = xb_xcc_id(); b.st = st;
    if (threadIdx.x == 0) (void)xb_add(&bar[XB_XCNT(b.x)], 1u);
    return b;
}
__device__ __forceinline__ void xcd_barrier_complete(unsigned* bar, unsigned x, unsigned& nloc, unsigned& nx) {
    const unsigned G = gridDim.x * gridDim.y * gridDim.z;
    unsigned sum, cnt, mine, sp = 0u;
    for (;;) {
        sum = 0u; cnt = 0u; mine = 0u;
#pragma unroll
        for (unsigned j = 0; j < 16; ++j) { const unsigned c = xb_ld(&bar[XB_XCNT(j)]); sum += c; cnt += (c > 0u) ? 1u : 0u; mine = (j == x) ? c : mine; }
        if (sum == G) break;
        __builtin_amdgcn_s_sleep(1);
        if ((++sp & 255u) == 0u) { if (xb_ld(&bar[XB_TMO])) break; if (sp > XB_SPIN_CAP) { atomicAdd(&bar[XB_TMO], 1u); break; } }
    }
    nloc = mine > 0u ? mine : 1u; nx = cnt > 0u ? cnt : 1u;
}

__device__ __forceinline__ void xcd_barrier(const XcdBarrier& b, bool leader) {
    asm volatile("s_waitcnt vmcnt(0)" ::: "memory");
    __syncthreads();
    if (leader) {
        unsigned* bar = b.bar;
        __builtin_amdgcn_s_waitcnt(0);
        unsigned nloc = b.st[0], nx = b.st[1];
        if (nloc == 0u) { xcd_barrier_complete(bar, b.x, nloc, nx); b.st[0] = nloc; b.st[1] = nx; }
        const unsigned old = xb_add(&bar[XB_XSUB(b.x)], 1u);
        const unsigned gen = old / nloc;
        if (old + 1u == (gen + 1u) * nloc) {
            __builtin_amdgcn_fence(__ATOMIC_RELEASE, "agent");
            asm volatile("s_waitcnt vmcnt(0)" ::: "memory");
            const unsigned og = xb_add(&bar[XB_TOP], 1u);
            const unsigned tg = og / nx;
            if (og + 1u == (tg + 1u) * nx) xb_add(&bar[XB_TOPGEN], 1u);
            else XB_SPIN(xb_ld(&bar[XB_TOPGEN]) == tg, bar);
            __builtin_amdgcn_fence(__ATOMIC_ACQUIRE, "agent");
            xb_add(&bar[XB_XGEN(b.x)], 1u);
            asm volatile("s_waitcnt vmcnt(0)" ::: "memory");
        } else {
            XB_SPIN(xb_ld(&bar[XB_XGEN(b.x)]) == gen, bar);
            __builtin_amdgcn_fence(__ATOMIC_ACQUIRE, "agent");
            asm volatile("s_waitcnt vmcnt(0)" ::: "memory");
        }
    }
    __syncthreads();
}


constexpr int LDS_BYTES = 147456;
__global__ void __launch_bounds__(NT) fwd_megakernel(Params p_unused) {
    KP p = (KP)__builtin_amdgcn_kernarg_segment_ptr();
    float* lds = (float*)dyn_lds;
    const int bid = blockIdx.x, nb = gridDim.x, wv_ = __builtin_amdgcn_readfirstlane((int)(threadIdx.x >> 6));
    volatile LAS unsigned* bst = (volatile LAS unsigned*)((LAS unsigned char*)dyn_lds + LDS_BYTES - 16);
    if (threadIdx.x < 4) bst[threadIdx.x] = 0u;
    __syncthreads();
    (void)xcd_barrier_post((unsigned*)(p->ws + WS_CTL), bst);
#define GRID_BAR() do { XcdBarrier xb_; xb_.bar = (unsigned*)(p->ws + WS_CTL); xb_.x = xb_xcc_id(); xb_.st = (volatile LAS unsigned*)((LAS unsigned char*)dyn_lds + LDS_BYTES - 16); xcd_barrier(xb_, opaque_tid() == 0); } while (0)
    phase_mod(p, lds, bid, nb, wv_);
    __syncthreads();
    phase_convert_weights(p, lds, bid, nb, wv_);
    phase_amax(p, bid, nb, wv_);
    phase_convert_experts(p, bid, nb, wv_);
    cg::this_grid().sync();
    for (int i = bid * NT + opaque_tid(); i < NB * NMOD; i += nb * NT) ((float*)(p->ws + WS_MODS))[i] = mod_at(p, i / NMOD, i % NMOD);
    phase_hrows<true>(p, p->in[I_X], p->in[I_GMIX], 0, D, (bf16_t*)(p->ws + WS_H), lds, bid, nb, wv_);
    phase_convert_weights8(p, lds, bid, nb, wv_);
    GRID_BAR();
    { pg8::Gemm g{(const bf16_t*)(p->ws + WS_H), (const bf16_t*)(p->ws + WS_WIN_T), M, NPROJ, D / 2}; pg8::StaticOrder S; S.init(M, NPROJ, nb, bid);
      pg8::EpiProj<true> E{(bf16_t*)(p->ws + WS_PROJ), (float*)(p->ws + WS_SSQV), M, (const float*)(p->ws + WS_HSCALE1), (const float*)(p->ws + WS_CTL) + CW_WSCALE};
      pg8::gemm_phase<pg8::EpiProj<true>, pg8::StaticOrder, true, true, 2>((LAS unsigned char*)dyn_lds, g, S, E, wv_); }
    GRID_BAR();
    phase_lru(p, dyn_lds, bid, nb, wv_);
    phase_sgu(p, dyn_lds, bid, nb, wv_);
    GRID_BAR();
    { pg8::Gemm g{(const bf16_t*)(p->ws + WS_YMIX), (const bf16_t*)(p->ws + WS_WOUT_T), M, D, D / 2}; pg8::StaticOrder S; S.init(M, D, nb, bid);
      pg8::EpiX1 E{p->in[I_X], (bf16_t*)(p->ws + WS_X1B), (const float*)(p->ws + WS_MODS), p->in[I_BADA], 2 * D, NMOD, SEQ, (const float*)(p->ws + WS_CTL) + CW_WSCALE + 1, 1.f / YMIX_SCALE};
      pg8::gemm_phase<pg8::EpiX1, pg8::StaticOrder, true, true, 1>((LAS unsigned char*)dyn_lds, g, S, E, wv_); }
    GRID_BAR();
    phase_hrows<false, true, true, true>(p, (const float*)(p->ws + WS_X1B), p->in[I_GFFN], 3 * D, 4 * D, (bf16_t*)(p->ws + WS_H), lds, bid, nb, wv_);
    GRID_BAR();
    { pg8::Gemm g{(const bf16_t*)(p->ws + WS_H8I), (const bf16_t*)(p->ws + WS_WQ_T), M, D, D / 2}; pg8::StaticOrder S; S.init(M, D, nb, bid);
      pg8::EpiQ E{(bf16_t*)(p->ws + WS_Q), D, (const float*)(p->ws + WS_HSC), (const float*)(p->ws + WS_CTL) + CW_WSCALE + 2};
      pg8::gemm_phase<pg8::EpiQ, pg8::StaticOrder, true, true, 2>((LAS unsigned char*)dyn_lds, g, S, E, wv_); }
    GRID_BAR();
    phase_topk(p, dyn_lds, bid, nb, wv_);
    GRID_BAR();
    phase_peer_gather<false>(p, lds, bid, nb, wv_);
    GRID_BAR();
    phase_peer_act(p, bid, nb, wv_);
    GRID_BAR();
    phase_peer_v(p, dyn_lds, bid, nb, wv_);
    GRID_BAR();
    phase_final_norm(p, bid, nb, wv_);
}

extern "C" void kernel_launch(void* const* d_in, const int* in_sizes, int n_in, void* d_out, int out_size, void* d_ws, size_t ws_size, hipStream_t stream) {
    static int grid_blocks = 0;
    if (grid_blocks == 0) {
        if (n_in != 23 || in_sizes[0] != M * D || out_size != M * D || ws_size < WS_END) { fprintf(stderr, "kernel_launch: unexpected shapes (n_in %d in0 %d out %d ws %zu)\n", n_in, n_in > 0 ? in_sizes[0] : -1, out_size, ws_size); grid_blocks = -1; return; }
        if (hipFuncSetAttribute((const void*)fwd_megakernel, hipFuncAttributeMaxDynamicSharedMemorySize, LDS_BYTES) != hipSuccess) { fprintf(stderr, "hipFuncSetAttribute failed\n"); grid_blocks = -1; return; }
        int dev = 0, cus = 0, per_cu = 0;
        hipGetDevice(&dev);
        hipDeviceGetAttribute(&cus, hipDeviceAttributeMultiprocessorCount, dev);
        if (hipOccupancyMaxActiveBlocksPerMultiprocessor(&per_cu, (const void*)fwd_megakernel, NT, LDS_BYTES) != hipSuccess || per_cu < 1) { fprintf(stderr, "occupancy query failed (%d)\n", per_cu); grid_blocks = -1; return; }
        grid_blocks = cus;
    }
    if (grid_blocks < 0) return;
    Params p{};
    for (int i = 0; i < 23; ++i) p.in[i] = (const float*)d_in[i];
    p.out = (float*)d_out; p.ws = (unsigned char*)d_ws;
    if (hipMemsetAsync((char*)d_ws + WS_CTL, 0, 65536, stream) != hipSuccess) { fprintf(stderr, "hipMemsetAsync of the barrier words failed\n"); return; }
    void* args[] = {&p};
    hipError_t e = hipLaunchCooperativeKernel((const void*)fwd_megakernel, dim3(grid_blocks), dim3(NT), args, LDS_BYTES, stream);
    if (e != hipSuccess) fprintf(stderr, "cooperative launch failed: %s (grid %d)\n", hipGetErrorString(e), grid_blocks);
}
```

```cpp
#include <hip/hip_runtime.h>
#include <hip/hip_cooperative_groups.h>
#include <cstdio>
#include <cstdint>

constexpr int D = 2048, NB = 8, SEQ = 2048, M = NB * SEQ;
constexpr int DLRU = 1024, DSGU = 1024, NPROJ = 4096;
constexpr int NMOD = 6 * D;
constexpr int NHEAD = 8, NKEYS = 128, TOPK = 16, NSEL = NHEAD * TOPK;
constexpr float EPS = 1e-6f;
constexpr int NT = 512;
namespace cg = cooperative_groups;

constexpr size_t MiB = 1u << 20;
constexpr size_t WS_CTL = 0;
constexpr size_t WS_MODP = 1 * MiB;
constexpr size_t WS_WGA_T = 3 * MiB;
constexpr size_t WS_WGI_T = 3 * MiB + 262144;
constexpr size_t WS_WSPB = 3 * MiB + 524288;
constexpr size_t WS_SKEYB = 3 * MiB + 786432;
constexpr size_t WS_SSQV = 5 * MiB;
constexpr size_t WS_RSTDV = 8 * MiB;
constexpr size_t WS_WIN_T = 9 * MiB;
constexpr size_t WS_WOUT_T = 25 * MiB;
constexpr size_t WS_WQ_T = 33 * MiB;
constexpr size_t WS_IDX = 41 * MiB;
constexpr size_t WS_GATE = 49 * MiB;
constexpr size_t WS_H = 64 * MiB;
constexpr size_t WS_PROJ = 128 * MiB;
constexpr size_t WS_Q = 128 * MiB;
constexpr size_t WS_YMIX = 256 * MiB;
constexpr size_t WS_EU8 = 320 * MiB;
constexpr size_t WS_EV8 = 352 * MiB;
constexpr size_t WS_ESCALE = 57 * MiB;
constexpr size_t WS_XC = 320 * MiB;
constexpr size_t WS_A = 384 * MiB;
constexpr size_t WS_BB = 448 * MiB;
constexpr size_t WS_ACT = 256 * MiB;
constexpr size_t WS_SSQ2 = 264 * MiB;
constexpr size_t WS_PDOT = 384 * MiB;
constexpr size_t WS_HSCALE1 = 58 * MiB;
constexpr size_t WS_HSC = 59 * MiB;
constexpr size_t WS_ASC = 60 * MiB;
constexpr size_t WS_H8I = 288 * MiB;
constexpr size_t WS_Y16 = 128 * MiB;
constexpr size_t WS_IDX16 = 61 * MiB;
constexpr size_t WS_IDXT = 72 * MiB;
constexpr size_t WS_SSQP = 80 * MiB;
constexpr size_t WS_X1B = 192 * MiB;
constexpr size_t WS_MODS = 448 * MiB;
constexpr size_t WS_H8T = 464 * MiB;
constexpr size_t WS_END = 512 * MiB;

typedef unsigned short bf16_t;
struct Params { const float* in[23]; float* out; unsigned char* ws; };
typedef const __attribute__((address_space(4))) Params* KP;
enum { I_X = 0, I_C, I_WADA, I_BADA, I_GMIX, I_WIN, I_CONVW, I_CONVB, I_WGA, I_BGA, I_WGI, I_BGI, I_LAM, I_GV, I_WSP, I_BSP, I_WOUT, I_GFFN, I_WQ, I_SKEY, I_EU, I_EV, I_GFIN };

__device__ __forceinline__ int opaque_tid_(int wv) { asm volatile("" : "+s"(wv)); int t = wv * 64 + (int)__builtin_amdgcn_mbcnt_hi(~0u, __builtin_amdgcn_mbcnt_lo(~0u, 0u)); asm volatile("" : "+v"(t)); return t; }
#define opaque_tid() opaque_tid_(wv_)
__device__ __forceinline__ float bf2f(bf16_t v) { return __uint_as_float(((unsigned)v) << 16); }
__device__ __forceinline__ bf16_t f2bf(float f) { unsigned u = __float_as_uint(f); u += 0x7fffu + ((u >> 16) & 1u); return (bf16_t)(u >> 16); }
__device__ __forceinline__ float sigmoidf_(float x) { return 1.f / (1.f + __expf(-x)); }
__device__ __forceinline__ float gelu_t(float x) { const float u = 0.7978845608028654f * (x + 0.044715f * x * x * x); return x * sigmoidf_(2.f * u); }
__device__ __forceinline__ float wave_sum(float v) {
#pragma unroll
    for (int o = 1; o < 64; o <<= 1) v += __shfl_xor(v, o);
    return v;
}
__device__ __forceinline__ float wave_max(float v) {
#pragma unroll
    for (int o = 1; o < 64; o <<= 1) v = fmaxf(v, __shfl_xor(v, o));
    return v;
}
__device__ __forceinline__ float pow2_scale_from_max(float am) { int ex = 0; if (am > 0.f) (void)frexpf(am, &ex); else ex = 8; return ldexpf(1.f, 8 - ex); }
__device__ __forceinline__ unsigned pk4_fp8(float a, float b, float c, float d) {
    int w = __builtin_amdgcn_cvt_pk_fp8_f32(fminf(fmaxf(a, -448.f), 448.f), fminf(fmaxf(b, -448.f), 448.f), 0, false);
    return (unsigned)__builtin_amdgcn_cvt_pk_fp8_f32(fminf(fmaxf(c, -448.f), 448.f), fminf(fmaxf(d, -448.f), 448.f), w, true);
}
__device__ __forceinline__ unsigned pk4_i8(float a, float b, float c, float d) {
    const int ia = __float2int_rn(a), ib = __float2int_rn(b), ic = __float2int_rn(c), id = __float2int_rn(d);
    return ((unsigned)ia & 0xffu) | (((unsigned)ib & 0xffu) << 8) | (((unsigned)ic & 0xffu) << 16) | ((unsigned)id << 24);
}
__device__ __forceinline__ float mod_at(KP p, int b, int n) {
    const float* mp = (const float*)(p->ws + WS_MODP);
    float s = p->in[I_BADA][n];
#pragma unroll
    for (int kc = 0; kc < 4; ++kc) s += mp[(size_t)(kc * 8 + b) * NMOD + n];
    return s;
}

__device__ __forceinline__ void phase_mod(KP p, float* lds, int bid, int nb, int wv_) {
    const int tid = opaque_tid(), lane = tid & 63, wave = tid >> 6;
    const float* c = p->in[I_C]; const float* W = p->in[I_WADA];
    float* modp = (float*)(p->ws + WS_MODP);
    for (int i = tid; i < NB * D; i += NT) { const float v = c[i]; lds[i] = v * sigmoidf_(v); }
    __syncthreads();
    float* red = lds + NB * D;
    for (int item = bid; item < 192; item += nb) {
        const int nt = item % 48, kc = item / 48;
        const int n0 = nt * 256 + lane * 4, k0 = kc * 512 + wave * 64;
        float acc[8][4];
#pragma unroll
        for (int b = 0; b < 8; ++b)
#pragma unroll
            for (int j = 0; j < 4; ++j) acc[b][j] = 0.f;
        for (int kk = 0; kk < 64; ++kk) {
            const float4 w = *(const float4*)(W + (size_t)(k0 + kk) * NMOD + n0);
#pragma unroll
            for (int b = 0; b < 8; ++b) { const float s = lds[b * D + k0 + kk]; acc[b][0] += s * w.x; acc[b][1] += s * w.y; acc[b][2] += s * w.z; acc[b][3] += s * w.w; }
        }
#pragma unroll
        for (int b = 0; b < 8; ++b)
#pragma unroll
            for (int j = 0; j < 4; ++j) red[(wave * 32 + b * 4 + j) * 64 + lane] = acc[b][j];
        __syncthreads();
        for (int o = tid; o < 2048; o += NT) {
            const int b = o >> 8, nn = o & 255, ln = nn >> 2, j = nn & 3;
            float s = 0.f;
#pragma unroll
            for (int w = 0; w < 8; ++w) s += red[(w * 32 + b * 4 + j) * 64 + ln];
            modp[(size_t)(kc * 8 + b) * NMOD + nt * 256 + nn] = s;
        }
        __syncthreads();
    }
}

#define LAS __attribute__((address_space(3)))
extern __shared__ __attribute__((aligned(16))) unsigned char dyn_lds[];
__device__ __forceinline__ LAS unsigned char* dyn_lds_base() { return (LAS unsigned char*)dyn_lds; }
typedef unsigned v2u_t __attribute__((ext_vector_type(2)));
typedef int v4i_t __attribute__((ext_vector_type(4)));
template <bool F8OUT, bool I8COPY = false, bool NOBF16 = false, bool SRC16 = false>
__device__ __forceinline__ void phase_hrows(KP p, const float* src, const float* gn, int shift_off, int scale_off, bf16_t* dst, float* lds, int bid, int nb, int wv_) {
    const int tid = opaque_tid(), lane = tid & 63, wave = tid >> 6;
    float* Aw = lds; float* Bw = lds + D;
    for (int item = bid; item < M / 64; item += nb) {
        const int b = item / (SEQ / 64);
        for (int col = tid; col < D; col += NT) { if (SRC16) { const float* ms = (const float*)(p->ws + WS_MODS) + (size_t)b * NMOD; Aw[col] = gn[col] * (1.f + ms[scale_off + col]); Bw[col] = ms[shift_off + col]; }
                                                 else { Aw[col] = gn[col] * (1.f + mod_at(p, b, scale_off + col)); Bw[col] = mod_at(p, b, shift_off + col); } }
        __syncthreads();
        for (int r = wave; r < 64; r += 8) {
            const size_t row = (size_t)item * 64 + r;
            float4 v[8]; float ss = 0.f;
#pragma unroll
            for (int j = 0; j < 8; ++j) { if (SRC16) { const uint2 w = *(const uint2*)((const bf16_t*)src + row * D + lane * 4 + 256 * j); v[j] = make_float4(__uint_as_float(w.x << 16), __uint_as_float(w.x & 0xffff0000u), __uint_as_float(w.y << 16), __uint_as_float(w.y & 0xffff0000u)); }
                                          else v[j] = *(const float4*)(src + row * D + lane * 4 + 256 * j);
                                          ss += v[j].x * v[j].x + v[j].y * v[j].y + v[j].z * v[j].z + v[j].w * v[j].w; }
            const float rstd = rsqrtf(wave_sum(ss) * (1.f / D) + EPS);
            float am = 0.f;
#pragma unroll
            for (int j = 0; j < 8; ++j) {
                const int col = lane * 4 + 256 * j;
                const float o0 = v[j].x * rstd * Aw[col] + Bw[col], o1 = v[j].y * rstd * Aw[col + 1] + Bw[col + 1];
                const float o2 = v[j].z * rstd * Aw[col + 2] + Bw[col + 2], o3 = v[j].w * rstd * Aw[col + 3] + Bw[col + 3];
                if (F8OUT || I8COPY) { v[j] = make_float4(o0, o1, o2, o3); am = fmaxf(am, fmaxf(fmaxf(fabsf(o0), fabsf(o1)), fmaxf(fabsf(o2), fabsf(o3)))); }
                if (!F8OUT && !NOBF16) { uint2 w; w.x = (unsigned)f2bf(o0) | ((unsigned)f2bf(o1) << 16); w.y = (unsigned)f2bf(o2) | ((unsigned)f2bf(o3) << 16); *(uint2*)(dst + row * D + col) = w; }
            }
            if (I8COPY) {
                am = wave_max(am); const float sc = am > 0.f ? 127.f / am : 0.f;
                unsigned* d8 = (unsigned*)(p->ws + WS_H8I + row * D);
#pragma unroll
                for (int j = 0; j < 8; ++j) { const unsigned w8 = pk4_i8(v[j].x * sc, v[j].y * sc, v[j].z * sc, v[j].w * sc); d8[lane + 64 * j] = w8; *(LAS unsigned*)(dyn_lds_base() + 16384 + (r & 31) * (D + 16) + lane * 4 + 256 * j) = w8; }
                if (lane == 0) ((float*)(p->ws + WS_HSC))[row] = am * (1.f / 127.f);
            }
            if (I8COPY && ((r >> 3) & 3) == 3) {
                __syncthreads();
#pragma unroll 4
                for (int k = 0; k < 16; ++k) { const int pid = k * NT + tid, slc = pid >> 5, rr = pid & 31;
                    *(v2u_t*)(p->ws + WS_H8T + ((size_t)slc * M + (size_t)item * 64 + (r & 32) + rr) * 8) = *(LAS const v2u_t*)(dyn_lds_base() + 16384 + rr * (D + 16) + slc * 8); }
                __syncthreads();
            }
            if (F8OUT) {
                am = wave_max(am); const float sc = am > 0.f ? 127.f / am : 0.f;
                unsigned* d8 = (unsigned*)((unsigned char*)dst + row * D);
#pragma unroll
                for (int j = 0; j < 8; ++j) d8[lane + 64 * j] = pk4_i8(v[j].x * sc, v[j].y * sc, v[j].z * sc, v[j].w * sc);
                if (lane == 0) ((float*)(p->ws + WS_HSCALE1))[row] = am * (1.f / 127.f);
            }
        }
        __syncthreads();
    }
}

namespace pg8 {
#define PG8_LAS __attribute__((address_space(3)))
typedef unsigned short bf16_t;
typedef short bf16x8 __attribute__((ext_vector_type(8)));
typedef float f32x4 __attribute__((ext_vector_type(4)));
typedef unsigned u32x4 __attribute__((ext_vector_type(4)));
constexpr int BM = 256, BK = 64, HALF = 128, HTB = HALF * BK * 2  , STAGE_BYTES = 8 * HTB, NXCD = 8, WGM = 8;

__host__ __device__ __forceinline__ int lds_byte(int r, int c) { const int st = (r >> 4) * 2 + (c >> 5), rr = r & 15, cc = c & 31, ob = rr * 64 + cc * 2; return st * 1024 + (ob ^ (((ob >> 9) & 1) << 5)); }
__host__ __device__ __forceinline__ void stage_rc(int b, int& R, int& C) { const int st = b / 1024, sb = b % 1024, swz = sb ^ (((sb >> 9) & 1) << 5); R = (st >> 1) * 16 + swz / 64; C = (st & 1) * 32 + (swz % 64) / 2; }
__host__ __device__ __forceinline__ int perm32(int rho) { const int n = rho >> 4, i = rho & 15; return 8 * (i >> 2) + 4 * n + (i & 3); }

struct Unit { int pm, pn; };
struct Gemm { const bf16_t* A; const bf16_t* Bt; int M, N, K; };

struct StaticOrder {
    int nM, nN, nwg, G, c;
    __host__ __device__ void init(int M, int N, int G_, int c_) { nM = M / BM; nN = N / BM; nwg = nM * nN; G = G_; c = c_; }
    __host__ __device__ bool next(int i, Unit& u) const {
        const long L = (long)i * G + c; if (L >= nwg) return false;
        int wgid = (int)L; { const int q = nwg / NXCD, r = nwg % NXCD, xcd = wgid % NXCD, off = wgid / NXCD; wgid = (xcd < r ? xcd * (q + 1) : r * (q + 1) + (xcd - r) * q) + off; }
        const int nig = WGM * nN, gid = wgid / nig, fm = gid * WGM, gsz = (nM - fm) < WGM ? (nM - fm) : WGM;
        u.pm = fm + ((wgid % nig) % gsz); u.pn = (wgid % nig) / gsz; return true;
    }
    __device__ __forceinline__ void a_ready(const Unit&) const {}
    __device__ __forceinline__ void done(const Unit&) const {}
};


__device__ __forceinline__ unsigned cvt_pk_bf16(float lo, float hi) { unsigned r; asm volatile("v_cvt_pk_bf16_f32 %0, %1, %2" : "=v"(r) : "v"(lo), "v"(hi)); return r; }
__device__ __forceinline__ float gelu_tanh(float x) { const float u = 1.5957691216057308f * (x + 0.044715f * x * x * x); return x * __builtin_amdgcn_rcpf(1.f + __expf(-u)); }
template <bool ACCI  > struct EpiProj {
    static constexpr bool PERM = true, AFTER_DRAIN = false;
    bf16_t* proj; float* ssqv; int Mrows; const float* rowscale; const float* cscale;
    __device__ __forceinline__ void operator()(const f32x4 (&acc)[2][2][4][2], const Unit& u, int wr, int wc, int fr, int fq) const {
        const int which = (u.pn * BM) >> 10, colt = (u.pn * BM) & 1023; const float cs = *cscale;
        bf16_t* base = proj + (size_t)which * Mrows * 1024;
        const int row0 = u.pm * BM + wr * 64 + fr, col0 = colt + wc * 32 + 8 * fq;
#pragma unroll
        for (int ai = 0; ai < 2; ++ai)
#pragma unroll
            for (int m = 0; m < 4; ++m) { const int row = row0 + ai * HALF + m * 16; bf16_t* rowp = base + (size_t)row * 1024 + col0; float ss = 0.f; const float f = cs * rowscale[row];
#pragma unroll
                for (int bj = 0; bj < 2; ++bj) { f32x4 v0 = acc[ai][bj][m][0], v1 = acc[ai][bj][m][1];
                    if (ACCI) { typedef int v4j_ __attribute__((ext_vector_type(4))); const v4j_ i0 = __builtin_bit_cast(v4j_, v0), i1 = __builtin_bit_cast(v4j_, v1);
                        v0 = (f32x4){(float)i0[0], (float)i0[1], (float)i0[2], (float)i0[3]}; v1 = (f32x4){(float)i1[0], (float)i1[1], (float)i1[2], (float)i1[3]}; }
                    v0 = v0 * f; v1 = v1 * f;
                    if (which) {
#pragma unroll
                        for (int j = 0; j < 4; ++j) { v0[j] = gelu_tanh(v0[j]); v1[j] = gelu_tanh(v1[j]); } }
                    ss += (v0[0] * v0[0] + v0[1] * v0[1]) + (v0[2] * v0[2] + v0[3] * v0[3]) + (v1[0] * v1[0] + v1[1] * v1[1]) + (v1[2] * v1[2] + v1[3] * v1[3]);
                    u32x4 w; w.x = cvt_pk_bf16(v0[0], v0[1]); w.y = cvt_pk_bf16(v0[2], v0[3]); w.z = cvt_pk_bf16(v1[0], v1[1]); w.w = cvt_pk_bf16(v1[2], v1[3]);
                    *(u32x4*)(rowp + bj * HALF) = w; }
                if (which == 3) { ss += __shfl_xor(ss, 16); ss += __shfl_xor(ss, 32); if (fq == 0) ssqv[(size_t)row * 16 + (u.pn & 3) * 4 + wc] = ss; } }
    }
};
struct EpiX1 {
    static constexpr bool PERM = false, AFTER_DRAIN = false;
    const float* x; bf16_t* out; const float* modp; const float* bada; int goff, nmod, seq; const float* cscale; float cscale2;
    __device__ __forceinline__ void operator()(const f32x4 (&acc)[2][2][4][2], const Unit& u, int wr, int wc, int fr, int fq) const {
        const int row0 = u.pm * BM + wr * 64 + fr, col0 = u.pn * BM + wc * 32 + 4 * fq, b = (u.pm * BM) / seq;
        f32x4 gv[2][2];
#pragma unroll
        for (int bj = 0; bj < 2; ++bj)
#pragma unroll
            for (int n = 0; n < 2; ++n) { const int c = goff + col0 + bj * HALF + n * 16; const f32x4 g = *(const f32x4*)(modp + (size_t)b * nmod + c);
                gv[bj][n] = g * (*cscale * cscale2); }
#pragma unroll
        for (int ai = 0; ai < 2; ++ai)
#pragma unroll
            for (int m = 0; m < 4; ++m) { const size_t off = (size_t)(row0 + ai * HALF + m * 16) * (size_t)(2048) + col0;
#pragma unroll
                for (int bj = 0; bj < 2; ++bj)
#pragma unroll
                    for (int n = 0; n < 2; ++n) { const f32x4 xv = *(const f32x4*)(x + off + bj * HALF + n * 16); const f32x4 r = xv + gv[bj][n] * acc[ai][bj][m][n];
                        uint2 w; w.x = (unsigned)f2bf(r[0]) | ((unsigned)f2bf(r[1]) << 16); w.y = (unsigned)f2bf(r[2]) | ((unsigned)f2bf(r[3]) << 16); *(uint2*)(out + off + bj * HALF + n * 16) = w; } }
    }
};
struct EpiQ {
    static constexpr bool PERM = true, AFTER_DRAIN = false;
    bf16_t* O; int ldc; const float* rowscale; const float* cscale;
    __device__ __forceinline__ void operator()(const f32x4 (&acc)[2][2][4][2], const Unit& u, int wr, int wc, int fr, int fq) const {
        const int row0 = u.pm * BM + wr * 64 + fr, col0 = u.pn * BM + wc * 32 + 8 * fq;
#pragma unroll
        for (int ai = 0; ai < 2; ++ai)
#pragma unroll
            for (int m = 0; m < 4; ++m) { bf16_t* rowp = O + (size_t)(row0 + ai * HALF + m * 16) * ldc + col0; const float f = *cscale * rowscale[row0 + ai * HALF + m * 16];
#pragma unroll
                for (int bj = 0; bj < 2; ++bj) { typedef int v4j_ __attribute__((ext_vector_type(4))); const v4j_ i0 = __builtin_bit_cast(v4j_, acc[ai][bj][m][0]), i1 = __builtin_bit_cast(v4j_, acc[ai][bj][m][1]);
                    const f32x4 v0 = (f32x4){(float)i0[0], (float)i0[1], (float)i0[2], (float)i0[3]} * f, v1 = (f32x4){(float)i1[0], (float)i1[1], (float)i1[2], (float)i1[3]} * f;
                    u32x4 w; w.x = cvt_pk_bf16(v0[0], v0[1]); w.y = cvt_pk_bf16(v0[2], v0[3]); w.z = cvt_pk_bf16(v1[0], v1[1]); w.w = cvt_pk_bf16(v1[2], v1[3]);
                    *(u32x4*)(rowp + bj * HALF) = w; } }
    }
};

template <class Epi, class Sched, bool ALIGN_EPI = false, bool SP2 = false, int OPK = 0>
__device__ __forceinline__ void gemm_phase(PG8_LAS unsigned char* lds, const Gemm g, const Sched& S, const Epi& E, int wv_) {
    const int tid = opaque_tid(), wid = __builtin_amdgcn_readfirstlane(tid >> 6), lane = tid & 63, wr = wid >> 2, wc = wid & 3, fr = lane & 15, fq = lane >> 4;
    const int K = g.K, nt = K / BK;
    unsigned voffA[2], voffB[2];
#pragma unroll
    for (int i = 0; i < 2; ++i) { int R, C; stage_rc(tid * 16 + i * 8192, R, C); const int Rb = Epi::PERM ? ((R & ~31) + perm32(R & 31)) : R;
        voffA[i] = (unsigned)(R * K + C) * 2u; voffB[i] = (unsigned)(Rb * K + C) * 2u; }
    const size_t kstep = (size_t)(BK * 2);
    const size_t hstep = (size_t)HALF * K * 2;
    const size_t tstep = 2 * hstep;
    const unsigned ldsw = (unsigned)wid * 1024u;
    const int aoff = lds_byte(wr * 64 + fr, fq * 8), boff = lds_byte(wc * 32 + fr, fq * 8);
#define PG8_SA(b, h) (((b) * 2 + (h)) * HTB)
#define PG8_SB(b, h) ((4 + (b) * 2 + (h)) * HTB)
#define PG8_STAGE(bufoff, gbase, voff) do { _Pragma("unroll") for (int _i = 0; _i < 2; ++_i) \
        __builtin_amdgcn_global_load_lds((const unsigned*)((const char*)(gbase) + (voff)[_i]), (PG8_LAS unsigned*)(lds + (bufoff) + ldsw + _i * 8192), 16, 0, 0); } while (0)
#define PG8_LDA(dst, b, h) do { _Pragma("unroll") for (int m = 0; m < 4; ++m) _Pragma("unroll") for (int k = 0; k < 2; ++k) dst[m][k] = *(const PG8_LAS bf16x8*)(lds + PG8_SA(b, h) + aoff + m * 2048 + k * 1024); } while (0)
#define PG8_LDB(dst, b, h) do { _Pragma("unroll") for (int n = 0; n < 2; ++n) _Pragma("unroll") for (int k = 0; k < 2; ++k) dst[n][k] = *(const PG8_LAS bf16x8*)(lds + PG8_SB(b, h) + boff + n * 2048 + k * 1024); } while (0)
#define PG8_MMA(ai, bj, At, Bt) do { __builtin_amdgcn_s_setprio(1); _Pragma("unroll") for (int m = 0; m < 4; ++m) _Pragma("unroll") for (int n = 0; n < 2; ++n) { \
        if constexpr (OPK == 2) { typedef int v4j_ __attribute__((ext_vector_type(4))); _Pragma("unroll") for (int k = 0; k < 2; ++k) \
            acc[ai][bj][m][n] = __builtin_bit_cast(f32x4, __builtin_amdgcn_mfma_i32_16x16x64_i8(__builtin_bit_cast(v4j_, Bt[n][k]), __builtin_bit_cast(v4j_, At[m][k]), __builtin_bit_cast(v4j_, acc[ai][bj][m][n]), 0, 0, 0)); } \
        else if constexpr (OPK == 1) { typedef int v4i_ __attribute__((ext_vector_type(4))); typedef int v8i_ __attribute__((ext_vector_type(8))); \
            const v8i_ a8 = __builtin_shufflevector(__builtin_bit_cast(v4i_, Bt[n][0]), __builtin_bit_cast(v4i_, Bt[n][1]), 0, 1, 2, 3, 4, 5, 6, 7), b8 = __builtin_shufflevector(__builtin_bit_cast(v4i_, At[m][0]), __builtin_bit_cast(v4i_, At[m][1]), 0, 1, 2, 3, 4, 5, 6, 7); \
            asm volatile("v_mfma_scale_f32_16x16x128_f8f6f4 %0, %1, %2, %0, %3, %3 op_sel_hi:[0,0,0]" : "+v"(acc[ai][bj][m][n]) : "v"(a8), "v"(b8), "v"(one8)); } \
        else { _Pragma("unroll") for (int k = 0; k < 2; ++k) acc[ai][bj][m][n] = __builtin_amdgcn_mfma_f32_16x16x32_bf16(Bt[n][k], At[m][k], acc[ai][bj][m][n], 0, 0, 0); } } \
        __builtin_amdgcn_s_setprio(0); } while (0)
#define PG8_WAIT_V(n) asm volatile("s_waitcnt vmcnt(" #n ")" ::: "memory")
#define PG8_WAIT_L(n) asm volatile("s_waitcnt lgkmcnt(" #n ")" ::: "memory")
#define PG8_BAR __builtin_amdgcn_s_barrier()
#define PG8_SCHED __builtin_amdgcn_sched_barrier(0)
    Unit cur, nxt; int ui = 0;
    if (!S.next(0, cur)) return;
    f32x4 acc[2][2][4][2];
#pragma unroll
    for (int a = 0; a < 2; ++a)
#pragma unroll
        for (int b = 0; b < 2; ++b)
#pragma unroll
            for (int m = 0; m < 4; ++m)
#pragma unroll
                for (int n = 0; n < 2; ++n) acc[a][b][m][n] = (f32x4){0.f, 0.f, 0.f, 0.f};
    bf16x8 At[4][2], B0[2][2], B1[2][2];
    int one8 = 0x7F7F7F7F; asm volatile("" : "+v"(one8));
    const char* cA = (const char*)g.A + (size_t)cur.pm * tstep; const char* cB = (const char*)g.Bt + (size_t)cur.pn * tstep;
    S.a_ready(cur);
    if constexpr (SP2) {
        PG8_STAGE(PG8_SB(0, 0), cB, voffB); PG8_STAGE(PG8_SB(0, 1), cB + hstep, voffB); PG8_STAGE(PG8_SA(0, 0), cA, voffA); PG8_STAGE(PG8_SA(0, 1), cA + hstep, voffA);
        if (wr == 1) PG8_BAR;
        PG8_WAIT_V(2); PG8_BAR;
        PG8_STAGE(PG8_SB(1, 0), cB + kstep, voffB); PG8_STAGE(PG8_SA(1, 0), cA + kstep, voffA); PG8_STAGE(PG8_SB(1, 1), cB + hstep + kstep, voffB);
        PG8_WAIT_V(6); PG8_BAR;
    } else {
        PG8_STAGE(PG8_SB(0, 0), cB, voffB); PG8_STAGE(PG8_SA(0, 0), cA, voffA); PG8_STAGE(PG8_SB(0, 1), cB + hstep, voffB); PG8_STAGE(PG8_SA(0, 1), cA + hstep, voffA);
        if (wr == 1) PG8_BAR;
        PG8_WAIT_V(4); PG8_BAR;
        PG8_STAGE(PG8_SB(1, 0), cB + kstep, voffB); PG8_STAGE(PG8_SA(1, 0), cA + kstep, voffA); PG8_STAGE(PG8_SB(1, 1), cB + hstep + kstep, voffB);
        PG8_WAIT_V(6); PG8_BAR;
    }
    for (;;) {
        const bool has_next = S.next(ui + 1, nxt);
        const char* nA = has_next ? (const char*)g.A + (size_t)nxt.pm * tstep : cA; const char* nB = has_next ? (const char*)g.Bt + (size_t)nxt.pn * tstep : cB;
        for (int t = 0; t < nt; t += 2) {
            const bool last = (t == nt - 2);
            const char* a1 = cA + (size_t)(t + 1) * kstep;
            const char* a2 = last ? nA : cA + (size_t)(t + 2) * kstep; const char* b2 = last ? nB : cB + (size_t)(t + 2) * kstep;
            const char* a3 = a2 + kstep; const char* b3 = b2 + kstep;
            if (last && has_next) S.a_ready(nxt);
            if constexpr (SP2) {
            PG8_LDB(B0, 0, 0); PG8_LDB(B1, 0, 1); PG8_SCHED; PG8_LDA(At, 0, 0); PG8_STAGE(PG8_SA(1, 1), a1 + hstep, voffA);
            PG8_WAIT_V(8); PG8_WAIT_L(0); PG8_BAR; PG8_MMA(0, 0, At, B0); PG8_MMA(0, 1, At, B1); PG8_BAR; PG8_SCHED;
            PG8_LDA(At, 0, 1); PG8_STAGE(PG8_SB(0, 0), b2, voffB); PG8_STAGE(PG8_SB(0, 1), b2 + hstep, voffB); PG8_STAGE(PG8_SA(0, 0), a2, voffA);
            PG8_WAIT_V(8); PG8_WAIT_L(0); PG8_BAR; PG8_MMA(1, 0, At, B0); PG8_MMA(1, 1, At, B1); PG8_BAR; PG8_SCHED;
            PG8_LDB(B0, 1, 0); PG8_LDB(B1, 1, 1); PG8_SCHED; PG8_LDA(At, 1, 0); PG8_STAGE(PG8_SA(0, 1), a2 + hstep, voffA);
            PG8_WAIT_V(8); PG8_WAIT_L(0); PG8_BAR; PG8_MMA(0, 0, At, B0); PG8_MMA(0, 1, At, B1); PG8_BAR; PG8_SCHED;
            PG8_LDA(At, 1, 1); PG8_STAGE(PG8_SB(1, 0), b3, voffB); PG8_STAGE(PG8_SB(1, 1), b3 + hstep, voffB); PG8_STAGE(PG8_SA(1, 0), a3, voffA);
            PG8_WAIT_V(8); PG8_WAIT_L(0); PG8_BAR; PG8_MMA(1, 0, At, B0); PG8_MMA(1, 1, At, B1); PG8_BAR; PG8_SCHED;
            } else {
            PG8_LDB(B0, 0, 0); PG8_SCHED; PG8_LDA(At, 0, 0); PG8_STAGE(PG8_SA(1, 1), a1 + hstep, voffA);
            PG8_WAIT_L(8); PG8_BAR; PG8_WAIT_L(0); PG8_MMA(0, 0, At, B0); PG8_BAR; PG8_SCHED;
            PG8_LDB(B1, 0, 1); PG8_STAGE(PG8_SB(0, 0), b2, voffB);
            PG8_BAR; PG8_WAIT_L(0); PG8_MMA(0, 1, At, B1); PG8_BAR;
            PG8_LDA(At, 0, 1); PG8_STAGE(PG8_SA(0, 0), a2, voffA);
            PG8_BAR; PG8_WAIT_L(0); PG8_MMA(1, 0, At, B0); PG8_BAR; PG8_SCHED;
            PG8_STAGE(PG8_SB(0, 1), b2 + hstep, voffB);
            PG8_WAIT_V(6); PG8_BAR; PG8_MMA(1, 1, At, B1); PG8_BAR;
            PG8_LDB(B0, 1, 0); PG8_SCHED; PG8_LDA(At, 1, 0); PG8_STAGE(PG8_SA(0, 1), a2 + hstep, voffA);
            PG8_WAIT_L(8); PG8_BAR; PG8_WAIT_L(0); PG8_MMA(0, 0, At, B0); PG8_BAR; PG8_SCHED;
            PG8_LDB(B1, 1, 1); PG8_STAGE(PG8_SB(1, 0), b3, voffB);
            PG8_BAR; PG8_WAIT_L(0); PG8_MMA(0, 1, At, B1); PG8_BAR;
            PG8_LDA(At, 1, 1); PG8_STAGE(PG8_SA(1, 0), a3, voffA);
            PG8_BAR; PG8_WAIT_L(0); PG8_MMA(1, 0, At, B0); PG8_BAR; PG8_SCHED;
            PG8_STAGE(PG8_SB(1, 1), b3 + hstep, voffB);
            PG8_WAIT_V(6); PG8_BAR; PG8_MMA(1, 1, At, B1); PG8_BAR;
            }
        }
        if constexpr (OPK == 1) {
            asm volatile("s_nop 15\n\ts_nop 7" ::: "memory");
#pragma unroll
            for (int a_ = 0; a_ < 2; ++a_)
#pragma unroll
                for (int b_ = 0; b_ < 2; ++b_)
#pragma unroll
                    for (int m_ = 0; m_ < 4; ++m_) asm volatile("" : "+v"(acc[a_][b_][m_][0]), "+v"(acc[a_][b_][m_][1]));
        }
        if constexpr (ALIGN_EPI) { if (wr == 0) PG8_BAR; }
        if constexpr (!Epi::AFTER_DRAIN) { E(acc, cur, wr, wc, fr, fq); S.done(cur); }
        if (!has_next) break;
#pragma unroll
        for (int a = 0; a < 2; ++a)
#pragma unroll
            for (int b = 0; b < 2; ++b)
#pragma unroll
                for (int m = 0; m < 4; ++m)
#pragma unroll
                    for (int n = 0; n < 2; ++n) acc[a][b][m][n] = (f32x4){0.f, 0.f, 0.f, 0.f};
        cur = nxt; cA = nA; cB = nB; ++ui;
        if constexpr (ALIGN_EPI) { if (wr == 1) PG8_BAR; }
    }
    PG8_WAIT_V(0);
    if constexpr (!ALIGN_EPI) { if (wr == 0) PG8_BAR; }
    PG8_BAR;
    if constexpr (Epi::AFTER_DRAIN) { E.fused(acc, cur, wr, wc, fr, fq, lds, wid, lane); S.done(cur); }
#undef PG8_SA
#undef PG8_SB
#undef PG8_STAGE
#undef PG8_LDA
#undef PG8_LDB
#undef PG8_MMA
#undef PG8_WAIT_V
#undef PG8_WAIT_L
#undef PG8_BAR
#undef PG8_SCHED
}
}

__device__ __forceinline__ unsigned pk2(float lo, float hi) { return (unsigned)f2bf(lo) | ((unsigned)f2bf(hi) << 16); }
__device__ __forceinline__ void transpose_item(const float* W, int K, int N, bf16_t* WT, float* scr, int item, int lane) {
    const int nblk = N / 32, kb = item / nblk, nbk = item % nblk, k0 = 64 * kb, n0 = 32 * nbk;
#pragma unroll 8
    for (int i = 0; i < 32; ++i) { const int kk = 2 * i + (lane >> 5); scr[kk * 33 + (lane & 31)] = W[(size_t)(k0 + kk) * N + n0 + (lane & 31)]; }
    asm volatile("s_waitcnt lgkmcnt(0)" ::: "memory");
    const int c = lane & 7;
#pragma unroll
    for (int j = 0; j < 4; ++j) { const int n = (lane >> 3) + 8 * j; const float* s = scr + (8 * c) * 33 + n;
        uint4 o; o.x = pk2(s[0 * 33], s[1 * 33]); o.y = pk2(s[2 * 33], s[3 * 33]); o.z = pk2(s[4 * 33], s[5 * 33]); o.w = pk2(s[6 * 33], s[7 * 33]);
        *(uint4*)(WT + (size_t)(n0 + n) * K + k0 + 8 * c) = o; }
    asm volatile("s_waitcnt lgkmcnt(0)" ::: "memory");
}
constexpr int CW_AMAX_WIN = 2048, CW_AMAX_WOUT = 2112, CW_WSCALE = 2176, CW_AMAX_WQ = 2240;
__device__ __forceinline__ void phase_amax(KP p, int bid, int nb, int wv_) {
    const int tid = opaque_tid(), lane = tid & 63;
    for (int t = 0; t < 3; ++t) {
        const float4* w = (const float4*)(t == 2 ? p->in[I_WQ] : t ? p->in[I_WOUT] : p->in[I_WIN]); const size_t n4 = (size_t)D * (t ? D : NPROJ) / 4;
        float am = 0.f;
        for (size_t i = (size_t)bid * NT + tid; i < n4; i += (size_t)nb * NT) { const float4 v = w[i]; am = fmaxf(am, fmaxf(fmaxf(fabsf(v.x), fabsf(v.y)), fmaxf(fabsf(v.z), fabsf(v.w)))); }
        am = wave_max(am);
        if (lane == 0) atomicMax((unsigned*)(p->ws + WS_CTL) + (t == 2 ? CW_AMAX_WQ : t ? CW_AMAX_WOUT : CW_AMAX_WIN), __float_as_uint(am));
    }
}
template <bool I8>
__device__ __forceinline__ void transpose_item8(const float* W, int K, int N, unsigned char* WT, float* scr, int item, int lane, float sc) {
    const int nblk = N / 32, kb = item / nblk, nbk = item % nblk, k0 = 64 * kb, n0 = 32 * nbk;
#pragma unroll 8
    for (int i = 0; i < 32; ++i) { const int kk = 2 * i + (lane >> 5); scr[kk * 33 + (lane & 31)] = W[(size_t)(k0 + kk) * N + n0 + (lane & 31)]; }
    asm volatile("s_waitcnt lgkmcnt(0)" ::: "memory");
    const int c = lane & 3;
#pragma unroll
    for (int j = 0; j < 2; ++j) { const int n = (lane >> 2) + 16 * j; const float* s = scr + (16 * c) * 33 + n;
        uint4 o;
        if (I8) { o.x = pk4_i8(s[0 * 33] * sc, s[1 * 33] * sc, s[2 * 33] * sc, s[3 * 33] * sc); o.y = pk4_i8(s[4 * 33] * sc, s[5 * 33] * sc, s[6 * 33] * sc, s[7 * 33] * sc);
            o.z = pk4_i8(s[8 * 33] * sc, s[9 * 33] * sc, s[10 * 33] * sc, s[11 * 33] * sc); o.w = pk4_i8(s[12 * 33] * sc, s[13 * 33] * sc, s[14 * 33] * sc, s[15 * 33] * sc); }
        else { o.x = pk4_fp8(s[0 * 33] * sc, s[1 * 33] * sc, s[2 * 33] * sc, s[3 * 33] * sc); o.y = pk4_fp8(s[4 * 33] * sc, s[5 * 33] * sc, s[6 * 33] * sc, s[7 * 33] * sc);
            o.z = pk4_fp8(s[8 * 33] * sc, s[9 * 33] * sc, s[10 * 33] * sc, s[11 * 33] * sc); o.w = pk4_fp8(s[12 * 33] * sc, s[13 * 33] * sc, s[14 * 33] * sc, s[15 * 33] * sc); }
        *(uint4*)(WT + (size_t)(n0 + n) * K + k0 + 16 * c) = o; }
    asm volatile("s_waitcnt lgkmcnt(0)" ::: "memory");
}
__device__ __forceinline__ void phase_convert_weights8(KP p, float* lds, int bid, int nb, int wv_) {
    const int tid = opaque_tid(), lane = tid & 63, wave = tid >> 6;
    float* scr = lds + 4096 + wave * (64 * 33);
    const unsigned* ctl = (const unsigned*)(p->ws + WS_CTL);
    const float am_in = __uint_as_float(__hip_atomic_load(ctl + CW_AMAX_WIN, __ATOMIC_RELAXED, __HIP_MEMORY_SCOPE_AGENT)); const float sc_in = am_in > 0.f ? 127.f / am_in : 0.f;
    const float sc_out = pow2_scale_from_max(__uint_as_float(__hip_atomic_load(ctl + CW_AMAX_WOUT, __ATOMIC_RELAXED, __HIP_MEMORY_SCOPE_AGENT)));
    if (bid == 0 && tid == 0) { ((float*)(p->ws + WS_CTL))[CW_WSCALE] = am_in * (1.f / 127.f); ((float*)(p->ws + WS_CTL))[CW_WSCALE + 1] = 1.f / sc_out; }
    const int gw = bid * 8 + wave, ngw = nb * 8;
    constexpr int I_IN = (D / 64) * (NPROJ / 32), I_SQ = (D / 64) * (D / 32);
    const float am_q = __uint_as_float(__hip_atomic_load(ctl + CW_AMAX_WQ, __ATOMIC_RELAXED, __HIP_MEMORY_SCOPE_AGENT)); const float sc_q = am_q > 0.f ? 127.f / am_q : 0.f;
    if (bid == 0 && tid == 0) ((float*)(p->ws + WS_CTL))[CW_WSCALE + 2] = am_q * (1.f / 127.f);
    for (int it = gw; it < I_IN + 2 * I_SQ; it += ngw) {
        if (it < I_IN) transpose_item8<true>(p->in[I_WIN], D, NPROJ, p->ws + WS_WIN_T, scr, it, lane, sc_in);
        else if (it < I_IN + I_SQ) transpose_item8<false>(p->in[I_WOUT], D, D, p->ws + WS_WOUT_T, scr, it - I_IN, lane, sc_out);
        else transpose_item8<true>(p->in[I_WQ], D, D, p->ws + WS_WQ_T, scr, it - I_IN - I_SQ, lane, sc_q);
    }
}
__device__ __forceinline__ void phase_convert_weights(KP p, float* lds, int bid, int nb, int wv_) {
    const int tid = opaque_tid(), lane = tid & 63, wave = tid >> 6;
    float* scr = lds + wave * (64 * 33);
    const int gw = bid * 8 + wave, ngw = nb * 8;
    constexpr int I_SQ = (D / 64) * (D / 32), I_G = 8 * (128 / 64) * (128 / 32);
    constexpr int NITEMS = 2 * I_G;
    for (int it = gw; it < NITEMS; it += ngw) {
        int r = it;

        if (r < I_G) { const int hd = r / 8; transpose_item(p->in[I_WGA] + hd * 16384, 128, 128, (bf16_t*)(p->ws + WS_WGA_T) + hd * 16384, scr, r % 8, lane); continue; } r -= I_G;
        { const int hd = r / 8; transpose_item(p->in[I_WGI] + hd * 16384, 128, 128, (bf16_t*)(p->ws + WS_WGI_T) + hd * 16384, scr, r % 8, lane); }
    }
    bf16_t* wsp = (bf16_t*)(p->ws + WS_WSPB); bf16_t* skb = (bf16_t*)(p->ws + WS_SKEYB);
    for (int e = bid * NT + tid; e < 8 * 128 * 128; e += nb * NT) { const int i = (e >> 7) & 127, j = e & 127; wsp[e] = f2bf(j <= i ? p->in[I_WSP][e] : 0.f); }
    for (int e = bid * NT + tid; e < 8 * 2 * 128 * 128; e += nb * NT) skb[e] = f2bf(p->in[I_SKEY][e]);
}

typedef short bf16x8_t __attribute__((ext_vector_type(8)));
typedef float f32x4_t __attribute__((ext_vector_type(4)));
typedef short s16x4_t __attribute__((ext_vector_type(4)));
constexpr float YMIX_SCALE = 8.f;
constexpr int XA_STRIDE = 272;
constexpr int LRU_XA = 0, LRU_SA = 34816, LRU_SB = LRU_SA + 16384, LRU_SEGP = LRU_SB + 16384, LRU_SEGH = LRU_SEGP + 2048, LRU_WF = LRU_SEGH + 2048;
__device__ __forceinline__ void phase_lru(KP p, unsigned char* lds, int bid, int nb, int wv_) {
    const int tid = opaque_tid(), lane = tid & 63, wave = tid >> 6, c16 = lane & 15, q = lane >> 4;
    const bf16_t* XL = (const bf16_t*)(p->ws + WS_PROJ); const bf16_t* YG = XL + (size_t)M * 1024; bf16_t* ymix = (bf16_t*)(p->ws + WS_YMIX);
    float* SA = (float*)(lds + LRU_SA); float* SB = (float*)(lds + LRU_SB); float* SEGP = (float*)(lds + LRU_SEGP); float* SEGH = (float*)(lds + LRU_SEGH);
    for (int unit = bid; unit < NB * 8 * 4; unit += nb) {
        const int b = unit >> 5, hd = (unit >> 2) & 7, cq = unit & 3;
        for (int i = tid; i < 2 * 32 * 16; i += NT) { const int gs = i >> 9, j = (i >> 4) & 31, o16 = i & 15;
            *(uint4*)(lds + LRU_WF + (gs * 32 + j) * XA_STRIDE + o16 * 16) = *(const uint4*)((const bf16_t*)(p->ws + (gs ? WS_WGI_T : WS_WGA_T)) + (size_t)(hd * 128 + cq * 32 + j) * 128 + o16 * 8); }
        float ba[2], bi[2], c2[2];
#pragma unroll
        for (int nt = 0; nt < 2; ++nt) { const int ch = hd * 128 + cq * 32 + nt * 16 + c16; ba[nt] = p->in[I_BGA][ch]; bi[nt] = p->in[I_BGI][ch];
            const float lam = p->in[I_LAM][ch]; const float sp = fmaxf(-lam, 0.f) + log1pf(__expf(-fabsf(lam))); c2[nt] = -8.f * sp * 1.4426950408889634f; }
        const int o = tid & 15, rg = tid >> 4;
        float cw[4][8], cb[8];
#pragma unroll
        for (int e = 0; e < 8; ++e) { cb[e] = p->in[I_CONVB][hd * 128 + o * 8 + e];
#pragma unroll
            for (int k = 0; k < 4; ++k) cw[k][e] = p->in[I_CONVW][k * DLRU + hd * 128 + o * 8 + e]; }
        const int sc = tid & 31, seg = tid >> 5;
        float carry = 0.f;
        uint4 xr[7];
#define LRU_LOAD_X(t0_) do { _Pragma("unroll") for (int i = 0; i < 7; ++i) { const int t = (t0_) + 4 * rg - 3 + i; const int tc = t < 0 ? 0 : t; const unsigned keep = t < 0 ? 0u : 0xffffffffu; \
            const uint4 w = *(const uint4*)(XL + ((size_t)b * SEQ + tc) * 1024 + hd * 128 + o * 8); xr[i] = make_uint4(w.x & keep, w.y & keep, w.z & keep, w.w & keep); } } while (0)
        LRU_LOAD_X(0);
        for (int ch = 0; ch < SEQ / 128; ++ch) {
            const int t0 = ch * 128; const size_t row0 = (size_t)b * SEQ + t0;
            bf16_t yg[8];
#pragma unroll
            for (int k = 0; k < 8; ++k) yg[k] = YG[(row0 + seg * 8 + k) * 1024 + hd * 128 + cq * 32 + sc];
#pragma unroll
            for (int r = 0; r < 4; ++r) {
                float acc8[8];
#pragma unroll
                for (int e = 0; e < 8; ++e) acc8[e] = cb[e];
#pragma unroll
                for (int k = 0; k < 4; ++k) { const uint4 w = xr[r + k]; const unsigned ww[4] = {w.x, w.y, w.z, w.w};
#pragma unroll
                    for (int e2 = 0; e2 < 4; ++e2) { acc8[2 * e2] += cw[k][2 * e2] * __uint_as_float(ww[e2] << 16); acc8[2 * e2 + 1] += cw[k][2 * e2 + 1] * __uint_as_float(ww[e2] & 0xffff0000u); } }
                uint4 ov; ov.x = pk2(acc8[0], acc8[1]); ov.y = pk2(acc8[2], acc8[3]); ov.z = pk2(acc8[4], acc8[5]); ov.w = pk2(acc8[6], acc8[7]);
                *(uint4*)(lds + LRU_XA + (4 * rg + r) * XA_STRIDE + o * 16) = ov;
            }
            if (ch + 1 < SEQ / 128) LRU_LOAD_X(t0 + 128);
            __syncthreads();
            f32x4_t acc[2][2];
#pragma unroll
            for (int gs = 0; gs < 2; ++gs)
#pragma unroll
                for (int nt = 0; nt < 2; ++nt) acc[gs][nt] = (f32x4_t){0.f, 0.f, 0.f, 0.f};
#pragma unroll
            for (int ks = 0; ks < 4; ++ks) {
                const bf16x8_t a = *(const bf16x8_t*)(lds + LRU_XA + (16 * wave + c16) * XA_STRIDE + (ks * 32 + 8 * q) * 2);
#pragma unroll
                for (int gs = 0; gs < 2; ++gs)
#pragma unroll
                    for (int nt = 0; nt < 2; ++nt) { const bf16x8_t wfr = *(const bf16x8_t*)(lds + LRU_WF + (gs * 32 + nt * 16 + c16) * XA_STRIDE + (ks * 32 + 8 * q) * 2);
                        acc[gs][nt] = __builtin_amdgcn_mfma_f32_16x16x32_bf16(a, wfr, acc[gs][nt], 0, 0, 0); }
            }
#pragma unroll
            for (int nt = 0; nt < 2; ++nt)
#pragma unroll
                for (int reg = 0; reg < 4; ++reg) {
                    const int t = 16 * wave + 4 * q + reg, jj = nt * 16 + c16;
                    const float za = acc[0][nt][reg] + ba[nt], zi = acc[1][nt][reg] + bi[nt];
                    const float r = __builtin_amdgcn_rcpf(1.f + __expf(-za)), ig = __builtin_amdgcn_rcpf(1.f + __expf(-zi));
                    const float a = __builtin_amdgcn_exp2f(c2[nt] * r);
                    const float xcv = bf2f(*(const bf16_t*)(lds + LRU_XA + t * XA_STRIDE + (cq * 32 + jj) * 2));
                    SA[t * 32 + jj] = a; SB[t * 32 + jj] = __builtin_amdgcn_sqrtf(fmaxf(1.f - a * a, 0.f)) * (ig * xcv);
                }
            __syncthreads();
            float av[8], bv[8];
#pragma unroll
            for (int k = 0; k < 8; ++k) { av[k] = SA[(seg * 8 + k) * 32 + sc]; bv[k] = SB[(seg * 8 + k) * 32 + sc]; }
            float P = 1.f, H = 0.f;
#pragma unroll
            for (int k = 0; k < 8; ++k) { H = av[k] * H + bv[k]; P *= av[k]; }
            SEGP[seg * 32 + sc] = P; SEGH[seg * 32 + sc] = H;
            __syncthreads();
            float run = carry, hin = carry;
            int segl = seg; asm volatile("" : "+v"(segl));
#pragma unroll
            for (int s = 0; s < 16; ++s) { if (s == segl) hin = run; run = SEGP[s * 32 + sc] * run + SEGH[s * 32 + sc]; }
            carry = run;
            H = hin;
#pragma unroll
            for (int k = 0; k < 8; ++k) { H = av[k] * H + bv[k]; ((unsigned char*)ymix)[(row0 + seg * 8 + k) * D + hd * 128 + cq * 32 + sc] = (unsigned char)(pk4_fp8(H * bf2f(yg[k]) * YMIX_SCALE, 0.f, 0.f, 0.f) & 0xffu); }
        }
        __syncthreads();
#undef LRU_LOAD_X
    }
}

constexpr int SGU_RS = 0, SGU_TV = 512, SGU_SS = SGU_TV + 128 * XA_STRIDE, SS_STRIDE = 132;
__device__ __forceinline__ void phase_sgu(KP p, unsigned char* lds, int bid, int nb, int wv_) {
    const int tid = opaque_tid(), lane = tid & 63, wave = tid >> 6, c16 = lane & 15, q = lane >> 4;
    const bf16_t* UG = (const bf16_t*)(p->ws + WS_PROJ) + (size_t)2 * M * 1024; const bf16_t* VG = UG + (size_t)M * 1024;
    const float* ssqv = (const float*)(p->ws + WS_SSQV); bf16_t* ymix = (bf16_t*)(p->ws + WS_YMIX);
    float* RS = (float*)(lds + SGU_RS); float* SS = (float*)(lds + SGU_SS);
    bf16x8_t wa[8][4]; float gvv[8]; int gcur = -1;
    const int oct = tid & 15;
    for (int it = bid; it < NB * 16 * 8; it += nb) {
        const int g = it & 7; const size_t base = (size_t)(it >> 3) * 128;
        if (g != gcur) { gcur = g;
#pragma unroll
            for (int mt = 0; mt < 8; ++mt)
#pragma unroll
                for (int ks = 0; ks < 4; ++ks) if (ks <= ((16 * mt + 15) >> 5))
                    wa[mt][ks] = *(const bf16x8_t*)((const bf16_t*)(p->ws + WS_WSPB) + ((size_t)(g * 128 + mt * 16 + c16) * 128 + ks * 32 + 8 * q));
#pragma unroll
            for (int e = 0; e < 8; ++e) gvv[e] = p->in[I_GV][g * 128 + oct * 8 + e]; }
        uint4 vch[4], uch[4];
#pragma unroll
        for (int k = 0; k < 4; ++k) { const int row = (tid >> 4) + 32 * k; vch[k] = *(const uint4*)(VG + (base + row) * 1024 + g * 128 + oct * 8); uch[k] = *(const uint4*)(UG + (base + row) * 1024 + g * 128 + oct * 8); }
        if (tid < 128) { float ss = 0.f;
#pragma unroll
            for (int k = 0; k < 16; ++k) ss += ssqv[(base + tid) * 16 + k];
            RS[tid] = rsqrtf(ss * (1.f / 1024.f) + EPS); }
        __syncthreads();
#pragma unroll
        for (int k = 0; k < 4; ++k) { const int row = (tid >> 4) + 32 * k; const float r = RS[row]; const unsigned ww[4] = {vch[k].x, vch[k].y, vch[k].z, vch[k].w}; unsigned oo[4];
#pragma unroll
            for (int e2 = 0; e2 < 4; ++e2) oo[e2] = pk2(__uint_as_float(ww[e2] << 16) * r * gvv[2 * e2], __uint_as_float(ww[e2] & 0xffff0000u) * r * gvv[2 * e2 + 1]);
            *(uint4*)(lds + SGU_TV + row * XA_STRIDE + oct * 16) = make_uint4(oo[0], oo[1], oo[2], oo[3]); }
        __syncthreads();
        bf16x8_t bfr[4];
        { const int q4 = c16 >> 2, p4 = c16 & 3;
#pragma unroll
          for (int ks = 0; ks < 4; ++ks) {
              const unsigned a1 = SGU_TV + (ks * 32 + 8 * q + q4) * XA_STRIDE + (wave * 16 + 4 * p4) * 2;
              const s16x4_t lo = __builtin_amdgcn_ds_read_tr16_b64_v4i16((LAS s16x4_t*)(lds + a1));
              const s16x4_t hi = __builtin_amdgcn_ds_read_tr16_b64_v4i16((LAS s16x4_t*)(lds + a1 + 4 * XA_STRIDE));
              bfr[ks] = __builtin_shufflevector(lo, hi, 0, 1, 2, 3, 4, 5, 6, 7); } }
        f32x4_t acc[8];
#pragma unroll
        for (int mt = 0; mt < 8; ++mt) { acc[mt] = (f32x4_t){0.f, 0.f, 0.f, 0.f};
#pragma unroll
            for (int ks = 0; ks < 4; ++ks) if (ks <= ((16 * mt + 15) >> 5)) acc[mt] = __builtin_amdgcn_mfma_f32_16x16x32_bf16(wa[mt][ks], bfr[ks], acc[mt], 0, 0, 0); }
#pragma unroll
        for (int mt = 0; mt < 8; ++mt)
#pragma unroll
            for (int reg = 0; reg < 4; ++reg) { const int i = mt * 16 + 4 * q + reg; SS[i * SS_STRIDE + wave * 16 + c16] = acc[mt][reg] + p->in[I_BSP][g * 128 + i]; }
        __syncthreads();
#pragma unroll
        for (int k = 0; k < 4; ++k) { const int row = (tid >> 4) + 32 * k; const float4 s0 = *(const float4*)(SS + row * SS_STRIDE + oct * 8), s1 = *(const float4*)(SS + row * SS_STRIDE + oct * 8 + 4);
            const unsigned ww[4] = {uch[k].x, uch[k].y, uch[k].z, uch[k].w}; const float sv[8] = {s0.x, s0.y, s0.z, s0.w, s1.x, s1.y, s1.z, s1.w}; unsigned oo[4];
#pragma unroll
            for (int e2 = 0; e2 < 2; ++e2) oo[e2] = pk4_fp8(__uint_as_float(ww[2 * e2] << 16) * sv[4 * e2] * YMIX_SCALE, __uint_as_float(ww[2 * e2] & 0xffff0000u) * sv[4 * e2 + 1] * YMIX_SCALE,
                                                          __uint_as_float(ww[2 * e2 + 1] << 16) * sv[4 * e2 + 2] * YMIX_SCALE, __uint_as_float(ww[2 * e2 + 1] & 0xffff0000u) * sv[4 * e2 + 3] * YMIX_SCALE);
            *(uint2*)((unsigned char*)ymix + (base + row) * D + 1024 + g * 128 + oct * 8) = make_uint2(oo[0], oo[1]); }
        __syncthreads();
    }
}

typedef float f32x16_t __attribute__((ext_vector_type(16)));
__device__ __forceinline__ float vmaxf(float a, float b) { float r; asm("v_max_f32 %0, %1, %2" : "=v"(r) : "v"(a), "v"(b)); return r; }
__device__ __forceinline__ float vminf(float a, float b) { float r; asm("v_min_f32 %0, %1, %2" : "=v"(r) : "v"(a), "v"(b)); return r; }
#define CE_DESC(a, b) do { const float _mx = vmaxf(a, b), _mn = vminf(a, b); a = _mx; b = _mn; } while (0)
__device__ __forceinline__ void sort16_desc(float (&v)[16]) {
#pragma unroll
    for (int k = 2; k <= 16; k <<= 1)
#pragma unroll
        for (int j = k >> 1; j > 0; j >>= 1)
#pragma unroll
            for (int i = 0; i < 16; ++i) { const int l = i ^ j; if (l > i) { if ((i & k) == 0) CE_DESC(v[i], v[l]); else CE_DESC(v[l], v[i]); } }
}
__device__ __forceinline__ void merge16_desc(float (&a)[16], const float (&b)[16]) {
#pragma unroll
    for (int i = 0; i < 16; ++i) a[i] = vmaxf(a[i], b[15 - i]);
#pragma unroll
    for (int j = 8; j > 0; j >>= 1)
#pragma unroll
        for (int i = 0; i < 16; ++i) { const int l = i ^ j; if (l > i) CE_DESC(a[i], a[l]); }
}
__device__ __forceinline__ void topk_half(const bf16_t* qp, const unsigned char* kl, unsigned hh4, float (&X)[16]) {
    f32x16_t acc[4];
#pragma unroll
    for (int kt = 0; kt < 4; ++kt)
#pragma unroll
        for (int i = 0; i < 16; ++i) acc[kt][i] = 0.f;
#pragma unroll 4
    for (int ks = 0; ks < 8; ++ks) {
        const bf16x8_t bq = *(const bf16x8_t*)(qp + ks * 16);
#pragma unroll
        for (int kt = 0; kt < 4; ++kt) { const bf16x8_t ak = *(const bf16x8_t*)(kl + kt * 32 * XA_STRIDE + ks * 32); acc[kt] = __builtin_amdgcn_mfma_f32_32x32x16_bf16(ak, bq, acc[kt], 0, 0, 0); }
    }
    float g[4][16];
#pragma unroll
    for (int kt = 0; kt < 4; ++kt)
#pragma unroll
        for (int reg = 0; reg < 16; ++reg) g[kt][reg] = __uint_as_float(((__float_as_uint(acc[kt][reg]) & 0xFFFFFF80u) | hh4) | (unsigned)(kt * 32 + (reg & 3) + 8 * (reg >> 2)));
    sort16_desc(g[0]); sort16_desc(g[1]); __builtin_amdgcn_sched_barrier(0); merge16_desc(g[0], g[1]); __builtin_amdgcn_sched_barrier(0);
    sort16_desc(g[2]); sort16_desc(g[3]); __builtin_amdgcn_sched_barrier(0); merge16_desc(g[2], g[3]); __builtin_amdgcn_sched_barrier(0); merge16_desc(g[0], g[2]);
#pragma unroll
    for (int i = 0; i < 16; ++i) X[i] = g[0][i];
}
__device__ __forceinline__ unsigned pack_b0(float a, float b, float c, float d) {
    const unsigned ab = __builtin_amdgcn_perm(__float_as_uint(b), __float_as_uint(a), 0x0c0c0400u), cd = __builtin_amdgcn_perm(__float_as_uint(d), __float_as_uint(c), 0x0c0c0400u);
    return __builtin_amdgcn_perm(cd, ab, 0x05040100u);
}
__device__ __forceinline__ unsigned byte_lookup(const unsigned (&pk)[4], unsigned e) {
    const unsigned lo = __builtin_amdgcn_perm(pk[1], pk[0], e & 7u), hi = __builtin_amdgcn_perm(pk[3], pk[2], e & 7u);
    return ((e & 8u) ? hi : lo) & 0x7Fu;
}
__device__ __forceinline__ void phase_topk(KP p, unsigned char* lds, int bid, int nb, int wv_) {
    const int tid = opaque_tid(), lane = tid & 63, wave = tid >> 6, r32 = lane & 31, hh = lane >> 5;
    const bf16_t* Q = (const bf16_t*)(p->ws + WS_Q); const bf16_t* KB = (const bf16_t*)(p->ws + WS_SKEYB);
    int* idx = (int*)(p->ws + WS_IDX); float* gate = (float*)(p->ws + WS_GATE);
    const float NEG = -3.0e38f;
    int hcur = -1;
    for (int bi = bid; bi < NHEAD * (M / 256); bi += nb) {
        const int hd = bi & 7, tile = (bi >> 3) * 8 + wave; const size_t token = (size_t)tile * 32 + r32;
        if (hd != hcur) { hcur = hd; __syncthreads();
#pragma unroll
            for (int k = 0; k < 8; ++k) { const int c = tid + NT * k, row = c >> 4, o = c & 15;
                *(uint4*)(lds + row * XA_STRIDE + o * 16) = *(const uint4*)(KB + ((size_t)hd * 256 + row) * 128 + o * 8); }
            __syncthreads(); }
        float X0[16], X1[16];
        topk_half(Q + token * D + hd * 256 + 8 * hh, lds + r32 * XA_STRIDE + hh * 16, 4u * hh, X0);
        __builtin_amdgcn_sched_barrier(0);
        topk_half(Q + token * D + hd * 256 + 128 + 8 * hh, lds + (128 + r32) * XA_STRIDE + hh * 16, 4u * hh, X1);
        __builtin_amdgcn_sched_barrier(0);
#pragma unroll
        for (int i = 0; i < 16; ++i) { const auto r = __builtin_amdgcn_permlane32_swap(__float_as_uint(X0[i]), __float_as_uint(X1[i]), false, false); X0[i] = __uint_as_float(r[0]); X1[i] = __uint_as_float(r[1]); }
        merge16_desc(X0, X1);
        float U[16];
#pragma unroll
        for (int i = 0; i < 16; ++i) U[i] = __shfl_xor(X0[i], 32);
        const unsigned hbit = (unsigned)hh << 8;
        float c0[16], c1[16];
#pragma unroll
        for (int j = 0; j < 16; ++j) { float s = X0[0] + U[j]; if (j == 0) s = hh ? NEG : s; c0[j] = __uint_as_float(((__float_as_uint(s) & 0xFFFFFE00u) | hbit) | (unsigned)j); }
        {
            int n = 0;
#pragma unroll
            for (int i = 1; i < 4; ++i)
#pragma unroll
                for (int j = i; j < 16; ++j) if ((i + 1) * (j + 1) <= 16) { float s = X0[i] + U[j]; if (j == i) s = hh ? NEG : s; c1[n] = __uint_as_float(((__float_as_uint(s) & 0xFFFFFE00u) | hbit) | (unsigned)(i * 16 + j)); ++n; }
#pragma unroll
            for (int k = 11; k < 16; ++k) c1[k] = NEG;
        }
        sort16_desc(c0); sort16_desc(c1); merge16_desc(c0, c1);
        float F[16];
#pragma unroll
        for (int i = 0; i < 16; ++i) F[i] = vmaxf(c0[i], __shfl_xor(c0[15 - i], 32));
        float mx = F[0];
#pragma unroll
        for (int i = 1; i < 16; ++i) mx = vmaxf(mx, F[i]);
        float ev[16], sum = 0.f;
#pragma unroll
        for (int i = 0; i < 16; ++i) { ev[i] = __expf(F[i] - mx); sum += ev[i]; }
        const float inv = 1.f / sum;
        unsigned pt[4], pu[4], pa[4], pb[4];
#pragma unroll
        for (int w = 0; w < 4; ++w) { pt[w] = pack_b0(X0[4 * w], X0[4 * w + 1], X0[4 * w + 2], X0[4 * w + 3]); pu[w] = pack_b0(U[4 * w], U[4 * w + 1], U[4 * w + 2], U[4 * w + 3]); }
#pragma unroll
        for (int w = 0; w < 4; ++w) { pa[w] = hh ? pu[w] : pt[w]; pb[w] = hh ? pt[w] : pu[w]; }
        int oi[8]; float og[8];
#pragma unroll
        for (int k = 0; k < 8; ++k) {
            const unsigned pl = __float_as_uint(F[k]) & 0x1FFu, sw = pl >> 8, pi = (pl >> 4) & 15u, pj = pl & 15u;
            const unsigned ai = sw ? pj : pi, bj = sw ? pi : pj;
            oi[k] = (int)(byte_lookup(pa, ai) * NKEYS + byte_lookup(pb, bj)); og[k] = ev[k] * inv;
        }
        int* io = idx + token * NSEL + hd * TOPK + 8 * hh; float* go = gate + token * NSEL + hd * TOPK + 8 * hh;
        { typedef __fp16 h2v_ __attribute__((ext_vector_type(2)));
          const h2v_ g0 = __builtin_amdgcn_cvt_pkrtz(og[0], og[1]), g1 = __builtin_amdgcn_cvt_pkrtz(og[2], og[3]), g2 = __builtin_amdgcn_cvt_pkrtz(og[4], og[5]), g3 = __builtin_amdgcn_cvt_pkrtz(og[6], og[7]);
          *(uint4*)((unsigned short*)(p->ws + WS_GATE) + token * NSEL + hd * TOPK + 8 * hh) = make_uint4(__builtin_bit_cast(unsigned, g0), __builtin_bit_cast(unsigned, g1), __builtin_bit_cast(unsigned, g2), __builtin_bit_cast(unsigned, g3)); }
        *(uint4*)(p->ws + WS_IDXT + ((((size_t)(token >> 6) * 16 + 2 * hd + hh) * 64 + (token & 63)) * 16)) = make_uint4((unsigned)oi[0] | ((unsigned)oi[1] << 16), (unsigned)oi[2] | ((unsigned)oi[3] << 16), (unsigned)oi[4] | ((unsigned)oi[5] << 16), (unsigned)oi[6] | ((unsigned)oi[7] << 16));
    }
}

__device__ __forceinline__ void wave_argmax(float& v, int& i) {
#pragma unroll
    for (int off = 32; off >= 1; off >>= 1) { const float ov = __shfl_xor(v, off); const int oi = __shfl_xor(i, off); if (ov > v || (ov == v && oi < i)) { v = ov; i = oi; } }
}
__device__ __forceinline__ void topk_half_naive(const bf16_t* q, const float* k0, int lane, float& outv, int& outi) {
    const float NEG = -3.0e38f;
    const float* k1 = k0 + 64 * 128;
    float s0 = 0.f, s1 = 0.f;
    for (int k = 0; k < 128; k += 4) {
        const uint2 qq = *(const uint2*)(q + k);
        const float q0 = bf2f((bf16_t)(qq.x & 0xffff)), q1 = bf2f((bf16_t)(qq.x >> 16)), q2 = bf2f((bf16_t)(qq.y & 0xffff)), q3 = bf2f((bf16_t)(qq.y >> 16));
        const float4 a = *(const float4*)(k0 + k), b = *(const float4*)(k1 + k);
        s0 += q0 * a.x + q1 * a.y + q2 * a.z + q3 * a.w; s1 += q0 * b.x + q1 * b.y + q2 * b.z + q3 * b.w;
    }
    float myv = NEG; int myi = 0;
    for (int r = 0; r < TOPK; ++r) {
        float v; int i; if (s0 >= s1) { v = s0; i = lane; } else { v = s1; i = lane + 64; }
        wave_argmax(v, i);
        if (i == lane) s0 = NEG; if (i == lane + 64) s1 = NEG;
        if (lane == r) { myv = v; myi = i; }
    }
    outv = myv; outi = myi;
}
__device__ __forceinline__ void phase_topk_naive(KP p, int bid, int nb, int wv_) {
    const bf16_t* Q = (const bf16_t*)(p->ws + WS_Q); const float* keys = p->in[I_SKEY];
    int* idx = (int*)(p->ws + WS_IDX); float* gate = (float*)(p->ws + WS_GATE);
    const int tid = opaque_tid(), lane = tid & 63, wave = tid >> 6;
    const float NEG = -3.0e38f;
    for (int task = bid * 8 + wave; task < M * NHEAD; task += nb * 8) {
        const int token = task >> 3, hd = task & 7;
        float tv0, tv1; int ti0, ti1;
        topk_half_naive(Q + (size_t)token * D + hd * 256, keys + ((size_t)(hd * 2) * 128 + lane) * 128, lane, tv0, ti0);
        topk_half_naive(Q + (size_t)token * D + hd * 256 + 128, keys + ((size_t)(hd * 2 + 1) * 128 + lane) * 128, lane, tv1, ti1);
        const float vb = __shfl(tv1, lane & 15);
        float c0 = __shfl(tv0, (lane >> 4)) + vb, c1 = __shfl(tv0, (lane >> 4) + 4) + vb, c2 = __shfl(tv0, (lane >> 4) + 8) + vb, c3 = __shfl(tv0, (lane >> 4) + 12) + vb;
        float selv = NEG; int selc = 0;
        for (int r = 0; r < TOPK; ++r) {
            float v = c0; int i = lane;
            if (c1 > v) { v = c1; i = lane + 64; }
            if (c2 > v) { v = c2; i = lane + 128; }
            if (c3 > v) { v = c3; i = lane + 192; }
            wave_argmax(v, i);
            if (i == lane) c0 = NEG; if (i == lane + 64) c1 = NEG; if (i == lane + 128) c2 = NEG; if (i == lane + 192) c3 = NEG;
            if (lane == r) { selv = v; selc = i; }
        }
        const float mx = __shfl(selv, 0);
        const float e = lane < TOPK ? __expf(selv - mx) : 0.f;
        const float sum = wave_sum(e);
        const int i1 = __shfl(ti0, selc >> 4), i2 = __shfl(ti1, selc & 15);
        if (lane < TOPK) { idx[(size_t)token * NSEL + hd * TOPK + lane] = i1 * NKEYS + i2; gate[(size_t)token * NSEL + hd * TOPK + lane] = e / sum; }
    }
}

typedef float f32x2_t __attribute__((ext_vector_type(2)));
constexpr size_t GRP_BYTES = (size_t)NKEYS * NKEYS * 128;
constexpr int NGRP = D / 128;
constexpr size_t VSL_BYTES = (size_t)NKEYS * NKEYS * 8;
constexpr int NVSL = D / 8;
__device__ __forceinline__ void phase_convert_experts(KP p, int bid, int nb, int wv_) {
    const int tid = opaque_tid(), lane = tid & 63, wave = tid >> 6;
    constexpr int PITCH = D + 16;
    LAS unsigned char* tile = dyn_lds_base();
    __syncthreads();
    for (int rb = bid; rb < 2 * NKEYS * NKEYS / 16; rb += nb) {
        const int t = rb * 16 >= NKEYS * NKEYS;
#pragma unroll 1
        for (int i2 = 0; i2 < 2; ++i2) {
            const int r16 = wave * 2 + i2, row = rb * 16 + r16, e = row - t * NKEYS * NKEYS;
            const float* src = (t ? p->in[I_EV] : p->in[I_EU]) + (size_t)e * D;
            float4 v[8]; float am = 0.f;
#pragma unroll
            for (int j = 0; j < 8; ++j) { v[j] = *(const float4*)(src + lane * 4 + 256 * j); am = fmaxf(am, fmaxf(fmaxf(fabsf(v[j].x), fabsf(v[j].y)), fmaxf(fabsf(v[j].z), fabsf(v[j].w)))); }
            am = wave_max(am);
            const float sc = am > 0.f ? 127.f / am : 0.f;
#pragma unroll
            for (int j = 0; j < 8; ++j) *(LAS unsigned*)(tile + r16 * PITCH + lane * 4 + 256 * j) = pk4_i8(v[j].x * sc, v[j].y * sc, v[j].z * sc, v[j].w * sc);
            if (lane == 0) ((float*)(p->ws + WS_ESCALE))[row] = am * (1.f / 127.f);
        }
        {
            __syncthreads();
            const int e0 = rb * 16 - t * NKEYS * NKEYS, pc = tid & 7;
#pragma unroll
            for (int rd = 0; rd < 4; ++rd) { const int slc = rd * 64 + (tid >> 3);
                const v2u_t lo = *(LAS const v2u_t*)(tile + (2 * pc) * PITCH + slc * 8), hi = *(LAS const v2u_t*)(tile + (2 * pc + 1) * PITCH + slc * 8);
                *(uint4*)(p->ws + (t ? WS_EV8 : WS_EU8) + (size_t)slc * VSL_BYTES + (size_t)(e0 + 2 * pc) * 8) = make_uint4(lo[0], lo[1], hi[0], hi[1]); }
            __syncthreads();
        }
    }
}
__device__ __forceinline__ unsigned xb_xcc_id();
constexpr int PEER_TT = 16;
constexpr int PEER_NTILE = M / PEER_TT;
constexpr int CW_UQ = 4096, CW_VQ = 8192;
__device__ __forceinline__ float dpp_xor1(float v) { return __builtin_bit_cast(float, __builtin_amdgcn_update_dpp(0, __builtin_bit_cast(int, v), 0xB1, 0xF, 0xF, true)); }
__device__ __forceinline__ float dpp_xor2(float v) { return __builtin_bit_cast(float, __builtin_amdgcn_update_dpp(0, __builtin_bit_cast(int, v), 0x4E, 0xF, 0xF, true)); }
__device__ __forceinline__ float dpp_hmirror(float v) { return __builtin_bit_cast(float, __builtin_amdgcn_update_dpp(0, __builtin_bit_cast(int, v), 0x141, 0xF, 0xF, true)); }
__device__ __forceinline__ void pg_load_ids(const unsigned short* idx16, size_t token, int k, unsigned c16, unsigned (&off)[16]) {
#pragma unroll
    for (int i = 0; i < 2; ++i) { const uint4 v = *(const uint4*)(idx16 + token * NSEL + 16 * k + 8 * i); const unsigned w[4] = {v.x, v.y, v.z, v.w};
#pragma unroll
        for (int j = 0; j < 4; ++j) { off[8 * i + 2 * j] = ((w[j] & 0xffffu) << 7) + c16; off[8 * i + 2 * j + 1] = ((w[j] >> 16) << 7) + c16; } }
}
__device__ __forceinline__ void pg_load_lines(const unsigned char* tg, const unsigned (&off)[16], uint4 (&r)[16]) {
#pragma unroll
    for (int j = 0; j < 16; ++j) r[j] = *(const uint4*)(tg + off[j]);
}
typedef _Float16 h2_t __attribute__((ext_vector_type(2)));
__device__ __forceinline__ int dppi(int v, int ctrl_sel) { return ctrl_sel == 0 ? __builtin_amdgcn_update_dpp(0, v, 0xB1, 0xF, 0xF, true) : ctrl_sel == 1 ? __builtin_amdgcn_update_dpp(0, v, 0x4E, 0xF, 0xF, true) : __builtin_amdgcn_update_dpp(0, v, 0x141, 0xF, 0xF, true); }
__device__ __forceinline__ int dot4_0(int a, int b) { int d; asm("v_dot4_i32_i8 %0, %1, %2, 0" : "=v"(d) : "v"(a), "v"(b)); return d; }
__device__ __forceinline__ void pg_compute_u(const uint4 (&r)[16], const uint4 (&hw)[2], short* po, int c) {
    int d[16];
#pragma unroll
    for (int j = 0; j < 16; ++j) { int s = 0; s = __builtin_amdgcn_sdot4((int)r[j].x, (int)hw[0].x, s, false); s = __builtin_amdgcn_sdot4((int)r[j].y, (int)hw[0].y, s, false); s = __builtin_amdgcn_sdot4((int)r[j].z, (int)hw[0].z, s, false); s = __builtin_amdgcn_sdot4((int)r[j].w, (int)hw[0].w, s, false); d[j] = s; }
#pragma unroll
    for (int j = 0; j < 16; ++j) d[j] += dppi(d[j], 0);
#pragma unroll
    for (int j = 0; j < 16; ++j) d[j] += dppi(d[j], 1);
#pragma unroll
    for (int j = 0; j < 16; ++j) d[j] += dppi(d[j], 2);
    int p0 = 0, p1 = 0;
#pragma unroll
    for (int j = 0; j < 8; ++j) { p0 = (c == j) ? d[2 * j] : p0; p1 = (c == j) ? d[2 * j + 1] : p1; }
    *(unsigned*)po = ((unsigned)((p0 + 32) >> 6) & 0xffffu) | ((unsigned)((p1 + 32) >> 6) << 16);
}
__device__ __forceinline__ void pg_compute_v(const uint4 (&r)[16], const f32x4_t (&aw)[4], const float* xo, unsigned* yo, const float* gtp, float* ssp, float asc, int k, int lane) {
    int acc[16];
#pragma unroll
    for (int m = 0; m < 16; ++m) acc[m] = 0;
    const uint4 a16 = __builtin_bit_cast(uint4, aw[0]); const unsigned aa[4] = {a16.x, a16.y, a16.z, a16.w};
#pragma unroll
    for (int jq = 0; jq < 4; ++jq) {
        const unsigned rr[4][4] = {{r[4 * jq].x, r[4 * jq].y, r[4 * jq].z, r[4 * jq].w}, {r[4 * jq + 1].x, r[4 * jq + 1].y, r[4 * jq + 1].z, r[4 * jq + 1].w},
                                   {r[4 * jq + 2].x, r[4 * jq + 2].y, r[4 * jq + 2].z, r[4 * jq + 2].w}, {r[4 * jq + 3].x, r[4 * jq + 3].y, r[4 * jq + 3].z, r[4 * jq + 3].w}};
#pragma unroll
        for (int cc = 0; cc < 4; ++cc) {
            const unsigned t0 = __builtin_amdgcn_perm(rr[1][cc], rr[0][cc], 0x05010400u), t1 = __builtin_amdgcn_perm(rr[1][cc], rr[0][cc], 0x07030602u);
            const unsigned t2 = __builtin_amdgcn_perm(rr[3][cc], rr[2][cc], 0x05010400u), t3 = __builtin_amdgcn_perm(rr[3][cc], rr[2][cc], 0x07030602u);
            acc[4 * cc + 0] = __builtin_amdgcn_sdot4((int)__builtin_amdgcn_perm(t2, t0, 0x05040100u), (int)aa[jq], acc[4 * cc + 0], false);
            acc[4 * cc + 1] = __builtin_amdgcn_sdot4((int)__builtin_amdgcn_perm(t2, t0, 0x07060302u), (int)aa[jq], acc[4 * cc + 1], false);
            acc[4 * cc + 2] = __builtin_amdgcn_sdot4((int)__builtin_amdgcn_perm(t3, t1, 0x05040100u), (int)aa[jq], acc[4 * cc + 2], false);
            acc[4 * cc + 3] = __builtin_amdgcn_sdot4((int)__builtin_amdgcn_perm(t3, t1, 0x07060302u), (int)aa[jq], acc[4 * cc + 3], false);
        }
    }
    int b8[8];
#pragma unroll
    for (int m = 0; m < 8; ++m) { const int u = acc[m] + __builtin_amdgcn_update_dpp(0, acc[m], 0x128, 0xF, 0xF, true), w = acc[8 + m] + __builtin_amdgcn_update_dpp(0, acc[8 + m], 0x128, 0xF, 0xF, true); b8[m] = (k & 1) ? w : u; }
    int b4[4];
#pragma unroll
    for (int m = 0; m < 4; ++m) { const auto r = __builtin_amdgcn_permlane16_swap((unsigned)b8[m], (unsigned)b8[4 + m], false, false); b4[m] = (int)(r[0] + r[1]); }
    int o2[2];
#pragma unroll
    for (int m = 0; m < 2; ++m) { const auto r = __builtin_amdgcn_permlane32_swap((unsigned)b4[m], (unsigned)b4[2 + m], false, false); o2[m] = (int)(r[0] + r[1]); }
    const float2 gt = *(const float2*)gtp;
    const float y0 = aw[1][1] + gt.x * ((float)o2[0] * asc), y1 = aw[1][2] + gt.y * ((float)o2[1] * asc);
    *yo = pk2(y0, y1);
    float ss = y0 * y0 + y1 * y1;
    ss += dpp_xor1(ss); ss += dpp_xor2(ss); ss += dpp_hmirror(ss);
    ss += __builtin_bit_cast(float, __builtin_amdgcn_update_dpp(0, __builtin_bit_cast(int, ss), 0x140, 0xF, 0xF, true));
    { const auto r = __builtin_amdgcn_permlane16_swap(__float_as_uint(ss), __float_as_uint(ss), false, false); ss = __uint_as_float(r[0]) + __uint_as_float(r[1]); }
    { const auto r = __builtin_amdgcn_permlane32_swap(__float_as_uint(ss), __float_as_uint(ss), false, false); ss = __uint_as_float(r[0]) + __uint_as_float(r[1]); }
    if (lane == 0) *ssp = ss;
}
template <bool VPASS>
__device__ __forceinline__ void phase_peer_gather(KP p, float* lds, int bid, int nb, int wv_) {
    const int tid = opaque_tid(), lane = tid & 63, k = lane >> 3, c = lane & 7;
    const unsigned char* H8 = p->ws + WS_H8I; const unsigned short* idx = (const unsigned short*)(p->ws + WS_IDX16); const float* ascp = (const float*)(p->ws + WS_ASC);
    const unsigned char* TAB = p->ws + (VPASS ? WS_EV8 : WS_EU8);
    int* pdot = (int*)(p->ws + WS_PDOT); const unsigned char* act = p->ws + WS_ACT; float* ssq2 = (float*)(p->ws + WS_SSQ2);
    unsigned* ctr = (unsigned*)(p->ws + WS_CTL) + (VPASS ? CW_VQ : CW_UQ);
    if (VPASS) { for (int i = tid; i < NB * D; i += NT) lds[i] = mod_at(p, i >> 11, 5 * D + (i & (D - 1))); __syncthreads(); }
    const unsigned slot0 = xb_xcc_id() & 7u, c16 = 16u * (unsigned)c;
    const int vcol = 16 * c + 8 * (k & 1) + 4 * ((k >> 1) & 1) + 2 * (k >> 2);
    for (int sl = 0; sl < 8; ++sl) {
        const int slot = (int)((slot0 + sl) & 7u);
        for (;;) {
            unsigned q = 0; if (lane == 0) q = __hip_atomic_fetch_add(ctr + 64 * slot, 1u, __ATOMIC_RELAXED, __HIP_MEMORY_SCOPE_AGENT);
            q = (unsigned)__builtin_amdgcn_readfirstlane((int)q);
            if (q >= 2u * PEER_NTILE) break;
            const int g = slot * 2 + (int)(q / PEER_NTILE), tile = (int)(q % PEER_NTILE);
            const unsigned char* tg = TAB + (size_t)g * GRP_BYTES;
            const size_t tok0 = (size_t)tile * PEER_TT;
            unsigned oA[16], oB[16]; uint4 rA[16], rB[16]; uint4 hA[2], hB[2]; f32x4_t aA[4], aB[4];
#define PG_AUX(tok, hX, aX) do { if (!VPASS) { hX[0] = *(const uint4*)(H8 + (tok) * D + g * 128 + 16 * c); } \
            else { aX[0] = *(const f32x4_t*)(act + (tok) * NSEL + 16 * k); aX[1][0] = ascp[(tok)]; const float2 x1_ = *(const float2*)(p->out + (tok) * D + g * 128 + vcol); aX[1][1] = x1_.x; aX[1][2] = x1_.y; } } while (0)
#define PG_COMPUTE(tok, rX, hX, aX) do { if (!VPASS) pg_compute_u(rX, hX, (short*)pdot + ((size_t)g * M + (tok)) * NSEL + 16 * k + 2 * c, c); \
            else pg_compute_v(rX, aX, p->out + (tok) * D + g * 128 + vcol, (unsigned*)(p->ws + WS_Y16) + ((tok) * D + g * 128 + vcol) / 2, lds + ((tok) / SEQ) * D + g * 128 + vcol, ssq2 + (size_t)g * M + (tok), aX[1][0], k, lane); } while (0)
            pg_load_ids(idx, tok0, k, c16, oA); pg_load_lines(tg, oA, rA); PG_AUX(tok0, hA, aA); pg_load_ids(idx, tok0 + 1, k, c16, oB);
            for (int tt = 0; tt < PEER_TT; tt += 2) {
                pg_load_lines(tg, oB, rB); PG_AUX(tok0 + tt + 1, hB, aB);
                if (tt + 2 < PEER_TT) pg_load_ids(idx, tok0 + tt + 2, k, c16, oA);
                PG_COMPUTE(tok0 + tt, rA, hA, aA);
                if (tt + 2 < PEER_TT) { pg_load_lines(tg, oA, rA); PG_AUX(tok0 + tt + 2, hA, aA); pg_load_ids(idx, tok0 + tt + 3, k, c16, oB); }
                PG_COMPUTE(tok0 + tt + 1, rB, hB, aB);
            }
#undef PG_AUX
#undef PG_COMPUTE
        }
    }
}
__device__ __forceinline__ unsigned u4c(const uint4& v, int i) { return i == 0 ? v.x : i == 1 ? v.y : i == 2 ? v.z : v.w; }
__device__ __forceinline__ void phase_peer_v(KP p, unsigned char* lds, int bid, int nb, int wv_) {
    const int tid = opaque_tid(), lane = tid & 63, wave = tid >> 6;
    const unsigned char* actt = p->ws + WS_ACT; const unsigned char* idxt = p->ws + WS_IDXT; const float* ascp = (const float*)(p->ws + WS_ASC);
    float* gtl = (float*)(lds + VSL_BYTES);
    const unsigned lbase = (unsigned)(size_t)(LAS unsigned char*)lds;
    for (int si = bid; si < NVSL; si += nb) {
        const int sl = ((si & 7) << 5) | (si >> 3);
        __syncthreads();
        { const unsigned char* src = p->ws + WS_EV8 + (size_t)sl * VSL_BYTES;
#pragma unroll 4
          for (int i = 0; i < (int)(VSL_BYTES / 16 / NT); ++i) *(uint4*)(lds + ((size_t)i * NT + tid) * 16) = *(const uint4*)(src + ((size_t)i * NT + tid) * 16);
          if (tid < 64) gtl[tid] = ((const float*)(p->ws + WS_MODS))[(size_t)(tid >> 3) * NMOD + 5 * D + sl * 8 + (tid & 7)]; }
        __syncthreads();
        uint4 W0[3], W1[3], AA[3];
#define PV_LOADCH(slot, btx, cx) do { W0[slot] = *(const uint4*)(idxt + (((size_t)(btx) * 16 + 2 * (cx)) * 64 + lane) * 16); W1[slot] = *(const uint4*)(idxt + (((size_t)(btx) * 16 + 2 * (cx) + 1) * 64 + lane) * 16); \
                                       AA[slot] = *(const uint4*)(actt + (((size_t)(btx) * 8 + (cx)) * 64 + lane) * 16); } while (0)
#define PV_ISSUE(g) do { const int sl_ = ((g) >> 2) % 3, q_ = (g) & 3; const unsigned wa_ = u4c(q_ < 2 ? W0[sl_] : W1[sl_], 2 * (q_ & 1)), wb_ = u4c(q_ < 2 ? W0[sl_] : W1[sl_], 2 * (q_ & 1) + 1); unsigned o0_, o1_, o2_, o3_; \
            asm("v_mad_u32_u16 %0, %1, 8, %2 op_sel:[0,0,0,0]" : "=v"(o0_) : "v"(wa_), "v"(lbase)); asm("v_mad_u32_u16 %0, %1, 8, %2 op_sel:[1,0,0,0]" : "=v"(o1_) : "v"(wa_), "v"(lbase)); \
            asm("v_mad_u32_u16 %0, %1, 8, %2 op_sel:[0,0,0,0]" : "=v"(o2_) : "v"(wb_), "v"(lbase)); asm("v_mad_u32_u16 %0, %1, 8, %2 op_sel:[1,0,0,0]" : "=v"(o3_) : "v"(wb_), "v"(lbase)); \
            VB[(g) % 3][0] = *(LAS const v2u_t*)(size_t)o0_; VB[(g) % 3][1] = *(LAS const v2u_t*)(size_t)o1_; VB[(g) % 3][2] = *(LAS const v2u_t*)(size_t)o2_; VB[(g) % 3][3] = *(LAS const v2u_t*)(size_t)o3_; } while (0)
        PV_LOADCH(0, wave, 0); PV_LOADCH(1, wave, 1);
        for (int bt = wave; bt < M / 64; bt += NT / 64) {
            const size_t token = (size_t)bt * 64 + lane;
            const int btn = bt + NT / 64 < M / 64 ? bt + NT / 64 : bt;
            const uint4 xw = *(const uint4*)((const bf16_t*)(p->ws + WS_X1B) + token * D + sl * 8);
            const float4 xa = make_float4(__uint_as_float(xw.x << 16), __uint_as_float(xw.x & 0xffff0000u), __uint_as_float(xw.y << 16), __uint_as_float(xw.y & 0xffff0000u)), xb = make_float4(__uint_as_float(xw.z << 16), __uint_as_float(xw.z & 0xffff0000u), __uint_as_float(xw.w << 16), __uint_as_float(xw.w & 0xffff0000u));
            const float asc = ascp[token];
            int acc[8];
            v2u_t VB[3][4];
            PV_ISSUE(0); PV_ISSUE(1);
#pragma unroll
            for (int g = 0; g < 32; ++g) {
                if ((g & 3) == 0) { const int c = g >> 2; if (c + 2 < 8) PV_LOADCH((c + 2) % 3, bt, c + 2); else PV_LOADCH((c + 2) % 3, btn, c + 2 - 8); }
                if (g + 2 < 32) PV_ISSUE(g + 2);
                __builtin_amdgcn_sched_barrier(0);
                const unsigned a4 = u4c(AA[(g >> 2) % 3], g & 3);
#pragma unroll
                for (int d = 0; d < 2; ++d) {
                    const unsigned r0 = VB[g % 3][0][d], r1 = VB[g % 3][1][d], r2 = VB[g % 3][2][d], r3 = VB[g % 3][3][d];
                    const unsigned t0 = __builtin_amdgcn_perm(r1, r0, 0x05010400u), t1 = __builtin_amdgcn_perm(r1, r0, 0x07030602u), t2 = __builtin_amdgcn_perm(r3, r2, 0x05010400u), t3 = __builtin_amdgcn_perm(r3, r2, 0x07030602u);
                    const int c0 = (int)__builtin_amdgcn_perm(t2, t0, 0x05040100u), c1 = (int)__builtin_amdgcn_perm(t2, t0, 0x07060302u), c2 = (int)__builtin_amdgcn_perm(t3, t1, 0x05040100u), c3 = (int)__builtin_amdgcn_perm(t3, t1, 0x07060302u);
                    if (g == 0) { acc[4 * d] = dot4_0(c0, (int)a4); acc[4 * d + 1] = dot4_0(c1, (int)a4); acc[4 * d + 2] = dot4_0(c2, (int)a4); acc[4 * d + 3] = dot4_0(c3, (int)a4); }
                    else { acc[4 * d] = __builtin_amdgcn_sdot4(c0, (int)a4, acc[4 * d], false); acc[4 * d + 1] = __builtin_amdgcn_sdot4(c1, (int)a4, acc[4 * d + 1], false);
                           acc[4 * d + 2] = __builtin_amdgcn_sdot4(c2, (int)a4, acc[4 * d + 2], false); acc[4 * d + 3] = __builtin_amdgcn_sdot4(c3, (int)a4, acc[4 * d + 3], false); }
                }
                __builtin_amdgcn_sched_barrier(0);
            }
            { const uint4 t0_ = W0[0], t1_ = W1[0], t2_ = AA[0]; W0[0] = W0[2]; W1[0] = W1[2]; AA[0] = AA[2]; W0[1] = t0_; W1[1] = t1_; AA[1] = t2_; }
            const float* gt = gtl + (bt >> 5) * 8;
            const float y0 = xa.x + gt[0] * ((float)acc[0] * asc), y1 = xa.y + gt[1] * ((float)acc[1] * asc), y2 = xa.z + gt[2] * ((float)acc[2] * asc), y3 = xa.w + gt[3] * ((float)acc[3] * asc);
            const float y4 = xb.x + gt[4] * ((float)acc[4] * asc), y5 = xb.y + gt[5] * ((float)acc[5] * asc), y6 = xb.z + gt[6] * ((float)acc[6] * asc), y7 = xb.w + gt[7] * ((float)acc[7] * asc);
            *(uint4*)((bf16_t*)(p->ws + WS_Y16) + ((size_t)sl * M + token) * 8) = make_uint4(pk2(y0, y1), pk2(y2, y3), pk2(y4, y5), pk2(y6, y7));
            ((float*)(p->ws + WS_SSQP))[(size_t)sl * M + token] = ((y0 * y0 + y1 * y1) + (y2 * y2 + y3 * y3)) + ((y4 * y4 + y5 * y5) + (y6 * y6 + y7 * y7));
        }
    }
}
#undef PV_LOADCH
#undef PV_ISSUE
constexpr int NCS = 4;
__device__ __forceinline__ void phase_peer_u(KP p, unsigned char* lds, int bid, int nb, int wv_) {
    const int tid = opaque_tid(), lane = tid & 63, wave = tid >> 6;
    const unsigned char* idxt = p->ws + WS_IDXT; const unsigned char* H8 = p->ws + WS_H8I;
    const unsigned lbase = (unsigned)(size_t)(LAS unsigned char*)lds;
    constexpr int NSL = NVSL / NCS;
    for (int unit = bid; unit < NCS * (M / 256); unit += nb) {
        const int cs = unit & 3, bt = (unit >> 2) * 4 + (wave >> 1), hf = wave & 1;
        const size_t token = (size_t)bt * 64 + lane;
        const unsigned char* tsl = p->ws + WS_EU8 + (size_t)cs * NSL * VSL_BYTES + (size_t)tid * 16;
        const unsigned char* idb = idxt + (((size_t)bt * 16 + hf * 8) * 64 + lane) * 16;
        const unsigned char* hb = p->ws + WS_H8T + ((size_t)cs * NSL * M + token) * 8;
        int acc[64];
#pragma unroll
        for (int i = 0; i < 64; ++i) acc[i] = 0;
        uint4 st[16];
#pragma unroll
        for (int i = 0; i < 16; ++i) st[i] = *(const uint4*)(tsl + (size_t)i * NT * 16);
        uint4 IW[8];
#pragma unroll
        for (int c = 0; c < 8; ++c) IW[c] = *(const uint4*)(idb + c * 1024);
        unsigned OA[64];
#pragma unroll
        for (int c = 0; c < 8; ++c)
#pragma unroll
            for (int w = 0; w < 4; ++w) { const unsigned wd = u4c(IW[c], w);
                asm("v_mad_u32_u16 %0, %1, 8, %2 op_sel:[0,0,0,0]" : "=v"(OA[8 * c + 2 * w]) : "v"(wd), "v"(lbase)); asm("v_mad_u32_u16 %0, %1, 8, %2 op_sel:[1,0,0,0]" : "=v"(OA[8 * c + 2 * w + 1]) : "v"(wd), "v"(lbase)); }
        v2u_t hn = *(const v2u_t*)(hb);
#pragma unroll 1
        for (int s = 0; s < NSL; ++s) {
            __syncthreads();
#pragma unroll
            for (int i = 0; i < 16; ++i) *(LAS v4i_t*)(size_t)(lbase + (unsigned)(i * NT + tid) * 16u) = __builtin_bit_cast(v4i_t, st[i]);
            __syncthreads();
            const v2u_t hv = hn;
            const int sn = s + 1 < NSL ? s + 1 : s;
            hn = *(const v2u_t*)(hb + (size_t)sn * M * 8);
            const unsigned char* tn = tsl + (size_t)sn * VSL_BYTES;
            v2u_t VB[3][4];
#define PU_ISSUE(g) do { VB[(g) % 3][0] = *(LAS const v2u_t*)(size_t)OA[4 * (g)]; VB[(g) % 3][1] = *(LAS const v2u_t*)(size_t)OA[4 * (g) + 1]; VB[(g) % 3][2] = *(LAS const v2u_t*)(size_t)OA[4 * (g) + 2]; VB[(g) % 3][3] = *(LAS const v2u_t*)(size_t)OA[4 * (g) + 3]; } while (0)
            PU_ISSUE(0); PU_ISSUE(1);
#pragma unroll
            for (int g = 0; g < 16; ++g) {
                if (g < 8) { st[2 * g] = *(const uint4*)(tn + (size_t)(2 * g) * NT * 16); st[2 * g + 1] = *(const uint4*)(tn + (size_t)(2 * g + 1) * NT * 16); }
                if (g + 2 < 16) PU_ISSUE(g + 2);
                __builtin_amdgcn_sched_barrier(0);
#pragma unroll
                for (int j = 0; j < 4; ++j) {
                    const int sidx = 4 * g + j;
                    int a_ = acc[sidx];
                    a_ = __builtin_amdgcn_sdot4((int)VB[g % 3][j][0], (int)hv[0], a_, false);
                    acc[sidx] = __builtin_amdgcn_sdot4((int)VB[g % 3][j][1], (int)hv[1], a_, false);
                }
                __builtin_amdgcn_sched_barrier(0);
            }
#undef PU_ISSUE
        }
        int* po = (int*)(p->ws + WS_PDOT) + ((size_t)cs * M + token) * NSEL + hf * 64;
#pragma unroll
        for (int i = 0; i < 16; ++i) *(int4*)(po + 4 * i) = make_int4(acc[4 * i], acc[4 * i + 1], acc[4 * i + 2], acc[4 * i + 3]);
    }
}
__device__ __forceinline__ void phase_peer_act(KP p, int bid, int nb, int wv_) {
    const int tid = opaque_tid(), lane = tid & 63, wave = tid >> 6;
    const int* idx = (const int*)(p->ws + WS_IDX); const float* gate = (const float*)(p->ws + WS_GATE); const float* esc = (const float*)(p->ws + WS_ESCALE);
    const unsigned* pdot = (const unsigned*)(p->ws + WS_PDOT); unsigned char* act = p->ws + WS_ACT;
    for (int token = bid * 8 + wave; token < M; token += nb * 8) {
        int d0 = 0, d1 = 0;
#pragma unroll
        for (int g = 0; g < NCS; ++g) { const int2 w = *(const int2*)((const int*)pdot + ((size_t)g * M + token) * NSEL + 2 * lane); d0 += w.x; d1 += w.y; }
        const unsigned ew = ((const unsigned*)(p->ws + WS_IDXT))[(((size_t)(token >> 6) * 16 + (lane >> 2)) * 64 + (token & 63)) * 4 + (lane & 3)], gw = ((const unsigned*)(p->ws + WS_GATE))[(size_t)token * (NSEL / 2) + lane];
        typedef __fp16 h2v_ __attribute__((ext_vector_type(2))); const h2v_ gh = __builtin_bit_cast(h2v_, gw);
        const int2 e = make_int2((int)(ew & 0xffffu), (int)(ew >> 16)); const float2 gt2 = make_float2((float)gh[0], (float)gh[1]);
        const float hs = ((const float*)(p->ws + WS_HSC))[token];
        const float a0 = gelu_t((float)d0 * (esc[e.x] * hs)) * gt2.x * esc[NKEYS * NKEYS + e.x];
        const float a1 = gelu_t((float)d1 * (esc[e.y] * hs)) * gt2.y * esc[NKEYS * NKEYS + e.y];
        const float am = wave_max(fmaxf(fabsf(a0), fabsf(a1))); const float sc = am > 0.f ? 127.f / am : 0.f;
        { const size_t bt = (size_t)(token >> 6), tl = (size_t)(token & 63);
          *(unsigned short*)(act + ((bt * 8 + (lane >> 3)) * 64 + tl) * 16 + (2 * lane & 15)) = (unsigned short)(((unsigned)__float2int_rn(a0 * sc) & 0xffu) | (((unsigned)__float2int_rn(a1 * sc) & 0xffu) << 8));
        }
        if (lane == 0) ((float*)(p->ws + WS_ASC))[token] = am * (1.f / 127.f);
    }
}
__device__ __forceinline__ void phase_final_norm(KP p, int bid, int nb, int wv_) {
    const int tid = opaque_tid();
    const float* gf = p->in[I_GFIN]; const float* ssqp = (const float*)(p->ws + WS_SSQP); const bf16_t* y16 = (const bf16_t*)(p->ws + WS_Y16);
    constexpr int PITCH = 2 * D + 16;
    LAS unsigned char* img = dyn_lds_base(); LAS float* part = (LAS float*)(img + 32 * PITCH);
    const float4 g4 = *(const float4*)(gf + 4 * tid);
    for (int item = bid; item < M / 32; item += nb) {
        const size_t tok0 = (size_t)item * 32; const int tk = tid & 31;
        __syncthreads();
        float ss = 0.f;
#pragma unroll
        for (int k = 0; k < 16; ++k) { const int sc = (k * NT + tid) >> 5;
            const uint4 w = *(const uint4*)(y16 + ((size_t)sc * M + tok0 + tk) * 8); *(LAS v4i_t*)(img + tk * PITCH + sc * 16) = __builtin_bit_cast(v4i_t, w);
            ss += ssqp[(size_t)sc * M + tok0 + tk]; }
        part[tid] = ss;
        __syncthreads();
#pragma unroll 8
        for (int r = 0; r < 32; ++r) {
            float s2 = 0.f;
#pragma unroll
            for (int j = 0; j < 16; ++j) s2 += part[r + 32 * j];
            const float rstd = rsqrtf(s2 * (1.f / D) + EPS);
            const v2u_t w = *(LAS const v2u_t*)(img + r * PITCH + tid * 8);
            *(float4*)(p->out + (tok0 + r) * D + 4 * tid) = make_float4(__uint_as_float(w[0] << 16) * rstd * g4.x, __uint_as_float(w[0] & 0xffff0000u) * rstd * g4.y, __uint_as_float(w[1] << 16) * rstd * g4.z, __uint_as_float(w[1] & 0xffff0000u) * rstd * g4.w);
        }
    }
}

#define XB_TMO      128
#define XB_XCNT(j)  (256  + 64 * (j))
#define XB_XSUB(j)  (1280 + 64 * (j))
#define XB_XGEN(j)  (2304 + 64 * (j))
#define XB_TOP      3328
#define XB_TOPGEN   3392
#define XCD_BAR_WORDS 3456
#define XB_SPIN_CAP (1u << 18)

__device__ __forceinline__ unsigned xb_ld(unsigned* p)              { return __hip_atomic_load(p, __ATOMIC_RELAXED, __HIP_MEMORY_SCOPE_AGENT); }
__device__ __forceinline__ unsigned xb_add(unsigned* p, unsigned v) { return __hip_atomic_fetch_add(p, v, __ATOMIC_RELAXED, __HIP_MEMORY_SCOPE_AGENT); }
__device__ __forceinline__ unsigned xb_xcc_id() { return (unsigned)__builtin_amdgcn_s_getreg((3 << 11) | 20) & 0xFu; }
#define XB_SPIN(cond, bar) do { unsigned _sp = 0; while (cond) { __builtin_amdgcn_s_sleep(1); \
    if ((++_sp & 255u) == 0u) { if (xb_ld(&(bar)[XB_TMO])) break; if (_sp > XB_SPIN_CAP) { atomicAdd(&(bar)[XB_TMO], 1u); break; } } } } while (0)

struct XcdBarrier {
    unsigned* bar; unsigned x;
    volatile LAS unsigned* st;
};

__device__ __forceinline__ XcdBarrier xcd_barrier_post(unsigned* bar, volatile LAS unsigned* st) {
    XcdBarrier b; b.bar = bar; b.x = xb_xcc_id(); b.st = st;
    if (threadIdx.x == 0) (void)xb_add(&bar[XB_XCNT(b.x)], 1u);
    return b;
}
__device__ __forceinline__ void xcd_barrier_complete(unsigned* bar, unsigned x, unsigned& nloc, unsigned& nx) {
    const unsigned G = gridDim.x * gridDim.y * gridDim.z;
    unsigned sum, cnt, mine, sp = 0u;
    for (;;) {
        sum = 0u; cnt = 0u; mine = 0u;
#pragma unroll
        for (unsigned j = 0; j < 16; ++j) { const unsigned c = xb_ld(&bar[XB_XCNT(j)]); sum += c; cnt += (c > 0u) ? 1u : 0u; mine = (j == x) ? c : mine; }
        if (sum == G) break;
        __builtin_amdgcn_s_sleep(1);
        if ((++sp & 255u) == 0u) { if (xb_ld(&bar[XB_TMO])) break; if (sp > XB_SPIN_CAP) { atomicAdd(&bar[XB_TMO], 1u); break; } }
    }
    nloc = mine > 0u ? mine : 1u; nx = cnt > 0u ? cnt : 1u;
}

__device__ __forceinline__ void xcd_barrier(const XcdBarrier& b, bool leader) {
    asm volatile("s_waitcnt vmcnt(0)" ::: "memory");
    __syncthreads();
    if (leader) {
        unsigned* bar = b.bar;
        __builtin_amdgcn_s_waitcnt(0);
        unsigned nloc = b.st[0], nx = b.st[1];
        if (nloc == 0u) { xcd_barrier_complete(bar, b.x, nloc, nx); b.st[0] = nloc; b.st[1] = nx; }
        const unsigned old = xb_add(&bar[XB_XSUB(b.x)], 1u);
        const unsigned gen = old / nloc;
        if (old + 1u == (gen + 1u) * nloc) {
            __builtin_amdgcn_fence(__ATOMIC_RELEASE, "agent");
            asm volatile("s_waitcnt vmcnt(0)" ::: "memory");
            const unsigned og = xb_add(&bar[XB_TOP], 1u);
            const unsigned tg = og / nx;
            if (og + 1u == (tg + 1u) * nx) xb_add(&bar[XB_TOPGEN], 1u);
            else XB_SPIN(xb_ld(&bar[XB_TOPGEN]) == tg, bar);
            __builtin_amdgcn_fence(__ATOMIC_ACQUIRE, "agent");
            xb_add(&bar[XB_XGEN(b.x)], 1u);
            asm volatile("s_waitcnt vmcnt(0)" ::: "memory");
        } else {
            XB_SPIN(xb_ld(&bar[XB_XGEN(b.x)]) == gen, bar);
            __builtin_amdgcn_fence(__ATOMIC_ACQUIRE, "agent");
            asm volatile("s_waitcnt vmcnt(0)" ::: "memory");
        }
    }
    __syncthreads();
}


constexpr int LDS_BYTES = 147456;
__global__ void __launch_bounds__(NT) fwd_megakernel(Params p_unused) {
    KP p = (KP)__builtin_amdgcn_kernarg_segment_ptr();
    float* lds = (float*)dyn_lds;
    const int bid = blockIdx.x, nb = gridDim.x, wv_ = __builtin_amdgcn_readfirstlane((int)(threadIdx.x >> 6));
    volatile LAS unsigned* bst = (volatile LAS unsigned*)((LAS unsigned char*)dyn_lds + LDS_BYTES - 16);
    if (threadIdx.x < 4) bst[threadIdx.x] = 0u;
    __syncthreads();
    (void)xcd_barrier_post((unsigned*)(p->ws + WS_CTL), bst);
#define GRID_BAR() do { XcdBarrier xb_; xb_.bar = (unsigned*)(p->ws + WS_CTL); xb_.x = xb_xcc_id(); xb_.st = (volatile LAS unsigned*)((LAS unsigned char*)dyn_lds + LDS_BYTES - 16); xcd_barrier(xb_, opaque_tid() == 0); } while (0)
    phase_mod(p, lds, bid, nb, wv_);
    __syncthreads();
    phase_convert_weights(p, lds, bid, nb, wv_);
    phase_amax(p, bid, nb, wv_);
    phase_convert_experts(p, bid, nb, wv_);
    cg::this_grid().sync();
    for (int i = bid * NT + opaque_tid(); i < NB * NMOD; i += nb * NT) ((float*)(p->ws + WS_MODS))[i] = mod_at(p, i / NMOD, i % NMOD);
    phase_hrows<true>(p, p->in[I_X], p->in[I_GMIX], 0, D, (bf16_t*)(p->ws + WS_H), lds, bid, nb, wv_);
    phase_convert_weights8(p, lds, bid, nb, wv_);
    GRID_BAR();
    { pg8::Gemm g{(const bf16_t*)(p->ws + WS_H), (const bf16_t*)(p->ws + WS_WIN_T), M, NPROJ, D / 2}; pg8::StaticOrder S; S.init(M, NPROJ, nb, bid);
      pg8::EpiProj<true> E{(bf16_t*)(p->ws + WS_PROJ), (float*)(p->ws + WS_SSQV), M, (const float*)(p->ws + WS_HSCALE1), (const float*)(p->ws + WS_CTL) + CW_WSCALE};
      pg8::gemm_phase<pg8::EpiProj<true>, pg8::StaticOrder, true, true, 2>((LAS unsigned char*)dyn_lds, g, S, E, wv_); }
    GRID_BAR();
    phase_lru(p, dyn_lds, bid, nb, wv_);
    phase_sgu(p, dyn_lds, bid, nb, wv_);
    GRID_BAR();
    { pg8::Gemm g{(const bf16_t*)(p->ws + WS_YMIX), (const bf16_t*)(p->ws + WS_WOUT_T), M, D, D / 2}; pg8::StaticOrder S; S.init(M, D, nb, bid);
      pg8::EpiX1 E{p->in[I_X], (bf16_t*)(p->ws + WS_X1B), (const float*)(p->ws + WS_MODS), p->in[I_BADA], 2 * D, NMOD, SEQ, (const float*)(p->ws + WS_CTL) + CW_WSCALE + 1, 1.f / YMIX_SCALE};
      pg8::gemm_phase<pg8::EpiX1, pg8::StaticOrder, true, true, 1>((LAS unsigned char*)dyn_lds, g, S, E, wv_); }
    GRID_BAR();
    phase_hrows<false, true, true, true>(p, (const float*)(p->ws + WS_X1B), p->in[I_GFFN], 3 * D, 4 * D, (bf16_t*)(p->ws + WS_H), lds, bid, nb, wv_);
    GRID_BAR();
    { pg8::Gemm g{(const bf16_t*)(p->ws + WS_H8I), (const bf16_t*)(p->ws + WS_WQ_T), M, D, D / 2}; pg8::StaticOrder S; S.init(M, D, nb, bid);
      pg8::EpiQ E{(bf16_t*)(p->ws + WS_Q), D, (const float*)(p->ws + WS_HSC), (const float*)(p->ws + WS_CTL) + CW_WSCALE + 2};
      pg8::gemm_phase<pg8::EpiQ, pg8::StaticOrder, true, true, 2>((LAS unsigned char*)dyn_lds, g, S, E, wv_); }
    GRID_BAR();
    phase_topk(p, dyn_lds, bid, nb, wv_);
    GRID_BAR();
    phase_peer_u(p, dyn_lds, bid, nb, wv_);
    GRID_BAR();
    phase_peer_act(p, bid, nb, wv_);
    GRID_BAR();
    phase_peer_v(p, dyn_lds, bid, nb, wv_);
    GRID_BAR();
    phase_final_norm(p, bid, nb, wv_);
}

extern "C" void kernel_launch(void* const* d_in, const int* in_sizes, int n_in, void* d_out, int out_size, void* d_ws, size_t ws_size, hipStream_t stream) {
    static int grid_blocks = 0;
    if (grid_blocks == 0) {
        if (n_in != 23 || in_sizes[0] != M * D || out_size != M * D || ws_size < WS_END) { fprintf(stderr, "kernel_launch: unexpected shapes (n_in %d in0 %d out %d ws %zu)\n", n_in, n_in > 0 ? in_sizes[0] : -1, out_size, ws_size); grid_blocks = -1; return; }
        if (hipFuncSetAttribute((const void*)fwd_megakernel, hipFuncAttributeMaxDynamicSharedMemorySize, LDS_BYTES) != hipSuccess) { fprintf(stderr, "hipFuncSetAttribute failed\n"); grid_blocks = -1; return; }
        int dev = 0, cus = 0, per_cu = 0;
        hipGetDevice(&dev);
        hipDeviceGetAttribute(&cus, hipDeviceAttributeMultiprocessorCount, dev);
        if (hipOccupancyMaxActiveBlocksPerMultiprocessor(&per_cu, (const void*)fwd_megakernel, NT, LDS_BYTES) != hipSuccess || per_cu < 1) { fprintf(stderr, "occupancy query failed (%d)\n", per_cu); grid_blocks = -1; return; }
        grid_blocks = cus;
    }
    if (grid_blocks < 0) return;
    Params p{};
    for (int i = 0; i < 23; ++i) p.in[i] = (const float*)d_in[i];
    p.out = (float*)d_out; p.ws = (unsigned char*)d_ws;
    if (hipMemsetAsync((char*)d_ws + WS_CTL, 0, 65536, stream) != hipSuccess) { fprintf(stderr, "hipMemsetAsync of the barrier words failed\n"); return; }
    void* args[] = {&p};
    hipError_t e = hipLaunchCooperativeKernel((const void*)fwd_megakernel, dim3(grid_blocks), dim3(NT), args, LDS_BYTES, stream);
    if (e != hipSuccess) fprintf(stderr, "cooperative launch failed: %s (grid %d)\n", hipGetErrorString(e), grid_blocks);
}
```

```cpp
#include <hip/hip_runtime.h>
#include <hip/hip_cooperative_groups.h>
#include <cstdio>
#include <cstdint>

constexpr int D = 2048, NB = 8, SEQ = 2048, M = NB * SEQ;
constexpr int DLRU = 1024, DSGU = 1024, NPROJ = 4096;
constexpr int NMOD = 6 * D;
constexpr int NHEAD = 8, NKEYS = 128, TOPK = 16, NSEL = NHEAD * TOPK;
constexpr float EPS = 1e-6f;
constexpr int NT = 512;
namespace cg = cooperative_groups;

constexpr size_t MiB = 1u << 20;
constexpr size_t WS_CTL = 0;
constexpr size_t WS_MODP = 1 * MiB;
constexpr size_t WS_WGA_T = 3 * MiB;
constexpr size_t WS_WGI_T = 3 * MiB + 262144;
constexpr size_t WS_WSPB = 3 * MiB + 524288;
constexpr size_t WS_SKEYB = 3 * MiB + 786432;
constexpr size_t WS_SSQV = 5 * MiB;
constexpr size_t WS_RSTDV = 8 * MiB;
constexpr size_t WS_WIN_T = 9 * MiB;
constexpr size_t WS_WOUT_T = 25 * MiB;
constexpr size_t WS_WQ_T = 33 * MiB;
constexpr size_t WS_IDX = 41 * MiB;
constexpr size_t WS_GATE = 49 * MiB;
constexpr size_t WS_H = 64 * MiB;
constexpr size_t WS_PROJ = 128 * MiB;
constexpr size_t WS_Q = 128 * MiB;
constexpr size_t WS_YMIX = 256 * MiB;
constexpr size_t WS_EU8 = 320 * MiB;
constexpr size_t WS_EV8 = 352 * MiB;
constexpr size_t WS_ESCALE = 57 * MiB;
constexpr size_t WS_XC = 320 * MiB;
constexpr size_t WS_A = 384 * MiB;
constexpr size_t WS_BB = 448 * MiB;
constexpr size_t WS_ACT = 256 * MiB;
constexpr size_t WS_SSQ2 = 264 * MiB;
constexpr size_t WS_PDOT = 384 * MiB;
constexpr size_t WS_HSCALE1 = 58 * MiB;
constexpr size_t WS_HSC = 59 * MiB;
constexpr size_t WS_ASC = 60 * MiB;
constexpr size_t WS_H8I = 288 * MiB;
constexpr size_t WS_Y16 = 128 * MiB;
constexpr size_t WS_IDX16 = 61 * MiB;
constexpr size_t WS_IDXT = 72 * MiB;
constexpr size_t WS_SSQP = 80 * MiB;
constexpr size_t WS_X1B = 192 * MiB;
constexpr size_t WS_MODS = 448 * MiB;
constexpr size_t WS_H8T = 464 * MiB;
constexpr size_t WS_END = 512 * MiB;

typedef unsigned short bf16_t;
struct Params { const float* in[23]; float* out; unsigned char* ws; };
typedef const __attribute__((address_space(4))) Params* KP;
enum { I_X = 0, I_C, I_WADA, I_BADA, I_GMIX, I_WIN, I_CONVW, I_CONVB, I_WGA, I_BGA, I_WGI, I_BGI, I_LAM, I_GV, I_WSP, I_BSP, I_WOUT, I_GFFN, I_WQ, I_SKEY, I_EU, I_EV, I_GFIN };

__device__ __forceinline__ int opaque_tid_(int wv) { asm volatile("" : "+s"(wv)); int t = wv * 64 + (int)__builtin_amdgcn_mbcnt_hi(~0u, __builtin_amdgcn_mbcnt_lo(~0u, 0u)); asm volatile("" : "+v"(t)); return t; }
#define opaque_tid() opaque_tid_(wv_)
__device__ __forceinline__ float bf2f(bf16_t v) { return __uint_as_float(((unsigned)v) << 16); }
__device__ __forceinline__ bf16_t f2bf(float f) { unsigned u = __float_as_uint(f); u += 0x7fffu + ((u >> 16) & 1u); return (bf16_t)(u >> 16); }
__device__ __forceinline__ float sigmoidf_(float x) { return 1.f / (1.f + __expf(-x)); }
__device__ __forceinline__ float gelu_t(float x) { const float u = 0.7978845608028654f * (x + 0.044715f * x * x * x); return x * sigmoidf_(2.f * u); }
__device__ __forceinline__ float wave_sum(float v) {
#pragma unroll
    for (int o = 1; o < 64; o <<= 1) v += __shfl_xor(v, o);
    return v;
}
__device__ __forceinline__ float wave_max(float v) {
#pragma unroll
    for (int o = 1; o < 64; o <<= 1) v = fmaxf(v, __shfl_xor(v, o));
    return v;
}
__device__ __forceinline__ float pow2_scale_from_max(float am) { int ex = 0; if (am > 0.f) (void)frexpf(am, &ex); else ex = 8; return ldexpf(1.f, 8 - ex); }
__device__ __forceinline__ unsigned pk4_fp8(float a, float b, float c, float d) {
    int w = __builtin_amdgcn_cvt_pk_fp8_f32(fminf(fmaxf(a, -448.f), 448.f), fminf(fmaxf(b, -448.f), 448.f), 0, false);
    return (unsigned)__builtin_amdgcn_cvt_pk_fp8_f32(fminf(fmaxf(c, -448.f), 448.f), fminf(fmaxf(d, -448.f), 448.f), w, true);
}
__device__ __forceinline__ unsigned pk4_i8(float a, float b, float c, float d) {
    const int ia = __float2int_rn(a), ib = __float2int_rn(b), ic = __float2int_rn(c), id = __float2int_rn(d);
    return ((unsigned)ia & 0xffu) | (((unsigned)ib & 0xffu) << 8) | (((unsigned)ic & 0xffu) << 16) | ((unsigned)id << 24);
}
__device__ __forceinline__ float mod_at(KP p, int b, int n) {
    const float* mp = (const float*)(p->ws + WS_MODP);
    float s = p->in[I_BADA][n];
#pragma unroll
    for (int kc = 0; kc < 4; ++kc) s += mp[(size_t)(kc * 8 + b) * NMOD + n];
    return s;
}

__device__ __forceinline__ void phase_mod(KP p, float* lds, int bid, int nb, int wv_) {
    const int tid = opaque_tid(), lane = tid & 63, wave = tid >> 6;
    const float* c = p->in[I_C]; const float* W = p->in[I_WADA];
    float* modp = (float*)(p->ws + WS_MODP);
    for (int i = tid; i < NB * D; i += NT) { const float v = c[i]; lds[i] = v * sigmoidf_(v); }
    __syncthreads();
    float* red = lds + NB * D;
    for (int item = bid; item < 192; item += nb) {
        const int nt = item % 48, kc = item / 48;
        const int n0 = nt * 256 + lane * 4, k0 = kc * 512 + wave * 64;
        float acc[8][4];
#pragma unroll
        for (int b = 0; b < 8; ++b)
#pragma unroll
            for (int j = 0; j < 4; ++j) acc[b][j] = 0.f;
        for (int kk = 0; kk < 64; ++kk) {
            const float4 w = *(const float4*)(W + (size_t)(k0 + kk) * NMOD + n0);
#pragma unroll
            for (int b = 0; b < 8; ++b) { const float s = lds[b * D + k0 + kk]; acc[b][0] += s * w.x; acc[b][1] += s * w.y; acc[b][2] += s * w.z; acc[b][3] += s * w.w; }
        }
#pragma unroll
        for (int b = 0; b < 8; ++b)
#pragma unroll
            for (int j = 0; j < 4; ++j) red[(wave * 32 + b * 4 + j) * 64 + lane] = acc[b][j];
        __syncthreads();
        for (int o = tid; o < 2048; o += NT) {
            const int b = o >> 8, nn = o & 255, ln = nn >> 2, j = nn & 3;
            float s = 0.f;
#pragma unroll
            for (int w = 0; w < 8; ++w) s += red[(w * 32 + b * 4 + j) * 64 + ln];
            modp[(size_t)(kc * 8 + b) * NMOD + nt * 256 + nn] = s;
        }
        __syncthreads();
    }
}

#define LAS __attribute__((address_space(3)))
extern __shared__ __attribute__((aligned(16))) unsigned char dyn_lds[];
__device__ __forceinline__ LAS unsigned char* dyn_lds_base() { return (LAS unsigned char*)dyn_lds; }
typedef unsigned v2u_t __attribute__((ext_vector_type(2)));
typedef int v4i_t __attribute__((ext_vector_type(4)));
#define LDS_BARRIER() asm volatile("s_waitcnt lgkmcnt(0)\n\ts_barrier" ::: "memory")
template <bool F8OUT, bool I8COPY = false, bool NOBF16 = false, bool SRC16 = false>
__device__ __forceinline__ void phase_hrows(KP p, const float* src, const float* gn, int shift_off, int scale_off, bf16_t* dst, float* lds, int bid, int nb, int wv_) {
    const int tid = opaque_tid(), lane = tid & 63, wave = tid >> 6;
    float* Aw = lds; float* Bw = lds + D;
    for (int item = bid; item < M / 64; item += nb) {
        const int b = item / (SEQ / 64);
        for (int col = tid; col < D; col += NT) { if (SRC16) { const float* ms = (const float*)(p->ws + WS_MODS) + (size_t)b * NMOD; Aw[col] = gn[col] * (1.f + ms[scale_off + col]); Bw[col] = ms[shift_off + col]; }
                                                 else { Aw[col] = gn[col] * (1.f + mod_at(p, b, scale_off + col)); Bw[col] = mod_at(p, b, shift_off + col); } }
        __syncthreads();
        for (int r = wave; r < 64; r += 8) {
            const size_t row = (size_t)item * 64 + r;
            float4 v[8]; float ss = 0.f;
#pragma unroll
            for (int j = 0; j < 8; ++j) { if (SRC16) { const uint2 w = *(const uint2*)((const bf16_t*)src + row * D + lane * 4 + 256 * j); v[j] = make_float4(__uint_as_float(w.x << 16), __uint_as_float(w.x & 0xffff0000u), __uint_as_float(w.y << 16), __uint_as_float(w.y & 0xffff0000u)); }
                                          else v[j] = *(const float4*)(src + row * D + lane * 4 + 256 * j);
                                          ss += v[j].x * v[j].x + v[j].y * v[j].y + v[j].z * v[j].z + v[j].w * v[j].w; }
            const float rstd = rsqrtf(wave_sum(ss) * (1.f / D) + EPS);
            float am = 0.f;
#pragma unroll
            for (int j = 0; j < 8; ++j) {
                const int col = lane * 4 + 256 * j;
                const float o0 = v[j].x * rstd * Aw[col] + Bw[col], o1 = v[j].y * rstd * Aw[col + 1] + Bw[col + 1];
                const float o2 = v[j].z * rstd * Aw[col + 2] + Bw[col + 2], o3 = v[j].w * rstd * Aw[col + 3] + Bw[col + 3];
                if (F8OUT || I8COPY) { v[j] = make_float4(o0, o1, o2, o3); am = fmaxf(am, fmaxf(fmaxf(fabsf(o0), fabsf(o1)), fmaxf(fabsf(o2), fabsf(o3)))); }
                if (!F8OUT && !NOBF16) { uint2 w; w.x = (unsigned)f2bf(o0) | ((unsigned)f2bf(o1) << 16); w.y = (unsigned)f2bf(o2) | ((unsigned)f2bf(o3) << 16); *(uint2*)(dst + row * D + col) = w; }
            }
            if (I8COPY) {
                am = wave_max(am); const float sc = am > 0.f ? 127.f / am : 0.f;
                unsigned* d8 = (unsigned*)(p->ws + WS_H8I + row * D);
#pragma unroll
                for (int j = 0; j < 8; ++j) { const unsigned w8 = pk4_i8(v[j].x * sc, v[j].y * sc, v[j].z * sc, v[j].w * sc); d8[lane + 64 * j] = w8; *(LAS unsigned*)(dyn_lds_base() + 16384 + (r & 31) * (D + 16) + lane * 4 + 256 * j) = w8; }
                if (lane == 0) ((float*)(p->ws + WS_HSC))[row] = am * (1.f / 127.f);
            }
            if (I8COPY && ((r >> 3) & 3) == 3) {
                LDS_BARRIER();
#pragma unroll 4
                for (int k = 0; k < 16; ++k) { const int pid = k * NT + tid, slc = pid >> 5, rr = pid & 31;
                    *(v2u_t*)(p->ws + WS_H8T + ((size_t)slc * M + (size_t)item * 64 + (r & 32) + rr) * 8) = *(LAS const v2u_t*)(dyn_lds_base() + 16384 + rr * (D + 16) + slc * 8); }
                LDS_BARRIER();
            }
            if (F8OUT) {
                am = wave_max(am); const float sc = am > 0.f ? 127.f / am : 0.f;
                unsigned* d8 = (unsigned*)((unsigned char*)dst + row * D);
#pragma unroll
                for (int j = 0; j < 8; ++j) d8[lane + 64 * j] = pk4_i8(v[j].x * sc, v[j].y * sc, v[j].z * sc, v[j].w * sc);
                if (lane == 0) ((float*)(p->ws + WS_HSCALE1))[row] = am * (1.f / 127.f);
            }
        }
        __syncthreads();
    }
}

namespace pg8 {
#define PG8_LAS __attribute__((address_space(3)))
typedef unsigned short bf16_t;
typedef short bf16x8 __attribute__((ext_vector_type(8)));
typedef float f32x4 __attribute__((ext_vector_type(4)));
typedef unsigned u32x4 __attribute__((ext_vector_type(4)));
constexpr int BM = 256, BK = 64, HALF = 128, HTB = HALF * BK * 2  , STAGE_BYTES = 8 * HTB, NXCD = 8, WGM = 8;

__host__ __device__ __forceinline__ int lds_byte(int r, int c) { const int st = (r >> 4) * 2 + (c >> 5), rr = r & 15, cc = c & 31, ob = rr * 64 + cc * 2; return st * 1024 + (ob ^ (((ob >> 9) & 1) << 5)); }
__host__ __device__ __forceinline__ void stage_rc(int b, int& R, int& C) { const int st = b / 1024, sb = b % 1024, swz = sb ^ (((sb >> 9) & 1) << 5); R = (st >> 1) * 16 + swz / 64; C = (st & 1) * 32 + (swz % 64) / 2; }
__host__ __device__ __forceinline__ int perm32(int rho) { const int n = rho >> 4, i = rho & 15; return 8 * (i >> 2) + 4 * n + (i & 3); }

struct Unit { int pm, pn; };
struct Gemm { const bf16_t* A; const bf16_t* Bt; int M, N, K; };

struct StaticOrder {
    int nM, nN, nwg, G, c;
    __host__ __device__ void init(int M, int N, int G_, int c_) { nM = M / BM; nN = N / BM; nwg = nM * nN; G = G_; c = c_; }
    __host__ __device__ bool next(int i, Unit& u) const {
        const long L = (long)i * G + c; if (L >= nwg) return false;
        int wgid = (int)L; { const int q = nwg / NXCD, r = nwg % NXCD, xcd = wgid % NXCD, off = wgid / NXCD; wgid = (xcd < r ? xcd * (q + 1) : r * (q + 1) + (xcd - r) * q) + off; }
        const int nig = WGM * nN, gid = wgid / nig, fm = gid * WGM, gsz = (nM - fm) < WGM ? (nM - fm) : WGM;
        u.pm = fm + ((wgid % nig) % gsz); u.pn = (wgid % nig) / gsz; return true;
    }
    __device__ __forceinline__ void a_ready(const Unit&) const {}
    __device__ __forceinline__ void done(const Unit&) const {}
};


__device__ __forceinline__ unsigned cvt_pk_bf16(float lo, float hi) { unsigned r; asm volatile("v_cvt_pk_bf16_f32 %0, %1, %2" : "=v"(r) : "v"(lo), "v"(hi)); return r; }
__device__ __forceinline__ float gelu_tanh(float x) { const float u = 1.5957691216057308f * (x + 0.044715f * x * x * x); return x * __builtin_amdgcn_rcpf(1.f + __expf(-u)); }
template <bool ACCI  > struct EpiProj {
    static constexpr bool PERM = true, AFTER_DRAIN = false;
    bf16_t* proj; float* ssqv; int Mrows; const float* rowscale; const float* cscale;
    __device__ __forceinline__ void operator()(const f32x4 (&acc)[2][2][4][2], const Unit& u, int wr, int wc, int fr, int fq) const {
        const int which = (u.pn * BM) >> 10, colt = (u.pn * BM) & 1023; const float cs = *cscale;
        bf16_t* base = proj + (size_t)which * Mrows * 1024;
        const int row0 = u.pm * BM + wr * 64 + fr, col0 = colt + wc * 32 + 8 * fq;
#pragma unroll
        for (int ai = 0; ai < 2; ++ai)
#pragma unroll
            for (int m = 0; m < 4; ++m) { const int row = row0 + ai * HALF + m * 16; bf16_t* rowp = base + (size_t)row * 1024 + col0; float ss = 0.f; const float f = cs * rowscale[row];
#pragma unroll
                for (int bj = 0; bj < 2; ++bj) { f32x4 v0 = acc[ai][bj][m][0], v1 = acc[ai][bj][m][1];
                    if (ACCI) { typedef int v4j_ __attribute__((ext_vector_type(4))); const v4j_ i0 = __builtin_bit_cast(v4j_, v0), i1 = __builtin_bit_cast(v4j_, v1);
                        v0 = (f32x4){(float)i0[0], (float)i0[1], (float)i0[2], (float)i0[3]}; v1 = (f32x4){(float)i1[0], (float)i1[1], (float)i1[2], (float)i1[3]}; }
                    v0 = v0 * f; v1 = v1 * f;
                    if (which) {
#pragma unroll
                        for (int j = 0; j < 4; ++j) { v0[j] = gelu_tanh(v0[j]); v1[j] = gelu_tanh(v1[j]); } }
                    ss += (v0[0] * v0[0] + v0[1] * v0[1]) + (v0[2] * v0[2] + v0[3] * v0[3]) + (v1[0] * v1[0] + v1[1] * v1[1]) + (v1[2] * v1[2] + v1[3] * v1[3]);
                    u32x4 w; w.x = cvt_pk_bf16(v0[0], v0[1]); w.y = cvt_pk_bf16(v0[2], v0[3]); w.z = cvt_pk_bf16(v1[0], v1[1]); w.w = cvt_pk_bf16(v1[2], v1[3]);
                    *(u32x4*)(rowp + bj * HALF) = w; }
                if (which == 3) { ss += __shfl_xor(ss, 16); ss += __shfl_xor(ss, 32); if (fq == 0) ssqv[(size_t)row * 16 + (u.pn & 3) * 4 + wc] = ss; } }
    }
};
struct EpiX1 {
    static constexpr bool PERM = false, AFTER_DRAIN = false;
    const float* x; bf16_t* out; const float* modp; const float* bada; int goff, nmod, seq; const float* cscale; float cscale2;
    __device__ __forceinline__ void operator()(const f32x4 (&acc)[2][2][4][2], const Unit& u, int wr, int wc, int fr, int fq) const {
        const int row0 = u.pm * BM + wr * 64 + fr, col0 = u.pn * BM + wc * 32 + 4 * fq, b = (u.pm * BM) / seq;
        f32x4 gv[2][2];
#pragma unroll
        for (int bj = 0; bj < 2; ++bj)
#pragma unroll
            for (int n = 0; n < 2; ++n) { const int c = goff + col0 + bj * HALF + n * 16; const f32x4 g = *(const f32x4*)(modp + (size_t)b * nmod + c);
                gv[bj][n] = g * (*cscale * cscale2); }
#pragma unroll
        for (int ai = 0; ai < 2; ++ai)
#pragma unroll
            for (int m = 0; m < 4; ++m) { const size_t off = (size_t)(row0 + ai * HALF + m * 16) * (size_t)(2048) + col0;
#pragma unroll
                for (int bj = 0; bj < 2; ++bj)
#pragma unroll
                    for (int n = 0; n < 2; ++n) { const f32x4 xv = *(const f32x4*)(x + off + bj * HALF + n * 16); const f32x4 r = xv + gv[bj][n] * acc[ai][bj][m][n];
                        uint2 w; w.x = (unsigned)f2bf(r[0]) | ((unsigned)f2bf(r[1]) << 16); w.y = (unsigned)f2bf(r[2]) | ((unsigned)f2bf(r[3]) << 16); *(uint2*)(out + off + bj * HALF + n * 16) = w; } }
    }
};
struct EpiQ {
    static constexpr bool PERM = true, AFTER_DRAIN = false;
    bf16_t* O; int ldc; const float* rowscale; const float* cscale;
    __device__ __forceinline__ void operator()(const f32x4 (&acc)[2][2][4][2], const Unit& u, int wr, int wc, int fr, int fq) const {
        const int row0 = u.pm * BM + wr * 64 + fr, col0 = u.pn * BM + wc * 32 + 8 * fq;
#pragma unroll
        for (int ai = 0; ai < 2; ++ai)
#pragma unroll
            for (int m = 0; m < 4; ++m) { bf16_t* rowp = O + (size_t)(row0 + ai * HALF + m * 16) * ldc + col0; const float f = *cscale * rowscale[row0 + ai * HALF + m * 16];
#pragma unroll
                for (int bj = 0; bj < 2; ++bj) { typedef int v4j_ __attribute__((ext_vector_type(4))); const v4j_ i0 = __builtin_bit_cast(v4j_, acc[ai][bj][m][0]), i1 = __builtin_bit_cast(v4j_, acc[ai][bj][m][1]);
                    const f32x4 v0 = (f32x4){(float)i0[0], (float)i0[1], (float)i0[2], (float)i0[3]} * f, v1 = (f32x4){(float)i1[0], (float)i1[1], (float)i1[2], (float)i1[3]} * f;
                    u32x4 w; w.x = cvt_pk_bf16(v0[0], v0[1]); w.y = cvt_pk_bf16(v0[2], v0[3]); w.z = cvt_pk_bf16(v1[0], v1[1]); w.w = cvt_pk_bf16(v1[2], v1[3]);
                    *(u32x4*)(rowp + bj * HALF) = w; } }
    }
};

template <class Epi, class Sched, bool ALIGN_EPI = false, bool SP2 = false, int OPK = 0>
__device__ __forceinline__ void gemm_phase(PG8_LAS unsigned char* lds, const Gemm g, const Sched& S, const Epi& E, int wv_) {
    const int tid = opaque_tid(), wid = __builtin_amdgcn_readfirstlane(tid >> 6), lane = tid & 63, wr = wid >> 2, wc = wid & 3, fr = lane & 15, fq = lane >> 4;
    const int K = g.K, nt = K / BK;
    unsigned voffA[2], voffB[2];
#pragma unroll
    for (int i = 0; i < 2; ++i) { int R, C; stage_rc(tid * 16 + i * 8192, R, C); const int Rb = Epi::PERM ? ((R & ~31) + perm32(R & 31)) : R;
        voffA[i] = (unsigned)(R * K + C) * 2u; voffB[i] = (unsigned)(Rb * K + C) * 2u; }
    const size_t kstep = (size_t)(BK * 2);
    const size_t hstep = (size_t)HALF * K * 2;
    const size_t tstep = 2 * hstep;
    const unsigned ldsw = (unsigned)wid * 1024u;
    const int aoff = lds_byte(wr * 64 + fr, fq * 8), boff = lds_byte(wc * 32 + fr, fq * 8);
#define PG8_SA(b, h) (((b) * 2 + (h)) * HTB)
#define PG8_SB(b, h) ((4 + (b) * 2 + (h)) * HTB)
#define PG8_STAGE(bufoff, gbase, voff) do { _Pragma("unroll") for (int _i = 0; _i < 2; ++_i) \
        __builtin_amdgcn_global_load_lds((const unsigned*)((const char*)(gbase) + (voff)[_i]), (PG8_LAS unsigned*)(lds + (bufoff) + ldsw + _i * 8192), 16, 0, 0); } while (0)
#define PG8_LDA(dst, b, h) do { _Pragma("unroll") for (int m = 0; m < 4; ++m) _Pragma("unroll") for (int k = 0; k < 2; ++k) dst[m][k] = *(const PG8_LAS bf16x8*)(lds + PG8_SA(b, h) + aoff + m * 2048 + k * 1024); } while (0)
#define PG8_LDB(dst, b, h) do { _Pragma("unroll") for (int n = 0; n < 2; ++n) _Pragma("unroll") for (int k = 0; k < 2; ++k) dst[n][k] = *(const PG8_LAS bf16x8*)(lds + PG8_SB(b, h) + boff + n * 2048 + k * 1024); } while (0)
#define PG8_MMA(ai, bj, At, Bt) do { __builtin_amdgcn_s_setprio(1); _Pragma("unroll") for (int m = 0; m < 4; ++m) _Pragma("unroll") for (int n = 0; n < 2; ++n) { \
        if constexpr (OPK == 2) { typedef int v4j_ __attribute__((ext_vector_type(4))); _Pragma("unroll") for (int k = 0; k < 2; ++k) \
            acc[ai][bj][m][n] = __builtin_bit_cast(f32x4, __builtin_amdgcn_mfma_i32_16x16x64_i8(__builtin_bit_cast(v4j_, Bt[n][k]), __builtin_bit_cast(v4j_, At[m][k]), __builtin_bit_cast(v4j_, acc[ai][bj][m][n]), 0, 0, 0)); } \
        else if constexpr (OPK == 1) { typedef int v4i_ __attribute__((ext_vector_type(4))); typedef int v8i_ __attribute__((ext_vector_type(8))); \
            const v8i_ a8 = __builtin_shufflevector(__builtin_bit_cast(v4i_, Bt[n][0]), __builtin_bit_cast(v4i_, Bt[n][1]), 0, 1, 2, 3, 4, 5, 6, 7), b8 = __builtin_shufflevector(__builtin_bit_cast(v4i_, At[m][0]), __builtin_bit_cast(v4i_, At[m][1]), 0, 1, 2, 3, 4, 5, 6, 7); \
            asm volatile("v_mfma_scale_f32_16x16x128_f8f6f4 %0, %1, %2, %0, %3, %3 op_sel_hi:[0,0,0]" : "+v"(acc[ai][bj][m][n]) : "v"(a8), "v"(b8), "v"(one8)); } \
        else { _Pragma("unroll") for (int k = 0; k < 2; ++k) acc[ai][bj][m][n] = __builtin_amdgcn_mfma_f32_16x16x32_bf16(Bt[n][k], At[m][k], acc[ai][bj][m][n], 0, 0, 0); } } \
        __builtin_amdgcn_s_setprio(0); } while (0)
#define PG8_WAIT_V(n) asm volatile("s_waitcnt vmcnt(" #n ")" ::: "memory")
#define PG8_WAIT_L(n) asm volatile("s_waitcnt lgkmcnt(" #n ")" ::: "memory")
#define PG8_BAR __builtin_amdgcn_s_barrier()
#define PG8_SCHED __builtin_amdgcn_sched_barrier(0)
    Unit cur, nxt; int ui = 0;
    if (!S.next(0, cur)) return;
    f32x4 acc[2][2][4][2];
#pragma unroll
    for (int a = 0; a < 2; ++a)
#pragma unroll
        for (int b = 0; b < 2; ++b)
#pragma unroll
            for (int m = 0; m < 4; ++m)
#pragma unroll
                for (int n = 0; n < 2; ++n) acc[a][b][m][n] = (f32x4){0.f, 0.f, 0.f, 0.f};
    bf16x8 At[4][2], B0[2][2], B1[2][2];
    int one8 = 0x7F7F7F7F; asm volatile("" : "+v"(one8));
    const char* cA = (const char*)g.A + (size_t)cur.pm * tstep; const char* cB = (const char*)g.Bt + (size_t)cur.pn * tstep;
    S.a_ready(cur);
    if constexpr (SP2) {
        PG8_STAGE(PG8_SB(0, 0), cB, voffB); PG8_STAGE(PG8_SB(0, 1), cB + hstep, voffB); PG8_STAGE(PG8_SA(0, 0), cA, voffA); PG8_STAGE(PG8_SA(0, 1), cA + hstep, voffA);
        if (wr == 1) PG8_BAR;
        PG8_WAIT_V(2); PG8_BAR;
        PG8_STAGE(PG8_SB(1, 0), cB + kstep, voffB); PG8_STAGE(PG8_SA(1, 0), cA + kstep, voffA); PG8_STAGE(PG8_SB(1, 1), cB + hstep + kstep, voffB);
        PG8_WAIT_V(6); PG8_BAR;
    } else {
        PG8_STAGE(PG8_SB(0, 0), cB, voffB); PG8_STAGE(PG8_SA(0, 0), cA, voffA); PG8_STAGE(PG8_SB(0, 1), cB + hstep, voffB); PG8_STAGE(PG8_SA(0, 1), cA + hstep, voffA);
        if (wr == 1) PG8_BAR;
        PG8_WAIT_V(4); PG8_BAR;
        PG8_STAGE(PG8_SB(1, 0), cB + kstep, voffB); PG8_STAGE(PG8_SA(1, 0), cA + kstep, voffA); PG8_STAGE(PG8_SB(1, 1), cB + hstep + kstep, voffB);
        PG8_WAIT_V(6); PG8_BAR;
    }
    for (;;) {
        const bool has_next = S.next(ui + 1, nxt);
        const char* nA = has_next ? (const char*)g.A + (size_t)nxt.pm * tstep : cA; const char* nB = has_next ? (const char*)g.Bt + (size_t)nxt.pn * tstep : cB;
        for (int t = 0; t < nt; t += 2) {
            const bool last = (t == nt - 2);
            const char* a1 = cA + (size_t)(t + 1) * kstep;
            const char* a2 = last ? nA : cA + (size_t)(t + 2) * kstep; const char* b2 = last ? nB : cB + (size_t)(t + 2) * kstep;
            const char* a3 = a2 + kstep; const char* b3 = b2 + kstep;
            if (last && has_next) S.a_ready(nxt);
            if constexpr (SP2) {
            PG8_LDB(B0, 0, 0); PG8_LDB(B1, 0, 1); PG8_SCHED; PG8_LDA(At, 0, 0); PG8_STAGE(PG8_SA(1, 1), a1 + hstep, voffA);
            PG8_WAIT_V(8); PG8_WAIT_L(0); PG8_BAR; PG8_MMA(0, 0, At, B0); PG8_MMA(0, 1, At, B1); PG8_BAR; PG8_SCHED;
            PG8_LDA(At, 0, 1); PG8_STAGE(PG8_SB(0, 0), b2, voffB); PG8_STAGE(PG8_SB(0, 1), b2 + hstep, voffB); PG8_STAGE(PG8_SA(0, 0), a2, voffA);
            PG8_WAIT_V(8); PG8_WAIT_L(0); PG8_BAR; PG8_MMA(1, 0, At, B0); PG8_MMA(1, 1, At, B1); PG8_BAR; PG8_SCHED;
            PG8_LDB(B0, 1, 0); PG8_LDB(B1, 1, 1); PG8_SCHED; PG8_LDA(At, 1, 0); PG8_STAGE(PG8_SA(0, 1), a2 + hstep, voffA);
            PG8_WAIT_V(8); PG8_WAIT_L(0); PG8_BAR; PG8_MMA(0, 0, At, B0); PG8_MMA(0, 1, At, B1); PG8_BAR; PG8_SCHED;
            PG8_LDA(At, 1, 1); PG8_STAGE(PG8_SB(1, 0), b3, voffB); PG8_STAGE(PG8_SB(1, 1), b3 + hstep, voffB); PG8_STAGE(PG8_SA(1, 0), a3, voffA);
            PG8_WAIT_V(8); PG8_WAIT_L(0); PG8_BAR; PG8_MMA(1, 0, At, B0); PG8_MMA(1, 1, At, B1); PG8_BAR; PG8_SCHED;
            } else {
            PG8_LDB(B0, 0, 0); PG8_SCHED; PG8_LDA(At, 0, 0); PG8_STAGE(PG8_SA(1, 1), a1 + hstep, voffA);
            PG8_WAIT_L(8); PG8_BAR; PG8_WAIT_L(0); PG8_MMA(0, 0, At, B0); PG8_BAR; PG8_SCHED;
            PG8_LDB(B1, 0, 1); PG8_STAGE(PG8_SB(0, 0), b2, voffB);
            PG8_BAR; PG8_WAIT_L(0); PG8_MMA(0, 1, At, B1); PG8_BAR;
            PG8_LDA(At, 0, 1); PG8_STAGE(PG8_SA(0, 0), a2, voffA);
            PG8_BAR; PG8_WAIT_L(0); PG8_MMA(1, 0, At, B0); PG8_BAR; PG8_SCHED;
            PG8_STAGE(PG8_SB(0, 1), b2 + hstep, voffB);
            PG8_WAIT_V(6); PG8_BAR; PG8_MMA(1, 1, At, B1); PG8_BAR;
            PG8_LDB(B0, 1, 0); PG8_SCHED; PG8_LDA(At, 1, 0); PG8_STAGE(PG8_SA(0, 1), a2 + hstep, voffA);
            PG8_WAIT_L(8); PG8_BAR; PG8_WAIT_L(0); PG8_MMA(0, 0, At, B0); PG8_BAR; PG8_SCHED;
            PG8_LDB(B1, 1, 1); PG8_STAGE(PG8_SB(1, 0), b3, voffB);
            PG8_BAR; PG8_WAIT_L(0); PG8_MMA(0, 1, At, B1); PG8_BAR;
            PG8_LDA(At, 1, 1); PG8_STAGE(PG8_SA(1, 0), a3, voffA);
            PG8_BAR; PG8_WAIT_L(0); PG8_MMA(1, 0, At, B0); PG8_BAR; PG8_SCHED;
            PG8_STAGE(PG8_SB(1, 1), b3 + hstep, voffB);
            PG8_WAIT_V(6); PG8_BAR; PG8_MMA(1, 1, At, B1); PG8_BAR;
            }
        }
        if constexpr (OPK == 1) {
            asm volatile("s_nop 15\n\ts_nop 7" ::: "memory");
#pragma unroll
            for (int a_ = 0; a_ < 2; ++a_)
#pragma unroll
                for (int b_ = 0; b_ < 2; ++b_)
#pragma unroll
                    for (int m_ = 0; m_ < 4; ++m_) asm volatile("" : "+v"(acc[a_][b_][m_][0]), "+v"(acc[a_][b_][m_][1]));
        }
        if constexpr (ALIGN_EPI) { if (wr == 0) PG8_BAR; }
        if constexpr (!Epi::AFTER_DRAIN) { E(acc, cur, wr, wc, fr, fq); S.done(cur); }
        if (!has_next) break;
#pragma unroll
        for (int a = 0; a < 2; ++a)
#pragma unroll
            for (int b = 0; b < 2; ++b)
#pragma unroll
                for (int m = 0; m < 4; ++m)
#pragma unroll
                    for (int n = 0; n < 2; ++n) acc[a][b][m][n] = (f32x4){0.f, 0.f, 0.f, 0.f};
        cur = nxt; cA = nA; cB = nB; ++ui;
        if constexpr (ALIGN_EPI) { if (wr == 1) PG8_BAR; }
    }
    PG8_WAIT_V(0);
    if constexpr (!ALIGN_EPI) { if (wr == 0) PG8_BAR; }
    PG8_BAR;
    if constexpr (Epi::AFTER_DRAIN) { E.fused(acc, cur, wr, wc, fr, fq, lds, wid, lane); S.done(cur); }
#undef PG8_SA
#undef PG8_SB
#undef PG8_STAGE
#undef PG8_LDA
#undef PG8_LDB
#undef PG8_MMA
#undef PG8_WAIT_V
#undef PG8_WAIT_L
#undef PG8_BAR
#undef PG8_SCHED
}
}

__device__ __forceinline__ unsigned pk2(float lo, float hi) { return (unsigned)f2bf(lo) | ((unsigned)f2bf(hi) << 16); }
__device__ __forceinline__ void transpose_item(const float* W, int K, int N, bf16_t* WT, float* scr, int item, int lane) {
    const int nblk = N / 32, kb = item / nblk, nbk = item % nblk, k0 = 64 * kb, n0 = 32 * nbk;
#pragma unroll 8
    for (int i = 0; i < 32; ++i) { const int kk = 2 * i + (lane >> 5); scr[kk * 33 + (lane & 31)] = W[(size_t)(k0 + kk) * N + n0 + (lane & 31)]; }
    asm volatile("s_waitcnt lgkmcnt(0)" ::: "memory");
    const int c = lane & 7;
#pragma unroll
    for (int j = 0; j < 4; ++j) { const int n = (lane >> 3) + 8 * j; const float* s = scr + (8 * c) * 33 + n;
        uint4 o; o.x = pk2(s[0 * 33], s[1 * 33]); o.y = pk2(s[2 * 33], s[3 * 33]); o.z = pk2(s[4 * 33], s[5 * 33]); o.w = pk2(s[6 * 33], s[7 * 33]);
        *(uint4*)(WT + (size_t)(n0 + n) * K + k0 + 8 * c) = o; }
    asm volatile("s_waitcnt lgkmcnt(0)" ::: "memory");
}
constexpr int CW_AMAXP = 16384;
constexpr int CW_AMAX_WIN = 2048, CW_AMAX_WOUT = 2112, CW_WSCALE = 2176, CW_AMAX_WQ = 2240;
__device__ __forceinline__ void phase_amax(KP p, int bid, int nb, int wv_) {
    const int tid = opaque_tid(), lane = tid & 63;
    for (int t = 0; t < 3; ++t) {
        const float4* w = (const float4*)(t == 2 ? p->in[I_WQ] : t ? p->in[I_WOUT] : p->in[I_WIN]); const size_t n4 = (size_t)D * (t ? D : NPROJ) / 4;
        float am = 0.f;
        for (size_t i = (size_t)bid * NT + tid; i < n4; i += (size_t)nb * NT) { const float4 v = w[i]; am = fmaxf(am, fmaxf(fmaxf(fabsf(v.x), fabsf(v.y)), fmaxf(fabsf(v.z), fabsf(v.w)))); }
        am = wave_max(am);
        if (lane == 0) ((float*)(p->ws + WS_CTL) + CW_AMAXP)[(size_t)t * 8 * nb + bid * 8 + (tid >> 6)] = am;
    }
}
template <bool I8>
__device__ __forceinline__ void transpose_item8(const float* W, int K, int N, unsigned char* WT, float* scr, int item, int lane, float sc) {
    const int nblk = N / 32, kb = item / nblk, nbk = item % nblk, k0 = 64 * kb, n0 = 32 * nbk;
#pragma unroll 8
    for (int i = 0; i < 32; ++i) { const int kk = 2 * i + (lane >> 5); scr[kk * 33 + (lane & 31)] = W[(size_t)(k0 + kk) * N + n0 + (lane & 31)]; }
    asm volatile("s_waitcnt lgkmcnt(0)" ::: "memory");
    const int c = lane & 3;
#pragma unroll
    for (int j = 0; j < 2; ++j) { const int n = (lane >> 2) + 16 * j; const float* s = scr + (16 * c) * 33 + n;
        uint4 o;
        if (I8) { o.x = pk4_i8(s[0 * 33] * sc, s[1 * 33] * sc, s[2 * 33] * sc, s[3 * 33] * sc); o.y = pk4_i8(s[4 * 33] * sc, s[5 * 33] * sc, s[6 * 33] * sc, s[7 * 33] * sc);
            o.z = pk4_i8(s[8 * 33] * sc, s[9 * 33] * sc, s[10 * 33] * sc, s[11 * 33] * sc); o.w = pk4_i8(s[12 * 33] * sc, s[13 * 33] * sc, s[14 * 33] * sc, s[15 * 33] * sc); }
        else { o.x = pk4_fp8(s[0 * 33] * sc, s[1 * 33] * sc, s[2 * 33] * sc, s[3 * 33] * sc); o.y = pk4_fp8(s[4 * 33] * sc, s[5 * 33] * sc, s[6 * 33] * sc, s[7 * 33] * sc);
            o.z = pk4_fp8(s[8 * 33] * sc, s[9 * 33] * sc, s[10 * 33] * sc, s[11 * 33] * sc); o.w = pk4_fp8(s[12 * 33] * sc, s[13 * 33] * sc, s[14 * 33] * sc, s[15 * 33] * sc); }
        *(uint4*)(WT + (size_t)(n0 + n) * K + k0 + 16 * c) = o; }
    asm volatile("s_waitcnt lgkmcnt(0)" ::: "memory");
}
__device__ __forceinline__ void phase_convert_weights8(KP p, float* lds, int bid, int nb, int wv_) {
    const int tid = opaque_tid(), lane = tid & 63, wave = tid >> 6;
    float* scr = lds + 4096 + wave * (64 * 33);
    const unsigned* ctl = (const unsigned*)(p->ws + WS_CTL);
    float am3[3];
    { float* red = lds + 4000;
      const float* part = (const float*)(p->ws + WS_CTL) + CW_AMAXP;
#pragma unroll
      for (int t = 0; t < 3; ++t) { float a = 0.f; for (int i = tid; i < 8 * nb; i += NT) a = fmaxf(a, part[(size_t)t * 8 * nb + i]); a = wave_max(a); if (lane == 0) red[t * 8 + wave] = a; }
      __syncthreads();
#pragma unroll
      for (int t = 0; t < 3; ++t) { float a = 0.f;
#pragma unroll
          for (int k = 0; k < 8; ++k) a = fmaxf(a, red[t * 8 + k]);
          am3[t] = a; }
      __syncthreads(); }
    const float am_in = am3[0]; const float sc_in = am_in > 0.f ? 127.f / am_in : 0.f;
    const float sc_out = pow2_scale_from_max(am3[1]);
    if (bid == 0 && tid == 0) { ((float*)(p->ws + WS_CTL))[CW_WSCALE] = am_in * (1.f / 127.f); ((float*)(p->ws + WS_CTL))[CW_WSCALE + 1] = 1.f / sc_out; }
    const int gw = bid * 8 + wave, ngw = nb * 8;
    constexpr int I_IN = (D / 64) * (NPROJ / 32), I_SQ = (D / 64) * (D / 32);
    const float am_q = am3[2]; const float sc_q = am_q > 0.f ? 127.f / am_q : 0.f;
    if (bid == 0 && tid == 0) ((float*)(p->ws + WS_CTL))[CW_WSCALE + 2] = am_q * (1.f / 127.f);
    for (int it = gw; it < I_IN + 2 * I_SQ; it += ngw) {
        if (it < I_IN) transpose_item8<true>(p->in[I_WIN], D, NPROJ, p->ws + WS_WIN_T, scr, it, lane, sc_in);
        else if (it < I_IN + I_SQ) transpose_item8<false>(p->in[I_WOUT], D, D, p->ws + WS_WOUT_T, scr, it - I_IN, lane, sc_out);
        else transpose_item8<true>(p->in[I_WQ], D, D, p->ws + WS_WQ_T, scr, it - I_IN - I_SQ, lane, sc_q);
    }
}
__device__ __forceinline__ void phase_convert_weights(KP p, float* lds, int bid, int nb, int wv_) {
    const int tid = opaque_tid(), lane = tid & 63, wave = tid >> 6;
    float* scr = lds + wave * (64 * 33);
    const int gw = bid * 8 + wave, ngw = nb * 8;
    constexpr int I_SQ = (D / 64) * (D / 32), I_G = 8 * (128 / 64) * (128 / 32);
    constexpr int NITEMS = 2 * I_G;
    for (int it = gw; it < NITEMS; it += ngw) {
        int r = it;

        if (r < I_G) { const int hd = r / 8; transpose_item(p->in[I_WGA] + hd * 16384, 128, 128, (bf16_t*)(p->ws + WS_WGA_T) + hd * 16384, scr, r % 8, lane); continue; } r -= I_G;
        { const int hd = r / 8; transpose_item(p->in[I_WGI] + hd * 16384, 128, 128, (bf16_t*)(p->ws + WS_WGI_T) + hd * 16384, scr, r % 8, lane); }
    }
    bf16_t* wsp = (bf16_t*)(p->ws + WS_WSPB); bf16_t* skb = (bf16_t*)(p->ws + WS_SKEYB);
    for (int e = bid * NT + tid; e < 8 * 128 * 128; e += nb * NT) { const int i = (e >> 7) & 127, j = e & 127; wsp[e] = f2bf(j <= i ? p->in[I_WSP][e] : 0.f); }
    for (int e = bid * NT + tid; e < 8 * 2 * 128 * 128; e += nb * NT) skb[e] = f2bf(p->in[I_SKEY][e]);
}

typedef short bf16x8_t __attribute__((ext_vector_type(8)));
typedef float f32x4_t __attribute__((ext_vector_type(4)));
typedef short s16x4_t __attribute__((ext_vector_type(4)));
constexpr float YMIX_SCALE = 8.f;
constexpr int XA_STRIDE = 272;
constexpr int LRU_XA = 0, LRU_SA = 34816, LRU_SB = LRU_SA + 16384, LRU_SEGP = LRU_SB + 16384, LRU_SEGH = LRU_SEGP + 2048, LRU_WF = LRU_SEGH + 2048;
__device__ __forceinline__ void phase_lru(KP p, unsigned char* lds, int bid, int nb, int wv_) {
    const int tid = opaque_tid(), lane = tid & 63, wave = tid >> 6, c16 = lane & 15, q = lane >> 4;
    const bf16_t* XL = (const bf16_t*)(p->ws + WS_PROJ); const bf16_t* YG = XL + (size_t)M * 1024; bf16_t* ymix = (bf16_t*)(p->ws + WS_YMIX);
    float* SA = (float*)(lds + LRU_SA); float* SB = (float*)(lds + LRU_SB); float* SEGP = (float*)(lds + LRU_SEGP); float* SEGH = (float*)(lds + LRU_SEGH);
    for (int unit = bid; unit < NB * 8 * 4; unit += nb) {
        const int b = unit >> 5, hd = (unit >> 2) & 7, cq = unit & 3;
        for (int i = tid; i < 2 * 32 * 16; i += NT) { const int gs = i >> 9, j = (i >> 4) & 31, o16 = i & 15;
            *(uint4*)(lds + LRU_WF + (gs * 32 + j) * XA_STRIDE + o16 * 16) = *(const uint4*)((const bf16_t*)(p->ws + (gs ? WS_WGI_T : WS_WGA_T)) + (size_t)(hd * 128 + cq * 32 + j) * 128 + o16 * 8); }
        float ba[2], bi[2], c2[2];
#pragma unroll
        for (int nt = 0; nt < 2; ++nt) { const int ch = hd * 128 + cq * 32 + nt * 16 + c16; ba[nt] = p->in[I_BGA][ch]; bi[nt] = p->in[I_BGI][ch];
            const float lam = p->in[I_LAM][ch]; const float sp = fmaxf(-lam, 0.f) + log1pf(__expf(-fabsf(lam))); c2[nt] = -8.f * sp * 1.4426950408889634f; }
        const int o = tid & 15, rg = tid >> 4;
        float cw[4][8], cb[8];
#pragma unroll
        for (int e = 0; e < 8; ++e) { cb[e] = p->in[I_CONVB][hd * 128 + o * 8 + e];
#pragma unroll
            for (int k = 0; k < 4; ++k) cw[k][e] = p->in[I_CONVW][k * DLRU + hd * 128 + o * 8 + e]; }
        const int sc = tid & 31, seg = tid >> 5;
        float carry = 0.f;
        uint4 xr[7];
#define LRU_LOAD_X(t0_) do { _Pragma("unroll") for (int i = 0; i < 7; ++i) { const int t = (t0_) + 4 * rg - 3 + i; const int tc = t < 0 ? 0 : t; const unsigned keep = t < 0 ? 0u : 0xffffffffu; \
            const uint4 w = *(const uint4*)(XL + ((size_t)b * SEQ + tc) * 1024 + hd * 128 + o * 8); xr[i] = make_uint4(w.x & keep, w.y & keep, w.z & keep, w.w & keep); } } while (0)
        LRU_LOAD_X(0);
        for (int ch = 0; ch < SEQ / 128; ++ch) {
            const int t0 = ch * 128; const size_t row0 = (size_t)b * SEQ + t0;
            bf16_t yg[8];
#pragma unroll
            for (int k = 0; k < 8; ++k) yg[k] = YG[(row0 + seg * 8 + k) * 1024 + hd * 128 + cq * 32 + sc];
#pragma unroll
            for (int r = 0; r < 4; ++r) {
                float acc8[8];
#pragma unroll
                for (int e = 0; e < 8; ++e) acc8[e] = cb[e];
#pragma unroll
                for (int k = 0; k < 4; ++k) { const uint4 w = xr[r + k]; const unsigned ww[4] = {w.x, w.y, w.z, w.w};
#pragma unroll
                    for (int e2 = 0; e2 < 4; ++e2) { acc8[2 * e2] += cw[k][2 * e2] * __uint_as_float(ww[e2] << 16); acc8[2 * e2 + 1] += cw[k][2 * e2 + 1] * __uint_as_float(ww[e2] & 0xffff0000u); } }
                uint4 ov; ov.x = pk2(acc8[0], acc8[1]); ov.y = pk2(acc8[2], acc8[3]); ov.z = pk2(acc8[4], acc8[5]); ov.w = pk2(acc8[6], acc8[7]);
                *(uint4*)(lds + LRU_XA + (4 * rg + r) * XA_STRIDE + o * 16) = ov;
            }
            if (ch + 1 < SEQ / 128) {
#pragma unroll
                for (int i = 0; i < 7; ++i) xr[i] = *(const uint4*)(XL + ((size_t)b * SEQ + t0 + 128 + 4 * rg - 3 + i) * 1024 + hd * 128 + o * 8); }
            LDS_BARRIER();
            f32x4_t acc[2][2];
#pragma unroll
            for (int gs = 0; gs < 2; ++gs)
#pragma unroll
                for (int nt = 0; nt < 2; ++nt) acc[gs][nt] = (f32x4_t){0.f, 0.f, 0.f, 0.f};
#pragma unroll
            for (int ks = 0; ks < 4; ++ks) {
                const bf16x8_t a = *(const bf16x8_t*)(lds + LRU_XA + (16 * wave + c16) * XA_STRIDE + (ks * 32 + 8 * q) * 2);
#pragma unroll
                for (int gs = 0; gs < 2; ++gs)
#pragma unroll
                    for (int nt = 0; nt < 2; ++nt) { const bf16x8_t wfr = *(const bf16x8_t*)(lds + LRU_WF + (gs * 32 + nt * 16 + c16) * XA_STRIDE + (ks * 32 + 8 * q) * 2);
                        acc[gs][nt] = __builtin_amdgcn_mfma_f32_16x16x32_bf16(a, wfr, acc[gs][nt], 0, 0, 0); }
            }
#pragma unroll
            for (int nt = 0; nt < 2; ++nt)
#pragma unroll
                for (int reg = 0; reg < 4; ++reg) {
                    const int t = 16 * wave + 4 * q + reg, jj = nt * 16 + c16;
                    const float za = acc[0][nt][reg] + ba[nt], zi = acc[1][nt][reg] + bi[nt];
                    const float r = __builtin_amdgcn_rcpf(1.f + __expf(-za)), ig = __builtin_amdgcn_rcpf(1.f + __expf(-zi));
                    const float a = __builtin_amdgcn_exp2f(c2[nt] * r);
                    const float xcv = bf2f(*(const bf16_t*)(lds + LRU_XA + t * XA_STRIDE + (cq * 32 + jj) * 2));
                    SA[t * 32 + jj] = a; SB[t * 32 + jj] = __builtin_amdgcn_sqrtf(fmaxf(1.f - a * a, 0.f)) * (ig * xcv);
                }
            LDS_BARRIER();
            float av[8], bv[8];
#pragma unroll
            for (int k = 0; k < 8; ++k) { av[k] = SA[(seg * 8 + k) * 32 + sc]; bv[k] = SB[(seg * 8 + k) * 32 + sc]; }
            float P = 1.f, H = 0.f;
#pragma unroll
            for (int k = 0; k < 8; ++k) { H = av[k] * H + bv[k]; P *= av[k]; }
            SEGP[seg * 32 + sc] = P; SEGH[seg * 32 + sc] = H;
            LDS_BARRIER();
            float run = carry, hin = carry;
            int segl = seg; asm volatile("" : "+v"(segl));
#pragma unroll
            for (int s = 0; s < 16; ++s) { if (s == segl) hin = run; run = SEGP[s * 32 + sc] * run + SEGH[s * 32 + sc]; }
            carry = run;
            H = hin;
#pragma unroll
            for (int k = 0; k < 8; ++k) { H = av[k] * H + bv[k]; ((unsigned char*)ymix)[(row0 + seg * 8 + k) * D + hd * 128 + cq * 32 + sc] = (unsigned char)(pk4_fp8(H * bf2f(yg[k]) * YMIX_SCALE, 0.f, 0.f, 0.f) & 0xffu); }
        }
        __syncthreads();
#undef LRU_LOAD_X
    }
}

constexpr int SGU_RS = 0, SGU_TV = 512, SGU_SS = SGU_TV + 128 * XA_STRIDE, SS_STRIDE = 132;
__device__ __forceinline__ void phase_sgu(KP p, unsigned char* lds, int bid, int nb, int wv_) {
    const int tid = opaque_tid(), lane = tid & 63, wave = tid >> 6, c16 = lane & 15, q = lane >> 4;
    const bf16_t* UG = (const bf16_t*)(p->ws + WS_PROJ) + (size_t)2 * M * 1024; const bf16_t* VG = UG + (size_t)M * 1024;
    const float* ssqv = (const float*)(p->ws + WS_SSQV); bf16_t* ymix = (bf16_t*)(p->ws + WS_YMIX);
    float* RS = (float*)(lds + SGU_RS); float* SS = (float*)(lds + SGU_SS);
    bf16x8_t wa[8][4]; float gvv[8]; int gcur = -1;
    const int oct = tid & 15;
    uint4 vch[4], uch[4]; float4 sq[4];
#define SGU_LOAD_V(itx) do { const int g_ = (itx) & 7; const size_t b_ = (size_t)((itx) >> 3) * 128; _Pragma("unroll") for (int k = 0; k < 4; ++k) vch[k] = *(const uint4*)(VG + (b_ + (tid >> 4) + 32 * k) * 1024 + g_ * 128 + oct * 8); \
        _Pragma("unroll") for (int k = 0; k < 4; ++k) sq[k] = *(const float4*)(ssqv + (b_ + (tid & 127)) * 16 + 4 * k); } while (0)
#define SGU_LOAD_U(itx) do { const int g_ = (itx) & 7; const size_t b_ = (size_t)((itx) >> 3) * 128; _Pragma("unroll") for (int k = 0; k < 4; ++k) uch[k] = *(const uint4*)(UG + (b_ + (tid >> 4) + 32 * k) * 1024 + g_ * 128 + oct * 8); } while (0)
    __syncthreads();
    for (int it = bid; it < NB * 16 * 8; it += nb) {
        const int g = it & 7; const size_t base = (size_t)(it >> 3) * 128;
        if (g != gcur) { gcur = g;
#pragma unroll
            for (int mt = 0; mt < 8; ++mt)
#pragma unroll
                for (int ks = 0; ks < 4; ++ks) if (ks <= ((16 * mt + 15) >> 5))
                    wa[mt][ks] = *(const bf16x8_t*)((const bf16_t*)(p->ws + WS_WSPB) + ((size_t)(g * 128 + mt * 16 + c16) * 128 + ks * 32 + 8 * q));
#pragma unroll
            for (int e = 0; e < 8; ++e) gvv[e] = p->in[I_GV][g * 128 + oct * 8 + e]; }
        if (it == bid) { SGU_LOAD_V(it); SGU_LOAD_U(it); }
        if (tid < 128) { const float ss = ((sq[0].x + sq[0].y) + (sq[0].z + sq[0].w)) + ((sq[1].x + sq[1].y) + (sq[1].z + sq[1].w)) + ((sq[2].x + sq[2].y) + (sq[2].z + sq[2].w)) + ((sq[3].x + sq[3].y) + (sq[3].z + sq[3].w));
            RS[tid] = rsqrtf(ss * (1.f / 1024.f) + EPS); }
        LDS_BARRIER();
#pragma unroll
        for (int k = 0; k < 4; ++k) { const int row = (tid >> 4) + 32 * k; const float r = RS[row]; const unsigned ww[4] = {vch[k].x, vch[k].y, vch[k].z, vch[k].w}; unsigned oo[4];
#pragma unroll
            for (int e2 = 0; e2 < 4; ++e2) oo[e2] = pk2(__uint_as_float(ww[e2] << 16) * r * gvv[2 * e2], __uint_as_float(ww[e2] & 0xffff0000u) * r * gvv[2 * e2 + 1]);
            *(uint4*)(lds + SGU_TV + row * XA_STRIDE + oct * 16) = make_uint4(oo[0], oo[1], oo[2], oo[3]); }
        if (it + nb < NB * 16 * 8) SGU_LOAD_V(it + nb);
        LDS_BARRIER();
        bf16x8_t bfr[4];
        { const int q4 = c16 >> 2, p4 = c16 & 3;
#pragma unroll
          for (int ks = 0; ks < 4; ++ks) {
              const unsigned a1 = SGU_TV + (ks * 32 + 8 * q + q4) * XA_STRIDE + (wave * 16 + 4 * p4) * 2;
              const s16x4_t lo = __builtin_amdgcn_ds_read_tr16_b64_v4i16((LAS s16x4_t*)(lds + a1));
              const s16x4_t hi = __builtin_amdgcn_ds_read_tr16_b64_v4i16((LAS s16x4_t*)(lds + a1 + 4 * XA_STRIDE));
              bfr[ks] = __builtin_shufflevector(lo, hi, 0, 1, 2, 3, 4, 5, 6, 7); } }
        f32x4_t acc[8];
#pragma unroll
        for (int mt = 0; mt < 8; ++mt) { acc[mt] = (f32x4_t){0.f, 0.f, 0.f, 0.f};
#pragma unroll
            for (int ks = 0; ks < 4; ++ks) if (ks <= ((16 * mt + 15) >> 5)) acc[mt] = __builtin_amdgcn_mfma_f32_16x16x32_bf16(wa[mt][ks], bfr[ks], acc[mt], 0, 0, 0); }
#pragma unroll
        for (int mt = 0; mt < 8; ++mt)
#pragma unroll
            for (int reg = 0; reg < 4; ++reg) { const int i = mt * 16 + 4 * q + reg; SS[i * SS_STRIDE + wave * 16 + c16] = acc[mt][reg] + p->in[I_BSP][g * 128 + i]; }
        LDS_BARRIER();
#pragma unroll
        for (int k = 0; k < 4; ++k) { const int row = (tid >> 4) + 32 * k; const float4 s0 = *(const float4*)(SS + row * SS_STRIDE + oct * 8), s1 = *(const float4*)(SS + row * SS_STRIDE + oct * 8 + 4);
            const unsigned ww[4] = {uch[k].x, uch[k].y, uch[k].z, uch[k].w}; const float sv[8] = {s0.x, s0.y, s0.z, s0.w, s1.x, s1.y, s1.z, s1.w}; unsigned oo[4];
#pragma unroll
            for (int e2 = 0; e2 < 2; ++e2) oo[e2] = pk4_fp8(__uint_as_float(ww[2 * e2] << 16) * sv[4 * e2] * YMIX_SCALE, __uint_as_float(ww[2 * e2] & 0xffff0000u) * sv[4 * e2 + 1] * YMIX_SCALE,
                                                          __uint_as_float(ww[2 * e2 + 1] << 16) * sv[4 * e2 + 2] * YMIX_SCALE, __uint_as_float(ww[2 * e2 + 1] & 0xffff0000u) * sv[4 * e2 + 3] * YMIX_SCALE);
            *(uint2*)((unsigned char*)ymix + (base + row) * D + 1024 + g * 128 + oct * 8) = make_uint2(oo[0], oo[1]); }
        if (it + nb < NB * 16 * 8) SGU_LOAD_U(it + nb);
        LDS_BARRIER();
    }
#undef SGU_LOAD_V
#undef SGU_LOAD_U
}

typedef float f32x16_t __attribute__((ext_vector_type(16)));
__device__ __forceinline__ float vmaxf(float a, float b) { float r; asm("v_max_f32 %0, %1, %2" : "=v"(r) : "v"(a), "v"(b)); return r; }
__device__ __forceinline__ float vminf(float a, float b) { float r; asm("v_min_f32 %0, %1, %2" : "=v"(r) : "v"(a), "v"(b)); return r; }
#define CE_DESC(a, b) do { const float _mx = vmaxf(a, b), _mn = vminf(a, b); a = _mx; b = _mn; } while (0)
__device__ __forceinline__ void sort16_desc(float (&v)[16]) {
#pragma unroll
    for (int k = 2; k <= 16; k <<= 1)
#pragma unroll
        for (int j = k >> 1; j > 0; j >>= 1)
#pragma unroll
            for (int i = 0; i < 16; ++i) { const int l = i ^ j; if (l > i) { if ((i & k) == 0) CE_DESC(v[i], v[l]); else CE_DESC(v[l], v[i]); } }
}
__device__ __forceinline__ void merge16_desc(float (&a)[16], const float (&b)[16]) {
#pragma unroll
    for (int i = 0; i < 16; ++i) a[i] = vmaxf(a[i], b[15 - i]);
#pragma unroll
    for (int j = 8; j > 0; j >>= 1)
#pragma unroll
        for (int i = 0; i < 16; ++i) { const int l = i ^ j; if (l > i) CE_DESC(a[i], a[l]); }
}
__device__ __forceinline__ void topk_half(const bf16_t* qp, const unsigned char* kl, unsigned hh4, float (&X)[16]) {
    f32x16_t acc[4];
#pragma unroll
    for (int kt = 0; kt < 4; ++kt)
#pragma unroll
        for (int i = 0; i < 16; ++i) acc[kt][i] = 0.f;
#pragma unroll 4
    for (int ks = 0; ks < 8; ++ks) {
        const bf16x8_t bq = *(const bf16x8_t*)(qp + ks * 16);
#pragma unroll
        for (int kt = 0; kt < 4; ++kt) { const bf16x8_t ak = *(const bf16x8_t*)(kl + kt * 32 * XA_STRIDE + ks * 32); acc[kt] = __builtin_amdgcn_mfma_f32_32x32x16_bf16(ak, bq, acc[kt], 0, 0, 0); }
    }
    float g[4][16];
#pragma unroll
    for (int kt = 0; kt < 4; ++kt)
#pragma unroll
        for (int reg = 0; reg < 16; ++reg) g[kt][reg] = __uint_as_float(((__float_as_uint(acc[kt][reg]) & 0xFFFFFF80u) | hh4) | (unsigned)(kt * 32 + (reg & 3) + 8 * (reg >> 2)));
    sort16_desc(g[0]); sort16_desc(g[1]); __builtin_amdgcn_sched_barrier(0); merge16_desc(g[0], g[1]); __builtin_amdgcn_sched_barrier(0);
    sort16_desc(g[2]); sort16_desc(g[3]); __builtin_amdgcn_sched_barrier(0); merge16_desc(g[2], g[3]); __builtin_amdgcn_sched_barrier(0); merge16_desc(g[0], g[2]);
#pragma unroll
    for (int i = 0; i < 16; ++i) X[i] = g[0][i];
}
__device__ __forceinline__ unsigned pack_b0(float a, float b, float c, float d) {
    const unsigned ab = __builtin_amdgcn_perm(__float_as_uint(b), __float_as_uint(a), 0x0c0c0400u), cd = __builtin_amdgcn_perm(__float_as_uint(d), __float_as_uint(c), 0x0c0c0400u);
    return __builtin_amdgcn_perm(cd, ab, 0x05040100u);
}
__device__ __forceinline__ unsigned byte_lookup(const unsigned (&pk)[4], unsigned e) {
    const unsigned lo = __builtin_amdgcn_perm(pk[1], pk[0], e & 7u), hi = __builtin_amdgcn_perm(pk[3], pk[2], e & 7u);
    return ((e & 8u) ? hi : lo) & 0x7Fu;
}
__device__ __forceinline__ void phase_topk(KP p, unsigned char* lds, int bid, int nb, int wv_) {
    const int tid = opaque_tid(), lane = tid & 63, wave = tid >> 6, r32 = lane & 31, hh = lane >> 5;
    const bf16_t* Q = (const bf16_t*)(p->ws + WS_Q); const bf16_t* KB = (const bf16_t*)(p->ws + WS_SKEYB);
    int* idx = (int*)(p->ws + WS_IDX); float* gate = (float*)(p->ws + WS_GATE);
    const float NEG = -3.0e38f;
    int hcur = -1;
    for (int bi = bid; bi < NHEAD * (M / 256); bi += nb) {
        const int hd = bi & 7, tile = (bi >> 3) * 8 + wave; const size_t token = (size_t)tile * 32 + r32;
        if (hd != hcur) { hcur = hd; __syncthreads();
#pragma unroll
            for (int k = 0; k < 8; ++k) { const int c = tid + NT * k, row = c >> 4, o = c & 15;
                *(uint4*)(lds + row * XA_STRIDE + o * 16) = *(const uint4*)(KB + ((size_t)hd * 256 + row) * 128 + o * 8); }
            __syncthreads(); }
        float X0[16], X1[16];
        topk_half(Q + token * D + hd * 256 + 8 * hh, lds + r32 * XA_STRIDE + hh * 16, 4u * hh, X0);
        __builtin_amdgcn_sched_barrier(0);
        topk_half(Q + token * D + hd * 256 + 128 + 8 * hh, lds + (128 + r32) * XA_STRIDE + hh * 16, 4u * hh, X1);
        __builtin_amdgcn_sched_barrier(0);
#pragma unroll
        for (int i = 0; i < 16; ++i) { const auto r = __builtin_amdgcn_permlane32_swap(__float_as_uint(X0[i]), __float_as_uint(X1[i]), false, false); X0[i] = __uint_as_float(r[0]); X1[i] = __uint_as_float(r[1]); }
        merge16_desc(X0, X1);
        float U[16];
#pragma unroll
        for (int i = 0; i < 16; ++i) U[i] = __shfl_xor(X0[i], 32);
        const unsigned hbit = (unsigned)hh << 8;
        float c0[16], c1[16];
#pragma unroll
        for (int j = 0; j < 16; ++j) { float s = X0[0] + U[j]; if (j == 0) s = hh ? NEG : s; c0[j] = __uint_as_float(((__float_as_uint(s) & 0xFFFFFE00u) | hbit) | (unsigned)j); }
        {
            int n = 0;
#pragma unroll
            for (int i = 1; i < 4; ++i)
#pragma unroll
                for (int j = i; j < 16; ++j) if ((i + 1) * (j + 1) <= 16) { float s = X0[i] + U[j]; if (j == i) s = hh ? NEG : s; c1[n] = __uint_as_float(((__float_as_uint(s) & 0xFFFFFE00u) | hbit) | (unsigned)(i * 16 + j)); ++n; }
#pragma unroll
            for (int k = 11; k < 16; ++k) c1[k] = NEG;
        }
        sort16_desc(c0); sort16_desc(c1); merge16_desc(c0, c1);
        float F[16];
#pragma unroll
        for (int i = 0; i < 16; ++i) F[i] = vmaxf(c0[i], __shfl_xor(c0[15 - i], 32));
        float mx = F[0];
#pragma unroll
        for (int i = 1; i < 16; ++i) mx = vmaxf(mx, F[i]);
        float ev[16], sum = 0.f;
#pragma unroll
        for (int i = 0; i < 16; ++i) { ev[i] = __expf(F[i] - mx); sum += ev[i]; }
        const float inv = 1.f / sum;
        unsigned pt[4], pu[4], pa[4], pb[4];
#pragma unroll
        for (int w = 0; w < 4; ++w) { pt[w] = pack_b0(X0[4 * w], X0[4 * w + 1], X0[4 * w + 2], X0[4 * w + 3]); pu[w] = pack_b0(U[4 * w], U[4 * w + 1], U[4 * w + 2], U[4 * w + 3]); }
#pragma unroll
        for (int w = 0; w < 4; ++w) { pa[w] = hh ? pu[w] : pt[w]; pb[w] = hh ? pt[w] : pu[w]; }
        int oi[8]; float og[8];
#pragma unroll
        for (int k = 0; k < 8; ++k) {
            const unsigned pl = __float_as_uint(F[k]) & 0x1FFu, sw = pl >> 8, pi = (pl >> 4) & 15u, pj = pl & 15u;
            const unsigned ai = sw ? pj : pi, bj = sw ? pi : pj;
            oi[k] = (int)(byte_lookup(pa, ai) * NKEYS + byte_lookup(pb, bj)); og[k] = ev[k] * inv;
        }
        int* io = idx + token * NSEL + hd * TOPK + 8 * hh; float* go = gate + token * NSEL + hd * TOPK + 8 * hh;
        { typedef __fp16 h2v_ __attribute__((ext_vector_type(2)));
          const h2v_ g0 = __builtin_amdgcn_cvt_pkrtz(og[0], og[1]), g1 = __builtin_amdgcn_cvt_pkrtz(og[2], og[3]), g2 = __builtin_amdgcn_cvt_pkrtz(og[4], og[5]), g3 = __builtin_amdgcn_cvt_pkrtz(og[6], og[7]);
          *(uint4*)((unsigned short*)(p->ws + WS_GATE) + token * NSEL + hd * TOPK + 8 * hh) = make_uint4(__builtin_bit_cast(unsigned, g0), __builtin_bit_cast(unsigned, g1), __builtin_bit_cast(unsigned, g2), __builtin_bit_cast(unsigned, g3)); }
        *(uint4*)(p->ws + WS_IDXT + ((((size_t)(token >> 6) * 16 + 2 * hd + hh) * 64 + (token & 63)) * 16)) = make_uint4((unsigned)oi[0] | ((unsigned)oi[1] << 16), (unsigned)oi[2] | ((unsigned)oi[3] << 16), (unsigned)oi[4] | ((unsigned)oi[5] << 16), (unsigned)oi[6] | ((unsigned)oi[7] << 16));
    }
}

__device__ __forceinline__ void wave_argmax(float& v, int& i) {
#pragma unroll
    for (int off = 32; off >= 1; off >>= 1) { const float ov = __shfl_xor(v, off); const int oi = __shfl_xor(i, off); if (ov > v || (ov == v && oi < i)) { v = ov; i = oi; } }
}
__device__ __forceinline__ void topk_half_naive(const bf16_t* q, const float* k0, int lane, float& outv, int& outi) {
    const float NEG = -3.0e38f;
    const float* k1 = k0 + 64 * 128;
    float s0 = 0.f, s1 = 0.f;
    for (int k = 0; k < 128; k += 4) {
        const uint2 qq = *(const uint2*)(q + k);
        const float q0 = bf2f((bf16_t)(qq.x & 0xffff)), q1 = bf2f((bf16_t)(qq.x >> 16)), q2 = bf2f((bf16_t)(qq.y & 0xffff)), q3 = bf2f((bf16_t)(qq.y >> 16));
        const float4 a = *(const float4*)(k0 + k), b = *(const float4*)(k1 + k);
        s0 += q0 * a.x + q1 * a.y + q2 * a.z + q3 * a.w; s1 += q0 * b.x + q1 * b.y + q2 * b.z + q3 * b.w;
    }
    float myv = NEG; int myi = 0;
    for (int r = 0; r < TOPK; ++r) {
        float v; int i; if (s0 >= s1) { v = s0; i = lane; } else { v = s1; i = lane + 64; }
        wave_argmax(v, i);
        if (i == lane) s0 = NEG; if (i == lane + 64) s1 = NEG;
        if (lane == r) { myv = v; myi = i; }
    }
    outv = myv; outi = myi;
}
__device__ __forceinline__ void phase_topk_naive(KP p, int bid, int nb, int wv_) {
    const bf16_t* Q = (const bf16_t*)(p->ws + WS_Q); const float* keys = p->in[I_SKEY];
    int* idx = (int*)(p->ws + WS_IDX); float* gate = (float*)(p->ws + WS_GATE);
    const int tid = opaque_tid(), lane = tid & 63, wave = tid >> 6;
    const float NEG = -3.0e38f;
    for (int task = bid * 8 + wave; task < M * NHEAD; task += nb * 8) {
        const int token = task >> 3, hd = task & 7;
        float tv0, tv1; int ti0, ti1;
        topk_half_naive(Q + (size_t)token * D + hd * 256, keys + ((size_t)(hd * 2) * 128 + lane) * 128, lane, tv0, ti0);
        topk_half_naive(Q + (size_t)token * D + hd * 256 + 128, keys + ((size_t)(hd * 2 + 1) * 128 + lane) * 128, lane, tv1, ti1);
        const float vb = __shfl(tv1, lane & 15);
        float c0 = __shfl(tv0, (lane >> 4)) + vb, c1 = __shfl(tv0, (lane >> 4) + 4) + vb, c2 = __shfl(tv0, (lane >> 4) + 8) + vb, c3 = __shfl(tv0, (lane >> 4) + 12) + vb;
        float selv = NEG; int selc = 0;
        for (int r = 0; r < TOPK; ++r) {
            float v = c0; int i = lane;
            if (c1 > v) { v = c1; i = lane + 64; }
            if (c2 > v) { v = c2; i = lane + 128; }
            if (c3 > v) { v = c3; i = lane + 192; }
            wave_argmax(v, i);
            if (i == lane) c0 = NEG; if (i == lane + 64) c1 = NEG; if (i == lane + 128) c2 = NEG; if (i == lane + 192) c3 = NEG;
            if (lane == r) { selv = v; selc = i; }
        }
        const float mx = __shfl(selv, 0);
        const float e = lane < TOPK ? __expf(selv - mx) : 0.f;
        const float sum = wave_sum(e);
        const int i1 = __shfl(ti0, selc >> 4), i2 = __shfl(ti1, selc & 15);
        if (lane < TOPK) { idx[(size_t)token * NSEL + hd * TOPK + lane] = i1 * NKEYS + i2; gate[(size_t)token * NSEL + hd * TOPK + lane] = e / sum; }
    }
}

typedef float f32x2_t __attribute__((ext_vector_type(2)));
constexpr size_t GRP_BYTES = (size_t)NKEYS * NKEYS * 128;
constexpr int NGRP = D / 128;
constexpr size_t VSL_BYTES = (size_t)NKEYS * NKEYS * 8;
constexpr int NVSL = D / 8;
__device__ __forceinline__ void phase_convert_experts(KP p, int bid, int nb, int wv_) {
    const int tid = opaque_tid(), lane = tid & 63, wave = tid >> 6;
    constexpr int PITCH = D + 16;
    LAS unsigned char* tile = dyn_lds_base();
    __syncthreads();
    for (int rb = bid; rb < 2 * NKEYS * NKEYS / 16; rb += nb) {
        const int t = rb * 16 >= NKEYS * NKEYS;
#pragma unroll 1
        for (int i2 = 0; i2 < 2; ++i2) {
            const int r16 = wave * 2 + i2, row = rb * 16 + r16, e = row - t * NKEYS * NKEYS;
            const float* src = (t ? p->in[I_EV] : p->in[I_EU]) + (size_t)e * D;
            float4 v[8]; float am = 0.f;
#pragma unroll
            for (int j = 0; j < 8; ++j) { v[j] = *(const float4*)(src + lane * 4 + 256 * j); am = fmaxf(am, fmaxf(fmaxf(fabsf(v[j].x), fabsf(v[j].y)), fmaxf(fabsf(v[j].z), fabsf(v[j].w)))); }
            am = wave_max(am);
            const float sc = am > 0.f ? 127.f / am : 0.f;
#pragma unroll
            for (int j = 0; j < 8; ++j) *(LAS unsigned*)(tile + r16 * PITCH + lane * 4 + 256 * j) = pk4_i8(v[j].x * sc, v[j].y * sc, v[j].z * sc, v[j].w * sc);
            if (lane == 0) ((float*)(p->ws + WS_ESCALE))[row] = am * (1.f / 127.f);
        }
        {
            LDS_BARRIER();
            const int e0 = rb * 16 - t * NKEYS * NKEYS, pc = tid & 7;
#pragma unroll
            for (int rd = 0; rd < 4; ++rd) { const int slc = rd * 64 + (tid >> 3);
                const v2u_t lo = *(LAS const v2u_t*)(tile + (2 * pc) * PITCH + slc * 8), hi = *(LAS const v2u_t*)(tile + (2 * pc + 1) * PITCH + slc * 8);
                *(uint4*)(p->ws + (t ? WS_EV8 : WS_EU8) + (size_t)slc * VSL_BYTES + (size_t)(e0 + 2 * pc) * 8) = make_uint4(lo[0], lo[1], hi[0], hi[1]); }
            LDS_BARRIER();
        }
    }
}
__device__ __forceinline__ unsigned xb_xcc_id();
constexpr int PEER_TT = 16;
constexpr int PEER_NTILE = M / PEER_TT;
constexpr int CW_UQ = 4096, CW_VQ = 8192;
__device__ __forceinline__ float dpp_xor1(float v) { return __builtin_bit_cast(float, __builtin_amdgcn_update_dpp(0, __builtin_bit_cast(int, v), 0xB1, 0xF, 0xF, true)); }
__device__ __forceinline__ float dpp_xor2(float v) { return __builtin_bit_cast(float, __builtin_amdgcn_update_dpp(0, __builtin_bit_cast(int, v), 0x4E, 0xF, 0xF, true)); }
__device__ __forceinline__ float dpp_hmirror(float v) { return __builtin_bit_cast(float, __builtin_amdgcn_update_dpp(0, __builtin_bit_cast(int, v), 0x141, 0xF, 0xF, true)); }
__device__ __forceinline__ void pg_load_ids(const unsigned short* idx16, size_t token, int k, unsigned c16, unsigned (&off)[16]) {
#pragma unroll
    for (int i = 0; i < 2; ++i) { const uint4 v = *(const uint4*)(idx16 + token * NSEL + 16 * k + 8 * i); const unsigned w[4] = {v.x, v.y, v.z, v.w};
#pragma unroll
        for (int j = 0; j < 4; ++j) { off[8 * i + 2 * j] = ((w[j] & 0xffffu) << 7) + c16; off[8 * i + 2 * j + 1] = ((w[j] >> 16) << 7) + c16; } }
}
__device__ __forceinline__ void pg_load_lines(const unsigned char* tg, const unsigned (&off)[16], uint4 (&r)[16]) {
#pragma unroll
    for (int j = 0; j < 16; ++j) r[j] = *(const uint4*)(tg + off[j]);
}
typedef _Float16 h2_t __attribute__((ext_vector_type(2)));
__device__ __forceinline__ int dppi(int v, int ctrl_sel) { return ctrl_sel == 0 ? __builtin_amdgcn_update_dpp(0, v, 0xB1, 0xF, 0xF, true) : ctrl_sel == 1 ? __builtin_amdgcn_update_dpp(0, v, 0x4E, 0xF, 0xF, true) : __builtin_amdgcn_update_dpp(0, v, 0x141, 0xF, 0xF, true); }
__device__ __forceinline__ int dot4_0(int a, int b) { int d; asm("v_dot4_i32_i8 %0, %1, %2, 0" : "=v"(d) : "v"(a), "v"(b)); return d; }
__device__ __forceinline__ void pg_compute_u(const uint4 (&r)[16], const uint4 (&hw)[2], short* po, int c) {
    int d[16];
#pragma unroll
    for (int j = 0; j < 16; ++j) { int s = 0; s = __builtin_amdgcn_sdot4((int)r[j].x, (int)hw[0].x, s, false); s = __builtin_amdgcn_sdot4((int)r[j].y, (int)hw[0].y, s, false); s = __builtin_amdgcn_sdot4((int)r[j].z, (int)hw[0].z, s, false); s = __builtin_amdgcn_sdot4((int)r[j].w, (int)hw[0].w, s, false); d[j] = s; }
#pragma unroll
    for (int j = 0; j < 16; ++j) d[j] += dppi(d[j], 0);
#pragma unroll
    for (int j = 0; j < 16; ++j) d[j] += dppi(d[j], 1);
#pragma unroll
    for (int j = 0; j < 16; ++j) d[j] += dppi(d[j], 2);
    int p0 = 0, p1 = 0;
#pragma unroll
    for (int j = 0; j < 8; ++j) { p0 = (c == j) ? d[2 * j] : p0; p1 = (c == j) ? d[2 * j + 1] : p1; }
    *(unsigned*)po = ((unsigned)((p0 + 32) >> 6) & 0xffffu) | ((unsigned)((p1 + 32) >> 6) << 16);
}
__device__ __forceinline__ void pg_compute_v(const uint4 (&r)[16], const f32x4_t (&aw)[4], const float* xo, unsigned* yo, const float* gtp, float* ssp, float asc, int k, int lane) {
    int acc[16];
#pragma unroll
    for (int m = 0; m < 16; ++m) acc[m] = 0;
    const uint4 a16 = __builtin_bit_cast(uint4, aw[0]); const unsigned aa[4] = {a16.x, a16.y, a16.z, a16.w};
#pragma unroll
    for (int jq = 0; jq < 4; ++jq) {
        const unsigned rr[4][4] = {{r[4 * jq].x, r[4 * jq].y, r[4 * jq].z, r[4 * jq].w}, {r[4 * jq + 1].x, r[4 * jq + 1].y, r[4 * jq + 1].z, r[4 * jq + 1].w},
                                   {r[4 * jq + 2].x, r[4 * jq + 2].y, r[4 * jq + 2].z, r[4 * jq + 2].w}, {r[4 * jq + 3].x, r[4 * jq + 3].y, r[4 * jq + 3].z, r[4 * jq + 3].w}};
#pragma unroll
        for (int cc = 0; cc < 4; ++cc) {
            const unsigned t0 = __builtin_amdgcn_perm(rr[1][cc], rr[0][cc], 0x05010400u), t1 = __builtin_amdgcn_perm(rr[1][cc], rr[0][cc], 0x07030602u);
            const unsigned t2 = __builtin_amdgcn_perm(rr[3][cc], rr[2][cc], 0x05010400u), t3 = __builtin_amdgcn_perm(rr[3][cc], rr[2][cc], 0x07030602u);
            acc[4 * cc + 0] = __builtin_amdgcn_sdot4((int)__builtin_amdgcn_perm(t2, t0, 0x05040100u), (int)aa[jq], acc[4 * cc + 0], false);
            acc[4 * cc + 1] = __builtin_amdgcn_sdot4((int)__builtin_amdgcn_perm(t2, t0, 0x07060302u), (int)aa[jq], acc[4 * cc + 1], false);
            acc[4 * cc + 2] = __builtin_amdgcn_sdot4((int)__builtin_amdgcn_perm(t3, t1, 0x05040100u), (int)aa[jq], acc[4 * cc + 2], false);
            acc[4 * cc + 3] = __builtin_amdgcn_sdot4((int)__builtin_amdgcn_perm(t3, t1, 0x07060302u), (int)aa[jq], acc[4 * cc + 3], false);
        }
    }
    int b8[8];
#pragma unroll
    for (int m = 0; m < 8; ++m) { const int u = acc[m] + __builtin_amdgcn_update_dpp(0, acc[m], 0x128, 0xF, 0xF, true), w = acc[8 + m] + __builtin_amdgcn_update_dpp(0, acc[8 + m], 0x128, 0xF, 0xF, true); b8[m] = (k & 1) ? w : u; }
    int b4[4];
#pragma unroll
    for (int m = 0; m < 4; ++m) { const auto r = __builtin_amdgcn_permlane16_swap((unsigned)b8[m], (unsigned)b8[4 + m], false, false); b4[m] = (int)(r[0] + r[1]); }
    int o2[2];
#pragma unroll
    for (int m = 0; m < 2; ++m) { const auto r = __builtin_amdgcn_permlane32_swap((unsigned)b4[m], (unsigned)b4[2 + m], false, false); o2[m] = (int)(r[0] + r[1]); }
    const float2 gt = *(const float2*)gtp;
    const float y0 = aw[1][1] + gt.x * ((float)o2[0] * asc), y1 = aw[1][2] + gt.y * ((float)o2[1] * asc);
    *yo = pk2(y0, y1);
    float ss = y0 * y0 + y1 * y1;
    ss += dpp_xor1(ss); ss += dpp_xor2(ss); ss += dpp_hmirror(ss);
    ss += __builtin_bit_cast(float, __builtin_amdgcn_update_dpp(0, __builtin_bit_cast(int, ss), 0x140, 0xF, 0xF, true));
    { const auto r = __builtin_amdgcn_permlane16_swap(__float_as_uint(ss), __float_as_uint(ss), false, false); ss = __uint_as_float(r[0]) + __uint_as_float(r[1]); }
    { const auto r = __builtin_amdgcn_permlane32_swap(__float_as_uint(ss), __float_as_uint(ss), false, false); ss = __uint_as_float(r[0]) + __uint_as_float(r[1]); }
    if (lane == 0) *ssp = ss;
}
template <bool VPASS>
__device__ __forceinline__ void phase_peer_gather(KP p, float* lds, int bid, int nb, int wv_) {
    const int tid = opaque_tid(), lane = tid & 63, k = lane >> 3, c = lane & 7;
    const unsigned char* H8 = p->ws + WS_H8I; const unsigned short* idx = (const unsigned short*)(p->ws + WS_IDX16); const float* ascp = (const float*)(p->ws + WS_ASC);
    const unsigned char* TAB = p->ws + (VPASS ? WS_EV8 : WS_EU8);
    int* pdot = (int*)(p->ws + WS_PDOT); const unsigned char* act = p->ws + WS_ACT; float* ssq2 = (float*)(p->ws + WS_SSQ2);
    unsigned* ctr = (unsigned*)(p->ws + WS_CTL) + (VPASS ? CW_VQ : CW_UQ);
    if (VPASS) { for (int i = tid; i < NB * D; i += NT) lds[i] = mod_at(p, i >> 11, 5 * D + (i & (D - 1))); __syncthreads(); }
    const unsigned slot0 = xb_xcc_id() & 7u, c16 = 16u * (unsigned)c;
    const int vcol = 16 * c + 8 * (k & 1) + 4 * ((k >> 1) & 1) + 2 * (k >> 2);
    for (int sl = 0; sl < 8; ++sl) {
        const int slot = (int)((slot0 + sl) & 7u);
        for (;;) {
            unsigned q = 0; if (lane == 0) q = __hip_atomic_fetch_add(ctr + 64 * slot, 1u, __ATOMIC_RELAXED, __HIP_MEMORY_SCOPE_AGENT);
            q = (unsigned)__builtin_amdgcn_readfirstlane((int)q);
            if (q >= 2u * PEER_NTILE) break;
            const int g = slot * 2 + (int)(q / PEER_NTILE), tile = (int)(q % PEER_NTILE);
            const unsigned char* tg = TAB + (size_t)g * GRP_BYTES;
            const size_t tok0 = (size_t)tile * PEER_TT;
            unsigned oA[16], oB[16]; uint4 rA[16], rB[16]; uint4 hA[2], hB[2]; f32x4_t aA[4], aB[4];
#define PG_AUX(tok, hX, aX) do { if (!VPASS) { hX[0] = *(const uint4*)(H8 + (tok) * D + g * 128 + 16 * c); } \
            else { aX[0] = *(const f32x4_t*)(act + (tok) * NSEL + 16 * k); aX[1][0] = ascp[(tok)]; const float2 x1_ = *(const float2*)(p->out + (tok) * D + g * 128 + vcol); aX[1][1] = x1_.x; aX[1][2] = x1_.y; } } while (0)
#define PG_COMPUTE(tok, rX, hX, aX) do { if (!VPASS) pg_compute_u(rX, hX, (short*)pdot + ((size_t)g * M + (tok)) * NSEL + 16 * k + 2 * c, c); \
            else pg_compute_v(rX, aX, p->out + (tok) * D + g * 128 + vcol, (unsigned*)(p->ws + WS_Y16) + ((tok) * D + g * 128 + vcol) / 2, lds + ((tok) / SEQ) * D + g * 128 + vcol, ssq2 + (size_t)g * M + (tok), aX[1][0], k, lane); } while (0)
            pg_load_ids(idx, tok0, k, c16, oA); pg_load_lines(tg, oA, rA); PG_AUX(tok0, hA, aA); pg_load_ids(idx, tok0 + 1, k, c16, oB);
            for (int tt = 0; tt < PEER_TT; tt += 2) {
                pg_load_lines(tg, oB, rB); PG_AUX(tok0 + tt + 1, hB, aB);
                if (tt + 2 < PEER_TT) pg_load_ids(idx, tok0 + tt + 2, k, c16, oA);
                PG_COMPUTE(tok0 + tt, rA, hA, aA);
                if (tt + 2 < PEER_TT) { pg_load_lines(tg, oA, rA); PG_AUX(tok0 + tt + 2, hA, aA); pg_load_ids(idx, tok0 + tt + 3, k, c16, oB); }
                PG_COMPUTE(tok0 + tt + 1, rB, hB, aB);
            }
#undef PG_AUX
#undef PG_COMPUTE
        }
    }
}
__device__ __forceinline__ unsigned u4c(const uint4& v, int i) { return i == 0 ? v.x : i == 1 ? v.y : i == 2 ? v.z : v.w; }
__device__ __forceinline__ int peer_v_slice(int si) { return ((si & 7) << 5) | (si >> 3); }
__device__ __forceinline__ void peer_v_image(KP p, unsigned char* lds, int sl, int wv_) {
    const int tid = opaque_tid(); float* gtl = (float*)(lds + VSL_BYTES);
    const unsigned char* src = p->ws + WS_EV8 + (size_t)sl * VSL_BYTES;
#pragma unroll 4
    for (int i = 0; i < (int)(VSL_BYTES / 16 / NT); ++i) *(uint4*)(lds + ((size_t)i * NT + tid) * 16) = *(const uint4*)(src + ((size_t)i * NT + tid) * 16);
    if (tid < 64) gtl[tid] = ((const float*)(p->ws + WS_MODS))[(size_t)(tid >> 3) * NMOD + 5 * D + sl * 8 + (tid & 7)];
}
template <bool PRE>
__device__ __forceinline__ void phase_peer_v(KP p, unsigned char* lds, int bid, int nb, int wv_) {
    const int tid = opaque_tid(), lane = tid & 63, wave = tid >> 6;
    const unsigned char* actt = p->ws + WS_ACT; const unsigned char* idxt = p->ws + WS_IDXT; const float* ascp = (const float*)(p->ws + WS_ASC);
    float* gtl = (float*)(lds + VSL_BYTES);
    const unsigned lbase = (unsigned)(size_t)(LAS unsigned char*)lds;
    for (int si = bid; si < NVSL; si += nb) {
        const int sl = ((si & 7) << 5) | (si >> 3);
        if (!(PRE && si == bid)) { __syncthreads(); peer_v_image(p, lds, sl, wv_); }
        __syncthreads();
        uint4 W0[3], W1[3], AA[3];
#define PV_LOADCH(slot, btx, cx) do { W0[slot] = *(const uint4*)(idxt + (((size_t)(btx) * 16 + 2 * (cx)) * 64 + lane) * 16); W1[slot] = *(const uint4*)(idxt + (((size_t)(btx) * 16 + 2 * (cx) + 1) * 64 + lane) * 16); \
                                       AA[slot] = *(const uint4*)(actt + (((size_t)(btx) * 8 + (cx)) * 64 + lane) * 16); } while (0)
#define PV_ISSUE(g) do { const int sl_ = ((g) >> 2) % 3, q_ = (g) & 3; const unsigned wa_ = u4c(q_ < 2 ? W0[sl_] : W1[sl_], 2 * (q_ & 1)), wb_ = u4c(q_ < 2 ? W0[sl_] : W1[sl_], 2 * (q_ & 1) + 1); unsigned o0_, o1_, o2_, o3_; \
            asm("v_mad_u32_u16 %0, %1, 8, %2 op_sel:[0,0,0,0]" : "=v"(o0_) : "v"(wa_), "v"(lbase)); asm("v_mad_u32_u16 %0, %1, 8, %2 op_sel:[1,0,0,0]" : "=v"(o1_) : "v"(wa_), "v"(lbase)); \
            asm("v_mad_u32_u16 %0, %1, 8, %2 op_sel:[0,0,0,0]" : "=v"(o2_) : "v"(wb_), "v"(lbase)); asm("v_mad_u32_u16 %0, %1, 8, %2 op_sel:[1,0,0,0]" : "=v"(o3_) : "v"(wb_), "v"(lbase)); \
            VB[(g) % 3][0] = *(LAS const v2u_t*)(size_t)o0_; VB[(g) % 3][1] = *(LAS const v2u_t*)(size_t)o1_; VB[(g) % 3][2] = *(LAS const v2u_t*)(size_t)o2_; VB[(g) % 3][3] = *(LAS const v2u_t*)(size_t)o3_; } while (0)
        PV_LOADCH(0, wave, 0); PV_LOADCH(1, wave, 1);
        for (int bt = wave; bt < M / 64; bt += NT / 64) {
            const size_t token = (size_t)bt * 64 + lane;
            const int btn = bt + NT / 64 < M / 64 ? bt + NT / 64 : bt;
            const uint4 xw = *(const uint4*)((const bf16_t*)(p->ws + WS_X1B) + token * D + sl * 8);
            const float4 xa = make_float4(__uint_as_float(xw.x << 16), __uint_as_float(xw.x & 0xffff0000u), __uint_as_float(xw.y << 16), __uint_as_float(xw.y & 0xffff0000u)), xb = make_float4(__uint_as_float(xw.z << 16), __uint_as_float(xw.z & 0xffff0000u), __uint_as_float(xw.w << 16), __uint_as_float(xw.w & 0xffff0000u));
            const float asc = ascp[token];
            int acc[8];
            v2u_t VB[3][4];
            PV_ISSUE(0); PV_ISSUE(1);
#pragma unroll
            for (int g = 0; g < 32; ++g) {
                if ((g & 3) == 0) { const int c = g >> 2; if (c + 2 < 8) PV_LOADCH((c + 2) % 3, bt, c + 2); else PV_LOADCH((c + 2) % 3, btn, c + 2 - 8); }
                if (g + 2 < 32) PV_ISSUE(g + 2);
                __builtin_amdgcn_sched_barrier(0);
                const unsigned a4 = u4c(AA[(g >> 2) % 3], g & 3);
#pragma unroll
                for (int d = 0; d < 2; ++d) {
                    const unsigned r0 = VB[g % 3][0][d], r1 = VB[g % 3][1][d], r2 = VB[g % 3][2][d], r3 = VB[g % 3][3][d];
                    const unsigned t0 = __builtin_amdgcn_perm(r1, r0, 0x05010400u), t1 = __builtin_amdgcn_perm(r1, r0, 0x07030602u), t2 = __builtin_amdgcn_perm(r3, r2, 0x05010400u), t3 = __builtin_amdgcn_perm(r3, r2, 0x07030602u);
                    const int c0 = (int)__builtin_amdgcn_perm(t2, t0, 0x05040100u), c1 = (int)__builtin_amdgcn_perm(t2, t0, 0x07060302u), c2 = (int)__builtin_amdgcn_perm(t3, t1, 0x05040100u), c3 = (int)__builtin_amdgcn_perm(t3, t1, 0x07060302u);
                    if (g == 0) { acc[4 * d] = dot4_0(c0, (int)a4); acc[4 * d + 1] = dot4_0(c1, (int)a4); acc[4 * d + 2] = dot4_0(c2, (int)a4); acc[4 * d + 3] = dot4_0(c3, (int)a4); }
                    else { acc[4 * d] = __builtin_amdgcn_sdot4(c0, (int)a4, acc[4 * d], false); acc[4 * d + 1] = __builtin_amdgcn_sdot4(c1, (int)a4, acc[4 * d + 1], false);
                           acc[4 * d + 2] = __builtin_amdgcn_sdot4(c2, (int)a4, acc[4 * d + 2], false); acc[4 * d + 3] = __builtin_amdgcn_sdot4(c3, (int)a4, acc[4 * d + 3], false); }
                }
                __builtin_amdgcn_sched_barrier(0);
            }
            { const uint4 t0_ = W0[0], t1_ = W1[0], t2_ = AA[0]; W0[0] = W0[2]; W1[0] = W1[2]; AA[0] = AA[2]; W0[1] = t0_; W1[1] = t1_; AA[1] = t2_; }
            const float* gt = gtl + (bt >> 5) * 8;
            const float y0 = xa.x + gt[0] * ((float)acc[0] * asc), y1 = xa.y + gt[1] * ((float)acc[1] * asc), y2 = xa.z + gt[2] * ((float)acc[2] * asc), y3 = xa.w + gt[3] * ((float)acc[3] * asc);
            const float y4 = xb.x + gt[4] * ((float)acc[4] * asc), y5 = xb.y + gt[5] * ((float)acc[5] * asc), y6 = xb.z + gt[6] * ((float)acc[6] * asc), y7 = xb.w + gt[7] * ((float)acc[7] * asc);
            *(uint4*)((bf16_t*)(p->ws + WS_Y16) + ((size_t)sl * M + token) * 8) = make_uint4(pk2(y0, y1), pk2(y2, y3), pk2(y4, y5), pk2(y6, y7));
        }
    }
}
#undef PV_LOADCH
#undef PV_ISSUE
constexpr int NCS = 4;
__device__ __forceinline__ void phase_peer_u(KP p, unsigned char* lds, int bid, int nb, int wv_) {
    const int tid = opaque_tid(), lane = tid & 63, wave = tid >> 6;
    const unsigned char* idxt = p->ws + WS_IDXT; const unsigned char* H8 = p->ws + WS_H8I;
    const unsigned lbase = (unsigned)(size_t)(LAS unsigned char*)lds;
    constexpr int NSL = NVSL / NCS;
    for (int unit = bid; unit < NCS * (M / 256); unit += nb) {
        const int cs = unit & 3, bt = (unit >> 2) * 4 + (wave >> 1), hf = wave & 1;
        const size_t token = (size_t)bt * 64 + lane;
        const unsigned char* tsl = p->ws + WS_EU8 + (size_t)cs * NSL * VSL_BYTES + (size_t)tid * 16;
        const unsigned char* idb = idxt + (((size_t)bt * 16 + hf * 8) * 64 + lane) * 16;
        const unsigned char* hb = p->ws + WS_H8T + ((size_t)cs * NSL * M + token) * 8;
        int acc[64];
#pragma unroll
        for (int i = 0; i < 64; ++i) acc[i] = 0;
        uint4 st[16];
#pragma unroll
        for (int i = 0; i < 16; ++i) st[i] = *(const uint4*)(tsl + (size_t)i * NT * 16);
        uint4 IW[8];
#pragma unroll
        for (int c = 0; c < 8; ++c) IW[c] = *(const uint4*)(idb + c * 1024);
        unsigned OA[64];
#pragma unroll
        for (int c = 0; c < 8; ++c)
#pragma unroll
            for (int w = 0; w < 4; ++w) { const unsigned wd = u4c(IW[c], w);
                asm("v_mad_u32_u16 %0, %1, 8, %2 op_sel:[0,0,0,0]" : "=v"(OA[8 * c + 2 * w]) : "v"(wd), "v"(lbase)); asm("v_mad_u32_u16 %0, %1, 8, %2 op_sel:[1,0,0,0]" : "=v"(OA[8 * c + 2 * w + 1]) : "v"(wd), "v"(lbase)); }
        v2u_t hn = *(const v2u_t*)(hb);
#pragma unroll 1
        for (int s = 0; s < NSL; ++s) {
            __syncthreads();
#pragma unroll
            for (int i = 0; i < 16; ++i) *(LAS v4i_t*)(size_t)(lbase + (unsigned)(i * NT + tid) * 16u) = __builtin_bit_cast(v4i_t, st[i]);
            __syncthreads();
            const v2u_t hv = hn;
            const int sn = s + 1 < NSL ? s + 1 : s;
            hn = *(const v2u_t*)(hb + (size_t)sn * M * 8);
            const unsigned char* tn = tsl + (size_t)sn * VSL_BYTES;
            v2u_t VB[3][4];
#define PU_ISSUE(g) do { VB[(g) % 3][0] = *(LAS const v2u_t*)(size_t)OA[4 * (g)]; VB[(g) % 3][1] = *(LAS const v2u_t*)(size_t)OA[4 * (g) + 1]; VB[(g) % 3][2] = *(LAS const v2u_t*)(size_t)OA[4 * (g) + 2]; VB[(g) % 3][3] = *(LAS const v2u_t*)(size_t)OA[4 * (g) + 3]; } while (0)
            PU_ISSUE(0); PU_ISSUE(1);
#pragma unroll
            for (int g = 0; g < 16; ++g) {
                if (g < 8) { st[2 * g] = *(const uint4*)(tn + (size_t)(2 * g) * NT * 16); st[2 * g + 1] = *(const uint4*)(tn + (size_t)(2 * g + 1) * NT * 16); }
                if (g + 2 < 16) PU_ISSUE(g + 2);
                __builtin_amdgcn_sched_barrier(0);
#pragma unroll
                for (int j = 0; j < 4; ++j) {
                    const int sidx = 4 * g + j;
                    int a_ = acc[sidx];
                    a_ = __builtin_amdgcn_sdot4((int)VB[g % 3][j][0], (int)hv[0], a_, false);
                    acc[sidx] = __builtin_amdgcn_sdot4((int)VB[g % 3][j][1], (int)hv[1], a_, false);
                }
                __builtin_amdgcn_sched_barrier(0);
            }
#undef PU_ISSUE
        }
        unsigned* po = (unsigned*)(p->ws + WS_PDOT) + ((size_t)cs * M + token) * (NSEL / 2) + hf * 32;
        typedef __fp16 h2v_ __attribute__((ext_vector_type(2)));
#define PKH(a, b) __builtin_bit_cast(unsigned, (h2v_)__builtin_amdgcn_cvt_pkrtz((float)(a) * (1.f / 256.f), (float)(b) * (1.f / 256.f)))
#pragma unroll
        for (int i = 0; i < 8; ++i) *(uint4*)(po + 4 * i) = make_uint4(PKH(acc[8 * i], acc[8 * i + 1]), PKH(acc[8 * i + 2], acc[8 * i + 3]), PKH(acc[8 * i + 4], acc[8 * i + 5]), PKH(acc[8 * i + 6], acc[8 * i + 7]));
#undef PKH
    }
}
__device__ __forceinline__ void act_scale_image(KP p, int wv_) {
    const int tid = opaque_tid(); const unsigned char* src = p->ws + WS_ESCALE; LAS unsigned char* img = dyn_lds_base();
#pragma unroll 4
    for (int i = 0; i < 16; ++i) *(LAS v4i_t*)(img + ((size_t)i * NT + tid) * 16) = __builtin_bit_cast(v4i_t, *(const uint4*)(src + ((size_t)i * NT + tid) * 16));
}
__device__ __forceinline__ void phase_peer_act(KP p, int bid, int nb, int wv_) {
    const int tid = opaque_tid(), lane = tid & 63, wave = tid >> 6;
    const int* idx = (const int*)(p->ws + WS_IDX); const float* gate = (const float*)(p->ws + WS_GATE); const LAS float* esc = (const LAS float*)dyn_lds_base();
    const unsigned* pdot = (const unsigned*)(p->ws + WS_PDOT); unsigned char* act = p->ws + WS_ACT;
    unsigned W[NCS]; unsigned ew_n = 0u, gw_n = 0u; float hs_n = 0.f;
#define ACT_LOAD(tk) do { _Pragma("unroll") for (int g = 0; g < NCS; ++g) W[g] = pdot[((size_t)g * M + (tk)) * (NSEL / 2) + lane]; \
        ew_n = ((const unsigned*)(p->ws + WS_IDXT))[(((size_t)((tk) >> 6) * 16 + (lane >> 2)) * 64 + ((tk) & 63)) * 4 + (lane & 3)]; gw_n = ((const unsigned*)(p->ws + WS_GATE))[(size_t)(tk) * (NSEL / 2) + lane]; \
        hs_n = ((const float*)(p->ws + WS_HSC))[(tk)]; } while (0)
    if (bid * 8 + wave < M) ACT_LOAD(bid * 8 + wave);
    for (int token = bid * 8 + wave; token < M; token += nb * 8) {
        float d0 = 0.f, d1 = 0.f;
#pragma unroll
        for (int g = 0; g < NCS; ++g) { typedef __fp16 h2p_ __attribute__((ext_vector_type(2))); const h2p_ hp = __builtin_bit_cast(h2p_, W[g]); d0 += (float)hp[0]; d1 += (float)hp[1]; }
        d0 *= 256.f; d1 *= 256.f;
        const unsigned ew = ew_n, gw = gw_n; const float hs = hs_n;
        if (token + nb * 8 < M) ACT_LOAD(token + nb * 8);
        typedef __fp16 h2v_ __attribute__((ext_vector_type(2))); const h2v_ gh = __builtin_bit_cast(h2v_, gw);
        const int2 e = make_int2((int)(ew & 0xffffu), (int)(ew >> 16)); const float2 gt2 = make_float2((float)gh[0], (float)gh[1]);
        const float a0 = gelu_t(d0 * (esc[e.x] * hs)) * gt2.x * esc[NKEYS * NKEYS + e.x];
        const float a1 = gelu_t(d1 * (esc[e.y] * hs)) * gt2.y * esc[NKEYS * NKEYS + e.y];
        const float am = wave_max(fmaxf(fabsf(a0), fabsf(a1))); const float sc = am > 0.f ? 127.f / am : 0.f;
        { const size_t bt = (size_t)(token >> 6), tl = (size_t)(token & 63);
          *(unsigned short*)(act + ((bt * 8 + (lane >> 3)) * 64 + tl) * 16 + (2 * lane & 15)) = (unsigned short)(((unsigned)__float2int_rn(a0 * sc) & 0xffu) | (((unsigned)__float2int_rn(a1 * sc) & 0xffu) << 8));
        }
        if (lane == 0) ((float*)(p->ws + WS_ASC))[token] = am * (1.f / 127.f);
    }
}
#undef ACT_LOAD
__device__ __forceinline__ void phase_final_norm(KP p, int bid, int nb, int wv_) {
    const int tid = opaque_tid();
    const float* gf = p->in[I_GFIN]; const bf16_t* y16 = (const bf16_t*)(p->ws + WS_Y16);
    constexpr int PITCH = 2 * D + 16;
    LAS unsigned char* img = dyn_lds_base(); LAS float* part = (LAS float*)(img + 32 * PITCH);
    const float4 g4 = *(const float4*)(gf + 4 * tid);
    uint4 wy[16]; const int tk = tid & 31;
#define FN_LOAD(itx) do { const size_t t0_ = (size_t)(itx) * 32; _Pragma("unroll") for (int k = 0; k < 16; ++k) { const int sc = (k * NT + tid) >> 5; \
        wy[k] = *(const uint4*)(y16 + ((size_t)sc * M + t0_ + tk) * 8); } } while (0)
    if (bid < M / 32) FN_LOAD(bid);
    for (int item = bid; item < M / 32; item += nb) {
        const size_t tok0 = (size_t)item * 32;
        LDS_BARRIER();
        float ss = 0.f;
#pragma unroll
        for (int k = 0; k < 16; ++k) { const int sc = (k * NT + tid) >> 5; *(LAS v4i_t*)(img + tk * PITCH + sc * 16) = __builtin_bit_cast(v4i_t, wy[k]);
            { const uint4 w_ = wy[k]; const float e0 = __uint_as_float(w_.x << 16), e1 = __uint_as_float(w_.x & 0xffff0000u), e2 = __uint_as_float(w_.y << 16), e3 = __uint_as_float(w_.y & 0xffff0000u), e4 = __uint_as_float(w_.z << 16), e5 = __uint_as_float(w_.z & 0xffff0000u), e6 = __uint_as_float(w_.w << 16), e7 = __uint_as_float(w_.w & 0xffff0000u);
              ss += ((e0 * e0 + e1 * e1) + (e2 * e2 + e3 * e3)) + ((e4 * e4 + e5 * e5) + (e6 * e6 + e7 * e7)); } }
        part[tid] = ss;
        LDS_BARRIER();
        if (item + nb < M / 32) FN_LOAD(item + nb);
#pragma unroll 8
        for (int r = 0; r < 32; ++r) {
            float s2 = 0.f;
#pragma unroll
            for (int j = 0; j < 16; ++j) s2 += part[r + 32 * j];
            const float rstd = rsqrtf(s2 * (1.f / D) + EPS);
            const v2u_t w = *(LAS const v2u_t*)(img + r * PITCH + tid * 8);
            *(float4*)(p->out + (tok0 + r) * D + 4 * tid) = make_float4(__uint_as_float(w[0] << 16) * rstd * g4.x, __uint_as_float(w[0] & 0xffff0000u) * rstd * g4.y, __uint_as_float(w[1] << 16) * rstd * g4.z, __uint_as_float(w[1] & 0xffff0000u) * rstd * g4.w);
        }
    }
}
#undef FN_LOAD

#define XB_TMO      128
#define XB_XCNT(j)  (256  + 64 * (j))
#define XB_XSUB(j)  (1280 + 64 * (j))
#define XB_XGEN(j)  (2304 + 64 * (j))
#define XB_TOP      3328
#define XB_TOPGEN   3392
#define XCD_BAR_WORDS 3456
#define XB_SPIN_CAP (1u << 18)

__device__ __forceinline__ unsigned xb_ld(unsigned* p)              { return __hip_atomic_load(p, __ATOMIC_RELAXED, __HIP_MEMORY_SCOPE_AGENT); }
__device__ __forceinline__ unsigned xb_add(unsigned* p, unsigned v) { return __hip_atomic_fetch_add(p, v, __ATOMIC_RELAXED, __HIP_MEMORY_SCOPE_AGENT); }
__device__ __forceinline__ unsigned xb_xcc_id() { return (unsigned)__builtin_amdgcn_s_getreg((3 << 11) | 20) & 0xFu; }
#define XB_SPIN(cond, bar) do { unsigned _sp = 0; while (cond) { __builtin_amdgcn_s_sleep(1); \
    if ((++_sp & 255u) == 0u) { if (xb_ld(&(bar)[XB_TMO])) break; if (_sp > XB_SPIN_CAP) { atomicAdd(&(bar)[XB_TMO], 1u); break; } } } } while (0)

struct XcdBarrier {
    unsigned* bar; unsigned x;
    volatile LAS unsigned* st;
};

__device__ __forceinline__ XcdBarrier xcd_barrier_post(unsigned* bar, volatile LAS unsigned* st) {
    XcdBarrier b; b.bar = bar; b.x = xb_xcc_id(); b.st = st;
    if (threadIdx.x == 0) (void)xb_add(&bar[XB_XCNT(b.x)], 1u);
    return b;
}
__device__ __forceinline__ void xcd_barrier_complete(unsigned* bar, unsigned x, unsigned& nloc, unsigned& nx, unsigned& xmask) {
    const unsigned G = gridDim.x * gridDim.y * gridDim.z;
    unsigned sum, cnt, mine, msk, sp = 0u;
    for (;;) {
        sum = 0u; cnt = 0u; mine = 0u; msk = 0u;
#pragma unroll
        for (unsigned j = 0; j < 16; ++j) { const unsigned c = xb_ld(&bar[XB_XCNT(j)]); sum += c; cnt += (c > 0u) ? 1u : 0u; msk |= (c > 0u) ? (1u << j) : 0u; mine = (j == x) ? c : mine; }
        if (sum == G) break;
        __builtin_amdgcn_s_sleep(1);
        if ((++sp & 255u) == 0u) { if (xb_ld(&bar[XB_TMO])) break; if (sp > XB_SPIN_CAP) { atomicAdd(&bar[XB_TMO], 1u); break; } }
    }
    nloc = mine > 0u ? mine : 1u; nx = cnt > 0u ? cnt : 1u; xmask = msk | (1u << x);
}

__device__ __forceinline__ void xcd_barrier_arrive(const XcdBarrier& b, bool leader) {
    asm volatile("s_waitcnt vmcnt(0)" ::: "memory");
    __syncthreads();
    if (leader) {
        unsigned* bar = b.bar;
        __builtin_amdgcn_s_waitcnt(0);
        unsigned nloc = b.st[0], nx = b.st[1];
        if (nloc == 0u) { unsigned xm_; xcd_barrier_complete(bar, b.x, nloc, nx, xm_); b.st[0] = nloc; b.st[1] = nx; b.st[2] = xm_; }
        const unsigned old = xb_add(&bar[XB_XSUB(b.x)], 1u);
        const unsigned gen = old / nloc;
        if (old + 1u == (gen + 1u) * nloc) {
            __builtin_amdgcn_fence(__ATOMIC_RELEASE, "agent");
            asm volatile("s_waitcnt vmcnt(0)" ::: "memory");
            const unsigned xm = b.st[2];
#pragma unroll
            for (unsigned j = 0; j < 16; ++j) if (xm & (1u << j)) (void)xb_add(&bar[XB_XGEN(j)], 1u);
        }
        b.st[3] = (gen + 1u) * nx;
    }
}
__device__ __forceinline__ void xcd_barrier_wait(const XcdBarrier& b, bool leader) {
    if (leader) {
        unsigned* bar = b.bar; const unsigned tgt = b.st[3];
        XB_SPIN(xb_ld(&bar[XB_XGEN(b.x)]) < tgt, bar);
        __builtin_amdgcn_fence(__ATOMIC_ACQUIRE, "agent");
        asm volatile("s_waitcnt vmcnt(0)" ::: "memory");
    }
    __syncthreads();
}
__device__ __forceinline__ void xcd_barrier(const XcdBarrier& b, bool leader) { xcd_barrier_arrive(b, leader); xcd_barrier_wait(b, leader); }


constexpr int LDS_BYTES = 147456;
__global__ void __launch_bounds__(NT) fwd_megakernel(Params p_unused) {
    KP p = (KP)__builtin_amdgcn_kernarg_segment_ptr();
    float* lds = (float*)dyn_lds;
    const int bid = blockIdx.x, nb = gridDim.x, wv_ = __builtin_amdgcn_readfirstlane((int)(threadIdx.x >> 6));
    volatile LAS unsigned* bst = (volatile LAS unsigned*)((LAS unsigned char*)dyn_lds + LDS_BYTES - 16);
    if (threadIdx.x < 4) bst[threadIdx.x] = 0u;
    __syncthreads();
    if (bid == 0) for (int i = (int)threadIdx.x; i < XCD_BAR_WORDS; i += NT) ((unsigned*)(p->ws + WS_CTL))[i] = 0u;
#define GRID_BAR() do { XcdBarrier xb_; xb_.bar = (unsigned*)(p->ws + WS_CTL); xb_.x = xb_xcc_id(); xb_.st = (volatile LAS unsigned*)((LAS unsigned char*)dyn_lds + LDS_BYTES - 16); xcd_barrier(xb_, opaque_tid() == 0); } while (0)
#define GRID_ARRIVE() do { XcdBarrier xb_; xb_.bar = (unsigned*)(p->ws + WS_CTL); xb_.x = xb_xcc_id(); xb_.st = (volatile LAS unsigned*)((LAS unsigned char*)dyn_lds + LDS_BYTES - 16); xcd_barrier_arrive(xb_, opaque_tid() == 0); } while (0)
#define GRID_WAIT() do { XcdBarrier xb_; xb_.bar = (unsigned*)(p->ws + WS_CTL); xb_.x = xb_xcc_id(); xb_.st = (volatile LAS unsigned*)((LAS unsigned char*)dyn_lds + LDS_BYTES - 16); xcd_barrier_wait(xb_, opaque_tid() == 0); } while (0)
    phase_mod(p, lds, bid, nb, wv_);
    __syncthreads();
    phase_convert_weights(p, lds, bid, nb, wv_);
    phase_amax(p, bid, nb, wv_);
    phase_convert_experts(p, bid, nb, wv_);
    cg::this_grid().sync();
    (void)xcd_barrier_post((unsigned*)(p->ws + WS_CTL), bst);
    for (int i = bid * NT + opaque_tid(); i < NB * NMOD; i += nb * NT) ((float*)(p->ws + WS_MODS))[i] = mod_at(p, i / NMOD, i % NMOD);
    phase_hrows<true>(p, p->in[I_X], p->in[I_GMIX], 0, D, (bf16_t*)(p->ws + WS_H), lds, bid, nb, wv_);
    phase_convert_weights8(p, lds, bid, nb, wv_);
    GRID_BAR();
    { pg8::Gemm g{(const bf16_t*)(p->ws + WS_H), (const bf16_t*)(p->ws + WS_WIN_T), M, NPROJ, D / 2}; pg8::StaticOrder S; S.init(M, NPROJ, nb, bid);
      pg8::EpiProj<true> E{(bf16_t*)(p->ws + WS_PROJ), (float*)(p->ws + WS_SSQV), M, (const float*)(p->ws + WS_HSCALE1), (const float*)(p->ws + WS_CTL) + CW_WSCALE};
      pg8::gemm_phase<pg8::EpiProj<true>, pg8::StaticOrder, true, true, 2>((LAS unsigned char*)dyn_lds, g, S, E, wv_); }
    GRID_BAR();
    phase_lru(p, dyn_lds, bid, nb, wv_);
    phase_sgu(p, dyn_lds, bid, nb, wv_);
    GRID_BAR();
    { pg8::Gemm g{(const bf16_t*)(p->ws + WS_YMIX), (const bf16_t*)(p->ws + WS_WOUT_T), M, D, D / 2}; pg8::StaticOrder S; S.init(M, D, nb, bid);
      pg8::EpiX1 E{p->in[I_X], (bf16_t*)(p->ws + WS_X1B), (const float*)(p->ws + WS_MODS), p->in[I_BADA], 2 * D, NMOD, SEQ, (const float*)(p->ws + WS_CTL) + CW_WSCALE + 1, 1.f / YMIX_SCALE};
      pg8::gemm_phase<pg8::EpiX1, pg8::StaticOrder, true, true, 1>((LAS unsigned char*)dyn_lds, g, S, E, wv_); }
    GRID_BAR();
    phase_hrows<false, true, true, true>(p, (const float*)(p->ws + WS_X1B), p->in[I_GFFN], 3 * D, 4 * D, (bf16_t*)(p->ws + WS_H), lds, bid, nb, wv_);
    GRID_BAR();
    { pg8::Gemm g{(const bf16_t*)(p->ws + WS_H8I), (const bf16_t*)(p->ws + WS_WQ_T), M, D, D / 2}; pg8::StaticOrder S; S.init(M, D, nb, bid);
      pg8::EpiQ E{(bf16_t*)(p->ws + WS_Q), D, (const float*)(p->ws + WS_HSC), (const float*)(p->ws + WS_CTL) + CW_WSCALE + 2};
      pg8::gemm_phase<pg8::EpiQ, pg8::StaticOrder, true, true, 2>((LAS unsigned char*)dyn_lds, g, S, E, wv_); }
    GRID_BAR();
    phase_topk(p, dyn_lds, bid, nb, wv_);
    GRID_BAR();
    phase_peer_u(p, dyn_lds, bid, nb, wv_);
    GRID_ARRIVE();
    act_scale_image(p, wv_);
    GRID_WAIT();
    phase_peer_act(p, bid, nb, wv_);
    GRID_ARRIVE();
    if (bid < NVSL) peer_v_image(p, dyn_lds, peer_v_slice(bid), wv_);
    GRID_WAIT();
    phase_peer_v<true>(p, dyn_lds, bid, nb, wv_);
    GRID_BAR();
    phase_final_norm(p, bid, nb, wv_);
}

extern "C" void kernel_launch(void* const* d_in, const int* in_sizes, int n_in, void* d_out, int out_size, void* d_ws, size_t ws_size, hipStream_t stream) {
    static int grid_blocks = 0;
    if (grid_blocks == 0) {
        if (n_in != 23 || in_sizes[0] != M * D || out_size != M * D || ws_size < WS_END) { fprintf(stderr, "kernel_launch: unexpected shapes (n_in %d in0 %d out %d ws %zu)\n", n_in, n_in > 0 ? in_sizes[0] : -1, out_size, ws_size); grid_blocks = -1; return; }
        if (hipFuncSetAttribute((const void*)fwd_megakernel, hipFuncAttributeMaxDynamicSharedMemorySize, LDS_BYTES) != hipSuccess) { fprintf(stderr, "hipFuncSetAttribute failed\n"); grid_blocks = -1; return; }
        int dev = 0, cus = 0, per_cu = 0;
        hipGetDevice(&dev);
        hipDeviceGetAttribute(&cus, hipDeviceAttributeMultiprocessorCount, dev);
        if (hipOccupancyMaxActiveBlocksPerMultiprocessor(&per_cu, (const void*)fwd_megakernel, NT, LDS_BYTES) != hipSuccess || per_cu < 1) { fprintf(stderr, "occupancy query failed (%d)\n", per_cu); grid_blocks = -1; return; }
        grid_blocks = cus;
    }
    if (grid_blocks < 0) return;
    Params p{};
    for (int i = 0; i < 23; ++i) p.in[i] = (const float*)d_in[i];
    p.out = (float*)d_out; p.ws = (unsigned char*)d_ws;
    void* args[] = {&p};
    hipError_t e = hipLaunchCooperativeKernel((const void*)fwd_megakernel, dim3(grid_blocks), dim3(NT), args, LDS_BYTES, stream);
    if (e != hipSuccess) fprintf(stderr, "cooperative launch failed: %s (grid %d)\n", hipGetErrorString(e), grid_blocks);
}
```
